# Optimizing an MI355X kernel written in HIP

```python
import jax, jax.numpy as jnp
from jax import lax
import numpy as np

D_MODEL = 1024
BATCH = 1
SEQ = 16384
DEPTH = 4

D_MIX = D_MODEL
D_REC = D_MIX // 2
D_SGU = D_MIX - D_REC
REC_EXPAND = 128
H_REC = D_REC // REC_EXPAND
DK_REC = REC_EXPAND
DV_REC = D_REC // H_REC
CHUNK_REC = 64
SGU_CHUNK = 128
H_SGU = 4
DH_SGU = D_SGU // H_SGU
D_IN = 4 * D_REC + 2 * D_SGU
N_GROUPS = 4
EXP_PER_GROUP = 8
N_EXPERTS = N_GROUPS * EXP_PER_GROUP
TOP_K = 2
D_EXPERT = 512
MOE_BLOCK = 128
P_DIM = 256
EPS = 1e-6

kernel_name = 'hybrid_hgrn2_chunksgu_hmoe'


def rmsnorm(x, g):
    xf = x.astype(jnp.float32)
    y = xf * lax.rsqrt(jnp.mean(xf * xf, axis=-1, keepdims=True) + EPS)
    return (y * g.astype(jnp.float32)).astype(x.dtype)


def hgrn2(q, fz, i, g, lb, o_gain):
    B, S, _ = q.shape
    dt = q.dtype
    nc = S // CHUNK_REC
    q = jax.nn.silu(q.astype(jnp.float32))
    fz = fz.astype(jnp.float32)
    logf = jnp.logaddexp(jnp.log(lb), jnp.log1p(-lb) + jax.nn.log_sigmoid(fz))
    k = (1.0 - lb) * jax.nn.sigmoid(-fz)

    def to_chunks(t, d):
        return t.reshape(B, nc, CHUNK_REC, H_REC, d).transpose(1, 0, 3, 2, 4)

    xs = (to_chunks(q, DK_REC), to_chunks(k, DK_REC), to_chunks(logf, DK_REC),
          to_chunks(i.astype(jnp.float32), DV_REC))
    causal = jnp.tril(jnp.ones((CHUNK_REC, CHUNK_REC), dtype=bool))[:, :, None]

    def step(state, c):
        qc, kc, lfc, ic = c
        b = jnp.cumsum(lfc, axis=2)
        o_inter = jnp.einsum('bhtk,bhkv->bhtv', qc * jnp.exp(b), state)
        decay = jnp.exp(jnp.where(causal, b[:, :, :, None, :] - b[:, :, None, :, :], -jnp.inf))
        scores = jnp.einsum('bhtk,bhsk,bhtsk->bhts', qc, kc, decay)
        o_intra = jnp.einsum('bhts,bhsv->bhtv', scores, ic)
        b_last = b[:, :, -1:, :]
        state = (jnp.exp(b_last[:, :, 0, :, None]) * state
                 + jnp.einsum('bhsk,bhsv->bhkv', kc * jnp.exp(b_last - b), ic))
        return state, o_inter + o_intra

    s0 = jnp.zeros((B, H_REC, DK_REC, DV_REC), jnp.float32)
    _, o = lax.scan(step, s0, xs)
    o = o.transpose(1, 0, 3, 2, 4).reshape(B, S, H_REC, DV_REC)
    o = o * lax.rsqrt(jnp.mean(o * o, axis=-1, keepdims=True) + EPS) * o_gain.astype(jnp.float32)
    o = o.reshape(B, S, D_REC) * jax.nn.silu(g.astype(jnp.float32))
    return o.astype(dt)


def chunk_sgu(u, v, ln_g, ln_b, w_s, b_s):
    B, S, _ = u.shape
    dt = u.dtype
    u = jax.nn.gelu(u.astype(jnp.float32))
    v = jax.nn.gelu(v.astype(jnp.float32))
    mu = jnp.mean(v, axis=-1, keepdims=True)
    var = jnp.mean(jnp.square(v - mu), axis=-1, keepdims=True)
    v = (v - mu) * lax.rsqrt(var + EPS) * ln_g.astype(jnp.float32) + ln_b.astype(jnp.float32)
    v = v.reshape(B, S // SGU_CHUNK, SGU_CHUNK, H_SGU, DH_SGU)
    w = w_s.astype(jnp.float32) * jnp.tril(jnp.ones((SGU_CHUNK, SGU_CHUNK), jnp.float32))
    s = jnp.einsum('hts,bnshd->bnthd', w, v) + b_s.astype(jnp.float32).T[:, :, None]
    return (u * s.reshape(B, S, D_SGU)).astype(dt)


def hier_moe(x, w_rg, b_rg, w_re, b_re, w_gate, w_up, w_down):
    B, S, D = x.shape
    T = B * S
    n = T * TOP_K
    xt = x.reshape(T, D)
    lg = (xt @ w_rg).astype(jnp.float32)
    g_sel = jnp.argmax(lg + b_rg.astype(jnp.float32), axis=-1)
    g_w = jnp.take_along_axis(jax.nn.softmax(lg, axis=-1), g_sel[:, None], axis=-1)
    le = (xt @ w_re).astype(jnp.float32).reshape(T, N_GROUPS, EXP_PER_GROUP)
    le = jnp.take_along_axis(le, g_sel[:, None, None], axis=1)[:, 0]
    be = b_re.astype(jnp.float32).reshape(N_GROUPS, EXP_PER_GROUP)[g_sel]
    _, e_sel = lax.top_k(le + be, TOP_K)
    e_w = jnp.take_along_axis(jax.nn.softmax(le, axis=-1), e_sel, axis=-1)
    e_w = e_w / jnp.sum(e_w, axis=-1, keepdims=True)
    w_tok = (g_w * e_w).reshape(n)
    expert = (g_sel[:, None] * EXP_PER_GROUP + e_sel).reshape(n).astype(jnp.int32)
    order = jnp.argsort(expert)
    e_sorted = expert[order]
    tok_sorted = (order // TOP_K).astype(jnp.int32)
    counts = jnp.bincount(expert, length=N_EXPERTS)
    padded = (counts + MOE_BLOCK - 1) // MOE_BLOCK * MOE_BLOCK
    start = jnp.cumsum(counts) - counts
    pend = jnp.cumsum(padded)
    pstart = pend - padded
    dest = pstart[e_sorted] + jnp.arange(n) - start[e_sorted]
    n_blocks = -(-n // MOE_BLOCK) + N_EXPERTS
    cap = n_blocks * MOE_BLOCK
    x_buf = jnp.zeros((cap, D), x.dtype).at[dest].set(xt[tok_sorted])
    tok_buf = jnp.full((cap,), T, jnp.int32).at[dest].set(tok_sorted)
    w_buf = jnp.zeros((cap,), jnp.float32).at[dest].set(w_tok[order])
    block_e = jnp.clip(jnp.searchsorted(pend, jnp.arange(n_blocks) * MOE_BLOCK, side='right'),
                       0, N_EXPERTS - 1)

    def expert_block(args):
        xb, e = args
        h = jax.nn.silu(xb @ w_gate[e]) * (xb @ w_up[e])
        return h @ w_down[e]

    y = lax.map(expert_block, (x_buf.reshape(n_blocks, MOE_BLOCK, D), block_e))
    y = y.reshape(cap, D).astype(jnp.float32) * w_buf[:, None]
    out = jax.ops.segment_sum(y, tok_buf, num_segments=T + 1)[:T]
    return out.reshape(B, S, D).astype(x.dtype)


def setup_inputs(seed: int = 0) -> dict:
    key = jax.random.key(seed)
    ks = jax.random.split(key, 26)
    f32 = jnp.float32

    def nrm(k, shape, scale):
        return jax.random.normal(k, shape, f32) * scale

    def gain(k, shape):
        return 1.0 + 0.02 * jax.random.normal(k, shape, f32)

    return {
        'x': nrm(ks[0], (BATCH, SEQ, D_MODEL), 1.0),
        'p': nrm(ks[1], (DEPTH, BATCH, SEQ, P_DIM), 1.0),
        'norm_mix': gain(ks[2], (DEPTH, D_MODEL)),
        'w_in': nrm(ks[3], (DEPTH, D_MODEL, D_IN), D_MODEL ** -0.5),
        'lb_logits': nrm(ks[4], (DEPTH, D_REC), 0.5),
        'rec_out_gain': gain(ks[5], (DEPTH, DV_REC)),
        'sgu_ln_g': gain(ks[6], (DEPTH, D_SGU)),
        'sgu_ln_b': nrm(ks[7], (DEPTH, D_SGU), 0.01),
        'sgu_w': nrm(ks[8], (DEPTH, H_SGU, SGU_CHUNK, SGU_CHUNK), SGU_CHUNK ** -0.5),
        'sgu_b': 1.0 + nrm(ks[9], (DEPTH, H_SGU, SGU_CHUNK), 0.01),
        'w_out': nrm(ks[10], (DEPTH, D_MIX, D_MODEL), D_MIX ** -0.5),
        'norm_ffn': gain(ks[11], (DEPTH, D_MODEL)),
        'w_rg': nrm(ks[12], (DEPTH, D_MODEL, N_GROUPS), D_MODEL ** -0.5),
        'b_rg': nrm(ks[13], (DEPTH, N_GROUPS), 0.01),
        'w_re': nrm(ks[14], (DEPTH, D_MODEL, N_EXPERTS), D_MODEL ** -0.5),
        'b_re': nrm(ks[15], (DEPTH, N_EXPERTS), 0.01),
        'w_gate': nrm(ks[16], (DEPTH, N_EXPERTS, D_MODEL, D_EXPERT), D_MODEL ** -0.5),
        'w_up': nrm(ks[17], (DEPTH, N_EXPERTS, D_MODEL, D_EXPERT), D_MODEL ** -0.5),
        'w_down': nrm(ks[18], (DEPTH, N_EXPERTS, D_EXPERT, D_MODEL), D_EXPERT ** -0.5),
        'norm_pg': gain(ks[19], (DEPTH, D_MODEL)),
        'w_pg': nrm(ks[20], (DEPTH, D_MODEL, D_MODEL), D_MODEL ** -0.5),
        'w_pe': nrm(ks[21], (DEPTH, P_DIM, D_MODEL), P_DIM ** -0.5),
        'norm_pe': gain(ks[22], (DEPTH, D_MODEL)),
        'norm_f': gain(ks[23], (D_MODEL,)),
    }


def reference(x, p, norm_mix, w_in, lb_logits, rec_out_gain, sgu_ln_g, sgu_ln_b, sgu_w, sgu_b,
              w_out, norm_ffn, w_rg, b_rg, w_re, b_re, w_gate, w_up, w_down,
              norm_pg, w_pg, w_pe, norm_pe, norm_f):
    lb_all = jnp.cumsum(jax.nn.softmax(lb_logits.astype(jnp.float32), axis=0), axis=0)
    lb_all = lb_all - lb_all[0]
    splits = [D_REC, 2 * D_REC, 3 * D_REC, 4 * D_REC, 4 * D_REC + D_SGU]
    h = x
    for l in range(DEPTH):
        hn = rmsnorm(h, norm_mix[l])
        q, fz, i, g, u, v = jnp.split(hn @ w_in[l], splits, axis=-1)
        o_rec = hgrn2(q, fz, i, g, lb_all[l], rec_out_gain[l])
        o_sgu = chunk_sgu(u, v, sgu_ln_g[l], sgu_ln_b[l], sgu_w[l], sgu_b[l])
        h = h + jnp.concatenate([o_rec, o_sgu], axis=-1) @ w_out[l]
        h = h + hier_moe(rmsnorm(h, norm_ffn[l]), w_rg[l], b_rg[l], w_re[l], b_re[l],
                         w_gate[l], w_up[l], w_down[l])
        gate = jax.nn.sigmoid((rmsnorm(h, norm_pg[l]) @ w_pg[l]).astype(jnp.float32))
        e = rmsnorm(p[l] @ w_pe[l], norm_pe[l]).astype(jnp.float32)
        h = h + (gate * e).astype(h.dtype)
    return rmsnorm(h, norm_f)
```

```cpp
#include <hip/hip_runtime.h>
#include <hip/hip_cooperative_groups.h>
#include <cstdio>
#include <cstdint>

#define GAS __attribute__((address_space(1)))
#define LAS __attribute__((address_space(3)))
typedef unsigned short bf16;
typedef float f32x4 __attribute__((ext_vector_type(4)));
typedef float f32x2 __attribute__((ext_vector_type(2)));
typedef unsigned u32x4 __attribute__((ext_vector_type(4)));
typedef unsigned u32x2 __attribute__((ext_vector_type(2)));
typedef short bf16x8 __attribute__((ext_vector_type(8)));

constexpr int T = 16384, D = 1024, DEPTH = 4, DIN = 3072, DREC = 512, DSGU = 512;
constexpr int NE = 32, DE = 512, PD = 256;
constexpr int RB = 256;
constexpr int CAP = 2 * T + NE * RB;
constexpr int NRBMAX = CAP / RB;
constexpr float EPS = 1e-6f;
constexpr int NWAVES = 8, NTHR = 512;

constexpr size_t MiB = 1u << 20, KiB = 1u << 10;
constexpr size_t WS_CTL = 0, CTL_BYTES = 1 * MiB;
constexpr size_t WS_MISC = 1 * MiB;
constexpr size_t MS_TOKE = WS_MISC + 0;
constexpr size_t MS_TOKW = WS_MISC + 128 * KiB;
constexpr size_t MS_SINFO = WS_MISC + 256 * KiB;
constexpr size_t MS_SDEST = WS_MISC + 384 * KiB;
constexpr size_t MS_RSTDPE = WS_MISC + 512 * KiB;
constexpr size_t MS_BLKBASE = WS_MISC + 576 * KiB;
constexpr size_t MS_LB = WS_MISC + 608 * KiB;
constexpr size_t MS_BLKE = WS_MISC + 640 * KiB;
constexpr size_t MS_DC = WS_MISC + 1 * MiB;
constexpr size_t MS_WRT = WS_MISC + 2 * MiB;
constexpr size_t MS_SGUW = WS_MISC + 3 * MiB;
constexpr size_t MS_MM = WS_MISC + 4 * MiB;
constexpr size_t MS_PTOT = WS_MISC + 5 * MiB;
constexpr size_t WS_WIN = 16 * MiB;
constexpr size_t WS_WOUT = 40 * MiB;
constexpr size_t WS_WGU = 48 * MiB;
constexpr size_t WS_WD = 304 * MiB;
constexpr size_t WS_WPG = 432 * MiB;
constexpr size_t WS_WPE = 440 * MiB;
constexpr size_t WS_PB = 442 * MiB;
constexpr size_t WS_H = 474 * MiB;
constexpr size_t WS_XN = 538 * MiB;
constexpr size_t WS_O = 570 * MiB;
constexpr size_t WS_PE = 602 * MiB;
constexpr size_t WS_R1 = 730 * MiB;
constexpr size_t WS_Z = WS_R1;
constexpr size_t WS_UT = WS_R1 + 96 * MiB;
constexpr size_t WS_ST = WS_R1 + 128 * MiB;
constexpr size_t WS_ORAW = WS_R1 + 96 * MiB;
constexpr size_t WS_VN = WS_R1 + 128 * MiB;
constexpr size_t WS_XB = WS_R1;
constexpr size_t WS_HB = WS_R1 + 80 * MiB;
constexpr size_t WS_Y = WS_R1 + 120 * MiB;
constexpr size_t WS_LTOT = 930 * MiB;
constexpr size_t WS_END = 934 * MiB;
constexpr int CW_CNT = 64;
constexpr int CW_BGQ = 1024;
constexpr int CW_DONE = 2048;
constexpr int CW_BAR = 4096;

constexpr int RING_BYTES = 131072, MISC_OFF = RING_BYTES, LDS_BYTES = 147456;

#ifndef PROBE_DUP
#define PROBE_DUP 0
#endif
#ifndef MOE_FUSED
#define MOE_FUSED 1
#endif
#ifndef USE_CG_SYNC
#define USE_CG_SYNC 0
#endif
struct Params { const float* in[24]; float* out; unsigned char* ws; int ph_lo, ph_hi, li, pad; };

#define LDS_WAIT() asm volatile("s_waitcnt lgkmcnt(0)" ::: "memory")
template <int M> __device__ __forceinline__ float shx(float v) { static_assert(M >= 1 && M < 32, "swizzle xor mask");
    return __int_as_float(__builtin_amdgcn_ds_swizzle(__float_as_int(v), (M << 10) | 0x1F)); }
__device__ __forceinline__ float halves_sum(float v) {
    return __int_as_float(__builtin_amdgcn_readlane(__float_as_int(v), 0)) + __int_as_float(__builtin_amdgcn_readlane(__float_as_int(v), 32)); }
__device__ __forceinline__ float wave_sum(float v) {
    v += shx<1>(v); v += shx<2>(v); v += shx<4>(v); v += shx<8>(v); v += shx<16>(v);
    return halves_sum(v);
}
typedef __bf16 bf16x2_t __attribute__((ext_vector_type(2)));
__device__ __forceinline__ unsigned pk2(float lo, float hi) { const bf16x2_t v = __builtin_convertvector((f32x2){lo, hi}, bf16x2_t); return __builtin_bit_cast(unsigned, v); }
__device__ __forceinline__ unsigned f2bf(float f) { return pk2(f, f) & 0xffffu; }
__device__ __forceinline__ float bflo(unsigned w) { return __uint_as_float(w << 16); }
__device__ __forceinline__ float bfhi(unsigned w) { return __uint_as_float(w & 0xffff0000u); }
__device__ __forceinline__ float bf2f(bf16 b) { return __uint_as_float(((unsigned)b) << 16); }
__device__ __forceinline__ float fexp(float x) { return __builtin_amdgcn_exp2f(x * 1.4426950408889634f); }
__device__ __forceinline__ float flog(float x) { return __builtin_amdgcn_logf(x) * 0.6931471805599453f; }
__device__ __forceinline__ float frcp(float x) { return __builtin_amdgcn_rcpf(x); }
__device__ __forceinline__ float frsq(float x) { return __builtin_amdgcn_rsqf(x); }
__device__ __forceinline__ float sigmoid_(float x) { return frcp(1.f + fexp(-x)); }
__device__ __forceinline__ float silu_(float x) { return x * sigmoid_(x); }
__device__ __forceinline__ float gelu_(float x) { const float y = 0.7978845608028654f * (x + 0.044715f * x * x * x); const float t = 1.f - 2.f * frcp(fexp(2.f * y) + 1.f); return 0.5f * x * (1.f + t); }

struct Frame {
    LAS unsigned char* lds; unsigned char* ws; const float* const* in; float* out;
    int wave, blk, G;
};
__device__ __forceinline__ int lane_now() { int l; asm volatile("v_mbcnt_lo_u32_b32 %0, -1, 0\n\tv_mbcnt_hi_u32_b32 %0, -1, %0" : "=v"(l)); return l; }
#define PH_TID() int ph_wave = F.wave; asm volatile("" : "+s"(ph_wave)); const int lane = lane_now(); (void)lane; const int tid = (ph_wave << 6) | lane; (void)tid

struct ConvJob { const float* W; const float* g; bf16* WT; int K, N, k0, n0, mode; };
constexpr int TL_IN = 16 * 12, TL_OUT = 16 * 4, TL_G = 32 * 16 * 2, TL_D = 32 * 8 * 4, TL_PG = 16 * 4, TL_PE = 4 * 4;
constexpr int TL_LAYER = TL_IN + TL_OUT + 2 * TL_G + TL_D + TL_PG + TL_PE;
__device__ __forceinline__ ConvJob conv_job(const Frame& F, int it) {
    unsigned char* ws = F.ws; const int l = it / TL_LAYER; int r = it % TL_LAYER; ConvJob j;
    if (r < TL_IN) { j.W = F.in[3] + (size_t)l * D * DIN; j.g = F.in[2] + l * D; j.WT = (bf16*)(ws + WS_WIN) + (size_t)l * DIN * D; j.K = D; j.N = DIN; j.k0 = 64 * (r / 12); j.n0 = 256 * (r % 12); j.mode = 0; return j; } r -= TL_IN;
    if (r < TL_OUT) { j.W = F.in[10] + (size_t)l * D * D; j.g = nullptr; j.WT = (bf16*)(ws + WS_WOUT) + (size_t)l * D * D; j.K = D; j.N = D; j.k0 = 64 * (r / 4); j.n0 = 256 * (r % 4); j.mode = 0; return j; } r -= TL_OUT;
    if (r < 2 * TL_G) { const int up = r >= TL_G; if (up) r -= TL_G; const int e = r / 32, rr = r % 32;
        j.W = F.in[up ? 17 : 16] + (size_t)(l * NE + e) * D * DE; j.g = F.in[11] + l * D; j.WT = (bf16*)(ws + WS_WGU) + (size_t)(l * NE + e) * 1024 * 1024; j.K = D; j.N = DE; j.k0 = 64 * (rr / 2); j.n0 = 256 * (rr % 2); j.mode = 1 + up; return j; } r -= 2 * TL_G;
    if (r < TL_D) { const int e = r / 32, rr = r % 32; j.W = F.in[18] + (size_t)(l * NE + e) * DE * D; j.g = nullptr; j.WT = (bf16*)(ws + WS_WD) + (size_t)(l * NE + e) * D * DE; j.K = DE; j.N = D; j.k0 = 64 * (rr / 4); j.n0 = 256 * (rr % 4); j.mode = 0; return j; } r -= TL_D;
    if (r < TL_PG) { j.W = F.in[20] + (size_t)l * D * D; j.g = F.in[19] + l * D; j.WT = (bf16*)(ws + WS_WPG) + (size_t)l * D * D; j.K = D; j.N = D; j.k0 = 64 * (r / 4); j.n0 = 256 * (r % 4); j.mode = 0; return j; } r -= TL_PG;
    j.W = F.in[21] + (size_t)l * PD * D; j.g = nullptr; j.WT = (bf16*)(ws + WS_WPE) + (size_t)l * D * PD; j.K = PD; j.N = D; j.k0 = 64 * (r / 4); j.n0 = 256 * (r % 4); j.mode = 0; return j;
}
__device__ __forceinline__ void conv_load(const ConvJob& j, int wave, int lane, f32x4 (&v)[8]) {
#pragma unroll
    for (int i = 0; i < 8; ++i) { const int row = 8 * wave + i; v[i] = *(const f32x4*)(j.W + (size_t)(j.k0 + row) * j.N + j.n0 + 4 * lane); if (j.g) v[i] = v[i] * j.g[j.k0 + row]; }
}
constexpr int NDEF = 384, NDEF1 = 128, NBG = 3024;
constexpr int NREST = TL_LAYER - NDEF - NBG, NPRO = TL_LAYER + 3 * NREST;
__device__ __forceinline__ int pro_tile(int f) { if (NREST == 0 || f < TL_LAYER) return f; f -= TL_LAYER; const int l = 1 + f / (NREST ? NREST : 1); return l * TL_LAYER + NDEF + NBG + f % (NREST ? NREST : 1); }
template <class M> __device__ __forceinline__ void conv_run(const Frame& F, int first, int stride, int count, M tile_of) {
    PH_TID();
    LAS float* tile = (LAS float*)F.lds;
    const int wave = ph_wave;
    int f = first; f32x4 v[8]; ConvJob cur{}, nxt{};
    if (f < count) { cur = conv_job(F, tile_of(f)); conv_load(cur, wave, lane, v); }
    while (f < count) {
#pragma unroll
        for (int i = 0; i < 8; ++i) { LAS float* d = tile + (8 * wave + i) * 257 + 4 * lane; d[0] = v[i].x; d[1] = v[i].y; d[2] = v[i].z; d[3] = v[i].w; }
        __syncthreads();
        const int fn = f + stride; if (fn < count) { nxt = conv_job(F, tile_of(fn)); conv_load(nxt, wave, lane, v); }
#pragma unroll
        for (int q = 0; q < 4; ++q) { const int nn = 32 * wave + 8 * q + (lane >> 3), c = lane & 7; const LAS float* sp = tile + (8 * c) * 257 + nn;
            u32x4 o; o.x = pk2(sp[0 * 257], sp[1 * 257]); o.y = pk2(sp[2 * 257], sp[3 * 257]); o.z = pk2(sp[4 * 257], sp[5 * 257]); o.w = pk2(sp[6 * 257], sp[7 * 257]);
            const int n = cur.n0 + nn; const int drow = cur.mode == 0 ? n : ((n >> 7) * 256 + (n & 127) + (cur.mode == 2 ? 128 : 0));
            *(u32x4*)(cur.WT + (size_t)drow * cur.K + cur.k0 + 8 * c) = o; }
        __syncthreads();
        cur = nxt; f = fn;
    }
}
__device__ __forceinline__ void conv_deferred(const Frame& F, int lnext, int r0, int r1, int first, int idle) {
    if (lnext >= DEPTH || F.blk < first) return;
    conv_run(F, F.blk - first, idle, r1 - r0, [=](int f) { return lnext * TL_LAYER + r0 + f; });
}
__device__ __forceinline__ void phase_prologue(const Frame& F) {
    PH_TID();
    unsigned char* ws = F.ws;
    conv_run(F, F.blk, F.G, NPRO, [](int f) { return pro_tile(f); });
    { const f32x4* src = (const f32x4*)F.in[1]; u32x4* dst = (u32x4*)(ws + WS_PB); const size_t n8 = (size_t)DEPTH * T * PD / 8;
      for (size_t i = (size_t)F.blk * NTHR + tid; i < n8; i += (size_t)F.G * NTHR) { const f32x4 a = src[2 * i], b = src[2 * i + 1]; u32x4 o; o.x = pk2(a.x, a.y); o.y = pk2(a.z, a.w); o.z = pk2(b.x, b.y); o.w = pk2(b.z, b.w); dst[i] = o; } }
    { float* wrt = (float*)(ws + MS_WRT);
      for (int i = F.blk * NTHR + tid; i < DEPTH * 36 * D; i += F.G * NTHR) { const int k = i % D, n = (i / D) % 36, l = i / (36 * D);
          const float w = n < 4 ? F.in[12][((size_t)l * D + k) * 4 + n] : F.in[14][((size_t)l * D + k) * NE + (n - 4)]; wrt[i] = w * F.in[11][l * D + k]; } }
    { bf16* wb = (bf16*)(ws + MS_SGUW); for (int i = F.blk * NTHR + tid; i < DEPTH * 4 * 128 * 128; i += F.G * NTHR) { const int tc = (i >> 7) & 127, sp = i & 127; wb[i] = sp <= tc ? (bf16)f2bf(F.in[8][i]) : (bf16)0; } }
    if (F.blk == 0 && tid < DREC) { const int c = tid; float v[DEPTH], m = -1e30f;
#pragma unroll
        for (int l = 0; l < DEPTH; ++l) { v[l] = F.in[4][l * DREC + c]; m = fmaxf(m, v[l]); }
        float s = 0.f;
#pragma unroll
        for (int l = 0; l < DEPTH; ++l) { v[l] = fexp(v[l] - m); s += v[l]; }
        float* lb = (float*)(ws + MS_LB); float acc = 0.f;
#pragma unroll
        for (int l = 0; l < DEPTH; ++l) { if (l > 0) acc += v[l] / s; lb[l * DREC + c] = acc; } }
}

__device__ __forceinline__ void load_row(const float* row, int lane, f32x4 (&v)[4]) { const f32x4* r = (const f32x4*)row + lane;
#pragma unroll
    for (int j = 0; j < 4; ++j) v[j] = r[64 * j]; }
__device__ __forceinline__ void load_row_bf(const bf16* row, int lane, f32x4 (&v)[4]) { const u32x2* r = (const u32x2*)row + lane;
#pragma unroll
    for (int j = 0; j < 4; ++j) { const u32x2 x = r[64 * j]; v[j] = (f32x4){bflo(x.x), bfhi(x.x), bflo(x.y), bfhi(x.y)}; } }
__device__ __forceinline__ float row_sumsq(const f32x4 (&v)[4]) { float s = 0.f;
#pragma unroll
    for (int j = 0; j < 4; ++j) s += (v[j].x * v[j].x + v[j].y * v[j].y) + (v[j].z * v[j].z + v[j].w * v[j].w);
    return wave_sum(s); }
__device__ __forceinline__ void store_row_bf16(bf16* orow, int lane, const f32x4 (&v)[4], float s) { u32x2* o = (u32x2*)orow + lane;
#pragma unroll
    for (int j = 0; j < 4; ++j) { u32x2 w; w.x = pk2(v[j].x * s, v[j].y * s); w.y = pk2(v[j].z * s, v[j].w * s); o[64 * j] = w; } }

__device__ __forceinline__ void phase_norm1(const Frame& F, int l) {
    PH_TID();
    bf16* XN = (bf16*)(F.ws + WS_XN); bf16* h = (bf16*)(F.ws + WS_H); const float* x = F.in[0];
    const int gw = F.blk * NWAVES + ph_wave, NGW = F.G * NWAVES;
    for (int t = gw; t < T; t += NGW) { f32x4 v[4];
        if (l == 0) { load_row(x + (size_t)t * D, lane, v); store_row_bf16(h + (size_t)t * D, lane, v, 1.f); } else load_row_bf(h + (size_t)t * D, lane, v);
        const float rstd = frsq(row_sumsq(v) * (1.f / D) + EPS); store_row_bf16(XN + (size_t)t * D, lane, v, rstd); }
}
__device__ __forceinline__ float bfly8(const float (&r)[8], int lane) {
    const bool b2 = lane & 4, b1 = lane & 2, b0 = lane & 1; float a[4], c[2];
#pragma unroll
    for (int i = 0; i < 4; ++i) { const float keep = b2 ? r[i + 4] : r[i], send = b2 ? r[i] : r[i + 4]; a[i] = keep + shx<4>(send); }
#pragma unroll
    for (int i = 0; i < 2; ++i) { const float keep = b1 ? a[i + 2] : a[i], send = b1 ? a[i] : a[i + 2]; c[i] = keep + shx<2>(send); }
    const float keep = b0 ? c[1] : c[0], send = b0 ? c[0] : c[1]; float d = keep + shx<1>(send);
    d += shx<8>(d); d += shx<16>(d);
    return d + __int_as_float(__builtin_amdgcn_ds_bpermute((lane ^ 32) << 2, __float_as_int(d)));
}
__device__ __forceinline__ void phase_norm2(const Frame& F, int l) {
    PH_TID();
    unsigned char* ws = F.ws;
    unsigned* hist = (unsigned*)(F.lds + MISC_OFF + 256);
    if (tid < 32) hist[tid] = 0u;
    __syncthreads();
    const bf16* h = (const bf16*)(ws + WS_H); bf16* XN = (bf16*)(ws + WS_XN);
    const float* WrT = (const float*)(ws + MS_WRT) + (size_t)l * 36 * D;
    const float* b_rg = F.in[13] + l * 4; const float* b_re = F.in[15] + l * NE;
    int* tok_e = (int*)(ws + MS_TOKE); float* tok_w = (float*)(ws + MS_TOKW); unsigned* sinfo = (unsigned*)(ws + MS_SINFO);
    const int RPB = T / F.G, RPW = RPB / NWAVES;
    for (int i0 = 0; i0 < RPW; i0 += 8) {
        const int t0 = F.blk * RPB + ph_wave * RPW + i0;
        f32x4 v[8][4]; float ss[8];
#pragma unroll
        for (int r = 0; r < 8; ++r) { load_row_bf(h + (size_t)(t0 + r) * D, lane, v[r]); float q = 0.f;
#pragma unroll
            for (int j = 0; j < 4; ++j) q += (v[r][j].x * v[r][j].x + v[r][j].y * v[r][j].y) + (v[r][j].z * v[r][j].z + v[r][j].w * v[r][j].w);
            ss[r] = q; }
        const float rstd_mine = frsq(bfly8(ss, lane) * (1.f / D) + EPS);
#pragma unroll
        for (int r = 0; r < 8; ++r) { const float rs = __int_as_float(__builtin_amdgcn_readlane(__float_as_int(rstd_mine), r)); store_row_bf16(XN + (size_t)(t0 + r) * D, lane, v[r], rs); }
        LAS float* lgw = (LAS float*)(F.lds + 4096) + ph_wave * (36 * 8);
#pragma unroll 2
        for (int n = 0; n < 36; ++n) { const f32x4* wr = (const f32x4*)(WrT + (size_t)n * D) + lane; const f32x4 w0 = wr[0], w1 = wr[64], w2 = wr[128], w3 = wr[192]; float pr[8];
#pragma unroll
            for (int r = 0; r < 8; ++r) pr[r] = ((v[r][0].x * w0.x + v[r][0].y * w0.y) + (v[r][0].z * w0.z + v[r][0].w * w0.w)) + ((v[r][1].x * w1.x + v[r][1].y * w1.y) + (v[r][1].z * w1.z + v[r][1].w * w1.w))
                                                 + ((v[r][2].x * w2.x + v[r][2].y * w2.y) + (v[r][2].z * w2.z + v[r][2].w * w2.w)) + ((v[r][3].x * w3.x + v[r][3].y * w3.y) + (v[r][3].z * w3.z + v[r][3].w * w3.w));
            const float val = bfly8(pr, lane) * rstd_mine; if (lane < 8) lgw[n * 8 + lane] = val; }
        const int row = lane & 7;
        float lg4[4], lgb[4];
#pragma unroll
        for (int j = 0; j < 4; ++j) { lg4[j] = lgw[j * 8 + row]; lgb[j] = lg4[j] + b_rg[j]; }
        int gs = 0; float gm = lgb[0];
#pragma unroll
        for (int j = 1; j < 4; ++j) if (lgb[j] > gm) { gm = lgb[j]; gs = j; }
        float mx = fmaxf(fmaxf(lg4[0], lg4[1]), fmaxf(lg4[2], lg4[3])), se = 0.f, lsel = lg4[0];
#pragma unroll
        for (int j = 0; j < 4; ++j) { se += fexp(lg4[j] - mx); if (j == gs) lsel = lg4[j]; }
        const float g_w = fexp(lsel - mx) * frcp(se);
        float le[8], leb[8];
#pragma unroll
        for (int j = 0; j < 8; ++j) { le[j] = lgw[(4 + gs * 8 + j) * 8 + row]; leb[j] = le[j] + b_re[gs * 8 + j]; }
        int s0 = 0; float m0 = leb[0];
#pragma unroll
        for (int j = 1; j < 8; ++j) if (leb[j] > m0) { m0 = leb[j]; s0 = j; }
        int s1 = -1; float m1 = -3.0e38f;
#pragma unroll
        for (int j = 0; j < 8; ++j) if (j != s0 && leb[j] > m1) { m1 = leb[j]; s1 = j; }
        if (s1 < 0) s1 = (s0 == 0) ? 1 : 0;
        float la = le[0], lb2 = le[0];
#pragma unroll
        for (int j = 1; j < 8; ++j) { if (j == s0) la = le[j]; if (j == s1) lb2 = le[j]; }
        const float wa = frcp(1.f + fexp(lb2 - la)), wb = 1.f - wa;
        if (lane < 8) { const int t = t0 + lane;
            const int e0 = gs * 8 + s0, e1 = gs * 8 + s1;
            const unsigned r0 = atomicAdd(&hist[e0], 1u), r1 = atomicAdd(&hist[e1], 1u);
            tok_e[2 * t] = e0; tok_e[2 * t + 1] = e1; tok_w[2 * t] = g_w * wa; tok_w[2 * t + 1] = g_w * wb;
            sinfo[2 * t] = ((unsigned)F.blk << 16) | r0; sinfo[2 * t + 1] = ((unsigned)F.blk << 16) | r1;
        }
    }
    __syncthreads();
    if (tid < 32) { unsigned* cnt = (unsigned*)(ws + WS_CTL) + CW_CNT + l * 32;
        const unsigned base = __hip_atomic_fetch_add(cnt + tid, hist[tid], __ATOMIC_RELAXED, __HIP_MEMORY_SCOPE_AGENT);
        ((unsigned*)(ws + MS_BLKBASE))[F.blk * 32 + tid] = base; }
}
__device__ __forceinline__ void phase_gather(const Frame& F, int l) {
    PH_TID();
    unsigned char* ws = F.ws;
    int* ps = (int*)(F.lds + MISC_OFF + 512);
    if (tid == 0) { unsigned* cnt = (unsigned*)(ws + WS_CTL) + CW_CNT + l * 32; int* blke = (int*)(ws + MS_BLKE) + l * 256; int acc = 0;
        for (int e = 0; e < NE; ++e) { const int c = (int)__hip_atomic_load(cnt + e, __ATOMIC_RELAXED, __HIP_MEMORY_SCOPE_AGENT); ps[e] = acc; const int pad = (c + RB - 1) / RB * RB;
            if (F.blk == 0) for (int rb = acc / RB; rb < (acc + pad) / RB; ++rb) blke[rb] = e;
            acc += pad; }
        if (F.blk == 0) blke[255] = acc / RB; }
    __syncthreads();
    const int* tok_e = (const int*)(ws + MS_TOKE); const unsigned* sinfo = (const unsigned*)(ws + MS_SINFO); const unsigned* bbase = (const unsigned*)(ws + MS_BLKBASE);
    int* sdest = (int*)(ws + MS_SDEST); const bf16* XN = (const bf16*)(ws + WS_XN); bf16* XB = (bf16*)(ws + WS_XB);
    const int gw = F.blk * NWAVES + ph_wave, NGW = F.G * NWAVES;
    for (int t = gw; t < T; t += NGW) {
        const u32x4* src = (const u32x4*)(XN + (size_t)t * D) + lane; const u32x4 a = src[0], b = src[64];
#pragma unroll
        for (int j = 0; j < 2; ++j) { const int e = tok_e[2 * t + j]; const unsigned info = sinfo[2 * t + j];
            const int dest = ps[e] + (int)bbase[(info >> 16) * 32 + e] + (int)(info & 0xffffu);
            if (lane == 0) sdest[2 * t + j] = dest;
            u32x4* dst = (u32x4*)(XB + (size_t)dest * D) + lane; dst[0] = a; dst[64] = b; }
    }
}
__device__ __forceinline__ void phase_combine(const Frame& F, int l) {
    PH_TID();
    unsigned char* ws = F.ws;
    bf16* h = (bf16*)(ws + WS_H); bf16* XN = (bf16*)(ws + WS_XN); const bf16* Y = (const bf16*)(ws + WS_Y); const bf16* PE = (const bf16*)(ws + WS_PE) + (size_t)l * T * D;
    const int* sdest = (const int*)(ws + MS_SDEST); const float* tok_w = (const float*)(ws + MS_TOKW); float* rstd_pe = (float*)(ws + MS_RSTDPE);
    const int gw = F.blk * NWAVES + ph_wave, NGW = F.G * NWAVES;
    for (int t = gw; t < T; t += NGW) {
        const int d0 = sdest[2 * t], d1 = sdest[2 * t + 1]; const float w0 = tok_w[2 * t], w1 = tok_w[2 * t + 1];
        f32x4 v[4]; load_row_bf(h + (size_t)t * D, lane, v);
        const u32x2* y0 = (const u32x2*)(Y + (size_t)d0 * D) + lane; const u32x2* y1 = (const u32x2*)(Y + (size_t)d1 * D) + lane; const u32x2* pe = (const u32x2*)(PE + (size_t)t * D) + lane;
        float sp = 0.f;
#pragma unroll
        for (int j = 0; j < 4; ++j) { const u32x2 a = y0[64 * j], b = y1[64 * j], c = pe[64 * j];
            v[j].x += w0 * bflo(a.x) + w1 * bflo(b.x); v[j].y += w0 * bfhi(a.x) + w1 * bfhi(b.x); v[j].z += w0 * bflo(a.y) + w1 * bflo(b.y); v[j].w += w0 * bfhi(a.y) + w1 * bfhi(b.y);
            const float p0 = bflo(c.x), p1 = bfhi(c.x), p2 = bflo(c.y), p3 = bfhi(c.y); sp += (p0 * p0 + p1 * p1) + (p2 * p2 + p3 * p3); }
        store_row_bf16(h + (size_t)t * D, lane, v, 1.f);
        const float rstd = frsq(row_sumsq(v) * (1.f / D) + EPS); store_row_bf16(XN + (size_t)t * D, lane, v, rstd);
        sp = wave_sum(sp); if (lane == 0) rstd_pe[t] = frsq(sp * (1.f / D) + EPS);
    }
}
__device__ __forceinline__ void phase_final(const Frame& F) {
    PH_TID();
    const bf16* h = (const bf16*)(F.ws + WS_H); const float* nf = F.in[23];
    const int gw = F.blk * NWAVES + ph_wave, NGW = F.G * NWAVES;
    for (int t = gw; t < T; t += NGW) { f32x4 v[4]; load_row_bf(h + (size_t)t * D, lane, v); const float rstd = frsq(row_sumsq(v) * (1.f / D) + EPS);
        f32x4* o = (f32x4*)(F.out + (size_t)t * D) + lane; const f32x4* g = (const f32x4*)nf + lane;
#pragma unroll
        for (int j = 0; j < 4; ++j) o[64 * j] = v[j] * rstd * g[64 * j]; }
}


namespace pg8 {
constexpr int BM = 256, BK = 64, HALF = 128, HTB = HALF * BK * 2, STAGE_BYTES = 8 * HTB, NXCD = 8, WGM = 8;
__host__ __device__ __forceinline__ int lds_byte(int r, int c) { const int st = (r >> 4) * 2 + (c >> 5), rr = r & 15, cc = c & 31, ob = rr * 64 + cc * 2; return st * 1024 + (ob ^ (((ob >> 9) & 1) << 5)); }
__host__ __device__ __forceinline__ void stage_rc(int b, int& R, int& C) { const int st = b / 1024, sb = b % 1024, swz = sb ^ (((sb >> 9) & 1) << 5); R = (st >> 1) * 16 + swz / 64; C = (st & 1) * 32 + (swz % 64) / 2; }
__host__ __device__ __forceinline__ int perm32(int rho) { const int n = rho >> 4, i = rho & 15; return 8 * (i >> 2) + 4 * n + (i & 3); }
struct Unit { int pm, pn; const char* A; const char* B; };
__device__ __forceinline__ void static_map(int wgid, int nM, int nN, int& pm, int& pn) {
    const int nwg = nM * nN; { const int q = nwg / NXCD, r = nwg % NXCD, xcd = wgid % NXCD, off = wgid / NXCD; wgid = (xcd < r ? xcd * (q + 1) : r * (q + 1) + (xcd - r) * q) + off; }
    const int nig = WGM * nN, gid = wgid / nig, fm = gid * WGM, gsz = (nM - fm) < WGM ? (nM - fm) : WGM;
    pm = fm + ((wgid % nig) % gsz); pn = (wgid % nig) / gsz;
}
struct DenseOrder { static constexpr bool DEPS = false;
    const char* A; const char* Bt; int nM, nN, nL, G, c; size_t tstep;
    __device__ void init(const void* A_, const void* Bt_, int M, int N, int K, int nL_, int G_, int c_) { A = (const char*)A_; Bt = (const char*)Bt_; nM = M / BM; nN = N / BM; nL = nL_; G = G_; c = c_; tstep = (size_t)BM * K * 2; }
    __device__ bool next(int i, Unit& u) const { const long L = (long)i * G + c; const int per = nM * nN; if (L >= (long)per * nL) return false;
        const int l = (int)(L / per); int pm, pn; static_map((int)(L % per), nM, nN, pm, pn); u.pm = l * nM + pm; u.pn = pn; u.A = A + (size_t)u.pm * tstep; u.B = Bt + (size_t)(l * nN + pn) * tstep; return true; }
};
struct MoeOrder { static constexpr bool DEPS = false;
    const char* A; const char* W; const int* blke; int nrb, nN, G, c; size_t a_tstep, w_estride, b_tstep;
    __device__ void init(const void* A_, const void* W_, const int* blke_, int K, int nN_, size_t w_estride_bytes, int G_, int c_) { A = (const char*)A_; W = (const char*)W_; blke = blke_; nrb = __builtin_amdgcn_readfirstlane(blke_[255]); nN = nN_; G = G_; c = c_;
        a_tstep = (size_t)BM * K * 2; b_tstep = a_tstep; w_estride = w_estride_bytes; }
    __device__ bool next(int i, Unit& u) const { const long L = (long)i * G + c; if (L >= (long)nrb * nN) return false; const int rb = (int)(L / nN), pn = (int)(L % nN);
        u.pm = rb; u.pn = pn; u.A = A + (size_t)rb * a_tstep; u.B = W + (size_t)__builtin_amdgcn_readfirstlane(blke[rb]) * w_estride + (size_t)pn * b_tstep; return true; }
};
__device__ __forceinline__ unsigned ag_ld(const unsigned* p)        { return __hip_atomic_load(p, __ATOMIC_RELAXED, __HIP_MEMORY_SCOPE_AGENT); }
__device__ __forceinline__ unsigned ag_add(unsigned* p, unsigned v) { return __hip_atomic_fetch_add(p, v, __ATOMIC_RELAXED, __HIP_MEMORY_SCOPE_AGENT); }
struct MoeDepOrder { static constexpr bool DEPS = true;
    const char* A; const char* W; const int* blke; const unsigned* done; int nrb, nN, G, c; size_t a_tstep, w_estride, b_tstep;
    __device__ void init(const void* A_, const void* W_, const int* blke_, const unsigned* done_, int K, int nN_, size_t w_estride_bytes, int G_, int c_) { A = (const char*)A_; W = (const char*)W_; blke = blke_; done = done_;
        nrb = __builtin_amdgcn_readfirstlane(blke_[255]); nN = nN_; G = G_; c = c_; a_tstep = (size_t)BM * K * 2; b_tstep = a_tstep; w_estride = w_estride_bytes; }
    __device__ bool next(int i, Unit& u) const { const long L = (long)i * G + c; if (L >= (long)nrb * nN) return false; const int rb = (int)(L / nN), pn = (int)(L % nN);
        u.pm = rb; u.pn = pn; u.A = A + (size_t)rb * a_tstep; u.B = W + (size_t)__builtin_amdgcn_readfirstlane(blke[rb]) * w_estride + (size_t)pn * b_tstep; return true; }
    __device__ void wait(const Unit& u, int wid) const {
        if (wid == 0 && lane_now() == 0) { while (ag_ld(done + u.pm) < 4u) __builtin_amdgcn_s_sleep(1); __builtin_amdgcn_fence(__ATOMIC_ACQUIRE, "agent"); } }
};
struct RangeOrder { static constexpr bool DEPS = false;
    const char* A; const char* Bt; int nM, nN, j0, n; size_t tstep;
    __device__ void init(const void* A_, const void* Bt_, int M, int N, int K, int j0_, int n_) { A = (const char*)A_; Bt = (const char*)Bt_; nM = M / BM; nN = N / BM; j0 = j0_; n = n_; tstep = (size_t)BM * K * 2; }
    __device__ bool next(int i, Unit& u) const { if (i >= n) return false; int pm, pn; static_map(j0 + i, nM, nN, pm, pn); u.pm = pm; u.pn = pn; u.A = A + (size_t)pm * tstep; u.B = Bt + (size_t)pn * tstep; return true; }
};
__device__ __forceinline__ unsigned cvt_pk_bf16(float lo, float hi) { return pk2(lo, hi); }
struct EpiBf16 { static constexpr bool PERM = true, ACC_INIT = false, SIGNAL = false; bf16* O; int ldc;
    __device__ __forceinline__ void operator()(const f32x4 (&acc)[2][2][4][2], const Unit& u, int wr, int wc, int, int) const {
        const int t2 = lane_now(), fr = t2 & 15, fq = t2 >> 4;
        const int row0 = u.pm * BM + wr * 64 + fr, col0 = u.pn * BM + wc * 32 + 8 * fq;
#pragma unroll
        for (int ai = 0; ai < 2; ++ai)
#pragma unroll
            for (int m = 0; m < 4; ++m) { bf16* rowp = O + (size_t)(row0 + ai * HALF + m * 16) * ldc + col0;
#pragma unroll
                for (int bj = 0; bj < 2; ++bj) { const f32x4 v0 = acc[ai][bj][m][0], v1 = acc[ai][bj][m][1];
                    u32x4 w; w.x = cvt_pk_bf16(v0[0], v0[1]); w.y = cvt_pk_bf16(v0[2], v0[3]); w.z = cvt_pk_bf16(v1[0], v1[1]); w.w = cvt_pk_bf16(v1[2], v1[3]);
                    *(u32x4*)(rowp + bj * HALF) = w; } }
    } };
struct EpiResid { static constexpr bool PERM = true, ACC_INIT = true, SIGNAL = false; bf16* h;
    __device__ __forceinline__ void init(f32x4 (&acc)[2][2][4][2], const Unit& u, int wr, int wc, int fr, int fq) const {
        const int row0 = u.pm * BM + wr * 64 + fr, col0 = u.pn * BM + wc * 32 + 8 * fq;
#pragma unroll
        for (int ai = 0; ai < 2; ++ai)
#pragma unroll
            for (int m = 0; m < 4; ++m) { const bf16* rowp = h + (size_t)(row0 + ai * HALF + m * 16) * D + col0;
#pragma unroll
                for (int bj = 0; bj < 2; ++bj) { const u32x4 x = *(const u32x4*)(rowp + bj * HALF);
                    acc[ai][bj][m][0] = (f32x4){bflo(x.x), bfhi(x.x), bflo(x.y), bfhi(x.y)}; acc[ai][bj][m][1] = (f32x4){bflo(x.z), bfhi(x.z), bflo(x.w), bfhi(x.w)}; } }
    }
    __device__ __forceinline__ void operator()(const f32x4 (&acc)[2][2][4][2], const Unit& u, int wr, int wc, int fr, int fq) const {
        asm volatile("" : "+v"(fr), "+v"(fq));
        const int row0 = u.pm * BM + wr * 64 + fr, col0 = u.pn * BM + wc * 32 + 8 * fq;
#pragma unroll
        for (int ai = 0; ai < 2; ++ai)
#pragma unroll
            for (int m = 0; m < 4; ++m) { bf16* rowp = h + (size_t)(row0 + ai * HALF + m * 16) * D + col0;
#pragma unroll
                for (int bj = 0; bj < 2; ++bj) { const f32x4 v0 = acc[ai][bj][m][0], v1 = acc[ai][bj][m][1];
                    u32x4 w; w.x = cvt_pk_bf16(v0[0], v0[1]); w.y = cvt_pk_bf16(v0[2], v0[3]); w.z = cvt_pk_bf16(v1[0], v1[1]); w.w = cvt_pk_bf16(v1[2], v1[3]);
                    *(u32x4*)(rowp + bj * HALF) = w; } }
    } };
struct EpiGateUp { static constexpr bool PERM = true, ACC_INIT = false, SIGNAL = false; bf16* H;
    __device__ __forceinline__ void operator()(const f32x4 (&acc)[2][2][4][2], const Unit& u, int wr, int wc, int, int) const {
        const int t2 = lane_now(), fr = t2 & 15, fq = t2 >> 4;
        const int row0 = u.pm * BM + wr * 64 + fr, col0 = u.pn * HALF + wc * 32 + 8 * fq;
#pragma unroll
        for (int ai = 0; ai < 2; ++ai)
#pragma unroll
            for (int m = 0; m < 4; ++m) { bf16* rowp = H + (size_t)(row0 + ai * HALF + m * 16) * DE + col0; float v[8];
#pragma unroll
                for (int n = 0; n < 2; ++n)
#pragma unroll
                    for (int j = 0; j < 4; ++j) v[4 * n + j] = silu_(acc[ai][0][m][n][j]) * acc[ai][1][m][n][j];
                u32x4 w; w.x = cvt_pk_bf16(v[0], v[1]); w.y = cvt_pk_bf16(v[2], v[3]); w.z = cvt_pk_bf16(v[4], v[5]); w.w = cvt_pk_bf16(v[6], v[7]);
                *(u32x4*)rowp = w; }
    } };
struct EpiGateUpPub { static constexpr bool PERM = true, ACC_INIT = false, SIGNAL = true; __amdgpu_buffer_rsrc_t rs; unsigned* done;
    __device__ __forceinline__ void operator()(const f32x4 (&acc)[2][2][4][2], const Unit& u, int wr, int wc, int fr, int fq) const {
        asm volatile("" : "+v"(fr), "+v"(fq));
        const int row0 = u.pm * BM + wr * 64 + fr, col0 = u.pn * HALF + wc * 32 + 8 * fq;
#pragma unroll
        for (int ai = 0; ai < 2; ++ai)
#pragma unroll
            for (int m = 0; m < 4; ++m) { const unsigned off = (unsigned)(((row0 + ai * HALF + m * 16) * DE + col0) * 2); float v[8];
#pragma unroll
                for (int n = 0; n < 2; ++n)
#pragma unroll
                    for (int j = 0; j < 4; ++j) v[4 * n + j] = silu_(acc[ai][0][m][n][j]) * acc[ai][1][m][n][j];
                u32x4 w; w.x = cvt_pk_bf16(v[0], v[1]); w.y = cvt_pk_bf16(v[2], v[3]); w.z = cvt_pk_bf16(v[4], v[5]); w.w = cvt_pk_bf16(v[6], v[7]);
                __builtin_amdgcn_raw_buffer_store_b128(w, rs, off, 0, 16); }
    }
    __device__ __forceinline__ void signal(const Unit& u) const { (void)ag_add(done + u.pm, 1u); }
};
struct EpiPG { static constexpr bool PERM = true, ACC_INIT = false, SIGNAL = false; bf16* h; const bf16* PE; const float* rstd_pe; const float* norm_pe;
    __device__ __forceinline__ void operator()(const f32x4 (&acc)[2][2][4][2], const Unit& u, int wr, int wc, int fr, int fq) const {
        asm volatile("" : "+v"(fr), "+v"(fq));
        const int row0 = u.pm * BM + wr * 64 + fr, col0 = u.pn * BM + wc * 32 + 8 * fq;
        f32x4 nv[2][2];
#pragma unroll
        for (int bj = 0; bj < 2; ++bj)
#pragma unroll
            for (int n = 0; n < 2; ++n) nv[bj][n] = *(const f32x4*)(norm_pe + col0 + bj * HALF + 4 * n);
#pragma unroll
        for (int ai = 0; ai < 2; ++ai)
#pragma unroll
            for (int m = 0; m < 4; ++m) { const int row = row0 + ai * HALF + m * 16; const float rs = rstd_pe[row];
#pragma unroll
                for (int bj = 0; bj < 2; ++bj) { const size_t o = (size_t)row * D + col0 + bj * HALF; const u32x4 pe = *(const u32x4*)(PE + o); const u32x4 hx = *(const u32x4*)(h + o);
                    f32x4 h0 = (f32x4){bflo(hx.x), bfhi(hx.x), bflo(hx.y), bfhi(hx.y)}, h1 = (f32x4){bflo(hx.z), bfhi(hx.z), bflo(hx.w), bfhi(hx.w)}; const f32x4 a0 = acc[ai][bj][m][0], a1 = acc[ai][bj][m][1];
                    const f32x4 e0 = (f32x4){bflo(pe.x), bfhi(pe.x), bflo(pe.y), bfhi(pe.y)} * rs * nv[bj][0], e1 = (f32x4){bflo(pe.z), bfhi(pe.z), bflo(pe.w), bfhi(pe.w)} * rs * nv[bj][1];
                    h0 += (f32x4){sigmoid_(a0[0]), sigmoid_(a0[1]), sigmoid_(a0[2]), sigmoid_(a0[3])} * e0; h1 += (f32x4){sigmoid_(a1[0]), sigmoid_(a1[1]), sigmoid_(a1[2]), sigmoid_(a1[3])} * e1;
                    u32x4 w; w.x = pk2(h0[0], h0[1]); w.y = pk2(h0[2], h0[3]); w.z = pk2(h1[0], h1[1]); w.w = pk2(h1[2], h1[3]); *(u32x4*)(h + o) = w; } }
    } };

template <class Epi, class Sched>
__device__ __forceinline__ void gemm_phase(int wave, LAS unsigned char* lds, int K, const Sched& S, const Epi& E) {
    int wid = wave; asm volatile("" : "+s"(wid));
    const int lane = lane_now(), tid = (wid << 6) | lane, wr = wid >> 2, wc = wid & 3, fr = lane & 15, fq = lane >> 4;
    const int nt = K / BK;
    unsigned voffA[2], voffB[2];
#pragma unroll
    for (int i = 0; i < 2; ++i) { int R, C; stage_rc(tid * 16 + i * 8192, R, C); const int Rb = Epi::PERM ? ((R & ~31) + perm32(R & 31)) : R;
        voffA[i] = (unsigned)(R * K + C) * 2u; voffB[i] = (unsigned)(Rb * K + C) * 2u; }
    const size_t kstep = (size_t)(BK * 2);
    const size_t hstep = (size_t)HALF * K * 2;
    const unsigned ldsw = (unsigned)wid * 1024u;
    const int aoff = lds_byte(wr * 64 + fr, fq * 8), boff = lds_byte(wc * 32 + fr, fq * 8);
#define PG8_SA(b, h) (((b) * 2 + (h)) * HTB)
#define PG8_SB(b, h) ((4 + (b) * 2 + (h)) * HTB)
#define PG8_STAGE(bufoff, gbase, voff) do { _Pragma("unroll") for (int _i = 0; _i < 2; ++_i) \
        __builtin_amdgcn_global_load_lds((const unsigned*)((const char*)(gbase) + (voff)[_i]), (LAS unsigned*)(lds + (bufoff) + ldsw + _i * 8192), 16, 0, 0); } while (0)
#define PG8_LDA(dst, b, h) do { _Pragma("unroll") for (int m = 0; m < 4; ++m) _Pragma("unroll") for (int k = 0; k < 2; ++k) dst[m][k] = *(const LAS bf16x8*)(lds + PG8_SA(b, h) + aoff + m * 2048 + k * 1024); } while (0)
#define PG8_LDB(dst, b, h) do { _Pragma("unroll") for (int n = 0; n < 2; ++n) _Pragma("unroll") for (int k = 0; k < 2; ++k) dst[n][k] = *(const LAS bf16x8*)(lds + PG8_SB(b, h) + boff + n * 2048 + k * 1024); } while (0)
#define PG8_MMA(ai, bj, At, Bt) do { __builtin_amdgcn_s_setprio(1); _Pragma("unroll") for (int m = 0; m < 4; ++m) _Pragma("unroll") for (int n = 0; n < 2; ++n) _Pragma("unroll") for (int k = 0; k < 2; ++k) \
        acc[ai][bj][m][n] = __builtin_amdgcn_mfma_f32_16x16x32_bf16(Bt[n][k], At[m][k], acc[ai][bj][m][n], 0, 0, 0); __builtin_amdgcn_s_setprio(0); } while (0)
#define PG8_WAIT_V(n) asm volatile("s_waitcnt vmcnt(" #n ")" ::: "memory")
#define PG8_WAIT_L(n) asm volatile("s_waitcnt lgkmcnt(" #n ")" ::: "memory")
#define PG8_BAR __builtin_amdgcn_s_barrier()
#define PG8_SCHED __builtin_amdgcn_sched_barrier(0)
    Unit cur, nxt; int ui = 0;
    if (!S.next(0, cur)) return;
    if constexpr (Sched::DEPS) { S.wait(cur, wid); PG8_BAR; }
    f32x4 acc[2][2][4][2];
    if constexpr (Epi::ACC_INIT) E.init(acc, cur, wr, wc, fr, fq);
    else {
#pragma unroll
    for (int a = 0; a < 2; ++a)
#pragma unroll
        for (int b = 0; b < 2; ++b)
#pragma unroll
            for (int m = 0; m < 4; ++m)
#pragma unroll
                for (int n = 0; n < 2; ++n) acc[a][b][m][n] = (f32x4){0.f, 0.f, 0.f, 0.f}; }
    bf16x8 At[4][2], B0[2][2], B1[2][2];
    const char* cA = cur.A; const char* cB = cur.B;
    PG8_STAGE(PG8_SB(0, 0), cB, voffB); PG8_STAGE(PG8_SB(0, 1), cB + hstep, voffB); PG8_STAGE(PG8_SA(0, 0), cA, voffA); PG8_STAGE(PG8_SA(0, 1), cA + hstep, voffA);
    if (wr == 1) PG8_BAR;
    PG8_WAIT_V(2); PG8_BAR;
    PG8_STAGE(PG8_SB(1, 0), cB + kstep, voffB); PG8_STAGE(PG8_SA(1, 0), cA + kstep, voffA); PG8_STAGE(PG8_SB(1, 1), cB + hstep + kstep, voffB);
    PG8_WAIT_V(6); PG8_BAR;
    for (;;) {
        const bool has_next = S.next(ui + 1, nxt);
        const char* nA = has_next ? nxt.A : cA; const char* nB = has_next ? nxt.B : cB;
        for (int t = 0; t < nt; t += 2) {
            const bool last = (t == nt - 2);
            if constexpr (Sched::DEPS) { if (last && has_next) S.wait(nxt, wid); }
            const char* a1 = cA + (size_t)(t + 1) * kstep;
            const char* a2 = last ? nA : cA + (size_t)(t + 2) * kstep; const char* b2 = last ? nB : cB + (size_t)(t + 2) * kstep;
            const char* a3 = a2 + kstep; const char* b3 = b2 + kstep;
            PG8_LDB(B0, 0, 0); PG8_LDB(B1, 0, 1); PG8_SCHED; PG8_LDA(At, 0, 0); PG8_STAGE(PG8_SA(1, 1), a1 + hstep, voffA);
            PG8_WAIT_V(8); PG8_WAIT_L(0); PG8_BAR; PG8_MMA(0, 0, At, B0); PG8_MMA(0, 1, At, B1); PG8_BAR; PG8_SCHED;
            PG8_LDA(At, 0, 1); PG8_STAGE(PG8_SB(0, 0), b2, voffB); PG8_STAGE(PG8_SB(0, 1), b2 + hstep, voffB); PG8_STAGE(PG8_SA(0, 0), a2, voffA);
            PG8_WAIT_V(8); PG8_WAIT_L(0); PG8_BAR; PG8_MMA(1, 0, At, B0); PG8_MMA(1, 1, At, B1); PG8_BAR; PG8_SCHED;
            PG8_LDB(B0, 1, 0); PG8_LDB(B1, 1, 1); PG8_SCHED; PG8_LDA(At, 1, 0); PG8_STAGE(PG8_SA(0, 1), a2 + hstep, voffA);
            PG8_WAIT_V(8); PG8_WAIT_L(0); PG8_BAR; PG8_MMA(0, 0, At, B0); PG8_MMA(0, 1, At, B1); PG8_BAR; PG8_SCHED;
            PG8_LDA(At, 1, 1); PG8_STAGE(PG8_SB(1, 0), b3, voffB); PG8_STAGE(PG8_SB(1, 1), b3 + hstep, voffB); PG8_STAGE(PG8_SA(1, 0), a3, voffA);
            PG8_WAIT_V(8); PG8_WAIT_L(0); PG8_BAR; PG8_MMA(1, 0, At, B0); PG8_MMA(1, 1, At, B1); PG8_BAR; PG8_SCHED;
        }
        if (wr == 0) PG8_BAR;
        E(acc, cur, wr, wc, fr, fq);
        if constexpr (Epi::SIGNAL) { PG8_WAIT_V(0); PG8_BAR; if (tid == 0) E.signal(cur); }
        if (!has_next) break;
        if constexpr (Epi::ACC_INIT) E.init(acc, nxt, wr, wc, fr, fq);
        else {
#pragma unroll
        for (int a = 0; a < 2; ++a)
#pragma unroll
            for (int b = 0; b < 2; ++b)
#pragma unroll
                for (int m = 0; m < 4; ++m)
#pragma unroll
                    for (int n = 0; n < 2; ++n) acc[a][b][m][n] = (f32x4){0.f, 0.f, 0.f, 0.f}; }
        cur = nxt; cA = nA; cB = nB; ++ui;
        if (wr == 1) PG8_BAR;
    }
    PG8_WAIT_V(0);
    PG8_BAR;
#undef PG8_SA
#undef PG8_SB
#undef PG8_STAGE
#undef PG8_LDA
#undef PG8_LDB
#undef PG8_MMA
#undef PG8_WAIT_V
#undef PG8_WAIT_L
#undef PG8_BAR
#undef PG8_SCHED
}
}

__device__ __forceinline__ void phase_gemm_pe(const Frame& F) {
    pg8::DenseOrder S; S.init(F.ws + WS_PB, F.ws + WS_WPE, T, D, PD, DEPTH, F.G, F.blk); pg8::EpiBf16 E{(bf16*)(F.ws + WS_PE), D};
    pg8::gemm_phase(F.wave, F.lds, PD, S, E);
}
__device__ __forceinline__ void phase_gemm_in(const Frame& F, int l) {
    pg8::DenseOrder S; S.init(F.ws + WS_XN, (bf16*)(F.ws + WS_WIN) + (size_t)l * DIN * D, T, DIN, D, 1, F.G, F.blk); pg8::EpiBf16 E{(bf16*)(F.ws + WS_Z), DIN};
    pg8::gemm_phase(F.wave, F.lds, D, S, E);
}
__device__ __forceinline__ void phase_gemm_out(const Frame& F, int l) {
    pg8::DenseOrder S; S.init(F.ws + WS_O, (bf16*)(F.ws + WS_WOUT) + (size_t)l * D * D, T, D, D, 1, F.G, F.blk); pg8::EpiResid E{(bf16*)(F.ws + WS_H)};
    pg8::gemm_phase(F.wave, F.lds, D, S, E);
}
__device__ __forceinline__ void phase_gemm_moe1(const Frame& F, int l) {
    pg8::MoeOrder S; S.init(F.ws + WS_XB, (bf16*)(F.ws + WS_WGU) + (size_t)l * NE * 1024 * 1024, (const int*)(F.ws + MS_BLKE) + l * 256, D, 4, (size_t)1024 * 1024 * 2, F.G, F.blk); pg8::EpiGateUp E{(bf16*)(F.ws + WS_HB)};
    pg8::gemm_phase(F.wave, F.lds, D, S, E);
    { const int nun = S.nrb * 4, rem = nun % F.G, few = (rem == 0 || F.G - rem < 64), idle = few ? F.G : F.G - rem, first = few ? 0 : rem;
      if (F.blk >= first) { pg8::DenseOrder P; P.init((const bf16*)(F.ws + WS_PB) + (size_t)l * T * PD, (const bf16*)(F.ws + WS_WPE) + (size_t)l * D * PD, T, D, PD, 1, idle, F.blk - first);
          pg8::EpiBf16 EP{(bf16*)(F.ws + WS_PE) + (size_t)l * T * D, D}; pg8::gemm_phase(F.wave, F.lds, PD, P, EP); }
      conv_deferred(F, l + 1, 0, NDEF1, first, idle); }
}
__device__ __forceinline__ void phase_gemm_moe2(const Frame& F, int l) {
    pg8::MoeOrder S; S.init(F.ws + WS_HB, (bf16*)(F.ws + WS_WD) + (size_t)l * NE * D * DE, (const int*)(F.ws + MS_BLKE) + l * 256, DE, 4, (size_t)D * DE * 2, F.G, F.blk); pg8::EpiBf16 E{(bf16*)(F.ws + WS_Y), D};
    pg8::gemm_phase(F.wave, F.lds, DE, S, E);
    { const int nun = S.nrb * 4, rem = nun % F.G, few = (rem == 0 || F.G - rem < 64), idle = few ? F.G : F.G - rem, first = few ? 0 : rem;
      conv_deferred(F, l + 1, NDEF1, NDEF, first, idle); }
}
#ifndef MOE_CPE
#define MOE_CPE 5
#endif
#ifndef MOE_CTL
#define MOE_CTL 2
#endif
template <int MODE = 0> __device__ __forceinline__ void phase_moe_fused(const Frame& F, int l) {
    unsigned char* ws = F.ws; const int G = F.G, blk = F.blk;
    const int* blke = (const int*)(ws + MS_BLKE) + l * 256;
    unsigned* done = (unsigned*)(ws + WS_CTL) + CW_DONE + l * 256;
    const int nrb = __builtin_amdgcn_readfirstlane(blke[255]), nu = 4 * nrb, e1 = nu % G;
    if constexpr (MODE == 1) { pg8::MoeOrder S; S.init(ws + WS_XB, (bf16*)(ws + WS_WGU) + (size_t)l * NE * 1024 * 1024, blke, D, 4, (size_t)1024 * 1024 * 2, G, blk);
      pg8::EpiGateUp E{(bf16*)(ws + WS_HB)}; pg8::gemm_phase(F.wave, F.lds, D, S, E); return; }
    if constexpr (MODE == 0) { pg8::MoeOrder S; S.init(ws + WS_XB, (bf16*)(ws + WS_WGU) + (size_t)l * NE * 1024 * 1024, blke, D, 4, (size_t)1024 * 1024 * 2, G, blk);
      pg8::EpiGateUpPub E{__builtin_amdgcn_make_buffer_rsrc(ws + WS_HB, 0, (int)((size_t)CAP * DE * 2), 0x00020000), done};
      pg8::gemm_phase(F.wave, F.lds, D, S, E); }
    if constexpr (MODE == 2) { pg8::MoeOrder S; S.init(ws + WS_HB, (bf16*)(ws + WS_WD) + (size_t)l * NE * D * DE, blke, DE, 4, (size_t)D * DE * 2, G, blk >= e1 ? blk - e1 : blk - e1 + G);
      pg8::EpiBf16 E{(bf16*)(ws + WS_Y), D}; pg8::gemm_phase(F.wave, F.lds, DE, S, E); }
    if constexpr (MODE == 0) { pg8::MoeDepOrder S; S.init(ws + WS_HB, (bf16*)(ws + WS_WD) + (size_t)l * NE * D * DE, blke, done, DE, 4, (size_t)D * DE * 2, G, blk >= e1 ? blk - e1 : blk - e1 + G);
      pg8::EpiBf16 E{(bf16*)(ws + WS_Y), D};
      pg8::gemm_phase(F.wave, F.lds, DE, S, E); }
    { const int nt = (l + 1 < DEPTH) ? NDEF : 0, ftot = 256 * MOE_CPE + nt * MOE_CTL;
      const int wrap = 2 * e1 > G ? 2 * e1 - G : 0;
      auto cls = [&](int x, int& c24, int& c16, int& c8, int& c0) {
          const int cA = x < e1 ? x : e1, cAB = x < wrap ? x : wrap;
          int cB = x - e1; cB = cB < 0 ? 0 : cB; if (!wrap) cB = cB > e1 ? e1 : cB; cB += cAB;
          c24 = cAB; c16 = cA - cAB; c8 = cB - cAB; c0 = x - c24 - c16 - c8; };
      auto fill = [&](int x, int lv) { int c24, c16, c8, c0; cls(x, c24, c16, c8, c0);
          return c0 * lv + c8 * (lv > 8 ? lv - 8 : 0) + c16 * (lv > 16 ? lv - 16 : 0) + c24 * (lv > 24 ? lv - 24 : 0); };
      int lv = 1; while (fill(G, lv) < ftot) ++lv;
      const int B0 = fill(blk, lv), B1 = fill(blk + 1, lv);
      const int pe_tot = 256 * MOE_CPE;
      int j0 = (B0 + MOE_CPE - 1) / MOE_CPE, j1 = (B1 + MOE_CPE - 1) / MOE_CPE; j0 = j0 < 256 ? j0 : 256; j1 = j1 < 256 ? j1 : 256;
      int t0 = B0 > pe_tot ? (B0 - pe_tot + MOE_CTL - 1) / MOE_CTL : 0, t1 = B1 > pe_tot ? (B1 - pe_tot + MOE_CTL - 1) / MOE_CTL : 0; t0 = t0 < nt ? t0 : nt; t1 = t1 < nt ? t1 : nt;
      if (j1 > j0) { pg8::RangeOrder P; P.init((const bf16*)(ws + WS_PB) + (size_t)l * T * PD, (const bf16*)(ws + WS_WPE) + (size_t)l * D * PD, T, D, PD, j0, j1 - j0);
          pg8::EpiBf16 EP{(bf16*)(ws + WS_PE) + (size_t)l * T * D, D}; pg8::gemm_phase(F.wave, F.lds, PD, P, EP); }
      if (t1 > t0) { const int base = (l + 1) * TL_LAYER + t0; conv_run(F, 0, 1, t1 - t0, [=](int f) { return base + f; }); } }
}
__device__ __forceinline__ void phase_gemm_pg(const Frame& F, int l) {
    pg8::DenseOrder S; S.init(F.ws + WS_XN, (bf16*)(F.ws + WS_WPG) + (size_t)l * D * D, T, D, D, 1, F.G, F.blk);
    pg8::EpiPG E{(bf16*)(F.ws + WS_H), (const bf16*)(F.ws + WS_PE) + (size_t)l * T * D, (const float*)(F.ws + MS_RSTDPE), F.in[22] + l * D};
    pg8::gemm_phase(F.wave, F.lds, D, S, E);
}

typedef short s16x4 __attribute__((ext_vector_type(4)));
__device__ __forceinline__ bf16x8 tr_frag(LAS unsigned char* p_lo, LAS unsigned char* p_hi) {
    const s16x4 lo = __builtin_amdgcn_ds_read_tr16_b64_v4i16((LAS s16x4*)p_lo), hi = __builtin_amdgcn_ds_read_tr16_b64_v4i16((LAS s16x4*)p_hi);
    return __builtin_shufflevector(lo, hi, 0, 1, 2, 3, 4, 5, 6, 7); }
#define MFMA16(a, b, c) __builtin_amdgcn_mfma_f32_16x16x32_bf16((a), (b), (c), 0, 0, 0)
constexpr int RP = 272;
constexpr int VP = 1040;

__device__ __forceinline__ void phase_rec_c1(const Frame& F, int l) {
    PH_TID();
    unsigned char* ws = F.ws; const bf16* Z = (const bf16*)(ws + WS_Z);
    bf16* UT = (bf16*)(ws + WS_UT); float* DC = (float*)(ws + MS_DC); float* MM = (float*)(ws + MS_MM);
    const float* lb = (const float*)(ws + MS_LB) + l * DREC;
    LAS unsigned char* KD = F.lds; LAS unsigned char* IM = F.lds + 128 * RP; LAS float* totx = (LAS float*)(F.lds + 256 * RP);
    const int wave = ph_wave, ch = tid & 255, half = tid >> 8, hl = ch >> 7, k = ch & 127, g = lane >> 4, li = lane & 15, q = li >> 2, p = li & 3;
    const int hG = F.G / 2, nmine = (F.G == 256) ? (F.blk < hG ? 3 : 1) : 0;
    for (int ui = 0; (F.G == 256) ? (ui < nmine) : (F.blk + ui * F.G < 512); ++ui) {
        const int unit = (F.G == 256) ? (F.blk < hG ? F.blk + ui * hG : 3 * hG + (F.blk - hG)) : F.blk + ui * F.G;
        const int c = unit >> 1, hp = unit & 1, hh = 2 * hp + hl;
        const bf16* zb = Z + (size_t)(c * 64 + 32 * half) * DIN + 512 + hh * 128 + k;
        const float lbk = lb[hh * 128 + k];
        float cs[32], kk[32]; float run = 1.f;
#pragma unroll
        for (int t = 0; t < 32; ++t) { const float fz = bf2f(zb[(size_t)t * DIN]); const float sg = sigmoid_(fz); run *= lbk + (1.f - lbk) * sg; cs[t] = run; kk[t] = (1.f - lbk) * (1.f - sg); }
        totx[half * 256 + ch] = run;
#pragma unroll
        for (int j = 0; j < 4; ++j) { const int idx = tid + 512 * j, hl2 = idx >> 10, row = (idx >> 4) & 63, cc = idx & 15;
            const u32x4 v = *(const u32x4*)(Z + (size_t)(c * 64 + row) * DIN + 1024 + (2 * hp + hl2) * 128 + cc * 8);
            *(LAS u32x4*)(IM + (hl2 * 64 + row) * RP + cc * 16) = v; }
        __syncthreads();
        const float other = totx[(1 - half) * 256 + ch]; const float p63 = run * other; const float base_p = half == 0 ? p63 : run;
#pragma unroll
        for (int t = 0; t < 32; ++t) *(LAS bf16*)(KD + (hl * 64 + 32 * half + t) * RP + 2 * k) = (bf16)f2bf(kk[t] * base_p * frcp(fmaxf(cs[t], 1e-30f)));
        if (half == 0) { DC[(c * 4 + hh) * 128 + k] = p63; MM[(c * 4 + hh) * 128 + k] = run; }
        __syncthreads();
        { const int whl = wave >> 2, kt0 = 2 * (wave & 3), whh = 2 * hp + whl;
          f32x4 acc[2][8];
#pragma unroll
          for (int i = 0; i < 2; ++i)
#pragma unroll
              for (int vt = 0; vt < 8; ++vt) acc[i][vt] = (f32x4){0.f, 0.f, 0.f, 0.f};
          LAS unsigned char* kdb = KD + whl * 64 * RP; LAS unsigned char* imb = IM + whl * 64 * RP;
#pragma unroll
          for (int a = 0; a < 2; ++a) { const unsigned ro = (unsigned)((32 * a + 8 * g + q) * RP);
              bf16x8 Af[2];
#pragma unroll
              for (int i = 0; i < 2; ++i) { const unsigned co = (unsigned)((16 * (kt0 + i) + 4 * p) * 2); Af[i] = tr_frag(kdb + ro + co, kdb + ro + 4 * RP + co); }
#pragma unroll
              for (int vt = 0; vt < 8; ++vt) { const unsigned co = (unsigned)((16 * vt + 4 * p) * 2); const bf16x8 Bf = tr_frag(imb + ro + co, imb + ro + 4 * RP + co);
#pragma unroll
                  for (int i = 0; i < 2; ++i) acc[i][vt] = MFMA16(Af[i], Bf, acc[i][vt]); } }
#pragma unroll
          for (int i = 0; i < 2; ++i)
#pragma unroll
              for (int vt = 0; vt < 8; ++vt) { u32x2 w; w.x = pg8::cvt_pk_bf16(acc[i][vt][0], acc[i][vt][1]); w.y = pg8::cvt_pk_bf16(acc[i][vt][2], acc[i][vt][3]);
                  *(u32x2*)(UT + ((size_t)(c * 4 + whh) * 128 + 16 * vt + li) * 128 + 16 * (kt0 + i) + 4 * g) = w; } }
        __syncthreads();
    }
}
__device__ __forceinline__ void phase_rec_c2a(const Frame& F) {
    PH_TID();
    unsigned char* ws = F.ws; const unsigned* UT = (const unsigned*)(ws + WS_UT); const float* DC = (const float*)(ws + MS_DC);
    f32x2* LT = (f32x2*)(ws + WS_LTOT); float* PT = (float*)(ws + MS_PTOT);
    for (int it = F.blk * NTHR + tid; it < 16 * 32768; it += F.G * NTHR) {
        const int gs = it >> 15, e = it & 32767, hh = e >> 13, v = (e >> 6) & 127, k0 = 2 * (e & 63);
        float S0 = 0.f, S1 = 0.f, P0 = 1.f, P1 = 1.f;
#pragma unroll
        for (int cc = 0; cc < 16; ++cc) { const int c = 16 * gs + cc; const unsigned u = UT[(size_t)c * 32768 + e]; const f32x2 d = *(const f32x2*)(DC + (c * 4 + hh) * 128 + k0);
            S0 = d.x * S0 + bflo(u); S1 = d.y * S1 + bfhi(u); P0 *= d.x; P1 *= d.y; }
        LT[it] = (f32x2){S0, S1};
        if (v == 0) *(f32x2*)(PT + (gs * 4 + hh) * 128 + k0) = (f32x2){P0, P1};
    }
}
__device__ __forceinline__ void phase_rec_c2c(const Frame& F) {
    PH_TID();
    unsigned char* ws = F.ws; const unsigned* UT = (const unsigned*)(ws + WS_UT); unsigned* ST = (unsigned*)(ws + WS_ST); const float* DC = (const float*)(ws + MS_DC); const float* MM = (const float*)(ws + MS_MM);
    const f32x2* LT = (const f32x2*)(ws + WS_LTOT); const float* PT = (const float*)(ws + MS_PTOT);
    for (int it = F.blk * NTHR + tid; it < 16 * 32768; it += F.G * NTHR) {
        const int gs = it >> 15, e = it & 32767, hh = e >> 13, k0 = 2 * (e & 63);
        float C0 = 0.f, C1 = 0.f;
        for (int g2 = 0; g2 < gs; ++g2) { const f32x2 pt = *(const f32x2*)(PT + (g2 * 4 + hh) * 128 + k0); const f32x2 lt = LT[g2 * 32768 + e]; C0 = pt.x * C0 + lt.x; C1 = pt.y * C1 + lt.y; }
#pragma unroll
        for (int cc = 0; cc < 16; ++cc) { const int c = 16 * gs + cc; const f32x2 mm = *(const f32x2*)(MM + (c * 4 + hh) * 128 + k0);
            ST[(size_t)c * 32768 + e] = pk2(C0 * mm.x, C1 * mm.y);
            const unsigned u = UT[(size_t)c * 32768 + e]; const f32x2 d = *(const f32x2*)(DC + (c * 4 + hh) * 128 + k0);
            C0 = d.x * C0 + bflo(u); C1 = d.y * C1 + bfhi(u); }
    }
}
__device__ __forceinline__ void phase_rec_c2(const Frame& F) {
    PH_TID();
    unsigned char* ws = F.ws; const int w = ph_wave;
    LAS float* tot = (LAS float*)F.lds;
    for (int unit = F.blk; unit < 256; unit += F.G) {
        const int hh = unit >> 6; const unsigned eo = (unsigned)(unit * 128 + lane), ko = (unsigned)(hh * 128 + 2 * lane);
        const unsigned* ut = (const unsigned*)(ws + WS_UT) + (size_t)(32 * w) * 32768; unsigned* st = (unsigned*)(ws + WS_ST) + (size_t)(32 * w) * 32768;
        const float* dc = (const float*)(ws + MS_DC) + (32 * w) * 512; const float* mmp = (const float*)(ws + MS_MM) + (32 * w) * 512;
        asm volatile("" : "+s"(ut), "+s"(st), "+s"(dc), "+s"(mmp));
        unsigned ua[32], ub[32]; f32x2 d[32], m0[16], m1[16];
#pragma unroll
        for (int cc = 0; cc < 32; ++cc) { ua[cc] = (ut + cc * 32768)[eo]; ub[cc] = (ut + cc * 32768 + 64)[eo]; d[cc] = *(const f32x2*)((dc + cc * 512) + ko); }
        __builtin_amdgcn_sched_barrier(0);
        float a0 = 0.f, a1 = 0.f, b0 = 0.f, b1 = 0.f, p0 = 1.f, p1 = 1.f;
#pragma unroll
        for (int cc = 0; cc < 32; ++cc) { a0 = d[cc].x * a0 + bflo(ua[cc]); a1 = d[cc].y * a1 + bfhi(ua[cc]); b0 = d[cc].x * b0 + bflo(ub[cc]); b1 = d[cc].y * b1 + bfhi(ub[cc]); p0 *= d[cc].x; p1 *= d[cc].y; }
        { LAS float* tw = tot + w * 384 + lane; tw[0] = a0; tw[64] = a1; tw[128] = b0; tw[192] = b1; tw[256] = p0; tw[320] = p1; }
        __builtin_amdgcn_sched_barrier(0);
#pragma unroll
        for (int cc = 0; cc < 16; ++cc) m0[cc] = *(const f32x2*)((mmp + cc * 512) + ko);
        __builtin_amdgcn_sched_barrier(0);
        __syncthreads();
        float A0 = 0.f, A1 = 0.f, B0 = 0.f, B1 = 0.f;
        for (int g2 = 0; g2 < w; ++g2) { const LAS float* tw = tot + g2 * 384 + lane; const float q0 = tw[256], q1 = tw[320]; A0 = q0 * A0 + tw[0]; A1 = q1 * A1 + tw[64]; B0 = q0 * B0 + tw[128]; B1 = q1 * B1 + tw[192]; }
        __builtin_amdgcn_sched_barrier(0);
#pragma unroll
        for (int cc = 0; cc < 16; ++cc) m1[cc] = *(const f32x2*)((mmp + (16 + cc) * 512) + ko);
        __builtin_amdgcn_sched_barrier(0);
#pragma unroll
        for (int cc = 0; cc < 32; ++cc) { const f32x2 mm = cc < 16 ? m0[cc & 15] : m1[cc & 15];
            (st + cc * 32768)[eo] = pk2(A0 * mm.x, A1 * mm.y); (st + cc * 32768 + 64)[eo] = pk2(B0 * mm.x, B1 * mm.y);
            unsigned xa = ua[cc], xb = ub[cc]; asm volatile("" : "+v"(xa), "+v"(xb));
            A0 = d[cc].x * A0 + bflo(xa); A1 = d[cc].y * A1 + bfhi(xa); B0 = d[cc].x * B0 + bflo(xb); B1 = d[cc].y * B1 + bfhi(xb);
            asm volatile("" : "+v"(A0), "+v"(A1), "+v"(B0), "+v"(B1) :: "memory"); }
        __syncthreads();
    }
}
template <int PV = 0> __device__ __forceinline__ void phase_rec_c3(const Frame& F, int l) {
    PH_TID();
    unsigned char* ws = F.ws; const bf16* Z = (const bf16*)(ws + WS_Z); const bf16* ST = (const bf16*)(ws + WS_ST); bf16* O = (bf16*)(ws + WS_O);
    const float* lb = (const float*)(ws + MS_LB) + l * DREC; const float* ogain = F.in[5] + l * 128;
    LAS unsigned char* QT = F.lds; LAS unsigned char* KT = F.lds + 128 * RP; LAS unsigned char* IM = F.lds + 256 * RP;
    const int wave = ph_wave, ch = tid & 255, half = tid >> 8, hl = ch >> 7, k = ch & 127, g = lane >> 4, li = lane & 15, q = li >> 2, p = li & 3;
    for (int unit = F.blk; unit < 512; unit += F.G) {
        const int c = unit >> 1, hp = unit & 1, hh = 2 * hp + hl;
        { const bf16* zb = Z + (size_t)(c * 64 + 32 * half) * DIN + hh * 128 + k;
          const float lbk = lb[hh * 128 + k];
          float cs[32], kk[32], qs[32]; float run = 1.f;
#pragma unroll
          for (int t = 0; t < 32; ++t) { const float fz = bf2f(zb[(size_t)t * DIN + 512]); const float sg = sigmoid_(fz); run *= lbk + (1.f - lbk) * sg; cs[t] = run; kk[t] = (1.f - lbk) * (1.f - sg); qs[t] = silu_(bf2f(zb[(size_t)t * DIN])); }
          const float inv = half == 0 ? frcp(fmaxf(run, 1e-30f)) : 1.f;
#pragma unroll
          for (int t = 0; t < 32; ++t) { const float ex = cs[t] * inv; const int off = (hl * 64 + 32 * half + t) * RP + 2 * k;
              *(LAS bf16*)(QT + off) = (bf16)f2bf(qs[t] * ex); *(LAS bf16*)(KT + off) = (bf16)f2bf(kk[t] * frcp(fmaxf(ex, 1e-30f))); } }
#pragma unroll
        for (int j = 0; j < 4; ++j) { const int idx = tid + 512 * j, hl2 = idx >> 10, row = (idx >> 4) & 63, cc = idx & 15;
            const u32x4 v = *(const u32x4*)(Z + (size_t)(c * 64 + row) * DIN + 1024 + (2 * hp + hl2) * 128 + cc * 8);
            *(LAS u32x4*)(IM + (hl2 * 64 + row) * RP + cc * 16) = v; }
        const int whl = wave >> 2, tt = wave & 3, whh = 2 * hp + whl;
        bf16x8 Sf[8][4];
#pragma unroll
        for (int vt = 0; vt < 8; ++vt)
#pragma unroll
            for (int a = 0; a < 4; ++a) Sf[vt][a] = *(const bf16x8*)(ST + ((size_t)(c * 4 + whh) * 128 + 16 * vt + li) * 128 + 32 * a + 8 * g);
        __syncthreads();
        if (PV != 1) {
          bf16 gz[8][4];
#pragma unroll
          for (int vt = 0; vt < 8; ++vt)
#pragma unroll
              for (int r = 0; r < 4; ++r) gz[vt][r] = Z[((size_t)c * 64 + 16 * tt + 4 * g + r) * DIN + 1536 + whh * 128 + 16 * vt + li];
          bf16x8 Qf[4];
#pragma unroll
          for (int a = 0; a < 4; ++a) Qf[a] = *(const LAS bf16x8*)(QT + (whl * 64 + 16 * tt + li) * RP + (32 * a + 8 * g) * 2);
          unsigned pw[4][2];
#pragma unroll
          for (int st = 0; st < 4; ++st) { pw[st][0] = 0u; pw[st][1] = 0u;
              { f32x4 s = (f32x4){0.f, 0.f, 0.f, 0.f};
#pragma unroll
                  for (int a = 0; a < 4; ++a) { const bf16x8 Kf = *(const LAS bf16x8*)(KT + (whl * 64 + 16 * st + li) * RP + (32 * a + 8 * g) * 2); s = MFMA16(Kf, Qf[a], s); }
                  if (st == tt) {
#pragma unroll
                      for (int r = 0; r < 4; ++r) if (4 * g + r > li) s[r] = 0.f; }
                  pw[st][0] = st <= tt ? pg8::cvt_pk_bf16(s[0], s[1]) : 0u; pw[st][1] = st <= tt ? pg8::cvt_pk_bf16(s[2], s[3]) : 0u; } }
          f32x4 acc[8];
#pragma unroll
          for (int vt = 0; vt < 8; ++vt) { acc[vt] = (f32x4){0.f, 0.f, 0.f, 0.f};
#pragma unroll
              for (int a = 0; a < 4; ++a) acc[vt] = MFMA16(Qf[a], Sf[vt][a], acc[vt]); }
          LAS unsigned char* imb = IM + whl * 64 * RP;
#pragma unroll
          for (int a = 0; a < 2; ++a) { const u32x4 pv = (u32x4){pw[2 * a][0], pw[2 * a][1], pw[2 * a + 1][0], pw[2 * a + 1][1]}; const bf16x8 Pf = __builtin_bit_cast(bf16x8, pv);
              const unsigned ro = (unsigned)((32 * a + 4 * g + q) * RP);
#pragma unroll
              for (int vt = 0; vt < 8; ++vt) { const unsigned co = (unsigned)((16 * vt + 4 * p) * 2); const bf16x8 If = tr_frag(imb + ro + co, imb + ro + 16 * RP + co); acc[vt] = MFMA16(Pf, If, acc[vt]); } }
          float rs[4];
#pragma unroll
          for (int r = 0; r < 4; ++r) { float ss = 0.f;
#pragma unroll
              for (int vt = 0; vt < 8; ++vt) ss += acc[vt][r] * acc[vt][r];
              ss += shx<1>(ss); ss += shx<2>(ss); ss += shx<4>(ss); ss += shx<8>(ss); rs[r] = frsq(ss * (1.f / 128.f) + EPS); }
#pragma unroll
          for (int vt = 0; vt < 8; ++vt) { const float og = ogain[16 * vt + li];
#pragma unroll
              for (int r = 0; r < 4; ++r) { const size_t t = (size_t)c * 64 + 16 * tt + 4 * g + r; const float gv = bf2f(gz[vt][r]);
                  O[t * D + whh * 128 + 16 * vt + li] = (bf16)f2bf(acc[vt][r] * rs[r] * og * silu_(gv)); } } }
        __syncthreads();
    }
}
__device__ __forceinline__ void phase_sgu(const Frame& F, int l) {
    PH_TID();
    unsigned char* ws = F.ws; const bf16* Z = (const bf16*)(ws + WS_Z); bf16* O = (bf16*)(ws + WS_O);
    const bf16* Wb = (const bf16*)(ws + MS_SGUW) + (size_t)l * 4 * 128 * 128; const float* sb = F.in[9] + l * 4 * 128;
    LAS unsigned char* VN = F.lds;
    const int wave = ph_wave, g = lane >> 4, li = lane & 15, q = li >> 2, p = li & 3;
    for (int unit = (F.blk + F.G / 2) % F.G; unit < 128; unit += F.G) {
        float lg[8], lbv[8];
#pragma unroll
        for (int j = 0; j < 8; ++j) { lg[j] = F.in[6][l * DSGU + 8 * lane + j]; lbv[j] = F.in[7][l * DSGU + 8 * lane + j]; }
        u32x4 raw[16];
#pragma unroll
        for (int i = 0; i < 16; ++i) raw[i] = *(const u32x4*)(Z + ((size_t)unit * 128 + 16 * wave + i) * DIN + 2560 + 8 * lane);
#pragma unroll
        for (int i = 0; i < 16; ++i) { const int s = 16 * wave + i; const u32x4 r = raw[i];
            float x[8] = {gelu_(bflo(r.x)), gelu_(bfhi(r.x)), gelu_(bflo(r.y)), gelu_(bfhi(r.y)), gelu_(bflo(r.z)), gelu_(bfhi(r.z)), gelu_(bflo(r.w)), gelu_(bfhi(r.w))};
            float sm = 0.f;
#pragma unroll
            for (int j = 0; j < 8; ++j) sm += x[j];
            const float mu = wave_sum(sm) * (1.f / 512.f); float qq = 0.f;
#pragma unroll
            for (int j = 0; j < 8; ++j) { x[j] -= mu; qq += x[j] * x[j]; }
            const float rstd = frsq(wave_sum(qq) * (1.f / 512.f) + EPS);
#pragma unroll
            for (int j = 0; j < 8; ++j) x[j] = x[j] * rstd * lg[j] + lbv[j];
            u32x4 o; o.x = pk2(x[0], x[1]); o.y = pk2(x[2], x[3]); o.z = pk2(x[4], x[5]); o.w = pk2(x[6], x[7]);
            *(LAS u32x4*)(VN + s * VP + lane * 16) = o; }
        __syncthreads();
        { const int hh = wave >> 1, dh = wave & 1; const bf16* W = Wb + (size_t)hh * 128 * 128;
          LAS unsigned char* vnb = VN;
#pragma unroll 1
          for (int dp = 0; dp < 2; ++dp) {
          bf16x8 Wf[2][8];
#pragma unroll
          for (int a = 0; a < 2; ++a)
#pragma unroll
              for (int ti = 0; ti < 8; ++ti) if (ti >= 2 * a) Wf[a][ti] = *(const bf16x8*)(W + (size_t)(16 * ti + li) * 128 + 32 * a + 8 * g);
          f32x4 acc[2][8];
#pragma unroll
          for (int dt = 0; dt < 2; ++dt)
#pragma unroll
              for (int ti = 0; ti < 8; ++ti) acc[dt][ti] = (f32x4){0.f, 0.f, 0.f, 0.f};
#pragma unroll
          for (int a = 0; a < 4; ++a) { const unsigned ro = (unsigned)((32 * a + 8 * g + q) * VP);
              bf16x8 Af[2];
#pragma unroll
              for (int dt = 0; dt < 2; ++dt) { const unsigned co = (unsigned)((hh * 128 + 64 * dh + 16 * (2 * dp + dt) + 4 * p) * 2); Af[dt] = tr_frag(vnb + ro + co, vnb + ro + 4 * VP + co); }
#pragma unroll
              for (int ti = 0; ti < 8; ++ti) if (ti >= 2 * a) {
                  const bf16x8 Bf = a < 2 ? Wf[a < 2 ? a : 0][ti] : *(const bf16x8*)(W + (size_t)(16 * ti + li) * 128 + 32 * a + 8 * g);
#pragma unroll
                  for (int dt = 0; dt < 2; ++dt) acc[dt][ti] = MFMA16(Af[dt], Bf, acc[dt][ti]); } }
#pragma unroll
          for (int ti = 0; ti < 8; ++ti) { const size_t t = (size_t)unit * 128 + 16 * ti + li; const float bias = sb[hh * 128 + 16 * ti + li];
#pragma unroll
              for (int dt = 0; dt < 2; ++dt) { const int col = hh * 128 + 64 * dh + 16 * (2 * dp + dt) + 4 * g; const u32x2 u = *(const u32x2*)(Z + t * DIN + 2048 + col);
                  u32x2 w; w.x = pk2((acc[dt][ti][0] + bias) * gelu_(bflo(u.x)), (acc[dt][ti][1] + bias) * gelu_(bfhi(u.x))); w.y = pk2((acc[dt][ti][2] + bias) * gelu_(bflo(u.y)), (acc[dt][ti][3] + bias) * gelu_(bfhi(u.y)));
                  *(u32x2*)(O + t * D + 512 + col) = w; } } } }
        __syncthreads();
    }
}

#define XB_TMO      128
#define XB_XCNT(j)  (256  + 64 * (j))
#define XB_XSUB(j)  (1280 + 64 * (j))
#define XB_XGEN(j)  (2304 + 64 * (j))
#define XB_TOP      3328
#define XB_TOPGEN   3392
#define XCD_BAR_WORDS 3456
#define XB_SPIN_CAP (1u << 18)
__device__ __forceinline__ unsigned xb_ld(unsigned* p)              { return __hip_atomic_load(p, __ATOMIC_RELAXED, __HIP_MEMORY_SCOPE_AGENT); }
__device__ __forceinline__ unsigned xb_add(unsigned* p, unsigned v) { return __hip_atomic_fetch_add(p, v, __ATOMIC_RELAXED, __HIP_MEMORY_SCOPE_AGENT); }
__device__ __forceinline__ unsigned xb_xcc_id() { return (unsigned)__builtin_amdgcn_s_getreg((3 << 11) | 20) & 0xFu; }
#define XB_SPIN(cond, bar) do { unsigned _sp = 0; while (cond) { __builtin_amdgcn_s_sleep(1); \
    if ((++_sp & 255u) == 0u) { if (xb_ld(&(bar)[XB_TMO])) break; if (_sp > XB_SPIN_CAP) { atomicAdd(&(bar)[XB_TMO], 1u); break; } } } } while (0)
struct XcdBarrier { unsigned* bar; unsigned x; volatile LAS unsigned* st; int wave; };
__device__ __forceinline__ XcdBarrier xcd_barrier_post(unsigned* bar, volatile LAS unsigned* st, int wave) {
    XcdBarrier b; b.bar = bar; b.x = xb_xcc_id(); b.st = st; b.wave = wave;
    if (wave == 0 && lane_now() == 0) (void)xb_add(&bar[XB_XCNT(b.x)], 1u);
    return b;
}
__device__ __forceinline__ void xcd_barrier_complete(unsigned* bar, unsigned x, unsigned& nloc, unsigned& nx) {
    const unsigned G = gridDim.x * gridDim.y * gridDim.z;
    unsigned sum, cnt, mine, sp = 0u;
    for (;;) {
        sum = 0u; cnt = 0u; mine = 0u;
#pragma unroll
        for (unsigned j = 0; j < 16; ++j) { const unsigned c = xb_ld(&bar[XB_XCNT(j)]); sum += c; cnt += (c > 0u) ? 1u : 0u; mine = (j == x) ? c : mine; }
        if (sum == G) break;
        __builtin_amdgcn_s_sleep(1);
        if ((++sp & 255u) == 0u) { if (xb_ld(&bar[XB_TMO])) break; if (sp > XB_SPIN_CAP) { atomicAdd(&bar[XB_TMO], 1u); break; } }
    }
    nloc = mine > 0u ? mine : 1u; nx = cnt > 0u ? cnt : 1u;
}
__device__ __forceinline__ void xcd_barrier(const XcdBarrier& b) {
    asm volatile("s_waitcnt vmcnt(0)" ::: "memory");
    __syncthreads();
    if (b.wave == 0 && lane_now() == 0) {
        unsigned* bar = b.bar;
        __builtin_amdgcn_s_waitcnt(0);
        unsigned nloc = b.st[0], nx = b.st[1];
        if (nloc == 0u) { xcd_barrier_complete(bar, b.x, nloc, nx); b.st[0] = nloc; b.st[1] = nx; }
        const unsigned old = xb_add(&bar[XB_XSUB(b.x)], 1u);
        const unsigned gen = old / nloc;
        if (old + 1u == (gen + 1u) * nloc) {
            __builtin_amdgcn_fence(__ATOMIC_RELEASE, "agent");
            asm volatile("s_waitcnt vmcnt(0)" ::: "memory");
            const unsigned og = xb_add(&bar[XB_TOP], 1u);
            const unsigned tg = og / nx;
            if (og + 1u == (tg + 1u) * nx) xb_add(&bar[XB_TOPGEN], 1u);
            else XB_SPIN(xb_ld(&bar[XB_TOPGEN]) == tg, bar);
            __builtin_amdgcn_fence(__ATOMIC_ACQUIRE, "agent");
            xb_add(&bar[XB_XGEN(b.x)], 1u);
            asm volatile("s_waitcnt vmcnt(0)" ::: "memory");
        } else {
            XB_SPIN(xb_ld(&bar[XB_XGEN(b.x)]) == gen, bar);
            __builtin_amdgcn_fence(__ATOMIC_ACQUIRE, "agent");
            asm volatile("s_waitcnt vmcnt(0)" ::: "memory");
        }
    }
    __syncthreads();
}


__device__ __forceinline__ void xcd_barrier_bg(const XcdBarrier& b, const Frame& F, int lnext, bool drain) {
    asm volatile("s_waitcnt vmcnt(0)" ::: "memory");
    __syncthreads();
    volatile LAS unsigned* sx = b.st + 4;
    unsigned* q = (unsigned*)(F.ws + WS_CTL) + CW_BGQ + lnext * 64;
    if (b.wave == 0 && lane_now() == 0) {
        unsigned* bar = b.bar;
        __builtin_amdgcn_s_waitcnt(0);
        unsigned nloc = b.st[0], nx = b.st[1];
        if (nloc == 0u) { xcd_barrier_complete(bar, b.x, nloc, nx); b.st[0] = nloc; b.st[1] = nx; }
        const unsigned old = xb_add(&bar[XB_XSUB(b.x)], 1u);
        const unsigned gen = old / nloc;
        const bool leader = (old + 1u == (gen + 1u) * nloc);
        unsigned ti = 0u; if (!leader) { const unsigned k = xb_add(q, 1u); if (k < (unsigned)NBG) ti = k + 1u; }
        sx[0] = leader ? 1u : 0u; sx[1] = gen; sx[2] = ti;
    }
    __syncthreads();
    if (__builtin_amdgcn_readfirstlane(sx[0]) == 0u) {
        unsigned ti = (unsigned)__builtin_amdgcn_readfirstlane(sx[2]);
        while (ti != 0u) {
            const int it = lnext * TL_LAYER + NDEF + (int)ti - 1;
            conv_run(F, 0, 1, 1, [=](int) { return it; });
            if (!drain) break;
            if (b.wave == 0 && lane_now() == 0) { const unsigned k = xb_add(q, 1u); sx[2] = k < (unsigned)NBG ? k + 1u : 0u; }
            __syncthreads();
            ti = (unsigned)__builtin_amdgcn_readfirstlane(sx[2]);
            __syncthreads();
        }
    }
    if (b.wave == 0 && lane_now() == 0) {
        unsigned* bar = b.bar; const unsigned gen = sx[1], nx = b.st[1];
        asm volatile("s_waitcnt vmcnt(0)" ::: "memory");
        if (sx[0] != 0u) {
            __builtin_amdgcn_fence(__ATOMIC_RELEASE, "agent");
            asm volatile("s_waitcnt vmcnt(0)" ::: "memory");
            const unsigned og = xb_add(&bar[XB_TOP], 1u);
            const unsigned tg = og / nx;
            if (og + 1u == (tg + 1u) * nx) xb_add(&bar[XB_TOPGEN], 1u);
            else XB_SPIN(xb_ld(&bar[XB_TOPGEN]) == tg, bar);
            __builtin_amdgcn_fence(__ATOMIC_ACQUIRE, "agent");
            xb_add(&bar[XB_XGEN(b.x)], 1u);
            asm volatile("s_waitcnt vmcnt(0)" ::: "memory");
        } else {
            XB_SPIN(xb_ld(&bar[XB_XGEN(b.x)]) == gen, bar);
            __builtin_amdgcn_fence(__ATOMIC_ACQUIRE, "agent");
            asm volatile("s_waitcnt vmcnt(0)" ::: "memory");
        }
    }
    __syncthreads();
}

__device__ __forceinline__ bool opq(Frame& F) { asm volatile("" : "+s"(F.ws), "+s"(F.blk), "+s"(F.out), "+s"(F.G)); return true; }
__device__ __forceinline__ int lq_(int l) { asm volatile("" : "+s"(l)); return l; }
__global__ void __launch_bounds__(NTHR, 2) k_mega(Params p) {
    extern __shared__ __attribute__((aligned(16))) unsigned char lds[];
    Frame F; F.lds = (LAS unsigned char*)lds; F.ws = p.ws; F.in = p.in; F.out = p.out; F.wave = __builtin_amdgcn_readfirstlane(threadIdx.x >> 6); F.blk = blockIdx.x; F.G = gridDim.x;
    volatile LAS unsigned* st = (volatile LAS unsigned*)(F.lds + LDS_BYTES - 32);
    if (threadIdx.x < 8) st[threadIdx.x] = 0u;
    __syncthreads();
#if USE_CG_SYNC
#define GRID_BAR() cooperative_groups::this_grid().sync()
#else
    const XcdBarrier bar = xcd_barrier_post((unsigned*)(p.ws + WS_CTL) + CW_BAR + p.li * XCD_BAR_WORDS, st, F.wave);
#define GRID_BAR() xcd_barrier(bar)
#endif
    const int lo = p.ph_lo, hi = p.ph_hi;
#define RUN(k) (lo <= (k) && (k) < hi && opq(F))
#define SEAM(k) do { if (RUN(k) && RUN((k) + 1)) GRID_BAR(); } while (0)
#define SEAM_BG(k, drain) do { if (RUN(k) && RUN((k) + 1)) { if (!USE_CG_SYNC && l + 1 < DEPTH) xcd_barrier_bg(bar, F, l + 1, drain); else GRID_BAR(); } } while (0)
    if (RUN(0)) { phase_prologue(F); if (PROBE_DUP & 16) { __syncthreads(); phase_prologue(F); } }
    SEAM(0);
    for (int l = 0; l < DEPTH; ++l) {
        const int b = 2 + 13 * l;
        if (RUN(b + 0)) phase_norm1(F, lq_(l));
        SEAM_BG(b + 0, false);
        if (RUN(b + 1)) phase_gemm_in(F, lq_(l));
        SEAM_BG(b + 1, false);
        if (RUN(b + 2)) { phase_rec_c1(F, lq_(l)); phase_sgu(F, lq_(l)); if (PROBE_DUP & 1) { __syncthreads(); phase_rec_c1(F, lq_(l)); phase_sgu(F, lq_(l)); } if (PROBE_DUP & 64) { __syncthreads(); phase_sgu(F, lq_(l)); } }
        SEAM_BG(b + 2, false);
        if (RUN(b + 3)) { phase_rec_c2(F); if (PROBE_DUP & 4) phase_rec_c2(F); }
        SEAM_BG(b + 3, false);
        if (RUN(b + 5)) { phase_rec_c3(F, lq_(l)); if (PROBE_DUP & 2) { __syncthreads(); phase_rec_c3(F, lq_(l)); } if (PROBE_DUP & 128) { __syncthreads(); phase_rec_c3<1>(F, lq_(l)); } }
        SEAM_BG(b + 5, false);
        if (RUN(b + 6)) phase_gemm_out(F, lq_(l));
        SEAM_BG(b + 6, false);
        if (RUN(b + 7)) phase_norm2(F, lq_(l));
        SEAM_BG(b + 7, false);
        if (RUN(b + 8)) { phase_gather(F, lq_(l)); if (PROBE_DUP & 8) { __syncthreads(); phase_gather(F, lq_(l)); } }
        SEAM_BG(b + 8, false);
#if MOE_FUSED == 1
        if (RUN(b + 9)) phase_moe_fused(F, lq_(l));
        SEAM_BG(b + 9, false);
#elif MOE_FUSED == 2
        if (RUN(b + 9)) phase_moe_fused<1>(F, lq_(l));
        SEAM_BG(b + 9, false);
        if (RUN(b + 10)) phase_moe_fused<2>(F, lq_(l));
        SEAM_BG(b + 10, false);
#else
        if (RUN(b + 9)) phase_gemm_moe1(F, lq_(l));
        SEAM_BG(b + 9, false);
        if (RUN(b + 10)) phase_gemm_moe2(F, lq_(l));
        SEAM_BG(b + 10, false);
#endif
        if (RUN(b + 11)) phase_combine(F, lq_(l));
        SEAM_BG(b + 11, true);
        if (RUN(b + 12)) phase_gemm_pg(F, lq_(l));
        SEAM(b + 12);
    }
    if (RUN(54)) phase_final(F);
#undef RUN
#undef SEAM
}

#ifndef ONE_LAUNCH
#define ONE_LAUNCH 1
#endif
#ifndef CUTS
#define CUTS {0, 55}
#endif
#ifndef MFMA_MASK
#define MFMA_MASK 255
#endif
extern "C" void kernel_launch(void* const* d_in, const int* in_sizes, int n_in, void* d_out, int out_size, void* d_ws, size_t ws_size, hipStream_t stream) {
    if (n_in != 24 || out_size != T * D || ws_size < WS_END) { fprintf(stderr, "kernel_launch: unexpected shapes (n_in %d out %d ws %zu)\n", n_in, out_size, ws_size); return; }
    static_assert(CW_BAR + 60 * XCD_BAR_WORDS <= (int)(CTL_BYTES / 4), "barrier regions inside the zeroed control words");
    Params p{}; for (int i = 0; i < 24; ++i) p.in[i] = (const float*)d_in[i]; p.out = (float*)d_out; p.ws = (unsigned char*)d_ws;
    unsigned char* ws = p.ws;
    (void)hipMemsetAsync(ws + WS_CTL, 0, CTL_BYTES, stream);
    { static bool attr = false; if (!attr) { (void)hipFuncSetAttribute((const void*)k_mega, hipFuncAttributeMaxDynamicSharedMemorySize, LDS_BYTES); attr = true; }
      const int cuts[] = CUTS; const int ncut = (int)(sizeof(cuts) / sizeof(cuts[0]));
      for (int i = 0; i + 1 < ncut; ++i) { p.ph_lo = cuts[i]; p.ph_hi = cuts[i + 1]; p.li = i; p.pad = 0;
#if USE_CG_SYNC
          void* args[] = {&p}; hipError_t e = hipLaunchCooperativeKernel((const void*)k_mega, dim3(256), dim3(NTHR), args, LDS_BYTES, stream);
          if (e != hipSuccess) fprintf(stderr, "cooperative launch failed: %s\n", hipGetErrorName(e));
#else
          hipLaunchKernelGGL(k_mega, dim3(256), dim3(NTHR), LDS_BYTES, stream, p);
#endif
      }
    }
}
```

```cpp
#include <hip/hip_runtime.h>
#include <hip/hip_cooperative_groups.h>
#include <cstdio>
#include <cstdint>

#define GAS __attribute__((address_space(1)))
#define LAS __attribute__((address_space(3)))
typedef unsigned short bf16;
typedef float f32x4 __attribute__((ext_vector_type(4)));
typedef float f32x2 __attribute__((ext_vector_type(2)));
typedef unsigned u32x4 __attribute__((ext_vector_type(4)));
typedef unsigned u32x2 __attribute__((ext_vector_type(2)));
typedef short bf16x8 __attribute__((ext_vector_type(8)));

constexpr int T = 16384, D = 1024, DEPTH = 4, DIN = 3072, DREC = 512, DSGU = 512;
constexpr int NE = 32, DE = 512, PD = 256;
constexpr int RB = 256;
constexpr int CAP = 2 * T + NE * RB;
constexpr int NRBMAX = CAP / RB;
constexpr float EPS = 1e-6f;
constexpr int NWAVES = 8, NTHR = 512;

constexpr size_t MiB = 1u << 20, KiB = 1u << 10;
constexpr size_t WS_CTL = 0, CTL_BYTES = 1 * MiB;
constexpr size_t WS_MISC = 1 * MiB;
constexpr size_t MS_TOKE = WS_MISC + 0;
constexpr size_t MS_TOKW = WS_MISC + 128 * KiB;
constexpr size_t MS_SINFO = WS_MISC + 256 * KiB;
constexpr size_t MS_SDEST = WS_MISC + 384 * KiB;
constexpr size_t MS_RSTDPE = WS_MISC + 512 * KiB;
constexpr size_t MS_BLKBASE = WS_MISC + 576 * KiB;
constexpr size_t MS_LB = WS_MISC + 608 * KiB;
constexpr size_t MS_BLKE = WS_MISC + 640 * KiB;
constexpr size_t MS_DC = WS_MISC + 1 * MiB;
constexpr size_t MS_WRT = WS_MISC + 2 * MiB;
constexpr size_t MS_SGUW = WS_MISC + 3 * MiB;
constexpr size_t MS_MM = WS_MISC + 4 * MiB;
constexpr size_t MS_PTOT = WS_MISC + 5 * MiB;
constexpr size_t WS_WIN = 16 * MiB;
constexpr size_t WS_WOUT = 40 * MiB;
constexpr size_t WS_WGU = 48 * MiB;
constexpr size_t WS_WD = 304 * MiB;
constexpr size_t WS_WPG = 432 * MiB;
constexpr size_t WS_WPE = 440 * MiB;
constexpr size_t WS_PB = 442 * MiB;
constexpr size_t WS_H = 474 * MiB;
constexpr size_t WS_XN = 538 * MiB;
constexpr size_t WS_O = 570 * MiB;
constexpr size_t WS_PE = 602 * MiB;
constexpr size_t WS_R1 = 730 * MiB;
constexpr size_t WS_Z = WS_R1;
constexpr size_t WS_UT = WS_R1 + 96 * MiB;
constexpr size_t WS_ST = WS_R1 + 128 * MiB;
constexpr size_t WS_ORAW = WS_R1 + 96 * MiB;
constexpr size_t WS_VN = WS_R1 + 128 * MiB;
constexpr size_t WS_XB = WS_R1;
constexpr size_t WS_HB = WS_R1 + 80 * MiB;
constexpr size_t WS_Y = WS_R1 + 120 * MiB;
constexpr size_t WS_LTOT = 930 * MiB;
constexpr size_t WS_END = 934 * MiB;
constexpr int CW_CNT = 64;
constexpr int CW_BGQ = 1024;
constexpr int CW_DONE = 2048;
constexpr int CW_BAR = 4096;

constexpr int RING_BYTES = 131072, MISC_OFF = RING_BYTES, LDS_BYTES = 147456;

#ifndef PROBE_DUP
#define PROBE_DUP 0
#endif
#ifndef MOE_FUSED
#define MOE_FUSED 1
#endif
#ifndef USE_CG_SYNC
#define USE_CG_SYNC 0
#endif
struct Params { const float* in[24]; float* out; unsigned char* ws; int ph_lo, ph_hi, li, pad; };

#define LDS_WAIT() asm volatile("s_waitcnt lgkmcnt(0)" ::: "memory")
template <int M> __device__ __forceinline__ float shx(float v) { static_assert(M >= 1 && M < 32, "swizzle xor mask");
    return __int_as_float(__builtin_amdgcn_ds_swizzle(__float_as_int(v), (M << 10) | 0x1F)); }
__device__ __forceinline__ float halves_sum(float v) {
    return __int_as_float(__builtin_amdgcn_readlane(__float_as_int(v), 0)) + __int_as_float(__builtin_amdgcn_readlane(__float_as_int(v), 32)); }
__device__ __forceinline__ float wave_sum(float v) {
    v += shx<1>(v); v += shx<2>(v); v += shx<4>(v); v += shx<8>(v); v += shx<16>(v);
    return halves_sum(v);
}
typedef __bf16 bf16x2_t __attribute__((ext_vector_type(2)));
__device__ __forceinline__ unsigned pk2(float lo, float hi) { const bf16x2_t v = __builtin_convertvector((f32x2){lo, hi}, bf16x2_t); return __builtin_bit_cast(unsigned, v); }
__device__ __forceinline__ unsigned f2bf(float f) { return pk2(f, f) & 0xffffu; }
__device__ __forceinline__ float bflo(unsigned w) { return __uint_as_float(w << 16); }
__device__ __forceinline__ float bfhi(unsigned w) { return __uint_as_float(w & 0xffff0000u); }
__device__ __forceinline__ float bf2f(bf16 b) { return __uint_as_float(((unsigned)b) << 16); }
__device__ __forceinline__ float fexp(float x) { return __builtin_amdgcn_exp2f(x * 1.4426950408889634f); }
__device__ __forceinline__ float flog(float x) { return __builtin_amdgcn_logf(x) * 0.6931471805599453f; }
__device__ __forceinline__ float frcp(float x) { return __builtin_amdgcn_rcpf(x); }
__device__ __forceinline__ float frsq(float x) { return __builtin_amdgcn_rsqf(x); }
__device__ __forceinline__ float sigmoid_(float x) { return frcp(1.f + fexp(-x)); }
__device__ __forceinline__ float silu_(float x) { return x * sigmoid_(x); }
__device__ __forceinline__ float gelu_(float x) { const float y = 0.7978845608028654f * (x + 0.044715f * x * x * x); const float t = 1.f - 2.f * frcp(fexp(2.f * y) + 1.f); return 0.5f * x * (1.f + t); }

struct Frame {
    LAS unsigned char* lds; unsigned char* ws; const float* const* in; float* out;
    int wave, blk, G;
};
__device__ __forceinline__ int lane_now() { int l; asm volatile("v_mbcnt_lo_u32_b32 %0, -1, 0\n\tv_mbcnt_hi_u32_b32 %0, -1, %0" : "=v"(l)); return l; }
#define PH_TID() int ph_wave = F.wave; asm volatile("" : "+s"(ph_wave)); const int lane = lane_now(); (void)lane; const int tid = (ph_wave << 6) | lane; (void)tid

struct ConvJob { const float* W; const float* g; bf16* WT; int K, N, k0, n0, mode; };
constexpr int TL_IN = 16 * 12, TL_OUT = 16 * 4, TL_G = 32 * 16 * 2, TL_D = 32 * 8 * 4, TL_PG = 16 * 4, TL_PE = 4 * 4;
constexpr int TL_LAYER = TL_IN + TL_OUT + 2 * TL_G + TL_D + TL_PG + TL_PE;
__device__ __forceinline__ ConvJob conv_job(const Frame& F, int it) {
    unsigned char* ws = F.ws; const int l = it / TL_LAYER; int r = it % TL_LAYER; ConvJob j;
    if (r < TL_IN) { j.W = F.in[3] + (size_t)l * D * DIN; j.g = F.in[2] + l * D; j.WT = (bf16*)(ws + WS_WIN) + (size_t)l * DIN * D; j.K = D; j.N = DIN; j.k0 = 64 * (r / 12); j.n0 = 256 * (r % 12); j.mode = 0; return j; } r -= TL_IN;
    if (r < TL_OUT) { j.W = F.in[10] + (size_t)l * D * D; j.g = nullptr; j.WT = (bf16*)(ws + WS_WOUT) + (size_t)l * D * D; j.K = D; j.N = D; j.k0 = 64 * (r / 4); j.n0 = 256 * (r % 4); j.mode = 0; return j; } r -= TL_OUT;
    if (r < 2 * TL_G) { const int up = r >= TL_G; if (up) r -= TL_G; const int e = r / 32, rr = r % 32;
        j.W = F.in[up ? 17 : 16] + (size_t)(l * NE + e) * D * DE; j.g = F.in[11] + l * D; j.WT = (bf16*)(ws + WS_WGU) + (size_t)(l * NE + e) * 1024 * 1024; j.K = D; j.N = DE; j.k0 = 64 * (rr / 2); j.n0 = 256 * (rr % 2); j.mode = 1 + up; return j; } r -= 2 * TL_G;
    if (r < TL_D) { const int e = r / 32, rr = r % 32; j.W = F.in[18] + (size_t)(l * NE + e) * DE * D; j.g = nullptr; j.WT = (bf16*)(ws + WS_WD) + (size_t)(l * NE + e) * D * DE; j.K = DE; j.N = D; j.k0 = 64 * (rr / 4); j.n0 = 256 * (rr % 4); j.mode = 0; return j; } r -= TL_D;
    if (r < TL_PG) { j.W = F.in[20] + (size_t)l * D * D; j.g = F.in[19] + l * D; j.WT = (bf16*)(ws + WS_WPG) + (size_t)l * D * D; j.K = D; j.N = D; j.k0 = 64 * (r / 4); j.n0 = 256 * (r % 4); j.mode = 0; return j; } r -= TL_PG;
    j.W = F.in[21] + (size_t)l * PD * D; j.g = nullptr; j.WT = (bf16*)(ws + WS_WPE) + (size_t)l * D * PD; j.K = PD; j.N = D; j.k0 = 64 * (r / 4); j.n0 = 256 * (r % 4); j.mode = 0; return j;
}
__device__ __forceinline__ void conv_load(const ConvJob& j, int wave, int lane, f32x4 (&v)[8]) {
#pragma unroll
    for (int i = 0; i < 8; ++i) { const int row = 8 * wave + i; v[i] = *(const f32x4*)(j.W + (size_t)(j.k0 + row) * j.N + j.n0 + 4 * lane); if (j.g) v[i] = v[i] * j.g[j.k0 + row]; }
}
constexpr int NDEF = 384, NDEF1 = 128, NBG = 3024;
constexpr int NREST = TL_LAYER - NDEF - NBG, NPRO = TL_LAYER + 3 * NREST;
__device__ __forceinline__ int pro_tile(int f) { if (NREST == 0 || f < TL_LAYER) return f; f -= TL_LAYER; const int l = 1 + f / (NREST ? NREST : 1); return l * TL_LAYER + NDEF + NBG + f % (NREST ? NREST : 1); }
template <class M> __device__ __forceinline__ void conv_run(const Frame& F, int first, int stride, int count, M tile_of) {
    PH_TID();
    LAS float* tile = (LAS float*)F.lds;
    const int wave = ph_wave;
    int f = first; f32x4 v[8]; ConvJob cur{}, nxt{};
    if (f < count) { cur = conv_job(F, tile_of(f)); conv_load(cur, wave, lane, v); }
    while (f < count) {
#pragma unroll
        for (int i = 0; i < 8; ++i) { LAS float* d = tile + (8 * wave + i) * 257 + 4 * lane; d[0] = v[i].x; d[1] = v[i].y; d[2] = v[i].z; d[3] = v[i].w; }
        __syncthreads();
        const int fn = f + stride; if (fn < count) { nxt = conv_job(F, tile_of(fn)); conv_load(nxt, wave, lane, v); }
#pragma unroll
        for (int q = 0; q < 4; ++q) { const int nn = 32 * wave + 8 * q + (lane >> 3), c = lane & 7; const LAS float* sp = tile + (8 * c) * 257 + nn;
            u32x4 o; o.x = pk2(sp[0 * 257], sp[1 * 257]); o.y = pk2(sp[2 * 257], sp[3 * 257]); o.z = pk2(sp[4 * 257], sp[5 * 257]); o.w = pk2(sp[6 * 257], sp[7 * 257]);
            const int n = cur.n0 + nn; const int drow = cur.mode == 0 ? n : ((n >> 7) * 256 + (n & 127) + (cur.mode == 2 ? 128 : 0));
            *(u32x4*)(cur.WT + (size_t)drow * cur.K + cur.k0 + 8 * c) = o; }
        __syncthreads();
        cur = nxt; f = fn;
    }
}
__device__ __forceinline__ void conv_deferred(const Frame& F, int lnext, int r0, int r1, int first, int idle) {
    if (lnext >= DEPTH || F.blk < first) return;
    conv_run(F, F.blk - first, idle, r1 - r0, [=](int f) { return lnext * TL_LAYER + r0 + f; });
}
__device__ __forceinline__ void phase_prologue(const Frame& F) {
    PH_TID();
    unsigned char* ws = F.ws;
    conv_run(F, F.blk, F.G, NPRO, [](int f) { return pro_tile(f); });
    { const f32x4* src = (const f32x4*)F.in[1]; u32x4* dst = (u32x4*)(ws + WS_PB); const size_t n8 = (size_t)DEPTH * T * PD / 8;
      for (size_t i = (size_t)F.blk * NTHR + tid; i < n8; i += (size_t)F.G * NTHR) { const f32x4 a = src[2 * i], b = src[2 * i + 1]; u32x4 o; o.x = pk2(a.x, a.y); o.y = pk2(a.z, a.w); o.z = pk2(b.x, b.y); o.w = pk2(b.z, b.w); dst[i] = o; } }
    { float* wrt = (float*)(ws + MS_WRT);
      for (int i = F.blk * NTHR + tid; i < DEPTH * 36 * D; i += F.G * NTHR) { const int k = i % D, n = (i / D) % 36, l = i / (36 * D);
          const float w = n < 4 ? F.in[12][((size_t)l * D + k) * 4 + n] : F.in[14][((size_t)l * D + k) * NE + (n - 4)]; wrt[i] = w * F.in[11][l * D + k]; } }
    { bf16* wb = (bf16*)(ws + MS_SGUW); for (int i = F.blk * NTHR + tid; i < DEPTH * 4 * 128 * 128; i += F.G * NTHR) { const int tc = (i >> 7) & 127, sp = i & 127; wb[i] = sp <= tc ? (bf16)f2bf(F.in[8][i]) : (bf16)0; } }
    if (F.blk == 0 && tid < DREC) { const int c = tid; float v[DEPTH], m = -1e30f;
#pragma unroll
        for (int l = 0; l < DEPTH; ++l) { v[l] = F.in[4][l * DREC + c]; m = fmaxf(m, v[l]); }
        float s = 0.f;
#pragma unroll
        for (int l = 0; l < DEPTH; ++l) { v[l] = fexp(v[l] - m); s += v[l]; }
        float* lb = (float*)(ws + MS_LB); float acc = 0.f;
#pragma unroll
        for (int l = 0; l < DEPTH; ++l) { if (l > 0) acc += v[l] / s; lb[l * DREC + c] = acc; } }
}

__device__ __forceinline__ void load_row(const float* row, int lane, f32x4 (&v)[4]) { const f32x4* r = (const f32x4*)row + lane;
#pragma unroll
    for (int j = 0; j < 4; ++j) v[j] = r[64 * j]; }
__device__ __forceinline__ void load_row_bf(const bf16* row, int lane, f32x4 (&v)[4]) { const u32x2* r = (const u32x2*)row + lane;
#pragma unroll
    for (int j = 0; j < 4; ++j) { const u32x2 x = r[64 * j]; v[j] = (f32x4){bflo(x.x), bfhi(x.x), bflo(x.y), bfhi(x.y)}; } }
__device__ __forceinline__ float row_sumsq(const f32x4 (&v)[4]) { float s = 0.f;
#pragma unroll
    for (int j = 0; j < 4; ++j) s += (v[j].x * v[j].x + v[j].y * v[j].y) + (v[j].z * v[j].z + v[j].w * v[j].w);
    return wave_sum(s); }
__device__ __forceinline__ void store_row_bf16(bf16* orow, int lane, const f32x4 (&v)[4], float s) { u32x2* o = (u32x2*)orow + lane;
#pragma unroll
    for (int j = 0; j < 4; ++j) { u32x2 w; w.x = pk2(v[j].x * s, v[j].y * s); w.y = pk2(v[j].z * s, v[j].w * s); o[64 * j] = w; } }

__device__ __forceinline__ void phase_norm1(const Frame& F, int l) {
    PH_TID();
    bf16* XN = (bf16*)(F.ws + WS_XN); bf16* h = (bf16*)(F.ws + WS_H); const float* x = F.in[0];
    const int gw = F.blk * NWAVES + ph_wave, NGW = F.G * NWAVES;
    for (int t = gw; t < T; t += NGW) { f32x4 v[4];
        if (l == 0) { load_row(x + (size_t)t * D, lane, v); store_row_bf16(h + (size_t)t * D, lane, v, 1.f); } else load_row_bf(h + (size_t)t * D, lane, v);
        const float rstd = frsq(row_sumsq(v) * (1.f / D) + EPS); store_row_bf16(XN + (size_t)t * D, lane, v, rstd); }
}
__device__ __forceinline__ float bfly8(const float (&r)[8], int lane) {
    const bool b2 = lane & 4, b1 = lane & 2, b0 = lane & 1; float a[4], c[2];
#pragma unroll
    for (int i = 0; i < 4; ++i) { const float keep = b2 ? r[i + 4] : r[i], send = b2 ? r[i] : r[i + 4]; a[i] = keep + shx<4>(send); }
#pragma unroll
    for (int i = 0; i < 2; ++i) { const float keep = b1 ? a[i + 2] : a[i], send = b1 ? a[i] : a[i + 2]; c[i] = keep + shx<2>(send); }
    const float keep = b0 ? c[1] : c[0], send = b0 ? c[0] : c[1]; float d = keep + shx<1>(send);
    d += shx<8>(d); d += shx<16>(d);
    return d + __int_as_float(__builtin_amdgcn_ds_bpermute((lane ^ 32) << 2, __float_as_int(d)));
}
__device__ __forceinline__ void phase_norm2(const Frame& F, int l) {
    PH_TID();
    unsigned char* ws = F.ws;
    unsigned* hist = (unsigned*)(F.lds + MISC_OFF + 256);
    if (tid < 32) hist[tid] = 0u;
    __syncthreads();
    const bf16* h = (const bf16*)(ws + WS_H); bf16* XN = (bf16*)(ws + WS_XN);
    const float* WrT = (const float*)(ws + MS_WRT) + (size_t)l * 36 * D;
    const float* b_rg = F.in[13] + l * 4; const float* b_re = F.in[15] + l * NE;
    int* tok_e = (int*)(ws + MS_TOKE); float* tok_w = (float*)(ws + MS_TOKW); unsigned* sinfo = (unsigned*)(ws + MS_SINFO);
    const int RPB = T / F.G, RPW = RPB / NWAVES;
    for (int i0 = 0; i0 < RPW; i0 += 8) {
        const int t0 = F.blk * RPB + ph_wave * RPW + i0;
        f32x4 v[8][4]; float ss[8];
#pragma unroll
        for (int r = 0; r < 8; ++r) { load_row_bf(h + (size_t)(t0 + r) * D, lane, v[r]); float q = 0.f;
#pragma unroll
            for (int j = 0; j < 4; ++j) q += (v[r][j].x * v[r][j].x + v[r][j].y * v[r][j].y) + (v[r][j].z * v[r][j].z + v[r][j].w * v[r][j].w);
            ss[r] = q; }
        const float rstd_mine = frsq(bfly8(ss, lane) * (1.f / D) + EPS);
#pragma unroll
        for (int r = 0; r < 8; ++r) { const float rs = __int_as_float(__builtin_amdgcn_readlane(__float_as_int(rstd_mine), r)); store_row_bf16(XN + (size_t)(t0 + r) * D, lane, v[r], rs); }
        LAS float* lgw = (LAS float*)(F.lds + 4096) + ph_wave * (36 * 8);
#pragma unroll 2
        for (int n = 0; n < 36; ++n) { const f32x4* wr = (const f32x4*)(WrT + (size_t)n * D) + lane; const f32x4 w0 = wr[0], w1 = wr[64], w2 = wr[128], w3 = wr[192]; float pr[8];
#pragma unroll
            for (int r = 0; r < 8; ++r) pr[r] = ((v[r][0].x * w0.x + v[r][0].y * w0.y) + (v[r][0].z * w0.z + v[r][0].w * w0.w)) + ((v[r][1].x * w1.x + v[r][1].y * w1.y) + (v[r][1].z * w1.z + v[r][1].w * w1.w))
                                                 + ((v[r][2].x * w2.x + v[r][2].y * w2.y) + (v[r][2].z * w2.z + v[r][2].w * w2.w)) + ((v[r][3].x * w3.x + v[r][3].y * w3.y) + (v[r][3].z * w3.z + v[r][3].w * w3.w));
            const float val = bfly8(pr, lane) * rstd_mine; if (lane < 8) lgw[n * 8 + lane] = val; }
        const int row = lane & 7;
        float lg4[4], lgb[4];
#pragma unroll
        for (int j = 0; j < 4; ++j) { lg4[j] = lgw[j * 8 + row]; lgb[j] = lg4[j] + b_rg[j]; }
        int gs = 0; float gm = lgb[0];
#pragma unroll
        for (int j = 1; j < 4; ++j) if (lgb[j] > gm) { gm = lgb[j]; gs = j; }
        float mx = fmaxf(fmaxf(lg4[0], lg4[1]), fmaxf(lg4[2], lg4[3])), se = 0.f, lsel = lg4[0];
#pragma unroll
        for (int j = 0; j < 4; ++j) { se += fexp(lg4[j] - mx); if (j == gs) lsel = lg4[j]; }
        const float g_w = fexp(lsel - mx) * frcp(se);
        float le[8], leb[8];
#pragma unroll
        for (int j = 0; j < 8; ++j) { le[j] = lgw[(4 + gs * 8 + j) * 8 + row]; leb[j] = le[j] + b_re[gs * 8 + j]; }
        int s0 = 0; float m0 = leb[0];
#pragma unroll
        for (int j = 1; j < 8; ++j) if (leb[j] > m0) { m0 = leb[j]; s0 = j; }
        int s1 = -1; float m1 = -3.0e38f;
#pragma unroll
        for (int j = 0; j < 8; ++j) if (j != s0 && leb[j] > m1) { m1 = leb[j]; s1 = j; }
        if (s1 < 0) s1 = (s0 == 0) ? 1 : 0;
        float la = le[0], lb2 = le[0];
#pragma unroll
        for (int j = 1; j < 8; ++j) { if (j == s0) la = le[j]; if (j == s1) lb2 = le[j]; }
        const float wa = frcp(1.f + fexp(lb2 - la)), wb = 1.f - wa;
        if (lane < 8) { const int t = t0 + lane;
            const int e0 = gs * 8 + s0, e1 = gs * 8 + s1;
            const unsigned r0 = atomicAdd(&hist[e0], 1u), r1 = atomicAdd(&hist[e1], 1u);
            tok_e[2 * t] = e0; tok_e[2 * t + 1] = e1; tok_w[2 * t] = g_w * wa; tok_w[2 * t + 1] = g_w * wb;
            sinfo[2 * t] = ((unsigned)F.blk << 16) | r0; sinfo[2 * t + 1] = ((unsigned)F.blk << 16) | r1;
        }
    }
    __syncthreads();
    if (tid < 32) { unsigned* cnt = (unsigned*)(ws + WS_CTL) + CW_CNT + l * 32;
        const unsigned base = __hip_atomic_fetch_add(cnt + tid, hist[tid], __ATOMIC_RELAXED, __HIP_MEMORY_SCOPE_AGENT);
        ((unsigned*)(ws + MS_BLKBASE))[F.blk * 32 + tid] = base; }
}
__device__ __forceinline__ void phase_gather(const Frame& F, int l) {
    PH_TID();
    unsigned char* ws = F.ws;
    int* ps = (int*)(F.lds + MISC_OFF + 512);
    if (tid == 0) { unsigned* cnt = (unsigned*)(ws + WS_CTL) + CW_CNT + l * 32; int* blke = (int*)(ws + MS_BLKE) + l * 256; int acc = 0;
        for (int e = 0; e < NE; ++e) { const int c = (int)__hip_atomic_load(cnt + e, __ATOMIC_RELAXED, __HIP_MEMORY_SCOPE_AGENT); ps[e] = acc; const int pad = (c + RB - 1) / RB * RB;
            if (F.blk == 0) for (int rb = acc / RB; rb < (acc + pad) / RB; ++rb) blke[rb] = e;
            acc += pad; }
        if (F.blk == 0) blke[255] = acc / RB; }
    __syncthreads();
    const int* tok_e = (const int*)(ws + MS_TOKE); const unsigned* sinfo = (const unsigned*)(ws + MS_SINFO); const unsigned* bbase = (const unsigned*)(ws + MS_BLKBASE);
    int* sdest = (int*)(ws + MS_SDEST); const bf16* XN = (const bf16*)(ws + WS_XN); bf16* XB = (bf16*)(ws + WS_XB);
    const int gw = F.blk * NWAVES + ph_wave, NGW = F.G * NWAVES;
    for (int t = gw; t < T; t += NGW) {
        const u32x4* src = (const u32x4*)(XN + (size_t)t * D) + lane; const u32x4 a = src[0], b = src[64];
#pragma unroll
        for (int j = 0; j < 2; ++j) { const int e = tok_e[2 * t + j]; const unsigned info = sinfo[2 * t + j];
            const int dest = ps[e] + (int)bbase[(info >> 16) * 32 + e] + (int)(info & 0xffffu);
            if (lane == 0) sdest[2 * t + j] = dest;
            u32x4* dst = (u32x4*)(XB + (size_t)dest * D) + lane; dst[0] = a; dst[64] = b; }
    }
}
__device__ __forceinline__ void phase_combine(const Frame& F, int l) {
    PH_TID();
    unsigned char* ws = F.ws;
    bf16* h = (bf16*)(ws + WS_H); bf16* XN = (bf16*)(ws + WS_XN); const bf16* Y = (const bf16*)(ws + WS_Y); const bf16* PE = (const bf16*)(ws + WS_PE) + (size_t)l * T * D;
    const int* sdest = (const int*)(ws + MS_SDEST); const float* tok_w = (const float*)(ws + MS_TOKW); float* rstd_pe = (float*)(ws + MS_RSTDPE);
    const int gw = F.blk * NWAVES + ph_wave, NGW = F.G * NWAVES;
    for (int t = gw; t < T; t += NGW) {
        const int d0 = sdest[2 * t], d1 = sdest[2 * t + 1]; const float w0 = tok_w[2 * t], w1 = tok_w[2 * t + 1];
        f32x4 v[4]; load_row_bf(h + (size_t)t * D, lane, v);
        const u32x2* y0 = (const u32x2*)(Y + (size_t)d0 * D) + lane; const u32x2* y1 = (const u32x2*)(Y + (size_t)d1 * D) + lane; const u32x2* pe = (const u32x2*)(PE + (size_t)t * D) + lane;
        float sp = 0.f;
#pragma unroll
        for (int j = 0; j < 4; ++j) { const u32x2 a = y0[64 * j], b = y1[64 * j], c = pe[64 * j];
            v[j].x += w0 * bflo(a.x) + w1 * bflo(b.x); v[j].y += w0 * bfhi(a.x) + w1 * bfhi(b.x); v[j].z += w0 * bflo(a.y) + w1 * bflo(b.y); v[j].w += w0 * bfhi(a.y) + w1 * bfhi(b.y);
            const float p0 = bflo(c.x), p1 = bfhi(c.x), p2 = bflo(c.y), p3 = bfhi(c.y); sp += (p0 * p0 + p1 * p1) + (p2 * p2 + p3 * p3); }
        store_row_bf16(h + (size_t)t * D, lane, v, 1.f);
        const float rstd = frsq(row_sumsq(v) * (1.f / D) + EPS); store_row_bf16(XN + (size_t)t * D, lane, v, rstd);
        sp = wave_sum(sp); if (lane == 0) rstd_pe[t] = frsq(sp * (1.f / D) + EPS);
    }
}
__device__ __forceinline__ void phase_final(const Frame& F) {
    PH_TID();
    const bf16* h = (const bf16*)(F.ws + WS_H); const float* nf = F.in[23];
    const int gw = F.blk * NWAVES + ph_wave, NGW = F.G * NWAVES;
    for (int t = gw; t < T; t += NGW) { f32x4 v[4]; load_row_bf(h + (size_t)t * D, lane, v); const float rstd = frsq(row_sumsq(v) * (1.f / D) + EPS);
        f32x4* o = (f32x4*)(F.out + (size_t)t * D) + lane; const f32x4* g = (const f32x4*)nf + lane;
#pragma unroll
        for (int j = 0; j < 4; ++j) o[64 * j] = v[j] * rstd * g[64 * j]; }
}


namespace pg8 {
constexpr int BM = 256, BK = 64, HALF = 128, HTB = HALF * BK * 2, STAGE_BYTES = 8 * HTB, NXCD = 8, WGM = 8;
__host__ __device__ __forceinline__ int lds_byte(int r, int c) { const int st = (r >> 4) * 2 + (c >> 5), rr = r & 15, cc = c & 31, ob = rr * 64 + cc * 2; return st * 1024 + (ob ^ (((ob >> 9) & 1) << 5)); }
__host__ __device__ __forceinline__ void stage_rc(int b, int& R, int& C) { const int st = b / 1024, sb = b % 1024, swz = sb ^ (((sb >> 9) & 1) << 5); R = (st >> 1) * 16 + swz / 64; C = (st & 1) * 32 + (swz % 64) / 2; }
__host__ __device__ __forceinline__ int perm32(int rho) { const int n = rho >> 4, i = rho & 15; return 8 * (i >> 2) + 4 * n + (i & 3); }
struct Unit { int pm, pn; const char* A; const char* B; };
__device__ __forceinline__ void static_map(int wgid, int nM, int nN, int& pm, int& pn) {
    const int nwg = nM * nN; { const int q = nwg / NXCD, r = nwg % NXCD, xcd = wgid % NXCD, off = wgid / NXCD; wgid = (xcd < r ? xcd * (q + 1) : r * (q + 1) + (xcd - r) * q) + off; }
    const int nig = WGM * nN, gid = wgid / nig, fm = gid * WGM, gsz = (nM - fm) < WGM ? (nM - fm) : WGM;
    pm = fm + ((wgid % nig) % gsz); pn = (wgid % nig) / gsz;
}
struct DenseOrder { static constexpr bool DEPS = false;
    const char* A; const char* Bt; int nM, nN, nL, G, c; size_t tstep;
    __device__ void init(const void* A_, const void* Bt_, int M, int N, int K, int nL_, int G_, int c_) { A = (const char*)A_; Bt = (const char*)Bt_; nM = M / BM; nN = N / BM; nL = nL_; G = G_; c = c_; tstep = (size_t)BM * K * 2; }
    __device__ bool next(int i, Unit& u) const { const long L = (long)i * G + c; const int per = nM * nN; if (L >= (long)per * nL) return false;
        const int l = (int)(L / per); int pm, pn; static_map((int)(L % per), nM, nN, pm, pn); u.pm = l * nM + pm; u.pn = pn; u.A = A + (size_t)u.pm * tstep; u.B = Bt + (size_t)(l * nN + pn) * tstep; return true; }
};
struct MoeOrder { static constexpr bool DEPS = false;
    const char* A; const char* W; const int* blke; int nrb, nN, G, c; size_t a_tstep, w_estride, b_tstep;
    __device__ void init(const void* A_, const void* W_, const int* blke_, int K, int nN_, size_t w_estride_bytes, int G_, int c_) { A = (const char*)A_; W = (const char*)W_; blke = blke_; nrb = __builtin_amdgcn_readfirstlane(blke_[255]); nN = nN_; G = G_; c = c_;
        a_tstep = (size_t)BM * K * 2; b_tstep = a_tstep; w_estride = w_estride_bytes; }
    __device__ bool next(int i, Unit& u) const { const long L = (long)i * G + c; if (L >= (long)nrb * nN) return false; const int rb = (int)(L / nN), pn = (int)(L % nN);
        u.pm = rb; u.pn = pn; u.A = A + (size_t)rb * a_tstep; u.B = W + (size_t)__builtin_amdgcn_readfirstlane(blke[rb]) * w_estride + (size_t)pn * b_tstep; return true; }
};
__device__ __forceinline__ unsigned ag_ld(const unsigned* p)        { return __hip_atomic_load(p, __ATOMIC_RELAXED, __HIP_MEMORY_SCOPE_AGENT); }
__device__ __forceinline__ unsigned ag_add(unsigned* p, unsigned v) { return __hip_atomic_fetch_add(p, v, __ATOMIC_RELAXED, __HIP_MEMORY_SCOPE_AGENT); }
struct MoeDepOrder { static constexpr bool DEPS = true;
    const char* A; const char* W; const int* blke; const unsigned* done; int nrb, nN, G, c; size_t a_tstep, w_estride, b_tstep;
    __device__ void init(const void* A_, const void* W_, const int* blke_, const unsigned* done_, int K, int nN_, size_t w_estride_bytes, int G_, int c_) { A = (const char*)A_; W = (const char*)W_; blke = blke_; done = done_;
        nrb = __builtin_amdgcn_readfirstlane(blke_[255]); nN = nN_; G = G_; c = c_; a_tstep = (size_t)BM * K * 2; b_tstep = a_tstep; w_estride = w_estride_bytes; }
    __device__ bool next(int i, Unit& u) const { const long L = (long)i * G + c; if (L >= (long)nrb * nN) return false; const int rb = (int)(L / nN), pn = (int)(L % nN);
        u.pm = rb; u.pn = pn; u.A = A + (size_t)rb * a_tstep; u.B = W + (size_t)__builtin_amdgcn_readfirstlane(blke[rb]) * w_estride + (size_t)pn * b_tstep; return true; }
    __device__ void wait(const Unit& u, int wid) const {
        if (wid == 0 && lane_now() == 0) { while (ag_ld(done + u.pm) < 4u) __builtin_amdgcn_s_sleep(1); __builtin_amdgcn_fence(__ATOMIC_ACQUIRE, "agent"); } }
};
struct RangeOrder { static constexpr bool DEPS = false;
    const char* A; const char* Bt; int nM, nN, j0, n; size_t tstep;
    __device__ void init(const void* A_, const void* Bt_, int M, int N, int K, int j0_, int n_) { A = (const char*)A_; Bt = (const char*)Bt_; nM = M / BM; nN = N / BM; j0 = j0_; n = n_; tstep = (size_t)BM * K * 2; }
    __device__ bool next(int i, Unit& u) const { if (i >= n) return false; int pm, pn; static_map(j0 + i, nM, nN, pm, pn); u.pm = pm; u.pn = pn; u.A = A + (size_t)pm * tstep; u.B = Bt + (size_t)pn * tstep; return true; }
};
__device__ __forceinline__ unsigned cvt_pk_bf16(float lo, float hi) { return pk2(lo, hi); }
struct EpiBf16 { static constexpr bool PERM = true, ACC_INIT = false, SIGNAL = false; bf16* O; int ldc;
    __device__ __forceinline__ void operator()(const f32x4 (&acc)[2][2][4][2], const Unit& u, int wr, int wc, int, int) const {
        const int t2 = lane_now(), fr = t2 & 15, fq = t2 >> 4;
        const int row0 = u.pm * BM + wr * 64 + fr, col0 = u.pn * BM + wc * 32 + 8 * fq;
#pragma unroll
        for (int ai = 0; ai < 2; ++ai)
#pragma unroll
            for (int m = 0; m < 4; ++m) { bf16* rowp = O + (size_t)(row0 + ai * HALF + m * 16) * ldc + col0;
#pragma unroll
                for (int bj = 0; bj < 2; ++bj) { const f32x4 v0 = acc[ai][bj][m][0], v1 = acc[ai][bj][m][1];
                    u32x4 w; w.x = cvt_pk_bf16(v0[0], v0[1]); w.y = cvt_pk_bf16(v0[2], v0[3]); w.z = cvt_pk_bf16(v1[0], v1[1]); w.w = cvt_pk_bf16(v1[2], v1[3]);
                    *(u32x4*)(rowp + bj * HALF) = w; } }
    } };
struct EpiResid { static constexpr bool PERM = true, ACC_INIT = true, SIGNAL = false; bf16* h;
    __device__ __forceinline__ void init(f32x4 (&acc)[2][2][4][2], const Unit& u, int wr, int wc, int fr, int fq) const {
        const int row0 = u.pm * BM + wr * 64 + fr, col0 = u.pn * BM + wc * 32 + 8 * fq;
#pragma unroll
        for (int ai = 0; ai < 2; ++ai)
#pragma unroll
            for (int m = 0; m < 4; ++m) { const bf16* rowp = h + (size_t)(row0 + ai * HALF + m * 16) * D + col0;
#pragma unroll
                for (int bj = 0; bj < 2; ++bj) { const u32x4 x = *(const u32x4*)(rowp + bj * HALF);
                    acc[ai][bj][m][0] = (f32x4){bflo(x.x), bfhi(x.x), bflo(x.y), bfhi(x.y)}; acc[ai][bj][m][1] = (f32x4){bflo(x.z), bfhi(x.z), bflo(x.w), bfhi(x.w)}; } }
    }
    __device__ __forceinline__ void operator()(const f32x4 (&acc)[2][2][4][2], const Unit& u, int wr, int wc, int fr, int fq) const {
        asm volatile("" : "+v"(fr), "+v"(fq));
        const int row0 = u.pm * BM + wr * 64 + fr, col0 = u.pn * BM + wc * 32 + 8 * fq;
#pragma unroll
        for (int ai = 0; ai < 2; ++ai)
#pragma unroll
            for (int m = 0; m < 4; ++m) { bf16* rowp = h + (size_t)(row0 + ai * HALF + m * 16) * D + col0;
#pragma unroll
                for (int bj = 0; bj < 2; ++bj) { const f32x4 v0 = acc[ai][bj][m][0], v1 = acc[ai][bj][m][1];
                    u32x4 w; w.x = cvt_pk_bf16(v0[0], v0[1]); w.y = cvt_pk_bf16(v0[2], v0[3]); w.z = cvt_pk_bf16(v1[0], v1[1]); w.w = cvt_pk_bf16(v1[2], v1[3]);
                    *(u32x4*)(rowp + bj * HALF) = w; } }
    } };
struct EpiGateUp { static constexpr bool PERM = true, ACC_INIT = false, SIGNAL = false; bf16* H;
    __device__ __forceinline__ void operator()(const f32x4 (&acc)[2][2][4][2], const Unit& u, int wr, int wc, int, int) const {
        const int t2 = lane_now(), fr = t2 & 15, fq = t2 >> 4;
        const int row0 = u.pm * BM + wr * 64 + fr, col0 = u.pn * HALF + wc * 32 + 8 * fq;
#pragma unroll
        for (int ai = 0; ai < 2; ++ai)
#pragma unroll
            for (int m = 0; m < 4; ++m) { bf16* rowp = H + (size_t)(row0 + ai * HALF + m * 16) * DE + col0; float v[8];
#pragma unroll
                for (int n = 0; n < 2; ++n)
#pragma unroll
                    for (int j = 0; j < 4; ++j) v[4 * n + j] = silu_(acc[ai][0][m][n][j]) * acc[ai][1][m][n][j];
                u32x4 w; w.x = cvt_pk_bf16(v[0], v[1]); w.y = cvt_pk_bf16(v[2], v[3]); w.z = cvt_pk_bf16(v[4], v[5]); w.w = cvt_pk_bf16(v[6], v[7]);
                *(u32x4*)rowp = w; }
    } };
struct EpiGateUpPub { static constexpr bool PERM = true, ACC_INIT = false, SIGNAL = true; __amdgpu_buffer_rsrc_t rs; unsigned* done;
    __device__ __forceinline__ void operator()(const f32x4 (&acc)[2][2][4][2], const Unit& u, int wr, int wc, int fr, int fq) const {
        asm volatile("" : "+v"(fr), "+v"(fq));
        const int row0 = u.pm * BM + wr * 64 + fr, col0 = u.pn * HALF + wc * 32 + 8 * fq;
#pragma unroll
        for (int ai = 0; ai < 2; ++ai)
#pragma unroll
            for (int m = 0; m < 4; ++m) { const unsigned off = (unsigned)(((row0 + ai * HALF + m * 16) * DE + col0) * 2); float v[8];
#pragma unroll
                for (int n = 0; n < 2; ++n)
#pragma unroll
                    for (int j = 0; j < 4; ++j) v[4 * n + j] = silu_(acc[ai][0][m][n][j]) * acc[ai][1][m][n][j];
                u32x4 w; w.x = cvt_pk_bf16(v[0], v[1]); w.y = cvt_pk_bf16(v[2], v[3]); w.z = cvt_pk_bf16(v[4], v[5]); w.w = cvt_pk_bf16(v[6], v[7]);
                __builtin_amdgcn_raw_buffer_store_b128(w, rs, off, 0, 16); }
    }
    __device__ __forceinline__ void signal(const Unit& u) const { (void)ag_add(done + u.pm, 1u); }
};
struct EpiPG { static constexpr bool PERM = true, ACC_INIT = false, SIGNAL = false; bf16* h; const bf16* PE; const float* rstd_pe; const float* norm_pe;
    __device__ __forceinline__ void operator()(const f32x4 (&acc)[2][2][4][2], const Unit& u, int wr, int wc, int fr, int fq) const {
        asm volatile("" : "+v"(fr), "+v"(fq));
        const int row0 = u.pm * BM + wr * 64 + fr, col0 = u.pn * BM + wc * 32 + 8 * fq;
        f32x4 nv[2][2];
#pragma unroll
        for (int bj = 0; bj < 2; ++bj)
#pragma unroll
            for (int n = 0; n < 2; ++n) nv[bj][n] = *(const f32x4*)(norm_pe + col0 + bj * HALF + 4 * n);
#pragma unroll
        for (int ai = 0; ai < 2; ++ai)
#pragma unroll
            for (int m = 0; m < 4; ++m) { const int row = row0 + ai * HALF + m * 16; const float rs = rstd_pe[row];
#pragma unroll
                for (int bj = 0; bj < 2; ++bj) { const size_t o = (size_t)row * D + col0 + bj * HALF; const u32x4 pe = *(const u32x4*)(PE + o); const u32x4 hx = *(const u32x4*)(h + o);
                    f32x4 h0 = (f32x4){bflo(hx.x), bfhi(hx.x), bflo(hx.y), bfhi(hx.y)}, h1 = (f32x4){bflo(hx.z), bfhi(hx.z), bflo(hx.w), bfhi(hx.w)}; const f32x4 a0 = acc[ai][bj][m][0], a1 = acc[ai][bj][m][1];
                    const f32x4 e0 = (f32x4){bflo(pe.x), bfhi(pe.x), bflo(pe.y), bfhi(pe.y)} * rs * nv[bj][0], e1 = (f32x4){bflo(pe.z), bfhi(pe.z), bflo(pe.w), bfhi(pe.w)} * rs * nv[bj][1];
                    h0 += (f32x4){sigmoid_(a0[0]), sigmoid_(a0[1]), sigmoid_(a0[2]), sigmoid_(a0[3])} * e0; h1 += (f32x4){sigmoid_(a1[0]), sigmoid_(a1[1]), sigmoid_(a1[2]), sigmoid_(a1[3])} * e1;
                    u32x4 w; w.x = pk2(h0[0], h0[1]); w.y = pk2(h0[2], h0[3]); w.z = pk2(h1[0], h1[1]); w.w = pk2(h1[2], h1[3]); *(u32x4*)(h + o) = w; } }
    } };

template <class Epi, class Sched>
__device__ __forceinline__ void gemm_phase(int wave, LAS unsigned char* lds, int K, const Sched& S, const Epi& E) {
    int wid = wave; asm volatile("" : "+s"(wid));
    const int lane = lane_now(), tid = (wid << 6) | lane, wr = wid >> 2, wc = wid & 3, fr = lane & 15, fq = lane >> 4;
    const int nt = K / BK;
    unsigned voffA[2], voffB[2];
#pragma unroll
    for (int i = 0; i < 2; ++i) { int R, C; stage_rc(tid * 16 + i * 8192, R, C); const int Rb = Epi::PERM ? ((R & ~31) + perm32(R & 31)) : R;
        voffA[i] = (unsigned)(R * K + C) * 2u; voffB[i] = (unsigned)(Rb * K + C) * 2u; }
    const size_t kstep = (size_t)(BK * 2);
    const size_t hstep = (size_t)HALF * K * 2;
    const unsigned ldsw = (unsigned)wid * 1024u;
    const int aoff = lds_byte(wr * 64 + fr, fq * 8), boff = lds_byte(wc * 32 + fr, fq * 8);
#define PG8_SA(b, h) (((b) * 2 + (h)) * HTB)
#define PG8_SB(b, h) ((4 + (b) * 2 + (h)) * HTB)
#define PG8_STAGE(bufoff, gbase, voff) do { _Pragma("unroll") for (int _i = 0; _i < 2; ++_i) \
        __builtin_amdgcn_global_load_lds((const unsigned*)((const char*)(gbase) + (voff)[_i]), (LAS unsigned*)(lds + (bufoff) + ldsw + _i * 8192), 16, 0, 0); } while (0)
#define PG8_LDA(dst, b, h) do { _Pragma("unroll") for (int m = 0; m < 4; ++m) _Pragma("unroll") for (int k = 0; k < 2; ++k) dst[m][k] = *(const LAS bf16x8*)(lds + PG8_SA(b, h) + aoff + m * 2048 + k * 1024); } while (0)
#define PG8_LDB(dst, b, h) do { _Pragma("unroll") for (int n = 0; n < 2; ++n) _Pragma("unroll") for (int k = 0; k < 2; ++k) dst[n][k] = *(const LAS bf16x8*)(lds + PG8_SB(b, h) + boff + n * 2048 + k * 1024); } while (0)
#define PG8_MMA(ai, bj, At, Bt) do { __builtin_amdgcn_s_setprio(1); _Pragma("unroll") for (int m = 0; m < 4; ++m) _Pragma("unroll") for (int n = 0; n < 2; ++n) _Pragma("unroll") for (int k = 0; k < 2; ++k) \
        acc[ai][bj][m][n] = __builtin_amdgcn_mfma_f32_16x16x32_bf16(Bt[n][k], At[m][k], acc[ai][bj][m][n], 0, 0, 0); __builtin_amdgcn_s_setprio(0); } while (0)
#define PG8_WAIT_V(n) asm volatile("s_waitcnt vmcnt(" #n ")" ::: "memory")
#define PG8_WAIT_L(n) asm volatile("s_waitcnt lgkmcnt(" #n ")" ::: "memory")
#define PG8_BAR __builtin_amdgcn_s_barrier()
#define PG8_SCHED __builtin_amdgcn_sched_barrier(0)
    Unit cur, nxt; int ui = 0;
    if (!S.next(0, cur)) return;
    if constexpr (Sched::DEPS) { S.wait(cur, wid); PG8_BAR; }
    f32x4 acc[2][2][4][2];
    if constexpr (Epi::ACC_INIT) E.init(acc, cur, wr, wc, fr, fq);
    else {
#pragma unroll
    for (int a = 0; a < 2; ++a)
#pragma unroll
        for (int b = 0; b < 2; ++b)
#pragma unroll
            for (int m = 0; m < 4; ++m)
#pragma unroll
                for (int n = 0; n < 2; ++n) acc[a][b][m][n] = (f32x4){0.f, 0.f, 0.f, 0.f}; }
    bf16x8 At[4][2], B0[2][2], B1[2][2];
    const char* cA = cur.A; const char* cB = cur.B;
    PG8_STAGE(PG8_SB(0, 0), cB, voffB); PG8_STAGE(PG8_SB(0, 1), cB + hstep, voffB); PG8_STAGE(PG8_SA(0, 0), cA, voffA); PG8_STAGE(PG8_SA(0, 1), cA + hstep, voffA);
    if (wr == 1) PG8_BAR;
    PG8_WAIT_V(2); PG8_BAR;
    PG8_STAGE(PG8_SB(1, 0), cB + kstep, voffB); PG8_STAGE(PG8_SA(1, 0), cA + kstep, voffA); PG8_STAGE(PG8_SB(1, 1), cB + hstep + kstep, voffB);
    PG8_WAIT_V(6); PG8_BAR;
    for (;;) {
        const bool has_next = S.next(ui + 1, nxt);
        const char* nA = has_next ? nxt.A : cA; const char* nB = has_next ? nxt.B : cB;
        for (int t = 0; t < nt; t += 2) {
            const bool last = (t == nt - 2);
            if constexpr (Sched::DEPS) { if (last && has_next) S.wait(nxt, wid); }
            const char* a1 = cA + (size_t)(t + 1) * kstep;
            const char* a2 = last ? nA : cA + (size_t)(t + 2) * kstep; const char* b2 = last ? nB : cB + (size_t)(t + 2) * kstep;
            const char* a3 = a2 + kstep; const char* b3 = b2 + kstep;
            PG8_LDB(B0, 0, 0); PG8_LDB(B1, 0, 1); PG8_SCHED; PG8_LDA(At, 0, 0); PG8_STAGE(PG8_SA(1, 1), a1 + hstep, voffA);
            PG8_WAIT_V(8); PG8_WAIT_L(0); PG8_BAR; PG8_MMA(0, 0, At, B0); PG8_MMA(0, 1, At, B1); PG8_BAR; PG8_SCHED;
            PG8_LDA(At, 0, 1); PG8_STAGE(PG8_SB(0, 0), b2, voffB); PG8_STAGE(PG8_SB(0, 1), b2 + hstep, voffB); PG8_STAGE(PG8_SA(0, 0), a2, voffA);
            PG8_WAIT_V(8); PG8_WAIT_L(0); PG8_BAR; PG8_MMA(1, 0, At, B0); PG8_MMA(1, 1, At, B1); PG8_BAR; PG8_SCHED;
            PG8_LDB(B0, 1, 0); PG8_LDB(B1, 1, 1); PG8_SCHED; PG8_LDA(At, 1, 0); PG8_STAGE(PG8_SA(0, 1), a2 + hstep, voffA);
            PG8_WAIT_V(8); PG8_WAIT_L(0); PG8_BAR; PG8_MMA(0, 0, At, B0); PG8_MMA(0, 1, At, B1); PG8_BAR; PG8_SCHED;
            PG8_LDA(At, 1, 1); PG8_STAGE(PG8_SB(1, 0), b3, voffB); PG8_STAGE(PG8_SB(1, 1), b3 + hstep, voffB); PG8_STAGE(PG8_SA(1, 0), a3, voffA);
            PG8_WAIT_V(8); PG8_WAIT_L(0); PG8_BAR; PG8_MMA(1, 0, At, B0); PG8_MMA(1, 1, At, B1); PG8_BAR; PG8_SCHED;
        }
        if (wr == 0) PG8_BAR;
        E(acc, cur, wr, wc, fr, fq);
        if constexpr (Epi::SIGNAL) { PG8_WAIT_V(0); PG8_BAR; if (tid == 0) E.signal(cur); }
        if (!has_next) break;
        if constexpr (Epi::ACC_INIT) E.init(acc, nxt, wr, wc, fr, fq);
        else {
#pragma unroll
        for (int a = 0; a < 2; ++a)
#pragma unroll
            for (int b = 0; b < 2; ++b)
#pragma unroll
                for (int m = 0; m < 4; ++m)
#pragma unroll
                    for (int n = 0; n < 2; ++n) acc[a][b][m][n] = (f32x4){0.f, 0.f, 0.f, 0.f}; }
        cur = nxt; cA = nA; cB = nB; ++ui;
        if (wr == 1) PG8_BAR;
    }
    PG8_WAIT_V(0);
    PG8_BAR;
#undef PG8_SA
#undef PG8_SB
#undef PG8_STAGE
#undef PG8_LDA
#undef PG8_LDB
#undef PG8_MMA
#undef PG8_WAIT_V
#undef PG8_WAIT_L
#undef PG8_BAR
#undef PG8_SCHED
}
}

__device__ __forceinline__ void phase_gemm_pe(const Frame& F) {
    pg8::DenseOrder S; S.init(F.ws + WS_PB, F.ws + WS_WPE, T, D, PD, DEPTH, F.G, F.blk); pg8::EpiBf16 E{(bf16*)(F.ws + WS_PE), D};
    pg8::gemm_phase(F.wave, F.lds, PD, S, E);
}
__device__ __forceinline__ void phase_gemm_in(const Frame& F, int l) {
    pg8::DenseOrder S; S.init(F.ws + WS_XN, (bf16*)(F.ws + WS_WIN) + (size_t)l * DIN * D, T, DIN, D, 1, F.G, F.blk); pg8::EpiBf16 E{(bf16*)(F.ws + WS_Z), DIN};
    pg8::gemm_phase(F.wave, F.lds, D, S, E);
}
__device__ __forceinline__ void phase_gemm_out(const Frame& F, int l) {
    pg8::DenseOrder S; S.init(F.ws + WS_O, (bf16*)(F.ws + WS_WOUT) + (size_t)l * D * D, T, D, D, 1, F.G, F.blk); pg8::EpiResid E{(bf16*)(F.ws + WS_H)};
    pg8::gemm_phase(F.wave, F.lds, D, S, E);
}
__device__ __forceinline__ void phase_gemm_moe1(const Frame& F, int l) {
    pg8::MoeOrder S; S.init(F.ws + WS_XB, (bf16*)(F.ws + WS_WGU) + (size_t)l * NE * 1024 * 1024, (const int*)(F.ws + MS_BLKE) + l * 256, D, 4, (size_t)1024 * 1024 * 2, F.G, F.blk); pg8::EpiGateUp E{(bf16*)(F.ws + WS_HB)};
    pg8::gemm_phase(F.wave, F.lds, D, S, E);
    { const int nun = S.nrb * 4, rem = nun % F.G, few = (rem == 0 || F.G - rem < 64), idle = few ? F.G : F.G - rem, first = few ? 0 : rem;
      if (F.blk >= first) { pg8::DenseOrder P; P.init((const bf16*)(F.ws + WS_PB) + (size_t)l * T * PD, (const bf16*)(F.ws + WS_WPE) + (size_t)l * D * PD, T, D, PD, 1, idle, F.blk - first);
          pg8::EpiBf16 EP{(bf16*)(F.ws + WS_PE) + (size_t)l * T * D, D}; pg8::gemm_phase(F.wave, F.lds, PD, P, EP); }
      conv_deferred(F, l + 1, 0, NDEF1, first, idle); }
}
__device__ __forceinline__ void phase_gemm_moe2(const Frame& F, int l) {
    pg8::MoeOrder S; S.init(F.ws + WS_HB, (bf16*)(F.ws + WS_WD) + (size_t)l * NE * D * DE, (const int*)(F.ws + MS_BLKE) + l * 256, DE, 4, (size_t)D * DE * 2, F.G, F.blk); pg8::EpiBf16 E{(bf16*)(F.ws + WS_Y), D};
    pg8::gemm_phase(F.wave, F.lds, DE, S, E);
    { const int nun = S.nrb * 4, rem = nun % F.G, few = (rem == 0 || F.G - rem < 64), idle = few ? F.G : F.G - rem, first = few ? 0 : rem;
      conv_deferred(F, l + 1, NDEF1, NDEF, first, idle); }
}
#ifndef MOE_CPE
#define MOE_CPE 5
#endif
#ifndef MOE_CTL
#define MOE_CTL 4
#endif
#ifndef MOE_X1
#define MOE_X1 16
#define MOE_X2 8
#endif
template <int MODE = 0> __device__ __forceinline__ void phase_moe_fused(const Frame& F, int l) {
    unsigned char* ws = F.ws; const int G = F.G, blk = F.blk;
    const int* blke = (const int*)(ws + MS_BLKE) + l * 256;
    unsigned* done = (unsigned*)(ws + WS_CTL) + CW_DONE + l * 256;
    const int nrb = __builtin_amdgcn_readfirstlane(blke[255]), nu = 4 * nrb, e1 = nu % G;
    if constexpr (MODE == 1) { pg8::MoeOrder S; S.init(ws + WS_XB, (bf16*)(ws + WS_WGU) + (size_t)l * NE * 1024 * 1024, blke, D, 4, (size_t)1024 * 1024 * 2, G, blk);
      pg8::EpiGateUp E{(bf16*)(ws + WS_HB)}; pg8::gemm_phase(F.wave, F.lds, D, S, E); return; }
    if constexpr (MODE == 0) { pg8::MoeOrder S; S.init(ws + WS_XB, (bf16*)(ws + WS_WGU) + (size_t)l * NE * 1024 * 1024, blke, D, 4, (size_t)1024 * 1024 * 2, G, blk);
      pg8::EpiGateUpPub E{__builtin_amdgcn_make_buffer_rsrc(ws + WS_HB, 0, (int)((size_t)CAP * DE * 2), 0x00020000), done};
      pg8::gemm_phase(F.wave, F.lds, D, S, E); }
    if constexpr (MODE == 2) { pg8::MoeOrder S; S.init(ws + WS_HB, (bf16*)(ws + WS_WD) + (size_t)l * NE * D * DE, blke, DE, 4, (size_t)D * DE * 2, G, blk >= e1 ? blk - e1 : blk - e1 + G);
      pg8::EpiBf16 E{(bf16*)(ws + WS_Y), D}; pg8::gemm_phase(F.wave, F.lds, DE, S, E); }
    if constexpr (MODE == 0) { pg8::MoeDepOrder S; S.init(ws + WS_HB, (bf16*)(ws + WS_WD) + (size_t)l * NE * D * DE, blke, done, DE, 4, (size_t)D * DE * 2, G, blk >= e1 ? blk - e1 : blk - e1 + G);
      pg8::EpiBf16 E{(bf16*)(ws + WS_Y), D};
      pg8::gemm_phase(F.wave, F.lds, DE, S, E); }
    { const int nt = (l + 1 < DEPTH) ? NDEF : 0, ftot = 256 * MOE_CPE + nt * MOE_CTL;
      const int wrap = 2 * e1 > G ? 2 * e1 - G : 0;
      auto cls = [&](int x, int& c24, int& c16, int& c8, int& c0) {
          const int cA = x < e1 ? x : e1, cAB = x < wrap ? x : wrap;
          int cB = x - e1; cB = cB < 0 ? 0 : cB; if (!wrap) cB = cB > e1 ? e1 : cB; cB += cAB;
          c24 = cAB; c16 = cA - cAB; c8 = cB - cAB; c0 = x - c24 - c16 - c8; };
      auto fill = [&](int x, int lv) { int c24, c16, c8, c0; cls(x, c24, c16, c8, c0);
          return c0 * lv + c8 * (lv > MOE_X2 ? lv - MOE_X2 : 0) + c16 * (lv > MOE_X1 ? lv - MOE_X1 : 0) + c24 * (lv > MOE_X1 + MOE_X2 ? lv - MOE_X1 - MOE_X2 : 0); };
      int lv = 1; while (fill(G, lv) < ftot) ++lv;
      const int B0 = fill(blk, lv), B1 = fill(blk + 1, lv);
      const int pe_tot = 256 * MOE_CPE;
      int j0 = (B0 + MOE_CPE - 1) / MOE_CPE, j1 = (B1 + MOE_CPE - 1) / MOE_CPE; j0 = j0 < 256 ? j0 : 256; j1 = j1 < 256 ? j1 : 256;
      int t0 = B0 > pe_tot ? (B0 - pe_tot + MOE_CTL - 1) / MOE_CTL : 0, t1 = B1 > pe_tot ? (B1 - pe_tot + MOE_CTL - 1) / MOE_CTL : 0; t0 = t0 < nt ? t0 : nt; t1 = t1 < nt ? t1 : nt;
      if (j1 > j0) { pg8::RangeOrder P; P.init((const bf16*)(ws + WS_PB) + (size_t)l * T * PD, (const bf16*)(ws + WS_WPE) + (size_t)l * D * PD, T, D, PD, j0, j1 - j0);
          pg8::EpiBf16 EP{(bf16*)(ws + WS_PE) + (size_t)l * T * D, D}; pg8::gemm_phase(F.wave, F.lds, PD, P, EP); }
      if (t1 > t0) { const int base = (l + 1) * TL_LAYER + t0; conv_run(F, 0, 1, t1 - t0, [=](int f) { return base + f; }); } }
}
__device__ __forceinline__ void phase_gemm_pg(const Frame& F, int l) {
    pg8::DenseOrder S; S.init(F.ws + WS_XN, (bf16*)(F.ws + WS_WPG) + (size_t)l * D * D, T, D, D, 1, F.G, F.blk);
    pg8::EpiPG E{(bf16*)(F.ws + WS_H), (const bf16*)(F.ws + WS_PE) + (size_t)l * T * D, (const float*)(F.ws + MS_RSTDPE), F.in[22] + l * D};
    pg8::gemm_phase(F.wave, F.lds, D, S, E);
}

typedef short s16x4 __attribute__((ext_vector_type(4)));
__device__ __forceinline__ bf16x8 tr_frag(LAS unsigned char* p_lo, LAS unsigned char* p_hi) {
    const s16x4 lo = __builtin_amdgcn_ds_read_tr16_b64_v4i16((LAS s16x4*)p_lo), hi = __builtin_amdgcn_ds_read_tr16_b64_v4i16((LAS s16x4*)p_hi);
    return __builtin_shufflevector(lo, hi, 0, 1, 2, 3, 4, 5, 6, 7); }
#define MFMA16(a, b, c) __builtin_amdgcn_mfma_f32_16x16x32_bf16((a), (b), (c), 0, 0, 0)
constexpr int RP = 272;
constexpr int VP = 1040;

__device__ __forceinline__ void phase_rec_c1(const Frame& F, int l) {
    PH_TID();
    unsigned char* ws = F.ws; const bf16* Z = (const bf16*)(ws + WS_Z);
    bf16* UT = (bf16*)(ws + WS_UT); float* DC = (float*)(ws + MS_DC); float* MM = (float*)(ws + MS_MM);
    const float* lb = (const float*)(ws + MS_LB) + l * DREC;
    LAS unsigned char* KD = F.lds; LAS unsigned char* IM = F.lds + 128 * RP; LAS float* totx = (LAS float*)(F.lds + 256 * RP);
    const int wave = ph_wave, ch = tid & 255, half = tid >> 8, hl = ch >> 7, k = ch & 127, g = lane >> 4, li = lane & 15, q = li >> 2, p = li & 3;
    const int hG = F.G / 2, nmine = (F.G == 256) ? (F.blk < hG ? 3 : 1) : 0;
    for (int ui = 0; (F.G == 256) ? (ui < nmine) : (F.blk + ui * F.G < 512); ++ui) {
        const int unit = (F.G == 256) ? (F.blk < hG ? F.blk + ui * hG : 3 * hG + (F.blk - hG)) : F.blk + ui * F.G;
        const int c = unit >> 1, hp = unit & 1, hh = 2 * hp + hl;
        const bf16* zb = Z + (size_t)(c * 64 + 32 * half) * DIN + 512 + hh * 128 + k;
        const float lbk = lb[hh * 128 + k];
        float cs[32], kk[32]; float run = 1.f;
#pragma unroll
        for (int t = 0; t < 32; ++t) { const float fz = bf2f(zb[(size_t)t * DIN]); const float sg = sigmoid_(fz); run *= lbk + (1.f - lbk) * sg; cs[t] = run; kk[t] = (1.f - lbk) * (1.f - sg); }
        totx[half * 256 + ch] = run;
#pragma unroll
        for (int j = 0; j < 4; ++j) { const int idx = tid + 512 * j, hl2 = idx >> 10, row = (idx >> 4) & 63, cc = idx & 15;
            const u32x4 v = *(const u32x4*)(Z + (size_t)(c * 64 + row) * DIN + 1024 + (2 * hp + hl2) * 128 + cc * 8);
            *(LAS u32x4*)(IM + (hl2 * 64 + row) * RP + cc * 16) = v; }
        __syncthreads();
        const float other = totx[(1 - half) * 256 + ch]; const float p63 = run * other; const float base_p = half == 0 ? p63 : run;
#pragma unroll
        for (int t = 0; t < 32; ++t) *(LAS bf16*)(KD + (hl * 64 + 32 * half + t) * RP + 2 * k) = (bf16)f2bf(kk[t] * base_p * frcp(fmaxf(cs[t], 1e-30f)));
        if (half == 0) { DC[(c * 4 + hh) * 128 + k] = p63; MM[(c * 4 + hh) * 128 + k] = run; }
        __syncthreads();
        { const int whl = wave >> 2, kt0 = 2 * (wave & 3), whh = 2 * hp + whl;
          f32x4 acc[2][8];
#pragma unroll
          for (int i = 0; i < 2; ++i)
#pragma unroll
              for (int vt = 0; vt < 8; ++vt) acc[i][vt] = (f32x4){0.f, 0.f, 0.f, 0.f};
          LAS unsigned char* kdb = KD + whl * 64 * RP; LAS unsigned char* imb = IM + whl * 64 * RP;
#pragma unroll
          for (int a = 0; a < 2; ++a) { const unsigned ro = (unsigned)((32 * a + 8 * g + q) * RP);
              bf16x8 Af[2];
#pragma unroll
              for (int i = 0; i < 2; ++i) { const unsigned co = (unsigned)((16 * (kt0 + i) + 4 * p) * 2); Af[i] = tr_frag(kdb + ro + co, kdb + ro + 4 * RP + co); }
#pragma unroll
              for (int vt = 0; vt < 8; ++vt) { const unsigned co = (unsigned)((16 * vt + 4 * p) * 2); const bf16x8 Bf = tr_frag(imb + ro + co, imb + ro + 4 * RP + co);
#pragma unroll
                  for (int i = 0; i < 2; ++i) acc[i][vt] = MFMA16(Af[i], Bf, acc[i][vt]); } }
#pragma unroll
          for (int i = 0; i < 2; ++i)
#pragma unroll
              for (int vt = 0; vt < 8; ++vt) { u32x2 w; w.x = pg8::cvt_pk_bf16(acc[i][vt][0], acc[i][vt][1]); w.y = pg8::cvt_pk_bf16(acc[i][vt][2], acc[i][vt][3]);
                  *(u32x2*)(UT + ((size_t)(c * 4 + whh) * 128 + 16 * vt + li) * 128 + 16 * (kt0 + i) + 4 * g) = w; } }
        __syncthreads();
    }
}
__device__ __forceinline__ void phase_rec_c2a(const Frame& F) {
    PH_TID();
    unsigned char* ws = F.ws; const unsigned* UT = (const unsigned*)(ws + WS_UT); const float* DC = (const float*)(ws + MS_DC);
    f32x2* LT = (f32x2*)(ws + WS_LTOT); float* PT = (float*)(ws + MS_PTOT);
    for (int it = F.blk * NTHR + tid; it < 16 * 32768; it += F.G * NTHR) {
        const int gs = it >> 15, e = it & 32767, hh = e >> 13, v = (e >> 6) & 127, k0 = 2 * (e & 63);
        float S0 = 0.f, S1 = 0.f, P0 = 1.f, P1 = 1.f;
#pragma unroll
        for (int cc = 0; cc < 16; ++cc) { const int c = 16 * gs + cc; const unsigned u = UT[(size_t)c * 32768 + e]; const f32x2 d = *(const f32x2*)(DC + (c * 4 + hh) * 128 + k0);
            S0 = d.x * S0 + bflo(u); S1 = d.y * S1 + bfhi(u); P0 *= d.x; P1 *= d.y; }
        LT[it] = (f32x2){S0, S1};
        if (v == 0) *(f32x2*)(PT + (gs * 4 + hh) * 128 + k0) = (f32x2){P0, P1};
    }
}
__device__ __forceinline__ void phase_rec_c2c(const Frame& F) {
    PH_TID();
    unsigned char* ws = F.ws; const unsigned* UT = (const unsigned*)(ws + WS_UT); unsigned* ST = (unsigned*)(ws + WS_ST); const float* DC = (const float*)(ws + MS_DC); const float* MM = (const float*)(ws + MS_MM);
    const f32x2* LT = (const f32x2*)(ws + WS_LTOT); const float* PT = (const float*)(ws + MS_PTOT);
    for (int it = F.blk * NTHR + tid; it < 16 * 32768; it += F.G * NTHR) {
        const int gs = it >> 15, e = it & 32767, hh = e >> 13, k0 = 2 * (e & 63);
        float C0 = 0.f, C1 = 0.f;
        for (int g2 = 0; g2 < gs; ++g2) { const f32x2 pt = *(const f32x2*)(PT + (g2 * 4 + hh) * 128 + k0); const f32x2 lt = LT[g2 * 32768 + e]; C0 = pt.x * C0 + lt.x; C1 = pt.y * C1 + lt.y; }
#pragma unroll
        for (int cc = 0; cc < 16; ++cc) { const int c = 16 * gs + cc; const f32x2 mm = *(const f32x2*)(MM + (c * 4 + hh) * 128 + k0);
            ST[(size_t)c * 32768 + e] = pk2(C0 * mm.x, C1 * mm.y);
            const unsigned u = UT[(size_t)c * 32768 + e]; const f32x2 d = *(const f32x2*)(DC + (c * 4 + hh) * 128 + k0);
            C0 = d.x * C0 + bflo(u); C1 = d.y * C1 + bfhi(u); }
    }
}
__device__ __forceinline__ void phase_rec_c2(const Frame& F) {
    PH_TID();
    unsigned char* ws = F.ws; const int w = ph_wave;
    LAS float* tot = (LAS float*)F.lds;
    for (int unit = F.blk; unit < 256; unit += F.G) {
        const int hh = unit >> 6; const unsigned eo = (unsigned)(unit * 128 + lane), ko = (unsigned)(hh * 128 + 2 * lane);
        const unsigned* ut = (const unsigned*)(ws + WS_UT) + (size_t)(32 * w) * 32768; unsigned* st = (unsigned*)(ws + WS_ST) + (size_t)(32 * w) * 32768;
        const float* dc = (const float*)(ws + MS_DC) + (32 * w) * 512; const float* mmp = (const float*)(ws + MS_MM) + (32 * w) * 512;
        asm volatile("" : "+s"(ut), "+s"(st), "+s"(dc), "+s"(mmp));
        unsigned ua[32], ub[32]; f32x2 d[32], m0[16], m1[16];
#pragma unroll
        for (int cc = 0; cc < 32; ++cc) { ua[cc] = (ut + cc * 32768)[eo]; ub[cc] = (ut + cc * 32768 + 64)[eo]; d[cc] = *(const f32x2*)((dc + cc * 512) + ko); }
        __builtin_amdgcn_sched_barrier(0);
        float a0 = 0.f, a1 = 0.f, b0 = 0.f, b1 = 0.f, p0 = 1.f, p1 = 1.f;
#pragma unroll
        for (int cc = 0; cc < 32; ++cc) { a0 = d[cc].x * a0 + bflo(ua[cc]); a1 = d[cc].y * a1 + bfhi(ua[cc]); b0 = d[cc].x * b0 + bflo(ub[cc]); b1 = d[cc].y * b1 + bfhi(ub[cc]); p0 *= d[cc].x; p1 *= d[cc].y; }
        { LAS float* tw = tot + w * 384 + lane; tw[0] = a0; tw[64] = a1; tw[128] = b0; tw[192] = b1; tw[256] = p0; tw[320] = p1; }
        __builtin_amdgcn_sched_barrier(0);
#pragma unroll
        for (int cc = 0; cc < 16; ++cc) m0[cc] = *(const f32x2*)((mmp + cc * 512) + ko);
        __builtin_amdgcn_sched_barrier(0);
        __syncthreads();
        float A0 = 0.f, A1 = 0.f, B0 = 0.f, B1 = 0.f;
        for (int g2 = 0; g2 < w; ++g2) { const LAS float* tw = tot + g2 * 384 + lane; const float q0 = tw[256], q1 = tw[320]; A0 = q0 * A0 + tw[0]; A1 = q1 * A1 + tw[64]; B0 = q0 * B0 + tw[128]; B1 = q1 * B1 + tw[192]; }
        __builtin_amdgcn_sched_barrier(0);
#pragma unroll
        for (int cc = 0; cc < 16; ++cc) m1[cc] = *(const f32x2*)((mmp + (16 + cc) * 512) + ko);
        __builtin_amdgcn_sched_barrier(0);
#pragma unroll
        for (int cc = 0; cc < 32; ++cc) { const f32x2 mm = cc < 16 ? m0[cc & 15] : m1[cc & 15];
            (st + cc * 32768)[eo] = pk2(A0 * mm.x, A1 * mm.y); (st + cc * 32768 + 64)[eo] = pk2(B0 * mm.x, B1 * mm.y);
            unsigned xa = ua[cc], xb = ub[cc]; asm volatile("" : "+v"(xa), "+v"(xb));
            A0 = d[cc].x * A0 + bflo(xa); A1 = d[cc].y * A1 + bfhi(xa); B0 = d[cc].x * B0 + bflo(xb); B1 = d[cc].y * B1 + bfhi(xb);
            asm volatile("" : "+v"(A0), "+v"(A1), "+v"(B0), "+v"(B1) :: "memory"); }
        __syncthreads();
    }
}
template <int PV = 0> __device__ __forceinline__ void phase_rec_c3(const Frame& F, int l) {
    PH_TID();
    unsigned char* ws = F.ws; const bf16* Z = (const bf16*)(ws + WS_Z); const bf16* ST = (const bf16*)(ws + WS_ST); bf16* O = (bf16*)(ws + WS_O);
    const float* lb = (const float*)(ws + MS_LB) + l * DREC; const float* ogain = F.in[5] + l * 128;
    LAS unsigned char* QT = F.lds; LAS unsigned char* KT = F.lds + 128 * RP; LAS unsigned char* IM = F.lds + 256 * RP;
    const int wave = ph_wave, ch = tid & 255, half = tid >> 8, hl = ch >> 7, k = ch & 127, g = lane >> 4, li = lane & 15, q = li >> 2, p = li & 3;
    for (int unit = F.blk; unit < 512; unit += F.G) {
        const int c = unit >> 1, hp = unit & 1, hh = 2 * hp + hl;
        { const bf16* zb = Z + (size_t)(c * 64 + 32 * half) * DIN + hh * 128 + k;
          const float lbk = lb[hh * 128 + k];
          float cs[32], kk[32], qs[32]; float run = 1.f;
#pragma unroll
          for (int t = 0; t < 32; ++t) { const float fz = bf2f(zb[(size_t)t * DIN + 512]); const float sg = sigmoid_(fz); run *= lbk + (1.f - lbk) * sg; cs[t] = run; kk[t] = (1.f - lbk) * (1.f - sg); qs[t] = silu_(bf2f(zb[(size_t)t * DIN])); }
          const float inv = half == 0 ? frcp(fmaxf(run, 1e-30f)) : 1.f;
#pragma unroll
          for (int t = 0; t < 32; ++t) { const float ex = cs[t] * inv; const int off = (hl * 64 + 32 * half + t) * RP + 2 * k;
              *(LAS bf16*)(QT + off) = (bf16)f2bf(qs[t] * ex); *(LAS bf16*)(KT + off) = (bf16)f2bf(kk[t] * frcp(fmaxf(ex, 1e-30f))); } }
#pragma unroll
        for (int j = 0; j < 4; ++j) { const int idx = tid + 512 * j, hl2 = idx >> 10, row = (idx >> 4) & 63, cc = idx & 15;
            const u32x4 v = *(const u32x4*)(Z + (size_t)(c * 64 + row) * DIN + 1024 + (2 * hp + hl2) * 128 + cc * 8);
            *(LAS u32x4*)(IM + (hl2 * 64 + row) * RP + cc * 16) = v; }
        const int whl = wave >> 2, tt = wave & 3, whh = 2 * hp + whl;
        bf16x8 Sf[8][4];
#pragma unroll
        for (int vt = 0; vt < 8; ++vt)
#pragma unroll
            for (int a = 0; a < 4; ++a) Sf[vt][a] = *(const bf16x8*)(ST + ((size_t)(c * 4 + whh) * 128 + 16 * vt + li) * 128 + 32 * a + 8 * g);
        __syncthreads();
        if (PV != 1) {
          bf16 gz[8][4];
#pragma unroll
          for (int vt = 0; vt < 8; ++vt)
#pragma unroll
              for (int r = 0; r < 4; ++r) gz[vt][r] = Z[((size_t)c * 64 + 16 * tt + 4 * g + r) * DIN + 1536 + whh * 128 + 16 * vt + li];
          bf16x8 Qf[4];
#pragma unroll
          for (int a = 0; a < 4; ++a) Qf[a] = *(const LAS bf16x8*)(QT + (whl * 64 + 16 * tt + li) * RP + (32 * a + 8 * g) * 2);
          unsigned pw[4][2];
#pragma unroll
          for (int st = 0; st < 4; ++st) { pw[st][0] = 0u; pw[st][1] = 0u;
              { f32x4 s = (f32x4){0.f, 0.f, 0.f, 0.f};
#pragma unroll
                  for (int a = 0; a < 4; ++a) { const bf16x8 Kf = *(const LAS bf16x8*)(KT + (whl * 64 + 16 * st + li) * RP + (32 * a + 8 * g) * 2); s = MFMA16(Kf, Qf[a], s); }
                  if (st == tt) {
#pragma unroll
                      for (int r = 0; r < 4; ++r) if (4 * g + r > li) s[r] = 0.f; }
                  pw[st][0] = st <= tt ? pg8::cvt_pk_bf16(s[0], s[1]) : 0u; pw[st][1] = st <= tt ? pg8::cvt_pk_bf16(s[2], s[3]) : 0u; } }
          f32x4 acc[8];
#pragma unroll
          for (int vt = 0; vt < 8; ++vt) { acc[vt] = (f32x4){0.f, 0.f, 0.f, 0.f};
#pragma unroll
              for (int a = 0; a < 4; ++a) acc[vt] = MFMA16(Qf[a], Sf[vt][a], acc[vt]); }
          LAS unsigned char* imb = IM + whl * 64 * RP;
#pragma unroll
          for (int a = 0; a < 2; ++a) { const u32x4 pv = (u32x4){pw[2 * a][0], pw[2 * a][1], pw[2 * a + 1][0], pw[2 * a + 1][1]}; const bf16x8 Pf = __builtin_bit_cast(bf16x8, pv);
              const unsigned ro = (unsigned)((32 * a + 4 * g + q) * RP);
#pragma unroll
              for (int vt = 0; vt < 8; ++vt) { const unsigned co = (unsigned)((16 * vt + 4 * p) * 2); const bf16x8 If = tr_frag(imb + ro + co, imb + ro + 16 * RP + co); acc[vt] = MFMA16(Pf, If, acc[vt]); } }
          float rs[4];
#pragma unroll
          for (int r = 0; r < 4; ++r) { float ss = 0.f;
#pragma unroll
              for (int vt = 0; vt < 8; ++vt) ss += acc[vt][r] * acc[vt][r];
              ss += shx<1>(ss); ss += shx<2>(ss); ss += shx<4>(ss); ss += shx<8>(ss); rs[r] = frsq(ss * (1.f / 128.f) + EPS); }
#pragma unroll
          for (int vt = 0; vt < 8; ++vt) { const float og = ogain[16 * vt + li];
#pragma unroll
              for (int r = 0; r < 4; ++r) { const size_t t = (size_t)c * 64 + 16 * tt + 4 * g + r; const float gv = bf2f(gz[vt][r]);
                  O[t * D + whh * 128 + 16 * vt + li] = (bf16)f2bf(acc[vt][r] * rs[r] * og * silu_(gv)); } } }
        __syncthreads();
    }
}
__device__ __forceinline__ void phase_sgu(const Frame& F, int l) {
    PH_TID();
    unsigned char* ws = F.ws; const bf16* Z = (const bf16*)(ws + WS_Z); bf16* O = (bf16*)(ws + WS_O);
    const bf16* Wb = (const bf16*)(ws + MS_SGUW) + (size_t)l * 4 * 128 * 128; const float* sb = F.in[9] + l * 4 * 128;
    LAS unsigned char* VN = F.lds;
    const int wave = ph_wave, g = lane >> 4, li = lane & 15, q = li >> 2, p = li & 3;
    for (int unit = (F.blk + F.G / 2) % F.G; unit < 128; unit += F.G) {
        float lg[8], lbv[8];
#pragma unroll
        for (int j = 0; j < 8; ++j) { lg[j] = F.in[6][l * DSGU + 8 * lane + j]; lbv[j] = F.in[7][l * DSGU + 8 * lane + j]; }
        u32x4 raw[16];
#pragma unroll
        for (int i = 0; i < 16; ++i) raw[i] = *(const u32x4*)(Z + ((size_t)unit * 128 + 16 * wave + i) * DIN + 2560 + 8 * lane);
#pragma unroll
        for (int i = 0; i < 16; ++i) { const int s = 16 * wave + i; const u32x4 r = raw[i];
            float x[8] = {gelu_(bflo(r.x)), gelu_(bfhi(r.x)), gelu_(bflo(r.y)), gelu_(bfhi(r.y)), gelu_(bflo(r.z)), gelu_(bfhi(r.z)), gelu_(bflo(r.w)), gelu_(bfhi(r.w))};
            float sm = 0.f;
#pragma unroll
            for (int j = 0; j < 8; ++j) sm += x[j];
            const float mu = wave_sum(sm) * (1.f / 512.f); float qq = 0.f;
#pragma unroll
            for (int j = 0; j < 8; ++j) { x[j] -= mu; qq += x[j] * x[j]; }
            const float rstd = frsq(wave_sum(qq) * (1.f / 512.f) + EPS);
#pragma unroll
            for (int j = 0; j < 8; ++j) x[j] = x[j] * rstd * lg[j] + lbv[j];
            u32x4 o; o.x = pk2(x[0], x[1]); o.y = pk2(x[2], x[3]); o.z = pk2(x[4], x[5]); o.w = pk2(x[6], x[7]);
            *(LAS u32x4*)(VN + s * VP + lane * 16) = o; }
        __syncthreads();
        { const int hh = wave >> 1, dh = wave & 1; const bf16* W = Wb + (size_t)hh * 128 * 128;
          LAS unsigned char* vnb = VN;
#pragma unroll 1
          for (int dp = 0; dp < 2; ++dp) {
          bf16x8 Wf[2][8];
#pragma unroll
          for (int a = 0; a < 2; ++a)
#pragma unroll
              for (int ti = 0; ti < 8; ++ti) if (ti >= 2 * a) Wf[a][ti] = *(const bf16x8*)(W + (size_t)(16 * ti + li) * 128 + 32 * a + 8 * g);
          f32x4 acc[2][8];
#pragma unroll
          for (int dt = 0; dt < 2; ++dt)
#pragma unroll
              for (int ti = 0; ti < 8; ++ti) acc[dt][ti] = (f32x4){0.f, 0.f, 0.f, 0.f};
#pragma unroll
          for (int a = 0; a < 4; ++a) { const unsigned ro = (unsigned)((32 * a + 8 * g + q) * VP);
              bf16x8 Af[2];
#pragma unroll
              for (int dt = 0; dt < 2; ++dt) { const unsigned co = (unsigned)((hh * 128 + 64 * dh + 16 * (2 * dp + dt) + 4 * p) * 2); Af[dt] = tr_frag(vnb + ro + co, vnb + ro + 4 * VP + co); }
#pragma unroll
              for (int ti = 0; ti < 8; ++ti) if (ti >= 2 * a) {
                  const bf16x8 Bf = a < 2 ? Wf[a < 2 ? a : 0][ti] : *(const bf16x8*)(W + (size_t)(16 * ti + li) * 128 + 32 * a + 8 * g);
#pragma unroll
                  for (int dt = 0; dt < 2; ++dt) acc[dt][ti] = MFMA16(Af[dt], Bf, acc[dt][ti]); } }
#pragma unroll
          for (int ti = 0; ti < 8; ++ti) { const size_t t = (size_t)unit * 128 + 16 * ti + li; const float bias = sb[hh * 128 + 16 * ti + li];
#pragma unroll
              for (int dt = 0; dt < 2; ++dt) { const int col = hh * 128 + 64 * dh + 16 * (2 * dp + dt) + 4 * g; const u32x2 u = *(const u32x2*)(Z + t * DIN + 2048 + col);
                  u32x2 w; w.x = pk2((acc[dt][ti][0] + bias) * gelu_(bflo(u.x)), (acc[dt][ti][1] + bias) * gelu_(bfhi(u.x))); w.y = pk2((acc[dt][ti][2] + bias) * gelu_(bflo(u.y)), (acc[dt][ti][3] + bias) * gelu_(bfhi(u.y)));
                  *(u32x2*)(O + t * D + 512 + col) = w; } } } }
        __syncthreads();
    }
}

#define XB_TMO      128
#define XB_XCNT(j)  (256  + 64 * (j))
#define XB_XSUB(j)  (1280 + 64 * (j))
#define XB_XGEN(j)  (2304 + 64 * (j))
#define XB_TOP      3328
#define XB_TOPGEN   3392
#define XCD_BAR_WORDS 3456
#define XB_SPIN_CAP (1u << 18)
__device__ __forceinline__ unsigned xb_ld(unsigned* p)              { return __hip_atomic_load(p, __ATOMIC_RELAXED, __HIP_MEMORY_SCOPE_AGENT); }
__device__ __forceinline__ unsigned xb_add(unsigned* p, unsigned v) { return __hip_atomic_fetch_add(p, v, __ATOMIC_RELAXED, __HIP_MEMORY_SCOPE_AGENT); }
__device__ __forceinline__ unsigned xb_xcc_id() { return (unsigned)__builtin_amdgcn_s_getreg((3 << 11) | 20) & 0xFu; }
#define XB_SPIN(cond, bar) do { unsigned _sp = 0; while (cond) { __builtin_amdgcn_s_sleep(1); \
    if ((++_sp & 255u) == 0u) { if (xb_ld(&(bar)[XB_TMO])) break; if (_sp > XB_SPIN_CAP) { atomicAdd(&(bar)[XB_TMO], 1u); break; } } } } while (0)
struct XcdBarrier { unsigned* bar; unsigned x; volatile LAS unsigned* st; int wave; };
__device__ __forceinline__ XcdBarrier xcd_barrier_post(unsigned* bar, volatile LAS unsigned* st, int wave) {
    XcdBarrier b; b.bar = bar; b.x = xb_xcc_id(); b.st = st; b.wave = wave;
    if (wave == 0 && lane_now() == 0) (void)xb_add(&bar[XB_XCNT(b.x)], 1u);
    return b;
}
__device__ __forceinline__ void xcd_barrier_complete(unsigned* bar, unsigned x, unsigned& nloc, unsigned& nx) {
    const unsigned G = gridDim.x * gridDim.y * gridDim.z;
    unsigned sum, cnt, mine, sp = 0u;
    for (;;) {
        sum = 0u; cnt = 0u; mine = 0u;
#pragma unroll
        for (unsigned j = 0; j < 16; ++j) { const unsigned c = xb_ld(&bar[XB_XCNT(j)]); sum += c; cnt += (c > 0u) ? 1u : 0u; mine = (j == x) ? c : mine; }
        if (sum == G) break;
        __builtin_amdgcn_s_sleep(1);
        if ((++sp & 255u) == 0u) { if (xb_ld(&bar[XB_TMO])) break; if (sp > XB_SPIN_CAP) { atomicAdd(&bar[XB_TMO], 1u); break; } }
    }
    nloc = mine > 0u ? mine : 1u; nx = cnt > 0u ? cnt : 1u;
}
__device__ __forceinline__ void xcd_barrier(const XcdBarrier& b) {
    asm volatile("s_waitcnt vmcnt(0)" ::: "memory");
    __syncthreads();
    if (b.wave == 0 && lane_now() == 0) {
        unsigned* bar = b.bar;
        __builtin_amdgcn_s_waitcnt(0);
        unsigned nloc = b.st[0], nx = b.st[1];
        if (nloc == 0u) { xcd_barrier_complete(bar, b.x, nloc, nx); b.st[0] = nloc; b.st[1] = nx; }
        const unsigned old = xb_add(&bar[XB_XSUB(b.x)], 1u);
        const unsigned gen = old / nloc;
        if (old + 1u == (gen + 1u) * nloc) {
            __builtin_amdgcn_fence(__ATOMIC_RELEASE, "agent");
            asm volatile("s_waitcnt vmcnt(0)" ::: "memory");
            const unsigned og = xb_add(&bar[XB_TOP], 1u);
            const unsigned tg = og / nx;
            if (og + 1u == (tg + 1u) * nx) xb_add(&bar[XB_TOPGEN], 1u);
            else XB_SPIN(xb_ld(&bar[XB_TOPGEN]) == tg, bar);
            __builtin_amdgcn_fence(__ATOMIC_ACQUIRE, "agent");
            xb_add(&bar[XB_XGEN(b.x)], 1u);
            asm volatile("s_waitcnt vmcnt(0)" ::: "memory");
        } else {
            XB_SPIN(xb_ld(&bar[XB_XGEN(b.x)]) == gen, bar);
            __builtin_amdgcn_fence(__ATOMIC_ACQUIRE, "agent");
            asm volatile("s_waitcnt vmcnt(0)" ::: "memory");
        }
    }
    __syncthreads();
}


__device__ __forceinline__ void xcd_barrier_bg(const XcdBarrier& b, const Frame& F, int lnext, bool drain) {
    asm volatile("s_waitcnt vmcnt(0)" ::: "memory");
    __syncthreads();
    volatile LAS unsigned* sx = b.st + 4;
    unsigned* q = (unsigned*)(F.ws + WS_CTL) + CW_BGQ + lnext * 64;
    if (b.wave == 0 && lane_now() == 0) {
        unsigned* bar = b.bar;
        __builtin_amdgcn_s_waitcnt(0);
        unsigned nloc = b.st[0], nx = b.st[1];
        if (nloc == 0u) { xcd_barrier_complete(bar, b.x, nloc, nx); b.st[0] = nloc; b.st[1] = nx; }
        const unsigned old = xb_add(&bar[XB_XSUB(b.x)], 1u);
        const unsigned gen = old / nloc;
        const bool leader = (old + 1u == (gen + 1u) * nloc);
        unsigned ti = 0u; if (!leader) { const unsigned k = xb_add(q, 1u); if (k < (unsigned)NBG) ti = k + 1u; }
        sx[0] = leader ? 1u : 0u; sx[1] = gen; sx[2] = ti;
    }
    __syncthreads();
    if (__builtin_amdgcn_readfirstlane(sx[0]) == 0u) {
        unsigned ti = (unsigned)__builtin_amdgcn_readfirstlane(sx[2]);
        while (ti != 0u) {
            const int it = lnext * TL_LAYER + NDEF + (int)ti - 1;
            conv_run(F, 0, 1, 1, [=](int) { return it; });
            if (!drain) break;
            if (b.wave == 0 && lane_now() == 0) { const unsigned k = xb_add(q, 1u); sx[2] = k < (unsigned)NBG ? k + 1u : 0u; }
            __syncthreads();
            ti = (unsigned)__builtin_amdgcn_readfirstlane(sx[2]);
            __syncthreads();
        }
    }
    if (b.wave == 0 && lane_now() == 0) {
        unsigned* bar = b.bar; const unsigned gen = sx[1], nx = b.st[1];
        asm volatile("s_waitcnt vmcnt(0)" ::: "memory");
        if (sx[0] != 0u) {
            __builtin_amdgcn_fence(__ATOMIC_RELEASE, "agent");
            asm volatile("s_waitcnt vmcnt(0)" ::: "memory");
            const unsigned og = xb_add(&bar[XB_TOP], 1u);
            const unsigned tg = og / nx;
            if (og + 1u == (tg + 1u) * nx) xb_add(&bar[XB_TOPGEN], 1u);
            else XB_SPIN(xb_ld(&bar[XB_TOPGEN]) == tg, bar);
            __builtin_amdgcn_fence(__ATOMIC_ACQUIRE, "agent");
            xb_add(&bar[XB_XGEN(b.x)], 1u);
            asm volatile("s_waitcnt vmcnt(0)" ::: "memory");
        } else {
            XB_SPIN(xb_ld(&bar[XB_XGEN(b.x)]) == gen, bar);
            __builtin_amdgcn_fence(__ATOMIC_ACQUIRE, "agent");
            asm volatile("s_waitcnt vmcnt(0)" ::: "memory");
        }
    }
    __syncthreads();
}

__device__ __forceinline__ bool opq(Frame& F) { asm volatile("" : "+s"(F.ws), "+s"(F.blk), "+s"(F.out), "+s"(F.G)); return true; }
__device__ __forceinline__ int lq_(int l) { asm volatile("" : "+s"(l)); return l; }
__global__ void __launch_bounds__(NTHR, 2) k_mega(Params p) {
    extern __shared__ __attribute__((aligned(16))) unsigned char lds[];
    Frame F; F.lds = (LAS unsigned char*)lds; F.ws = p.ws; F.in = p.in; F.out = p.out; F.wave = __builtin_amdgcn_readfirstlane(threadIdx.x >> 6); F.blk = blockIdx.x; F.G = gridDim.x;
    volatile LAS unsigned* st = (volatile LAS unsigned*)(F.lds + LDS_BYTES - 32);
    if (threadIdx.x < 8) st[threadIdx.x] = 0u;
    __syncthreads();
#if USE_CG_SYNC
#define GRID_BAR() cooperative_groups::this_grid().sync()
#else
    const XcdBarrier bar = xcd_barrier_post((unsigned*)(p.ws + WS_CTL) + CW_BAR + p.li * XCD_BAR_WORDS, st, F.wave);
#define GRID_BAR() xcd_barrier(bar)
#endif
    const int lo = p.ph_lo, hi = p.ph_hi;
#define RUN(k) (lo <= (k) && (k) < hi && opq(F))
#define SEAM(k) do { if (RUN(k) && RUN((k) + 1)) GRID_BAR(); } while (0)
#define SEAM_BG(k, drain) do { if (RUN(k) && RUN((k) + 1)) { if (!USE_CG_SYNC && l + 1 < DEPTH) xcd_barrier_bg(bar, F, l + 1, drain); else GRID_BAR(); } } while (0)
    if (RUN(0)) { phase_prologue(F); if (PROBE_DUP & 16) { __syncthreads(); phase_prologue(F); } }
    SEAM(0);
    for (int l = 0; l < DEPTH; ++l) {
        const int b = 2 + 13 * l;
        if (RUN(b + 0)) phase_norm1(F, lq_(l));
        SEAM_BG(b + 0, false);
        if (RUN(b + 1)) phase_gemm_in(F, lq_(l));
        SEAM_BG(b + 1, false);
        if (RUN(b + 2)) { phase_rec_c1(F, lq_(l)); phase_sgu(F, lq_(l)); if (PROBE_DUP & 1) { __syncthreads(); phase_rec_c1(F, lq_(l)); phase_sgu(F, lq_(l)); } if (PROBE_DUP & 64) { __syncthreads(); phase_sgu(F, lq_(l)); } }
        SEAM_BG(b + 2, false);
        if (RUN(b + 3)) { phase_rec_c2(F); if (PROBE_DUP & 4) phase_rec_c2(F); }
        SEAM_BG(b + 3, false);
        if (RUN(b + 5)) { phase_rec_c3(F, lq_(l)); if (PROBE_DUP & 2) { __syncthreads(); phase_rec_c3(F, lq_(l)); } if (PROBE_DUP & 128) { __syncthreads(); phase_rec_c3<1>(F, lq_(l)); } }
        SEAM_BG(b + 5, false);
        if (RUN(b + 6)) phase_gemm_out(F, lq_(l));
        SEAM_BG(b + 6, false);
        if (RUN(b + 7)) phase_norm2(F, lq_(l));
        SEAM_BG(b + 7, false);
        if (RUN(b + 8)) { phase_gather(F, lq_(l)); if (PROBE_DUP & 8) { __syncthreads(); phase_gather(F, lq_(l)); } }
        SEAM_BG(b + 8, false);
#if MOE_FUSED == 1
        if (RUN(b + 9)) phase_moe_fused(F, lq_(l));
        SEAM_BG(b + 9, false);
#elif MOE_FUSED == 2
        if (RUN(b + 9)) phase_moe_fused<1>(F, lq_(l));
        SEAM_BG(b + 9, false);
        if (RUN(b + 10)) phase_moe_fused<2>(F, lq_(l));
        SEAM_BG(b + 10, false);
#else
        if (RUN(b + 9)) phase_gemm_moe1(F, lq_(l));
        SEAM_BG(b + 9, false);
        if (RUN(b + 10)) phase_gemm_moe2(F, lq_(l));
        SEAM_BG(b + 10, false);
#endif
        if (RUN(b + 11)) phase_combine(F, lq_(l));
        SEAM_BG(b + 11, true);
        if (RUN(b + 12)) phase_gemm_pg(F, lq_(l));
        SEAM(b + 12);
    }
    if (RUN(54)) phase_final(F);
#undef RUN
#undef SEAM
}

#ifndef ONE_LAUNCH
#define ONE_LAUNCH 1
#endif
#ifndef CUTS
#define CUTS {0, 55}
#endif
#ifndef MFMA_MASK
#define MFMA_MASK 255
#endif
extern "C" void kernel_launch(void* const* d_in, const int* in_sizes, int n_in, void* d_out, int out_size, void* d_ws, size_t ws_size, hipStream_t stream) {
    if (n_in != 24 || out_size != T * D || ws_size < WS_END) { fprintf(stderr, "kernel_launch: unexpected shapes (n_in %d out %d ws %zu)\n", n_in, out_size, ws_size); return; }
    static_assert(CW_BAR + 60 * XCD_BAR_WORDS <= (int)(CTL_BYTES / 4), "barrier regions inside the zeroed control words");
    Params p{}; for (int i = 0; i < 24; ++i) p.in[i] = (const float*)d_in[i]; p.out = (float*)d_out; p.ws = (unsigned char*)d_ws;
    unsigned char* ws = p.ws;
    (void)hipMemsetAsync(ws + WS_CTL, 0, CTL_BYTES, stream);
    { static bool attr = false; if (!attr) { (void)hipFuncSetAttribute((const void*)k_mega, hipFuncAttributeMaxDynamicSharedMemorySize, LDS_BYTES); attr = true; }
      const int cuts[] = CUTS; const int ncut = (int)(sizeof(cuts) / sizeof(cuts[0]));
      for (int i = 0; i + 1 < ncut; ++i) { p.ph_lo = cuts[i]; p.ph_hi = cuts[i + 1]; p.li = i; p.pad = 0;
#if USE_CG_SYNC
          void* args[] = {&p}; hipError_t e = hipLaunchCooperativeKernel((const void*)k_mega, dim3(256), dim3(NTHR), args, LDS_BYTES, stream);
          if (e != hipSuccess) fprintf(stderr, "cooperative launch failed: %s\n", hipGetErrorName(e));
#else
          hipLaunchKernelGGL(k_mega, dim3(256), dim3(NTHR), LDS_BYTES, stream, p);
#endif
      }
    }
}
```

```cpp
#include <hip/hip_runtime.h>
#include <hip/hip_cooperative_groups.h>
#include <cstdio>
#include <cstdint>

#define GAS __attribute__((address_space(1)))
#define LAS __attribute__((address_space(3)))
typedef unsigned short bf16;
typedef float f32x4 __attribute__((ext_vector_type(4)));
typedef float f32x2 __attribute__((ext_vector_type(2)));
typedef unsigned u32x4 __attribute__((ext_vector_type(4)));
typedef unsigned u32x2 __attribute__((ext_vector_type(2)));
typedef short bf16x8 __attribute__((ext_vector_type(8)));

constexpr int T = 16384, D = 1024, DEPTH = 4, DIN = 3072, DREC = 512, DSGU = 512;
constexpr int NE = 32, DE = 512, PD = 256;
constexpr int RB = 256;
constexpr int CAP = 2 * T + NE * RB;
constexpr int NRBMAX = CAP / RB;
constexpr float EPS = 1e-6f;
constexpr int NWAVES = 8, NTHR = 512;

constexpr size_t MiB = 1u << 20, KiB = 1u << 10;
constexpr size_t WS_CTL = 0, CTL_BYTES = 1 * MiB;
constexpr size_t WS_MISC = 1 * MiB;
constexpr size_t MS_TOKE = WS_MISC + 0;
constexpr size_t MS_TOKW = WS_MISC + 128 * KiB;
constexpr size_t MS_SINFO = WS_MISC + 256 * KiB;
constexpr size_t MS_SDEST = WS_MISC + 384 * KiB;
constexpr size_t MS_RSTDPE = WS_MISC + 512 * KiB;
constexpr size_t MS_BLKBASE = WS_MISC + 576 * KiB;
constexpr size_t MS_LB = WS_MISC + 608 * KiB;
constexpr size_t MS_BLKE = WS_MISC + 640 * KiB;
constexpr size_t MS_DC = WS_MISC + 1 * MiB;
constexpr size_t MS_WRT = WS_MISC + 2 * MiB;
constexpr size_t MS_SGUW = WS_MISC + 3 * MiB;
constexpr size_t MS_MM = WS_MISC + 4 * MiB;
constexpr size_t MS_PTOT = WS_MISC + 5 * MiB;
constexpr size_t WS_WIN = 16 * MiB;
constexpr size_t WS_WOUT = 40 * MiB;
constexpr size_t WS_WGU = 48 * MiB;
constexpr size_t WS_WD = 304 * MiB;
constexpr size_t WS_WPG = 432 * MiB;
constexpr size_t WS_WPE = 440 * MiB;
constexpr size_t WS_PB = 442 * MiB;
constexpr size_t WS_H = 474 * MiB;
constexpr size_t WS_XN = 538 * MiB;
constexpr size_t WS_O = 570 * MiB;
constexpr size_t WS_PE = 602 * MiB;
constexpr size_t WS_R1 = 730 * MiB;
constexpr size_t WS_Z = WS_R1;
constexpr size_t WS_UT = WS_R1 + 96 * MiB;
constexpr size_t WS_ST = WS_R1 + 128 * MiB;
constexpr size_t WS_ORAW = WS_R1 + 96 * MiB;
constexpr size_t WS_VN = WS_R1 + 128 * MiB;
constexpr size_t WS_XB = WS_R1;
constexpr size_t WS_HB = WS_R1 + 80 * MiB;
constexpr size_t WS_Y = WS_R1 + 120 * MiB;
constexpr size_t WS_LTOT = 930 * MiB;
constexpr size_t WS_END = 934 * MiB;
constexpr int CW_CNT = 64;
constexpr int CW_BGQ = 1024;
constexpr int CW_DONE = 2048;
constexpr int CW_BAR = 4096;

constexpr int RING_BYTES = 131072, MISC_OFF = RING_BYTES, LDS_BYTES = 147456;

#ifndef PROBE_DUP
#define PROBE_DUP 0
#endif
#ifndef MOE_FUSED
#define MOE_FUSED 1
#endif
#ifndef USE_CG_SYNC
#define USE_CG_SYNC 0
#endif
struct Params { const float* in[24]; float* out; unsigned char* ws; int ph_lo, ph_hi, li, pad; };

#define LDS_WAIT() asm volatile("s_waitcnt lgkmcnt(0)" ::: "memory")
template <int M> __device__ __forceinline__ float shx(float v) { static_assert(M >= 1 && M < 32, "swizzle xor mask");
    return __int_as_float(__builtin_amdgcn_ds_swizzle(__float_as_int(v), (M << 10) | 0x1F)); }
__device__ __forceinline__ float halves_sum(float v) {
    return __int_as_float(__builtin_amdgcn_readlane(__float_as_int(v), 0)) + __int_as_float(__builtin_amdgcn_readlane(__float_as_int(v), 32)); }
__device__ __forceinline__ float wave_sum(float v) {
    v += shx<1>(v); v += shx<2>(v); v += shx<4>(v); v += shx<8>(v); v += shx<16>(v);
    return halves_sum(v);
}
typedef __bf16 bf16x2_t __attribute__((ext_vector_type(2)));
__device__ __forceinline__ unsigned pk2(float lo, float hi) { const bf16x2_t v = __builtin_convertvector((f32x2){lo, hi}, bf16x2_t); return __builtin_bit_cast(unsigned, v); }
__device__ __forceinline__ unsigned f2bf(float f) { return pk2(f, f) & 0xffffu; }
__device__ __forceinline__ float bflo(unsigned w) { return __uint_as_float(w << 16); }
__device__ __forceinline__ float bfhi(unsigned w) { return __uint_as_float(w & 0xffff0000u); }
__device__ __forceinline__ float bf2f(bf16 b) { return __uint_as_float(((unsigned)b) << 16); }
__device__ __forceinline__ float fexp(float x) { return __builtin_amdgcn_exp2f(x * 1.4426950408889634f); }
__device__ __forceinline__ float flog(float x) { return __builtin_amdgcn_logf(x) * 0.6931471805599453f; }
__device__ __forceinline__ float frcp(float x) { return __builtin_amdgcn_rcpf(x); }
__device__ __forceinline__ float frsq(float x) { return __builtin_amdgcn_rsqf(x); }
__device__ __forceinline__ float sigmoid_(float x) { return frcp(1.f + fexp(-x)); }
__device__ __forceinline__ float silu_(float x) { return x * sigmoid_(x); }
__device__ __forceinline__ float gelu_(float x) { const float y = 0.7978845608028654f * (x + 0.044715f * x * x * x); const float t = 1.f - 2.f * frcp(fexp(2.f * y) + 1.f); return 0.5f * x * (1.f + t); }

struct Frame {
    LAS unsigned char* lds; unsigned char* ws; const float* const* in; float* out;
    int wave, blk, G;
};
__device__ __forceinline__ int lane_now() { int l; asm volatile("v_mbcnt_lo_u32_b32 %0, -1, 0\n\tv_mbcnt_hi_u32_b32 %0, -1, %0" : "=v"(l)); return l; }
#define PH_TID() int ph_wave = F.wave; asm volatile("" : "+s"(ph_wave)); const int lane = lane_now(); (void)lane; const int tid = (ph_wave << 6) | lane; (void)tid

struct ConvJob { const float* W; const float* g; bf16* WT; int K, N, k0, n0, mode; };
constexpr int TL_IN = 16 * 12, TL_OUT = 16 * 4, TL_G = 32 * 16 * 2, TL_D = 32 * 8 * 4, TL_PG = 16 * 4, TL_PE = 4 * 4;
constexpr int TL_LAYER = TL_IN + TL_OUT + 2 * TL_G + TL_D + TL_PG + TL_PE;
__device__ __forceinline__ ConvJob conv_job(const Frame& F, int it) {
    unsigned char* ws = F.ws; const int l = it / TL_LAYER; int r = it % TL_LAYER; ConvJob j;
    if (r < TL_IN) { j.W = F.in[3] + (size_t)l * D * DIN; j.g = F.in[2] + l * D; j.WT = (bf16*)(ws + WS_WIN) + (size_t)l * DIN * D; j.K = D; j.N = DIN; j.k0 = 64 * (r / 12); j.n0 = 256 * (r % 12); j.mode = 0; return j; } r -= TL_IN;
    if (r < TL_OUT) { j.W = F.in[10] + (size_t)l * D * D; j.g = nullptr; j.WT = (bf16*)(ws + WS_WOUT) + (size_t)l * D * D; j.K = D; j.N = D; j.k0 = 64 * (r / 4); j.n0 = 256 * (r % 4); j.mode = 0; return j; } r -= TL_OUT;
    if (r < 2 * TL_G) { const int up = r >= TL_G; if (up) r -= TL_G; const int e = r / 32, rr = r % 32;
        j.W = F.in[up ? 17 : 16] + (size_t)(l * NE + e) * D * DE; j.g = F.in[11] + l * D; j.WT = (bf16*)(ws + WS_WGU) + (size_t)(l * NE + e) * 1024 * 1024; j.K = D; j.N = DE; j.k0 = 64 * (rr / 2); j.n0 = 256 * (rr % 2); j.mode = 1 + up; return j; } r -= 2 * TL_G;
    if (r < TL_D) { const int e = r / 32, rr = r % 32; j.W = F.in[18] + (size_t)(l * NE + e) * DE * D; j.g = nullptr; j.WT = (bf16*)(ws + WS_WD) + (size_t)(l * NE + e) * D * DE; j.K = DE; j.N = D; j.k0 = 64 * (rr / 4); j.n0 = 256 * (rr % 4); j.mode = 0; return j; } r -= TL_D;
    if (r < TL_PG) { j.W = F.in[20] + (size_t)l * D * D; j.g = F.in[19] + l * D; j.WT = (bf16*)(ws + WS_WPG) + (size_t)l * D * D; j.K = D; j.N = D; j.k0 = 64 * (r / 4); j.n0 = 256 * (r % 4); j.mode = 0; return j; } r -= TL_PG;
    j.W = F.in[21] + (size_t)l * PD * D; j.g = nullptr; j.WT = (bf16*)(ws + WS_WPE) + (size_t)l * D * PD; j.K = PD; j.N = D; j.k0 = 64 * (r / 4); j.n0 = 256 * (r % 4); j.mode = 0; return j;
}
__device__ __forceinline__ void conv_load(const ConvJob& j, int wave, int lane, f32x4 (&v)[8]) {
#pragma unroll
    for (int i = 0; i < 8; ++i) { const int row = 8 * wave + i; v[i] = *(const f32x4*)(j.W + (size_t)(j.k0 + row) * j.N + j.n0 + 4 * lane); if (j.g) v[i] = v[i] * j.g[j.k0 + row]; }
}
constexpr int NDEF = 384, NDEF1 = 128, NBG = 3024;
constexpr int NREST = TL_LAYER - NDEF - NBG, NPRO = TL_LAYER + 3 * NREST;
__device__ __forceinline__ int pro_tile(int f) { if (NREST == 0 || f < TL_LAYER) return f; f -= TL_LAYER; const int l = 1 + f / (NREST ? NREST : 1); return l * TL_LAYER + NDEF + NBG + f % (NREST ? NREST : 1); }
template <class M> __device__ __forceinline__ void conv_run(const Frame& F, int first, int stride, int count, M tile_of) {
    PH_TID();
    LAS float* tile = (LAS float*)F.lds;
    const int wave = ph_wave;
    int f = first; f32x4 v[8]; ConvJob cur{}, nxt{};
    if (f < count) { cur = conv_job(F, tile_of(f)); conv_load(cur, wave, lane, v); }
    while (f < count) {
#pragma unroll
        for (int i = 0; i < 8; ++i) { LAS float* d = tile + (8 * wave + i) * 257 + 4 * lane; d[0] = v[i].x; d[1] = v[i].y; d[2] = v[i].z; d[3] = v[i].w; }
        __syncthreads();
        const int fn = f + stride; if (fn < count) { nxt = conv_job(F, tile_of(fn)); conv_load(nxt, wave, lane, v); }
#pragma unroll
        for (int q = 0; q < 4; ++q) { const int nn = 32 * wave + 8 * q + (lane >> 3), c = lane & 7; const LAS float* sp = tile + (8 * c) * 257 + nn;
            u32x4 o; o.x = pk2(sp[0 * 257], sp[1 * 257]); o.y = pk2(sp[2 * 257], sp[3 * 257]); o.z = pk2(sp[4 * 257], sp[5 * 257]); o.w = pk2(sp[6 * 257], sp[7 * 257]);
            const int n = cur.n0 + nn; const int drow = cur.mode == 0 ? n : ((n >> 7) * 256 + (n & 127) + (cur.mode == 2 ? 128 : 0));
            *(u32x4*)(cur.WT + (size_t)drow * cur.K + cur.k0 + 8 * c) = o; }
        __syncthreads();
        cur = nxt; f = fn;
    }
}
__device__ __forceinline__ void conv_deferred(const Frame& F, int lnext, int r0, int r1, int first, int idle) {
    if (lnext >= DEPTH || F.blk < first) return;
    conv_run(F, F.blk - first, idle, r1 - r0, [=](int f) { return lnext * TL_LAYER + r0 + f; });
}
__device__ __forceinline__ void phase_prologue(const Frame& F) {
    PH_TID();
    unsigned char* ws = F.ws;
    conv_run(F, F.blk, F.G, NPRO, [](int f) { return pro_tile(f); });
    { const f32x4* src = (const f32x4*)F.in[1]; u32x4* dst = (u32x4*)(ws + WS_PB); const size_t n8 = (size_t)DEPTH * T * PD / 8;
      for (size_t i = (size_t)F.blk * NTHR + tid; i < n8; i += (size_t)F.G * NTHR) { const f32x4 a = src[2 * i], b = src[2 * i + 1]; u32x4 o; o.x = pk2(a.x, a.y); o.y = pk2(a.z, a.w); o.z = pk2(b.x, b.y); o.w = pk2(b.z, b.w); dst[i] = o; } }
    { float* wrt = (float*)(ws + MS_WRT);
      for (int i = F.blk * NTHR + tid; i < DEPTH * 36 * D; i += F.G * NTHR) { const int k = i % D, n = (i / D) % 36, l = i / (36 * D);
          const float w = n < 4 ? F.in[12][((size_t)l * D + k) * 4 + n] : F.in[14][((size_t)l * D + k) * NE + (n - 4)]; wrt[i] = w * F.in[11][l * D + k]; } }
    { bf16* wb = (bf16*)(ws + MS_SGUW); for (int i = F.blk * NTHR + tid; i < DEPTH * 4 * 128 * 128; i += F.G * NTHR) { const int tc = (i >> 7) & 127, sp = i & 127; wb[i] = sp <= tc ? (bf16)f2bf(F.in[8][i]) : (bf16)0; } }
    if (F.blk == 0 && tid < DREC) { const int c = tid; float v[DEPTH], m = -1e30f;
#pragma unroll
        for (int l = 0; l < DEPTH; ++l) { v[l] = F.in[4][l * DREC + c]; m = fmaxf(m, v[l]); }
        float s = 0.f;
#pragma unroll
        for (int l = 0; l < DEPTH; ++l) { v[l] = fexp(v[l] - m); s += v[l]; }
        float* lb = (float*)(ws + MS_LB); float acc = 0.f;
#pragma unroll
        for (int l = 0; l < DEPTH; ++l) { if (l > 0) acc += v[l] / s; lb[l * DREC + c] = acc; } }
}

__device__ __forceinline__ void load_row(const float* row, int lane, f32x4 (&v)[4]) { const f32x4* r = (const f32x4*)row + lane;
#pragma unroll
    for (int j = 0; j < 4; ++j) v[j] = r[64 * j]; }
__device__ __forceinline__ void load_row_bf(const bf16* row, int lane, f32x4 (&v)[4]) { const u32x2* r = (const u32x2*)row + lane;
#pragma unroll
    for (int j = 0; j < 4; ++j) { const u32x2 x = r[64 * j]; v[j] = (f32x4){bflo(x.x), bfhi(x.x), bflo(x.y), bfhi(x.y)}; } }
__device__ __forceinline__ float row_sumsq(const f32x4 (&v)[4]) { float s = 0.f;
#pragma unroll
    for (int j = 0; j < 4; ++j) s += (v[j].x * v[j].x + v[j].y * v[j].y) + (v[j].z * v[j].z + v[j].w * v[j].w);
    return wave_sum(s); }
__device__ __forceinline__ void store_row_bf16(bf16* orow, int lane, const f32x4 (&v)[4], float s) { u32x2* o = (u32x2*)orow + lane;
#pragma unroll
    for (int j = 0; j < 4; ++j) { u32x2 w; w.x = pk2(v[j].x * s, v[j].y * s); w.y = pk2(v[j].z * s, v[j].w * s); o[64 * j] = w; } }

__device__ __forceinline__ void phase_norm1(const Frame& F, int l) {
    PH_TID();
    bf16* XN = (bf16*)(F.ws + WS_XN); bf16* h = (bf16*)(F.ws + WS_H); const float* x = F.in[0];
    const int gw = F.blk * NWAVES + ph_wave, NGW = F.G * NWAVES;
    for (int t = gw; t < T; t += NGW) { f32x4 v[4];
        if (l == 0) { load_row(x + (size_t)t * D, lane, v); store_row_bf16(h + (size_t)t * D, lane, v, 1.f); } else load_row_bf(h + (size_t)t * D, lane, v);
        const float rstd = frsq(row_sumsq(v) * (1.f / D) + EPS); store_row_bf16(XN + (size_t)t * D, lane, v, rstd); }
}
__device__ __forceinline__ float bfly8(const float (&r)[8], int lane) {
    const bool b2 = lane & 4, b1 = lane & 2, b0 = lane & 1; float a[4], c[2];
#pragma unroll
    for (int i = 0; i < 4; ++i) { const float keep = b2 ? r[i + 4] : r[i], send = b2 ? r[i] : r[i + 4]; a[i] = keep + shx<4>(send); }
#pragma unroll
    for (int i = 0; i < 2; ++i) { const float keep = b1 ? a[i + 2] : a[i], send = b1 ? a[i] : a[i + 2]; c[i] = keep + shx<2>(send); }
    const float keep = b0 ? c[1] : c[0], send = b0 ? c[0] : c[1]; float d = keep + shx<1>(send);
    d += shx<8>(d); d += shx<16>(d);
    return d + __int_as_float(__builtin_amdgcn_ds_bpermute((lane ^ 32) << 2, __float_as_int(d)));
}
__device__ __forceinline__ void phase_norm2(const Frame& F, int l) {
    PH_TID();
    unsigned char* ws = F.ws;
    unsigned* hist = (unsigned*)(F.lds + MISC_OFF + 256);
    if (tid < 32) hist[tid] = 0u;
    __syncthreads();
    const bf16* h = (const bf16*)(ws + WS_H); bf16* XN = (bf16*)(ws + WS_XN);
    const float* WrT = (const float*)(ws + MS_WRT) + (size_t)l * 36 * D;
    const float* b_rg = F.in[13] + l * 4; const float* b_re = F.in[15] + l * NE;
    int* tok_e = (int*)(ws + MS_TOKE); float* tok_w = (float*)(ws + MS_TOKW); unsigned* sinfo = (unsigned*)(ws + MS_SINFO);
    const int RPB = T / F.G, RPW = RPB / NWAVES;
    for (int i0 = 0; i0 < RPW; i0 += 8) {
        const int t0 = F.blk * RPB + ph_wave * RPW + i0;
        f32x4 v[8][4]; float ss[8];
#pragma unroll
        for (int r = 0; r < 8; ++r) { load_row_bf(h + (size_t)(t0 + r) * D, lane, v[r]); float q = 0.f;
#pragma unroll
            for (int j = 0; j < 4; ++j) q += (v[r][j].x * v[r][j].x + v[r][j].y * v[r][j].y) + (v[r][j].z * v[r][j].z + v[r][j].w * v[r][j].w);
            ss[r] = q; }
        const float rstd_mine = frsq(bfly8(ss, lane) * (1.f / D) + EPS);
#pragma unroll
        for (int r = 0; r < 8; ++r) { const float rs = __int_as_float(__builtin_amdgcn_readlane(__float_as_int(rstd_mine), r)); store_row_bf16(XN + (size_t)(t0 + r) * D, lane, v[r], rs); }
        LAS float* lgw = (LAS float*)(F.lds + 4096) + ph_wave * (36 * 8);
#pragma unroll 2
        for (int n = 0; n < 36; ++n) { const f32x4* wr = (const f32x4*)(WrT + (size_t)n * D) + lane; const f32x4 w0 = wr[0], w1 = wr[64], w2 = wr[128], w3 = wr[192]; float pr[8];
#pragma unroll
            for (int r = 0; r < 8; ++r) pr[r] = ((v[r][0].x * w0.x + v[r][0].y * w0.y) + (v[r][0].z * w0.z + v[r][0].w * w0.w)) + ((v[r][1].x * w1.x + v[r][1].y * w1.y) + (v[r][1].z * w1.z + v[r][1].w * w1.w))
                                                 + ((v[r][2].x * w2.x + v[r][2].y * w2.y) + (v[r][2].z * w2.z + v[r][2].w * w2.w)) + ((v[r][3].x * w3.x + v[r][3].y * w3.y) + (v[r][3].z * w3.z + v[r][3].w * w3.w));
            const float val = bfly8(pr, lane) * rstd_mine; if (lane < 8) lgw[n * 8 + lane] = val; }
        const int row = lane & 7;
        float lg4[4], lgb[4];
#pragma unroll
        for (int j = 0; j < 4; ++j) { lg4[j] = lgw[j * 8 + row]; lgb[j] = lg4[j] + b_rg[j]; }
        int gs = 0; float gm = lgb[0];
#pragma unroll
        for (int j = 1; j < 4; ++j) if (lgb[j] > gm) { gm = lgb[j]; gs = j; }
        float mx = fmaxf(fmaxf(lg4[0], lg4[1]), fmaxf(lg4[2], lg4[3])), se = 0.f, lsel = lg4[0];
#pragma unroll
        for (int j = 0; j < 4; ++j) { se += fexp(lg4[j] - mx); if (j == gs) lsel = lg4[j]; }
        const float g_w = fexp(lsel - mx) * frcp(se);
        float le[8], leb[8];
#pragma unroll
        for (int j = 0; j < 8; ++j) { le[j] = lgw[(4 + gs * 8 + j) * 8 + row]; leb[j] = le[j] + b_re[gs * 8 + j]; }
        int s0 = 0; float m0 = leb[0];
#pragma unroll
        for (int j = 1; j < 8; ++j) if (leb[j] > m0) { m0 = leb[j]; s0 = j; }
        int s1 = -1; float m1 = -3.0e38f;
#pragma unroll
        for (int j = 0; j < 8; ++j) if (j != s0 && leb[j] > m1) { m1 = leb[j]; s1 = j; }
        if (s1 < 0) s1 = (s0 == 0) ? 1 : 0;
        float la = le[0], lb2 = le[0];
#pragma unroll
        for (int j = 1; j < 8; ++j) { if (j == s0) la = le[j]; if (j == s1) lb2 = le[j]; }
        const float wa = frcp(1.f + fexp(lb2 - la)), wb = 1.f - wa;
        if (lane < 8) { const int t = t0 + lane;
            const int e0 = gs * 8 + s0, e1 = gs * 8 + s1;
            const unsigned r0 = atomicAdd(&hist[e0], 1u), r1 = atomicAdd(&hist[e1], 1u);
            tok_e[2 * t] = e0; tok_e[2 * t + 1] = e1; tok_w[2 * t] = g_w * wa; tok_w[2 * t + 1] = g_w * wb;
            sinfo[2 * t] = ((unsigned)F.blk << 16) | r0; sinfo[2 * t + 1] = ((unsigned)F.blk << 16) | r1;
        }
    }
    __syncthreads();
    if (tid < 32) { unsigned* cnt = (unsigned*)(ws + WS_CTL) + CW_CNT + l * 32;
        const unsigned base = __hip_atomic_fetch_add(cnt + tid, hist[tid], __ATOMIC_RELAXED, __HIP_MEMORY_SCOPE_AGENT);
        ((unsigned*)(ws + MS_BLKBASE))[F.blk * 32 + tid] = base; }
}
__device__ __forceinline__ void phase_gather(const Frame& F, int l) {
    PH_TID();
    unsigned char* ws = F.ws;
    int* ps = (int*)(F.lds + MISC_OFF + 512);
    if (tid == 0) { unsigned* cnt = (unsigned*)(ws + WS_CTL) + CW_CNT + l * 32; int* blke = (int*)(ws + MS_BLKE) + l * 256; int acc = 0;
        for (int e = 0; e < NE; ++e) { const int c = (int)__hip_atomic_load(cnt + e, __ATOMIC_RELAXED, __HIP_MEMORY_SCOPE_AGENT); ps[e] = acc; const int pad = (c + RB - 1) / RB * RB;
            if (F.blk == 0) for (int rb = acc / RB; rb < (acc + pad) / RB; ++rb) blke[rb] = e;
            acc += pad; }
        if (F.blk == 0) blke[255] = acc / RB; }
    __syncthreads();
    const int* tok_e = (const int*)(ws + MS_TOKE); const unsigned* sinfo = (const unsigned*)(ws + MS_SINFO); const unsigned* bbase = (const unsigned*)(ws + MS_BLKBASE);
    int* sdest = (int*)(ws + MS_SDEST); const bf16* XN = (const bf16*)(ws + WS_XN); bf16* XB = (bf16*)(ws + WS_XB);
    const int gw = F.blk * NWAVES + ph_wave, NGW = F.G * NWAVES;
    for (int t = gw; t < T; t += NGW) {
        const u32x4* src = (const u32x4*)(XN + (size_t)t * D) + lane; const u32x4 a = src[0], b = src[64];
#pragma unroll
        for (int j = 0; j < 2; ++j) { const int e = tok_e[2 * t + j]; const unsigned info = sinfo[2 * t + j];
            const int dest = ps[e] + (int)bbase[(info >> 16) * 32 + e] + (int)(info & 0xffffu);
            if (lane == 0) sdest[2 * t + j] = dest;
            u32x4* dst = (u32x4*)(XB + (size_t)dest * D) + lane; dst[0] = a; dst[64] = b; }
    }
}
__device__ __forceinline__ void phase_combine(const Frame& F, int l) {
    PH_TID();
    unsigned char* ws = F.ws;
    bf16* h = (bf16*)(ws + WS_H); bf16* XN = (bf16*)(ws + WS_XN); const bf16* Y = (const bf16*)(ws + WS_Y); const bf16* PE = (const bf16*)(ws + WS_PE) + (size_t)l * T * D;
    const int* sdest = (const int*)(ws + MS_SDEST); const float* tok_w = (const float*)(ws + MS_TOKW); float* rstd_pe = (float*)(ws + MS_RSTDPE);
    const int gw = F.blk * NWAVES + ph_wave, NGW = F.G * NWAVES;
    for (int t = gw; t < T; t += NGW) {
        const int d0 = sdest[2 * t], d1 = sdest[2 * t + 1]; const float w0 = tok_w[2 * t], w1 = tok_w[2 * t + 1];
        f32x4 v[4]; load_row_bf(h + (size_t)t * D, lane, v);
        const u32x2* y0 = (const u32x2*)(Y + (size_t)d0 * D) + lane; const u32x2* y1 = (const u32x2*)(Y + (size_t)d1 * D) + lane; const u32x2* pe = (const u32x2*)(PE + (size_t)t * D) + lane;
        float sp = 0.f;
#pragma unroll
        for (int j = 0; j < 4; ++j) { const u32x2 a = y0[64 * j], b = y1[64 * j], c = pe[64 * j];
            v[j].x += w0 * bflo(a.x) + w1 * bflo(b.x); v[j].y += w0 * bfhi(a.x) + w1 * bfhi(b.x); v[j].z += w0 * bflo(a.y) + w1 * bflo(b.y); v[j].w += w0 * bfhi(a.y) + w1 * bfhi(b.y);
            const float p0 = bflo(c.x), p1 = bfhi(c.x), p2 = bflo(c.y), p3 = bfhi(c.y); sp += (p0 * p0 + p1 * p1) + (p2 * p2 + p3 * p3); }
        store_row_bf16(h + (size_t)t * D, lane, v, 1.f);
        const float rstd = frsq(row_sumsq(v) * (1.f / D) + EPS); store_row_bf16(XN + (size_t)t * D, lane, v, rstd);
        sp = wave_sum(sp); if (lane == 0) rstd_pe[t] = frsq(sp * (1.f / D) + EPS);
    }
}
__device__ __forceinline__ void phase_final(const Frame& F) {
    PH_TID();
    const bf16* h = (const bf16*)(F.ws + WS_H); const float* nf = F.in[23];
    const int gw = F.blk * NWAVES + ph_wave, NGW = F.G * NWAVES;
    for (int t = gw; t < T; t += NGW) { f32x4 v[4]; load_row_bf(h + (size_t)t * D, lane, v); const float rstd = frsq(row_sumsq(v) * (1.f / D) + EPS);
        f32x4* o = (f32x4*)(F.out + (size_t)t * D) + lane; const f32x4* g = (const f32x4*)nf + lane;
#pragma unroll
        for (int j = 0; j < 4; ++j) o[64 * j] = v[j] * rstd * g[64 * j]; }
}


namespace pg8 {
constexpr int BM = 256, BK = 64, HALF = 128, HTB = HALF * BK * 2, STAGE_BYTES = 8 * HTB, NXCD = 8, WGM = 8;
__host__ __device__ __forceinline__ int lds_byte(int r, int c) { const int st = (r >> 4) * 2 + (c >> 5), rr = r & 15, cc = c & 31, ob = rr * 64 + cc * 2; return st * 1024 + (ob ^ (((ob >> 9) & 1) << 5)); }
__host__ __device__ __forceinline__ void stage_rc(int b, int& R, int& C) { const int st = b / 1024, sb = b % 1024, swz = sb ^ (((sb >> 9) & 1) << 5); R = (st >> 1) * 16 + swz / 64; C = (st & 1) * 32 + (swz % 64) / 2; }
__host__ __device__ __forceinline__ int perm32(int rho) { const int n = rho >> 4, i = rho & 15; return 8 * (i >> 2) + 4 * n + (i & 3); }
struct Unit { int pm, pn; const char* A; const char* B; };
__device__ __forceinline__ void static_map(int wgid, int nM, int nN, int& pm, int& pn) {
    const int nwg = nM * nN; { const int q = nwg / NXCD, r = nwg % NXCD, xcd = wgid % NXCD, off = wgid / NXCD; wgid = (xcd < r ? xcd * (q + 1) : r * (q + 1) + (xcd - r) * q) + off; }
    const int nig = WGM * nN, gid = wgid / nig, fm = gid * WGM, gsz = (nM - fm) < WGM ? (nM - fm) : WGM;
    pm = fm + ((wgid % nig) % gsz); pn = (wgid % nig) / gsz;
}
struct DenseOrder { static constexpr bool DEPS = false;
    const char* A; const char* Bt; int nM, nN, nL, G, c; size_t tstep;
    __device__ void init(const void* A_, const void* Bt_, int M, int N, int K, int nL_, int G_, int c_) { A = (const char*)A_; Bt = (const char*)Bt_; nM = M / BM; nN = N / BM; nL = nL_; G = G_; c = c_; tstep = (size_t)BM * K * 2; }
    __device__ bool next(int i, Unit& u) const { const long L = (long)i * G + c; const int per = nM * nN; if (L >= (long)per * nL) return false;
        const int l = (int)(L / per); int pm, pn; static_map((int)(L % per), nM, nN, pm, pn); u.pm = l * nM + pm; u.pn = pn; u.A = A + (size_t)u.pm * tstep; u.B = Bt + (size_t)(l * nN + pn) * tstep; return true; }
};
struct MoeOrder { static constexpr bool DEPS = false;
    const char* A; const char* W; const int* blke; int nrb, nN, G, c, e0, e1, e2; size_t a_tstep, w_estride, b_tstep;
    __device__ void init(const void* A_, const void* W_, const int* blke_, int K, int nN_, size_t w_estride_bytes, int G_, int c_) { A = (const char*)A_; W = (const char*)W_; blke = blke_; nrb = __builtin_amdgcn_readfirstlane(blke_[255]); nN = nN_; G = G_; c = c_;
        a_tstep = (size_t)BM * K * 2; b_tstep = a_tstep; w_estride = w_estride_bytes;
        const int r0 = c / nN, r1 = (G + c) / nN, r2 = (2 * G + c) / nN; const int x0 = blke_[r0 < 255 ? r0 : 254], x1 = blke_[r1 < 255 ? r1 : 254], x2 = blke_[r2 < 255 ? r2 : 254];
        e0 = __builtin_amdgcn_readfirstlane(x0); e1 = __builtin_amdgcn_readfirstlane(x1); e2 = __builtin_amdgcn_readfirstlane(x2); }
    __device__ bool next(int i, Unit& u) const { const long L = (long)i * G + c; if (L >= (long)nrb * nN) return false; const int rb = (int)(L / nN), pn = (int)(L % nN);
        const int ex = i == 0 ? e0 : i == 1 ? e1 : i == 2 ? e2 : __builtin_amdgcn_readfirstlane(blke[rb]);
        u.pm = rb; u.pn = pn; u.A = A + (size_t)rb * a_tstep; u.B = W + (size_t)ex * w_estride + (size_t)pn * b_tstep; return true; }
};
__device__ __forceinline__ unsigned ag_ld(const unsigned* p)        { return __hip_atomic_load(p, __ATOMIC_RELAXED, __HIP_MEMORY_SCOPE_AGENT); }
__device__ __forceinline__ unsigned ag_add(unsigned* p, unsigned v) { return __hip_atomic_fetch_add(p, v, __ATOMIC_RELAXED, __HIP_MEMORY_SCOPE_AGENT); }
struct MoeDepOrder { static constexpr bool DEPS = true;
    const char* A; const char* W; const int* blke; const unsigned* done; int nrb, nN, G, c, e0, e1, e2; size_t a_tstep, w_estride, b_tstep;
    __device__ void init(const void* A_, const void* W_, const int* blke_, const unsigned* done_, int K, int nN_, size_t w_estride_bytes, int G_, int c_) { A = (const char*)A_; W = (const char*)W_; blke = blke_; done = done_;
        nrb = __builtin_amdgcn_readfirstlane(blke_[255]); nN = nN_; G = G_; c = c_; a_tstep = (size_t)BM * K * 2; b_tstep = a_tstep; w_estride = w_estride_bytes;
        const int r0 = c / nN, r1 = (G + c) / nN, r2 = (2 * G + c) / nN; const int x0 = blke_[r0 < 255 ? r0 : 254], x1 = blke_[r1 < 255 ? r1 : 254], x2 = blke_[r2 < 255 ? r2 : 254];
        e0 = __builtin_amdgcn_readfirstlane(x0); e1 = __builtin_amdgcn_readfirstlane(x1); e2 = __builtin_amdgcn_readfirstlane(x2); }
    __device__ bool next(int i, Unit& u) const { const long L = (long)i * G + c; if (L >= (long)nrb * nN) return false; const int rb = (int)(L / nN), pn = (int)(L % nN);
        const int ex = i == 0 ? e0 : i == 1 ? e1 : i == 2 ? e2 : __builtin_amdgcn_readfirstlane(blke[rb]);
        u.pm = rb; u.pn = pn; u.A = A + (size_t)rb * a_tstep; u.B = W + (size_t)ex * w_estride + (size_t)pn * b_tstep; return true; }
    __device__ void wait(const Unit& u, int wid) const {
        if (wid == 0 && lane_now() == 0) { while (ag_ld(done + u.pm) < 4u) __builtin_amdgcn_s_sleep(1); __builtin_amdgcn_fence(__ATOMIC_ACQUIRE, "agent"); } }
};
struct RangeOrder { static constexpr bool DEPS = false;
    const char* A; const char* Bt; int nM, nN, j0, n; size_t tstep;
    __device__ void init(const void* A_, const void* Bt_, int M, int N, int K, int j0_, int n_) { A = (const char*)A_; Bt = (const char*)Bt_; nM = M / BM; nN = N / BM; j0 = j0_; n = n_; tstep = (size_t)BM * K * 2; }
    __device__ bool next(int i, Unit& u) const { if (i >= n) return false; int pm, pn; static_map(j0 + i, nM, nN, pm, pn); u.pm = pm; u.pn = pn; u.A = A + (size_t)pm * tstep; u.B = Bt + (size_t)pn * tstep; return true; }
};
__device__ __forceinline__ unsigned cvt_pk_bf16(float lo, float hi) { return pk2(lo, hi); }
struct EpiBf16 { static constexpr bool PERM = true, ACC_INIT = false, SIGNAL = false; bf16* O; int ldc;
    __device__ __forceinline__ void operator()(const f32x4 (&acc)[2][2][4][2], const Unit& u, int wr, int wc, int, int) const {
        const int t2 = lane_now(), fr = t2 & 15, fq = t2 >> 4;
        const int row0 = u.pm * BM + wr * 64 + fr, col0 = u.pn * BM + wc * 32 + 8 * fq;
#pragma unroll
        for (int ai = 0; ai < 2; ++ai)
#pragma unroll
            for (int m = 0; m < 4; ++m) { bf16* rowp = O + (size_t)(row0 + ai * HALF + m * 16) * ldc + col0;
#pragma unroll
                for (int bj = 0; bj < 2; ++bj) { const f32x4 v0 = acc[ai][bj][m][0], v1 = acc[ai][bj][m][1];
                    u32x4 w; w.x = cvt_pk_bf16(v0[0], v0[1]); w.y = cvt_pk_bf16(v0[2], v0[3]); w.z = cvt_pk_bf16(v1[0], v1[1]); w.w = cvt_pk_bf16(v1[2], v1[3]);
                    *(u32x4*)(rowp + bj * HALF) = w; } }
    } };
struct EpiResid { static constexpr bool PERM = true, ACC_INIT = true, SIGNAL = false; bf16* h;
    __device__ __forceinline__ void init(f32x4 (&acc)[2][2][4][2], const Unit& u, int wr, int wc, int fr, int fq) const {
        const int row0 = u.pm * BM + wr * 64 + fr, col0 = u.pn * BM + wc * 32 + 8 * fq;
#pragma unroll
        for (int ai = 0; ai < 2; ++ai)
#pragma unroll
            for (int m = 0; m < 4; ++m) { const bf16* rowp = h + (size_t)(row0 + ai * HALF + m * 16) * D + col0;
#pragma unroll
                for (int bj = 0; bj < 2; ++bj) { const u32x4 x = *(const u32x4*)(rowp + bj * HALF);
                    acc[ai][bj][m][0] = (f32x4){bflo(x.x), bfhi(x.x), bflo(x.y), bfhi(x.y)}; acc[ai][bj][m][1] = (f32x4){bflo(x.z), bfhi(x.z), bflo(x.w), bfhi(x.w)}; } }
    }
    __device__ __forceinline__ void operator()(const f32x4 (&acc)[2][2][4][2], const Unit& u, int wr, int wc, int fr, int fq) const {
        asm volatile("" : "+v"(fr), "+v"(fq));
        const int row0 = u.pm * BM + wr * 64 + fr, col0 = u.pn * BM + wc * 32 + 8 * fq;
#pragma unroll
        for (int ai = 0; ai < 2; ++ai)
#pragma unroll
            for (int m = 0; m < 4; ++m) { bf16* rowp = h + (size_t)(row0 + ai * HALF + m * 16) * D + col0;
#pragma unroll
                for (int bj = 0; bj < 2; ++bj) { const f32x4 v0 = acc[ai][bj][m][0], v1 = acc[ai][bj][m][1];
                    u32x4 w; w.x = cvt_pk_bf16(v0[0], v0[1]); w.y = cvt_pk_bf16(v0[2], v0[3]); w.z = cvt_pk_bf16(v1[0], v1[1]); w.w = cvt_pk_bf16(v1[2], v1[3]);
                    *(u32x4*)(rowp + bj * HALF) = w; } }
    } };
struct EpiGateUp { static constexpr bool PERM = true, ACC_INIT = false, SIGNAL = false; bf16* H;
    __device__ __forceinline__ void operator()(const f32x4 (&acc)[2][2][4][2], const Unit& u, int wr, int wc, int, int) const {
        const int t2 = lane_now(), fr = t2 & 15, fq = t2 >> 4;
        const int row0 = u.pm * BM + wr * 64 + fr, col0 = u.pn * HALF + wc * 32 + 8 * fq;
#pragma unroll
        for (int ai = 0; ai < 2; ++ai)
#pragma unroll
            for (int m = 0; m < 4; ++m) { bf16* rowp = H + (size_t)(row0 + ai * HALF + m * 16) * DE + col0; float v[8];
#pragma unroll
                for (int n = 0; n < 2; ++n)
#pragma unroll
                    for (int j = 0; j < 4; ++j) v[4 * n + j] = silu_(acc[ai][0][m][n][j]) * acc[ai][1][m][n][j];
                u32x4 w; w.x = cvt_pk_bf16(v[0], v[1]); w.y = cvt_pk_bf16(v[2], v[3]); w.z = cvt_pk_bf16(v[4], v[5]); w.w = cvt_pk_bf16(v[6], v[7]);
                *(u32x4*)rowp = w; }
    } };
struct EpiGateUpPub { static constexpr bool PERM = true, ACC_INIT = false, SIGNAL = true; __amdgpu_buffer_rsrc_t rs; unsigned* done;
    __device__ __forceinline__ void operator()(const f32x4 (&acc)[2][2][4][2], const Unit& u, int wr, int wc, int fr, int fq) const {
        asm volatile("" : "+v"(fr), "+v"(fq));
        const int row0 = u.pm * BM + wr * 64 + fr, col0 = u.pn * HALF + wc * 32 + 8 * fq;
#pragma unroll
        for (int ai = 0; ai < 2; ++ai)
#pragma unroll
            for (int m = 0; m < 4; ++m) { const unsigned off = (unsigned)(((row0 + ai * HALF + m * 16) * DE + col0) * 2); float v[8];
#pragma unroll
                for (int n = 0; n < 2; ++n)
#pragma unroll
                    for (int j = 0; j < 4; ++j) v[4 * n + j] = silu_(acc[ai][0][m][n][j]) * acc[ai][1][m][n][j];
                u32x4 w; w.x = cvt_pk_bf16(v[0], v[1]); w.y = cvt_pk_bf16(v[2], v[3]); w.z = cvt_pk_bf16(v[4], v[5]); w.w = cvt_pk_bf16(v[6], v[7]);
                __builtin_amdgcn_raw_buffer_store_b128(w, rs, off, 0, 16); }
    }
    __device__ __forceinline__ void signal(const Unit& u) const { (void)ag_add(done + u.pm, 1u); }
};
struct EpiPG { static constexpr bool PERM = true, ACC_INIT = false, SIGNAL = false; bf16* h; const bf16* PE; const float* rstd_pe; const float* norm_pe;
    __device__ __forceinline__ void operator()(const f32x4 (&acc)[2][2][4][2], const Unit& u, int wr, int wc, int fr, int fq) const {
        asm volatile("" : "+v"(fr), "+v"(fq));
        const int row0 = u.pm * BM + wr * 64 + fr, col0 = u.pn * BM + wc * 32 + 8 * fq;
        f32x4 nv[2][2];
#pragma unroll
        for (int bj = 0; bj < 2; ++bj)
#pragma unroll
            for (int n = 0; n < 2; ++n) nv[bj][n] = *(const f32x4*)(norm_pe + col0 + bj * HALF + 4 * n);
#pragma unroll
        for (int ai = 0; ai < 2; ++ai)
#pragma unroll
            for (int m = 0; m < 4; ++m) { const int row = row0 + ai * HALF + m * 16; const float rs = rstd_pe[row];
#pragma unroll
                for (int bj = 0; bj < 2; ++bj) { const size_t o = (size_t)row * D + col0 + bj * HALF; const u32x4 pe = *(const u32x4*)(PE + o); const u32x4 hx = *(const u32x4*)(h + o);
                    f32x4 h0 = (f32x4){bflo(hx.x), bfhi(hx.x), bflo(hx.y), bfhi(hx.y)}, h1 = (f32x4){bflo(hx.z), bfhi(hx.z), bflo(hx.w), bfhi(hx.w)}; const f32x4 a0 = acc[ai][bj][m][0], a1 = acc[ai][bj][m][1];
                    const f32x4 e0 = (f32x4){bflo(pe.x), bfhi(pe.x), bflo(pe.y), bfhi(pe.y)} * rs * nv[bj][0], e1 = (f32x4){bflo(pe.z), bfhi(pe.z), bflo(pe.w), bfhi(pe.w)} * rs * nv[bj][1];
                    h0 += (f32x4){sigmoid_(a0[0]), sigmoid_(a0[1]), sigmoid_(a0[2]), sigmoid_(a0[3])} * e0; h1 += (f32x4){sigmoid_(a1[0]), sigmoid_(a1[1]), sigmoid_(a1[2]), sigmoid_(a1[3])} * e1;
                    u32x4 w; w.x = pk2(h0[0], h0[1]); w.y = pk2(h0[2], h0[3]); w.z = pk2(h1[0], h1[1]); w.w = pk2(h1[2], h1[3]); *(u32x4*)(h + o) = w; } }
    } };

template <class Epi, class Sched>
__device__ __forceinline__ void gemm_phase(int wave, LAS unsigned char* lds, int K, const Sched& S, const Epi& E) {
    int wid = wave; asm volatile("" : "+s"(wid));
    const int lane = lane_now(), tid = (wid << 6) | lane, wr = wid >> 2, wc = wid & 3, fr = lane & 15, fq = lane >> 4;
    const int nt = K / BK;
    unsigned voffA[2], voffB[2];
#pragma unroll
    for (int i = 0; i < 2; ++i) { int R, C; stage_rc(tid * 16 + i * 8192, R, C); const int Rb = Epi::PERM ? ((R & ~31) + perm32(R & 31)) : R;
        voffA[i] = (unsigned)(R * K + C) * 2u; voffB[i] = (unsigned)(Rb * K + C) * 2u; }
    const size_t kstep = (size_t)(BK * 2);
    const size_t hstep = (size_t)HALF * K * 2;
    const unsigned ldsw = (unsigned)wid * 1024u;
    const int aoff = lds_byte(wr * 64 + fr, fq * 8), boff = lds_byte(wc * 32 + fr, fq * 8);
#define PG8_SA(b, h) (((b) * 2 + (h)) * HTB)
#define PG8_SB(b, h) ((4 + (b) * 2 + (h)) * HTB)
#define PG8_STAGE(bufoff, gbase, voff) do { _Pragma("unroll") for (int _i = 0; _i < 2; ++_i) \
        __builtin_amdgcn_global_load_lds((const unsigned*)((const char*)(gbase) + (voff)[_i]), (LAS unsigned*)(lds + (bufoff) + ldsw + _i * 8192), 16, 0, 0); } while (0)
#define PG8_LDA(dst, b, h) do { _Pragma("unroll") for (int m = 0; m < 4; ++m) _Pragma("unroll") for (int k = 0; k < 2; ++k) dst[m][k] = *(const LAS bf16x8*)(lds + PG8_SA(b, h) + aoff + m * 2048 + k * 1024); } while (0)
#define PG8_LDB(dst, b, h) do { _Pragma("unroll") for (int n = 0; n < 2; ++n) _Pragma("unroll") for (int k = 0; k < 2; ++k) dst[n][k] = *(const LAS bf16x8*)(lds + PG8_SB(b, h) + boff + n * 2048 + k * 1024); } while (0)
#define PG8_MMA(ai, bj, At, Bt) do { __builtin_amdgcn_s_setprio(1); _Pragma("unroll") for (int m = 0; m < 4; ++m) _Pragma("unroll") for (int n = 0; n < 2; ++n) _Pragma("unroll") for (int k = 0; k < 2; ++k) \
        acc[ai][bj][m][n] = __builtin_amdgcn_mfma_f32_16x16x32_bf16(Bt[n][k], At[m][k], acc[ai][bj][m][n], 0, 0, 0); __builtin_amdgcn_s_setprio(0); } while (0)
#define PG8_WAIT_V(n) asm volatile("s_waitcnt vmcnt(" #n ")" ::: "memory")
#define PG8_WAIT_L(n) asm volatile("s_waitcnt lgkmcnt(" #n ")" ::: "memory")
#define PG8_BAR __builtin_amdgcn_s_barrier()
#define PG8_SCHED __builtin_amdgcn_sched_barrier(0)
    Unit cur, nxt; int ui = 0;
    if (!S.next(0, cur)) return;
    if constexpr (Sched::DEPS) { S.wait(cur, wid); PG8_BAR; }
    f32x4 acc[2][2][4][2];
    if constexpr (Epi::ACC_INIT) E.init(acc, cur, wr, wc, fr, fq);
    else {
#pragma unroll
    for (int a = 0; a < 2; ++a)
#pragma unroll
        for (int b = 0; b < 2; ++b)
#pragma unroll
            for (int m = 0; m < 4; ++m)
#pragma unroll
                for (int n = 0; n < 2; ++n) acc[a][b][m][n] = (f32x4){0.f, 0.f, 0.f, 0.f}; }
    bf16x8 At[4][2], B0[2][2], B1[2][2];
    const char* cA = cur.A; const char* cB = cur.B;
    PG8_STAGE(PG8_SB(0, 0), cB, voffB); PG8_STAGE(PG8_SB(0, 1), cB + hstep, voffB); PG8_STAGE(PG8_SA(0, 0), cA, voffA); PG8_STAGE(PG8_SA(0, 1), cA + hstep, voffA);
    if (wr == 1) PG8_BAR;
    PG8_WAIT_V(2); PG8_BAR;
    PG8_STAGE(PG8_SB(1, 0), cB + kstep, voffB); PG8_STAGE(PG8_SA(1, 0), cA + kstep, voffA); PG8_STAGE(PG8_SB(1, 1), cB + hstep + kstep, voffB);
    PG8_WAIT_V(6); PG8_BAR;
    for (;;) {
        const bool has_next = S.next(ui + 1, nxt);
        const char* nA = has_next ? nxt.A : cA; const char* nB = has_next ? nxt.B : cB;
        for (int t = 0; t < nt; t += 2) {
            const bool last = (t == nt - 2);
            if constexpr (Sched::DEPS) { if (last && has_next) S.wait(nxt, wid); }
            const char* a1 = cA + (size_t)(t + 1) * kstep;
            const char* a2 = last ? nA : cA + (size_t)(t + 2) * kstep; const char* b2 = last ? nB : cB + (size_t)(t + 2) * kstep;
            const char* a3 = a2 + kstep; const char* b3 = b2 + kstep;
            PG8_LDB(B0, 0, 0); PG8_LDB(B1, 0, 1); PG8_SCHED; PG8_LDA(At, 0, 0); PG8_STAGE(PG8_SA(1, 1), a1 + hstep, voffA);
            PG8_WAIT_V(8); PG8_WAIT_L(0); PG8_BAR; PG8_MMA(0, 0, At, B0); PG8_MMA(0, 1, At, B1); PG8_BAR; PG8_SCHED;
            PG8_LDA(At, 0, 1); PG8_STAGE(PG8_SB(0, 0), b2, voffB); PG8_STAGE(PG8_SB(0, 1), b2 + hstep, voffB); PG8_STAGE(PG8_SA(0, 0), a2, voffA);
            PG8_WAIT_V(8); PG8_WAIT_L(0); PG8_BAR; PG8_MMA(1, 0, At, B0); PG8_MMA(1, 1, At, B1); PG8_BAR; PG8_SCHED;
            PG8_LDB(B0, 1, 0); PG8_LDB(B1, 1, 1); PG8_SCHED; PG8_LDA(At, 1, 0); PG8_STAGE(PG8_SA(0, 1), a2 + hstep, voffA);
            PG8_WAIT_V(8); PG8_WAIT_L(0); PG8_BAR; PG8_MMA(0, 0, At, B0); PG8_MMA(0, 1, At, B1); PG8_BAR; PG8_SCHED;
            PG8_LDA(At, 1, 1); PG8_STAGE(PG8_SB(1, 0), b3, voffB); PG8_STAGE(PG8_SB(1, 1), b3 + hstep, voffB); PG8_STAGE(PG8_SA(1, 0), a3, voffA);
            PG8_WAIT_V(8); PG8_WAIT_L(0); PG8_BAR; PG8_MMA(1, 0, At, B0); PG8_MMA(1, 1, At, B1); PG8_BAR; PG8_SCHED;
        }
        if (wr == 0) PG8_BAR;
        E(acc, cur, wr, wc, fr, fq);
        if constexpr (Epi::SIGNAL) { PG8_WAIT_V(0); PG8_BAR; if (tid == 0) E.signal(cur); }
        if (!has_next) break;
        if constexpr (Epi::ACC_INIT) E.init(acc, nxt, wr, wc, fr, fq);
        else {
#pragma unroll
        for (int a = 0; a < 2; ++a)
#pragma unroll
            for (int b = 0; b < 2; ++b)
#pragma unroll
                for (int m = 0; m < 4; ++m)
#pragma unroll
                    for (int n = 0; n < 2; ++n) acc[a][b][m][n] = (f32x4){0.f, 0.f, 0.f, 0.f}; }
        cur = nxt; cA = nA; cB = nB; ++ui;
        if (wr == 1) PG8_BAR;
    }
    PG8_WAIT_V(0);
    PG8_BAR;
#undef PG8_SA
#undef PG8_SB
#undef PG8_STAGE
#undef PG8_LDA
#undef PG8_LDB
#undef PG8_MMA
#undef PG8_WAIT_V
#undef PG8_WAIT_L
#undef PG8_BAR
#undef PG8_SCHED
}
}

__device__ __forceinline__ void phase_gemm_pe(const Frame& F) {
    pg8::DenseOrder S; S.init(F.ws + WS_PB, F.ws + WS_WPE, T, D, PD, DEPTH, F.G, F.blk); pg8::EpiBf16 E{(bf16*)(F.ws + WS_PE), D};
    pg8::gemm_phase(F.wave, F.lds, PD, S, E);
}
__device__ __forceinline__ void phase_gemm_in(const Frame& F, int l) {
    pg8::DenseOrder S; S.init(F.ws + WS_XN, (bf16*)(F.ws + WS_WIN) + (size_t)l * DIN * D, T, DIN, D, 1, F.G, F.blk); pg8::EpiBf16 E{(bf16*)(F.ws + WS_Z), DIN};
    pg8::gemm_phase(F.wave, F.lds, D, S, E);
}
__device__ __forceinline__ void phase_gemm_out(const Frame& F, int l) {
    pg8::DenseOrder S; S.init(F.ws + WS_O, (bf16*)(F.ws + WS_WOUT) + (size_t)l * D * D, T, D, D, 1, F.G, F.blk); pg8::EpiResid E{(bf16*)(F.ws + WS_H)};
    pg8::gemm_phase(F.wave, F.lds, D, S, E);
}
__device__ __forceinline__ void phase_gemm_moe1(const Frame& F, int l) {
    pg8::MoeOrder S; S.init(F.ws + WS_XB, (bf16*)(F.ws + WS_WGU) + (size_t)l * NE * 1024 * 1024, (const int*)(F.ws + MS_BLKE) + l * 256, D, 4, (size_t)1024 * 1024 * 2, F.G, F.blk); pg8::EpiGateUp E{(bf16*)(F.ws + WS_HB)};
    pg8::gemm_phase(F.wave, F.lds, D, S, E);
    { const int nun = S.nrb * 4, rem = nun % F.G, few = (rem == 0 || F.G - rem < 64), idle = few ? F.G : F.G - rem, first = few ? 0 : rem;
      if (F.blk >= first) { pg8::DenseOrder P; P.init((const bf16*)(F.ws + WS_PB) + (size_t)l * T * PD, (const bf16*)(F.ws + WS_WPE) + (size_t)l * D * PD, T, D, PD, 1, idle, F.blk - first);
          pg8::EpiBf16 EP{(bf16*)(F.ws + WS_PE) + (size_t)l * T * D, D}; pg8::gemm_phase(F.wave, F.lds, PD, P, EP); }
      conv_deferred(F, l + 1, 0, NDEF1, first, idle); }
}
__device__ __forceinline__ void phase_gemm_moe2(const Frame& F, int l) {
    pg8::MoeOrder S; S.init(F.ws + WS_HB, (bf16*)(F.ws + WS_WD) + (size_t)l * NE * D * DE, (const int*)(F.ws + MS_BLKE) + l * 256, DE, 4, (size_t)D * DE * 2, F.G, F.blk); pg8::EpiBf16 E{(bf16*)(F.ws + WS_Y), D};
    pg8::gemm_phase(F.wave, F.lds, DE, S, E);
    { const int nun = S.nrb * 4, rem = nun % F.G, few = (rem == 0 || F.G - rem < 64), idle = few ? F.G : F.G - rem, first = few ? 0 : rem;
      conv_deferred(F, l + 1, NDEF1, NDEF, first, idle); }
}
#ifndef MOE_CPE
#define MOE_CPE 5
#endif
#ifndef MOE_CTL
#define MOE_CTL 4
#endif
#ifndef MOE_X1
#define MOE_X1 16
#define MOE_X2 8
#endif
template <int MODE = 0> __device__ __forceinline__ void phase_moe_fused(const Frame& F, int l) {
    unsigned char* ws = F.ws; const int G = F.G, blk = F.blk;
    const int* blke = (const int*)(ws + MS_BLKE) + l * 256;
    unsigned* done = (unsigned*)(ws + WS_CTL) + CW_DONE + l * 256;
    const int nrb = __builtin_amdgcn_readfirstlane(blke[255]), nu = 4 * nrb, e1 = nu % G;
    if constexpr (MODE == 1) { pg8::MoeOrder S; S.init(ws + WS_XB, (bf16*)(ws + WS_WGU) + (size_t)l * NE * 1024 * 1024, blke, D, 4, (size_t)1024 * 1024 * 2, G, blk);
      pg8::EpiGateUp E{(bf16*)(ws + WS_HB)}; pg8::gemm_phase(F.wave, F.lds, D, S, E); return; }
    if constexpr (MODE == 0) { pg8::MoeOrder S; S.init(ws + WS_XB, (bf16*)(ws + WS_WGU) + (size_t)l * NE * 1024 * 1024, blke, D, 4, (size_t)1024 * 1024 * 2, G, blk);
      pg8::EpiGateUpPub E{__builtin_amdgcn_make_buffer_rsrc(ws + WS_HB, 0, (int)((size_t)CAP * DE * 2), 0x00020000), done};
      pg8::gemm_phase(F.wave, F.lds, D, S, E); }
    if constexpr (MODE == 2) { pg8::MoeOrder S; S.init(ws + WS_HB, (bf16*)(ws + WS_WD) + (size_t)l * NE * D * DE, blke, DE, 4, (size_t)D * DE * 2, G, blk >= e1 ? blk - e1 : blk - e1 + G);
      pg8::EpiBf16 E{(bf16*)(ws + WS_Y), D}; pg8::gemm_phase(F.wave, F.lds, DE, S, E); }
    if constexpr (MODE == 0) { pg8::MoeDepOrder S; S.init(ws + WS_HB, (bf16*)(ws + WS_WD) + (size_t)l * NE * D * DE, blke, done, DE, 4, (size_t)D * DE * 2, G, blk >= e1 ? blk - e1 : blk - e1 + G);
      pg8::EpiBf16 E{(bf16*)(ws + WS_Y), D};
      pg8::gemm_phase(F.wave, F.lds, DE, S, E); }
    { const int nt = (l + 1 < DEPTH) ? NDEF : 0, ftot = 256 * MOE_CPE + nt * MOE_CTL;
      const int wrap = 2 * e1 > G ? 2 * e1 - G : 0;
      auto cls = [&](int x, int& c24, int& c16, int& c8, int& c0) {
          const int cA = x < e1 ? x : e1, cAB = x < wrap ? x : wrap;
          int cB = x - e1; cB = cB < 0 ? 0 : cB; if (!wrap) cB = cB > e1 ? e1 : cB; cB += cAB;
          c24 = cAB; c16 = cA - cAB; c8 = cB - cAB; c0 = x - c24 - c16 - c8; };
      auto fill = [&](int x, int lv) { int c24, c16, c8, c0; cls(x, c24, c16, c8, c0);
          return c0 * lv + c8 * (lv > MOE_X2 ? lv - MOE_X2 : 0) + c16 * (lv > MOE_X1 ? lv - MOE_X1 : 0) + c24 * (lv > MOE_X1 + MOE_X2 ? lv - MOE_X1 - MOE_X2 : 0); };
      int lv = 1; while (fill(G, lv) < ftot) ++lv;
      const int B0 = fill(blk, lv), B1 = fill(blk + 1, lv);
      const int pe_tot = 256 * MOE_CPE;
      int j0 = (B0 + MOE_CPE - 1) / MOE_CPE, j1 = (B1 + MOE_CPE - 1) / MOE_CPE; j0 = j0 < 256 ? j0 : 256; j1 = j1 < 256 ? j1 : 256;
      int t0 = B0 > pe_tot ? (B0 - pe_tot + MOE_CTL - 1) / MOE_CTL : 0, t1 = B1 > pe_tot ? (B1 - pe_tot + MOE_CTL - 1) / MOE_CTL : 0; t0 = t0 < nt ? t0 : nt; t1 = t1 < nt ? t1 : nt;
      if (j1 > j0) { pg8::RangeOrder P; P.init((const bf16*)(ws + WS_PB) + (size_t)l * T * PD, (const bf16*)(ws + WS_WPE) + (size_t)l * D * PD, T, D, PD, j0, j1 - j0);
          pg8::EpiBf16 EP{(bf16*)(ws + WS_PE) + (size_t)l * T * D, D}; pg8::gemm_phase(F.wave, F.lds, PD, P, EP); }
      if (t1 > t0) { const int base = (l + 1) * TL_LAYER + t0; conv_run(F, 0, 1, t1 - t0, [=](int f) { return base + f; }); } }
}
__device__ __forceinline__ void phase_gemm_pg(const Frame& F, int l) {
    pg8::DenseOrder S; S.init(F.ws + WS_XN, (bf16*)(F.ws + WS_WPG) + (size_t)l * D * D, T, D, D, 1, F.G, F.blk);
    pg8::EpiPG E{(bf16*)(F.ws + WS_H), (const bf16*)(F.ws + WS_PE) + (size_t)l * T * D, (const float*)(F.ws + MS_RSTDPE), F.in[22] + l * D};
    pg8::gemm_phase(F.wave, F.lds, D, S, E);
}

typedef short s16x4 __attribute__((ext_vector_type(4)));
__device__ __forceinline__ bf16x8 tr_frag(LAS unsigned char* p_lo, LAS unsigned char* p_hi) {
    const s16x4 lo = __builtin_amdgcn_ds_read_tr16_b64_v4i16((LAS s16x4*)p_lo), hi = __builtin_amdgcn_ds_read_tr16_b64_v4i16((LAS s16x4*)p_hi);
    return __builtin_shufflevector(lo, hi, 0, 1, 2, 3, 4, 5, 6, 7); }
#define MFMA16(a, b, c) __builtin_amdgcn_mfma_f32_16x16x32_bf16((a), (b), (c), 0, 0, 0)
constexpr int RP = 272;
constexpr int VP = 1040;

__device__ __forceinline__ void phase_rec_c1(const Frame& F, int l) {
    PH_TID();
    unsigned char* ws = F.ws; const bf16* Z = (const bf16*)(ws + WS_Z);
    bf16* UT = (bf16*)(ws + WS_UT); float* DC = (float*)(ws + MS_DC); float* MM = (float*)(ws + MS_MM);
    const float* lb = (const float*)(ws + MS_LB) + l * DREC;
    LAS unsigned char* KD = F.lds; LAS unsigned char* IM = F.lds + 128 * RP; LAS float* totx = (LAS float*)(F.lds + 256 * RP);
    const int wave = ph_wave, ch = tid & 255, half = tid >> 8, hl = ch >> 7, k = ch & 127, g = lane >> 4, li = lane & 15, q = li >> 2, p = li & 3;
    const int hG = F.G / 2, nmine = (F.G == 256) ? (F.blk < hG ? 3 : 1) : 0;
    for (int ui = 0; (F.G == 256) ? (ui < nmine) : (F.blk + ui * F.G < 512); ++ui) {
        const int unit = (F.G == 256) ? (F.blk < hG ? F.blk + ui * hG : 3 * hG + (F.blk - hG)) : F.blk + ui * F.G;
        const int c = unit >> 1, hp = unit & 1, hh = 2 * hp + hl;
        const bf16* zb = Z + (size_t)(c * 64 + 32 * half) * DIN + 512 + hh * 128 + k;
        const float lbk = lb[hh * 128 + k];
        float cs[32], kk[32]; float run = 1.f;
#pragma unroll
        for (int t = 0; t < 32; ++t) { const float fz = bf2f(zb[(size_t)t * DIN]); const float sg = sigmoid_(fz); run *= lbk + (1.f - lbk) * sg; cs[t] = run; kk[t] = (1.f - lbk) * (1.f - sg); }
        totx[half * 256 + ch] = run;
#pragma unroll
        for (int j = 0; j < 4; ++j) { const int idx = tid + 512 * j, hl2 = idx >> 10, row = (idx >> 4) & 63, cc = idx & 15;
            const u32x4 v = *(const u32x4*)(Z + (size_t)(c * 64 + row) * DIN + 1024 + (2 * hp + hl2) * 128 + cc * 8);
            *(LAS u32x4*)(IM + (hl2 * 64 + row) * RP + cc * 16) = v; }
        __syncthreads();
        const float other = totx[(1 - half) * 256 + ch]; const float p63 = run * other; const float base_p = half == 0 ? p63 : run;
#pragma unroll
        for (int t = 0; t < 32; ++t) *(LAS bf16*)(KD + (hl * 64 + 32 * half + t) * RP + 2 * k) = (bf16)f2bf(kk[t] * base_p * frcp(fmaxf(cs[t], 1e-30f)));
        if (half == 0) { DC[(c * 4 + hh) * 128 + k] = p63; MM[(c * 4 + hh) * 128 + k] = run; }
        __syncthreads();
        { const int whl = wave >> 2, kt0 = 2 * (wave & 3), whh = 2 * hp + whl;
          f32x4 acc[2][8];
#pragma unroll
          for (int i = 0; i < 2; ++i)
#pragma unroll
              for (int vt = 0; vt < 8; ++vt) acc[i][vt] = (f32x4){0.f, 0.f, 0.f, 0.f};
          LAS unsigned char* kdb = KD + whl * 64 * RP; LAS unsigned char* imb = IM + whl * 64 * RP;
#pragma unroll
          for (int a = 0; a < 2; ++a) { const unsigned ro = (unsigned)((32 * a + 8 * g + q) * RP);
              bf16x8 Af[2];
#pragma unroll
              for (int i = 0; i < 2; ++i) { const unsigned co = (unsigned)((16 * (kt0 + i) + 4 * p) * 2); Af[i] = tr_frag(kdb + ro + co, kdb + ro + 4 * RP + co); }
#pragma unroll
              for (int vt = 0; vt < 8; ++vt) { const unsigned co = (unsigned)((16 * vt + 4 * p) * 2); const bf16x8 Bf = tr_frag(imb + ro + co, imb + ro + 4 * RP + co);
#pragma unroll
                  for (int i = 0; i < 2; ++i) acc[i][vt] = MFMA16(Af[i], Bf, acc[i][vt]); } }
#pragma unroll
          for (int i = 0; i < 2; ++i)
#pragma unroll
              for (int vt = 0; vt < 8; ++vt) { u32x2 w; w.x = pg8::cvt_pk_bf16(acc[i][vt][0], acc[i][vt][1]); w.y = pg8::cvt_pk_bf16(acc[i][vt][2], acc[i][vt][3]);
                  *(u32x2*)(UT + ((size_t)(c * 4 + whh) * 128 + 16 * vt + li) * 128 + 16 * (kt0 + i) + 4 * g) = w; } }
        __syncthreads();
    }
}
__device__ __forceinline__ void phase_rec_c2a(const Frame& F) {
    PH_TID();
    unsigned char* ws = F.ws; const unsigned* UT = (const unsigned*)(ws + WS_UT); const float* DC = (const float*)(ws + MS_DC);
    f32x2* LT = (f32x2*)(ws + WS_LTOT); float* PT = (float*)(ws + MS_PTOT);
    for (int it = F.blk * NTHR + tid; it < 16 * 32768; it += F.G * NTHR) {
        const int gs = it >> 15, e = it & 32767, hh = e >> 13, v = (e >> 6) & 127, k0 = 2 * (e & 63);
        float S0 = 0.f, S1 = 0.f, P0 = 1.f, P1 = 1.f;
#pragma unroll
        for (int cc = 0; cc < 16; ++cc) { const int c = 16 * gs + cc; const unsigned u = UT[(size_t)c * 32768 + e]; const f32x2 d = *(const f32x2*)(DC + (c * 4 + hh) * 128 + k0);
            S0 = d.x * S0 + bflo(u); S1 = d.y * S1 + bfhi(u); P0 *= d.x; P1 *= d.y; }
        LT[it] = (f32x2){S0, S1};
        if (v == 0) *(f32x2*)(PT + (gs * 4 + hh) * 128 + k0) = (f32x2){P0, P1};
    }
}
__device__ __forceinline__ void phase_rec_c2c(const Frame& F) {
    PH_TID();
    unsigned char* ws = F.ws; const unsigned* UT = (const unsigned*)(ws + WS_UT); unsigned* ST = (unsigned*)(ws + WS_ST); const float* DC = (const float*)(ws + MS_DC); const float* MM = (const float*)(ws + MS_MM);
    const f32x2* LT = (const f32x2*)(ws + WS_LTOT); const float* PT = (const float*)(ws + MS_PTOT);
    for (int it = F.blk * NTHR + tid; it < 16 * 32768; it += F.G * NTHR) {
        const int gs = it >> 15, e = it & 32767, hh = e >> 13, k0 = 2 * (e & 63);
        float C0 = 0.f, C1 = 0.f;
        for (int g2 = 0; g2 < gs; ++g2) { const f32x2 pt = *(const f32x2*)(PT + (g2 * 4 + hh) * 128 + k0); const f32x2 lt = LT[g2 * 32768 + e]; C0 = pt.x * C0 + lt.x; C1 = pt.y * C1 + lt.y; }
#pragma unroll
        for (int cc = 0; cc < 16; ++cc) { const int c = 16 * gs + cc; const f32x2 mm = *(const f32x2*)(MM + (c * 4 + hh) * 128 + k0);
            ST[(size_t)c * 32768 + e] = pk2(C0 * mm.x, C1 * mm.y);
            const unsigned u = UT[(size_t)c * 32768 + e]; const f32x2 d = *(const f32x2*)(DC + (c * 4 + hh) * 128 + k0);
            C0 = d.x * C0 + bflo(u); C1 = d.y * C1 + bfhi(u); }
    }
}
__device__ __forceinline__ void phase_rec_c2(const Frame& F) {
    PH_TID();
    unsigned char* ws = F.ws; const int w = ph_wave;
    LAS float* tot = (LAS float*)F.lds;
    for (int unit = F.blk; unit < 256; unit += F.G) {
        const int hh = unit >> 6; const unsigned eo = (unsigned)(unit * 128 + lane), ko = (unsigned)(hh * 128 + 2 * lane);
        const unsigned* ut = (const unsigned*)(ws + WS_UT) + (size_t)(32 * w) * 32768; unsigned* st = (unsigned*)(ws + WS_ST) + (size_t)(32 * w) * 32768;
        const float* dc = (const float*)(ws + MS_DC) + (32 * w) * 512; const float* mmp = (const float*)(ws + MS_MM) + (32 * w) * 512;
        asm volatile("" : "+s"(ut), "+s"(st), "+s"(dc), "+s"(mmp));
        unsigned ua[32], ub[32]; f32x2 d[32], m0[16], m1[16];
#pragma unroll
        for (int cc = 0; cc < 32; ++cc) { ua[cc] = (ut + cc * 32768)[eo]; ub[cc] = (ut + cc * 32768 + 64)[eo]; d[cc] = *(const f32x2*)((dc + cc * 512) + ko); }
        __builtin_amdgcn_sched_barrier(0);
        float a0 = 0.f, a1 = 0.f, b0 = 0.f, b1 = 0.f, p0 = 1.f, p1 = 1.f;
#pragma unroll
        for (int cc = 0; cc < 32; ++cc) { a0 = d[cc].x * a0 + bflo(ua[cc]); a1 = d[cc].y * a1 + bfhi(ua[cc]); b0 = d[cc].x * b0 + bflo(ub[cc]); b1 = d[cc].y * b1 + bfhi(ub[cc]); p0 *= d[cc].x; p1 *= d[cc].y; }
        { LAS float* tw = tot + w * 384 + lane; tw[0] = a0; tw[64] = a1; tw[128] = b0; tw[192] = b1; tw[256] = p0; tw[320] = p1; }
        __builtin_amdgcn_sched_barrier(0);
#pragma unroll
        for (int cc = 0; cc < 16; ++cc) m0[cc] = *(const f32x2*)((mmp + cc * 512) + ko);
        __builtin_amdgcn_sched_barrier(0);
        __syncthreads();
        float A0 = 0.f, A1 = 0.f, B0 = 0.f, B1 = 0.f;
        for (int g2 = 0; g2 < w; ++g2) { const LAS float* tw = tot + g2 * 384 + lane; const float q0 = tw[256], q1 = tw[320]; A0 = q0 * A0 + tw[0]; A1 = q1 * A1 + tw[64]; B0 = q0 * B0 + tw[128]; B1 = q1 * B1 + tw[192]; }
        __builtin_amdgcn_sched_barrier(0);
#pragma unroll
        for (int cc = 0; cc < 16; ++cc) m1[cc] = *(const f32x2*)((mmp + (16 + cc) * 512) + ko);
        __builtin_amdgcn_sched_barrier(0);
#pragma unroll
        for (int cc = 0; cc < 32; ++cc) { const f32x2 mm = cc < 16 ? m0[cc & 15] : m1[cc & 15];
            (st + cc * 32768)[eo] = pk2(A0 * mm.x, A1 * mm.y); (st + cc * 32768 + 64)[eo] = pk2(B0 * mm.x, B1 * mm.y);
            unsigned xa = ua[cc], xb = ub[cc]; asm volatile("" : "+v"(xa), "+v"(xb));
            A0 = d[cc].x * A0 + bflo(xa); A1 = d[cc].y * A1 + bfhi(xa); B0 = d[cc].x * B0 + bflo(xb); B1 = d[cc].y * B1 + bfhi(xb);
            asm volatile("" : "+v"(A0), "+v"(A1), "+v"(B0), "+v"(B1) :: "memory"); }
        __syncthreads();
    }
}
template <int PV = 0> __device__ __forceinline__ void phase_rec_c3(const Frame& F, int l) {
    PH_TID();
    unsigned char* ws = F.ws; const bf16* Z = (const bf16*)(ws + WS_Z); const bf16* ST = (const bf16*)(ws + WS_ST); bf16* O = (bf16*)(ws + WS_O);
    const float* lb = (const float*)(ws + MS_LB) + l * DREC; const float* ogain = F.in[5] + l * 128;
    LAS unsigned char* QT = F.lds; LAS unsigned char* KT = F.lds + 128 * RP; LAS unsigned char* IM = F.lds + 256 * RP;
    const int wave = ph_wave, ch = tid & 255, half = tid >> 8, hl = ch >> 7, k = ch & 127, g = lane >> 4, li = lane & 15, q = li >> 2, p = li & 3;
    for (int unit = F.blk; unit < 512; unit += F.G) {
        const int c = unit >> 1, hp = unit & 1, hh = 2 * hp + hl;
#pragma unroll
        for (int j = 0; j < 4; ++j) { const int idx = tid + 512 * j, hl2 = idx >> 10, row = (idx >> 4) & 63, cc = idx & 15;
            const bf16* src = Z + (size_t)(c * 64 + row) * DIN + (2 * hp + hl2) * 128 + cc * 8; const int dst = (hl2 * 64 + row) * RP + cc * 16;
            const u32x4 vq = *(const u32x4*)src, vf = *(const u32x4*)(src + 512), vi = *(const u32x4*)(src + 1024);
            *(LAS u32x4*)(QT + dst) = vq; *(LAS u32x4*)(KT + dst) = vf; *(LAS u32x4*)(IM + dst) = vi; }
        __syncthreads();
        { const float lbk = lb[hh * 128 + k]; const int col = (hl * 64 + 32 * half) * RP + 2 * k;
          float cs[32], kk[32], qs[32]; float run = 1.f;
#pragma unroll
          for (int t = 0; t < 32; ++t) { const float fz = bf2f(*(const LAS bf16*)(KT + col + t * RP)); const float sg = sigmoid_(fz); run *= lbk + (1.f - lbk) * sg; cs[t] = run; kk[t] = (1.f - lbk) * (1.f - sg);
              qs[t] = silu_(bf2f(*(const LAS bf16*)(QT + col + t * RP))); }
          const float inv = half == 0 ? frcp(fmaxf(run, 1e-30f)) : 1.f;
#pragma unroll
          for (int t = 0; t < 32; ++t) { const float ex = cs[t] * inv; const int off = col + t * RP;
              *(LAS bf16*)(QT + off) = (bf16)f2bf(qs[t] * ex); *(LAS bf16*)(KT + off) = (bf16)f2bf(kk[t] * frcp(fmaxf(ex, 1e-30f))); } }
        const int whl = wave >> 2, tt = wave & 3, whh = 2 * hp + whl;
        bf16x8 Sf[8][4];
#pragma unroll
        for (int vt = 0; vt < 8; ++vt)
#pragma unroll
            for (int a = 0; a < 4; ++a) Sf[vt][a] = *(const bf16x8*)(ST + ((size_t)(c * 4 + whh) * 128 + 16 * vt + li) * 128 + 32 * a + 8 * g);
        __syncthreads();
        if (PV != 1) {
          bf16 gz[8][4];
#pragma unroll
          for (int vt = 0; vt < 8; ++vt)
#pragma unroll
              for (int r = 0; r < 4; ++r) gz[vt][r] = Z[((size_t)c * 64 + 16 * tt + 4 * g + r) * DIN + 1536 + whh * 128 + 16 * vt + li];
          bf16x8 Qf[4];
#pragma unroll
          for (int a = 0; a < 4; ++a) Qf[a] = *(const LAS bf16x8*)(QT + (whl * 64 + 16 * tt + li) * RP + (32 * a + 8 * g) * 2);
          unsigned pw[4][2];
#pragma unroll
          for (int st = 0; st < 4; ++st) { pw[st][0] = 0u; pw[st][1] = 0u;
              { f32x4 s = (f32x4){0.f, 0.f, 0.f, 0.f};
#pragma unroll
                  for (int a = 0; a < 4; ++a) { const bf16x8 Kf = *(const LAS bf16x8*)(KT + (whl * 64 + 16 * st + li) * RP + (32 * a + 8 * g) * 2); s = MFMA16(Kf, Qf[a], s); }
                  if (st == tt) {
#pragma unroll
                      for (int r = 0; r < 4; ++r) if (4 * g + r > li) s[r] = 0.f; }
                  pw[st][0] = st <= tt ? pg8::cvt_pk_bf16(s[0], s[1]) : 0u; pw[st][1] = st <= tt ? pg8::cvt_pk_bf16(s[2], s[3]) : 0u; } }
          f32x4 acc[8];
#pragma unroll
          for (int vt = 0; vt < 8; ++vt) { acc[vt] = (f32x4){0.f, 0.f, 0.f, 0.f};
#pragma unroll
              for (int a = 0; a < 4; ++a) acc[vt] = MFMA16(Qf[a], Sf[vt][a], acc[vt]); }
          LAS unsigned char* imb = IM + whl * 64 * RP;
#pragma unroll
          for (int a = 0; a < 2; ++a) { const u32x4 pv = (u32x4){pw[2 * a][0], pw[2 * a][1], pw[2 * a + 1][0], pw[2 * a + 1][1]}; const bf16x8 Pf = __builtin_bit_cast(bf16x8, pv);
              const unsigned ro = (unsigned)((32 * a + 4 * g + q) * RP);
#pragma unroll
              for (int vt = 0; vt < 8; ++vt) { const unsigned co = (unsigned)((16 * vt + 4 * p) * 2); const bf16x8 If = tr_frag(imb + ro + co, imb + ro + 16 * RP + co); acc[vt] = MFMA16(Pf, If, acc[vt]); } }
          float rs[4];
#pragma unroll
          for (int r = 0; r < 4; ++r) { float ss = 0.f;
#pragma unroll
              for (int vt = 0; vt < 8; ++vt) ss += acc[vt][r] * acc[vt][r];
              ss += shx<1>(ss); ss += shx<2>(ss); ss += shx<4>(ss); ss += shx<8>(ss); rs[r] = frsq(ss * (1.f / 128.f) + EPS); }
#pragma unroll
          for (int vt = 0; vt < 8; ++vt) { const float og = ogain[16 * vt + li];
#pragma unroll
              for (int r = 0; r < 4; ++r) { const size_t t = (size_t)c * 64 + 16 * tt + 4 * g + r; const float gv = bf2f(gz[vt][r]);
                  O[t * D + whh * 128 + 16 * vt + li] = (bf16)f2bf(acc[vt][r] * rs[r] * og * silu_(gv)); } } }
        __syncthreads();
    }
}
__device__ __forceinline__ void phase_sgu(const Frame& F, int l) {
    PH_TID();
    unsigned char* ws = F.ws; const bf16* Z = (const bf16*)(ws + WS_Z); bf16* O = (bf16*)(ws + WS_O);
    const bf16* Wb = (const bf16*)(ws + MS_SGUW) + (size_t)l * 4 * 128 * 128; const float* sb = F.in[9] + l * 4 * 128;
    LAS unsigned char* VN = F.lds;
    const int wave = ph_wave, g = lane >> 4, li = lane & 15, q = li >> 2, p = li & 3;
    for (int unit = (F.blk + F.G / 2) % F.G; unit < 128; unit += F.G) {
        float lg[8], lbv[8];
#pragma unroll
        for (int j = 0; j < 8; ++j) { lg[j] = F.in[6][l * DSGU + 8 * lane + j]; lbv[j] = F.in[7][l * DSGU + 8 * lane + j]; }
        u32x4 raw[16];
#pragma unroll
        for (int i = 0; i < 16; ++i) raw[i] = *(const u32x4*)(Z + ((size_t)unit * 128 + 16 * wave + i) * DIN + 2560 + 8 * lane);
#pragma unroll
        for (int i = 0; i < 16; ++i) { const int s = 16 * wave + i; const u32x4 r = raw[i];
            float x[8] = {gelu_(bflo(r.x)), gelu_(bfhi(r.x)), gelu_(bflo(r.y)), gelu_(bfhi(r.y)), gelu_(bflo(r.z)), gelu_(bfhi(r.z)), gelu_(bflo(r.w)), gelu_(bfhi(r.w))};
            float sm = 0.f;
#pragma unroll
            for (int j = 0; j < 8; ++j) sm += x[j];
            const float mu = wave_sum(sm) * (1.f / 512.f); float qq = 0.f;
#pragma unroll
            for (int j = 0; j < 8; ++j) { x[j] -= mu; qq += x[j] * x[j]; }
            const float rstd = frsq(wave_sum(qq) * (1.f / 512.f) + EPS);
#pragma unroll
            for (int j = 0; j < 8; ++j) x[j] = x[j] * rstd * lg[j] + lbv[j];
            u32x4 o; o.x = pk2(x[0], x[1]); o.y = pk2(x[2], x[3]); o.z = pk2(x[4], x[5]); o.w = pk2(x[6], x[7]);
            *(LAS u32x4*)(VN + s * VP + lane * 16) = o; }
        __syncthreads();
        { const int hh = wave >> 1, dh = wave & 1; const bf16* W = Wb + (size_t)hh * 128 * 128;
          LAS unsigned char* vnb = VN;
#pragma unroll 1
          for (int dp = 0; dp < 2; ++dp) {
          bf16x8 Wf[2][8];
#pragma unroll
          for (int a = 0; a < 2; ++a)
#pragma unroll
              for (int ti = 0; ti < 8; ++ti) if (ti >= 2 * a) Wf[a][ti] = *(const bf16x8*)(W + (size_t)(16 * ti + li) * 128 + 32 * a + 8 * g);
          f32x4 acc[2][8];
#pragma unroll
          for (int dt = 0; dt < 2; ++dt)
#pragma unroll
              for (int ti = 0; ti < 8; ++ti) acc[dt][ti] = (f32x4){0.f, 0.f, 0.f, 0.f};
#pragma unroll
          for (int a = 0; a < 4; ++a) { const unsigned ro = (unsigned)((32 * a + 8 * g + q) * VP);
              bf16x8 Af[2];
#pragma unroll
              for (int dt = 0; dt < 2; ++dt) { const unsigned co = (unsigned)((hh * 128 + 64 * dh + 16 * (2 * dp + dt) + 4 * p) * 2); Af[dt] = tr_frag(vnb + ro + co, vnb + ro + 4 * VP + co); }
#pragma unroll
              for (int ti = 0; ti < 8; ++ti) if (ti >= 2 * a) {
                  const bf16x8 Bf = a < 2 ? Wf[a < 2 ? a : 0][ti] : *(const bf16x8*)(W + (size_t)(16 * ti + li) * 128 + 32 * a + 8 * g);
#pragma unroll
                  for (int dt = 0; dt < 2; ++dt) acc[dt][ti] = MFMA16(Af[dt], Bf, acc[dt][ti]); } }
#pragma unroll
          for (int ti = 0; ti < 8; ++ti) { const size_t t = (size_t)unit * 128 + 16 * ti + li; const float bias = sb[hh * 128 + 16 * ti + li];
#pragma unroll
              for (int dt = 0; dt < 2; ++dt) { const int col = hh * 128 + 64 * dh + 16 * (2 * dp + dt) + 4 * g; const u32x2 u = *(const u32x2*)(Z + t * DIN + 2048 + col);
                  u32x2 w; w.x = pk2((acc[dt][ti][0] + bias) * gelu_(bflo(u.x)), (acc[dt][ti][1] + bias) * gelu_(bfhi(u.x))); w.y = pk2((acc[dt][ti][2] + bias) * gelu_(bflo(u.y)), (acc[dt][ti][3] + bias) * gelu_(bfhi(u.y)));
                  *(u32x2*)(O + t * D + 512 + col) = w; } } } }
        __syncthreads();
    }
}

#define XB_TMO      128
#define XB_XCNT(j)  (256  + 64 * (j))
#define XB_XSUB(j)  (1280 + 64 * (j))
#define XB_XGEN(j)  (2304 + 64 * (j))
#define XB_TOP      3328
#define XB_TOPGEN   3392
#define XCD_BAR_WORDS 3456
#define XB_SPIN_CAP (1u << 18)
__device__ __forceinline__ unsigned xb_ld(unsigned* p)              { return __hip_atomic_load(p, __ATOMIC_RELAXED, __HIP_MEMORY_SCOPE_AGENT); }
__device__ __forceinline__ unsigned xb_add(unsigned* p, unsigned v) { return __hip_atomic_fetch_add(p, v, __ATOMIC_RELAXED, __HIP_MEMORY_SCOPE_AGENT); }
__device__ __forceinline__ unsigned xb_xcc_id() { return (unsigned)__builtin_amdgcn_s_getreg((3 << 11) | 20) & 0xFu; }
#define XB_SPIN(cond, bar) do { unsigned _sp = 0; while (cond) { __builtin_amdgcn_s_sleep(1); \
    if ((++_sp & 255u) == 0u) { if (xb_ld(&(bar)[XB_TMO])) break; if (_sp > XB_SPIN_CAP) { atomicAdd(&(bar)[XB_TMO], 1u); break; } } } } while (0)
struct XcdBarrier { unsigned* bar; unsigned x; volatile LAS unsigned* st; int wave; };
__device__ __forceinline__ XcdBarrier xcd_barrier_post(unsigned* bar, volatile LAS unsigned* st, int wave) {
    XcdBarrier b; b.bar = bar; b.x = xb_xcc_id(); b.st = st; b.wave = wave;
    if (wave == 0 && lane_now() == 0) (void)xb_add(&bar[XB_XCNT(b.x)], 1u);
    return b;
}
__device__ __forceinline__ void xcd_barrier_complete(unsigned* bar, unsigned x, unsigned& nloc, unsigned& nx) {
    const unsigned G = gridDim.x * gridDim.y * gridDim.z;
    unsigned sum, cnt, mine, sp = 0u;
    for (;;) {
        sum = 0u; cnt = 0u; mine = 0u;
#pragma unroll
        for (unsigned j = 0; j < 16; ++j) { const unsigned c = xb_ld(&bar[XB_XCNT(j)]); sum += c; cnt += (c > 0u) ? 1u : 0u; mine = (j == x) ? c : mine; }
        if (sum == G) break;
        __builtin_amdgcn_s_sleep(1);
        if ((++sp & 255u) == 0u) { if (xb_ld(&bar[XB_TMO])) break; if (sp > XB_SPIN_CAP) { atomicAdd(&bar[XB_TMO], 1u); break; } }
    }
    nloc = mine > 0u ? mine : 1u; nx = cnt > 0u ? cnt : 1u;
}
__device__ __forceinline__ void xcd_barrier(const XcdBarrier& b) {
    asm volatile("s_waitcnt vmcnt(0)" ::: "memory");
    __syncthreads();
    if (b.wave == 0 && lane_now() == 0) {
        unsigned* bar = b.bar;
        __builtin_amdgcn_s_waitcnt(0);
        unsigned nloc = b.st[0], nx = b.st[1];
        if (nloc == 0u) { xcd_barrier_complete(bar, b.x, nloc, nx); b.st[0] = nloc; b.st[1] = nx; }
        const unsigned old = xb_add(&bar[XB_XSUB(b.x)], 1u);
        const unsigned gen = old / nloc;
        if (old + 1u == (gen + 1u) * nloc) {
            __builtin_amdgcn_fence(__ATOMIC_RELEASE, "agent");
            asm volatile("s_waitcnt vmcnt(0)" ::: "memory");
            const unsigned og = xb_add(&bar[XB_TOP], 1u);
            const unsigned tg = og / nx;
            if (og + 1u == (tg + 1u) * nx) xb_add(&bar[XB_TOPGEN], 1u);
            else XB_SPIN(xb_ld(&bar[XB_TOPGEN]) == tg, bar);
            __builtin_amdgcn_fence(__ATOMIC_ACQUIRE, "agent");
            xb_add(&bar[XB_XGEN(b.x)], 1u);
            asm volatile("s_waitcnt vmcnt(0)" ::: "memory");
        } else {
            XB_SPIN(xb_ld(&bar[XB_XGEN(b.x)]) == gen, bar);
            __builtin_amdgcn_fence(__ATOMIC_ACQUIRE, "agent");
            asm volatile("s_waitcnt vmcnt(0)" ::: "memory");
        }
    }
    __syncthreads();
}


__device__ __forceinline__ void xcd_barrier_bg(const XcdBarrier& b, const Frame& F, int lnext, bool drain) {
    asm volatile("s_waitcnt vmcnt(0)" ::: "memory");
    __syncthreads();
    volatile LAS unsigned* sx = b.st + 4;
    unsigned* q = (unsigned*)(F.ws + WS_CTL) + CW_BGQ + lnext * 64;
    if (b.wave == 0 && lane_now() == 0) {
        unsigned* bar = b.bar;
        __builtin_amdgcn_s_waitcnt(0);
        unsigned nloc = b.st[0], nx = b.st[1];
        if (nloc == 0u) { xcd_barrier_complete(bar, b.x, nloc, nx); b.st[0] = nloc; b.st[1] = nx; }
        const unsigned old = xb_add(&bar[XB_XSUB(b.x)], 1u);
        const unsigned gen = old / nloc;
        const bool leader = (old + 1u == (gen + 1u) * nloc);
        unsigned ti = 0u; if (!leader) { const unsigned k = xb_add(q, 1u); if (k < (unsigned)NBG) ti = k + 1u; }
        sx[0] = leader ? 1u : 0u; sx[1] = gen; sx[2] = ti;
    }
    __syncthreads();
    if (__builtin_amdgcn_readfirstlane(sx[0]) == 0u) {
        unsigned ti = (unsigned)__builtin_amdgcn_readfirstlane(sx[2]);
        while (ti != 0u) {
            const int it = lnext * TL_LAYER + NDEF + (int)ti - 1;
            conv_run(F, 0, 1, 1, [=](int) { return it; });
            if (!drain) break;
            if (b.wave == 0 && lane_now() == 0) { const unsigned k = xb_add(q, 1u); sx[2] = k < (unsigned)NBG ? k + 1u : 0u; }
            __syncthreads();
            ti = (unsigned)__builtin_amdgcn_readfirstlane(sx[2]);
            __syncthreads();
        }
    }
    if (b.wave == 0 && lane_now() == 0) {
        unsigned* bar = b.bar; const unsigned gen = sx[1], nx = b.st[1];
        asm volatile("s_waitcnt vmcnt(0)" ::: "memory");
        if (sx[0] != 0u) {
            __builtin_amdgcn_fence(__ATOMIC_RELEASE, "agent");
            asm volatile("s_waitcnt vmcnt(0)" ::: "memory");
            const unsigned og = xb_add(&bar[XB_TOP], 1u);
            const unsigned tg = og / nx;
            if (og + 1u == (tg + 1u) * nx) xb_add(&bar[XB_TOPGEN], 1u);
            else XB_SPIN(xb_ld(&bar[XB_TOPGEN]) == tg, bar);
            __builtin_amdgcn_fence(__ATOMIC_ACQUIRE, "agent");
            xb_add(&bar[XB_XGEN(b.x)], 1u);
            asm volatile("s_waitcnt vmcnt(0)" ::: "memory");
        } else {
            XB_SPIN(xb_ld(&bar[XB_XGEN(b.x)]) == gen, bar);
            __builtin_amdgcn_fence(__ATOMIC_ACQUIRE, "agent");
            asm volatile("s_waitcnt vmcnt(0)" ::: "memory");
        }
    }
    __syncthreads();
}

__device__ __forceinline__ bool opq(Frame& F) { asm volatile("" : "+s"(F.ws), "+s"(F.blk), "+s"(F.out), "+s"(F.G)); return true; }
__device__ __forceinline__ int lq_(int l) { asm volatile("" : "+s"(l)); return l; }
__global__ void __launch_bounds__(NTHR, 2) k_mega(Params p) {
    extern __shared__ __attribute__((aligned(16))) unsigned char lds[];
    Frame F; F.lds = (LAS unsigned char*)lds; F.ws = p.ws; F.in = p.in; F.out = p.out; F.wave = __builtin_amdgcn_readfirstlane(threadIdx.x >> 6); F.blk = blockIdx.x; F.G = gridDim.x;
    volatile LAS unsigned* st = (volatile LAS unsigned*)(F.lds + LDS_BYTES - 32);
    if (threadIdx.x < 8) st[threadIdx.x] = 0u;
    __syncthreads();
#if USE_CG_SYNC
#define GRID_BAR() cooperative_groups::this_grid().sync()
#else
    const XcdBarrier bar = xcd_barrier_post((unsigned*)(p.ws + WS_CTL) + CW_BAR + p.li * XCD_BAR_WORDS, st, F.wave);
#define GRID_BAR() xcd_barrier(bar)
#endif
    const int lo = p.ph_lo, hi = p.ph_hi;
#define RUN(k) (lo <= (k) && (k) < hi && opq(F))
#define SEAM(k) do { if (RUN(k) && RUN((k) + 1)) GRID_BAR(); } while (0)
#define SEAM_BG(k, drain) do { if (RUN(k) && RUN((k) + 1)) { if (!USE_CG_SYNC && l + 1 < DEPTH) xcd_barrier_bg(bar, F, l + 1, drain); else GRID_BAR(); } } while (0)
    if (RUN(0)) { phase_prologue(F); if (PROBE_DUP & 16) { __syncthreads(); phase_prologue(F); } }
    SEAM(0);
    for (int l = 0; l < DEPTH; ++l) {
        const int b = 2 + 13 * l;
        if (RUN(b + 0)) phase_norm1(F, lq_(l));
        SEAM_BG(b + 0, false);
        if (RUN(b + 1)) phase_gemm_in(F, lq_(l));
        SEAM_BG(b + 1, false);
        if (RUN(b + 2)) { phase_rec_c1(F, lq_(l)); phase_sgu(F, lq_(l)); if (PROBE_DUP & 1) { __syncthreads(); phase_rec_c1(F, lq_(l)); phase_sgu(F, lq_(l)); } if (PROBE_DUP & 64) { __syncthreads(); phase_sgu(F, lq_(l)); } }
        SEAM_BG(b + 2, false);
        if (RUN(b + 3)) { phase_rec_c2(F); if (PROBE_DUP & 4) phase_rec_c2(F); }
        SEAM_BG(b + 3, false);
        if (RUN(b + 5)) { phase_rec_c3(F, lq_(l)); if (PROBE_DUP & 2) { __syncthreads(); phase_rec_c3(F, lq_(l)); } if (PROBE_DUP & 128) { __syncthreads(); phase_rec_c3<1>(F, lq_(l)); } }
        SEAM_BG(b + 5, false);
        if (RUN(b + 6)) phase_gemm_out(F, lq_(l));
        SEAM_BG(b + 6, false);
        if (RUN(b + 7)) phase_norm2(F, lq_(l));
        SEAM_BG(b + 7, false);
        if (RUN(b + 8)) { phase_gather(F, lq_(l)); if (PROBE_DUP & 8) { __syncthreads(); phase_gather(F, lq_(l)); } }
        SEAM_BG(b + 8, false);
#if MOE_FUSED == 1
        if (RUN(b + 9)) phase_moe_fused(F, lq_(l));
        SEAM_BG(b + 9, false);
#elif MOE_FUSED == 2
        if (RUN(b + 9)) phase_moe_fused<1>(F, lq_(l));
        SEAM_BG(b + 9, false);
        if (RUN(b + 10)) phase_moe_fused<2>(F, lq_(l));
        SEAM_BG(b + 10, false);
#else
        if (RUN(b + 9)) phase_gemm_moe1(F, lq_(l));
        SEAM_BG(b + 9, false);
        if (RUN(b + 10)) phase_gemm_moe2(F, lq_(l));
        SEAM_BG(b + 10, false);
#endif
        if (RUN(b + 11)) phase_combine(F, lq_(l));
        SEAM_BG(b + 11, true);
        if (RUN(b + 12)) phase_gemm_pg(F, lq_(l));
        SEAM(b + 12);
    }
    if (RUN(54)) phase_final(F);
#undef RUN
#undef SEAM
}

#ifndef ONE_LAUNCH
#define ONE_LAUNCH 1
#endif
#ifndef CUTS
#define CUTS {0, 55}
#endif
#ifndef MFMA_MASK
#define MFMA_MASK 255
#endif
extern "C" void kernel_launch(void* const* d_in, const int* in_sizes, int n_in, void* d_out, int out_size, void* d_ws, size_t ws_size, hipStream_t stream) {
    if (n_in != 24 || out_size != T * D || ws_size < WS_END) { fprintf(stderr, "kernel_launch: unexpected shapes (n_in %d out %d ws %zu)\n", n_in, out_size, ws_size); return; }
    static_assert(CW_BAR + 60 * XCD_BAR_WORDS <= (int)(CTL_BYTES / 4), "barrier regions inside the zeroed control words");
    Params p{}; for (int i = 0; i < 24; ++i) p.in[i] = (const float*)d_in[i]; p.out = (float*)d_out; p.ws = (unsigned char*)d_ws;
    unsigned char* ws = p.ws;
    (void)hipMemsetAsync(ws + WS_CTL, 0, CTL_BYTES, stream);
    { static bool attr = false; if (!attr) { (void)hipFuncSetAttribute((const void*)k_mega, hipFuncAttributeMaxDynamicSharedMemorySize, LDS_BYTES); attr = true; }
      const int cuts[] = CUTS; const int ncut = (int)(sizeof(cuts) / sizeof(cuts[0]));
      for (int i = 0; i + 1 < ncut; ++i) { p.ph_lo = cuts[i]; p.ph_hi = cuts[i + 1]; p.li = i; p.pad = 0;
#if USE_CG_SYNC
          void* args[] = {&p}; hipError_t e = hipLaunchCooperativeKernel((const void*)k_mega, dim3(256), dim3(NTHR), args, LDS_BYTES, stream);
          if (e != hipSuccess) fprintf(stderr, "cooperative launch failed: %s\n", hipGetErrorName(e));
#else
          hipLaunchKernelGGL(k_mega, dim3(256), dim3(NTHR), LDS_BYTES, stream, p);
#endif
      }
    }
}
```

```cpp
#include <hip/hip_runtime.h>
#include <hip/hip_cooperative_groups.h>
#include <cstdio>
#include <cstdint>

#define GAS __attribute__((address_space(1)))
#define LAS __attribute__((address_space(3)))
typedef unsigned short bf16;
typedef float f32x4 __attribute__((ext_vector_type(4)));
typedef float f32x2 __attribute__((ext_vector_type(2)));
typedef unsigned u32x4 __attribute__((ext_vector_type(4)));
typedef unsigned u32x2 __attribute__((ext_vector_type(2)));
typedef short bf16x8 __attribute__((ext_vector_type(8)));

constexpr int T = 16384, D = 1024, DEPTH = 4, DIN = 3072, DREC = 512, DSGU = 512;
constexpr int NE = 32, DE = 512, PD = 256;
constexpr int RB = 256;
constexpr int CAP = 2 * T + NE * RB;
constexpr int NRBMAX = CAP / RB;
constexpr float EPS = 1e-6f;
constexpr int NWAVES = 8, NTHR = 512;

constexpr size_t MiB = 1u << 20, KiB = 1u << 10;
constexpr size_t WS_CTL = 0, CTL_BYTES = 1 * MiB;
constexpr size_t WS_MISC = 1 * MiB;
constexpr size_t MS_TOKE = WS_MISC + 0;
constexpr size_t MS_TOKW = WS_MISC + 128 * KiB;
constexpr size_t MS_SINFO = WS_MISC + 256 * KiB;
constexpr size_t MS_SDEST = WS_MISC + 384 * KiB;
constexpr size_t MS_RSTDPE = WS_MISC + 512 * KiB;
constexpr size_t MS_BLKBASE = WS_MISC + 576 * KiB;
constexpr size_t MS_LB = WS_MISC + 608 * KiB;
constexpr size_t MS_BLKE = WS_MISC + 640 * KiB;
constexpr size_t MS_DC = WS_MISC + 1 * MiB;
constexpr size_t MS_WRT = WS_MISC + 2 * MiB;
constexpr size_t MS_SGUW = WS_MISC + 3 * MiB;
constexpr size_t MS_MM = WS_MISC + 4 * MiB;
constexpr size_t MS_PTOT = WS_MISC + 5 * MiB;
constexpr size_t WS_WIN = 16 * MiB;
constexpr size_t WS_WOUT = 40 * MiB;
constexpr size_t WS_WGU = 48 * MiB;
constexpr size_t WS_WD = 304 * MiB;
constexpr size_t WS_WPG = 432 * MiB;
constexpr size_t WS_WPE = 440 * MiB;
constexpr size_t WS_PB = 442 * MiB;
constexpr size_t WS_H = 474 * MiB;
constexpr size_t WS_XN = 538 * MiB;
constexpr size_t WS_O = 570 * MiB;
constexpr size_t WS_PE = 602 * MiB;
constexpr size_t WS_R1 = 730 * MiB;
constexpr size_t WS_Z = WS_R1;
constexpr size_t WS_UT = WS_R1 + 96 * MiB;
constexpr size_t WS_ST = WS_R1 + 128 * MiB;
constexpr size_t WS_ORAW = WS_R1 + 96 * MiB;
constexpr size_t WS_VN = WS_R1 + 128 * MiB;
constexpr size_t WS_XB = WS_R1;
constexpr size_t WS_HB = WS_R1 + 80 * MiB;
constexpr size_t WS_Y = WS_R1 + 120 * MiB;
constexpr size_t WS_LTOT = 930 * MiB;
constexpr size_t WS_END = 934 * MiB;
constexpr int CW_CNT = 64;
constexpr int CW_BGQ = 1024;
constexpr int CW_DONE = 2048;
constexpr int CW_BAR = 4096;

constexpr int RING_BYTES = 131072, MISC_OFF = RING_BYTES, LDS_BYTES = 147456;

#ifndef PROBE_DUP
#define PROBE_DUP 0
#endif
#ifndef MOE_FUSED
#define MOE_FUSED 1
#endif
#ifndef USE_CG_SYNC
#define USE_CG_SYNC 0
#endif
struct Params { const float* in[24]; float* out; unsigned char* ws; int ph_lo, ph_hi, li, pad; };

#define LDS_WAIT() asm volatile("s_waitcnt lgkmcnt(0)" ::: "memory")
template <int M> __device__ __forceinline__ float shx(float v) { static_assert(M >= 1 && M < 32, "swizzle xor mask");
    return __int_as_float(__builtin_amdgcn_ds_swizzle(__float_as_int(v), (M << 10) | 0x1F)); }
__device__ __forceinline__ float halves_sum(float v) {
    return __int_as_float(__builtin_amdgcn_readlane(__float_as_int(v), 0)) + __int_as_float(__builtin_amdgcn_readlane(__float_as_int(v), 32)); }
__device__ __forceinline__ float wave_sum(float v) {
    v += shx<1>(v); v += shx<2>(v); v += shx<4>(v); v += shx<8>(v); v += shx<16>(v);
    return halves_sum(v);
}
typedef __bf16 bf16x2_t __attribute__((ext_vector_type(2)));
__device__ __forceinline__ unsigned pk2(float lo, float hi) { const bf16x2_t v = __builtin_convertvector((f32x2){lo, hi}, bf16x2_t); return __builtin_bit_cast(unsigned, v); }
__device__ __forceinline__ unsigned f2bf(float f) { return pk2(f, f) & 0xffffu; }
__device__ __forceinline__ float bflo(unsigned w) { return __uint_as_float(w << 16); }
__device__ __forceinline__ float bfhi(unsigned w) { return __uint_as_float(w & 0xffff0000u); }
__device__ __forceinline__ float bf2f(bf16 b) { return __uint_as_float(((unsigned)b) << 16); }
__device__ __forceinline__ float fexp(float x) { return __builtin_amdgcn_exp2f(x * 1.4426950408889634f); }
__device__ __forceinline__ float flog(float x) { return __builtin_amdgcn_logf(x) * 0.6931471805599453f; }
__device__ __forceinline__ float frcp(float x) { return __builtin_amdgcn_rcpf(x); }
__device__ __forceinline__ float frsq(float x) { return __builtin_amdgcn_rsqf(x); }
__device__ __forceinline__ float sigmoid_(float x) { return frcp(1.f + fexp(-x)); }
__device__ __forceinline__ float silu_(float x) { return x * sigmoid_(x); }
__device__ __forceinline__ float gelu_(float x) { const float K1 = 2.f * 0.7978845608028654f * 1.4426950408889634f, K3 = K1 * 0.044715f;
    const float r = frcp(__builtin_amdgcn_exp2f(x * (K1 + K3 * (x * x))) + 1.f); return x - x * r; }

struct Frame {
    LAS unsigned char* lds; unsigned char* ws; const float* const* in; float* out;
    int wave, blk, G;
};
__device__ __forceinline__ int lane_now() { int l; asm volatile("v_mbcnt_lo_u32_b32 %0, -1, 0\n\tv_mbcnt_hi_u32_b32 %0, -1, %0" : "=v"(l)); return l; }
#define PH_TID() int ph_wave = F.wave; asm volatile("" : "+s"(ph_wave)); const int lane = lane_now(); (void)lane; const int tid = (ph_wave << 6) | lane; (void)tid

struct ConvJob { const float* W; const float* g; bf16* WT; int K, N, k0, n0, mode; };
constexpr int TL_IN = 16 * 12, TL_OUT = 16 * 4, TL_G = 32 * 16 * 2, TL_D = 32 * 8 * 4, TL_PG = 16 * 4, TL_PE = 4 * 4;
constexpr int TL_LAYER = TL_IN + TL_OUT + 2 * TL_G + TL_D + TL_PG + TL_PE;
__device__ __forceinline__ ConvJob conv_job(const Frame& F, int it) {
    unsigned char* ws = F.ws; const int l = it / TL_LAYER; int r = it % TL_LAYER; ConvJob j;
    if (r < TL_IN) { j.W = F.in[3] + (size_t)l * D * DIN; j.g = F.in[2] + l * D; j.WT = (bf16*)(ws + WS_WIN) + (size_t)l * DIN * D; j.K = D; j.N = DIN; j.k0 = 64 * (r / 12); j.n0 = 256 * (r % 12); j.mode = 0; return j; } r -= TL_IN;
    if (r < TL_OUT) { j.W = F.in[10] + (size_t)l * D * D; j.g = nullptr; j.WT = (bf16*)(ws + WS_WOUT) + (size_t)l * D * D; j.K = D; j.N = D; j.k0 = 64 * (r / 4); j.n0 = 256 * (r % 4); j.mode = 0; return j; } r -= TL_OUT;
    if (r < 2 * TL_G) { const int up = r >= TL_G; if (up) r -= TL_G; const int e = r / 32, rr = r % 32;
        j.W = F.in[up ? 17 : 16] + (size_t)(l * NE + e) * D * DE; j.g = F.in[11] + l * D; j.WT = (bf16*)(ws + WS_WGU) + (size_t)(l * NE + e) * 1024 * 1024; j.K = D; j.N = DE; j.k0 = 64 * (rr / 2); j.n0 = 256 * (rr % 2); j.mode = 1 + up; return j; } r -= 2 * TL_G;
    if (r < TL_D) { const int e = r / 32, rr = r % 32; j.W = F.in[18] + (size_t)(l * NE + e) * DE * D; j.g = nullptr; j.WT = (bf16*)(ws + WS_WD) + (size_t)(l * NE + e) * D * DE; j.K = DE; j.N = D; j.k0 = 64 * (rr / 4); j.n0 = 256 * (rr % 4); j.mode = 0; return j; } r -= TL_D;
    if (r < TL_PG) { j.W = F.in[20] + (size_t)l * D * D; j.g = F.in[19] + l * D; j.WT = (bf16*)(ws + WS_WPG) + (size_t)l * D * D; j.K = D; j.N = D; j.k0 = 64 * (r / 4); j.n0 = 256 * (r % 4); j.mode = 0; return j; } r -= TL_PG;
    j.W = F.in[21] + (size_t)l * PD * D; j.g = nullptr; j.WT = (bf16*)(ws + WS_WPE) + (size_t)l * D * PD; j.K = PD; j.N = D; j.k0 = 64 * (r / 4); j.n0 = 256 * (r % 4); j.mode = 0; return j;
}
__device__ __forceinline__ void conv_load(const ConvJob& j, int wave, int lane, f32x4 (&v)[8]) {
#pragma unroll
    for (int i = 0; i < 8; ++i) { const int row = 8 * wave + i; v[i] = *(const f32x4*)(j.W + (size_t)(j.k0 + row) * j.N + j.n0 + 4 * lane); if (j.g) v[i] = v[i] * j.g[j.k0 + row]; }
}
constexpr int NDEF = 384, NDEF1 = 128, NBG = 3024;
constexpr int NREST = TL_LAYER - NDEF - NBG, NPRO = TL_LAYER + 3 * NREST;
__device__ __forceinline__ int pro_tile(int f) { if (NREST == 0 || f < TL_LAYER) return f; f -= TL_LAYER; const int l = 1 + f / (NREST ? NREST : 1); return l * TL_LAYER + NDEF + NBG + f % (NREST ? NREST : 1); }
template <class M> __device__ __forceinline__ void conv_run(const Frame& F, int first, int stride, int count, M tile_of) {
    PH_TID();
    LAS float* tile = (LAS float*)F.lds;
    const int wave = ph_wave;
    int f = first; f32x4 v[8]; ConvJob cur{}, nxt{};
    if (f < count) { cur = conv_job(F, tile_of(f)); conv_load(cur, wave, lane, v); }
    while (f < count) {
#pragma unroll
        for (int i = 0; i < 8; ++i) { LAS float* d = tile + (8 * wave + i) * 257 + 4 * lane; d[0] = v[i].x; d[1] = v[i].y; d[2] = v[i].z; d[3] = v[i].w; }
        __syncthreads();
        const int fn = f + stride; if (fn < count) { nxt = conv_job(F, tile_of(fn)); conv_load(nxt, wave, lane, v); }
#pragma unroll
        for (int q = 0; q < 4; ++q) { const int nn = 32 * wave + 8 * q + (lane >> 3), c = lane & 7; const LAS float* sp = tile + (8 * c) * 257 + nn;
            u32x4 o; o.x = pk2(sp[0 * 257], sp[1 * 257]); o.y = pk2(sp[2 * 257], sp[3 * 257]); o.z = pk2(sp[4 * 257], sp[5 * 257]); o.w = pk2(sp[6 * 257], sp[7 * 257]);
            const int n = cur.n0 + nn; const int drow = cur.mode == 0 ? n : ((n >> 7) * 256 + (n & 127) + (cur.mode == 2 ? 128 : 0));
            *(u32x4*)(cur.WT + (size_t)drow * cur.K + cur.k0 + 8 * c) = o; }
        __syncthreads();
        cur = nxt; f = fn;
    }
}
__device__ __forceinline__ void conv_deferred(const Frame& F, int lnext, int r0, int r1, int first, int idle) {
    if (lnext >= DEPTH || F.blk < first) return;
    conv_run(F, F.blk - first, idle, r1 - r0, [=](int f) { return lnext * TL_LAYER + r0 + f; });
}
__device__ __forceinline__ void phase_prologue(const Frame& F) {
    PH_TID();
    unsigned char* ws = F.ws;
    conv_run(F, F.blk, F.G, NPRO, [](int f) { return pro_tile(f); });
    { const f32x4* src = (const f32x4*)F.in[1]; u32x4* dst = (u32x4*)(ws + WS_PB); const size_t n8 = (size_t)DEPTH * T * PD / 8;
      for (size_t i = (size_t)F.blk * NTHR + tid; i < n8; i += (size_t)F.G * NTHR) { const f32x4 a = src[2 * i], b = src[2 * i + 1]; u32x4 o; o.x = pk2(a.x, a.y); o.y = pk2(a.z, a.w); o.z = pk2(b.x, b.y); o.w = pk2(b.z, b.w); dst[i] = o; } }
    { float* wrt = (float*)(ws + MS_WRT);
      for (int i = F.blk * NTHR + tid; i < DEPTH * 36 * D; i += F.G * NTHR) { const int k = i % D, n = (i / D) % 36, l = i / (36 * D);
          const float w = n < 4 ? F.in[12][((size_t)l * D + k) * 4 + n] : F.in[14][((size_t)l * D + k) * NE + (n - 4)]; wrt[i] = w * F.in[11][l * D + k]; } }
    { bf16* wb = (bf16*)(ws + MS_SGUW); for (int i = F.blk * NTHR + tid; i < DEPTH * 4 * 128 * 128; i += F.G * NTHR) { const int tc = (i >> 7) & 127, sp = i & 127; wb[i] = sp <= tc ? (bf16)f2bf(F.in[8][i]) : (bf16)0; } }
    if (F.blk == 0 && tid < DREC) { const int c = tid; float v[DEPTH], m = -1e30f;
#pragma unroll
        for (int l = 0; l < DEPTH; ++l) { v[l] = F.in[4][l * DREC + c]; m = fmaxf(m, v[l]); }
        float s = 0.f;
#pragma unroll
        for (int l = 0; l < DEPTH; ++l) { v[l] = fexp(v[l] - m); s += v[l]; }
        float* lb = (float*)(ws + MS_LB); float acc = 0.f;
#pragma unroll
        for (int l = 0; l < DEPTH; ++l) { if (l > 0) acc += v[l] / s; lb[l * DREC + c] = acc; } }
}

__device__ __forceinline__ void load_row(const float* row, int lane, f32x4 (&v)[4]) { const f32x4* r = (const f32x4*)row + lane;
#pragma unroll
    for (int j = 0; j < 4; ++j) v[j] = r[64 * j]; }
__device__ __forceinline__ void load_row_bf(const bf16* row, int lane, f32x4 (&v)[4]) { const u32x2* r = (const u32x2*)row + lane;
#pragma unroll
    for (int j = 0; j < 4; ++j) { const u32x2 x = r[64 * j]; v[j] = (f32x4){bflo(x.x), bfhi(x.x), bflo(x.y), bfhi(x.y)}; } }
__device__ __forceinline__ float row_sumsq(const f32x4 (&v)[4]) { float s = 0.f;
#pragma unroll
    for (int j = 0; j < 4; ++j) s += (v[j].x * v[j].x + v[j].y * v[j].y) + (v[j].z * v[j].z + v[j].w * v[j].w);
    return wave_sum(s); }
__device__ __forceinline__ void store_row_bf16(bf16* orow, int lane, const f32x4 (&v)[4], float s) { u32x2* o = (u32x2*)orow + lane;
#pragma unroll
    for (int j = 0; j < 4; ++j) { u32x2 w; w.x = pk2(v[j].x * s, v[j].y * s); w.y = pk2(v[j].z * s, v[j].w * s); o[64 * j] = w; } }

__device__ __forceinline__ void phase_norm1(const Frame& F, int l) {
    PH_TID();
    bf16* XN = (bf16*)(F.ws + WS_XN); bf16* h = (bf16*)(F.ws + WS_H); const float* x = F.in[0];
    const int gw = F.blk * NWAVES + ph_wave, NGW = F.G * NWAVES;
    for (int t = gw; t < T; t += NGW) { f32x4 v[4];
        if (l == 0) { load_row(x + (size_t)t * D, lane, v); store_row_bf16(h + (size_t)t * D, lane, v, 1.f); } else load_row_bf(h + (size_t)t * D, lane, v);
        const float rstd = frsq(row_sumsq(v) * (1.f / D) + EPS); store_row_bf16(XN + (size_t)t * D, lane, v, rstd); }
}
__device__ __forceinline__ float bfly8(const float (&r)[8], int lane) {
    const bool b2 = lane & 4, b1 = lane & 2, b0 = lane & 1; float a[4], c[2];
#pragma unroll
    for (int i = 0; i < 4; ++i) { const float keep = b2 ? r[i + 4] : r[i], send = b2 ? r[i] : r[i + 4]; a[i] = keep + shx<4>(send); }
#pragma unroll
    for (int i = 0; i < 2; ++i) { const float keep = b1 ? a[i + 2] : a[i], send = b1 ? a[i] : a[i + 2]; c[i] = keep + shx<2>(send); }
    const float keep = b0 ? c[1] : c[0], send = b0 ? c[0] : c[1]; float d = keep + shx<1>(send);
    d += shx<8>(d); d += shx<16>(d);
    return d + __int_as_float(__builtin_amdgcn_ds_bpermute((lane ^ 32) << 2, __float_as_int(d)));
}
__device__ __forceinline__ void phase_norm2(const Frame& F, int l) {
    PH_TID();
    unsigned char* ws = F.ws;
    unsigned* hist = (unsigned*)(F.lds + MISC_OFF + 256);
    if (tid < 32) hist[tid] = 0u;
    __syncthreads();
    const bf16* h = (const bf16*)(ws + WS_H); bf16* XN = (bf16*)(ws + WS_XN);
    const float* WrT = (const float*)(ws + MS_WRT) + (size_t)l * 36 * D;
    const float* b_rg = F.in[13] + l * 4; const float* b_re = F.in[15] + l * NE;
    int* tok_e = (int*)(ws + MS_TOKE); float* tok_w = (float*)(ws + MS_TOKW); unsigned* sinfo = (unsigned*)(ws + MS_SINFO);
    const int RPB = T / F.G, RPW = RPB / NWAVES;
    for (int i0 = 0; i0 < RPW; i0 += 8) {
        const int t0 = F.blk * RPB + ph_wave * RPW + i0;
        f32x4 v[8][4]; float ss[8];
#pragma unroll
        for (int r = 0; r < 8; ++r) { load_row_bf(h + (size_t)(t0 + r) * D, lane, v[r]); float q = 0.f;
#pragma unroll
            for (int j = 0; j < 4; ++j) q += (v[r][j].x * v[r][j].x + v[r][j].y * v[r][j].y) + (v[r][j].z * v[r][j].z + v[r][j].w * v[r][j].w);
            ss[r] = q; }
        const float rstd_mine = frsq(bfly8(ss, lane) * (1.f / D) + EPS);
#pragma unroll
        for (int r = 0; r < 8; ++r) { const float rs = __int_as_float(__builtin_amdgcn_readlane(__float_as_int(rstd_mine), r)); store_row_bf16(XN + (size_t)(t0 + r) * D, lane, v[r], rs); }
        LAS float* lgw = (LAS float*)(F.lds + 4096) + ph_wave * (36 * 8);
#pragma unroll 2
        for (int n = 0; n < 36; ++n) { const f32x4* wr = (const f32x4*)(WrT + (size_t)n * D) + lane; const f32x4 w0 = wr[0], w1 = wr[64], w2 = wr[128], w3 = wr[192]; float pr[8];
#pragma unroll
            for (int r = 0; r < 8; ++r) pr[r] = ((v[r][0].x * w0.x + v[r][0].y * w0.y) + (v[r][0].z * w0.z + v[r][0].w * w0.w)) + ((v[r][1].x * w1.x + v[r][1].y * w1.y) + (v[r][1].z * w1.z + v[r][1].w * w1.w))
                                                 + ((v[r][2].x * w2.x + v[r][2].y * w2.y) + (v[r][2].z * w2.z + v[r][2].w * w2.w)) + ((v[r][3].x * w3.x + v[r][3].y * w3.y) + (v[r][3].z * w3.z + v[r][3].w * w3.w));
            const float val = bfly8(pr, lane) * rstd_mine; if (lane < 8) lgw[n * 8 + lane] = val; }
        const int row = lane & 7;
        float lg4[4], lgb[4];
#pragma unroll
        for (int j = 0; j < 4; ++j) { lg4[j] = lgw[j * 8 + row]; lgb[j] = lg4[j] + b_rg[j]; }
        int gs = 0; float gm = lgb[0];
#pragma unroll
        for (int j = 1; j < 4; ++j) if (lgb[j] > gm) { gm = lgb[j]; gs = j; }
        float mx = fmaxf(fmaxf(lg4[0], lg4[1]), fmaxf(lg4[2], lg4[3])), se = 0.f, lsel = lg4[0];
#pragma unroll
        for (int j = 0; j < 4; ++j) { se += fexp(lg4[j] - mx); if (j == gs) lsel = lg4[j]; }
        const float g_w = fexp(lsel - mx) * frcp(se);
        float le[8], leb[8];
#pragma unroll
        for (int j = 0; j < 8; ++j) { le[j] = lgw[(4 + gs * 8 + j) * 8 + row]; leb[j] = le[j] + b_re[gs * 8 + j]; }
        int s0 = 0; float m0 = leb[0];
#pragma unroll
        for (int j = 1; j < 8; ++j) if (leb[j] > m0) { m0 = leb[j]; s0 = j; }
        int s1 = -1; float m1 = -3.0e38f;
#pragma unroll
        for (int j = 0; j < 8; ++j) if (j != s0 && leb[j] > m1) { m1 = leb[j]; s1 = j; }
        if (s1 < 0) s1 = (s0 == 0) ? 1 : 0;
        float la = le[0], lb2 = le[0];
#pragma unroll
        for (int j = 1; j < 8; ++j) { if (j == s0) la = le[j]; if (j == s1) lb2 = le[j]; }
        const float wa = frcp(1.f + fexp(lb2 - la)), wb = 1.f - wa;
        if (lane < 8) { const int t = t0 + lane;
            const int e0 = gs * 8 + s0, e1 = gs * 8 + s1;
            const unsigned r0 = atomicAdd(&hist[e0], 1u), r1 = atomicAdd(&hist[e1], 1u);
            tok_e[2 * t] = e0; tok_e[2 * t + 1] = e1; tok_w[2 * t] = g_w * wa; tok_w[2 * t + 1] = g_w * wb;
            sinfo[2 * t] = ((unsigned)F.blk << 16) | r0; sinfo[2 * t + 1] = ((unsigned)F.blk << 16) | r1;
        }
    }
    __syncthreads();
    if (tid < 32) { unsigned* cnt = (unsigned*)(ws + WS_CTL) + CW_CNT + l * 32;
        const unsigned base = __hip_atomic_fetch_add(cnt + tid, hist[tid], __ATOMIC_RELAXED, __HIP_MEMORY_SCOPE_AGENT);
        ((unsigned*)(ws + MS_BLKBASE))[F.blk * 32 + tid] = base; }
}
__device__ __forceinline__ void phase_gather(const Frame& F, int l) {
    PH_TID();
    unsigned char* ws = F.ws;
    int* ps = (int*)(F.lds + MISC_OFF + 512);
    if (tid == 0) { unsigned* cnt = (unsigned*)(ws + WS_CTL) + CW_CNT + l * 32; int* blke = (int*)(ws + MS_BLKE) + l * 256; int acc = 0;
        for (int e = 0; e < NE; ++e) { const int c = (int)__hip_atomic_load(cnt + e, __ATOMIC_RELAXED, __HIP_MEMORY_SCOPE_AGENT); ps[e] = acc; const int pad = (c + RB - 1) / RB * RB;
            if (F.blk == 0) for (int rb = acc / RB; rb < (acc + pad) / RB; ++rb) blke[rb] = e;
            acc += pad; }
        if (F.blk == 0) blke[255] = acc / RB; }
    __syncthreads();
    const int* tok_e = (const int*)(ws + MS_TOKE); const unsigned* sinfo = (const unsigned*)(ws + MS_SINFO); const unsigned* bbase = (const unsigned*)(ws + MS_BLKBASE);
    int* sdest = (int*)(ws + MS_SDEST); const bf16* XN = (const bf16*)(ws + WS_XN); bf16* XB = (bf16*)(ws + WS_XB);
    const int gw = F.blk * NWAVES + ph_wave, NGW = F.G * NWAVES;
    for (int t = gw; t < T; t += NGW) {
        const u32x4* src = (const u32x4*)(XN + (size_t)t * D) + lane; const u32x4 a = src[0], b = src[64];
#pragma unroll
        for (int j = 0; j < 2; ++j) { const int e = tok_e[2 * t + j]; const unsigned info = sinfo[2 * t + j];
            const int dest = ps[e] + (int)bbase[(info >> 16) * 32 + e] + (int)(info & 0xffffu);
            if (lane == 0) sdest[2 * t + j] = dest;
            u32x4* dst = (u32x4*)(XB + (size_t)dest * D) + lane; dst[0] = a; dst[64] = b; }
    }
}
__device__ __forceinline__ void phase_combine(const Frame& F, int l) {
    PH_TID();
    unsigned char* ws = F.ws;
    bf16* h = (bf16*)(ws + WS_H); bf16* XN = (bf16*)(ws + WS_XN); const bf16* Y = (const bf16*)(ws + WS_Y); const bf16* PE = (const bf16*)(ws + WS_PE) + (size_t)l * T * D;
    const int* sdest = (const int*)(ws + MS_SDEST); const float* tok_w = (const float*)(ws + MS_TOKW); float* rstd_pe = (float*)(ws + MS_RSTDPE);
    const int gw = F.blk * NWAVES + ph_wave, NGW = F.G * NWAVES;
    for (int t = gw; t < T; t += NGW) {
        const int d0 = sdest[2 * t], d1 = sdest[2 * t + 1]; const float w0 = tok_w[2 * t], w1 = tok_w[2 * t + 1];
        f32x4 v[4]; load_row_bf(h + (size_t)t * D, lane, v);
        const u32x2* y0 = (const u32x2*)(Y + (size_t)d0 * D) + lane; const u32x2* y1 = (const u32x2*)(Y + (size_t)d1 * D) + lane; const u32x2* pe = (const u32x2*)(PE + (size_t)t * D) + lane;
        float sp = 0.f;
#pragma unroll
        for (int j = 0; j < 4; ++j) { const u32x2 a = y0[64 * j], b = y1[64 * j], c = pe[64 * j];
            v[j].x += w0 * bflo(a.x) + w1 * bflo(b.x); v[j].y += w0 * bfhi(a.x) + w1 * bfhi(b.x); v[j].z += w0 * bflo(a.y) + w1 * bflo(b.y); v[j].w += w0 * bfhi(a.y) + w1 * bfhi(b.y);
            const float p0 = bflo(c.x), p1 = bfhi(c.x), p2 = bflo(c.y), p3 = bfhi(c.y); sp += (p0 * p0 + p1 * p1) + (p2 * p2 + p3 * p3); }
        store_row_bf16(h + (size_t)t * D, lane, v, 1.f);
        const float rstd = frsq(row_sumsq(v) * (1.f / D) + EPS); store_row_bf16(XN + (size_t)t * D, lane, v, rstd);
        sp = wave_sum(sp); if (lane == 0) rstd_pe[t] = frsq(sp * (1.f / D) + EPS);
    }
}
__device__ __forceinline__ void phase_final(const Frame& F) {
    PH_TID();
    const bf16* h = (const bf16*)(F.ws + WS_H); const float* nf = F.in[23];
    const int gw = F.blk * NWAVES + ph_wave, NGW = F.G * NWAVES;
    for (int t = gw; t < T; t += NGW) { f32x4 v[4]; load_row_bf(h + (size_t)t * D, lane, v); const float rstd = frsq(row_sumsq(v) * (1.f / D) + EPS);
        f32x4* o = (f32x4*)(F.out + (size_t)t * D) + lane; const f32x4* g = (const f32x4*)nf + lane;
#pragma unroll
        for (int j = 0; j < 4; ++j) o[64 * j] = v[j] * rstd * g[64 * j]; }
}


namespace pg8 {
constexpr int BM = 256, BK = 64, HALF = 128, HTB = HALF * BK * 2, STAGE_BYTES = 8 * HTB, NXCD = 8, WGM = 8;
__host__ __device__ __forceinline__ int lds_byte(int r, int c) { const int st = (r >> 4) * 2 + (c >> 5), rr = r & 15, cc = c & 31, ob = rr * 64 + cc * 2; return st * 1024 + (ob ^ (((ob >> 9) & 1) << 5)); }
__host__ __device__ __forceinline__ void stage_rc(int b, int& R, int& C) { const int st = b / 1024, sb = b % 1024, swz = sb ^ (((sb >> 9) & 1) << 5); R = (st >> 1) * 16 + swz / 64; C = (st & 1) * 32 + (swz % 64) / 2; }
__host__ __device__ __forceinline__ int perm32(int rho) { const int n = rho >> 4, i = rho & 15; return 8 * (i >> 2) + 4 * n + (i & 3); }
struct Unit { int pm, pn; const char* A; const char* B; };
__device__ __forceinline__ void static_map(int wgid, int nM, int nN, int& pm, int& pn) {
    const int nwg = nM * nN; { const int q = nwg / NXCD, r = nwg % NXCD, xcd = wgid % NXCD, off = wgid / NXCD; wgid = (xcd < r ? xcd * (q + 1) : r * (q + 1) + (xcd - r) * q) + off; }
    const int nig = WGM * nN, gid = wgid / nig, fm = gid * WGM, gsz = (nM - fm) < WGM ? (nM - fm) : WGM;
    pm = fm + ((wgid % nig) % gsz); pn = (wgid % nig) / gsz;
}
struct DenseOrder { static constexpr bool DEPS = false;
    const char* A; const char* Bt; int nM, nN, nL, G, c; size_t tstep;
    __device__ void init(const void* A_, const void* Bt_, int M, int N, int K, int nL_, int G_, int c_) { A = (const char*)A_; Bt = (const char*)Bt_; nM = M / BM; nN = N / BM; nL = nL_; G = G_; c = c_; tstep = (size_t)BM * K * 2; }
    __device__ bool next(int i, Unit& u) const { const long L = (long)i * G + c; const int per = nM * nN; if (L >= (long)per * nL) return false;
        const int l = (int)(L / per); int pm, pn; static_map((int)(L % per), nM, nN, pm, pn); u.pm = l * nM + pm; u.pn = pn; u.A = A + (size_t)u.pm * tstep; u.B = Bt + (size_t)(l * nN + pn) * tstep; return true; }
};
struct MoeOrder { static constexpr bool DEPS = false;
    const char* A; const char* W; const int* blke; int nrb, nN, G, c, e0, e1, e2; size_t a_tstep, w_estride, b_tstep;
    __device__ void init(const void* A_, const void* W_, const int* blke_, int K, int nN_, size_t w_estride_bytes, int G_, int c_) { A = (const char*)A_; W = (const char*)W_; blke = blke_; nrb = __builtin_amdgcn_readfirstlane(blke_[255]); nN = nN_; G = G_; c = c_;
        a_tstep = (size_t)BM * K * 2; b_tstep = a_tstep; w_estride = w_estride_bytes;
        const int r0 = c / nN, r1 = (G + c) / nN, r2 = (2 * G + c) / nN; const int x0 = blke_[r0 < 255 ? r0 : 254], x1 = blke_[r1 < 255 ? r1 : 254], x2 = blke_[r2 < 255 ? r2 : 254];
        e0 = __builtin_amdgcn_readfirstlane(x0); e1 = __builtin_amdgcn_readfirstlane(x1); e2 = __builtin_amdgcn_readfirstlane(x2); }
    __device__ bool next(int i, Unit& u) const { const long L = (long)i * G + c; if (L >= (long)nrb * nN) return false; const int rb = (int)(L / nN), pn = (int)(L % nN);
        const int ex = i == 0 ? e0 : i == 1 ? e1 : i == 2 ? e2 : __builtin_amdgcn_readfirstlane(blke[rb]);
        u.pm = rb; u.pn = pn; u.A = A + (size_t)rb * a_tstep; u.B = W + (size_t)ex * w_estride + (size_t)pn * b_tstep; return true; }
};
__device__ __forceinline__ unsigned ag_ld(const unsigned* p)        { return __hip_atomic_load(p, __ATOMIC_RELAXED, __HIP_MEMORY_SCOPE_AGENT); }
__device__ __forceinline__ unsigned ag_add(unsigned* p, unsigned v) { return __hip_atomic_fetch_add(p, v, __ATOMIC_RELAXED, __HIP_MEMORY_SCOPE_AGENT); }
struct MoeDepOrder { static constexpr bool DEPS = true;
    const char* A; const char* W; const int* blke; const unsigned* done; int nrb, nN, G, c, e0, e1, e2; size_t a_tstep, w_estride, b_tstep;
    __device__ void init(const void* A_, const void* W_, const int* blke_, const unsigned* done_, int K, int nN_, size_t w_estride_bytes, int G_, int c_) { A = (const char*)A_; W = (const char*)W_; blke = blke_; done = done_;
        nrb = __builtin_amdgcn_readfirstlane(blke_[255]); nN = nN_; G = G_; c = c_; a_tstep = (size_t)BM * K * 2; b_tstep = a_tstep; w_estride = w_estride_bytes;
        const int r0 = c / nN, r1 = (G + c) / nN, r2 = (2 * G + c) / nN; const int x0 = blke_[r0 < 255 ? r0 : 254], x1 = blke_[r1 < 255 ? r1 : 254], x2 = blke_[r2 < 255 ? r2 : 254];
        e0 = __builtin_amdgcn_readfirstlane(x0); e1 = __builtin_amdgcn_readfirstlane(x1); e2 = __builtin_amdgcn_readfirstlane(x2); }
    __device__ bool next(int i, Unit& u) const { const long L = (long)i * G + c; if (L >= (long)nrb * nN) return false; const int rb = (int)(L / nN), pn = (int)(L % nN);
        const int ex = i == 0 ? e0 : i == 1 ? e1 : i == 2 ? e2 : __builtin_amdgcn_readfirstlane(blke[rb]);
        u.pm = rb; u.pn = pn; u.A = A + (size_t)rb * a_tstep; u.B = W + (size_t)ex * w_estride + (size_t)pn * b_tstep; return true; }
    __device__ void wait(const Unit& u, int wid) const {
        if (wid == 0 && lane_now() == 0) { while (ag_ld(done + u.pm) < 4u) __builtin_amdgcn_s_sleep(1); __builtin_amdgcn_fence(__ATOMIC_ACQUIRE, "agent"); } }
};
struct RangeOrder { static constexpr bool DEPS = false;
    const char* A; const char* Bt; int nM, nN, j0, n; size_t tstep;
    __device__ void init(const void* A_, const void* Bt_, int M, int N, int K, int j0_, int n_) { A = (const char*)A_; Bt = (const char*)Bt_; nM = M / BM; nN = N / BM; j0 = j0_; n = n_; tstep = (size_t)BM * K * 2; }
    __device__ bool next(int i, Unit& u) const { if (i >= n) return false; int pm, pn; static_map(j0 + i, nM, nN, pm, pn); u.pm = pm; u.pn = pn; u.A = A + (size_t)pm * tstep; u.B = Bt + (size_t)pn * tstep; return true; }
};
__device__ __forceinline__ unsigned cvt_pk_bf16(float lo, float hi) { return pk2(lo, hi); }
struct EpiBf16 { static constexpr bool PERM = true, ACC_INIT = false, SIGNAL = false; bf16* O; int ldc;
    __device__ __forceinline__ void operator()(const f32x4 (&acc)[2][2][4][2], const Unit& u, int wr, int wc, int, int) const {
        const int t2 = lane_now(), fr = t2 & 15, fq = t2 >> 4;
        const int row0 = u.pm * BM + wr * 64 + fr, col0 = u.pn * BM + wc * 32 + 8 * fq;
#pragma unroll
        for (int ai = 0; ai < 2; ++ai)
#pragma unroll
            for (int m = 0; m < 4; ++m) { bf16* rowp = O + (size_t)(row0 + ai * HALF + m * 16) * ldc + col0;
#pragma unroll
                for (int bj = 0; bj < 2; ++bj) { const f32x4 v0 = acc[ai][bj][m][0], v1 = acc[ai][bj][m][1];
                    u32x4 w; w.x = cvt_pk_bf16(v0[0], v0[1]); w.y = cvt_pk_bf16(v0[2], v0[3]); w.z = cvt_pk_bf16(v1[0], v1[1]); w.w = cvt_pk_bf16(v1[2], v1[3]);
                    *(u32x4*)(rowp + bj * HALF) = w; } }
    } };
struct EpiResid { static constexpr bool PERM = true, ACC_INIT = true, SIGNAL = false; bf16* h;
    __device__ __forceinline__ void init(f32x4 (&acc)[2][2][4][2], const Unit& u, int wr, int wc, int fr, int fq) const {
        const int row0 = u.pm * BM + wr * 64 + fr, col0 = u.pn * BM + wc * 32 + 8 * fq;
#pragma unroll
        for (int ai = 0; ai < 2; ++ai)
#pragma unroll
            for (int m = 0; m < 4; ++m) { const bf16* rowp = h + (size_t)(row0 + ai * HALF + m * 16) * D + col0;
#pragma unroll
                for (int bj = 0; bj < 2; ++bj) { const u32x4 x = *(const u32x4*)(rowp + bj * HALF);
                    acc[ai][bj][m][0] = (f32x4){bflo(x.x), bfhi(x.x), bflo(x.y), bfhi(x.y)}; acc[ai][bj][m][1] = (f32x4){bflo(x.z), bfhi(x.z), bflo(x.w), bfhi(x.w)}; } }
    }
    __device__ __forceinline__ void operator()(const f32x4 (&acc)[2][2][4][2], const Unit& u, int wr, int wc, int fr, int fq) const {
        asm volatile("" : "+v"(fr), "+v"(fq));
        const int row0 = u.pm * BM + wr * 64 + fr, col0 = u.pn * BM + wc * 32 + 8 * fq;
#pragma unroll
        for (int ai = 0; ai < 2; ++ai)
#pragma unroll
            for (int m = 0; m < 4; ++m) { bf16* rowp = h + (size_t)(row0 + ai * HALF + m * 16) * D + col0;
#pragma unroll
                for (int bj = 0; bj < 2; ++bj) { const f32x4 v0 = acc[ai][bj][m][0], v1 = acc[ai][bj][m][1];
                    u32x4 w; w.x = cvt_pk_bf16(v0[0], v0[1]); w.y = cvt_pk_bf16(v0[2], v0[3]); w.z = cvt_pk_bf16(v1[0], v1[1]); w.w = cvt_pk_bf16(v1[2], v1[3]);
                    *(u32x4*)(rowp + bj * HALF) = w; } }
    } };
struct EpiGateUp { static constexpr bool PERM = true, ACC_INIT = false, SIGNAL = false; bf16* H;
    __device__ __forceinline__ void operator()(const f32x4 (&acc)[2][2][4][2], const Unit& u, int wr, int wc, int, int) const {
        const int t2 = lane_now(), fr = t2 & 15, fq = t2 >> 4;
        const int row0 = u.pm * BM + wr * 64 + fr, col0 = u.pn * HALF + wc * 32 + 8 * fq;
#pragma unroll
        for (int ai = 0; ai < 2; ++ai)
#pragma unroll
            for (int m = 0; m < 4; ++m) { bf16* rowp = H + (size_t)(row0 + ai * HALF + m * 16) * DE + col0; float v[8];
#pragma unroll
                for (int n = 0; n < 2; ++n)
#pragma unroll
                    for (int j = 0; j < 4; ++j) v[4 * n + j] = silu_(acc[ai][0][m][n][j]) * acc[ai][1][m][n][j];
                u32x4 w; w.x = cvt_pk_bf16(v[0], v[1]); w.y = cvt_pk_bf16(v[2], v[3]); w.z = cvt_pk_bf16(v[4], v[5]); w.w = cvt_pk_bf16(v[6], v[7]);
                *(u32x4*)rowp = w; }
    } };
struct EpiGateUpPub { static constexpr bool PERM = true, ACC_INIT = false, SIGNAL = true; __amdgpu_buffer_rsrc_t rs; unsigned* done;
    __device__ __forceinline__ void operator()(const f32x4 (&acc)[2][2][4][2], const Unit& u, int wr, int wc, int fr, int fq) const {
        asm volatile("" : "+v"(fr), "+v"(fq));
        const int row0 = u.pm * BM + wr * 64 + fr, col0 = u.pn * HALF + wc * 32 + 8 * fq;
#pragma unroll
        for (int ai = 0; ai < 2; ++ai)
#pragma unroll
            for (int m = 0; m < 4; ++m) { const unsigned off = (unsigned)(((row0 + ai * HALF + m * 16) * DE + col0) * 2); float v[8];
#pragma unroll
                for (int n = 0; n < 2; ++n)
#pragma unroll
                    for (int j = 0; j < 4; ++j) v[4 * n + j] = silu_(acc[ai][0][m][n][j]) * acc[ai][1][m][n][j];
                u32x4 w; w.x = cvt_pk_bf16(v[0], v[1]); w.y = cvt_pk_bf16(v[2], v[3]); w.z = cvt_pk_bf16(v[4], v[5]); w.w = cvt_pk_bf16(v[6], v[7]);
                __builtin_amdgcn_raw_buffer_store_b128(w, rs, off, 0, 16); }
    }
    __device__ __forceinline__ void signal(const Unit& u) const { (void)ag_add(done + u.pm, 1u); }
};
struct EpiPG { static constexpr bool PERM = true, ACC_INIT = false, SIGNAL = false; bf16* h; const bf16* PE; const float* rstd_pe; const float* norm_pe;
    __device__ __forceinline__ void operator()(const f32x4 (&acc)[2][2][4][2], const Unit& u, int wr, int wc, int fr, int fq) const {
        asm volatile("" : "+v"(fr), "+v"(fq));
        const int row0 = u.pm * BM + wr * 64 + fr, col0 = u.pn * BM + wc * 32 + 8 * fq;
        f32x4 nv[2][2];
#pragma unroll
        for (int bj = 0; bj < 2; ++bj)
#pragma unroll
            for (int n = 0; n < 2; ++n) nv[bj][n] = *(const f32x4*)(norm_pe + col0 + bj * HALF + 4 * n);
#pragma unroll
        for (int ai = 0; ai < 2; ++ai)
#pragma unroll
            for (int m = 0; m < 4; ++m) { const int row = row0 + ai * HALF + m * 16; const float rs = rstd_pe[row];
#pragma unroll
                for (int bj = 0; bj < 2; ++bj) { const size_t o = (size_t)row * D + col0 + bj * HALF; const u32x4 pe = *(const u32x4*)(PE + o); const u32x4 hx = *(const u32x4*)(h + o);
                    f32x4 h0 = (f32x4){bflo(hx.x), bfhi(hx.x), bflo(hx.y), bfhi(hx.y)}, h1 = (f32x4){bflo(hx.z), bfhi(hx.z), bflo(hx.w), bfhi(hx.w)}; const f32x4 a0 = acc[ai][bj][m][0], a1 = acc[ai][bj][m][1];
                    const f32x4 e0 = (f32x4){bflo(pe.x), bfhi(pe.x), bflo(pe.y), bfhi(pe.y)} * rs * nv[bj][0], e1 = (f32x4){bflo(pe.z), bfhi(pe.z), bflo(pe.w), bfhi(pe.w)} * rs * nv[bj][1];
                    h0 += (f32x4){sigmoid_(a0[0]), sigmoid_(a0[1]), sigmoid_(a0[2]), sigmoid_(a0[3])} * e0; h1 += (f32x4){sigmoid_(a1[0]), sigmoid_(a1[1]), sigmoid_(a1[2]), sigmoid_(a1[3])} * e1;
                    u32x4 w; w.x = pk2(h0[0], h0[1]); w.y = pk2(h0[2], h0[3]); w.z = pk2(h1[0], h1[1]); w.w = pk2(h1[2], h1[3]); *(u32x4*)(h + o) = w; } }
    } };

template <class Epi, class Sched>
__device__ __forceinline__ void gemm_phase(int wave, LAS unsigned char* lds, int K, const Sched& S, const Epi& E) {
    int wid = wave; asm volatile("" : "+s"(wid));
    const int lane = lane_now(), tid = (wid << 6) | lane, wr = wid >> 2, wc = wid & 3, fr = lane & 15, fq = lane >> 4;
    const int nt = K / BK;
    unsigned voffA[2], voffB[2];
#pragma unroll
    for (int i = 0; i < 2; ++i) { int R, C; stage_rc(tid * 16 + i * 8192, R, C); const int Rb = Epi::PERM ? ((R & ~31) + perm32(R & 31)) : R;
        voffA[i] = (unsigned)(R * K + C) * 2u; voffB[i] = (unsigned)(Rb * K + C) * 2u; }
    const size_t kstep = (size_t)(BK * 2);
    const size_t hstep = (size_t)HALF * K * 2;
    const unsigned ldsw = (unsigned)wid * 1024u;
    const int aoff = lds_byte(wr * 64 + fr, fq * 8), boff = lds_byte(wc * 32 + fr, fq * 8);
#define PG8_SA(b, h) (((b) * 2 + (h)) * HTB)
#define PG8_SB(b, h) ((4 + (b) * 2 + (h)) * HTB)
#define PG8_STAGE(bufoff, gbase, voff) do { _Pragma("unroll") for (int _i = 0; _i < 2; ++_i) \
        __builtin_amdgcn_global_load_lds((const unsigned*)((const char*)(gbase) + (voff)[_i]), (LAS unsigned*)(lds + (bufoff) + ldsw + _i * 8192), 16, 0, 0); } while (0)
#define PG8_LDA(dst, b, h) do { _Pragma("unroll") for (int m = 0; m < 4; ++m) _Pragma("unroll") for (int k = 0; k < 2; ++k) dst[m][k] = *(const LAS bf16x8*)(lds + PG8_SA(b, h) + aoff + m * 2048 + k * 1024); } while (0)
#define PG8_LDB(dst, b, h) do { _Pragma("unroll") for (int n = 0; n < 2; ++n) _Pragma("unroll") for (int k = 0; k < 2; ++k) dst[n][k] = *(const LAS bf16x8*)(lds + PG8_SB(b, h) + boff + n * 2048 + k * 1024); } while (0)
#define PG8_MMA(ai, bj, At, Bt) do { __builtin_amdgcn_s_setprio(1); _Pragma("unroll") for (int m = 0; m < 4; ++m) _Pragma("unroll") for (int n = 0; n < 2; ++n) _Pragma("unroll") for (int k = 0; k < 2; ++k) \
        acc[ai][bj][m][n] = __builtin_amdgcn_mfma_f32_16x16x32_bf16(Bt[n][k], At[m][k], acc[ai][bj][m][n], 0, 0, 0); __builtin_amdgcn_s_setprio(0); } while (0)
#define PG8_WAIT_V(n) asm volatile("s_waitcnt vmcnt(" #n ")" ::: "memory")
#define PG8_WAIT_L(n) asm volatile("s_waitcnt lgkmcnt(" #n ")" ::: "memory")
#define PG8_BAR __builtin_amdgcn_s_barrier()
#define PG8_SCHED __builtin_amdgcn_sched_barrier(0)
    Unit cur, nxt; int ui = 0;
    if (!S.next(0, cur)) return;
    if constexpr (Sched::DEPS) { S.wait(cur, wid); PG8_BAR; }
    f32x4 acc[2][2][4][2];
    if constexpr (Epi::ACC_INIT) E.init(acc, cur, wr, wc, fr, fq);
    else {
#pragma unroll
    for (int a = 0; a < 2; ++a)
#pragma unroll
        for (int b = 0; b < 2; ++b)
#pragma unroll
            for (int m = 0; m < 4; ++m)
#pragma unroll
                for (int n = 0; n < 2; ++n) acc[a][b][m][n] = (f32x4){0.f, 0.f, 0.f, 0.f}; }
    bf16x8 At[4][2], B0[2][2], B1[2][2];
    const char* cA = cur.A; const char* cB = cur.B;
    PG8_STAGE(PG8_SB(0, 0), cB, voffB); PG8_STAGE(PG8_SB(0, 1), cB + hstep, voffB); PG8_STAGE(PG8_SA(0, 0), cA, voffA); PG8_STAGE(PG8_SA(0, 1), cA + hstep, voffA);
    if (wr == 1) PG8_BAR;
    PG8_WAIT_V(2); PG8_BAR;
    PG8_STAGE(PG8_SB(1, 0), cB + kstep, voffB); PG8_STAGE(PG8_SA(1, 0), cA + kstep, voffA); PG8_STAGE(PG8_SB(1, 1), cB + hstep + kstep, voffB);
    PG8_WAIT_V(6); PG8_BAR;
    for (;;) {
        const bool has_next = S.next(ui + 1, nxt);
        const char* nA = has_next ? nxt.A : cA; const char* nB = has_next ? nxt.B : cB;
#pragma nounroll
        for (int t = 0; t < nt; t += 2) {
            const bool last = (t == nt - 2);
            if constexpr (Sched::DEPS) { if (last && has_next) S.wait(nxt, wid); }
            const char* a1 = cA + (size_t)(t + 1) * kstep;
            const char* a2 = last ? nA : cA + (size_t)(t + 2) * kstep; const char* b2 = last ? nB : cB + (size_t)(t + 2) * kstep;
            const char* a3 = a2 + kstep; const char* b3 = b2 + kstep;
            PG8_LDB(B0, 0, 0); PG8_LDB(B1, 0, 1); PG8_SCHED; PG8_LDA(At, 0, 0); PG8_STAGE(PG8_SA(1, 1), a1 + hstep, voffA);
            PG8_WAIT_V(8); PG8_WAIT_L(0); PG8_BAR; PG8_MMA(0, 0, At, B0); PG8_MMA(0, 1, At, B1); PG8_BAR; PG8_SCHED;
            PG8_LDA(At, 0, 1); PG8_STAGE(PG8_SB(0, 0), b2, voffB); PG8_STAGE(PG8_SB(0, 1), b2 + hstep, voffB); PG8_STAGE(PG8_SA(0, 0), a2, voffA);
            PG8_WAIT_V(8); PG8_WAIT_L(0); PG8_BAR; PG8_MMA(1, 0, At, B0); PG8_MMA(1, 1, At, B1); PG8_BAR; PG8_SCHED;
            PG8_LDB(B0, 1, 0); PG8_LDB(B1, 1, 1); PG8_SCHED; PG8_LDA(At, 1, 0); PG8_STAGE(PG8_SA(0, 1), a2 + hstep, voffA);
            PG8_WAIT_V(8); PG8_WAIT_L(0); PG8_BAR; PG8_MMA(0, 0, At, B0); PG8_MMA(0, 1, At, B1); PG8_BAR; PG8_SCHED;
            PG8_LDA(At, 1, 1); PG8_STAGE(PG8_SB(1, 0), b3, voffB); PG8_STAGE(PG8_SB(1, 1), b3 + hstep, voffB); PG8_STAGE(PG8_SA(1, 0), a3, voffA);
            PG8_WAIT_V(8); PG8_WAIT_L(0); PG8_BAR; PG8_MMA(1, 0, At, B0); PG8_MMA(1, 1, At, B1); PG8_BAR; PG8_SCHED;
        }
        if (wr == 0) PG8_BAR;
        E(acc, cur, wr, wc, fr, fq);
        if constexpr (Epi::SIGNAL) { PG8_WAIT_V(0); PG8_BAR; if (tid == 0) E.signal(cur); }
        if (!has_next) break;
        if constexpr (Epi::ACC_INIT) E.init(acc, nxt, wr, wc, fr, fq);
        else {
#pragma unroll
        for (int a = 0; a < 2; ++a)
#pragma unroll
            for (int b = 0; b < 2; ++b)
#pragma unroll
                for (int m = 0; m < 4; ++m)
#pragma unroll
                    for (int n = 0; n < 2; ++n) acc[a][b][m][n] = (f32x4){0.f, 0.f, 0.f, 0.f}; }
        cur = nxt; cA = nA; cB = nB; ++ui;
        if (wr == 1) PG8_BAR;
    }
    PG8_WAIT_V(0);
    PG8_BAR;
#undef PG8_SA
#undef PG8_SB
#undef PG8_STAGE
#undef PG8_LDA
#undef PG8_LDB
#undef PG8_MMA
#undef PG8_WAIT_V
#undef PG8_WAIT_L
#undef PG8_BAR
#undef PG8_SCHED
}
}

__device__ __forceinline__ void phase_gemm_pe(const Frame& F) {
    pg8::DenseOrder S; S.init(F.ws + WS_PB, F.ws + WS_WPE, T, D, PD, DEPTH, F.G, F.blk); pg8::EpiBf16 E{(bf16*)(F.ws + WS_PE), D};
    pg8::gemm_phase(F.wave, F.lds, PD, S, E);
}
__device__ __forceinline__ void phase_gemm_in(const Frame& F, int l) {
    pg8::DenseOrder S; S.init(F.ws + WS_XN, (bf16*)(F.ws + WS_WIN) + (size_t)l * DIN * D, T, DIN, D, 1, F.G, F.blk); pg8::EpiBf16 E{(bf16*)(F.ws + WS_Z), DIN};
    pg8::gemm_phase(F.wave, F.lds, D, S, E);
}
__device__ __forceinline__ void phase_gemm_out(const Frame& F, int l) {
    pg8::DenseOrder S; S.init(F.ws + WS_O, (bf16*)(F.ws + WS_WOUT) + (size_t)l * D * D, T, D, D, 1, F.G, F.blk); pg8::EpiResid E{(bf16*)(F.ws + WS_H)};
    pg8::gemm_phase(F.wave, F.lds, D, S, E);
}
__device__ __forceinline__ void phase_gemm_moe1(const Frame& F, int l) {
    pg8::MoeOrder S; S.init(F.ws + WS_XB, (bf16*)(F.ws + WS_WGU) + (size_t)l * NE * 1024 * 1024, (const int*)(F.ws + MS_BLKE) + l * 256, D, 4, (size_t)1024 * 1024 * 2, F.G, F.blk); pg8::EpiGateUp E{(bf16*)(F.ws + WS_HB)};
    pg8::gemm_phase(F.wave, F.lds, D, S, E);
    { const int nun = S.nrb * 4, rem = nun % F.G, few = (rem == 0 || F.G - rem < 64), idle = few ? F.G : F.G - rem, first = few ? 0 : rem;
      if (F.blk >= first) { pg8::DenseOrder P; P.init((const bf16*)(F.ws + WS_PB) + (size_t)l * T * PD, (const bf16*)(F.ws + WS_WPE) + (size_t)l * D * PD, T, D, PD, 1, idle, F.blk - first);
          pg8::EpiBf16 EP{(bf16*)(F.ws + WS_PE) + (size_t)l * T * D, D}; pg8::gemm_phase(F.wave, F.lds, PD, P, EP); }
      conv_deferred(F, l + 1, 0, NDEF1, first, idle); }
}
__device__ __forceinline__ void phase_gemm_moe2(const Frame& F, int l) {
    pg8::MoeOrder S; S.init(F.ws + WS_HB, (bf16*)(F.ws + WS_WD) + (size_t)l * NE * D * DE, (const int*)(F.ws + MS_BLKE) + l * 256, DE, 4, (size_t)D * DE * 2, F.G, F.blk); pg8::EpiBf16 E{(bf16*)(F.ws + WS_Y), D};
    pg8::gemm_phase(F.wave, F.lds, DE, S, E);
    { const int nun = S.nrb * 4, rem = nun % F.G, few = (rem == 0 || F.G - rem < 64), idle = few ? F.G : F.G - rem, first = few ? 0 : rem;
      conv_deferred(F, l + 1, NDEF1, NDEF, first, idle); }
}
#ifndef MOE_CPE
#define MOE_CPE 5
#endif
#ifndef MOE_CTL
#define MOE_CTL 4
#endif
#ifndef MOE_X1
#define MOE_X1 16
#define MOE_X2 8
#endif
template <int MODE = 0> __device__ __forceinline__ void phase_moe_fused(const Frame& F, int l) {
    unsigned char* ws = F.ws; const int G = F.G, blk = F.blk;
    const int* blke = (const int*)(ws + MS_BLKE) + l * 256;
    unsigned* done = (unsigned*)(ws + WS_CTL) + CW_DONE + l * 256;
    const int nrb = __builtin_amdgcn_readfirstlane(blke[255]), nu = 4 * nrb, e1 = nu % G;
    if constexpr (MODE == 1) { pg8::MoeOrder S; S.init(ws + WS_XB, (bf16*)(ws + WS_WGU) + (size_t)l * NE * 1024 * 1024, blke, D, 4, (size_t)1024 * 1024 * 2, G, blk);
      pg8::EpiGateUp E{(bf16*)(ws + WS_HB)}; pg8::gemm_phase(F.wave, F.lds, D, S, E); return; }
    if constexpr (MODE == 0) { pg8::MoeOrder S; S.init(ws + WS_XB, (bf16*)(ws + WS_WGU) + (size_t)l * NE * 1024 * 1024, blke, D, 4, (size_t)1024 * 1024 * 2, G, blk);
      pg8::EpiGateUpPub E{__builtin_amdgcn_make_buffer_rsrc(ws + WS_HB, 0, (int)((size_t)CAP * DE * 2), 0x00020000), done};
      pg8::gemm_phase(F.wave, F.lds, D, S, E); }
    if constexpr (MODE == 2) { pg8::MoeOrder S; S.init(ws + WS_HB, (bf16*)(ws + WS_WD) + (size_t)l * NE * D * DE, blke, DE, 4, (size_t)D * DE * 2, G, blk >= e1 ? blk - e1 : blk - e1 + G);
      pg8::EpiBf16 E{(bf16*)(ws + WS_Y), D}; pg8::gemm_phase(F.wave, F.lds, DE, S, E); }
    if constexpr (MODE == 0) { pg8::MoeDepOrder S; S.init(ws + WS_HB, (bf16*)(ws + WS_WD) + (size_t)l * NE * D * DE, blke, done, DE, 4, (size_t)D * DE * 2, G, blk >= e1 ? blk - e1 : blk - e1 + G);
      pg8::EpiBf16 E{(bf16*)(ws + WS_Y), D};
      pg8::gemm_phase(F.wave, F.lds, DE, S, E); }
    { const int nt = (l + 1 < DEPTH) ? NDEF : 0, ftot = 256 * MOE_CPE + nt * MOE_CTL;
      const int wrap = 2 * e1 > G ? 2 * e1 - G : 0;
      auto cls = [&](int x, int& c24, int& c16, int& c8, int& c0) {
          const int cA = x < e1 ? x : e1, cAB = x < wrap ? x : wrap;
          int cB = x - e1; cB = cB < 0 ? 0 : cB; if (!wrap) cB = cB > e1 ? e1 : cB; cB += cAB;
          c24 = cAB; c16 = cA - cAB; c8 = cB - cAB; c0 = x - c24 - c16 - c8; };
      auto fill = [&](int x, int lv) { int c24, c16, c8, c0; cls(x, c24, c16, c8, c0);
          return c0 * lv + c8 * (lv > MOE_X2 ? lv - MOE_X2 : 0) + c16 * (lv > MOE_X1 ? lv - MOE_X1 : 0) + c24 * (lv > MOE_X1 + MOE_X2 ? lv - MOE_X1 - MOE_X2 : 0); };
      int lv = 1; while (fill(G, lv) < ftot) ++lv;
      const int B0 = fill(blk, lv), B1 = fill(blk + 1, lv);
      const int pe_tot = 256 * MOE_CPE;
      int j0 = (B0 + MOE_CPE - 1) / MOE_CPE, j1 = (B1 + MOE_CPE - 1) / MOE_CPE; j0 = j0 < 256 ? j0 : 256; j1 = j1 < 256 ? j1 : 256;
      int t0 = B0 > pe_tot ? (B0 - pe_tot + MOE_CTL - 1) / MOE_CTL : 0, t1 = B1 > pe_tot ? (B1 - pe_tot + MOE_CTL - 1) / MOE_CTL : 0; t0 = t0 < nt ? t0 : nt; t1 = t1 < nt ? t1 : nt;
      if (j1 > j0) { pg8::RangeOrder P; P.init((const bf16*)(ws + WS_PB) + (size_t)l * T * PD, (const bf16*)(ws + WS_WPE) + (size_t)l * D * PD, T, D, PD, j0, j1 - j0);
          pg8::EpiBf16 EP{(bf16*)(ws + WS_PE) + (size_t)l * T * D, D}; pg8::gemm_phase(F.wave, F.lds, PD, P, EP); }
      if (t1 > t0) { const int base = (l + 1) * TL_LAYER + t0; conv_run(F, 0, 1, t1 - t0, [=](int f) { return base + f; }); } }
}
__device__ __forceinline__ void phase_gemm_pg(const Frame& F, int l) {
    pg8::DenseOrder S; S.init(F.ws + WS_XN, (bf16*)(F.ws + WS_WPG) + (size_t)l * D * D, T, D, D, 1, F.G, F.blk);
    pg8::EpiPG E{(bf16*)(F.ws + WS_H), (const bf16*)(F.ws + WS_PE) + (size_t)l * T * D, (const float*)(F.ws + MS_RSTDPE), F.in[22] + l * D};
    pg8::gemm_phase(F.wave, F.lds, D, S, E);
}

typedef short s16x4 __attribute__((ext_vector_type(4)));
__device__ __forceinline__ bf16x8 tr_frag(LAS unsigned char* p_lo, LAS unsigned char* p_hi) {
    const s16x4 lo = __builtin_amdgcn_ds_read_tr16_b64_v4i16((LAS s16x4*)p_lo), hi = __builtin_amdgcn_ds_read_tr16_b64_v4i16((LAS s16x4*)p_hi);
    return __builtin_shufflevector(lo, hi, 0, 1, 2, 3, 4, 5, 6, 7); }
#define MFMA16(a, b, c) __builtin_amdgcn_mfma_f32_16x16x32_bf16((a), (b), (c), 0, 0, 0)
constexpr int RP = 272;
constexpr int VP = 1040;

__device__ __forceinline__ void phase_rec_c1(const Frame& F, int l) {
    PH_TID();
    unsigned char* ws = F.ws; const bf16* Z = (const bf16*)(ws + WS_Z);
    bf16* UT = (bf16*)(ws + WS_UT); float* DC = (float*)(ws + MS_DC); float* MM = (float*)(ws + MS_MM);
    const float* lb = (const float*)(ws + MS_LB) + l * DREC;
    LAS unsigned char* KD = F.lds; LAS unsigned char* IM = F.lds + 128 * RP; LAS float* totx = (LAS float*)(F.lds + 256 * RP);
    const int wave = ph_wave, ch = tid & 255, half = tid >> 8, hl = ch >> 7, k = ch & 127, g = lane >> 4, li = lane & 15, q = li >> 2, p = li & 3;
    const int hG = F.G / 2, nmine = (F.G == 256) ? (F.blk < hG ? 4 : 0) : 0;
    for (int ui = 0; (F.G == 256) ? (ui < nmine) : (F.blk + ui * F.G < 512); ++ui) {
        const int unit = (F.G == 256) ? F.blk + ui * hG : F.blk + ui * F.G;
        const int c = unit >> 1, hp = unit & 1, hh = 2 * hp + hl;
        const bf16* zb = Z + (size_t)(c * 64 + 32 * half) * DIN + 512 + hh * 128 + k;
        const float lbk = lb[hh * 128 + k];
        float cs[32], kk[32]; float run = 1.f;
#pragma unroll
        for (int t = 0; t < 32; ++t) { const float fz = bf2f(zb[(size_t)t * DIN]); const float sg = sigmoid_(fz); run *= lbk + (1.f - lbk) * sg; cs[t] = run; kk[t] = (1.f - lbk) * (1.f - sg); }
        totx[half * 256 + ch] = run;
#pragma unroll
        for (int j = 0; j < 4; ++j) { const int idx = tid + 512 * j, hl2 = idx >> 10, row = (idx >> 4) & 63, cc = idx & 15;
            const u32x4 v = *(const u32x4*)(Z + (size_t)(c * 64 + row) * DIN + 1024 + (2 * hp + hl2) * 128 + cc * 8);
            *(LAS u32x4*)(IM + (hl2 * 64 + row) * RP + cc * 16) = v; }
        __syncthreads();
        const float other = totx[(1 - half) * 256 + ch]; const float p63 = run * other; const float base_p = half == 0 ? p63 : run;
#pragma unroll
        for (int t = 0; t < 32; ++t) *(LAS bf16*)(KD + (hl * 64 + 32 * half + t) * RP + 2 * k) = (bf16)f2bf(kk[t] * base_p * frcp(fmaxf(cs[t], 1e-30f)));
        if (half == 0) { DC[(c * 4 + hh) * 128 + k] = p63; MM[(c * 4 + hh) * 128 + k] = run; }
        __syncthreads();
        { const int whl = wave >> 2, kt0 = 2 * (wave & 3), whh = 2 * hp + whl;
          f32x4 acc[2][8];
#pragma unroll
          for (int i = 0; i < 2; ++i)
#pragma unroll
              for (int vt = 0; vt < 8; ++vt) acc[i][vt] = (f32x4){0.f, 0.f, 0.f, 0.f};
          LAS unsigned char* kdb = KD + whl * 64 * RP; LAS unsigned char* imb = IM + whl * 64 * RP;
#pragma unroll
          for (int a = 0; a < 2; ++a) { const unsigned ro = (unsigned)((32 * a + 8 * g + q) * RP);
              bf16x8 Af[2];
#pragma unroll
              for (int i = 0; i < 2; ++i) { const unsigned co = (unsigned)((16 * (kt0 + i) + 4 * p) * 2); Af[i] = tr_frag(kdb + ro + co, kdb + ro + 4 * RP + co); }
#pragma unroll
              for (int vt = 0; vt < 8; ++vt) { const unsigned co = (unsigned)((16 * vt + 4 * p) * 2); const bf16x8 Bf = tr_frag(imb + ro + co, imb + ro + 4 * RP + co);
#pragma unroll
                  for (int i = 0; i < 2; ++i) acc[i][vt] = MFMA16(Af[i], Bf, acc[i][vt]); } }
#pragma unroll
          for (int i = 0; i < 2; ++i)
#pragma unroll
              for (int vt = 0; vt < 8; ++vt) { u32x2 w; w.x = pg8::cvt_pk_bf16(acc[i][vt][0], acc[i][vt][1]); w.y = pg8::cvt_pk_bf16(acc[i][vt][2], acc[i][vt][3]);
                  *(u32x2*)(UT + ((size_t)(c * 4 + whh) * 128 + 16 * vt + li) * 128 + 16 * (kt0 + i) + 4 * g) = w; } }
        __syncthreads();
    }
}
__device__ __forceinline__ void phase_rec_c2a(const Frame& F) {
    PH_TID();
    unsigned char* ws = F.ws; const unsigned* UT = (const unsigned*)(ws + WS_UT); const float* DC = (const float*)(ws + MS_DC);
    f32x2* LT = (f32x2*)(ws + WS_LTOT); float* PT = (float*)(ws + MS_PTOT);
    for (int it = F.blk * NTHR + tid; it < 16 * 32768; it += F.G * NTHR) {
        const int gs = it >> 15, e = it & 32767, hh = e >> 13, v = (e >> 6) & 127, k0 = 2 * (e & 63);
        float S0 = 0.f, S1 = 0.f, P0 = 1.f, P1 = 1.f;
#pragma unroll
        for (int cc = 0; cc < 16; ++cc) { const int c = 16 * gs + cc; const unsigned u = UT[(size_t)c * 32768 + e]; const f32x2 d = *(const f32x2*)(DC + (c * 4 + hh) * 128 + k0);
            S0 = d.x * S0 + bflo(u); S1 = d.y * S1 + bfhi(u); P0 *= d.x; P1 *= d.y; }
        LT[it] = (f32x2){S0, S1};
        if (v == 0) *(f32x2*)(PT + (gs * 4 + hh) * 128 + k0) = (f32x2){P0, P1};
    }
}
__device__ __forceinline__ void phase_rec_c2c(const Frame& F) {
    PH_TID();
    unsigned char* ws = F.ws; const unsigned* UT = (const unsigned*)(ws + WS_UT); unsigned* ST = (unsigned*)(ws + WS_ST); const float* DC = (const float*)(ws + MS_DC); const float* MM = (const float*)(ws + MS_MM);
    const f32x2* LT = (const f32x2*)(ws + WS_LTOT); const float* PT = (const float*)(ws + MS_PTOT);
    for (int it = F.blk * NTHR + tid; it < 16 * 32768; it += F.G * NTHR) {
        const int gs = it >> 15, e = it & 32767, hh = e >> 13, k0 = 2 * (e & 63);
        float C0 = 0.f, C1 = 0.f;
        for (int g2 = 0; g2 < gs; ++g2) { const f32x2 pt = *(const f32x2*)(PT + (g2 * 4 + hh) * 128 + k0); const f32x2 lt = LT[g2 * 32768 + e]; C0 = pt.x * C0 + lt.x; C1 = pt.y * C1 + lt.y; }
#pragma unroll
        for (int cc = 0; cc < 16; ++cc) { const int c = 16 * gs + cc; const f32x2 mm = *(const f32x2*)(MM + (c * 4 + hh) * 128 + k0);
            ST[(size_t)c * 32768 + e] = pk2(C0 * mm.x, C1 * mm.y);
            const unsigned u = UT[(size_t)c * 32768 + e]; const f32x2 d = *(const f32x2*)(DC + (c * 4 + hh) * 128 + k0);
            C0 = d.x * C0 + bflo(u); C1 = d.y * C1 + bfhi(u); }
    }
}
__device__ __forceinline__ void phase_rec_c2(const Frame& F) {
    PH_TID();
    unsigned char* ws = F.ws; const int w = ph_wave;
    LAS float* tot = (LAS float*)F.lds;
    for (int unit = F.blk; unit < 256; unit += F.G) {
        const int hh = unit >> 6; const unsigned eo = (unsigned)(unit * 128 + lane), ko = (unsigned)(hh * 128 + 2 * lane);
        const unsigned* ut = (const unsigned*)(ws + WS_UT) + (size_t)(32 * w) * 32768; unsigned* st = (unsigned*)(ws + WS_ST) + (size_t)(32 * w) * 32768;
        const float* dc = (const float*)(ws + MS_DC) + (32 * w) * 512; const float* mmp = (const float*)(ws + MS_MM) + (32 * w) * 512;
        asm volatile("" : "+s"(ut), "+s"(st), "+s"(dc), "+s"(mmp));
        unsigned ua[32], ub[32]; f32x2 d[32], m0[16], m1[16];
#pragma unroll
        for (int cc = 0; cc < 32; ++cc) { ua[cc] = (ut + cc * 32768)[eo]; ub[cc] = (ut + cc * 32768 + 64)[eo]; d[cc] = *(const f32x2*)((dc + cc * 512) + ko); }
        __builtin_amdgcn_sched_barrier(0);
        float a0 = 0.f, a1 = 0.f, b0 = 0.f, b1 = 0.f, p0 = 1.f, p1 = 1.f;
#pragma unroll
        for (int cc = 0; cc < 32; ++cc) { a0 = d[cc].x * a0 + bflo(ua[cc]); a1 = d[cc].y * a1 + bfhi(ua[cc]); b0 = d[cc].x * b0 + bflo(ub[cc]); b1 = d[cc].y * b1 + bfhi(ub[cc]); p0 *= d[cc].x; p1 *= d[cc].y; }
        { LAS float* tw = tot + w * 384 + lane; tw[0] = a0; tw[64] = a1; tw[128] = b0; tw[192] = b1; tw[256] = p0; tw[320] = p1; }
        __builtin_amdgcn_sched_barrier(0);
#pragma unroll
        for (int cc = 0; cc < 16; ++cc) m0[cc] = *(const f32x2*)((mmp + cc * 512) + ko);
        __builtin_amdgcn_sched_barrier(0);
        __syncthreads();
        float A0 = 0.f, A1 = 0.f, B0 = 0.f, B1 = 0.f;
        for (int g2 = 0; g2 < w; ++g2) { const LAS float* tw = tot + g2 * 384 + lane; const float q0 = tw[256], q1 = tw[320]; A0 = q0 * A0 + tw[0]; A1 = q1 * A1 + tw[64]; B0 = q0 * B0 + tw[128]; B1 = q1 * B1 + tw[192]; }
        __builtin_amdgcn_sched_barrier(0);
#pragma unroll
        for (int cc = 0; cc < 16; ++cc) m1[cc] = *(const f32x2*)((mmp + (16 + cc) * 512) + ko);
        __builtin_amdgcn_sched_barrier(0);
#pragma unroll
        for (int cc = 0; cc < 32; ++cc) { const f32x2 mm = cc < 16 ? m0[cc & 15] : m1[cc & 15];
            (st + cc * 32768)[eo] = pk2(A0 * mm.x, A1 * mm.y); (st + cc * 32768 + 64)[eo] = pk2(B0 * mm.x, B1 * mm.y);
            unsigned xa = ua[cc], xb = ub[cc]; asm volatile("" : "+v"(xa), "+v"(xb));
            A0 = d[cc].x * A0 + bflo(xa); A1 = d[cc].y * A1 + bfhi(xa); B0 = d[cc].x * B0 + bflo(xb); B1 = d[cc].y * B1 + bfhi(xb);
            asm volatile("" : "+v"(A0), "+v"(A1), "+v"(B0), "+v"(B1) :: "memory"); }
        __syncthreads();
    }
}
template <int PV = 0> __device__ __forceinline__ void phase_rec_c3(const Frame& F, int l) {
    PH_TID();
    unsigned char* ws = F.ws; const bf16* Z = (const bf16*)(ws + WS_Z); const bf16* ST = (const bf16*)(ws + WS_ST); bf16* O = (bf16*)(ws + WS_O);
    const float* lb = (const float*)(ws + MS_LB) + l * DREC; const float* ogain = F.in[5] + l * 128;
    LAS unsigned char* QT = F.lds; LAS unsigned char* KT = F.lds + 128 * RP; LAS unsigned char* IM = F.lds + 256 * RP;
    const int wave = ph_wave, ch = tid & 255, half = tid >> 8, hl = ch >> 7, k = ch & 127, g = lane >> 4, li = lane & 15, q = li >> 2, p = li & 3;
    for (int unit = F.blk; unit < 512; unit += F.G) {
        const int c = unit >> 1, hp = unit & 1, hh = 2 * hp + hl;
#pragma unroll
        for (int j = 0; j < 4; ++j) { const int idx = tid + 512 * j, hl2 = idx >> 10, row = (idx >> 4) & 63, cc = idx & 15;
            const bf16* src = Z + (size_t)(c * 64 + row) * DIN + (2 * hp + hl2) * 128 + cc * 8; const int dst = (hl2 * 64 + row) * RP + cc * 16;
            const u32x4 vq = *(const u32x4*)src, vf = *(const u32x4*)(src + 512), vi = *(const u32x4*)(src + 1024);
            *(LAS u32x4*)(QT + dst) = vq; *(LAS u32x4*)(KT + dst) = vf; *(LAS u32x4*)(IM + dst) = vi; }
        __syncthreads();
        { const float lbk = lb[hh * 128 + k]; const int col = (hl * 64 + 32 * half) * RP + 2 * k;
          float cs[32], kk[32], qs[32]; float run = 1.f;
#pragma unroll
          for (int t = 0; t < 32; ++t) { const float fz = bf2f(*(const LAS bf16*)(KT + col + t * RP)); const float sg = sigmoid_(fz); run *= lbk + (1.f - lbk) * sg; cs[t] = run; kk[t] = (1.f - lbk) * (1.f - sg);
              qs[t] = silu_(bf2f(*(const LAS bf16*)(QT + col + t * RP))); }
          const float inv = half == 0 ? frcp(fmaxf(run, 1e-30f)) : 1.f;
#pragma unroll
          for (int t = 0; t < 32; ++t) { const float ex = cs[t] * inv; const int off = col + t * RP;
              *(LAS bf16*)(QT + off) = (bf16)f2bf(qs[t] * ex); *(LAS bf16*)(KT + off) = (bf16)f2bf(kk[t] * frcp(fmaxf(ex, 1e-30f))); } }
        const int whl = wave >> 2, tt = wave & 3, whh = 2 * hp + whl;
        bf16x8 Sf[8][4];
#pragma unroll
        for (int vt = 0; vt < 8; ++vt)
#pragma unroll
            for (int a = 0; a < 4; ++a) Sf[vt][a] = *(const bf16x8*)(ST + ((size_t)(c * 4 + whh) * 128 + 16 * vt + li) * 128 + 32 * a + 8 * g);
        __syncthreads();
        if (PV != 1) {
          bf16 gz[8][4];
#pragma unroll
          for (int vt = 0; vt < 8; ++vt)
#pragma unroll
              for (int r = 0; r < 4; ++r) gz[vt][r] = Z[((size_t)c * 64 + 16 * tt + 4 * g + r) * DIN + 1536 + whh * 128 + 16 * vt + li];
          bf16x8 Qf[4];
#pragma unroll
          for (int a = 0; a < 4; ++a) Qf[a] = *(const LAS bf16x8*)(QT + (whl * 64 + 16 * tt + li) * RP + (32 * a + 8 * g) * 2);
          unsigned pw[4][2];
#pragma unroll
          for (int st = 0; st < 4; ++st) { pw[st][0] = 0u; pw[st][1] = 0u;
              { f32x4 s = (f32x4){0.f, 0.f, 0.f, 0.f};
#pragma unroll
                  for (int a = 0; a < 4; ++a) { const bf16x8 Kf = *(const LAS bf16x8*)(KT + (whl * 64 + 16 * st + li) * RP + (32 * a + 8 * g) * 2); s = MFMA16(Kf, Qf[a], s); }
                  if (st == tt) {
#pragma unroll
                      for (int r = 0; r < 4; ++r) if (4 * g + r > li) s[r] = 0.f; }
                  pw[st][0] = st <= tt ? pg8::cvt_pk_bf16(s[0], s[1]) : 0u; pw[st][1] = st <= tt ? pg8::cvt_pk_bf16(s[2], s[3]) : 0u; } }
          f32x4 acc[8];
#pragma unroll
          for (int vt = 0; vt < 8; ++vt) { acc[vt] = (f32x4){0.f, 0.f, 0.f, 0.f};
#pragma unroll
              for (int a = 0; a < 4; ++a) acc[vt] = MFMA16(Qf[a], Sf[vt][a], acc[vt]); }
          LAS unsigned char* imb = IM + whl * 64 * RP;
#pragma unroll
          for (int a = 0; a < 2; ++a) { const u32x4 pv = (u32x4){pw[2 * a][0], pw[2 * a][1], pw[2 * a + 1][0], pw[2 * a + 1][1]}; const bf16x8 Pf = __builtin_bit_cast(bf16x8, pv);
              const unsigned ro = (unsigned)((32 * a + 4 * g + q) * RP);
#pragma unroll
              for (int vt = 0; vt < 8; ++vt) { const unsigned co = (unsigned)((16 * vt + 4 * p) * 2); const bf16x8 If = tr_frag(imb + ro + co, imb + ro + 16 * RP + co); acc[vt] = MFMA16(Pf, If, acc[vt]); } }
          float rs[4];
#pragma unroll
          for (int r = 0; r < 4; ++r) { float ss = 0.f;
#pragma unroll
              for (int vt = 0; vt < 8; ++vt) ss += acc[vt][r] * acc[vt][r];
              ss += shx<1>(ss); ss += shx<2>(ss); ss += shx<4>(ss); ss += shx<8>(ss); rs[r] = frsq(ss * (1.f / 128.f) + EPS); }
#pragma unroll
          for (int vt = 0; vt < 8; ++vt) { const float og = ogain[16 * vt + li];
#pragma unroll
              for (int r = 0; r < 4; ++r) { const size_t t = (size_t)c * 64 + 16 * tt + 4 * g + r; const float gv = bf2f(gz[vt][r]);
                  O[t * D + whh * 128 + 16 * vt + li] = (bf16)f2bf(acc[vt][r] * rs[r] * og * silu_(gv)); } } }
        __syncthreads();
    }
}
__device__ __forceinline__ void phase_sgu(const Frame& F, int l) {
    PH_TID();
    unsigned char* ws = F.ws; const bf16* Z = (const bf16*)(ws + WS_Z); bf16* O = (bf16*)(ws + WS_O);
    const bf16* Wb = (const bf16*)(ws + MS_SGUW) + (size_t)l * 4 * 128 * 128; const float* sb = F.in[9] + l * 4 * 128;
    LAS unsigned char* VN = F.lds;
    const int wave = ph_wave, g = lane >> 4, li = lane & 15, q = li >> 2, p = li & 3;
    for (int unit = (F.blk + F.G / 2) % F.G; unit < 128; unit += F.G) {
        float lg[8], lbv[8];
#pragma unroll
        for (int j = 0; j < 8; ++j) { lg[j] = F.in[6][l * DSGU + 8 * lane + j]; lbv[j] = F.in[7][l * DSGU + 8 * lane + j]; }
        u32x4 raw[16];
#pragma unroll
        for (int i = 0; i < 16; ++i) raw[i] = *(const u32x4*)(Z + ((size_t)unit * 128 + 16 * wave + i) * DIN + 2560 + 8 * lane);
#pragma unroll
        for (int i = 0; i < 16; ++i) { const int s = 16 * wave + i; const u32x4 r = raw[i];
            float x[8] = {gelu_(bflo(r.x)), gelu_(bfhi(r.x)), gelu_(bflo(r.y)), gelu_(bfhi(r.y)), gelu_(bflo(r.z)), gelu_(bfhi(r.z)), gelu_(bflo(r.w)), gelu_(bfhi(r.w))};
            float sm = 0.f, qq = 0.f;
#pragma unroll
            for (int j = 0; j < 8; ++j) { sm += x[j]; qq += x[j] * x[j]; }
            sm += shx<1>(sm); qq += shx<1>(qq); sm += shx<2>(sm); qq += shx<2>(qq); sm += shx<4>(sm); qq += shx<4>(qq); sm += shx<8>(sm); qq += shx<8>(qq); sm += shx<16>(sm); qq += shx<16>(qq);
            const float mu = halves_sum(sm) * (1.f / 512.f); const float var = fmaxf(halves_sum(qq) * (1.f / 512.f) - mu * mu, 0.f);
            const float rstd = frsq(var + EPS);
#pragma unroll
            for (int j = 0; j < 8; ++j) x[j] = (x[j] - mu) * rstd * lg[j] + lbv[j];
            u32x4 o; o.x = pk2(x[0], x[1]); o.y = pk2(x[2], x[3]); o.z = pk2(x[4], x[5]); o.w = pk2(x[6], x[7]);
            *(LAS u32x4*)(VN + s * VP + lane * 16) = o; }
        __syncthreads();
        { const int hh = wave >> 1, dh = wave & 1; const bf16* W = Wb + (size_t)hh * 128 * 128;
          LAS unsigned char* vnb = VN;
#pragma unroll 1
          for (int dp = 0; dp < 2; ++dp) {
          bf16x8 Wf[2][8];
#pragma unroll
          for (int a = 0; a < 2; ++a)
#pragma unroll
              for (int ti = 0; ti < 8; ++ti) if (ti >= 2 * a) Wf[a][ti] = *(const bf16x8*)(W + (size_t)(16 * ti + li) * 128 + 32 * a + 8 * g);
          f32x4 acc[2][8];
#pragma unroll
          for (int dt = 0; dt < 2; ++dt)
#pragma unroll
              for (int ti = 0; ti < 8; ++ti) acc[dt][ti] = (f32x4){0.f, 0.f, 0.f, 0.f};
#pragma unroll
          for (int a = 0; a < 4; ++a) { const unsigned ro = (unsigned)((32 * a + 8 * g + q) * VP);
              bf16x8 Af[2];
#pragma unroll
              for (int dt = 0; dt < 2; ++dt) { const unsigned co = (unsigned)((hh * 128 + 64 * dh + 16 * (2 * dp + dt) + 4 * p) * 2); Af[dt] = tr_frag(vnb + ro + co, vnb + ro + 4 * VP + co); }
#pragma unroll
              for (int ti = 0; ti < 8; ++ti) if (ti >= 2 * a) {
                  const bf16x8 Bf = a < 2 ? Wf[a < 2 ? a : 0][ti] : *(const bf16x8*)(W + (size_t)(16 * ti + li) * 128 + 32 * a + 8 * g);
#pragma unroll
                  for (int dt = 0; dt < 2; ++dt) acc[dt][ti] = MFMA16(Af[dt], Bf, acc[dt][ti]); } }
#pragma unroll
          for (int ti = 0; ti < 8; ++ti) { const size_t t = (size_t)unit * 128 + 16 * ti + li; const float bias = sb[hh * 128 + 16 * ti + li];
#pragma unroll
              for (int dt = 0; dt < 2; ++dt) { const int col = hh * 128 + 64 * dh + 16 * (2 * dp + dt) + 4 * g; const u32x2 u = *(const u32x2*)(Z + t * DIN + 2048 + col);
                  u32x2 w; w.x = pk2((acc[dt][ti][0] + bias) * gelu_(bflo(u.x)), (acc[dt][ti][1] + bias) * gelu_(bfhi(u.x))); w.y = pk2((acc[dt][ti][2] + bias) * gelu_(bflo(u.y)), (acc[dt][ti][3] + bias) * gelu_(bfhi(u.y)));
                  *(u32x2*)(O + t * D + 512 + col) = w; } } } }
        __syncthreads();
    }
}

#define XB_TMO      128
#define XB_XCNT(j)  (256  + 64 * (j))
#define XB_XSUB(j)  (1280 + 64 * (j))
#define XB_XGEN(j)  (2304 + 64 * (j))
#define XB_TOP      3328
#define XB_TOPGEN   3392
#define XCD_BAR_WORDS 3456
#define XB_SPIN_CAP (1u << 18)
__device__ __forceinline__ unsigned xb_ld(unsigned* p)              { return __hip_atomic_load(p, __ATOMIC_RELAXED, __HIP_MEMORY_SCOPE_AGENT); }
__device__ __forceinline__ unsigned xb_add(unsigned* p, unsigned v) { return __hip_atomic_fetch_add(p, v, __ATOMIC_RELAXED, __HIP_MEMORY_SCOPE_AGENT); }
__device__ __forceinline__ unsigned xb_xcc_id() { return (unsigned)__builtin_amdgcn_s_getreg((3 << 11) | 20) & 0xFu; }
#define XB_SPIN(cond, bar) do { unsigned _sp = 0; while (cond) { __builtin_amdgcn_s_sleep(1); \
    if ((++_sp & 255u) == 0u) { if (xb_ld(&(bar)[XB_TMO])) break; if (_sp > XB_SPIN_CAP) { atomicAdd(&(bar)[XB_TMO], 1u); break; } } } } while (0)
struct XcdBarrier { unsigned* bar; unsigned x; volatile LAS unsigned* st; int wave; };
__device__ __forceinline__ XcdBarrier xcd_barrier_post(unsigned* bar, volatile LAS unsigned* st, int wave) {
    XcdBarrier b; b.bar = bar; b.x = xb_xcc_id(); b.st = st; b.wave = wave;
    if (wave == 0 && lane_now() == 0) (void)xb_add(&bar[XB_XCNT(b.x)], 1u);
    return b;
}
__device__ __forceinline__ void xcd_barrier_complete(unsigned* bar, unsigned x, unsigned& nloc, unsigned& nx) {
    const unsigned G = gridDim.x * gridDim.y * gridDim.z;
    unsigned sum, cnt, mine, sp = 0u;
    for (;;) {
        sum = 0u; cnt = 0u; mine = 0u;
#pragma unroll
        for (unsigned j = 0; j < 16; ++j) { const unsigned c = xb_ld(&bar[XB_XCNT(j)]); sum += c; cnt += (c > 0u) ? 1u : 0u; mine = (j == x) ? c : mine; }
        if (sum == G) break;
        __builtin_amdgcn_s_sleep(1);
        if ((++sp & 255u) == 0u) { if (xb_ld(&bar[XB_TMO])) break; if (sp > XB_SPIN_CAP) { atomicAdd(&bar[XB_TMO], 1u); break; } }
    }
    nloc = mine > 0u ? mine : 1u; nx = cnt > 0u ? cnt : 1u;
}
__device__ __forceinline__ void xcd_barrier(const XcdBarrier& b) {
    asm volatile("s_waitcnt vmcnt(0)" ::: "memory");
    __syncthreads();
    if (b.wave == 0 && lane_now() == 0) {
        unsigned* bar = b.bar;
        __builtin_amdgcn_s_waitcnt(0);
        unsigned nloc = b.st[0], nx = b.st[1];
        if (nloc == 0u) { xcd_barrier_complete(bar, b.x, nloc, nx); b.st[0] = nloc; b.st[1] = nx; }
        const unsigned old = xb_add(&bar[XB_XSUB(b.x)], 1u);
        const unsigned gen = old / nloc;
        if (old + 1u == (gen + 1u) * nloc) {
            __builtin_amdgcn_fence(__ATOMIC_RELEASE, "agent");
            asm volatile("s_waitcnt vmcnt(0)" ::: "memory");
            const unsigned og = xb_add(&bar[XB_TOP], 1u);
            const unsigned tg = og / nx;
            if (og + 1u == (tg + 1u) * nx) xb_add(&bar[XB_TOPGEN], 1u);
            else XB_SPIN(xb_ld(&bar[XB_TOPGEN]) == tg, bar);
            __builtin_amdgcn_fence(__ATOMIC_ACQUIRE, "agent");
            xb_add(&bar[XB_XGEN(b.x)], 1u);
            asm volatile("s_waitcnt vmcnt(0)" ::: "memory");
        } else {
            XB_SPIN(xb_ld(&bar[XB_XGEN(b.x)]) == gen, bar);
            __builtin_amdgcn_fence(__ATOMIC_ACQUIRE, "agent");
            asm volatile("s_waitcnt vmcnt(0)" ::: "memory");
        }
    }
    __syncthreads();
}


__device__ __forceinline__ void xcd_barrier_bg(const XcdBarrier& b, const Frame& F, int lnext, bool drain) {
    asm volatile("s_waitcnt vmcnt(0)" ::: "memory");
    __syncthreads();
    volatile LAS unsigned* sx = b.st + 4;
    unsigned* q = (unsigned*)(F.ws + WS_CTL) + CW_BGQ + lnext * 64;
    if (b.wave == 0 && lane_now() == 0) {
        unsigned* bar = b.bar;
        __builtin_amdgcn_s_waitcnt(0);
        unsigned nloc = b.st[0], nx = b.st[1];
        if (nloc == 0u) { xcd_barrier_complete(bar, b.x, nloc, nx); b.st[0] = nloc; b.st[1] = nx; }
        const unsigned old = xb_add(&bar[XB_XSUB(b.x)], 1u);
        const unsigned gen = old / nloc;
        const bool leader = (old + 1u == (gen + 1u) * nloc);
        unsigned ti = 0u; if (!leader) { const unsigned k = xb_add(q, 1u); if (k < (unsigned)NBG) ti = k + 1u; }
        sx[0] = leader ? 1u : 0u; sx[1] = gen; sx[2] = ti;
    }
    __syncthreads();
    if (__builtin_amdgcn_readfirstlane(sx[0]) == 0u) {
        unsigned ti = (unsigned)__builtin_amdgcn_readfirstlane(sx[2]);
        while (ti != 0u) {
            const int it = lnext * TL_LAYER + NDEF + (int)ti - 1;
            conv_run(F, 0, 1, 1, [=](int) { return it; });
            if (!drain) break;
            if (b.wave == 0 && lane_now() == 0) { const unsigned k = xb_add(q, 1u); sx[2] = k < (unsigned)NBG ? k + 1u : 0u; }
            __syncthreads();
            ti = (unsigned)__builtin_amdgcn_readfirstlane(sx[2]);
            __syncthreads();
        }
    }
    if (b.wave == 0 && lane_now() == 0) {
        unsigned* bar = b.bar; const unsigned gen = sx[1], nx = b.st[1];
        asm volatile("s_waitcnt vmcnt(0)" ::: "memory");
        if (sx[0] != 0u) {
            __builtin_amdgcn_fence(__ATOMIC_RELEASE, "agent");
            asm volatile("s_waitcnt vmcnt(0)" ::: "memory");
            const unsigned og = xb_add(&bar[XB_TOP], 1u);
            const unsigned tg = og / nx;
            if (og + 1u == (tg + 1u) * nx) xb_add(&bar[XB_TOPGEN], 1u);
            else XB_SPIN(xb_ld(&bar[XB_TOPGEN]) == tg, bar);
            __builtin_amdgcn_fence(__ATOMIC_ACQUIRE, "agent");
            xb_add(&bar[XB_XGEN(b.x)], 1u);
            asm volatile("s_waitcnt vmcnt(0)" ::: "memory");
        } else {
            XB_SPIN(xb_ld(&bar[XB_XGEN(b.x)]) == gen, bar);
            __builtin_amdgcn_fence(__ATOMIC_ACQUIRE, "agent");
            asm volatile("s_waitcnt vmcnt(0)" ::: "memory");
        }
    }
    __syncthreads();
}

__device__ __forceinline__ bool opq(Frame& F) { asm volatile("" : "+s"(F.ws), "+s"(F.blk), "+s"(F.out), "+s"(F.G)); return true; }
__device__ __forceinline__ int lq_(int l) { asm volatile("" : "+s"(l)); return l; }
__global__ void __launch_bounds__(NTHR, 2) k_mega(Params p) {
    extern __shared__ __attribute__((aligned(16))) unsigned char lds[];
    Frame F; F.lds = (LAS unsigned char*)lds; F.ws = p.ws; F.in = p.in; F.out = p.out; F.wave = __builtin_amdgcn_readfirstlane(threadIdx.x >> 6); F.blk = blockIdx.x; F.G = gridDim.x;
    volatile LAS unsigned* st = (volatile LAS unsigned*)(F.lds + LDS_BYTES - 32);
    if (threadIdx.x < 8) st[threadIdx.x] = 0u;
    __syncthreads();
#if USE_CG_SYNC
#define GRID_BAR() cooperative_groups::this_grid().sync()
#else
    const XcdBarrier bar = xcd_barrier_post((unsigned*)(p.ws + WS_CTL) + CW_BAR + p.li * XCD_BAR_WORDS, st, F.wave);
#define GRID_BAR() xcd_barrier(bar)
#endif
    const int lo = p.ph_lo, hi = p.ph_hi;
#define RUN(k) (lo <= (k) && (k) < hi && opq(F))
#define SEAM(k) do { if (RUN(k) && RUN((k) + 1)) GRID_BAR(); } while (0)
#define SEAM_BG(k, drain) do { if (RUN(k) && RUN((k) + 1)) { if (!USE_CG_SYNC && l + 1 < DEPTH) xcd_barrier_bg(bar, F, l + 1, drain); else GRID_BAR(); } } while (0)
    if (RUN(0)) { phase_prologue(F); if (PROBE_DUP & 16) { __syncthreads(); phase_prologue(F); } }
    SEAM(0);
    for (int l = 0; l < DEPTH; ++l) {
        const int b = 2 + 13 * l;
        if (RUN(b + 0)) phase_norm1(F, lq_(l));
        SEAM_BG(b + 0, false);
        if (RUN(b + 1)) phase_gemm_in(F, lq_(l));
        SEAM_BG(b + 1, false);
        if (RUN(b + 2)) { phase_rec_c1(F, lq_(l)); phase_sgu(F, lq_(l)); if (PROBE_DUP & 1) { __syncthreads(); phase_rec_c1(F, lq_(l)); phase_sgu(F, lq_(l)); } if (PROBE_DUP & 64) { __syncthreads(); phase_sgu(F, lq_(l)); } }
        SEAM_BG(b + 2, false);
        if (RUN(b + 3)) { phase_rec_c2(F); if (PROBE_DUP & 4) phase_rec_c2(F); }
        SEAM_BG(b + 3, false);
        if (RUN(b + 5)) { phase_rec_c3(F, lq_(l)); if (PROBE_DUP & 2) { __syncthreads(); phase_rec_c3(F, lq_(l)); } if (PROBE_DUP & 128) { __syncthreads(); phase_rec_c3<1>(F, lq_(l)); } }
        SEAM_BG(b + 5, false);
        if (RUN(b + 6)) phase_gemm_out(F, lq_(l));
        SEAM_BG(b + 6, false);
        if (RUN(b + 7)) phase_norm2(F, lq_(l));
        SEAM_BG(b + 7, false);
        if (RUN(b + 8)) { phase_gather(F, lq_(l)); if (PROBE_DUP & 8) { __syncthreads(); phase_gather(F, lq_(l)); } }
        SEAM_BG(b + 8, false);
#if MOE_FUSED == 1
        if (RUN(b + 9)) phase_moe_fused(F, lq_(l));
        SEAM_BG(b + 9, false);
#elif MOE_FUSED == 2
        if (RUN(b + 9)) phase_moe_fused<1>(F, lq_(l));
        SEAM_BG(b + 9, false);
        if (RUN(b + 10)) phase_moe_fused<2>(F, lq_(l));
        SEAM_BG(b + 10, false);
#else
        if (RUN(b + 9)) phase_gemm_moe1(F, lq_(l));
        SEAM_BG(b + 9, false);
        if (RUN(b + 10)) phase_gemm_moe2(F, lq_(l));
        SEAM_BG(b + 10, false);
#endif
        if (RUN(b + 11)) phase_combine(F, lq_(l));
        SEAM_BG(b + 11, true);
        if (RUN(b + 12)) phase_gemm_pg(F, lq_(l));
        SEAM(b + 12);
    }
    if (RUN(54)) phase_final(F);
#undef RUN
#undef SEAM
}

#ifndef ONE_LAUNCH
#define ONE_LAUNCH 1
#endif
#ifndef CUTS
#define CUTS {0, 55}
#endif
#ifndef MFMA_MASK
#define MFMA_MASK 255
#endif
extern "C" void kernel_launch(void* const* d_in, const int* in_sizes, int n_in, void* d_out, int out_size, void* d_ws, size_t ws_size, hipStream_t stream) {
    if (n_in != 24 || out_size != T * D || ws_size < WS_END) { fprintf(stderr, "kernel_launch: unexpected shapes (n_in %d out %d ws %zu)\n", n_in, out_size, ws_size); return; }
    static_assert(CW_BAR + 60 * XCD_BAR_WORDS <= (int)(CTL_BYTES / 4), "barrier regions inside the zeroed control words");
    Params p{}; for (int i = 0; i < 24; ++i) p.in[i] = (const float*)d_in[i]; p.out = (float*)d_out; p.ws = (unsigned char*)d_ws;
    unsigned char* ws = p.ws;
    (void)hipMemsetAsync(ws + WS_CTL, 0, CTL_BYTES, stream);
    { static bool attr = false; if (!attr) { (void)hipFuncSetAttribute((const void*)k_mega, hipFuncAttributeMaxDynamicSharedMemorySize, LDS_BYTES); attr = true; }
      const int cuts[] = CUTS; const int ncut = (int)(sizeof(cuts) / sizeof(cuts[0]));
      for (int i = 0; i + 1 < ncut; ++i) { p.ph_lo = cuts[i]; p.ph_hi = cuts[i + 1]; p.li = i; p.pad = 0;
#if USE_CG_SYNC
          void* args[] = {&p}; hipError_t e = hipLaunchCooperativeKernel((const void*)k_mega, dim3(256), dim3(NTHR), args, LDS_BYTES, stream);
          if (e != hipSuccess) fprintf(stderr, "cooperative launch failed: %s\n", hipGetErrorName(e));
#else
          hipLaunchKernelGGL(k_mega, dim3(256), dim3(NTHR), LDS_BYTES, stream, p);
#endif
      }
    }
}
```

```cpp
#include <hip/hip_runtime.h>
#include <hip/hip_cooperative_groups.h>
#include <cstdio>
#include <cstdint>

#define GAS __attribute__((address_space(1)))
#define LAS __attribute__((address_space(3)))
typedef unsigned short bf16;
typedef float f32x4 __attribute__((ext_vector_type(4)));
typedef float f32x2 __attribute__((ext_vector_type(2)));
typedef unsigned u32x4 __attribute__((ext_vector_type(4)));
typedef unsigned u32x2 __attribute__((ext_vector_type(2)));
typedef short bf16x8 __attribute__((ext_vector_type(8)));

constexpr int T = 16384, D = 1024, DEPTH = 4, DIN = 3072, DREC = 512, DSGU = 512;
constexpr int NE = 32, DE = 512, PD = 256;
constexpr int RB = 256;
constexpr int CAP = 2 * T + NE * RB;
constexpr int NRBMAX = CAP / RB;
constexpr float EPS = 1e-6f;
constexpr int NWAVES = 8, NTHR = 512;

constexpr size_t MiB = 1u << 20, KiB = 1u << 10;
constexpr size_t WS_CTL = 0, CTL_BYTES = 1 * MiB;
constexpr size_t WS_MISC = 1 * MiB;
constexpr size_t MS_TOKE = WS_MISC + 0;
constexpr size_t MS_TOKW = WS_MISC + 128 * KiB;
constexpr size_t MS_SINFO = WS_MISC + 256 * KiB;
constexpr size_t MS_SDEST = WS_MISC + 384 * KiB;
constexpr size_t MS_RSTDPE = WS_MISC + 512 * KiB;
constexpr size_t MS_BLKBASE = WS_MISC + 576 * KiB;
constexpr size_t MS_LB = WS_MISC + 608 * KiB;
constexpr size_t MS_BLKE = WS_MISC + 640 * KiB;
constexpr size_t MS_DC = WS_MISC + 1 * MiB;
constexpr size_t MS_WRT = WS_MISC + 2 * MiB;
constexpr size_t MS_SGUW = WS_MISC + 3 * MiB;
constexpr size_t MS_MM = WS_MISC + 4 * MiB;
constexpr size_t MS_PTOT = WS_MISC + 5 * MiB;
constexpr size_t WS_WIN = 16 * MiB;
constexpr size_t WS_WOUT = 40 * MiB;
constexpr size_t WS_WGU = 48 * MiB;
constexpr size_t WS_WD = 304 * MiB;
constexpr size_t WS_WPG = 432 * MiB;
constexpr size_t WS_WPE = 440 * MiB;
constexpr size_t WS_PB = 442 * MiB;
constexpr size_t WS_H = 474 * MiB;
constexpr size_t WS_XN = 538 * MiB;
constexpr size_t WS_O = 570 * MiB;
constexpr size_t WS_PE = 602 * MiB;
constexpr size_t WS_R1 = 730 * MiB;
constexpr size_t WS_Z = WS_R1;
constexpr size_t WS_UT = WS_R1 + 96 * MiB;
constexpr size_t WS_ST = WS_R1 + 128 * MiB;
constexpr size_t WS_ORAW = WS_R1 + 96 * MiB;
constexpr size_t WS_VN = WS_R1 + 128 * MiB;
constexpr size_t WS_XB = WS_R1;
constexpr size_t WS_HB = WS_R1 + 80 * MiB;
constexpr size_t WS_Y = WS_R1 + 120 * MiB;
constexpr size_t WS_LTOT = 930 * MiB;
constexpr size_t WS_END = 934 * MiB;
constexpr int CW_CNT = 64;
constexpr int CW_BGQ = 1024;
constexpr int CW_DONE = 2048;
constexpr int CW_BAR = 4096;

constexpr int RING_BYTES = 131072, MISC_OFF = RING_BYTES, LDS_BYTES = 147456;

#ifndef PROBE_DUP
#define PROBE_DUP 0
#endif
#ifndef MOE_FUSED
#define MOE_FUSED 1
#endif
#ifndef USE_CG_SYNC
#define USE_CG_SYNC 0
#endif
struct Params { const float* in[24]; float* out; unsigned char* ws; int ph_lo, ph_hi, li, pad; };

#define LDS_WAIT() asm volatile("s_waitcnt lgkmcnt(0)" ::: "memory")
template <int M> __device__ __forceinline__ float shx(float v) { static_assert(M >= 1 && M < 32, "swizzle xor mask");
    return __int_as_float(__builtin_amdgcn_ds_swizzle(__float_as_int(v), (M << 10) | 0x1F)); }
__device__ __forceinline__ float halves_sum(float v) {
    return __int_as_float(__builtin_amdgcn_readlane(__float_as_int(v), 0)) + __int_as_float(__builtin_amdgcn_readlane(__float_as_int(v), 32)); }
__device__ __forceinline__ float wave_sum(float v) {
    v += shx<1>(v); v += shx<2>(v); v += shx<4>(v); v += shx<8>(v); v += shx<16>(v);
    return halves_sum(v);
}
typedef __bf16 bf16x2_t __attribute__((ext_vector_type(2)));
__device__ __forceinline__ unsigned pk2(float lo, float hi) { const bf16x2_t v = __builtin_convertvector((f32x2){lo, hi}, bf16x2_t); return __builtin_bit_cast(unsigned, v); }
__device__ __forceinline__ unsigned f2bf(float f) { return pk2(f, f) & 0xffffu; }
__device__ __forceinline__ float bflo(unsigned w) { return __uint_as_float(w << 16); }
__device__ __forceinline__ float bfhi(unsigned w) { return __uint_as_float(w & 0xffff0000u); }
__device__ __forceinline__ float bf2f(bf16 b) { return __uint_as_float(((unsigned)b) << 16); }
__device__ __forceinline__ float fexp(float x) { return __builtin_amdgcn_exp2f(x * 1.4426950408889634f); }
__device__ __forceinline__ float flog(float x) { return __builtin_amdgcn_logf(x) * 0.6931471805599453f; }
__device__ __forceinline__ float frcp(float x) { return __builtin_amdgcn_rcpf(x); }
__device__ __forceinline__ float frsq(float x) { return __builtin_amdgcn_rsqf(x); }
__device__ __forceinline__ float sigmoid_(float x) { return frcp(1.f + fexp(-x)); }
__device__ __forceinline__ float silu_(float x) { return x * sigmoid_(x); }
__device__ __forceinline__ float gelu_(float x) { const float K1 = 2.f * 0.7978845608028654f * 1.4426950408889634f, K3 = K1 * 0.044715f;
    const float r = frcp(__builtin_amdgcn_exp2f(x * (K1 + K3 * (x * x))) + 1.f); return x - x * r; }

struct Frame {
    LAS unsigned char* lds; unsigned char* ws; const float* const* in; float* out;
    int wave, blk, G;
};
__device__ __forceinline__ int lane_now() { int l; asm volatile("v_mbcnt_lo_u32_b32 %0, -1, 0\n\tv_mbcnt_hi_u32_b32 %0, -1, %0" : "=v"(l)); return l; }
#define PH_TID() int ph_wave = F.wave; asm volatile("" : "+s"(ph_wave)); const int lane = lane_now(); (void)lane; const int tid = (ph_wave << 6) | lane; (void)tid

struct ConvJob { const float* W; const float* g; bf16* WT; int K, N, k0, n0, mode; };
constexpr int TL_IN = 16 * 12, TL_OUT = 16 * 4, TL_G = 32 * 16 * 2, TL_D = 32 * 8 * 4, TL_PG = 16 * 4, TL_PE = 4 * 4;
constexpr int TL_LAYER = TL_IN + TL_OUT + 2 * TL_G + TL_D + TL_PG + TL_PE;
__device__ __forceinline__ ConvJob conv_job(const Frame& F, int it) {
    unsigned char* ws = F.ws; const int l = it / TL_LAYER; int r = it % TL_LAYER; ConvJob j;
    if (r < TL_IN) { j.W = F.in[3] + (size_t)l * D * DIN; j.g = F.in[2] + l * D; j.WT = (bf16*)(ws + WS_WIN) + (size_t)l * DIN * D; j.K = D; j.N = DIN; j.k0 = 64 * (r / 12); j.n0 = 256 * (r % 12); j.mode = 0; return j; } r -= TL_IN;
    if (r < TL_OUT) { j.W = F.in[10] + (size_t)l * D * D; j.g = nullptr; j.WT = (bf16*)(ws + WS_WOUT) + (size_t)l * D * D; j.K = D; j.N = D; j.k0 = 64 * (r / 4); j.n0 = 256 * (r % 4); j.mode = 0; return j; } r -= TL_OUT;
    if (r < 2 * TL_G) { const int up = r >= TL_G; if (up) r -= TL_G; const int e = r / 32, rr = r % 32;
        j.W = F.in[up ? 17 : 16] + (size_t)(l * NE + e) * D * DE; j.g = F.in[11] + l * D; j.WT = (bf16*)(ws + WS_WGU) + (size_t)(l * NE + e) * 1024 * 1024; j.K = D; j.N = DE; j.k0 = 64 * (rr / 2); j.n0 = 256 * (rr % 2); j.mode = 1 + up; return j; } r -= 2 * TL_G;
    if (r < TL_D) { const int e = r / 32, rr = r % 32; j.W = F.in[18] + (size_t)(l * NE + e) * DE * D; j.g = nullptr; j.WT = (bf16*)(ws + WS_WD) + (size_t)(l * NE + e) * D * DE; j.K = DE; j.N = D; j.k0 = 64 * (rr / 4); j.n0 = 256 * (rr % 4); j.mode = 0; return j; } r -= TL_D;
    if (r < TL_PG) { j.W = F.in[20] + (size_t)l * D * D; j.g = F.in[19] + l * D; j.WT = (bf16*)(ws + WS_WPG) + (size_t)l * D * D; j.K = D; j.N = D; j.k0 = 64 * (r / 4); j.n0 = 256 * (r % 4); j.mode = 0; return j; } r -= TL_PG;
    j.W = F.in[21] + (size_t)l * PD * D; j.g = nullptr; j.WT = (bf16*)(ws + WS_WPE) + (size_t)l * D * PD; j.K = PD; j.N = D; j.k0 = 64 * (r / 4); j.n0 = 256 * (r % 4); j.mode = 0; return j;
}
__device__ __forceinline__ void conv_load(const ConvJob& j, int wave, int lane, f32x4 (&v)[8]) {
#pragma unroll
    for (int i = 0; i < 8; ++i) { const int row = 8 * wave + i; v[i] = *(const f32x4*)(j.W + (size_t)(j.k0 + row) * j.N + j.n0 + 4 * lane); if (j.g) v[i] = v[i] * j.g[j.k0 + row]; }
}
constexpr int NDEF = 384, NDEF1 = 128, NBG = 3024;
constexpr int NREST = TL_LAYER - NDEF - NBG, NPRO = TL_LAYER + 3 * NREST;
__device__ __forceinline__ int pro_tile(int f) { if (NREST == 0 || f < TL_LAYER) return f; f -= TL_LAYER; const int l = 1 + f / (NREST ? NREST : 1); return l * TL_LAYER + NDEF + NBG + f % (NREST ? NREST : 1); }
template <class M> __device__ __forceinline__ void conv_run(const Frame& F, int first, int stride, int count, M tile_of) {
    PH_TID();
    LAS float* tile = (LAS float*)F.lds;
    const int wave = ph_wave;
    int f = first; f32x4 v[8]; ConvJob cur{}, nxt{};
    if (f < count) { cur = conv_job(F, tile_of(f)); conv_load(cur, wave, lane, v); }
    while (f < count) {
#pragma unroll
        for (int i = 0; i < 8; ++i) { LAS float* d = tile + (8 * wave + i) * 257 + 4 * lane; d[0] = v[i].x; d[1] = v[i].y; d[2] = v[i].z; d[3] = v[i].w; }
        __syncthreads();
        const int fn = f + stride; if (fn < count) { nxt = conv_job(F, tile_of(fn)); conv_load(nxt, wave, lane, v); }
#pragma unroll
        for (int q = 0; q < 4; ++q) { const int nn = 32 * wave + 8 * q + (lane >> 3), c = lane & 7; const LAS float* sp = tile + (8 * c) * 257 + nn;
            u32x4 o; o.x = pk2(sp[0 * 257], sp[1 * 257]); o.y = pk2(sp[2 * 257], sp[3 * 257]); o.z = pk2(sp[4 * 257], sp[5 * 257]); o.w = pk2(sp[6 * 257], sp[7 * 257]);
            const int n = cur.n0 + nn; const int drow = cur.mode == 0 ? n : ((n >> 7) * 256 + (n & 127) + (cur.mode == 2 ? 128 : 0));
            *(u32x4*)(cur.WT + (size_t)drow * cur.K + cur.k0 + 8 * c) = o; }
        __syncthreads();
        cur = nxt; f = fn;
    }
}
__device__ __forceinline__ void conv_deferred(const Frame& F, int lnext, int r0, int r1, int first, int idle) {
    if (lnext >= DEPTH || F.blk < first) return;
    conv_run(F, F.blk - first, idle, r1 - r0, [=](int f) { return lnext * TL_LAYER + r0 + f; });
}
__device__ __forceinline__ void phase_prologue(const Frame& F) {
    PH_TID();
    unsigned char* ws = F.ws;
    conv_run(F, F.blk, F.G, NPRO, [](int f) { return pro_tile(f); });
    { const f32x4* src = (const f32x4*)F.in[1]; u32x4* dst = (u32x4*)(ws + WS_PB); const size_t n8 = (size_t)DEPTH * T * PD / 8;
      for (size_t i = (size_t)F.blk * NTHR + tid; i < n8; i += (size_t)F.G * NTHR) { const f32x4 a = src[2 * i], b = src[2 * i + 1]; u32x4 o; o.x = pk2(a.x, a.y); o.y = pk2(a.z, a.w); o.z = pk2(b.x, b.y); o.w = pk2(b.z, b.w); dst[i] = o; } }
    { float* wrt = (float*)(ws + MS_WRT);
      for (int i = F.blk * NTHR + tid; i < DEPTH * 36 * D; i += F.G * NTHR) { const int k = i % D, n = (i / D) % 36, l = i / (36 * D);
          const float w = n < 4 ? F.in[12][((size_t)l * D + k) * 4 + n] : F.in[14][((size_t)l * D + k) * NE + (n - 4)]; wrt[i] = w * F.in[11][l * D + k]; } }
    { bf16* wb = (bf16*)(ws + MS_SGUW); for (int i = F.blk * NTHR + tid; i < DEPTH * 4 * 128 * 128; i += F.G * NTHR) { const int tc = (i >> 7) & 127, sp = i & 127; wb[i] = sp <= tc ? (bf16)f2bf(F.in[8][i]) : (bf16)0; } }
    if (F.blk == 0 && tid < DREC) { const int c = tid; float v[DEPTH], m = -1e30f;
#pragma unroll
        for (int l = 0; l < DEPTH; ++l) { v[l] = F.in[4][l * DREC + c]; m = fmaxf(m, v[l]); }
        float s = 0.f;
#pragma unroll
        for (int l = 0; l < DEPTH; ++l) { v[l] = fexp(v[l] - m); s += v[l]; }
        float* lb = (float*)(ws + MS_LB); float acc = 0.f;
#pragma unroll
        for (int l = 0; l < DEPTH; ++l) { if (l > 0) acc += v[l] / s; lb[l * DREC + c] = acc; } }
}

__device__ __forceinline__ void load_row(const float* row, int lane, f32x4 (&v)[4]) { const f32x4* r = (const f32x4*)row + lane;
#pragma unroll
    for (int j = 0; j < 4; ++j) v[j] = r[64 * j]; }
__device__ __forceinline__ void load_row_bf(const bf16* row, int lane, f32x4 (&v)[4]) { const u32x2* r = (const u32x2*)row + lane;
#pragma unroll
    for (int j = 0; j < 4; ++j) { const u32x2 x = r[64 * j]; v[j] = (f32x4){bflo(x.x), bfhi(x.x), bflo(x.y), bfhi(x.y)}; } }
__device__ __forceinline__ float row_sumsq(const f32x4 (&v)[4]) { float s = 0.f;
#pragma unroll
    for (int j = 0; j < 4; ++j) s += (v[j].x * v[j].x + v[j].y * v[j].y) + (v[j].z * v[j].z + v[j].w * v[j].w);
    return wave_sum(s); }
__device__ __forceinline__ void store_row_bf16(bf16* orow, int lane, const f32x4 (&v)[4], float s) { u32x2* o = (u32x2*)orow + lane;
#pragma unroll
    for (int j = 0; j < 4; ++j) { u32x2 w; w.x = pk2(v[j].x * s, v[j].y * s); w.y = pk2(v[j].z * s, v[j].w * s); o[64 * j] = w; } }

__device__ __forceinline__ void phase_norm1(const Frame& F, int l) {
    PH_TID();
    bf16* XN = (bf16*)(F.ws + WS_XN); bf16* h = (bf16*)(F.ws + WS_H); const float* x = F.in[0];
    const int gw = F.blk * NWAVES + ph_wave, NGW = F.G * NWAVES;
    for (int t = gw; t < T; t += NGW) { f32x4 v[4];
        if (l == 0) { load_row(x + (size_t)t * D, lane, v); store_row_bf16(h + (size_t)t * D, lane, v, 1.f); } else load_row_bf(h + (size_t)t * D, lane, v);
        const float rstd = frsq(row_sumsq(v) * (1.f / D) + EPS); store_row_bf16(XN + (size_t)t * D, lane, v, rstd); }
}
__device__ __forceinline__ float bfly8(const float (&r)[8], int lane) {
    const bool b2 = lane & 4, b1 = lane & 2, b0 = lane & 1; float a[4], c[2];
#pragma unroll
    for (int i = 0; i < 4; ++i) { const float keep = b2 ? r[i + 4] : r[i], send = b2 ? r[i] : r[i + 4]; a[i] = keep + shx<4>(send); }
#pragma unroll
    for (int i = 0; i < 2; ++i) { const float keep = b1 ? a[i + 2] : a[i], send = b1 ? a[i] : a[i + 2]; c[i] = keep + shx<2>(send); }
    const float keep = b0 ? c[1] : c[0], send = b0 ? c[0] : c[1]; float d = keep + shx<1>(send);
    d += shx<8>(d); d += shx<16>(d);
    return d + __int_as_float(__builtin_amdgcn_ds_bpermute((lane ^ 32) << 2, __float_as_int(d)));
}
__device__ __forceinline__ void phase_norm2(const Frame& F, int l) {
    PH_TID();
    unsigned char* ws = F.ws;
    unsigned* hist = (unsigned*)(F.lds + MISC_OFF + 256);
    if (tid < 32) hist[tid] = 0u;
    __syncthreads();
    const bf16* h = (const bf16*)(ws + WS_H); bf16* XN = (bf16*)(ws + WS_XN);
    const float* WrT = (const float*)(ws + MS_WRT) + (size_t)l * 36 * D;
    const float* b_rg = F.in[13] + l * 4; const float* b_re = F.in[15] + l * NE;
    int* tok_e = (int*)(ws + MS_TOKE); float* tok_w = (float*)(ws + MS_TOKW); unsigned* sinfo = (unsigned*)(ws + MS_SINFO);
    const int RPB = T / F.G, RPW = RPB / NWAVES;
    for (int i0 = 0; i0 < RPW; i0 += 8) {
        const int t0 = F.blk * RPB + ph_wave * RPW + i0;
        f32x4 v[8][4]; float ss[8];
#pragma unroll
        for (int r = 0; r < 8; ++r) { load_row_bf(h + (size_t)(t0 + r) * D, lane, v[r]); float q = 0.f;
#pragma unroll
            for (int j = 0; j < 4; ++j) q += (v[r][j].x * v[r][j].x + v[r][j].y * v[r][j].y) + (v[r][j].z * v[r][j].z + v[r][j].w * v[r][j].w);
            ss[r] = q; }
        const float rstd_mine = frsq(bfly8(ss, lane) * (1.f / D) + EPS);
#pragma unroll
        for (int r = 0; r < 8; ++r) { const float rs = __int_as_float(__builtin_amdgcn_readlane(__float_as_int(rstd_mine), r)); store_row_bf16(XN + (size_t)(t0 + r) * D, lane, v[r], rs); }
        LAS float* lgw = (LAS float*)(F.lds + 4096) + ph_wave * (36 * 8);
#pragma unroll 2
        for (int n = 0; n < 36; ++n) { const f32x4* wr = (const f32x4*)(WrT + (size_t)n * D) + lane; const f32x4 w0 = wr[0], w1 = wr[64], w2 = wr[128], w3 = wr[192]; float pr[8];
#pragma unroll
            for (int r = 0; r < 8; ++r) pr[r] = ((v[r][0].x * w0.x + v[r][0].y * w0.y) + (v[r][0].z * w0.z + v[r][0].w * w0.w)) + ((v[r][1].x * w1.x + v[r][1].y * w1.y) + (v[r][1].z * w1.z + v[r][1].w * w1.w))
                                                 + ((v[r][2].x * w2.x + v[r][2].y * w2.y) + (v[r][2].z * w2.z + v[r][2].w * w2.w)) + ((v[r][3].x * w3.x + v[r][3].y * w3.y) + (v[r][3].z * w3.z + v[r][3].w * w3.w));
            const float val = bfly8(pr, lane) * rstd_mine; if (lane < 8) lgw[n * 8 + lane] = val; }
        const int row = lane & 7;
        float lg4[4], lgb[4];
#pragma unroll
        for (int j = 0; j < 4; ++j) { lg4[j] = lgw[j * 8 + row]; lgb[j] = lg4[j] + b_rg[j]; }
        int gs = 0; float gm = lgb[0];
#pragma unroll
        for (int j = 1; j < 4; ++j) if (lgb[j] > gm) { gm = lgb[j]; gs = j; }
        float mx = fmaxf(fmaxf(lg4[0], lg4[1]), fmaxf(lg4[2], lg4[3])), se = 0.f, lsel = lg4[0];
#pragma unroll
        for (int j = 0; j < 4; ++j) { se += fexp(lg4[j] - mx); if (j == gs) lsel = lg4[j]; }
        const float g_w = fexp(lsel - mx) * frcp(se);
        float le[8], leb[8];
#pragma unroll
        for (int j = 0; j < 8; ++j) { le[j] = lgw[(4 + gs * 8 + j) * 8 + row]; leb[j] = le[j] + b_re[gs * 8 + j]; }
        int s0 = 0; float m0 = leb[0];
#pragma unroll
        for (int j = 1; j < 8; ++j) if (leb[j] > m0) { m0 = leb[j]; s0 = j; }
        int s1 = -1; float m1 = -3.0e38f;
#pragma unroll
        for (int j = 0; j < 8; ++j) if (j != s0 && leb[j] > m1) { m1 = leb[j]; s1 = j; }
        if (s1 < 0) s1 = (s0 == 0) ? 1 : 0;
        float la = le[0], lb2 = le[0];
#pragma unroll
        for (int j = 1; j < 8; ++j) { if (j == s0) la = le[j]; if (j == s1) lb2 = le[j]; }
        const float wa = frcp(1.f + fexp(lb2 - la)), wb = 1.f - wa;
        if (lane < 8) { const int t = t0 + lane;
            const int e0 = gs * 8 + s0, e1 = gs * 8 + s1;
            const unsigned r0 = atomicAdd(&hist[e0], 1u), r1 = atomicAdd(&hist[e1], 1u);
            tok_e[2 * t] = e0; tok_e[2 * t + 1] = e1; tok_w[2 * t] = g_w * wa; tok_w[2 * t + 1] = g_w * wb;
            sinfo[2 * t] = ((unsigned)F.blk << 16) | r0; sinfo[2 * t + 1] = ((unsigned)F.blk << 16) | r1;
        }
    }
    __syncthreads();
    if (tid < 32) { unsigned* cnt = (unsigned*)(ws + WS_CTL) + CW_CNT + l * 32;
        const unsigned base = __hip_atomic_fetch_add(cnt + tid, hist[tid], __ATOMIC_RELAXED, __HIP_MEMORY_SCOPE_AGENT);
        ((unsigned*)(ws + MS_BLKBASE))[F.blk * 32 + tid] = base; }
}
__device__ __forceinline__ void phase_gather(const Frame& F, int l) {
    PH_TID();
    unsigned char* ws = F.ws;
    int* ps = (int*)(F.lds + MISC_OFF + 512);
    if (tid == 0) { unsigned* cnt = (unsigned*)(ws + WS_CTL) + CW_CNT + l * 32; int* blke = (int*)(ws + MS_BLKE) + l * 256; int acc = 0;
        for (int e = 0; e < NE; ++e) { const int c = (int)__hip_atomic_load(cnt + e, __ATOMIC_RELAXED, __HIP_MEMORY_SCOPE_AGENT); ps[e] = acc; const int pad = (c + RB - 1) / RB * RB;
            if (F.blk == 0) for (int rb = acc / RB; rb < (acc + pad) / RB; ++rb) blke[rb] = e;
            acc += pad; }
        if (F.blk == 0) blke[255] = acc / RB; }
    __syncthreads();
    const int* tok_e = (const int*)(ws + MS_TOKE); const unsigned* sinfo = (const unsigned*)(ws + MS_SINFO); const unsigned* bbase = (const unsigned*)(ws + MS_BLKBASE);
    int* sdest = (int*)(ws + MS_SDEST); const bf16* XN = (const bf16*)(ws + WS_XN); bf16* XB = (bf16*)(ws + WS_XB);
    const int gw = F.blk * NWAVES + ph_wave, NGW = F.G * NWAVES;
    for (int t = gw; t < T; t += NGW) {
        const u32x4* src = (const u32x4*)(XN + (size_t)t * D) + lane; const u32x4 a = src[0], b = src[64];
#pragma unroll
        for (int j = 0; j < 2; ++j) { const int e = tok_e[2 * t + j]; const unsigned info = sinfo[2 * t + j];
            const int dest = ps[e] + (int)bbase[(info >> 16) * 32 + e] + (int)(info & 0xffffu);
            if (lane == 0) sdest[2 * t + j] = dest;
            u32x4* dst = (u32x4*)(XB + (size_t)dest * D) + lane; dst[0] = a; dst[64] = b; }
    }
}
__device__ __forceinline__ void phase_combine(const Frame& F, int l) {
    PH_TID();
    unsigned char* ws = F.ws;
    bf16* h = (bf16*)(ws + WS_H); bf16* XN = (bf16*)(ws + WS_XN); const bf16* Y = (const bf16*)(ws + WS_Y); const bf16* PE = (const bf16*)(ws + WS_PE) + (size_t)l * T * D;
    const int* sdest = (const int*)(ws + MS_SDEST); const float* tok_w = (const float*)(ws + MS_TOKW); float* rstd_pe = (float*)(ws + MS_RSTDPE);
    const int gw = F.blk * NWAVES + ph_wave, NGW = F.G * NWAVES;
    for (int t = gw; t < T; t += NGW) {
        const int d0 = sdest[2 * t], d1 = sdest[2 * t + 1]; const float w0 = tok_w[2 * t], w1 = tok_w[2 * t + 1];
        f32x4 v[4]; load_row_bf(h + (size_t)t * D, lane, v);
        const u32x2* y0 = (const u32x2*)(Y + (size_t)d0 * D) + lane; const u32x2* y1 = (const u32x2*)(Y + (size_t)d1 * D) + lane; const u32x2* pe = (const u32x2*)(PE + (size_t)t * D) + lane;
        float sp = 0.f;
#pragma unroll
        for (int j = 0; j < 4; ++j) { const u32x2 a = y0[64 * j], b = y1[64 * j], c = pe[64 * j];
            v[j].x += w0 * bflo(a.x) + w1 * bflo(b.x); v[j].y += w0 * bfhi(a.x) + w1 * bfhi(b.x); v[j].z += w0 * bflo(a.y) + w1 * bflo(b.y); v[j].w += w0 * bfhi(a.y) + w1 * bfhi(b.y);
            const float p0 = bflo(c.x), p1 = bfhi(c.x), p2 = bflo(c.y), p3 = bfhi(c.y); sp += (p0 * p0 + p1 * p1) + (p2 * p2 + p3 * p3); }
        store_row_bf16(h + (size_t)t * D, lane, v, 1.f);
        const float rstd = frsq(row_sumsq(v) * (1.f / D) + EPS); store_row_bf16(XN + (size_t)t * D, lane, v, rstd);
        sp = wave_sum(sp); if (lane == 0) rstd_pe[t] = frsq(sp * (1.f / D) + EPS);
    }
}
__device__ __forceinline__ void phase_final(const Frame& F) {
    PH_TID();
    const bf16* h = (const bf16*)(F.ws + WS_H); const float* nf = F.in[23];
    const int gw = F.blk * NWAVES + ph_wave, NGW = F.G * NWAVES;
    for (int t = gw; t < T; t += NGW) { f32x4 v[4]; load_row_bf(h + (size_t)t * D, lane, v); const float rstd = frsq(row_sumsq(v) * (1.f / D) + EPS);
        f32x4* o = (f32x4*)(F.out + (size_t)t * D) + lane; const f32x4* g = (const f32x4*)nf + lane;
#pragma unroll
        for (int j = 0; j < 4; ++j) o[64 * j] = v[j] * rstd * g[64 * j]; }
}


namespace pg8 {
constexpr int BM = 256, BK = 64, HALF = 128, HTB = HALF * BK * 2, STAGE_BYTES = 8 * HTB, NXCD = 8, WGM = 8;
__host__ __device__ __forceinline__ int lds_byte(int r, int c) { const int st = (r >> 4) * 2 + (c >> 5), rr = r & 15, cc = c & 31, ob = rr * 64 + cc * 2; return st * 1024 + (ob ^ (((ob >> 9) & 1) << 5)); }
__host__ __device__ __forceinline__ void stage_rc(int b, int& R, int& C) { const int st = b / 1024, sb = b % 1024, swz = sb ^ (((sb >> 9) & 1) << 5); R = (st >> 1) * 16 + swz / 64; C = (st & 1) * 32 + (swz % 64) / 2; }
__host__ __device__ __forceinline__ int perm32(int rho) { const int n = rho >> 4, i = rho & 15; return 8 * (i >> 2) + 4 * n + (i & 3); }
struct Unit { int pm, pn; const char* A; const char* B; };
__device__ __forceinline__ void static_map(int wgid, int nM, int nN, int& pm, int& pn) {
    const int nwg = nM * nN; { const int q = nwg / NXCD, r = nwg % NXCD, xcd = wgid % NXCD, off = wgid / NXCD; wgid = (xcd < r ? xcd * (q + 1) : r * (q + 1) + (xcd - r) * q) + off; }
    const int nig = WGM * nN, gid = wgid / nig, fm = gid * WGM, gsz = (nM - fm) < WGM ? (nM - fm) : WGM;
    pm = fm + ((wgid % nig) % gsz); pn = (wgid % nig) / gsz;
}
struct DenseOrder { static constexpr bool DEPS = false;
    const char* A; const char* Bt; int nM, nN, nL, G, c; size_t tstep;
    __device__ void init(const void* A_, const void* Bt_, int M, int N, int K, int nL_, int G_, int c_) { A = (const char*)A_; Bt = (const char*)Bt_; nM = M / BM; nN = N / BM; nL = nL_; G = G_; c = c_; tstep = (size_t)BM * K * 2; }
    __device__ bool next(int i, Unit& u) const { const long L = (long)i * G + c; const int per = nM * nN; if (L >= (long)per * nL) return false;
        const int l = (int)(L / per); int pm, pn; static_map((int)(L % per), nM, nN, pm, pn); u.pm = l * nM + pm; u.pn = pn; u.A = A + (size_t)u.pm * tstep; u.B = Bt + (size_t)(l * nN + pn) * tstep; return true; }
};
struct MoeOrder { static constexpr bool DEPS = false;
    const char* A; const char* W; const int* blke; int nrb, nN, G, c, e0, e1, e2; size_t a_tstep, w_estride, b_tstep;
    __device__ void init(const void* A_, const void* W_, const int* blke_, int K, int nN_, size_t w_estride_bytes, int G_, int c_) { A = (const char*)A_; W = (const char*)W_; blke = blke_; nrb = __builtin_amdgcn_readfirstlane(blke_[255]); nN = nN_; G = G_; c = c_;
        a_tstep = (size_t)BM * K * 2; b_tstep = a_tstep; w_estride = w_estride_bytes;
        const int r0 = c / nN, r1 = (G + c) / nN, r2 = (2 * G + c) / nN; const int x0 = blke_[r0 < 255 ? r0 : 254], x1 = blke_[r1 < 255 ? r1 : 254], x2 = blke_[r2 < 255 ? r2 : 254];
        e0 = __builtin_amdgcn_readfirstlane(x0); e1 = __builtin_amdgcn_readfirstlane(x1); e2 = __builtin_amdgcn_readfirstlane(x2); }
    __device__ bool next(int i, Unit& u) const { const long L = (long)i * G + c; if (L >= (long)nrb * nN) return false; const int rb = (int)(L / nN), pn = (int)(L % nN);
        const int ex = i == 0 ? e0 : i == 1 ? e1 : i == 2 ? e2 : __builtin_amdgcn_readfirstlane(blke[rb]);
        u.pm = rb; u.pn = pn; u.A = A + (size_t)rb * a_tstep; u.B = W + (size_t)ex * w_estride + (size_t)pn * b_tstep; return true; }
};
__device__ __forceinline__ unsigned ag_ld(const unsigned* p)        { return __hip_atomic_load(p, __ATOMIC_RELAXED, __HIP_MEMORY_SCOPE_AGENT); }
__device__ __forceinline__ unsigned ag_add(unsigned* p, unsigned v) { return __hip_atomic_fetch_add(p, v, __ATOMIC_RELAXED, __HIP_MEMORY_SCOPE_AGENT); }
struct MoeDepOrder { static constexpr bool DEPS = true;
    const char* A; const char* W; const int* blke; const unsigned* done; int nrb, nN, G, c, e0, e1, e2; size_t a_tstep, w_estride, b_tstep;
    __device__ void init(const void* A_, const void* W_, const int* blke_, const unsigned* done_, int K, int nN_, size_t w_estride_bytes, int G_, int c_) { A = (const char*)A_; W = (const char*)W_; blke = blke_; done = done_;
        nrb = __builtin_amdgcn_readfirstlane(blke_[255]); nN = nN_; G = G_; c = c_; a_tstep = (size_t)BM * K * 2; b_tstep = a_tstep; w_estride = w_estride_bytes;
        const int r0 = c / nN, r1 = (G + c) / nN, r2 = (2 * G + c) / nN; const int x0 = blke_[r0 < 255 ? r0 : 254], x1 = blke_[r1 < 255 ? r1 : 254], x2 = blke_[r2 < 255 ? r2 : 254];
        e0 = __builtin_amdgcn_readfirstlane(x0); e1 = __builtin_amdgcn_readfirstlane(x1); e2 = __builtin_amdgcn_readfirstlane(x2); }
    __device__ bool next(int i, Unit& u) const { const long L = (long)i * G + c; if (L >= (long)nrb * nN) return false; const int rb = (int)(L / nN), pn = (int)(L % nN);
        const int ex = i == 0 ? e0 : i == 1 ? e1 : i == 2 ? e2 : __builtin_amdgcn_readfirstlane(blke[rb]);
        u.pm = rb; u.pn = pn; u.A = A + (size_t)rb * a_tstep; u.B = W + (size_t)ex * w_estride + (size_t)pn * b_tstep; return true; }
    __device__ void wait(const Unit& u, int wid) const {
        if (wid == 0 && lane_now() == 0) { while (ag_ld(done + u.pm) < 4u) __builtin_amdgcn_s_sleep(1); __builtin_amdgcn_fence(__ATOMIC_ACQUIRE, "agent"); } }
};
struct RangeOrder { static constexpr bool DEPS = false;
    const char* A; const char* Bt; int nM, nN, j0, n; size_t tstep;
    __device__ void init(const void* A_, const void* Bt_, int M, int N, int K, int j0_, int n_) { A = (const char*)A_; Bt = (const char*)Bt_; nM = M / BM; nN = N / BM; j0 = j0_; n = n_; tstep = (size_t)BM * K * 2; }
    __device__ bool next(int i, Unit& u) const { if (i >= n) return false; int pm, pn; static_map(j0 + i, nM, nN, pm, pn); u.pm = pm; u.pn = pn; u.A = A + (size_t)pm * tstep; u.B = Bt + (size_t)pn * tstep; return true; }
};
__device__ __forceinline__ unsigned cvt_pk_bf16(float lo, float hi) { return pk2(lo, hi); }
struct EpiBf16 { static constexpr bool PERM = true, ACC_INIT = false, SIGNAL = false; bf16* O; int ldc;
    __device__ __forceinline__ void operator()(const f32x4 (&acc)[2][2][4][2], const Unit& u, int wr, int wc, int, int) const {
        const int t2 = lane_now(), fr = t2 & 15, fq = t2 >> 4;
        const int row0 = u.pm * BM + wr * 64 + fr, col0 = u.pn * BM + wc * 32 + 8 * fq;
#pragma unroll
        for (int ai = 0; ai < 2; ++ai)
#pragma unroll
            for (int m = 0; m < 4; ++m) { bf16* rowp = O + (size_t)(row0 + ai * HALF + m * 16) * ldc + col0;
#pragma unroll
                for (int bj = 0; bj < 2; ++bj) { const f32x4 v0 = acc[ai][bj][m][0], v1 = acc[ai][bj][m][1];
                    u32x4 w; w.x = cvt_pk_bf16(v0[0], v0[1]); w.y = cvt_pk_bf16(v0[2], v0[3]); w.z = cvt_pk_bf16(v1[0], v1[1]); w.w = cvt_pk_bf16(v1[2], v1[3]);
                    *(u32x4*)(rowp + bj * HALF) = w; } }
    } };
struct EpiResid { static constexpr bool PERM = true, ACC_INIT = true, SIGNAL = false; bf16* h;
    __device__ __forceinline__ void init(f32x4 (&acc)[2][2][4][2], const Unit& u, int wr, int wc, int fr, int fq) const {
        const int row0 = u.pm * BM + wr * 64 + fr, col0 = u.pn * BM + wc * 32 + 8 * fq;
#pragma unroll
        for (int ai = 0; ai < 2; ++ai)
#pragma unroll
            for (int m = 0; m < 4; ++m) { const bf16* rowp = h + (size_t)(row0 + ai * HALF + m * 16) * D + col0;
#pragma unroll
                for (int bj = 0; bj < 2; ++bj) { const u32x4 x = *(const u32x4*)(rowp + bj * HALF);
                    acc[ai][bj][m][0] = (f32x4){bflo(x.x), bfhi(x.x), bflo(x.y), bfhi(x.y)}; acc[ai][bj][m][1] = (f32x4){bflo(x.z), bfhi(x.z), bflo(x.w), bfhi(x.w)}; } }
    }
    __device__ __forceinline__ void operator()(const f32x4 (&acc)[2][2][4][2], const Unit& u, int wr, int wc, int fr, int fq) const {
        asm volatile("" : "+v"(fr), "+v"(fq));
        const int row0 = u.pm * BM + wr * 64 + fr, col0 = u.pn * BM + wc * 32 + 8 * fq;
#pragma unroll
        for (int ai = 0; ai < 2; ++ai)
#pragma unroll
            for (int m = 0; m < 4; ++m) { bf16* rowp = h + (size_t)(row0 + ai * HALF + m * 16) * D + col0;
#pragma unroll
                for (int bj = 0; bj < 2; ++bj) { const f32x4 v0 = acc[ai][bj][m][0], v1 = acc[ai][bj][m][1];
                    u32x4 w; w.x = cvt_pk_bf16(v0[0], v0[1]); w.y = cvt_pk_bf16(v0[2], v0[3]); w.z = cvt_pk_bf16(v1[0], v1[1]); w.w = cvt_pk_bf16(v1[2], v1[3]);
                    *(u32x4*)(rowp + bj * HALF) = w; } }
    } };
struct EpiGateUp { static constexpr bool PERM = true, ACC_INIT = false, SIGNAL = false; bf16* H;
    __device__ __forceinline__ void operator()(const f32x4 (&acc)[2][2][4][2], const Unit& u, int wr, int wc, int, int) const {
        const int t2 = lane_now(), fr = t2 & 15, fq = t2 >> 4;
        const int row0 = u.pm * BM + wr * 64 + fr, col0 = u.pn * HALF + wc * 32 + 8 * fq;
#pragma unroll
        for (int ai = 0; ai < 2; ++ai)
#pragma unroll
            for (int m = 0; m < 4; ++m) { bf16* rowp = H + (size_t)(row0 + ai * HALF + m * 16) * DE + col0; float v[8];
#pragma unroll
                for (int n = 0; n < 2; ++n)
#pragma unroll
                    for (int j = 0; j < 4; ++j) v[4 * n + j] = silu_(acc[ai][0][m][n][j]) * acc[ai][1][m][n][j];
                u32x4 w; w.x = cvt_pk_bf16(v[0], v[1]); w.y = cvt_pk_bf16(v[2], v[3]); w.z = cvt_pk_bf16(v[4], v[5]); w.w = cvt_pk_bf16(v[6], v[7]);
                *(u32x4*)rowp = w; }
    } };
struct EpiGateUpPub { static constexpr bool PERM = true, ACC_INIT = false, SIGNAL = true; __amdgpu_buffer_rsrc_t rs; unsigned* done;
    __device__ __forceinline__ void operator()(const f32x4 (&acc)[2][2][4][2], const Unit& u, int wr, int wc, int fr, int fq) const {
        asm volatile("" : "+v"(fr), "+v"(fq));
        const int row0 = u.pm * BM + wr * 64 + fr, col0 = u.pn * HALF + wc * 32 + 8 * fq;
#pragma unroll
        for (int ai = 0; ai < 2; ++ai)
#pragma unroll
            for (int m = 0; m < 4; ++m) { const unsigned off = (unsigned)(((row0 + ai * HALF + m * 16) * DE + col0) * 2); float v[8];
#pragma unroll
                for (int n = 0; n < 2; ++n)
#pragma unroll
                    for (int j = 0; j < 4; ++j) v[4 * n + j] = silu_(acc[ai][0][m][n][j]) * acc[ai][1][m][n][j];
                u32x4 w; w.x = cvt_pk_bf16(v[0], v[1]); w.y = cvt_pk_bf16(v[2], v[3]); w.z = cvt_pk_bf16(v[4], v[5]); w.w = cvt_pk_bf16(v[6], v[7]);
                __builtin_amdgcn_raw_buffer_store_b128(w, rs, off, 0, 16); }
    }
    __device__ __forceinline__ void signal(const Unit& u) const { (void)ag_add(done + u.pm, 1u); }
};
struct EpiPG { static constexpr bool PERM = true, ACC_INIT = false, SIGNAL = false; bf16* h; const bf16* PE; const float* rstd_pe; const float* norm_pe;
    __device__ __forceinline__ void operator()(const f32x4 (&acc)[2][2][4][2], const Unit& u, int wr, int wc, int fr, int fq) const {
        asm volatile("" : "+v"(fr), "+v"(fq));
        const int row0 = u.pm * BM + wr * 64 + fr, col0 = u.pn * BM + wc * 32 + 8 * fq;
        f32x4 nv[2][2];
#pragma unroll
        for (int bj = 0; bj < 2; ++bj)
#pragma unroll
            for (int n = 0; n < 2; ++n) nv[bj][n] = *(const f32x4*)(norm_pe + col0 + bj * HALF + 4 * n);
#pragma unroll
        for (int ai = 0; ai < 2; ++ai)
#pragma unroll
            for (int m = 0; m < 4; ++m) { const int row = row0 + ai * HALF + m * 16; const float rs = rstd_pe[row];
#pragma unroll
                for (int bj = 0; bj < 2; ++bj) { const size_t o = (size_t)row * D + col0 + bj * HALF; const u32x4 pe = *(const u32x4*)(PE + o); const u32x4 hx = *(const u32x4*)(h + o);
                    f32x4 h0 = (f32x4){bflo(hx.x), bfhi(hx.x), bflo(hx.y), bfhi(hx.y)}, h1 = (f32x4){bflo(hx.z), bfhi(hx.z), bflo(hx.w), bfhi(hx.w)}; const f32x4 a0 = acc[ai][bj][m][0], a1 = acc[ai][bj][m][1];
                    const f32x4 e0 = (f32x4){bflo(pe.x), bfhi(pe.x), bflo(pe.y), bfhi(pe.y)} * rs * nv[bj][0], e1 = (f32x4){bflo(pe.z), bfhi(pe.z), bflo(pe.w), bfhi(pe.w)} * rs * nv[bj][1];
                    h0 += (f32x4){sigmoid_(a0[0]), sigmoid_(a0[1]), sigmoid_(a0[2]), sigmoid_(a0[3])} * e0; h1 += (f32x4){sigmoid_(a1[0]), sigmoid_(a1[1]), sigmoid_(a1[2]), sigmoid_(a1[3])} * e1;
                    u32x4 w; w.x = pk2(h0[0], h0[1]); w.y = pk2(h0[2], h0[3]); w.z = pk2(h1[0], h1[1]); w.w = pk2(h1[2], h1[3]); *(u32x4*)(h + o) = w; } }
    } };

template <class Epi, class Sched>
__device__ __forceinline__ void gemm_phase(int wave, LAS unsigned char* lds, int K, const Sched& S, const Epi& E) {
    int wid = wave; asm volatile("" : "+s"(wid));
    const int lane = lane_now(), tid = (wid << 6) | lane, wr = wid >> 2, wc = wid & 3, fr = lane & 15, fq = lane >> 4;
    const int nt = K / BK;
    unsigned voffA[2], voffB[2];
#pragma unroll
    for (int i = 0; i < 2; ++i) { int R, C; stage_rc(tid * 16 + i * 8192, R, C); const int Rb = Epi::PERM ? ((R & ~31) + perm32(R & 31)) : R;
        voffA[i] = (unsigned)(R * K + C) * 2u; voffB[i] = (unsigned)(Rb * K + C) * 2u; }
    const size_t kstep = (size_t)(BK * 2);
    const size_t hstep = (size_t)HALF * K * 2;
    const unsigned ldsw = (unsigned)wid * 1024u;
    const int aoff = lds_byte(wr * 64 + fr, fq * 8), boff = lds_byte(wc * 32 + fr, fq * 8);
#define PG8_SA(b, h) (((b) * 2 + (h)) * HTB)
#define PG8_SB(b, h) ((4 + (b) * 2 + (h)) * HTB)
#define PG8_STAGE(bufoff, gbase, voff) do { _Pragma("unroll") for (int _i = 0; _i < 2; ++_i) \
        __builtin_amdgcn_global_load_lds((const unsigned*)((const char*)(gbase) + (voff)[_i]), (LAS unsigned*)(lds + (bufoff) + ldsw + _i * 8192), 16, 0, 0); } while (0)
#define PG8_LDA(dst, b, h) do { _Pragma("unroll") for (int m = 0; m < 4; ++m) _Pragma("unroll") for (int k = 0; k < 2; ++k) dst[m][k] = *(const LAS bf16x8*)(lds + PG8_SA(b, h) + aoff + m * 2048 + k * 1024); } while (0)
#define PG8_LDB(dst, b, h) do { _Pragma("unroll") for (int n = 0; n < 2; ++n) _Pragma("unroll") for (int k = 0; k < 2; ++k) dst[n][k] = *(const LAS bf16x8*)(lds + PG8_SB(b, h) + boff + n * 2048 + k * 1024); } while (0)
#define PG8_MMA(ai, bj, At, Bt) do { __builtin_amdgcn_s_setprio(1); _Pragma("unroll") for (int m = 0; m < 4; ++m) _Pragma("unroll") for (int n = 0; n < 2; ++n) _Pragma("unroll") for (int k = 0; k < 2; ++k) \
        acc[ai][bj][m][n] = __builtin_amdgcn_mfma_f32_16x16x32_bf16(Bt[n][k], At[m][k], acc[ai][bj][m][n], 0, 0, 0); __builtin_amdgcn_s_setprio(0); } while (0)
#define PG8_WAIT_V(n) asm volatile("s_waitcnt vmcnt(" #n ")" ::: "memory")
#define PG8_WAIT_L(n) asm volatile("s_waitcnt lgkmcnt(" #n ")" ::: "memory")
#define PG8_BAR __builtin_amdgcn_s_barrier()
#define PG8_SCHED __builtin_amdgcn_sched_barrier(0)
    Unit cur, nxt; int ui = 0;
    if (!S.next(0, cur)) return;
    if constexpr (Sched::DEPS) { S.wait(cur, wid); PG8_BAR; }
    f32x4 acc[2][2][4][2];
    if constexpr (Epi::ACC_INIT) E.init(acc, cur, wr, wc, fr, fq);
    else {
#pragma unroll
    for (int a = 0; a < 2; ++a)
#pragma unroll
        for (int b = 0; b < 2; ++b)
#pragma unroll
            for (int m = 0; m < 4; ++m)
#pragma unroll
                for (int n = 0; n < 2; ++n) acc[a][b][m][n] = (f32x4){0.f, 0.f, 0.f, 0.f}; }
    bf16x8 At[4][2], B0[2][2], B1[2][2];
    const char* cA = cur.A; const char* cB = cur.B;
    PG8_STAGE(PG8_SB(0, 0), cB, voffB); PG8_STAGE(PG8_SB(0, 1), cB + hstep, voffB); PG8_STAGE(PG8_SA(0, 0), cA, voffA); PG8_STAGE(PG8_SA(0, 1), cA + hstep, voffA);
    if (wr == 1) PG8_BAR;
    PG8_WAIT_V(2); PG8_BAR;
    PG8_STAGE(PG8_SB(1, 0), cB + kstep, voffB); PG8_STAGE(PG8_SA(1, 0), cA + kstep, voffA); PG8_STAGE(PG8_SB(1, 1), cB + hstep + kstep, voffB);
    PG8_WAIT_V(6); PG8_BAR;
    for (;;) {
        const bool has_next = S.next(ui + 1, nxt);
        const char* nA = has_next ? nxt.A : cA; const char* nB = has_next ? nxt.B : cB;
#pragma nounroll
        for (int t = 0; t < nt; t += 2) {
            const bool last = (t == nt - 2);
            if constexpr (Sched::DEPS) { if (last && has_next) S.wait(nxt, wid); }
            const char* a1 = cA + (size_t)(t + 1) * kstep;
            const char* a2 = last ? nA : cA + (size_t)(t + 2) * kstep; const char* b2 = last ? nB : cB + (size_t)(t + 2) * kstep;
            const char* a3 = a2 + kstep; const char* b3 = b2 + kstep;
            PG8_LDB(B0, 0, 0); PG8_LDB(B1, 0, 1); PG8_SCHED; PG8_LDA(At, 0, 0); PG8_STAGE(PG8_SA(1, 1), a1 + hstep, voffA);
            PG8_WAIT_V(8); PG8_WAIT_L(0); PG8_BAR; PG8_MMA(0, 0, At, B0); PG8_MMA(0, 1, At, B1); PG8_BAR; PG8_SCHED;
            PG8_LDA(At, 0, 1); PG8_STAGE(PG8_SB(0, 0), b2, voffB); PG8_STAGE(PG8_SB(0, 1), b2 + hstep, voffB); PG8_STAGE(PG8_SA(0, 0), a2, voffA);
            PG8_WAIT_V(8); PG8_WAIT_L(0); PG8_BAR; PG8_MMA(1, 0, At, B0); PG8_MMA(1, 1, At, B1); PG8_BAR; PG8_SCHED;
            PG8_LDB(B0, 1, 0); PG8_LDB(B1, 1, 1); PG8_SCHED; PG8_LDA(At, 1, 0); PG8_STAGE(PG8_SA(0, 1), a2 + hstep, voffA);
            PG8_WAIT_V(8); PG8_WAIT_L(0); PG8_BAR; PG8_MMA(0, 0, At, B0); PG8_MMA(0, 1, At, B1); PG8_BAR; PG8_SCHED;
            PG8_LDA(At, 1, 1); PG8_STAGE(PG8_SB(1, 0), b3, voffB); PG8_STAGE(PG8_SB(1, 1), b3 + hstep, voffB); PG8_STAGE(PG8_SA(1, 0), a3, voffA);
            PG8_WAIT_V(8); PG8_WAIT_L(0); PG8_BAR; PG8_MMA(1, 0, At, B0); PG8_MMA(1, 1, At, B1); PG8_BAR; PG8_SCHED;
        }
        if (wr == 0) PG8_BAR;
        E(acc, cur, wr, wc, fr, fq);
        if constexpr (Epi::SIGNAL) { PG8_WAIT_V(0); PG8_BAR; if (tid == 0) E.signal(cur); }
        if (!has_next) break;
        if constexpr (Epi::ACC_INIT) E.init(acc, nxt, wr, wc, fr, fq);
        else {
#pragma unroll
        for (int a = 0; a < 2; ++a)
#pragma unroll
            for (int b = 0; b < 2; ++b)
#pragma unroll
                for (int m = 0; m < 4; ++m)
#pragma unroll
                    for (int n = 0; n < 2; ++n) acc[a][b][m][n] = (f32x4){0.f, 0.f, 0.f, 0.f}; }
        cur = nxt; cA = nA; cB = nB; ++ui;
        if (wr == 1) PG8_BAR;
    }
    PG8_WAIT_V(0);
    PG8_BAR;
#undef PG8_SA
#undef PG8_SB
#undef PG8_STAGE
#undef PG8_LDA
#undef PG8_LDB
#undef PG8_MMA
#undef PG8_WAIT_V
#undef PG8_WAIT_L
#undef PG8_BAR
#undef PG8_SCHED
}
}

__device__ __forceinline__ void phase_gemm_pe(const Frame& F) {
    pg8::DenseOrder S; S.init(F.ws + WS_PB, F.ws + WS_WPE, T, D, PD, DEPTH, F.G, F.blk); pg8::EpiBf16 E{(bf16*)(F.ws + WS_PE), D};
    pg8::gemm_phase(F.wave, F.lds, PD, S, E);
}
__device__ __forceinline__ void phase_gemm_in(const Frame& F, int l) {
    pg8::DenseOrder S; S.init(F.ws + WS_XN, (bf16*)(F.ws + WS_WIN) + (size_t)l * DIN * D, T, DIN, D, 1, F.G, F.blk); pg8::EpiBf16 E{(bf16*)(F.ws + WS_Z), DIN};
    pg8::gemm_phase(F.wave, F.lds, D, S, E);
}
__device__ __forceinline__ void phase_gemm_out(const Frame& F, int l) {
    pg8::DenseOrder S; S.init(F.ws + WS_O, (bf16*)(F.ws + WS_WOUT) + (size_t)l * D * D, T, D, D, 1, F.G, F.blk); pg8::EpiResid E{(bf16*)(F.ws + WS_H)};
    pg8::gemm_phase(F.wave, F.lds, D, S, E);
}
__device__ __forceinline__ void phase_gemm_moe1(const Frame& F, int l) {
    pg8::MoeOrder S; S.init(F.ws + WS_XB, (bf16*)(F.ws + WS_WGU) + (size_t)l * NE * 1024 * 1024, (const int*)(F.ws + MS_BLKE) + l * 256, D, 4, (size_t)1024 * 1024 * 2, F.G, F.blk); pg8::EpiGateUp E{(bf16*)(F.ws + WS_HB)};
    pg8::gemm_phase(F.wave, F.lds, D, S, E);
    { const int nun = S.nrb * 4, rem = nun % F.G, few = (rem == 0 || F.G - rem < 64), idle = few ? F.G : F.G - rem, first = few ? 0 : rem;
      if (F.blk >= first) { pg8::DenseOrder P; P.init((const bf16*)(F.ws + WS_PB) + (size_t)l * T * PD, (const bf16*)(F.ws + WS_WPE) + (size_t)l * D * PD, T, D, PD, 1, idle, F.blk - first);
          pg8::EpiBf16 EP{(bf16*)(F.ws + WS_PE) + (size_t)l * T * D, D}; pg8::gemm_phase(F.wave, F.lds, PD, P, EP); }
      conv_deferred(F, l + 1, 0, NDEF1, first, idle); }
}
__device__ __forceinline__ void phase_gemm_moe2(const Frame& F, int l) {
    pg8::MoeOrder S; S.init(F.ws + WS_HB, (bf16*)(F.ws + WS_WD) + (size_t)l * NE * D * DE, (const int*)(F.ws + MS_BLKE) + l * 256, DE, 4, (size_t)D * DE * 2, F.G, F.blk); pg8::EpiBf16 E{(bf16*)(F.ws + WS_Y), D};
    pg8::gemm_phase(F.wave, F.lds, DE, S, E);
    { const int nun = S.nrb * 4, rem = nun % F.G, few = (rem == 0 || F.G - rem < 64), idle = few ? F.G : F.G - rem, first = few ? 0 : rem;
      conv_deferred(F, l + 1, NDEF1, NDEF, first, idle); }
}
#ifndef MOE_CPE
#define MOE_CPE 5
#endif
#ifndef MOE_CTL
#define MOE_CTL 4
#endif
#ifndef MOE_X1
#define MOE_X1 16
#define MOE_X2 8
#endif
template <int MODE = 0> __device__ __forceinline__ void phase_moe_fused(const Frame& F, int l) {
    unsigned char* ws = F.ws; const int G = F.G, blk = F.blk;
    const int* blke = (const int*)(ws + MS_BLKE) + l * 256;
    unsigned* done = (unsigned*)(ws + WS_CTL) + CW_DONE + l * 256;
    const int nrb = __builtin_amdgcn_readfirstlane(blke[255]), nu = 4 * nrb, e1 = nu % G;
    if constexpr (MODE == 1) { pg8::MoeOrder S; S.init(ws + WS_XB, (bf16*)(ws + WS_WGU) + (size_t)l * NE * 1024 * 1024, blke, D, 4, (size_t)1024 * 1024 * 2, G, blk);
      pg8::EpiGateUp E{(bf16*)(ws + WS_HB)}; pg8::gemm_phase(F.wave, F.lds, D, S, E); return; }
    if constexpr (MODE == 0) { pg8::MoeOrder S; S.init(ws + WS_XB, (bf16*)(ws + WS_WGU) + (size_t)l * NE * 1024 * 1024, blke, D, 4, (size_t)1024 * 1024 * 2, G, blk);
      pg8::EpiGateUpPub E{__builtin_amdgcn_make_buffer_rsrc(ws + WS_HB, 0, (int)((size_t)CAP * DE * 2), 0x00020000), done};
      pg8::gemm_phase(F.wave, F.lds, D, S, E); }
    if constexpr (MODE == 2) { pg8::MoeOrder S; S.init(ws + WS_HB, (bf16*)(ws + WS_WD) + (size_t)l * NE * D * DE, blke, DE, 4, (size_t)D * DE * 2, G, blk >= e1 ? blk - e1 : blk - e1 + G);
      pg8::EpiBf16 E{(bf16*)(ws + WS_Y), D}; pg8::gemm_phase(F.wave, F.lds, DE, S, E); }
    if constexpr (MODE == 0) { pg8::MoeDepOrder S; S.init(ws + WS_HB, (bf16*)(ws + WS_WD) + (size_t)l * NE * D * DE, blke, done, DE, 4, (size_t)D * DE * 2, G, blk >= e1 ? blk - e1 : blk - e1 + G);
      pg8::EpiBf16 E{(bf16*)(ws + WS_Y), D};
      pg8::gemm_phase(F.wave, F.lds, DE, S, E); }
    { const int nt = (l + 1 < DEPTH) ? NDEF : 0, ftot = 256 * MOE_CPE + nt * MOE_CTL;
      const int wrap = 2 * e1 > G ? 2 * e1 - G : 0;
      auto cls = [&](int x, int& c24, int& c16, int& c8, int& c0) {
          const int cA = x < e1 ? x : e1, cAB = x < wrap ? x : wrap;
          int cB = x - e1; cB = cB < 0 ? 0 : cB; if (!wrap) cB = cB > e1 ? e1 : cB; cB += cAB;
          c24 = cAB; c16 = cA - cAB; c8 = cB - cAB; c0 = x - c24 - c16 - c8; };
      auto fill = [&](int x, int lv) { int c24, c16, c8, c0; cls(x, c24, c16, c8, c0);
          return c0 * lv + c8 * (lv > MOE_X2 ? lv - MOE_X2 : 0) + c16 * (lv > MOE_X1 ? lv - MOE_X1 : 0) + c24 * (lv > MOE_X1 + MOE_X2 ? lv - MOE_X1 - MOE_X2 : 0); };
      int lv = 1; while (fill(G, lv) < ftot) ++lv;
      const int B0 = fill(blk, lv), B1 = fill(blk + 1, lv);
      const int pe_tot = 256 * MOE_CPE;
      int j0 = (B0 + MOE_CPE - 1) / MOE_CPE, j1 = (B1 + MOE_CPE - 1) / MOE_CPE; j0 = j0 < 256 ? j0 : 256; j1 = j1 < 256 ? j1 : 256;
      int t0 = B0 > pe_tot ? (B0 - pe_tot + MOE_CTL - 1) / MOE_CTL : 0, t1 = B1 > pe_tot ? (B1 - pe_tot + MOE_CTL - 1) / MOE_CTL : 0; t0 = t0 < nt ? t0 : nt; t1 = t1 < nt ? t1 : nt;
      if (j1 > j0) { pg8::RangeOrder P; P.init((const bf16*)(ws + WS_PB) + (size_t)l * T * PD, (const bf16*)(ws + WS_WPE) + (size_t)l * D * PD, T, D, PD, j0, j1 - j0);
          pg8::EpiBf16 EP{(bf16*)(ws + WS_PE) + (size_t)l * T * D, D}; pg8::gemm_phase(F.wave, F.lds, PD, P, EP); }
      if (t1 > t0) { const int base = (l + 1) * TL_LAYER + t0; conv_run(F, 0, 1, t1 - t0, [=](int f) { return base + f; }); } }
}
__device__ __forceinline__ void phase_gemm_pg(const Frame& F, int l) {
    pg8::DenseOrder S; S.init(F.ws + WS_XN, (bf16*)(F.ws + WS_WPG) + (size_t)l * D * D, T, D, D, 1, F.G, F.blk);
    pg8::EpiPG E{(bf16*)(F.ws + WS_H), (const bf16*)(F.ws + WS_PE) + (size_t)l * T * D, (const float*)(F.ws + MS_RSTDPE), F.in[22] + l * D};
    pg8::gemm_phase(F.wave, F.lds, D, S, E);
}

typedef short s16x4 __attribute__((ext_vector_type(4)));
__device__ __forceinline__ bf16x8 tr_frag(LAS unsigned char* p_lo, LAS unsigned char* p_hi) {
    const s16x4 lo = __builtin_amdgcn_ds_read_tr16_b64_v4i16((LAS s16x4*)p_lo), hi = __builtin_amdgcn_ds_read_tr16_b64_v4i16((LAS s16x4*)p_hi);
    return __builtin_shufflevector(lo, hi, 0, 1, 2, 3, 4, 5, 6, 7); }
#define MFMA16(a, b, c) __builtin_amdgcn_mfma_f32_16x16x32_bf16((a), (b), (c), 0, 0, 0)
constexpr int RP = 272;
constexpr int VP = 1040;

__device__ __forceinline__ void phase_rec_c1(const Frame& F, int l) {
    PH_TID();
    unsigned char* ws = F.ws; const bf16* Z = (const bf16*)(ws + WS_Z);
    bf16* UT = (bf16*)(ws + WS_UT); float* DC = (float*)(ws + MS_DC); float* MM = (float*)(ws + MS_MM);
    const float* lb = (const float*)(ws + MS_LB) + l * DREC;
    LAS unsigned char* KD = F.lds; LAS unsigned char* IM = F.lds + 128 * RP; LAS float* totx = (LAS float*)(F.lds + 256 * RP);
    const int wave = ph_wave, ch = tid & 255, half = tid >> 8, hl = ch >> 7, k = ch & 127, g = lane >> 4, li = lane & 15, q = li >> 2, p = li & 3;
    const int hG = F.G / 2, nmine = (F.G == 256) ? (F.blk < hG ? 4 : 0) : (F.blk < 512 ? (512 - F.blk + F.G - 1) / F.G : 0);
    const int ustep = (F.G == 256) ? hG : F.G;
    u32x4 pf[4], pi[4];
    auto fetch = [&](int unit) { const int c = unit >> 1, hp = unit & 1;
#pragma unroll
        for (int j = 0; j < 4; ++j) { const int idx = tid + 512 * j, hl2 = idx >> 10, row = (idx >> 4) & 63, cc = idx & 15;
            const bf16* src = Z + (size_t)(c * 64 + row) * DIN + 512 + (2 * hp + hl2) * 128 + cc * 8; pf[j] = *(const u32x4*)src; pi[j] = *(const u32x4*)(src + 512); } };
    if (nmine > 0) fetch(F.blk);
    for (int ui = 0; ui < nmine; ++ui) {
        const int unit = F.blk + ui * ustep;
        const int c = unit >> 1, hp = unit & 1, hh = 2 * hp + hl;
#pragma unroll
        for (int j = 0; j < 4; ++j) { const int idx = tid + 512 * j, hl2 = idx >> 10, row = (idx >> 4) & 63, cc = idx & 15; const int dst = (hl2 * 64 + row) * RP + cc * 16;
            *(LAS u32x4*)(KD + dst) = pf[j]; *(LAS u32x4*)(IM + dst) = pi[j]; }
        __syncthreads();
        if (ui + 1 < nmine) fetch(unit + ustep);
        const float lbk = lb[hh * 128 + k];
        float cs[32], kk[32]; float run = 1.f;
#pragma unroll
        for (int t = 0; t < 32; ++t) { const float fz = bf2f(*(const LAS bf16*)(KD + (hl * 64 + 32 * half + t) * RP + 2 * k)); const float sg = sigmoid_(fz); run *= lbk + (1.f - lbk) * sg; cs[t] = run; kk[t] = (1.f - lbk) * (1.f - sg); }
        totx[half * 256 + ch] = run;
        __syncthreads();
        const float other = totx[(1 - half) * 256 + ch]; const float p63 = run * other; const float base_p = half == 0 ? p63 : run;
#pragma unroll
        for (int t = 0; t < 32; ++t) *(LAS bf16*)(KD + (hl * 64 + 32 * half + t) * RP + 2 * k) = (bf16)f2bf(kk[t] * base_p * frcp(fmaxf(cs[t], 1e-30f)));
        if (half == 0) { DC[(c * 4 + hh) * 128 + k] = p63; MM[(c * 4 + hh) * 128 + k] = run; }
        __syncthreads();
        { const int whl = wave >> 2, kt0 = 2 * (wave & 3), whh = 2 * hp + whl;
          f32x4 acc[2][8];
#pragma unroll
          for (int i = 0; i < 2; ++i)
#pragma unroll
              for (int vt = 0; vt < 8; ++vt) acc[i][vt] = (f32x4){0.f, 0.f, 0.f, 0.f};
          LAS unsigned char* kdb = KD + whl * 64 * RP; LAS unsigned char* imb = IM + whl * 64 * RP;
#pragma unroll
          for (int a = 0; a < 2; ++a) { const unsigned ro = (unsigned)((32 * a + 8 * g + q) * RP);
              bf16x8 Af[2];
#pragma unroll
              for (int i = 0; i < 2; ++i) { const unsigned co = (unsigned)((16 * (kt0 + i) + 4 * p) * 2); Af[i] = tr_frag(kdb + ro + co, kdb + ro + 4 * RP + co); }
#pragma unroll
              for (int vt = 0; vt < 8; ++vt) { const unsigned co = (unsigned)((16 * vt + 4 * p) * 2); const bf16x8 Bf = tr_frag(imb + ro + co, imb + ro + 4 * RP + co);
#pragma unroll
                  for (int i = 0; i < 2; ++i) acc[i][vt] = MFMA16(Af[i], Bf, acc[i][vt]); } }
#pragma unroll
          for (int i = 0; i < 2; ++i)
#pragma unroll
              for (int vt = 0; vt < 8; ++vt) { u32x2 w; w.x = pg8::cvt_pk_bf16(acc[i][vt][0], acc[i][vt][1]); w.y = pg8::cvt_pk_bf16(acc[i][vt][2], acc[i][vt][3]);
                  *(u32x2*)(UT + ((size_t)(c * 4 + whh) * 128 + 16 * vt + li) * 128 + 16 * (kt0 + i) + 4 * g) = w; } }
        __syncthreads();
    }
}
__device__ __forceinline__ void phase_rec_c2a(const Frame& F) {
    PH_TID();
    unsigned char* ws = F.ws; const unsigned* UT = (const unsigned*)(ws + WS_UT); const float* DC = (const float*)(ws + MS_DC);
    f32x2* LT = (f32x2*)(ws + WS_LTOT); float* PT = (float*)(ws + MS_PTOT);
    for (int it = F.blk * NTHR + tid; it < 16 * 32768; it += F.G * NTHR) {
        const int gs = it >> 15, e = it & 32767, hh = e >> 13, v = (e >> 6) & 127, k0 = 2 * (e & 63);
        float S0 = 0.f, S1 = 0.f, P0 = 1.f, P1 = 1.f;
#pragma unroll
        for (int cc = 0; cc < 16; ++cc) { const int c = 16 * gs + cc; const unsigned u = UT[(size_t)c * 32768 + e]; const f32x2 d = *(const f32x2*)(DC + (c * 4 + hh) * 128 + k0);
            S0 = d.x * S0 + bflo(u); S1 = d.y * S1 + bfhi(u); P0 *= d.x; P1 *= d.y; }
        LT[it] = (f32x2){S0, S1};
        if (v == 0) *(f32x2*)(PT + (gs * 4 + hh) * 128 + k0) = (f32x2){P0, P1};
    }
}
__device__ __forceinline__ void phase_rec_c2c(const Frame& F) {
    PH_TID();
    unsigned char* ws = F.ws; const unsigned* UT = (const unsigned*)(ws + WS_UT); unsigned* ST = (unsigned*)(ws + WS_ST); const float* DC = (const float*)(ws + MS_DC); const float* MM = (const float*)(ws + MS_MM);
    const f32x2* LT = (const f32x2*)(ws + WS_LTOT); const float* PT = (const float*)(ws + MS_PTOT);
    for (int it = F.blk * NTHR + tid; it < 16 * 32768; it += F.G * NTHR) {
        const int gs = it >> 15, e = it & 32767, hh = e >> 13, k0 = 2 * (e & 63);
        float C0 = 0.f, C1 = 0.f;
        for (int g2 = 0; g2 < gs; ++g2) { const f32x2 pt = *(const f32x2*)(PT + (g2 * 4 + hh) * 128 + k0); const f32x2 lt = LT[g2 * 32768 + e]; C0 = pt.x * C0 + lt.x; C1 = pt.y * C1 + lt.y; }
#pragma unroll
        for (int cc = 0; cc < 16; ++cc) { const int c = 16 * gs + cc; const f32x2 mm = *(const f32x2*)(MM + (c * 4 + hh) * 128 + k0);
            ST[(size_t)c * 32768 + e] = pk2(C0 * mm.x, C1 * mm.y);
            const unsigned u = UT[(size_t)c * 32768 + e]; const f32x2 d = *(const f32x2*)(DC + (c * 4 + hh) * 128 + k0);
            C0 = d.x * C0 + bflo(u); C1 = d.y * C1 + bfhi(u); }
    }
}
__device__ __forceinline__ void phase_rec_c2(const Frame& F) {
    PH_TID();
    unsigned char* ws = F.ws; const int w = ph_wave;
    LAS float* tot = (LAS float*)F.lds;
    for (int unit = F.blk; unit < 256; unit += F.G) {
        const int hh = unit >> 6; const unsigned eo = (unsigned)(unit * 128 + lane), ko = (unsigned)(hh * 128 + 2 * lane);
        const unsigned* ut = (const unsigned*)(ws + WS_UT) + (size_t)(32 * w) * 32768; unsigned* st = (unsigned*)(ws + WS_ST) + (size_t)(32 * w) * 32768;
        const float* dc = (const float*)(ws + MS_DC) + (32 * w) * 512; const float* mmp = (const float*)(ws + MS_MM) + (32 * w) * 512;
        asm volatile("" : "+s"(ut), "+s"(st), "+s"(dc), "+s"(mmp));
        unsigned ua[32], ub[32]; f32x2 d[32], m0[16], m1[16];
#pragma unroll
        for (int cc = 0; cc < 32; ++cc) { ua[cc] = (ut + cc * 32768)[eo]; ub[cc] = (ut + cc * 32768 + 64)[eo]; d[cc] = *(const f32x2*)((dc + cc * 512) + ko); }
        __builtin_amdgcn_sched_barrier(0);
        float a0 = 0.f, a1 = 0.f, b0 = 0.f, b1 = 0.f, p0 = 1.f, p1 = 1.f;
#pragma unroll
        for (int cc = 0; cc < 32; ++cc) { a0 = d[cc].x * a0 + bflo(ua[cc]); a1 = d[cc].y * a1 + bfhi(ua[cc]); b0 = d[cc].x * b0 + bflo(ub[cc]); b1 = d[cc].y * b1 + bfhi(ub[cc]); p0 *= d[cc].x; p1 *= d[cc].y; }
        { LAS float* tw = tot + w * 384 + lane; tw[0] = a0; tw[64] = a1; tw[128] = b0; tw[192] = b1; tw[256] = p0; tw[320] = p1; }
        __builtin_amdgcn_sched_barrier(0);
#pragma unroll
        for (int cc = 0; cc < 16; ++cc) m0[cc] = *(const f32x2*)((mmp + cc * 512) + ko);
        __builtin_amdgcn_sched_barrier(0);
        __syncthreads();
        float A0 = 0.f, A1 = 0.f, B0 = 0.f, B1 = 0.f;
        for (int g2 = 0; g2 < w; ++g2) { const LAS float* tw = tot + g2 * 384 + lane; const float q0 = tw[256], q1 = tw[320]; A0 = q0 * A0 + tw[0]; A1 = q1 * A1 + tw[64]; B0 = q0 * B0 + tw[128]; B1 = q1 * B1 + tw[192]; }
        __builtin_amdgcn_sched_barrier(0);
#pragma unroll
        for (int cc = 0; cc < 16; ++cc) m1[cc] = *(const f32x2*)((mmp + (16 + cc) * 512) + ko);
        __builtin_amdgcn_sched_barrier(0);
#pragma unroll
        for (int cc = 0; cc < 32; ++cc) { const f32x2 mm = cc < 16 ? m0[cc & 15] : m1[cc & 15];
            (st + cc * 32768)[eo] = pk2(A0 * mm.x, A1 * mm.y); (st + cc * 32768 + 64)[eo] = pk2(B0 * mm.x, B1 * mm.y);
            unsigned xa = ua[cc], xb = ub[cc]; asm volatile("" : "+v"(xa), "+v"(xb));
            A0 = d[cc].x * A0 + bflo(xa); A1 = d[cc].y * A1 + bfhi(xa); B0 = d[cc].x * B0 + bflo(xb); B1 = d[cc].y * B1 + bfhi(xb);
            asm volatile("" : "+v"(A0), "+v"(A1), "+v"(B0), "+v"(B1) :: "memory"); }
        __syncthreads();
    }
}
template <int PV = 0> __device__ __forceinline__ void phase_rec_c3(const Frame& F, int l) {
    PH_TID();
    unsigned char* ws = F.ws; const bf16* Z = (const bf16*)(ws + WS_Z); const bf16* ST = (const bf16*)(ws + WS_ST); bf16* O = (bf16*)(ws + WS_O);
    const float* lb = (const float*)(ws + MS_LB) + l * DREC; const float* ogain = F.in[5] + l * 128;
    LAS unsigned char* QT = F.lds; LAS unsigned char* KT = F.lds + 128 * RP; LAS unsigned char* IM = F.lds + 256 * RP;
    const int wave = ph_wave, ch = tid & 255, half = tid >> 8, hl = ch >> 7, k = ch & 127, g = lane >> 4, li = lane & 15, q = li >> 2, p = li & 3;
    for (int unit = F.blk; unit < 512; unit += F.G) {
        const int c = unit >> 1, hp = unit & 1, hh = 2 * hp + hl;
#pragma unroll
        for (int j = 0; j < 4; ++j) { const int idx = tid + 512 * j, hl2 = idx >> 10, row = (idx >> 4) & 63, cc = idx & 15;
            const bf16* src = Z + (size_t)(c * 64 + row) * DIN + (2 * hp + hl2) * 128 + cc * 8; const int dst = (hl2 * 64 + row) * RP + cc * 16;
            const u32x4 vq = *(const u32x4*)src, vf = *(const u32x4*)(src + 512), vi = *(const u32x4*)(src + 1024);
            *(LAS u32x4*)(QT + dst) = vq; *(LAS u32x4*)(KT + dst) = vf; *(LAS u32x4*)(IM + dst) = vi; }
        __syncthreads();
        { const float lbk = lb[hh * 128 + k]; const int col = (hl * 64 + 32 * half) * RP + 2 * k;
          float cs[32], kk[32], qs[32]; float run = 1.f;
#pragma unroll
          for (int t = 0; t < 32; ++t) { const float fz = bf2f(*(const LAS bf16*)(KT + col + t * RP)); const float sg = sigmoid_(fz); run *= lbk + (1.f - lbk) * sg; cs[t] = run; kk[t] = (1.f - lbk) * (1.f - sg);
              qs[t] = silu_(bf2f(*(const LAS bf16*)(QT + col + t * RP))); }
          const float inv = half == 0 ? frcp(fmaxf(run, 1e-30f)) : 1.f;
#pragma unroll
          for (int t = 0; t < 32; ++t) { const float ex = cs[t] * inv; const int off = col + t * RP;
              *(LAS bf16*)(QT + off) = (bf16)f2bf(qs[t] * ex); *(LAS bf16*)(KT + off) = (bf16)f2bf(kk[t] * frcp(fmaxf(ex, 1e-30f))); } }
        const int whl = wave >> 2, tt = wave & 3, whh = 2 * hp + whl;
        bf16x8 Sf[8][4];
#pragma unroll
        for (int vt = 0; vt < 8; ++vt)
#pragma unroll
            for (int a = 0; a < 4; ++a) Sf[vt][a] = *(const bf16x8*)(ST + ((size_t)(c * 4 + whh) * 128 + 16 * vt + li) * 128 + 32 * a + 8 * g);
        __syncthreads();
        if (PV != 1) {
          bf16 gz[8][4];
#pragma unroll
          for (int vt = 0; vt < 8; ++vt)
#pragma unroll
              for (int r = 0; r < 4; ++r) gz[vt][r] = Z[((size_t)c * 64 + 16 * tt + 4 * g + r) * DIN + 1536 + whh * 128 + 16 * vt + li];
          bf16x8 Qf[4];
#pragma unroll
          for (int a = 0; a < 4; ++a) Qf[a] = *(const LAS bf16x8*)(QT + (whl * 64 + 16 * tt + li) * RP + (32 * a + 8 * g) * 2);
          unsigned pw[4][2];
#pragma unroll
          for (int st = 0; st < 4; ++st) { pw[st][0] = 0u; pw[st][1] = 0u;
              { f32x4 s = (f32x4){0.f, 0.f, 0.f, 0.f};
#pragma unroll
                  for (int a = 0; a < 4; ++a) { const bf16x8 Kf = *(const LAS bf16x8*)(KT + (whl * 64 + 16 * st + li) * RP + (32 * a + 8 * g) * 2); s = MFMA16(Kf, Qf[a], s); }
                  if (st == tt) {
#pragma unroll
                      for (int r = 0; r < 4; ++r) if (4 * g + r > li) s[r] = 0.f; }
                  pw[st][0] = st <= tt ? pg8::cvt_pk_bf16(s[0], s[1]) : 0u; pw[st][1] = st <= tt ? pg8::cvt_pk_bf16(s[2], s[3]) : 0u; } }
          f32x4 acc[8];
#pragma unroll
          for (int vt = 0; vt < 8; ++vt) { acc[vt] = (f32x4){0.f, 0.f, 0.f, 0.f};
#pragma unroll
              for (int a = 0; a < 4; ++a) acc[vt] = MFMA16(Qf[a], Sf[vt][a], acc[vt]); }
          LAS unsigned char* imb = IM + whl * 64 * RP;
#pragma unroll
          for (int a = 0; a < 2; ++a) { const u32x4 pv = (u32x4){pw[2 * a][0], pw[2 * a][1], pw[2 * a + 1][0], pw[2 * a + 1][1]}; const bf16x8 Pf = __builtin_bit_cast(bf16x8, pv);
              const unsigned ro = (unsigned)((32 * a + 4 * g + q) * RP);
#pragma unroll
              for (int vt = 0; vt < 8; ++vt) { const unsigned co = (unsigned)((16 * vt + 4 * p) * 2); const bf16x8 If = tr_frag(imb + ro + co, imb + ro + 16 * RP + co); acc[vt] = MFMA16(Pf, If, acc[vt]); } }
          float rs[4];
#pragma unroll
          for (int r = 0; r < 4; ++r) { float ss = 0.f;
#pragma unroll
              for (int vt = 0; vt < 8; ++vt) ss += acc[vt][r] * acc[vt][r];
              ss += shx<1>(ss); ss += shx<2>(ss); ss += shx<4>(ss); ss += shx<8>(ss); rs[r] = frsq(ss * (1.f / 128.f) + EPS); }
#pragma unroll
          for (int vt = 0; vt < 8; ++vt) { const float og = ogain[16 * vt + li];
#pragma unroll
              for (int r = 0; r < 4; ++r) { const size_t t = (size_t)c * 64 + 16 * tt + 4 * g + r; const float gv = bf2f(gz[vt][r]);
                  O[t * D + whh * 128 + 16 * vt + li] = (bf16)f2bf(acc[vt][r] * rs[r] * og * silu_(gv)); } } }
        __syncthreads();
    }
}
__device__ __forceinline__ void phase_sgu(const Frame& F, int l) {
    PH_TID();
    unsigned char* ws = F.ws; const bf16* Z = (const bf16*)(ws + WS_Z); bf16* O = (bf16*)(ws + WS_O);
    const bf16* Wb = (const bf16*)(ws + MS_SGUW) + (size_t)l * 4 * 128 * 128; const float* sb = F.in[9] + l * 4 * 128;
    LAS unsigned char* VN = F.lds;
    const int wave = ph_wave, g = lane >> 4, li = lane & 15, q = li >> 2, p = li & 3;
    for (int unit = (F.blk + F.G / 2) % F.G; unit < 128; unit += F.G) {
        float lg[8], lbv[8];
#pragma unroll
        for (int j = 0; j < 8; ++j) { lg[j] = F.in[6][l * DSGU + 8 * lane + j]; lbv[j] = F.in[7][l * DSGU + 8 * lane + j]; }
        u32x4 raw[16];
#pragma unroll
        for (int i = 0; i < 16; ++i) raw[i] = *(const u32x4*)(Z + ((size_t)unit * 128 + 16 * wave + i) * DIN + 2560 + 8 * lane);
#pragma unroll
        for (int i = 0; i < 16; ++i) { const int s = 16 * wave + i; const u32x4 r = raw[i];
            float x[8] = {gelu_(bflo(r.x)), gelu_(bfhi(r.x)), gelu_(bflo(r.y)), gelu_(bfhi(r.y)), gelu_(bflo(r.z)), gelu_(bfhi(r.z)), gelu_(bflo(r.w)), gelu_(bfhi(r.w))};
            float sm = 0.f, qq = 0.f;
#pragma unroll
            for (int j = 0; j < 8; ++j) { sm += x[j]; qq += x[j] * x[j]; }
            sm += shx<1>(sm); qq += shx<1>(qq); sm += shx<2>(sm); qq += shx<2>(qq); sm += shx<4>(sm); qq += shx<4>(qq); sm += shx<8>(sm); qq += shx<8>(qq); sm += shx<16>(sm); qq += shx<16>(qq);
            const float mu = halves_sum(sm) * (1.f / 512.f); const float var = fmaxf(halves_sum(qq) * (1.f / 512.f) - mu * mu, 0.f);
            const float rstd = frsq(var + EPS);
#pragma unroll
            for (int j = 0; j < 8; ++j) x[j] = (x[j] - mu) * rstd * lg[j] + lbv[j];
            u32x4 o; o.x = pk2(x[0], x[1]); o.y = pk2(x[2], x[3]); o.z = pk2(x[4], x[5]); o.w = pk2(x[6], x[7]);
            *(LAS u32x4*)(VN + s * VP + lane * 16) = o; }
        __syncthreads();
        { const int hh = wave >> 1, dh = wave & 1; const bf16* W = Wb + (size_t)hh * 128 * 128;
          LAS unsigned char* vnb = VN;
#pragma unroll 1
          for (int dp = 0; dp < 2; ++dp) {
          bf16x8 Wf[2][8];
#pragma unroll
          for (int a = 0; a < 2; ++a)
#pragma unroll
              for (int ti = 0; ti < 8; ++ti) if (ti >= 2 * a) Wf[a][ti] = *(const bf16x8*)(W + (size_t)(16 * ti + li) * 128 + 32 * a + 8 * g);
          u32x2 uu[8][2]; float bs[8];
#pragma unroll
          for (int ti = 0; ti < 8; ++ti) { bs[ti] = sb[hh * 128 + 16 * ti + li];
#pragma unroll
              for (int dt = 0; dt < 2; ++dt) uu[ti][dt] = *(const u32x2*)(Z + ((size_t)unit * 128 + 16 * ti + li) * DIN + 2048 + hh * 128 + 64 * dh + 16 * (2 * dp + dt) + 4 * g); }
          f32x4 acc[2][8];
#pragma unroll
          for (int dt = 0; dt < 2; ++dt)
#pragma unroll
              for (int ti = 0; ti < 8; ++ti) acc[dt][ti] = (f32x4){0.f, 0.f, 0.f, 0.f};
#pragma unroll
          for (int a = 0; a < 4; ++a) { const unsigned ro = (unsigned)((32 * a + 8 * g + q) * VP);
              bf16x8 Af[2];
#pragma unroll
              for (int dt = 0; dt < 2; ++dt) { const unsigned co = (unsigned)((hh * 128 + 64 * dh + 16 * (2 * dp + dt) + 4 * p) * 2); Af[dt] = tr_frag(vnb + ro + co, vnb + ro + 4 * VP + co); }
#pragma unroll
              for (int ti = 0; ti < 8; ++ti) if (ti >= 2 * a) {
                  const bf16x8 Bf = a < 2 ? Wf[a < 2 ? a : 0][ti] : *(const bf16x8*)(W + (size_t)(16 * ti + li) * 128 + 32 * a + 8 * g);
#pragma unroll
                  for (int dt = 0; dt < 2; ++dt) acc[dt][ti] = MFMA16(Af[dt], Bf, acc[dt][ti]); } }
#pragma unroll
          for (int ti = 0; ti < 8; ++ti) { const size_t t = (size_t)unit * 128 + 16 * ti + li; const float bias = bs[ti];
#pragma unroll
              for (int dt = 0; dt < 2; ++dt) { const int col = hh * 128 + 64 * dh + 16 * (2 * dp + dt) + 4 * g; const u32x2 u = uu[ti][dt];
                  u32x2 w; w.x = pk2((acc[dt][ti][0] + bias) * gelu_(bflo(u.x)), (acc[dt][ti][1] + bias) * gelu_(bfhi(u.x))); w.y = pk2((acc[dt][ti][2] + bias) * gelu_(bflo(u.y)), (acc[dt][ti][3] + bias) * gelu_(bfhi(u.y)));
                  *(u32x2*)(O + t * D + 512 + col) = w; } } } }
        __syncthreads();
    }
}

#define XB_TMO      128
#define XB_XCNT(j)  (256  + 64 * (j))
#define XB_XSUB(j)  (1280 + 64 * (j))
#define XB_XGEN(j)  (2304 + 64 * (j))
#define XB_TOP      3328
#define XB_TOPGEN   3392
#define XCD_BAR_WORDS 3456
#define XB_SPIN_CAP (1u << 18)
__device__ __forceinline__ unsigned xb_ld(unsigned* p)              { return __hip_atomic_load(p, __ATOMIC_RELAXED, __HIP_MEMORY_SCOPE_AGENT); }
__device__ __forceinline__ unsigned xb_add(unsigned* p, unsigned v) { return __hip_atomic_fetch_add(p, v, __ATOMIC_RELAXED, __HIP_MEMORY_SCOPE_AGENT); }
__device__ __forceinline__ unsigned xb_xcc_id() { return (unsigned)__builtin_amdgcn_s_getreg((3 << 11) | 20) & 0xFu; }
#define XB_SPIN(cond, bar) do { unsigned _sp = 0; while (cond) { __builtin_amdgcn_s_sleep(1); \
    if ((++_sp & 255u) == 0u) { if (xb_ld(&(bar)[XB_TMO])) break; if (_sp > XB_SPIN_CAP) { atomicAdd(&(bar)[XB_TMO], 1u); break; } } } } while (0)
struct XcdBarrier { unsigned* bar; unsigned x; volatile LAS unsigned* st; int wave; };
__device__ __forceinline__ XcdBarrier xcd_barrier_post(unsigned* bar, volatile LAS unsigned* st, int wave) {
    XcdBarrier b; b.bar = bar; b.x = xb_xcc_id(); b.st = st; b.wave = wave;
    if (wave == 0 && lane_now() == 0) (void)xb_add(&bar[XB_XCNT(b.x)], 1u);
    return b;
}
__device__ __forceinline__ void xcd_barrier_complete(unsigned* bar, unsigned x, unsigned& nloc, unsigned& nx) {
    const unsigned G = gridDim.x * gridDim.y * gridDim.z;
    unsigned sum, cnt, mine, sp = 0u;
    for (;;) {
        sum = 0u; cnt = 0u; mine = 0u;
#pragma unroll
        for (unsigned j = 0; j < 16; ++j) { const unsigned c = xb_ld(&bar[XB_XCNT(j)]); sum += c; cnt += (c > 0u) ? 1u : 0u; mine = (j == x) ? c : mine; }
        if (sum == G) break;
        __builtin_amdgcn_s_sleep(1);
        if ((++sp & 255u) == 0u) { if (xb_ld(&bar[XB_TMO])) break; if (sp > XB_SPIN_CAP) { atomicAdd(&bar[XB_TMO], 1u); break; } }
    }
    nloc = mine > 0u ? mine : 1u; nx = cnt > 0u ? cnt : 1u;
}
__device__ __forceinline__ void xcd_barrier(const XcdBarrier& b) {
    asm volatile("s_waitcnt vmcnt(0)" ::: "memory");
    __syncthreads();
    if (b.wave == 0 && lane_now() == 0) {
        unsigned* bar = b.bar;
        __builtin_amdgcn_s_waitcnt(0);
        unsigned nloc = b.st[0], nx = b.st[1];
        if (nloc == 0u) { xcd_barrier_complete(bar, b.x, nloc, nx); b.st[0] = nloc; b.st[1] = nx; }
        const unsigned old = xb_add(&bar[XB_XSUB(b.x)], 1u);
        const unsigned gen = old / nloc;
        if (old + 1u == (gen + 1u) * nloc) {
            __builtin_amdgcn_fence(__ATOMIC_RELEASE, "agent");
            asm volatile("s_waitcnt vmcnt(0)" ::: "memory");
            const unsigned og = xb_add(&bar[XB_TOP], 1u);
            const unsigned tg = og / nx;
            if (og + 1u == (tg + 1u) * nx) xb_add(&bar[XB_TOPGEN], 1u);
            else XB_SPIN(xb_ld(&bar[XB_TOPGEN]) == tg, bar);
            __builtin_amdgcn_fence(__ATOMIC_ACQUIRE, "agent");
            xb_add(&bar[XB_XGEN(b.x)], 1u);
            asm volatile("s_waitcnt vmcnt(0)" ::: "memory");
        } else {
            XB_SPIN(xb_ld(&bar[XB_XGEN(b.x)]) == gen, bar);
            __builtin_amdgcn_fence(__ATOMIC_ACQUIRE, "agent");
            asm volatile("s_waitcnt vmcnt(0)" ::: "memory");
        }
    }
    __syncthreads();
}


__device__ __forceinline__ void xcd_barrier_bg(const XcdBarrier& b, const Frame& F, int lnext, bool drain) {
    asm volatile("s_waitcnt vmcnt(0)" ::: "memory");
    __syncthreads();
    volatile LAS unsigned* sx = b.st + 4;
    unsigned* q = (unsigned*)(F.ws + WS_CTL) + CW_BGQ + lnext * 64;
    if (b.wave == 0 && lane_now() == 0) {
        unsigned* bar = b.bar;
        __builtin_amdgcn_s_waitcnt(0);
        unsigned nloc = b.st[0], nx = b.st[1];
        if (nloc == 0u) { xcd_barrier_complete(bar, b.x, nloc, nx); b.st[0] = nloc; b.st[1] = nx; }
        const unsigned old = xb_add(&bar[XB_XSUB(b.x)], 1u);
        const unsigned gen = old / nloc;
        const bool leader = (old + 1u == (gen + 1u) * nloc);
        unsigned ti = 0u; if (!leader) { const unsigned k = xb_add(q, 1u); if (k < (unsigned)NBG) ti = k + 1u; }
        sx[0] = leader ? 1u : 0u; sx[1] = gen; sx[2] = ti;
    }
    __syncthreads();
    if (__builtin_amdgcn_readfirstlane(sx[0]) == 0u) {
        unsigned ti = (unsigned)__builtin_amdgcn_readfirstlane(sx[2]);
        while (ti != 0u) {
            const int it = lnext * TL_LAYER + NDEF + (int)ti - 1;
            conv_run(F, 0, 1, 1, [=](int) { return it; });
            if (!drain) break;
            if (b.wave == 0 && lane_now() == 0) { const unsigned k = xb_add(q, 1u); sx[2] = k < (unsigned)NBG ? k + 1u : 0u; }
            __syncthreads();
            ti = (unsigned)__builtin_amdgcn_readfirstlane(sx[2]);
            __syncthreads();
        }
    }
    if (b.wave == 0 && lane_now() == 0) {
        unsigned* bar = b.bar; const unsigned gen = sx[1], nx = b.st[1];
        asm volatile("s_waitcnt vmcnt(0)" ::: "memory");
        if (sx[0] != 0u) {
            __builtin_amdgcn_fence(__ATOMIC_RELEASE, "agent");
            asm volatile("s_waitcnt vmcnt(0)" ::: "memory");
            const unsigned og = xb_add(&bar[XB_TOP], 1u);
            const unsigned tg = og / nx;
            if (og + 1u == (tg + 1u) * nx) xb_add(&bar[XB_TOPGEN], 1u);
            else XB_SPIN(xb_ld(&bar[XB_TOPGEN]) == tg, bar);
            __builtin_amdgcn_fence(__ATOMIC_ACQUIRE, "agent");
            xb_add(&bar[XB_XGEN(b.x)], 1u);
            asm volatile("s_waitcnt vmcnt(0)" ::: "memory");
        } else {
            XB_SPIN(xb_ld(&bar[XB_XGEN(b.x)]) == gen, bar);
            __builtin_amdgcn_fence(__ATOMIC_ACQUIRE, "agent");
            asm volatile("s_waitcnt vmcnt(0)" ::: "memory");
        }
    }
    __syncthreads();
}

__device__ __forceinline__ bool opq(Frame& F) { asm volatile("" : "+s"(F.ws), "+s"(F.blk), "+s"(F.out), "+s"(F.G)); return true; }
__device__ __forceinline__ int lq_(int l) { asm volatile("" : "+s"(l)); return l; }
__global__ void __launch_bounds__(NTHR, 2) k_mega(Params p) {
    extern __shared__ __attribute__((aligned(16))) unsigned char lds[];
    Frame F; F.lds = (LAS unsigned char*)lds; F.ws = p.ws; F.in = p.in; F.out = p.out; F.wave = __builtin_amdgcn_readfirstlane(threadIdx.x >> 6); F.blk = blockIdx.x; F.G = gridDim.x;
    volatile LAS unsigned* st = (volatile LAS unsigned*)(F.lds + LDS_BYTES - 32);
    if (threadIdx.x < 8) st[threadIdx.x] = 0u;
    __syncthreads();
#if USE_CG_SYNC
#define GRID_BAR() cooperative_groups::this_grid().sync()
#else
    const XcdBarrier bar = xcd_barrier_post((unsigned*)(p.ws + WS_CTL) + CW_BAR + p.li * XCD_BAR_WORDS, st, F.wave);
#define GRID_BAR() xcd_barrier(bar)
#endif
    const int lo = p.ph_lo, hi = p.ph_hi;
#define RUN(k) (lo <= (k) && (k) < hi && opq(F))
#define SEAM(k) do { if (RUN(k) && RUN((k) + 1)) GRID_BAR(); } while (0)
#define SEAM_BG(k, drain) do { if (RUN(k) && RUN((k) + 1)) { if (!USE_CG_SYNC && l + 1 < DEPTH) xcd_barrier_bg(bar, F, l + 1, drain); else GRID_BAR(); } } while (0)
    if (RUN(0)) { phase_prologue(F); if (PROBE_DUP & 16) { __syncthreads(); phase_prologue(F); } }
    SEAM(0);
    for (int l = 0; l < DEPTH; ++l) {
        const int b = 2 + 13 * l;
        if (RUN(b + 0)) phase_norm1(F, lq_(l));
        SEAM_BG(b + 0, false);
        if (RUN(b + 1)) phase_gemm_in(F, lq_(l));
        SEAM_BG(b + 1, false);
        if (RUN(b + 2)) { phase_rec_c1(F, lq_(l)); phase_sgu(F, lq_(l)); if (PROBE_DUP & 1) { __syncthreads(); phase_rec_c1(F, lq_(l)); phase_sgu(F, lq_(l)); } if (PROBE_DUP & 64) { __syncthreads(); phase_sgu(F, lq_(l)); } }
        SEAM_BG(b + 2, false);
        if (RUN(b + 3)) { phase_rec_c2(F); if (PROBE_DUP & 4) phase_rec_c2(F); }
        SEAM_BG(b + 3, false);
        if (RUN(b + 5)) { phase_rec_c3(F, lq_(l)); if (PROBE_DUP & 2) { __syncthreads(); phase_rec_c3(F, lq_(l)); } if (PROBE_DUP & 128) { __syncthreads(); phase_rec_c3<1>(F, lq_(l)); } }
        SEAM_BG(b + 5, false);
        if (RUN(b + 6)) phase_gemm_out(F, lq_(l));
        SEAM_BG(b + 6, false);
        if (RUN(b + 7)) phase_norm2(F, lq_(l));
        SEAM_BG(b + 7, false);
        if (RUN(b + 8)) { phase_gather(F, lq_(l)); if (PROBE_DUP & 8) { __syncthreads(); phase_gather(F, lq_(l)); } }
        SEAM_BG(b + 8, false);
#if MOE_FUSED == 1
        if (RUN(b + 9)) phase_moe_fused(F, lq_(l));
        SEAM_BG(b + 9, false);
#elif MOE_FUSED == 2
        if (RUN(b + 9)) phase_moe_fused<1>(F, lq_(l));
        SEAM_BG(b + 9, false);
        if (RUN(b + 10)) phase_moe_fused<2>(F, lq_(l));
        SEAM_BG(b + 10, false);
#else
        if (RUN(b + 9)) phase_gemm_moe1(F, lq_(l));
        SEAM_BG(b + 9, false);
        if (RUN(b + 10)) phase_gemm_moe2(F, lq_(l));
        SEAM_BG(b + 10, false);
#endif
        if (RUN(b + 11)) phase_combine(F, lq_(l));
        SEAM_BG(b + 11, true);
        if (RUN(b + 12)) phase_gemm_pg(F, lq_(l));
        SEAM(b + 12);
    }
    if (RUN(54)) phase_final(F);
#undef RUN
#undef SEAM
}

#ifndef ONE_LAUNCH
#define ONE_LAUNCH 1
#endif
#ifndef CUTS
#define CUTS {0, 55}
#endif
#ifndef MFMA_MASK
#define MFMA_MASK 255
#endif
extern "C" void kernel_launch(void* const* d_in, const int* in_sizes, int n_in, void* d_out, int out_size, void* d_ws, size_t ws_size, hipStream_t stream) {
    if (n_in != 24 || out_size != T * D || ws_size < WS_END) { fprintf(stderr, "kernel_launch: unexpected shapes (n_in %d out %d ws %zu)\n", n_in, out_size, ws_size); return; }
    static_assert(CW_BAR + 60 * XCD_BAR_WORDS <= (int)(CTL_BYTES / 4), "barrier regions inside the zeroed control words");
    Params p{}; for (int i = 0; i < 24; ++i) p.in[i] = (const float*)d_in[i]; p.out = (float*)d_out; p.ws = (unsigned char*)d_ws;
    unsigned char* ws = p.ws;
    (void)hipMemsetAsync(ws + WS_CTL, 0, CTL_BYTES, stream);
    { static bool attr = false; if (!attr) { (void)hipFuncSetAttribute((const void*)k_mega, hipFuncAttributeMaxDynamicSharedMemorySize, LDS_BYTES); attr = true; }
      const int cuts[] = CUTS; const int ncut = (int)(sizeof(cuts) / sizeof(cuts[0]));
      for (int i = 0; i + 1 < ncut; ++i) { p.ph_lo = cuts[i]; p.ph_hi = cuts[i + 1]; p.li = i; p.pad = 0;
#if USE_CG_SYNC
          void* args[] = {&p}; hipError_t e = hipLaunchCooperativeKernel((const void*)k_mega, dim3(256), dim3(NTHR), args, LDS_BYTES, stream);
          if (e != hipSuccess) fprintf(stderr, "cooperative launch failed: %s\n", hipGetErrorName(e));
#else
          hipLaunchKernelGGL(k_mega, dim3(256), dim3(NTHR), LDS_BYTES, stream, p);
#endif
      }
    }
}
```

```cpp
#include <hip/hip_runtime.h>
#include <hip/hip_cooperative_groups.h>
#include <cstdio>
#include <cstdint>

#define GAS __attribute__((address_space(1)))
#define LAS __attribute__((address_space(3)))
typedef unsigned short bf16;
typedef float f32x4 __attribute__((ext_vector_type(4)));
typedef float f32x2 __attribute__((ext_vector_type(2)));
typedef unsigned u32x4 __attribute__((ext_vector_type(4)));
typedef unsigned u32x2 __attribute__((ext_vector_type(2)));
typedef short bf16x8 __attribute__((ext_vector_type(8)));

constexpr int T = 16384, D = 1024, DEPTH = 4, DIN = 3072, DREC = 512, DSGU = 512;
constexpr int NE = 32, DE = 512, PD = 256;
constexpr int RB = 256;
constexpr int CAP = 2 * T + NE * RB;
constexpr int NRBMAX = CAP / RB;
constexpr float EPS = 1e-6f;
constexpr int NWAVES = 8, NTHR = 512;

constexpr size_t MiB = 1u << 20, KiB = 1u << 10;
constexpr size_t WS_CTL = 0, CTL_BYTES = 1 * MiB;
constexpr size_t WS_MISC = 1 * MiB;
constexpr size_t MS_TOKE = WS_MISC + 0;
constexpr size_t MS_TOKW = WS_MISC + 128 * KiB;
constexpr size_t MS_SINFO = WS_MISC + 256 * KiB;
constexpr size_t MS_SDEST = WS_MISC + 384 * KiB;
constexpr size_t MS_RSTDPE = WS_MISC + 512 * KiB;
constexpr size_t MS_BLKBASE = WS_MISC + 576 * KiB;
constexpr size_t MS_LB = WS_MISC + 608 * KiB;
constexpr size_t MS_BLKE = WS_MISC + 640 * KiB;
constexpr size_t MS_DC = WS_MISC + 1 * MiB;
constexpr size_t MS_WRT = WS_MISC + 2 * MiB;
constexpr size_t MS_SGUW = WS_MISC + 3 * MiB;
constexpr size_t MS_MM = WS_MISC + 4 * MiB;
constexpr size_t MS_PTOT = WS_MISC + 5 * MiB;
constexpr size_t WS_WIN = 16 * MiB;
constexpr size_t WS_WOUT = 40 * MiB;
constexpr size_t WS_WGU = 48 * MiB;
constexpr size_t WS_WD = 304 * MiB;
constexpr size_t WS_WPG = 432 * MiB;
constexpr size_t WS_WPE = 440 * MiB;
constexpr size_t WS_PB = 442 * MiB;
constexpr size_t WS_H = 474 * MiB;
constexpr size_t WS_XN = 538 * MiB;
constexpr size_t WS_O = 570 * MiB;
constexpr size_t WS_PE = 602 * MiB;
constexpr size_t WS_R1 = 730 * MiB;
constexpr size_t WS_Z = WS_R1;
constexpr size_t WS_UT = WS_R1 + 96 * MiB;
constexpr size_t WS_ST = WS_R1 + 128 * MiB;
constexpr size_t WS_ORAW = WS_R1 + 96 * MiB;
constexpr size_t WS_VN = WS_R1 + 128 * MiB;
constexpr size_t WS_XB = WS_R1;
constexpr size_t WS_HB = WS_R1 + 80 * MiB;
constexpr size_t WS_Y = WS_R1 + 120 * MiB;
constexpr size_t WS_LTOT = 930 * MiB;
constexpr size_t WS_END = 934 * MiB;
constexpr int CW_CNT = 64;
constexpr int CW_BGQ = 1024;
constexpr int CW_DONE = 2048;
constexpr int CW_BAR = 4096;

constexpr int RING_BYTES = 131072, MISC_OFF = RING_BYTES, LDS_BYTES = 147456;

#ifndef PROBE_DUP
#define PROBE_DUP 0
#endif
#ifndef MOE_FUSED
#define MOE_FUSED 1
#endif
#ifndef USE_CG_SYNC
#define USE_CG_SYNC 0
#endif
struct Params { const float* in[24]; float* out; unsigned char* ws; int ph_lo, ph_hi, li, pad; };

#define LDS_WAIT() asm volatile("s_waitcnt lgkmcnt(0)" ::: "memory")
template <int M> __device__ __forceinline__ float shx(float v) { static_assert(M >= 1 && M < 32, "swizzle xor mask");
    return __int_as_float(__builtin_amdgcn_ds_swizzle(__float_as_int(v), (M << 10) | 0x1F)); }
__device__ __forceinline__ float halves_sum(float v) {
    return __int_as_float(__builtin_amdgcn_readlane(__float_as_int(v), 0)) + __int_as_float(__builtin_amdgcn_readlane(__float_as_int(v), 32)); }
__device__ __forceinline__ float wave_sum(float v) {
    v += shx<1>(v); v += shx<2>(v); v += shx<4>(v); v += shx<8>(v); v += shx<16>(v);
    return halves_sum(v);
}
typedef __bf16 bf16x2_t __attribute__((ext_vector_type(2)));
__device__ __forceinline__ unsigned pk2(float lo, float hi) { const bf16x2_t v = __builtin_convertvector((f32x2){lo, hi}, bf16x2_t); return __builtin_bit_cast(unsigned, v); }
__device__ __forceinline__ unsigned f2bf(float f) { return pk2(f, f) & 0xffffu; }
__device__ __forceinline__ float bflo(unsigned w) { return __uint_as_float(w << 16); }
__device__ __forceinline__ float bfhi(unsigned w) { return __uint_as_float(w & 0xffff0000u); }
__device__ __forceinline__ float bf2f(bf16 b) { return __uint_as_float(((unsigned)b) << 16); }
__device__ __forceinline__ float fexp(float x) { return __builtin_amdgcn_exp2f(x * 1.4426950408889634f); }
__device__ __forceinline__ float flog(float x) { return __builtin_amdgcn_logf(x) * 0.6931471805599453f; }
__device__ __forceinline__ float frcp(float x) { return __builtin_amdgcn_rcpf(x); }
__device__ __forceinline__ float frsq(float x) { return __builtin_amdgcn_rsqf(x); }
__device__ __forceinline__ float sigmoid_(float x) { return frcp(1.f + fexp(-x)); }
__device__ __forceinline__ float silu_(float x) { return x * sigmoid_(x); }
__device__ __forceinline__ float gelu_(float x) { const float K1 = 2.f * 0.7978845608028654f * 1.4426950408889634f, K3 = K1 * 0.044715f;
    const float r = frcp(__builtin_amdgcn_exp2f(x * (K1 + K3 * (x * x))) + 1.f); return x - x * r; }

struct Frame {
    LAS unsigned char* lds; unsigned char* ws; const float* const* in; float* out;
    int wave, blk, G;
};
__device__ __forceinline__ int lane_now() { int l; asm volatile("v_mbcnt_lo_u32_b32 %0, -1, 0\n\tv_mbcnt_hi_u32_b32 %0, -1, %0" : "=v"(l)); return l; }
#define PH_TID() int ph_wave = F.wave; asm volatile("" : "+s"(ph_wave)); const int lane = lane_now(); (void)lane; const int tid = (ph_wave << 6) | lane; (void)tid

struct ConvJob { const float* W; const float* g; bf16* WT; int K, N, k0, n0, mode; };
constexpr int TL_IN = 16 * 12, TL_OUT = 16 * 4, TL_G = 32 * 16 * 2, TL_D = 32 * 8 * 4, TL_PG = 16 * 4, TL_PE = 4 * 4;
constexpr int TL_LAYER = TL_IN + TL_OUT + 2 * TL_G + TL_D + TL_PG + TL_PE;
__device__ __forceinline__ ConvJob conv_job(const Frame& F, int it) {
    unsigned char* ws = F.ws; const int l = it / TL_LAYER; int r = it % TL_LAYER; ConvJob j;
    if (r < TL_IN) { j.W = F.in[3] + (size_t)l * D * DIN; j.g = F.in[2] + l * D; j.WT = (bf16*)(ws + WS_WIN) + (size_t)l * DIN * D; j.K = D; j.N = DIN; j.k0 = 64 * (r / 12); j.n0 = 256 * (r % 12); j.mode = 0; return j; } r -= TL_IN;
    if (r < TL_OUT) { j.W = F.in[10] + (size_t)l * D * D; j.g = nullptr; j.WT = (bf16*)(ws + WS_WOUT) + (size_t)l * D * D; j.K = D; j.N = D; j.k0 = 64 * (r / 4); j.n0 = 256 * (r % 4); j.mode = 0; return j; } r -= TL_OUT;
    if (r < 2 * TL_G) { const int up = r >= TL_G; if (up) r -= TL_G; const int e = r / 32, rr = r % 32;
        j.W = F.in[up ? 17 : 16] + (size_t)(l * NE + e) * D * DE; j.g = F.in[11] + l * D; j.WT = (bf16*)(ws + WS_WGU) + (size_t)(l * NE + e) * 1024 * 1024; j.K = D; j.N = DE; j.k0 = 64 * (rr / 2); j.n0 = 256 * (rr % 2); j.mode = 1 + up; return j; } r -= 2 * TL_G;
    if (r < TL_D) { const int e = r / 32, rr = r % 32; j.W = F.in[18] + (size_t)(l * NE + e) * DE * D; j.g = nullptr; j.WT = (bf16*)(ws + WS_WD) + (size_t)(l * NE + e) * D * DE; j.K = DE; j.N = D; j.k0 = 64 * (rr / 4); j.n0 = 256 * (rr % 4); j.mode = 0; return j; } r -= TL_D;
    if (r < TL_PG) { j.W = F.in[20] + (size_t)l * D * D; j.g = F.in[19] + l * D; j.WT = (bf16*)(ws + WS_WPG) + (size_t)l * D * D; j.K = D; j.N = D; j.k0 = 64 * (r / 4); j.n0 = 256 * (r % 4); j.mode = 0; return j; } r -= TL_PG;
    j.W = F.in[21] + (size_t)l * PD * D; j.g = nullptr; j.WT = (bf16*)(ws + WS_WPE) + (size_t)l * D * PD; j.K = PD; j.N = D; j.k0 = 64 * (r / 4); j.n0 = 256 * (r % 4); j.mode = 0; return j;
}
__device__ __forceinline__ void conv_load(const ConvJob& j, int wave, int lane, f32x4 (&v)[8]) {
#pragma unroll
    for (int i = 0; i < 8; ++i) { const int row = 8 * wave + i; v[i] = *(const f32x4*)(j.W + (size_t)(j.k0 + row) * j.N + j.n0 + 4 * lane); if (j.g) v[i] = v[i] * j.g[j.k0 + row]; }
}
constexpr int NDEF = 384, NDEF1 = 128, NBG = 3024;
constexpr int NREST = TL_LAYER - NDEF - NBG, NPRO = TL_LAYER + 3 * NREST;
__device__ __forceinline__ int pro_tile(int f) { if (NREST == 0 || f < TL_LAYER) return f; f -= TL_LAYER; const int l = 1 + f / (NREST ? NREST : 1); return l * TL_LAYER + NDEF + NBG + f % (NREST ? NREST : 1); }
template <class M> __device__ __forceinline__ void conv_run(const Frame& F, int first, int stride, int count, M tile_of) {
    PH_TID();
    LAS float* tile = (LAS float*)F.lds;
    const int wave = ph_wave;
    int f = first; f32x4 v[8]; ConvJob cur{}, nxt{};
    if (f < count) { cur = conv_job(F, tile_of(f)); conv_load(cur, wave, lane, v); }
    while (f < count) {
#pragma unroll
        for (int i = 0; i < 8; ++i) { LAS float* d = tile + (8 * wave + i) * 257 + 4 * lane; d[0] = v[i].x; d[1] = v[i].y; d[2] = v[i].z; d[3] = v[i].w; }
        __syncthreads();
        const int fn = f + stride; if (fn < count) { nxt = conv_job(F, tile_of(fn)); conv_load(nxt, wave, lane, v); }
#pragma unroll
        for (int q = 0; q < 4; ++q) { const int nn = 32 * wave + 8 * q + (lane >> 3), c = lane & 7; const LAS float* sp = tile + (8 * c) * 257 + nn;
            u32x4 o; o.x = pk2(sp[0 * 257], sp[1 * 257]); o.y = pk2(sp[2 * 257], sp[3 * 257]); o.z = pk2(sp[4 * 257], sp[5 * 257]); o.w = pk2(sp[6 * 257], sp[7 * 257]);
            const int n = cur.n0 + nn; const int drow = cur.mode == 0 ? n : ((n >> 7) * 256 + (n & 127) + (cur.mode == 2 ? 128 : 0));
            *(u32x4*)(cur.WT + (size_t)drow * cur.K + cur.k0 + 8 * c) = o; }
        __syncthreads();
        cur = nxt; f = fn;
    }
}
__device__ __forceinline__ void conv_deferred(const Frame& F, int lnext, int r0, int r1, int first, int idle) {
    if (lnext >= DEPTH || F.blk < first) return;
    conv_run(F, F.blk - first, idle, r1 - r0, [=](int f) { return lnext * TL_LAYER + r0 + f; });
}
__device__ __forceinline__ void phase_prologue(const Frame& F) {
    PH_TID();
    unsigned char* ws = F.ws;
    conv_run(F, F.blk, F.G, NPRO, [](int f) { return pro_tile(f); });
    { const f32x4* src = (const f32x4*)F.in[1]; u32x4* dst = (u32x4*)(ws + WS_PB); const size_t n8 = (size_t)DEPTH * T * PD / 8;
      for (size_t i = (size_t)F.blk * NTHR + tid; i < n8; i += (size_t)F.G * NTHR) { const f32x4 a = src[2 * i], b = src[2 * i + 1]; u32x4 o; o.x = pk2(a.x, a.y); o.y = pk2(a.z, a.w); o.z = pk2(b.x, b.y); o.w = pk2(b.z, b.w); dst[i] = o; } }
    { float* wrt = (float*)(ws + MS_WRT);
      for (int i = F.blk * NTHR + tid; i < DEPTH * 36 * D; i += F.G * NTHR) { const int k = i % D, n = (i / D) % 36, l = i / (36 * D);
          const float w = n < 4 ? F.in[12][((size_t)l * D + k) * 4 + n] : F.in[14][((size_t)l * D + k) * NE + (n - 4)]; wrt[i] = w * F.in[11][l * D + k]; } }
    { bf16* wb = (bf16*)(ws + MS_SGUW); for (int i = F.blk * NTHR + tid; i < DEPTH * 4 * 128 * 128; i += F.G * NTHR) { const int tc = (i >> 7) & 127, sp = i & 127; wb[i] = sp <= tc ? (bf16)f2bf(F.in[8][i]) : (bf16)0; } }
    if (F.blk == 0 && tid < DREC) { const int c = tid; float v[DEPTH], m = -1e30f;
#pragma unroll
        for (int l = 0; l < DEPTH; ++l) { v[l] = F.in[4][l * DREC + c]; m = fmaxf(m, v[l]); }
        float s = 0.f;
#pragma unroll
        for (int l = 0; l < DEPTH; ++l) { v[l] = fexp(v[l] - m); s += v[l]; }
        float* lb = (float*)(ws + MS_LB); float acc = 0.f;
#pragma unroll
        for (int l = 0; l < DEPTH; ++l) { if (l > 0) acc += v[l] / s; lb[l * DREC + c] = acc; } }
}

__device__ __forceinline__ void load_row(const float* row, int lane, f32x4 (&v)[4]) { const f32x4* r = (const f32x4*)row + lane;
#pragma unroll
    for (int j = 0; j < 4; ++j) v[j] = r[64 * j]; }
__device__ __forceinline__ void load_row_bf(const bf16* row, int lane, f32x4 (&v)[4]) { const u32x2* r = (const u32x2*)row + lane;
#pragma unroll
    for (int j = 0; j < 4; ++j) { const u32x2 x = r[64 * j]; v[j] = (f32x4){bflo(x.x), bfhi(x.x), bflo(x.y), bfhi(x.y)}; } }
__device__ __forceinline__ float row_sumsq(const f32x4 (&v)[4]) { float s = 0.f;
#pragma unroll
    for (int j = 0; j < 4; ++j) s += (v[j].x * v[j].x + v[j].y * v[j].y) + (v[j].z * v[j].z + v[j].w * v[j].w);
    return wave_sum(s); }
__device__ __forceinline__ void store_row_bf16(bf16* orow, int lane, const f32x4 (&v)[4], float s) { u32x2* o = (u32x2*)orow + lane;
#pragma unroll
    for (int j = 0; j < 4; ++j) { u32x2 w; w.x = pk2(v[j].x * s, v[j].y * s); w.y = pk2(v[j].z * s, v[j].w * s); o[64 * j] = w; } }

__device__ __forceinline__ void phase_norm1(const Frame& F, int l) {
    PH_TID();
    bf16* XN = (bf16*)(F.ws + WS_XN); bf16* h = (bf16*)(F.ws + WS_H); const float* x = F.in[0];
    const int gw = F.blk * NWAVES + ph_wave, NGW = F.G * NWAVES;
    for (int t = gw; t < T; t += NGW) { f32x4 v[4];
        if (l == 0) { load_row(x + (size_t)t * D, lane, v); store_row_bf16(h + (size_t)t * D, lane, v, 1.f); } else load_row_bf(h + (size_t)t * D, lane, v);
        const float rstd = frsq(row_sumsq(v) * (1.f / D) + EPS); store_row_bf16(XN + (size_t)t * D, lane, v, rstd); }
}
__device__ __forceinline__ float bfly8(const float (&r)[8], int lane) {
    const bool b2 = lane & 4, b1 = lane & 2, b0 = lane & 1; float a[4], c[2];
#pragma unroll
    for (int i = 0; i < 4; ++i) { const float keep = b2 ? r[i + 4] : r[i], send = b2 ? r[i] : r[i + 4]; a[i] = keep + shx<4>(send); }
#pragma unroll
    for (int i = 0; i < 2; ++i) { const float keep = b1 ? a[i + 2] : a[i], send = b1 ? a[i] : a[i + 2]; c[i] = keep + shx<2>(send); }
    const float keep = b0 ? c[1] : c[0], send = b0 ? c[0] : c[1]; float d = keep + shx<1>(send);
    d += shx<8>(d); d += shx<16>(d);
    return d + __int_as_float(__builtin_amdgcn_ds_bpermute((lane ^ 32) << 2, __float_as_int(d)));
}
__device__ __forceinline__ void phase_norm2(const Frame& F, int l) {
    PH_TID();
    unsigned char* ws = F.ws;
    unsigned* hist = (unsigned*)(F.lds + MISC_OFF + 256);
    if (tid < 32) hist[tid] = 0u;
    __syncthreads();
    const bf16* h = (const bf16*)(ws + WS_H); bf16* XN = (bf16*)(ws + WS_XN);
    const float* WrT = (const float*)(ws + MS_WRT) + (size_t)l * 36 * D;
    const float* b_rg = F.in[13] + l * 4; const float* b_re = F.in[15] + l * NE;
    int* tok_e = (int*)(ws + MS_TOKE); float* tok_w = (float*)(ws + MS_TOKW); unsigned* sinfo = (unsigned*)(ws + MS_SINFO);
    const int RPB = T / F.G, RPW = RPB / NWAVES;
    for (int i0 = 0; i0 < RPW; i0 += 8) {
        const int t0 = F.blk * RPB + ph_wave * RPW + i0;
        f32x4 v[8][4]; float ss[8];
#pragma unroll
        for (int r = 0; r < 8; ++r) { load_row_bf(h + (size_t)(t0 + r) * D, lane, v[r]); float q = 0.f;
#pragma unroll
            for (int j = 0; j < 4; ++j) q += (v[r][j].x * v[r][j].x + v[r][j].y * v[r][j].y) + (v[r][j].z * v[r][j].z + v[r][j].w * v[r][j].w);
            ss[r] = q; }
        const float rstd_mine = frsq(bfly8(ss, lane) * (1.f / D) + EPS);
#pragma unroll
        for (int r = 0; r < 8; ++r) { const float rs = __int_as_float(__builtin_amdgcn_readlane(__float_as_int(rstd_mine), r)); store_row_bf16(XN + (size_t)(t0 + r) * D, lane, v[r], rs); }
        LAS float* lgw = (LAS float*)(F.lds + 4096) + ph_wave * (36 * 8);
#pragma unroll 2
        for (int n = 0; n < 36; ++n) { const f32x4* wr = (const f32x4*)(WrT + (size_t)n * D) + lane; const f32x4 w0 = wr[0], w1 = wr[64], w2 = wr[128], w3 = wr[192]; float pr[8];
#pragma unroll
            for (int r = 0; r < 8; ++r) pr[r] = ((v[r][0].x * w0.x + v[r][0].y * w0.y) + (v[r][0].z * w0.z + v[r][0].w * w0.w)) + ((v[r][1].x * w1.x + v[r][1].y * w1.y) + (v[r][1].z * w1.z + v[r][1].w * w1.w))
                                                 + ((v[r][2].x * w2.x + v[r][2].y * w2.y) + (v[r][2].z * w2.z + v[r][2].w * w2.w)) + ((v[r][3].x * w3.x + v[r][3].y * w3.y) + (v[r][3].z * w3.z + v[r][3].w * w3.w));
            const float val = bfly8(pr, lane) * rstd_mine; if (lane < 8) lgw[n * 8 + lane] = val; }
        const int row = lane & 7;
        float lg4[4], lgb[4];
#pragma unroll
        for (int j = 0; j < 4; ++j) { lg4[j] = lgw[j * 8 + row]; lgb[j] = lg4[j] + b_rg[j]; }
        int gs = 0; float gm = lgb[0];
#pragma unroll
        for (int j = 1; j < 4; ++j) if (lgb[j] > gm) { gm = lgb[j]; gs = j; }
        float mx = fmaxf(fmaxf(lg4[0], lg4[1]), fmaxf(lg4[2], lg4[3])), se = 0.f, lsel = lg4[0];
#pragma unroll
        for (int j = 0; j < 4; ++j) { se += fexp(lg4[j] - mx); if (j == gs) lsel = lg4[j]; }
        const float g_w = fexp(lsel - mx) * frcp(se);
        float le[8], leb[8];
#pragma unroll
        for (int j = 0; j < 8; ++j) { le[j] = lgw[(4 + gs * 8 + j) * 8 + row]; leb[j] = le[j] + b_re[gs * 8 + j]; }
        int s0 = 0; float m0 = leb[0];
#pragma unroll
        for (int j = 1; j < 8; ++j) if (leb[j] > m0) { m0 = leb[j]; s0 = j; }
        int s1 = -1; float m1 = -3.0e38f;
#pragma unroll
        for (int j = 0; j < 8; ++j) if (j != s0 && leb[j] > m1) { m1 = leb[j]; s1 = j; }
        if (s1 < 0) s1 = (s0 == 0) ? 1 : 0;
        float la = le[0], lb2 = le[0];
#pragma unroll
        for (int j = 1; j < 8; ++j) { if (j == s0) la = le[j]; if (j == s1) lb2 = le[j]; }
        const float wa = frcp(1.f + fexp(lb2 - la)), wb = 1.f - wa;
        if (lane < 8) { const int t = t0 + lane;
            const int e0 = gs * 8 + s0, e1 = gs * 8 + s1;
            const unsigned r0 = atomicAdd(&hist[e0], 1u), r1 = atomicAdd(&hist[e1], 1u);
            tok_e[2 * t] = e0; tok_e[2 * t + 1] = e1; tok_w[2 * t] = g_w * wa; tok_w[2 * t + 1] = g_w * wb;
            sinfo[2 * t] = ((unsigned)F.blk << 16) | r0; sinfo[2 * t + 1] = ((unsigned)F.blk << 16) | r1;
        }
    }
    __syncthreads();
    if (tid < 32) { unsigned* cnt = (unsigned*)(ws + WS_CTL) + CW_CNT + l * 32;
        const unsigned base = __hip_atomic_fetch_add(cnt + tid, hist[tid], __ATOMIC_RELAXED, __HIP_MEMORY_SCOPE_AGENT);
        ((unsigned*)(ws + MS_BLKBASE))[F.blk * 32 + tid] = base; }
}
__device__ __forceinline__ void phase_gather(const Frame& F, int l) {
    PH_TID();
    unsigned char* ws = F.ws;
    int* ps = (int*)(F.lds + MISC_OFF + 512);
    if (tid == 0) { unsigned* cnt = (unsigned*)(ws + WS_CTL) + CW_CNT + l * 32; int* blke = (int*)(ws + MS_BLKE) + l * 256; int acc = 0;
        for (int e = 0; e < NE; ++e) { const int c = (int)__hip_atomic_load(cnt + e, __ATOMIC_RELAXED, __HIP_MEMORY_SCOPE_AGENT); ps[e] = acc; const int pad = (c + RB - 1) / RB * RB;
            if (F.blk == 0) for (int rb = acc / RB; rb < (acc + pad) / RB; ++rb) blke[rb] = e;
            acc += pad; }
        if (F.blk == 0) blke[255] = acc / RB; }
    __syncthreads();
    const int* tok_e = (const int*)(ws + MS_TOKE); const unsigned* sinfo = (const unsigned*)(ws + MS_SINFO); const unsigned* bbase = (const unsigned*)(ws + MS_BLKBASE);
    int* sdest = (int*)(ws + MS_SDEST); const bf16* XN = (const bf16*)(ws + WS_XN); bf16* XB = (bf16*)(ws + WS_XB);
    const int gw = F.blk * NWAVES + ph_wave, NGW = F.G * NWAVES;
    for (int t = gw; t < T; t += NGW) {
        const u32x4* src = (const u32x4*)(XN + (size_t)t * D) + lane; const u32x4 a = src[0], b = src[64];
#pragma unroll
        for (int j = 0; j < 2; ++j) { const int e = tok_e[2 * t + j]; const unsigned info = sinfo[2 * t + j];
            const int dest = ps[e] + (int)bbase[(info >> 16) * 32 + e] + (int)(info & 0xffffu);
            if (lane == 0) sdest[2 * t + j] = dest;
            u32x4* dst = (u32x4*)(XB + (size_t)dest * D) + lane; dst[0] = a; dst[64] = b; }
    }
}
__device__ __forceinline__ void phase_combine(const Frame& F, int l) {
    PH_TID();
    unsigned char* ws = F.ws;
    bf16* h = (bf16*)(ws + WS_H); bf16* XN = (bf16*)(ws + WS_XN); const bf16* Y = (const bf16*)(ws + WS_Y); const bf16* PE = (const bf16*)(ws + WS_PE) + (size_t)l * T * D;
    const int* sdest = (const int*)(ws + MS_SDEST); const float* tok_w = (const float*)(ws + MS_TOKW); float* rstd_pe = (float*)(ws + MS_RSTDPE);
    const int gw = F.blk * NWAVES + ph_wave, NGW = F.G * NWAVES;
    for (int t = gw; t < T; t += NGW) {
        const int d0 = sdest[2 * t], d1 = sdest[2 * t + 1]; const float w0 = tok_w[2 * t], w1 = tok_w[2 * t + 1];
        f32x4 v[4]; load_row_bf(h + (size_t)t * D, lane, v);
        const u32x2* y0 = (const u32x2*)(Y + (size_t)d0 * D) + lane; const u32x2* y1 = (const u32x2*)(Y + (size_t)d1 * D) + lane; const u32x2* pe = (const u32x2*)(PE + (size_t)t * D) + lane;
        float sp = 0.f;
#pragma unroll
        for (int j = 0; j < 4; ++j) { const u32x2 a = y0[64 * j], b = y1[64 * j], c = pe[64 * j];
            v[j].x += w0 * bflo(a.x) + w1 * bflo(b.x); v[j].y += w0 * bfhi(a.x) + w1 * bfhi(b.x); v[j].z += w0 * bflo(a.y) + w1 * bflo(b.y); v[j].w += w0 * bfhi(a.y) + w1 * bfhi(b.y);
            const float p0 = bflo(c.x), p1 = bfhi(c.x), p2 = bflo(c.y), p3 = bfhi(c.y); sp += (p0 * p0 + p1 * p1) + (p2 * p2 + p3 * p3); }
        store_row_bf16(h + (size_t)t * D, lane, v, 1.f);
        const float rstd = frsq(row_sumsq(v) * (1.f / D) + EPS); store_row_bf16(XN + (size_t)t * D, lane, v, rstd);
        sp = wave_sum(sp); if (lane == 0) rstd_pe[t] = frsq(sp * (1.f / D) + EPS);
    }
}
__device__ __forceinline__ void phase_final(const Frame& F) {
    PH_TID();
    const bf16* h = (const bf16*)(F.ws + WS_H); const float* nf = F.in[23];
    const int gw = F.blk * NWAVES + ph_wave, NGW = F.G * NWAVES;
    for (int t = gw; t < T; t += NGW) { f32x4 v[4]; load_row_bf(h + (size_t)t * D, lane, v); const float rstd = frsq(row_sumsq(v) * (1.f / D) + EPS);
        f32x4* o = (f32x4*)(F.out + (size_t)t * D) + lane; const f32x4* g = (const f32x4*)nf + lane;
#pragma unroll
        for (int j = 0; j < 4; ++j) o[64 * j] = v[j] * rstd * g[64 * j]; }
}


namespace pg8 {
constexpr int BM = 256, BK = 64, HALF = 128, HTB = HALF * BK * 2, STAGE_BYTES = 8 * HTB, NXCD = 8, WGM = 8;
__host__ __device__ __forceinline__ int lds_byte(int r, int c) { const int st = (r >> 4) * 2 + (c >> 5), rr = r & 15, cc = c & 31, ob = rr * 64 + cc * 2; return st * 1024 + (ob ^ (((ob >> 9) & 1) << 5)); }
__host__ __device__ __forceinline__ void stage_rc(int b, int& R, int& C) { const int st = b / 1024, sb = b % 1024, swz = sb ^ (((sb >> 9) & 1) << 5); R = (st >> 1) * 16 + swz / 64; C = (st & 1) * 32 + (swz % 64) / 2; }
__host__ __device__ __forceinline__ int perm32(int rho) { const int n = rho >> 4, i = rho & 15; return 8 * (i >> 2) + 4 * n + (i & 3); }
struct Unit { int pm, pn; const char* A; const char* B; };
__device__ __forceinline__ void static_map(int wgid, int nM, int nN, int& pm, int& pn) {
    const int nwg = nM * nN; { const int q = nwg / NXCD, r = nwg % NXCD, xcd = wgid % NXCD, off = wgid / NXCD; wgid = (xcd < r ? xcd * (q + 1) : r * (q + 1) + (xcd - r) * q) + off; }
    const int nig = WGM * nN, gid = wgid / nig, fm = gid * WGM, gsz = (nM - fm) < WGM ? (nM - fm) : WGM;
    pm = fm + ((wgid % nig) % gsz); pn = (wgid % nig) / gsz;
}
struct DenseOrder { static constexpr bool DEPS = false;
    const char* A; const char* Bt; int nM, nN, nL, G, c; size_t tstep;
    __device__ void init(const void* A_, const void* Bt_, int M, int N, int K, int nL_, int G_, int c_) { A = (const char*)A_; Bt = (const char*)Bt_; nM = M / BM; nN = N / BM; nL = nL_; G = G_; c = c_; tstep = (size_t)BM * K * 2; }
    __device__ bool next(int i, Unit& u) const { const long L = (long)i * G + c; const int per = nM * nN; if (L >= (long)per * nL) return false;
        const int l = (int)(L / per); int pm, pn; static_map((int)(L % per), nM, nN, pm, pn); u.pm = l * nM + pm; u.pn = pn; u.A = A + (size_t)u.pm * tstep; u.B = Bt + (size_t)(l * nN + pn) * tstep; return true; }
};
struct MoeOrder { static constexpr bool DEPS = false;
    const char* A; const char* W; const int* blke; int nrb, nN, G, c, e0, e1, e2; size_t a_tstep, w_estride, b_tstep;
    __device__ void init(const void* A_, const void* W_, const int* blke_, int K, int nN_, size_t w_estride_bytes, int G_, int c_) { A = (const char*)A_; W = (const char*)W_; blke = blke_; nrb = __builtin_amdgcn_readfirstlane(blke_[255]); nN = nN_; G = G_; c = c_;
        a_tstep = (size_t)BM * K * 2; b_tstep = a_tstep; w_estride = w_estride_bytes;
        const int r0 = c / nN, r1 = (G + c) / nN, r2 = (2 * G + c) / nN; const int x0 = blke_[r0 < 255 ? r0 : 254], x1 = blke_[r1 < 255 ? r1 : 254], x2 = blke_[r2 < 255 ? r2 : 254];
        e0 = __builtin_amdgcn_readfirstlane(x0); e1 = __builtin_amdgcn_readfirstlane(x1); e2 = __builtin_amdgcn_readfirstlane(x2); }
    __device__ bool next(int i, Unit& u) const { const long L = (long)i * G + c; if (L >= (long)nrb * nN) return false; const int rb = (int)(L / nN), pn = (int)(L % nN);
        const int ex = i == 0 ? e0 : i == 1 ? e1 : i == 2 ? e2 : __builtin_amdgcn_readfirstlane(blke[rb]);
        u.pm = rb; u.pn = pn; u.A = A + (size_t)rb * a_tstep; u.B = W + (size_t)ex * w_estride + (size_t)pn * b_tstep; return true; }
};
__device__ __forceinline__ unsigned ag_ld(const unsigned* p)        { return __hip_atomic_load(p, __ATOMIC_RELAXED, __HIP_MEMORY_SCOPE_AGENT); }
__device__ __forceinline__ unsigned ag_add(unsigned* p, unsigned v) { return __hip_atomic_fetch_add(p, v, __ATOMIC_RELAXED, __HIP_MEMORY_SCOPE_AGENT); }
struct MoeDepOrder { static constexpr bool DEPS = true;
    const char* A; const char* W; const int* blke; const unsigned* done; int nrb, nN, G, c, e0, e1, e2; size_t a_tstep, w_estride, b_tstep;
    __device__ void init(const void* A_, const void* W_, const int* blke_, const unsigned* done_, int K, int nN_, size_t w_estride_bytes, int G_, int c_) { A = (const char*)A_; W = (const char*)W_; blke = blke_; done = done_;
        nrb = __builtin_amdgcn_readfirstlane(blke_[255]); nN = nN_; G = G_; c = c_; a_tstep = (size_t)BM * K * 2; b_tstep = a_tstep; w_estride = w_estride_bytes;
        const int r0 = c / nN, r1 = (G + c) / nN, r2 = (2 * G + c) / nN; const int x0 = blke_[r0 < 255 ? r0 : 254], x1 = blke_[r1 < 255 ? r1 : 254], x2 = blke_[r2 < 255 ? r2 : 254];
        e0 = __builtin_amdgcn_readfirstlane(x0); e1 = __builtin_amdgcn_readfirstlane(x1); e2 = __builtin_amdgcn_readfirstlane(x2); }
    __device__ bool next(int i, Unit& u) const { const long L = (long)i * G + c; if (L >= (long)nrb * nN) return false; const int rb = (int)(L / nN), pn = (int)(L % nN);
        const int ex = i == 0 ? e0 : i == 1 ? e1 : i == 2 ? e2 : __builtin_amdgcn_readfirstlane(blke[rb]);
        u.pm = rb; u.pn = pn; u.A = A + (size_t)rb * a_tstep; u.B = W + (size_t)ex * w_estride + (size_t)pn * b_tstep; return true; }
    __device__ void wait(const Unit& u, int wid) const {
        if (wid == 0 && lane_now() == 0) { while (ag_ld(done + u.pm) < 4u) __builtin_amdgcn_s_sleep(1); __builtin_amdgcn_fence(__ATOMIC_ACQUIRE, "agent"); } }
};
struct RangeOrder { static constexpr bool DEPS = false;
    const char* A; const char* Bt; int nM, nN, j0, n; size_t tstep;
    __device__ void init(const void* A_, const void* Bt_, int M, int N, int K, int j0_, int n_) { A = (const char*)A_; Bt = (const char*)Bt_; nM = M / BM; nN = N / BM; j0 = j0_; n = n_; tstep = (size_t)BM * K * 2; }
    __device__ bool next(int i, Unit& u) const { if (i >= n) return false; int pm, pn; static_map(j0 + i, nM, nN, pm, pn); u.pm = pm; u.pn = pn; u.A = A + (size_t)pm * tstep; u.B = Bt + (size_t)pn * tstep; return true; }
};
__device__ __forceinline__ unsigned cvt_pk_bf16(float lo, float hi) { return pk2(lo, hi); }
struct EpiBf16 { static constexpr bool PERM = true, ACC_INIT = false, SIGNAL = false; bf16* O; int ldc;
    __device__ __forceinline__ void operator()(const f32x4 (&acc)[2][2][4][2], const Unit& u, int wr, int wc, int, int) const {
        const int t2 = lane_now(), fr = t2 & 15, fq = t2 >> 4;
        const int row0 = u.pm * BM + wr * 64 + fr, col0 = u.pn * BM + wc * 32 + 8 * fq;
#pragma unroll
        for (int ai = 0; ai < 2; ++ai)
#pragma unroll
            for (int m = 0; m < 4; ++m) { bf16* rowp = O + (size_t)(row0 + ai * HALF + m * 16) * ldc + col0;
#pragma unroll
                for (int bj = 0; bj < 2; ++bj) { const f32x4 v0 = acc[ai][bj][m][0], v1 = acc[ai][bj][m][1];
                    u32x4 w; w.x = cvt_pk_bf16(v0[0], v0[1]); w.y = cvt_pk_bf16(v0[2], v0[3]); w.z = cvt_pk_bf16(v1[0], v1[1]); w.w = cvt_pk_bf16(v1[2], v1[3]);
                    *(u32x4*)(rowp + bj * HALF) = w; } }
    } };
struct EpiResid { static constexpr bool PERM = true, ACC_INIT = true, SIGNAL = false; bf16* h;
    __device__ __forceinline__ void init(f32x4 (&acc)[2][2][4][2], const Unit& u, int wr, int wc, int fr, int fq) const {
        const int row0 = u.pm * BM + wr * 64 + fr, col0 = u.pn * BM + wc * 32 + 8 * fq;
#pragma unroll
        for (int ai = 0; ai < 2; ++ai)
#pragma unroll
            for (int m = 0; m < 4; ++m) { const bf16* rowp = h + (size_t)(row0 + ai * HALF + m * 16) * D + col0;
#pragma unroll
                for (int bj = 0; bj < 2; ++bj) { const u32x4 x = *(const u32x4*)(rowp + bj * HALF);
                    acc[ai][bj][m][0] = (f32x4){bflo(x.x), bfhi(x.x), bflo(x.y), bfhi(x.y)}; acc[ai][bj][m][1] = (f32x4){bflo(x.z), bfhi(x.z), bflo(x.w), bfhi(x.w)}; } }
    }
    __device__ __forceinline__ void operator()(const f32x4 (&acc)[2][2][4][2], const Unit& u, int wr, int wc, int fr, int fq) const {
        asm volatile("" : "+v"(fr), "+v"(fq));
        const int row0 = u.pm * BM + wr * 64 + fr, col0 = u.pn * BM + wc * 32 + 8 * fq;
#pragma unroll
        for (int ai = 0; ai < 2; ++ai)
#pragma unroll
            for (int m = 0; m < 4; ++m) { bf16* rowp = h + (size_t)(row0 + ai * HALF + m * 16) * D + col0;
#pragma unroll
                for (int bj = 0; bj < 2; ++bj) { const f32x4 v0 = acc[ai][bj][m][0], v1 = acc[ai][bj][m][1];
                    u32x4 w; w.x = cvt_pk_bf16(v0[0], v0[1]); w.y = cvt_pk_bf16(v0[2], v0[3]); w.z = cvt_pk_bf16(v1[0], v1[1]); w.w = cvt_pk_bf16(v1[2], v1[3]);
                    *(u32x4*)(rowp + bj * HALF) = w; } }
    } };
struct EpiGateUp { static constexpr bool PERM = true, ACC_INIT = false, SIGNAL = false; bf16* H;
    __device__ __forceinline__ void operator()(const f32x4 (&acc)[2][2][4][2], const Unit& u, int wr, int wc, int, int) const {
        const int t2 = lane_now(), fr = t2 & 15, fq = t2 >> 4;
        const int row0 = u.pm * BM + wr * 64 + fr, col0 = u.pn * HALF + wc * 32 + 8 * fq;
#pragma unroll
        for (int ai = 0; ai < 2; ++ai)
#pragma unroll
            for (int m = 0; m < 4; ++m) { bf16* rowp = H + (size_t)(row0 + ai * HALF + m * 16) * DE + col0; float v[8];
#pragma unroll
                for (int n = 0; n < 2; ++n)
#pragma unroll
                    for (int j = 0; j < 4; ++j) v[4 * n + j] = silu_(acc[ai][0][m][n][j]) * acc[ai][1][m][n][j];
                u32x4 w; w.x = cvt_pk_bf16(v[0], v[1]); w.y = cvt_pk_bf16(v[2], v[3]); w.z = cvt_pk_bf16(v[4], v[5]); w.w = cvt_pk_bf16(v[6], v[7]);
                *(u32x4*)rowp = w; }
    } };
struct EpiGateUpPub { static constexpr bool PERM = true, ACC_INIT = false, SIGNAL = true; __amdgpu_buffer_rsrc_t rs; unsigned* done;
    __device__ __forceinline__ void operator()(const f32x4 (&acc)[2][2][4][2], const Unit& u, int wr, int wc, int fr, int fq) const {
        asm volatile("" : "+v"(fr), "+v"(fq));
        const int row0 = u.pm * BM + wr * 64 + fr, col0 = u.pn * HALF + wc * 32 + 8 * fq;
#pragma unroll
        for (int ai = 0; ai < 2; ++ai)
#pragma unroll
            for (int m = 0; m < 4; ++m) { const unsigned off = (unsigned)(((row0 + ai * HALF + m * 16) * DE + col0) * 2); float v[8];
#pragma unroll
                for (int n = 0; n < 2; ++n)
#pragma unroll
                    for (int j = 0; j < 4; ++j) v[4 * n + j] = silu_(acc[ai][0][m][n][j]) * acc[ai][1][m][n][j];
                u32x4 w; w.x = cvt_pk_bf16(v[0], v[1]); w.y = cvt_pk_bf16(v[2], v[3]); w.z = cvt_pk_bf16(v[4], v[5]); w.w = cvt_pk_bf16(v[6], v[7]);
                __builtin_amdgcn_raw_buffer_store_b128(w, rs, off, 0, 16); }
    }
    __device__ __forceinline__ void signal(const Unit& u) const { (void)ag_add(done + u.pm, 1u); }
};
struct EpiPG { static constexpr bool PERM = true, ACC_INIT = false, SIGNAL = false; bf16* h; const bf16* PE; const float* rstd_pe; const float* norm_pe;
    __device__ __forceinline__ void operator()(const f32x4 (&acc)[2][2][4][2], const Unit& u, int wr, int wc, int fr, int fq) const {
        asm volatile("" : "+v"(fr), "+v"(fq));
        const int row0 = u.pm * BM + wr * 64 + fr, col0 = u.pn * BM + wc * 32 + 8 * fq;
        f32x4 nv[2][2];
#pragma unroll
        for (int bj = 0; bj < 2; ++bj)
#pragma unroll
            for (int n = 0; n < 2; ++n) nv[bj][n] = *(const f32x4*)(norm_pe + col0 + bj * HALF + 4 * n);
#pragma unroll
        for (int ai = 0; ai < 2; ++ai)
#pragma unroll
            for (int m = 0; m < 4; ++m) { const int row = row0 + ai * HALF + m * 16; const float rs = rstd_pe[row];
#pragma unroll
                for (int bj = 0; bj < 2; ++bj) { const size_t o = (size_t)row * D + col0 + bj * HALF; const u32x4 pe = *(const u32x4*)(PE + o); const u32x4 hx = *(const u32x4*)(h + o);
                    f32x4 h0 = (f32x4){bflo(hx.x), bfhi(hx.x), bflo(hx.y), bfhi(hx.y)}, h1 = (f32x4){bflo(hx.z), bfhi(hx.z), bflo(hx.w), bfhi(hx.w)}; const f32x4 a0 = acc[ai][bj][m][0], a1 = acc[ai][bj][m][1];
                    const f32x4 e0 = (f32x4){bflo(pe.x), bfhi(pe.x), bflo(pe.y), bfhi(pe.y)} * rs * nv[bj][0], e1 = (f32x4){bflo(pe.z), bfhi(pe.z), bflo(pe.w), bfhi(pe.w)} * rs * nv[bj][1];
                    h0 += (f32x4){sigmoid_(a0[0]), sigmoid_(a0[1]), sigmoid_(a0[2]), sigmoid_(a0[3])} * e0; h1 += (f32x4){sigmoid_(a1[0]), sigmoid_(a1[1]), sigmoid_(a1[2]), sigmoid_(a1[3])} * e1;
                    u32x4 w; w.x = pk2(h0[0], h0[1]); w.y = pk2(h0[2], h0[3]); w.z = pk2(h1[0], h1[1]); w.w = pk2(h1[2], h1[3]); *(u32x4*)(h + o) = w; } }
    } };

template <class Epi, class Sched>
__device__ __forceinline__ void gemm_phase(int wave, LAS unsigned char* lds, int K, const Sched& S, const Epi& E) {
    int wid = wave; asm volatile("" : "+s"(wid));
    const int lane = lane_now(), tid = (wid << 6) | lane, wr = wid >> 2, wc = wid & 3, fr = lane & 15, fq = lane >> 4;
    const int nt = K / BK;
    unsigned voffA[2], voffB[2];
#pragma unroll
    for (int i = 0; i < 2; ++i) { int R, C; stage_rc(tid * 16 + i * 8192, R, C); const int Rb = Epi::PERM ? ((R & ~31) + perm32(R & 31)) : R;
        voffA[i] = (unsigned)(R * K + C) * 2u; voffB[i] = (unsigned)(Rb * K + C) * 2u; }
    const size_t kstep = (size_t)(BK * 2);
    const size_t hstep = (size_t)HALF * K * 2;
    const unsigned ldsw = (unsigned)wid * 1024u;
    const int aoff = lds_byte(wr * 64 + fr, fq * 8), boff = lds_byte(wc * 32 + fr, fq * 8);
#define PG8_SA(b, h) (((b) * 2 + (h)) * HTB)
#define PG8_SB(b, h) ((4 + (b) * 2 + (h)) * HTB)
#define PG8_STAGE(bufoff, gbase, voff) do { _Pragma("unroll") for (int _i = 0; _i < 2; ++_i) \
        __builtin_amdgcn_global_load_lds((const unsigned*)((const char*)(gbase) + (voff)[_i]), (LAS unsigned*)(lds + (bufoff) + ldsw + _i * 8192), 16, 0, 0); } while (0)
#define PG8_LDA(dst, b, h) do { _Pragma("unroll") for (int m = 0; m < 4; ++m) _Pragma("unroll") for (int k = 0; k < 2; ++k) dst[m][k] = *(const LAS bf16x8*)(lds + PG8_SA(b, h) + aoff + m * 2048 + k * 1024); } while (0)
#define PG8_LDB(dst, b, h) do { _Pragma("unroll") for (int n = 0; n < 2; ++n) _Pragma("unroll") for (int k = 0; k < 2; ++k) dst[n][k] = *(const LAS bf16x8*)(lds + PG8_SB(b, h) + boff + n * 2048 + k * 1024); } while (0)
#define PG8_MMA(ai, bj, At, Bt) do { __builtin_amdgcn_s_setprio(1); _Pragma("unroll") for (int m = 0; m < 4; ++m) _Pragma("unroll") for (int n = 0; n < 2; ++n) _Pragma("unroll") for (int k = 0; k < 2; ++k) \
        acc[ai][bj][m][n] = __builtin_amdgcn_mfma_f32_16x16x32_bf16(Bt[n][k], At[m][k], acc[ai][bj][m][n], 0, 0, 0); __builtin_amdgcn_s_setprio(0); } while (0)
#define PG8_WAIT_V(n) asm volatile("s_waitcnt vmcnt(" #n ")" ::: "memory")
#define PG8_WAIT_L(n) asm volatile("s_waitcnt lgkmcnt(" #n ")" ::: "memory")
#define PG8_BAR __builtin_amdgcn_s_barrier()
#define PG8_SCHED __builtin_amdgcn_sched_barrier(0)
    Unit cur, nxt; int ui = 0;
    if (!S.next(0, cur)) return;
    if constexpr (Sched::DEPS) { S.wait(cur, wid); PG8_BAR; }
    f32x4 acc[2][2][4][2];
    if constexpr (Epi::ACC_INIT) E.init(acc, cur, wr, wc, fr, fq);
    else {
#pragma unroll
    for (int a = 0; a < 2; ++a)
#pragma unroll
        for (int b = 0; b < 2; ++b)
#pragma unroll
            for (int m = 0; m < 4; ++m)
#pragma unroll
                for (int n = 0; n < 2; ++n) acc[a][b][m][n] = (f32x4){0.f, 0.f, 0.f, 0.f}; }
    bf16x8 At[4][2], B0[2][2], B1[2][2];
    const char* cA = cur.A; const char* cB = cur.B;
    PG8_STAGE(PG8_SB(0, 0), cB, voffB); PG8_STAGE(PG8_SB(0, 1), cB + hstep, voffB); PG8_STAGE(PG8_SA(0, 0), cA, voffA); PG8_STAGE(PG8_SA(0, 1), cA + hstep, voffA);
    if (wr == 1) PG8_BAR;
    PG8_WAIT_V(2); PG8_BAR;
    PG8_STAGE(PG8_SB(1, 0), cB + kstep, voffB); PG8_STAGE(PG8_SA(1, 0), cA + kstep, voffA); PG8_STAGE(PG8_SB(1, 1), cB + hstep + kstep, voffB);
    PG8_WAIT_V(6); PG8_BAR;
    for (;;) {
        const bool has_next = S.next(ui + 1, nxt);
        const char* nA = has_next ? nxt.A : cA; const char* nB = has_next ? nxt.B : cB;
#pragma nounroll
        for (int t = 0; t < nt; t += 2) {
            const bool last = (t == nt - 2);
            if constexpr (Sched::DEPS) { if (last && has_next) S.wait(nxt, wid); }
            const char* a1 = cA + (size_t)(t + 1) * kstep;
            const char* a2 = last ? nA : cA + (size_t)(t + 2) * kstep; const char* b2 = last ? nB : cB + (size_t)(t + 2) * kstep;
            const char* a3 = a2 + kstep; const char* b3 = b2 + kstep;
            PG8_LDB(B0, 0, 0); PG8_LDB(B1, 0, 1); PG8_SCHED; PG8_LDA(At, 0, 0); PG8_STAGE(PG8_SA(1, 1), a1 + hstep, voffA);
            PG8_WAIT_V(8); PG8_WAIT_L(0); PG8_BAR; PG8_MMA(0, 0, At, B0); PG8_MMA(0, 1, At, B1); PG8_BAR; PG8_SCHED;
            PG8_LDA(At, 0, 1); PG8_STAGE(PG8_SB(0, 0), b2, voffB); PG8_STAGE(PG8_SB(0, 1), b2 + hstep, voffB); PG8_STAGE(PG8_SA(0, 0), a2, voffA);
            PG8_WAIT_V(8); PG8_WAIT_L(0); PG8_BAR; PG8_MMA(1, 0, At, B0); PG8_MMA(1, 1, At, B1); PG8_BAR; PG8_SCHED;
            PG8_LDB(B0, 1, 0); PG8_LDB(B1, 1, 1); PG8_SCHED; PG8_LDA(At, 1, 0); PG8_STAGE(PG8_SA(0, 1), a2 + hstep, voffA);
            PG8_WAIT_V(8); PG8_WAIT_L(0); PG8_BAR; PG8_MMA(0, 0, At, B0); PG8_MMA(0, 1, At, B1); PG8_BAR; PG8_SCHED;
            PG8_LDA(At, 1, 1); PG8_STAGE(PG8_SB(1, 0), b3, voffB); PG8_STAGE(PG8_SB(1, 1), b3 + hstep, voffB); PG8_STAGE(PG8_SA(1, 0), a3, voffA);
            PG8_WAIT_V(8); PG8_WAIT_L(0); PG8_BAR; PG8_MMA(1, 0, At, B0); PG8_MMA(1, 1, At, B1); PG8_BAR; PG8_SCHED;
        }
        if (wr == 0) PG8_BAR;
        E(acc, cur, wr, wc, fr, fq);
        if constexpr (Epi::SIGNAL) { PG8_WAIT_V(0); PG8_BAR; if (tid == 0) E.signal(cur); }
        if (!has_next) break;
        if constexpr (Epi::ACC_INIT) E.init(acc, nxt, wr, wc, fr, fq);
        else {
#pragma unroll
        for (int a = 0; a < 2; ++a)
#pragma unroll
            for (int b = 0; b < 2; ++b)
#pragma unroll
                for (int m = 0; m < 4; ++m)
#pragma unroll
                    for (int n = 0; n < 2; ++n) acc[a][b][m][n] = (f32x4){0.f, 0.f, 0.f, 0.f}; }
        cur = nxt; cA = nA; cB = nB; ++ui;
        if (wr == 1) PG8_BAR;
    }
    PG8_WAIT_V(0);
    PG8_BAR;
#undef PG8_SA
#undef PG8_SB
#undef PG8_STAGE
#undef PG8_LDA
#undef PG8_LDB
#undef PG8_MMA
#undef PG8_WAIT_V
#undef PG8_WAIT_L
#undef PG8_BAR
#undef PG8_SCHED
}
}

__device__ __forceinline__ void phase_gemm_pe(const Frame& F) {
    pg8::DenseOrder S; S.init(F.ws + WS_PB, F.ws + WS_WPE, T, D, PD, DEPTH, F.G, F.blk); pg8::EpiBf16 E{(bf16*)(F.ws + WS_PE), D};
    pg8::gemm_phase(F.wave, F.lds, PD, S, E);
}
__device__ __forceinline__ void phase_gemm_in(const Frame& F, int l) {
    pg8::DenseOrder S; S.init(F.ws + WS_XN, (bf16*)(F.ws + WS_WIN) + (size_t)l * DIN * D, T, DIN, D, 1, F.G, F.blk); pg8::EpiBf16 E{(bf16*)(F.ws + WS_Z), DIN};
    pg8::gemm_phase(F.wave, F.lds, D, S, E);
}
__device__ __forceinline__ void phase_gemm_out(const Frame& F, int l) {
    pg8::DenseOrder S; S.init(F.ws + WS_O, (bf16*)(F.ws + WS_WOUT) + (size_t)l * D * D, T, D, D, 1, F.G, F.blk); pg8::EpiResid E{(bf16*)(F.ws + WS_H)};
    pg8::gemm_phase(F.wave, F.lds, D, S, E);
}
__device__ __forceinline__ void phase_gemm_moe1(const Frame& F, int l) {
    pg8::MoeOrder S; S.init(F.ws + WS_XB, (bf16*)(F.ws + WS_WGU) + (size_t)l * NE * 1024 * 1024, (const int*)(F.ws + MS_BLKE) + l * 256, D, 4, (size_t)1024 * 1024 * 2, F.G, F.blk); pg8::EpiGateUp E{(bf16*)(F.ws + WS_HB)};
    pg8::gemm_phase(F.wave, F.lds, D, S, E);
    { const int nun = S.nrb * 4, rem = nun % F.G, few = (rem == 0 || F.G - rem < 64), idle = few ? F.G : F.G - rem, first = few ? 0 : rem;
      if (F.blk >= first) { pg8::DenseOrder P; P.init((const bf16*)(F.ws + WS_PB) + (size_t)l * T * PD, (const bf16*)(F.ws + WS_WPE) + (size_t)l * D * PD, T, D, PD, 1, idle, F.blk - first);
          pg8::EpiBf16 EP{(bf16*)(F.ws + WS_PE) + (size_t)l * T * D, D}; pg8::gemm_phase(F.wave, F.lds, PD, P, EP); }
      conv_deferred(F, l + 1, 0, NDEF1, first, idle); }
}
__device__ __forceinline__ void phase_gemm_moe2(const Frame& F, int l) {
    pg8::MoeOrder S; S.init(F.ws + WS_HB, (bf16*)(F.ws + WS_WD) + (size_t)l * NE * D * DE, (const int*)(F.ws + MS_BLKE) + l * 256, DE, 4, (size_t)D * DE * 2, F.G, F.blk); pg8::EpiBf16 E{(bf16*)(F.ws + WS_Y), D};
    pg8::gemm_phase(F.wave, F.lds, DE, S, E);
    { const int nun = S.nrb * 4, rem = nun % F.G, few = (rem == 0 || F.G - rem < 64), idle = few ? F.G : F.G - rem, first = few ? 0 : rem;
      conv_deferred(F, l + 1, NDEF1, NDEF, first, idle); }
}
#ifndef MOE_CPE
#define MOE_CPE 5
#endif
#ifndef MOE_CTL
#define MOE_CTL 4
#endif
#ifndef MOE_X1
#define MOE_X1 16
#define MOE_X2 8
#endif
template <int MODE = 0> __device__ __forceinline__ void phase_moe_fused(const Frame& F, int l) {
    unsigned char* ws = F.ws; const int G = F.G, blk = F.blk;
    const int* blke = (const int*)(ws + MS_BLKE) + l * 256;
    unsigned* done = (unsigned*)(ws + WS_CTL) + CW_DONE + l * 256;
    const int nrb = __builtin_amdgcn_readfirstlane(blke[255]), nu = 4 * nrb, e1 = nu % G;
    if constexpr (MODE == 1) { pg8::MoeOrder S; S.init(ws + WS_XB, (bf16*)(ws + WS_WGU) + (size_t)l * NE * 1024 * 1024, blke, D, 4, (size_t)1024 * 1024 * 2, G, blk);
      pg8::EpiGateUp E{(bf16*)(ws + WS_HB)}; pg8::gemm_phase(F.wave, F.lds, D, S, E); return; }
    if constexpr (MODE == 0) { pg8::MoeOrder S; S.init(ws + WS_XB, (bf16*)(ws + WS_WGU) + (size_t)l * NE * 1024 * 1024, blke, D, 4, (size_t)1024 * 1024 * 2, G, blk);
      pg8::EpiGateUpPub E{__builtin_amdgcn_make_buffer_rsrc(ws + WS_HB, 0, (int)((size_t)CAP * DE * 2), 0x00020000), done};
      pg8::gemm_phase(F.wave, F.lds, D, S, E); }
    if constexpr (MODE == 2) { pg8::MoeOrder S; S.init(ws + WS_HB, (bf16*)(ws + WS_WD) + (size_t)l * NE * D * DE, blke, DE, 4, (size_t)D * DE * 2, G, blk >= e1 ? blk - e1 : blk - e1 + G);
      pg8::EpiBf16 E{(bf16*)(ws + WS_Y), D}; pg8::gemm_phase(F.wave, F.lds, DE, S, E); }
    if constexpr (MODE == 0) { pg8::MoeDepOrder S; S.init(ws + WS_HB, (bf16*)(ws + WS_WD) + (size_t)l * NE * D * DE, blke, done, DE, 4, (size_t)D * DE * 2, G, blk >= e1 ? blk - e1 : blk - e1 + G);
      pg8::EpiBf16 E{(bf16*)(ws + WS_Y), D};
      pg8::gemm_phase(F.wave, F.lds, DE, S, E); }
    { const int nt = (l + 1 < DEPTH) ? NDEF : 0, ftot = 256 * MOE_CPE + nt * MOE_CTL;
      const int wrap = 2 * e1 > G ? 2 * e1 - G : 0;
      auto cls = [&](int x, int& c24, int& c16, int& c8, int& c0) {
          const int cA = x < e1 ? x : e1, cAB = x < wrap ? x : wrap;
          int cB = x - e1; cB = cB < 0 ? 0 : cB; if (!wrap) cB = cB > e1 ? e1 : cB; cB += cAB;
          c24 = cAB; c16 = cA - cAB; c8 = cB - cAB; c0 = x - c24 - c16 - c8; };
      auto fill = [&](int x, int lv) { int c24, c16, c8, c0; cls(x, c24, c16, c8, c0);
          return c0 * lv + c8 * (lv > MOE_X2 ? lv - MOE_X2 : 0) + c16 * (lv > MOE_X1 ? lv - MOE_X1 : 0) + c24 * (lv > MOE_X1 + MOE_X2 ? lv - MOE_X1 - MOE_X2 : 0); };
      int lv = 1; while (fill(G, lv) < ftot) ++lv;
      const int B0 = fill(blk, lv), B1 = fill(blk + 1, lv);
      const int pe_tot = 256 * MOE_CPE;
      int j0 = (B0 + MOE_CPE - 1) / MOE_CPE, j1 = (B1 + MOE_CPE - 1) / MOE_CPE; j0 = j0 < 256 ? j0 : 256; j1 = j1 < 256 ? j1 : 256;
      int t0 = B0 > pe_tot ? (B0 - pe_tot + MOE_CTL - 1) / MOE_CTL : 0, t1 = B1 > pe_tot ? (B1 - pe_tot + MOE_CTL - 1) / MOE_CTL : 0; t0 = t0 < nt ? t0 : nt; t1 = t1 < nt ? t1 : nt;
      if (j1 > j0) { pg8::RangeOrder P; P.init((const bf16*)(ws + WS_PB) + (size_t)l * T * PD, (const bf16*)(ws + WS_WPE) + (size_t)l * D * PD, T, D, PD, j0, j1 - j0);
          pg8::EpiBf16 EP{(bf16*)(ws + WS_PE) + (size_t)l * T * D, D}; pg8::gemm_phase(F.wave, F.lds, PD, P, EP); }
      if (t1 > t0) { const int base = (l + 1) * TL_LAYER + t0; conv_run(F, 0, 1, t1 - t0, [=](int f) { return base + f; }); } }
}
__device__ __forceinline__ void phase_gemm_pg(const Frame& F, int l) {
    pg8::DenseOrder S; S.init(F.ws + WS_XN, (bf16*)(F.ws + WS_WPG) + (size_t)l * D * D, T, D, D, 1, F.G, F.blk);
    pg8::EpiPG E{(bf16*)(F.ws + WS_H), (const bf16*)(F.ws + WS_PE) + (size_t)l * T * D, (const float*)(F.ws + MS_RSTDPE), F.in[22] + l * D};
    pg8::gemm_phase(F.wave, F.lds, D, S, E);
}

typedef short s16x4 __attribute__((ext_vector_type(4)));
__device__ __forceinline__ bf16x8 tr_frag(LAS unsigned char* p_lo, LAS unsigned char* p_hi) {
    const s16x4 lo = __builtin_amdgcn_ds_read_tr16_b64_v4i16((LAS s16x4*)p_lo), hi = __builtin_amdgcn_ds_read_tr16_b64_v4i16((LAS s16x4*)p_hi);
    return __builtin_shufflevector(lo, hi, 0, 1, 2, 3, 4, 5, 6, 7); }
#define MFMA16(a, b, c) __builtin_amdgcn_mfma_f32_16x16x32_bf16((a), (b), (c), 0, 0, 0)
constexpr int RP = 272;
constexpr int VP = 1040;

__device__ __forceinline__ void phase_rec_c1(const Frame& F, int l) {
    PH_TID();
    unsigned char* ws = F.ws; const bf16* Z = (const bf16*)(ws + WS_Z);
    bf16* UT = (bf16*)(ws + WS_UT); float* DC = (float*)(ws + MS_DC); float* MM = (float*)(ws + MS_MM);
    const float* lb = (const float*)(ws + MS_LB) + l * DREC;
    LAS unsigned char* KD = F.lds; LAS unsigned char* IM = F.lds + 128 * RP; LAS float* totx = (LAS float*)(F.lds + 256 * RP);
    const int wave = ph_wave, ch = tid & 255, half = tid >> 8, hl = ch >> 7, k = ch & 127, g = lane >> 4, li = lane & 15, q = li >> 2, p = li & 3;
    const int hG = F.G / 2, nmine = (F.G == 256) ? (F.blk < hG ? 4 : 0) : (F.blk < 512 ? (512 - F.blk + F.G - 1) / F.G : 0);
    const int ustep = (F.G == 256) ? hG : F.G;
    u32x4 pf[4], pi[4];
    auto fetch = [&](int unit) { const int c = unit >> 1, hp = unit & 1;
#pragma unroll
        for (int j = 0; j < 4; ++j) { const int idx = tid + 512 * j, hl2 = idx >> 10, row = (idx >> 4) & 63, cc = idx & 15;
            const bf16* src = Z + (size_t)(c * 64 + row) * DIN + 512 + (2 * hp + hl2) * 128 + cc * 8; pf[j] = *(const u32x4*)src; pi[j] = *(const u32x4*)(src + 512); } };
    if (nmine > 0) fetch(F.blk);
    for (int ui = 0; ui < nmine; ++ui) {
        const int unit = F.blk + ui * ustep;
        const int c = unit >> 1, hp = unit & 1, hh = 2 * hp + hl;
#pragma unroll
        for (int j = 0; j < 4; ++j) { const int idx = tid + 512 * j, hl2 = idx >> 10, row = (idx >> 4) & 63, cc = idx & 15; const int dst = (hl2 * 64 + row) * RP + cc * 16;
            *(LAS u32x4*)(KD + dst) = pf[j]; *(LAS u32x4*)(IM + dst) = pi[j]; }
        __syncthreads();
        if (ui + 1 < nmine) fetch(unit + ustep);
        const float lbk = lb[hh * 128 + k];
        float cs[32], kk[32]; float run = 1.f;
#pragma unroll
        for (int t = 0; t < 32; ++t) { const float fz = bf2f(*(const LAS bf16*)(KD + (hl * 64 + 32 * half + t) * RP + 2 * k)); const float sg = sigmoid_(fz); run *= lbk + (1.f - lbk) * sg; cs[t] = run; kk[t] = (1.f - lbk) * (1.f - sg); }
        totx[half * 256 + ch] = run;
        __syncthreads();
        const float other = totx[(1 - half) * 256 + ch]; const float p63 = run * other; const float base_p = half == 0 ? p63 : run;
#pragma unroll
        for (int t = 0; t < 32; ++t) *(LAS bf16*)(KD + (hl * 64 + 32 * half + t) * RP + 2 * k) = (bf16)f2bf(kk[t] * base_p * frcp(fmaxf(cs[t], 1e-30f)));
        if (half == 0) { DC[(c * 4 + hh) * 128 + k] = p63; MM[(c * 4 + hh) * 128 + k] = run; }
        __syncthreads();
        { const int whl = wave >> 2, kt0 = 2 * (wave & 3), whh = 2 * hp + whl;
          f32x4 acc[2][8];
#pragma unroll
          for (int i = 0; i < 2; ++i)
#pragma unroll
              for (int vt = 0; vt < 8; ++vt) acc[i][vt] = (f32x4){0.f, 0.f, 0.f, 0.f};
          LAS unsigned char* kdb = KD + whl * 64 * RP; LAS unsigned char* imb = IM + whl * 64 * RP;
#pragma unroll
          for (int a = 0; a < 2; ++a) { const unsigned ro = (unsigned)((32 * a + 8 * g + q) * RP);
              bf16x8 Af[2];
#pragma unroll
              for (int i = 0; i < 2; ++i) { const unsigned co = (unsigned)((16 * (kt0 + i) + 4 * p) * 2); Af[i] = tr_frag(kdb + ro + co, kdb + ro + 4 * RP + co); }
#pragma unroll
              for (int vt = 0; vt < 8; ++vt) { const unsigned co = (unsigned)((16 * vt + 4 * p) * 2); const bf16x8 Bf = tr_frag(imb + ro + co, imb + ro + 4 * RP + co);
#pragma unroll
                  for (int i = 0; i < 2; ++i) acc[i][vt] = MFMA16(Af[i], Bf, acc[i][vt]); } }
#pragma unroll
          for (int i = 0; i < 2; ++i)
#pragma unroll
              for (int vt = 0; vt < 8; ++vt) { u32x2 w; w.x = pg8::cvt_pk_bf16(acc[i][vt][0], acc[i][vt][1]); w.y = pg8::cvt_pk_bf16(acc[i][vt][2], acc[i][vt][3]);
                  *(u32x2*)(UT + ((size_t)(c * 4 + whh) * 128 + 16 * vt + li) * 128 + 16 * (kt0 + i) + 4 * g) = w; } }
        __syncthreads();
    }
}
__device__ __forceinline__ void phase_rec_c2a(const Frame& F) {
    PH_TID();
    unsigned char* ws = F.ws; const unsigned* UT = (const unsigned*)(ws + WS_UT); const float* DC = (const float*)(ws + MS_DC);
    f32x2* LT = (f32x2*)(ws + WS_LTOT); float* PT = (float*)(ws + MS_PTOT);
    for (int it = F.blk * NTHR + tid; it < 16 * 32768; it += F.G * NTHR) {
        const int gs = it >> 15, e = it & 32767, hh = e >> 13, v = (e >> 6) & 127, k0 = 2 * (e & 63);
        float S0 = 0.f, S1 = 0.f, P0 = 1.f, P1 = 1.f;
#pragma unroll
        for (int cc = 0; cc < 16; ++cc) { const int c = 16 * gs + cc; const unsigned u = UT[(size_t)c * 32768 + e]; const f32x2 d = *(const f32x2*)(DC + (c * 4 + hh) * 128 + k0);
            S0 = d.x * S0 + bflo(u); S1 = d.y * S1 + bfhi(u); P0 *= d.x; P1 *= d.y; }
        LT[it] = (f32x2){S0, S1};
        if (v == 0) *(f32x2*)(PT + (gs * 4 + hh) * 128 + k0) = (f32x2){P0, P1};
    }
}
__device__ __forceinline__ void phase_rec_c2c(const Frame& F) {
    PH_TID();
    unsigned char* ws = F.ws; const unsigned* UT = (const unsigned*)(ws + WS_UT); unsigned* ST = (unsigned*)(ws + WS_ST); const float* DC = (const float*)(ws + MS_DC); const float* MM = (const float*)(ws + MS_MM);
    const f32x2* LT = (const f32x2*)(ws + WS_LTOT); const float* PT = (const float*)(ws + MS_PTOT);
    for (int it = F.blk * NTHR + tid; it < 16 * 32768; it += F.G * NTHR) {
        const int gs = it >> 15, e = it & 32767, hh = e >> 13, k0 = 2 * (e & 63);
        float C0 = 0.f, C1 = 0.f;
        for (int g2 = 0; g2 < gs; ++g2) { const f32x2 pt = *(const f32x2*)(PT + (g2 * 4 + hh) * 128 + k0); const f32x2 lt = LT[g2 * 32768 + e]; C0 = pt.x * C0 + lt.x; C1 = pt.y * C1 + lt.y; }
#pragma unroll
        for (int cc = 0; cc < 16; ++cc) { const int c = 16 * gs + cc; const f32x2 mm = *(const f32x2*)(MM + (c * 4 + hh) * 128 + k0);
            ST[(size_t)c * 32768 + e] = pk2(C0 * mm.x, C1 * mm.y);
            const unsigned u = UT[(size_t)c * 32768 + e]; const f32x2 d = *(const f32x2*)(DC + (c * 4 + hh) * 128 + k0);
            C0 = d.x * C0 + bflo(u); C1 = d.y * C1 + bfhi(u); }
    }
}
__device__ __forceinline__ void phase_rec_c2(const Frame& F) {
    PH_TID();
    unsigned char* ws = F.ws; const int w = ph_wave;
    LAS float* tot = (LAS float*)F.lds;
    for (int unit = F.blk; unit < 256; unit += F.G) {
        const int hh = unit >> 6; const unsigned eo = (unsigned)(unit * 128 + lane), ko = (unsigned)(hh * 128 + 2 * lane);
        const unsigned* ut = (const unsigned*)(ws + WS_UT) + (size_t)(32 * w) * 32768; unsigned* st = (unsigned*)(ws + WS_ST) + (size_t)(32 * w) * 32768;
        const float* dc = (const float*)(ws + MS_DC) + (32 * w) * 512; const float* mmp = (const float*)(ws + MS_MM) + (32 * w) * 512;
        asm volatile("" : "+s"(ut), "+s"(st), "+s"(dc), "+s"(mmp));
        unsigned ua[32], ub[32]; f32x2 d[32], m0[16], m1[16];
#pragma unroll
        for (int cc = 0; cc < 32; ++cc) { ua[cc] = (ut + cc * 32768)[eo]; ub[cc] = (ut + cc * 32768 + 64)[eo]; d[cc] = *(const f32x2*)((dc + cc * 512) + ko); }
        __builtin_amdgcn_sched_barrier(0);
        float a0 = 0.f, a1 = 0.f, b0 = 0.f, b1 = 0.f, p0 = 1.f, p1 = 1.f;
#pragma unroll
        for (int cc = 0; cc < 32; ++cc) { a0 = d[cc].x * a0 + bflo(ua[cc]); a1 = d[cc].y * a1 + bfhi(ua[cc]); b0 = d[cc].x * b0 + bflo(ub[cc]); b1 = d[cc].y * b1 + bfhi(ub[cc]); p0 *= d[cc].x; p1 *= d[cc].y; }
        { LAS float* tw = tot + w * 384 + lane; tw[0] = a0; tw[64] = a1; tw[128] = b0; tw[192] = b1; tw[256] = p0; tw[320] = p1; }
        __builtin_amdgcn_sched_barrier(0);
#pragma unroll
        for (int cc = 0; cc < 16; ++cc) m0[cc] = *(const f32x2*)((mmp + cc * 512) + ko);
        __builtin_amdgcn_sched_barrier(0);
        __syncthreads();
        float A0 = 0.f, A1 = 0.f, B0 = 0.f, B1 = 0.f;
        for (int g2 = 0; g2 < w; ++g2) { const LAS float* tw = tot + g2 * 384 + lane; const float q0 = tw[256], q1 = tw[320]; A0 = q0 * A0 + tw[0]; A1 = q1 * A1 + tw[64]; B0 = q0 * B0 + tw[128]; B1 = q1 * B1 + tw[192]; }
        __builtin_amdgcn_sched_barrier(0);
#pragma unroll
        for (int cc = 0; cc < 16; ++cc) m1[cc] = *(const f32x2*)((mmp + (16 + cc) * 512) + ko);
        __builtin_amdgcn_sched_barrier(0);
#pragma unroll
        for (int cc = 0; cc < 32; ++cc) { const f32x2 mm = cc < 16 ? m0[cc & 15] : m1[cc & 15];
            (st + cc * 32768)[eo] = pk2(A0 * mm.x, A1 * mm.y); (st + cc * 32768 + 64)[eo] = pk2(B0 * mm.x, B1 * mm.y);
            unsigned xa = ua[cc], xb = ub[cc]; asm volatile("" : "+v"(xa), "+v"(xb));
            A0 = d[cc].x * A0 + bflo(xa); A1 = d[cc].y * A1 + bfhi(xa); B0 = d[cc].x * B0 + bflo(xb); B1 = d[cc].y * B1 + bfhi(xb);
            asm volatile("" : "+v"(A0), "+v"(A1), "+v"(B0), "+v"(B1) :: "memory"); }
        __syncthreads();
    }
}
template <int PV = 0> __device__ __forceinline__ void phase_rec_c3(const Frame& F, int l) {
    PH_TID();
    unsigned char* ws = F.ws; const bf16* Z = (const bf16*)(ws + WS_Z); const bf16* ST = (const bf16*)(ws + WS_ST); bf16* O = (bf16*)(ws + WS_O);
    const float* lb = (const float*)(ws + MS_LB) + l * DREC; const float* ogain = F.in[5] + l * 128;
    LAS unsigned char* QT = F.lds; LAS unsigned char* KT = F.lds + 128 * RP; LAS unsigned char* IM = F.lds + 256 * RP;
    const int wave = ph_wave, ch = tid & 255, half = tid >> 8, hl = ch >> 7, k = ch & 127, g = lane >> 4, li = lane & 15, q = li >> 2, p = li & 3;
    u32x4 pq[4], pf[4];
    const unsigned tvo = (unsigned)((tid >> 4) * DIN + (tid & 15) * 8), tlo = (unsigned)((tid >> 4) * RP + (tid & 15) * 16);
    auto fetch = [&](int unit) { const bf16* zc = Z + (size_t)(unit >> 1) * 64 * DIN + (unit & 1) * 256;
#pragma unroll
        for (int j = 0; j < 4; ++j) { const bf16* src = zc + (32 * (j & 1)) * DIN + (j >> 1) * 128; pq[j] = *(const u32x4*)(src + tvo); pf[j] = *(const u32x4*)(src + 512 + tvo); } };
    if (F.blk < 512) fetch(F.blk);
    for (int unit = F.blk; unit < 512; unit += F.G) {
        const int c = unit >> 1, hp = unit & 1, hh = 2 * hp + hl;
#pragma unroll
        for (int j = 0; j < 4; ++j) { const int dst = ((j >> 1) * 64 + 32 * (j & 1)) * RP;
            *(LAS u32x4*)(QT + dst + tlo) = pq[j]; *(LAS u32x4*)(KT + dst + tlo) = pf[j]; }
        u32x4 vi[4];
        { const bf16* zc = Z + (size_t)c * 64 * DIN + hp * 256 + 1024;
#pragma unroll
          for (int j = 0; j < 4; ++j) vi[j] = *(const u32x4*)(zc + (32 * (j & 1)) * DIN + (j >> 1) * 128 + tvo); }
        __syncthreads();
        { const float lbk = lb[hh * 128 + k]; const int col = (hl * 64 + 32 * half) * RP + 2 * k;
          float cs[32], kk[32], qs[32]; float run = 1.f;
#pragma unroll
          for (int t = 0; t < 32; ++t) { const float fz = bf2f(*(const LAS bf16*)(KT + col + t * RP)); const float sg = sigmoid_(fz); run *= lbk + (1.f - lbk) * sg; cs[t] = run; kk[t] = (1.f - lbk) * (1.f - sg);
              qs[t] = silu_(bf2f(*(const LAS bf16*)(QT + col + t * RP))); }
          const float inv = half == 0 ? frcp(fmaxf(run, 1e-30f)) : 1.f;
#pragma unroll
          for (int t = 0; t < 32; ++t) { const float ex = cs[t] * inv; const int off = col + t * RP;
              *(LAS bf16*)(QT + off) = (bf16)f2bf(qs[t] * ex); *(LAS bf16*)(KT + off) = (bf16)f2bf(kk[t] * frcp(fmaxf(ex, 1e-30f))); } }
#pragma unroll
        for (int j = 0; j < 4; ++j) *(LAS u32x4*)(IM + ((j >> 1) * 64 + 32 * (j & 1)) * RP + tlo) = vi[j];
        const int whl = wave >> 2, tt = wave & 3, whh = 2 * hp + whl;
        bf16x8 Sf[8][4];
#pragma unroll
        for (int vt = 0; vt < 8; ++vt)
#pragma unroll
            for (int a = 0; a < 4; ++a) Sf[vt][a] = *(const bf16x8*)(ST + ((size_t)(c * 4 + whh) * 128 + 16 * vt + li) * 128 + 32 * a + 8 * g);
        __syncthreads();
        if (PV != 1) {
          bf16 gz[8][4];
#pragma unroll
          for (int vt = 0; vt < 8; ++vt)
#pragma unroll
              for (int r = 0; r < 4; ++r) gz[vt][r] = Z[((size_t)c * 64 + 16 * tt + 4 * g + r) * DIN + 1536 + whh * 128 + 16 * vt + li];
          bf16x8 Qf[4];
#pragma unroll
          for (int a = 0; a < 4; ++a) Qf[a] = *(const LAS bf16x8*)(QT + (whl * 64 + 16 * tt + li) * RP + (32 * a + 8 * g) * 2);
          unsigned pw[4][2];
#pragma unroll
          for (int st = 0; st < 4; ++st) { pw[st][0] = 0u; pw[st][1] = 0u;
              { f32x4 s = (f32x4){0.f, 0.f, 0.f, 0.f};
#pragma unroll
                  for (int a = 0; a < 4; ++a) { const bf16x8 Kf = *(const LAS bf16x8*)(KT + (whl * 64 + 16 * st + li) * RP + (32 * a + 8 * g) * 2); s = MFMA16(Kf, Qf[a], s); }
                  if (st == tt) {
#pragma unroll
                      for (int r = 0; r < 4; ++r) if (4 * g + r > li) s[r] = 0.f; }
                  pw[st][0] = st <= tt ? pg8::cvt_pk_bf16(s[0], s[1]) : 0u; pw[st][1] = st <= tt ? pg8::cvt_pk_bf16(s[2], s[3]) : 0u; } }
          f32x4 acc[8];
#pragma unroll
          for (int vt = 0; vt < 8; ++vt) { acc[vt] = (f32x4){0.f, 0.f, 0.f, 0.f};
#pragma unroll
              for (int a = 0; a < 4; ++a) acc[vt] = MFMA16(Qf[a], Sf[vt][a], acc[vt]); }
          __builtin_amdgcn_sched_barrier(0);
          if (unit + F.G < 512) fetch(unit + F.G);
          __builtin_amdgcn_sched_barrier(0);
          LAS unsigned char* imb = IM + whl * 64 * RP;
#pragma unroll
          for (int a = 0; a < 2; ++a) { const u32x4 pv = (u32x4){pw[2 * a][0], pw[2 * a][1], pw[2 * a + 1][0], pw[2 * a + 1][1]}; const bf16x8 Pf = __builtin_bit_cast(bf16x8, pv);
              const unsigned ro = (unsigned)((32 * a + 4 * g + q) * RP);
#pragma unroll
              for (int vt = 0; vt < 8; ++vt) { const unsigned co = (unsigned)((16 * vt + 4 * p) * 2); const bf16x8 If = tr_frag(imb + ro + co, imb + ro + 16 * RP + co); acc[vt] = MFMA16(Pf, If, acc[vt]); } }
          float rs[4];
#pragma unroll
          for (int r = 0; r < 4; ++r) { float ss = 0.f;
#pragma unroll
              for (int vt = 0; vt < 8; ++vt) ss += acc[vt][r] * acc[vt][r];
              ss += shx<1>(ss); ss += shx<2>(ss); ss += shx<4>(ss); ss += shx<8>(ss); rs[r] = frsq(ss * (1.f / 128.f) + EPS); }
#pragma unroll
          for (int vt = 0; vt < 8; ++vt) { const float og = ogain[16 * vt + li];
#pragma unroll
              for (int r = 0; r < 4; ++r) { const size_t t = (size_t)c * 64 + 16 * tt + 4 * g + r; const float gv = bf2f(gz[vt][r]);
                  O[t * D + whh * 128 + 16 * vt + li] = (bf16)f2bf(acc[vt][r] * rs[r] * og * silu_(gv)); } } }
        __syncthreads();
    }
}
__device__ __forceinline__ void phase_sgu(const Frame& F, int l) {
    PH_TID();
    unsigned char* ws = F.ws; const bf16* Z = (const bf16*)(ws + WS_Z); bf16* O = (bf16*)(ws + WS_O);
    const bf16* Wb = (const bf16*)(ws + MS_SGUW) + (size_t)l * 4 * 128 * 128; const float* sb = F.in[9] + l * 4 * 128;
    LAS unsigned char* VN = F.lds;
    const int wave = ph_wave, g = lane >> 4, li = lane & 15, q = li >> 2, p = li & 3;
    for (int unit = (F.blk + F.G / 2) % F.G; unit < 128; unit += F.G) {
        float lg[8], lbv[8];
#pragma unroll
        for (int j = 0; j < 8; ++j) { lg[j] = F.in[6][l * DSGU + 8 * lane + j]; lbv[j] = F.in[7][l * DSGU + 8 * lane + j]; }
        u32x4 raw[16];
#pragma unroll
        for (int i = 0; i < 16; ++i) raw[i] = *(const u32x4*)(Z + ((size_t)unit * 128 + 16 * wave + i) * DIN + 2560 + 8 * lane);
#pragma unroll
        for (int i = 0; i < 16; ++i) { const int s = 16 * wave + i; const u32x4 r = raw[i];
            float x[8] = {gelu_(bflo(r.x)), gelu_(bfhi(r.x)), gelu_(bflo(r.y)), gelu_(bfhi(r.y)), gelu_(bflo(r.z)), gelu_(bfhi(r.z)), gelu_(bflo(r.w)), gelu_(bfhi(r.w))};
            float sm = 0.f, qq = 0.f;
#pragma unroll
            for (int j = 0; j < 8; ++j) { sm += x[j]; qq += x[j] * x[j]; }
            sm += shx<1>(sm); qq += shx<1>(qq); sm += shx<2>(sm); qq += shx<2>(qq); sm += shx<4>(sm); qq += shx<4>(qq); sm += shx<8>(sm); qq += shx<8>(qq); sm += shx<16>(sm); qq += shx<16>(qq);
            const float mu = halves_sum(sm) * (1.f / 512.f); const float var = fmaxf(halves_sum(qq) * (1.f / 512.f) - mu * mu, 0.f);
            const float rstd = frsq(var + EPS);
#pragma unroll
            for (int j = 0; j < 8; ++j) x[j] = (x[j] - mu) * rstd * lg[j] + lbv[j];
            u32x4 o; o.x = pk2(x[0], x[1]); o.y = pk2(x[2], x[3]); o.z = pk2(x[4], x[5]); o.w = pk2(x[6], x[7]);
            *(LAS u32x4*)(VN + s * VP + lane * 16) = o; }
        __syncthreads();
        { const int hh = wave >> 1, dh = wave & 1; const bf16* W = Wb + (size_t)hh * 128 * 128;
          LAS unsigned char* vnb = VN;
#pragma unroll 1
          for (int dp = 0; dp < 2; ++dp) {
          bf16x8 Wf[2][8];
#pragma unroll
          for (int a = 0; a < 2; ++a)
#pragma unroll
              for (int ti = 0; ti < 8; ++ti) if (ti >= 2 * a) Wf[a][ti] = *(const bf16x8*)(W + (size_t)(16 * ti + li) * 128 + 32 * a + 8 * g);
          u32x2 uu[8][2]; float bs[8];
#pragma unroll
          for (int ti = 0; ti < 8; ++ti) { bs[ti] = sb[hh * 128 + 16 * ti + li];
#pragma unroll
              for (int dt = 0; dt < 2; ++dt) uu[ti][dt] = *(const u32x2*)(Z + ((size_t)unit * 128 + 16 * ti + li) * DIN + 2048 + hh * 128 + 64 * dh + 16 * (2 * dp + dt) + 4 * g); }
          f32x4 acc[2][8];
#pragma unroll
          for (int dt = 0; dt < 2; ++dt)
#pragma unroll
              for (int ti = 0; ti < 8; ++ti) acc[dt][ti] = (f32x4){0.f, 0.f, 0.f, 0.f};
#pragma unroll
          for (int a = 0; a < 4; ++a) { const unsigned ro = (unsigned)((32 * a + 8 * g + q) * VP);
              bf16x8 Af[2];
#pragma unroll
              for (int dt = 0; dt < 2; ++dt) { const unsigned co = (unsigned)((hh * 128 + 64 * dh + 16 * (2 * dp + dt) + 4 * p) * 2); Af[dt] = tr_frag(vnb + ro + co, vnb + ro + 4 * VP + co); }
#pragma unroll
              for (int ti = 0; ti < 8; ++ti) if (ti >= 2 * a) {
                  const bf16x8 Bf = a < 2 ? Wf[a < 2 ? a : 0][ti] : *(const bf16x8*)(W + (size_t)(16 * ti + li) * 128 + 32 * a + 8 * g);
#pragma unroll
                  for (int dt = 0; dt < 2; ++dt) acc[dt][ti] = MFMA16(Af[dt], Bf, acc[dt][ti]); } }
#pragma unroll
          for (int ti = 0; ti < 8; ++ti) { const size_t t = (size_t)unit * 128 + 16 * ti + li; const float bias = bs[ti];
#pragma unroll
              for (int dt = 0; dt < 2; ++dt) { const int col = hh * 128 + 64 * dh + 16 * (2 * dp + dt) + 4 * g; const u32x2 u = uu[ti][dt];
                  u32x2 w; w.x = pk2((acc[dt][ti][0] + bias) * gelu_(bflo(u.x)), (acc[dt][ti][1] + bias) * gelu_(bfhi(u.x))); w.y = pk2((acc[dt][ti][2] + bias) * gelu_(bflo(u.y)), (acc[dt][ti][3] + bias) * gelu_(bfhi(u.y)));
                  *(u32x2*)(O + t * D + 512 + col) = w; } } } }
        __syncthreads();
    }
}

#define XB_TMO      128
#define XB_XCNT(j)  (256  + 64 * (j))
#define XB_XSUB(j)  (1280 + 64 * (j))
#define XB_XGEN(j)  (2304 + 64 * (j))
#define XB_TOP      3328
#define XB_TOPGEN   3392
#define XCD_BAR_WORDS 3456
#define XB_SPIN_CAP (1u << 18)
__device__ __forceinline__ unsigned xb_ld(unsigned* p)              { return __hip_atomic_load(p, __ATOMIC_RELAXED, __HIP_MEMORY_SCOPE_AGENT); }
__device__ __forceinline__ unsigned xb_add(unsigned* p, unsigned v) { return __hip_atomic_fetch_add(p, v, __ATOMIC_RELAXED, __HIP_MEMORY_SCOPE_AGENT); }
__device__ __forceinline__ unsigned xb_xcc_id() { return (unsigned)__builtin_amdgcn_s_getreg((3 << 11) | 20) & 0xFu; }
#define XB_SPIN(cond, bar) do { unsigned _sp = 0; while (cond) { __builtin_amdgcn_s_sleep(1); \
    if ((++_sp & 255u) == 0u) { if (xb_ld(&(bar)[XB_TMO])) break; if (_sp > XB_SPIN_CAP) { atomicAdd(&(bar)[XB_TMO], 1u); break; } } } } while (0)
struct XcdBarrier { unsigned* bar; unsigned x; volatile LAS unsigned* st; int wave; };
__device__ __forceinline__ XcdBarrier xcd_barrier_post(unsigned* bar, volatile LAS unsigned* st, int wave) {
    XcdBarrier b; b.bar = bar; b.x = xb_xcc_id(); b.st = st; b.wave = wave;
    if (wave == 0 && lane_now() == 0) (void)xb_add(&bar[XB_XCNT(b.x)], 1u);
    return b;
}
__device__ __forceinline__ void xcd_barrier_complete(unsigned* bar, unsigned x, unsigned& nloc, unsigned& nx) {
    const unsigned G = gridDim.x * gridDim.y * gridDim.z;
    unsigned sum, cnt, mine, sp = 0u;
    for (;;) {
        sum = 0u; cnt = 0u; mine = 0u;
#pragma unroll
        for (unsigned j = 0; j < 16; ++j) { const unsigned c = xb_ld(&bar[XB_XCNT(j)]); sum += c; cnt += (c > 0u) ? 1u : 0u; mine = (j == x) ? c : mine; }
        if (sum == G) break;
        __builtin_amdgcn_s_sleep(1);
        if ((++sp & 255u) == 0u) { if (xb_ld(&bar[XB_TMO])) break; if (sp > XB_SPIN_CAP) { atomicAdd(&bar[XB_TMO], 1u); break; } }
    }
    nloc = mine > 0u ? mine : 1u; nx = cnt > 0u ? cnt : 1u;
}
__device__ __forceinline__ void xcd_barrier(const XcdBarrier& b) {
    asm volatile("s_waitcnt vmcnt(0)" ::: "memory");
    __syncthreads();
    if (b.wave == 0 && lane_now() == 0) {
        unsigned* bar = b.bar;
        __builtin_amdgcn_s_waitcnt(0);
        unsigned nloc = b.st[0], nx = b.st[1];
        if (nloc == 0u) { xcd_barrier_complete(bar, b.x, nloc, nx); b.st[0] = nloc; b.st[1] = nx; }
        const unsigned old = xb_add(&bar[XB_XSUB(b.x)], 1u);
        const unsigned gen = old / nloc;
        if (old + 1u == (gen + 1u) * nloc) {
            __builtin_amdgcn_fence(__ATOMIC_RELEASE, "agent");
            asm volatile("s_waitcnt vmcnt(0)" ::: "memory");
            const unsigned og = xb_add(&bar[XB_TOP], 1u);
            const unsigned tg = og / nx;
            if (og + 1u == (tg + 1u) * nx) xb_add(&bar[XB_TOPGEN], 1u);
            else XB_SPIN(xb_ld(&bar[XB_TOPGEN]) == tg, bar);
            __builtin_amdgcn_fence(__ATOMIC_ACQUIRE, "agent");
            xb_add(&bar[XB_XGEN(b.x)], 1u);
            asm volatile("s_waitcnt vmcnt(0)" ::: "memory");
        } else {
            XB_SPIN(xb_ld(&bar[XB_XGEN(b.x)]) == gen, bar);
            __builtin_amdgcn_fence(__ATOMIC_ACQUIRE, "agent");
            asm volatile("s_waitcnt vmcnt(0)" ::: "memory");
        }
    }
    __syncthreads();
}


__device__ __forceinline__ void xcd_barrier_bg(const XcdBarrier& b, const Frame& F, int lnext, bool drain) {
    asm volatile("s_waitcnt vmcnt(0)" ::: "memory");
    __syncthreads();
    volatile LAS unsigned* sx = b.st + 4;
    unsigned* q = (unsigned*)(F.ws + WS_CTL) + CW_BGQ + lnext * 64;
    if (b.wave == 0 && lane_now() == 0) {
        unsigned* bar = b.bar;
        __builtin_amdgcn_s_waitcnt(0);
        unsigned nloc = b.st[0], nx = b.st[1];
        if (nloc == 0u) { xcd_barrier_complete(bar, b.x, nloc, nx); b.st[0] = nloc; b.st[1] = nx; }
        const unsigned old = xb_add(&bar[XB_XSUB(b.x)], 1u);
        const unsigned gen = old / nloc;
        const bool leader = (old + 1u == (gen + 1u) * nloc);
        unsigned ti = 0u; if (!leader) { const unsigned k = xb_add(q, 1u); if (k < (unsigned)NBG) ti = k + 1u; }
        sx[0] = leader ? 1u : 0u; sx[1] = gen; sx[2] = ti;
    }
    __syncthreads();
    if (__builtin_amdgcn_readfirstlane(sx[0]) == 0u) {
        unsigned ti = (unsigned)__builtin_amdgcn_readfirstlane(sx[2]);
        while (ti != 0u) {
            const int it = lnext * TL_LAYER + NDEF + (int)ti - 1;
            conv_run(F, 0, 1, 1, [=](int) { return it; });
            if (!drain) break;
            if (b.wave == 0 && lane_now() == 0) { const unsigned k = xb_add(q, 1u); sx[2] = k < (unsigned)NBG ? k + 1u : 0u; }
            __syncthreads();
            ti = (unsigned)__builtin_amdgcn_readfirstlane(sx[2]);
            __syncthreads();
        }
    }
    if (b.wave == 0 && lane_now() == 0) {
        unsigned* bar = b.bar; const unsigned gen = sx[1], nx = b.st[1];
        asm volatile("s_waitcnt vmcnt(0)" ::: "memory");
        if (sx[0] != 0u) {
            __builtin_amdgcn_fence(__ATOMIC_RELEASE, "agent");
            asm volatile("s_waitcnt vmcnt(0)" ::: "memory");
            const unsigned og = xb_add(&bar[XB_TOP], 1u);
            const unsigned tg = og / nx;
            if (og + 1u == (tg + 1u) * nx) xb_add(&bar[XB_TOPGEN], 1u);
            else XB_SPIN(xb_ld(&bar[XB_TOPGEN]) == tg, bar);
            __builtin_amdgcn_fence(__ATOMIC_ACQUIRE, "agent");
            xb_add(&bar[XB_XGEN(b.x)], 1u);
            asm volatile("s_waitcnt vmcnt(0)" ::: "memory");
        } else {
            XB_SPIN(xb_ld(&bar[XB_XGEN(b.x)]) == gen, bar);
            __builtin_amdgcn_fence(__ATOMIC_ACQUIRE, "agent");
            asm volatile("s_waitcnt vmcnt(0)" ::: "memory");
        }
    }
    __syncthreads();
}

__device__ __forceinline__ bool opq(Frame& F) { asm volatile("" : "+s"(F.ws), "+s"(F.blk), "+s"(F.out), "+s"(F.G)); return true; }
__device__ __forceinline__ int lq_(int l) { asm volatile("" : "+s"(l)); return l; }
__global__ void __launch_bounds__(NTHR, 2) k_mega(Params p) {
    extern __shared__ __attribute__((aligned(16))) unsigned char lds[];
    Frame F; F.lds = (LAS unsigned char*)lds; F.ws = p.ws; F.in = p.in; F.out = p.out; F.wave = __builtin_amdgcn_readfirstlane(threadIdx.x >> 6); F.blk = blockIdx.x; F.G = gridDim.x;
    volatile LAS unsigned* st = (volatile LAS unsigned*)(F.lds + LDS_BYTES - 32);
    if (threadIdx.x < 8) st[threadIdx.x] = 0u;
    __syncthreads();
#if USE_CG_SYNC
#define GRID_BAR() cooperative_groups::this_grid().sync()
#else
    const XcdBarrier bar = xcd_barrier_post((unsigned*)(p.ws + WS_CTL) + CW_BAR + p.li * XCD_BAR_WORDS, st, F.wave);
#define GRID_BAR() xcd_barrier(bar)
#endif
    const int lo = p.ph_lo, hi = p.ph_hi;
#define RUN(k) (lo <= (k) && (k) < hi && opq(F))
#define SEAM(k) do { if (RUN(k) && RUN((k) + 1)) GRID_BAR(); } while (0)
#define SEAM_BG(k, drain) do { if (RUN(k) && RUN((k) + 1)) { if (!USE_CG_SYNC && l + 1 < DEPTH) xcd_barrier_bg(bar, F, l + 1, drain); else GRID_BAR(); } } while (0)
    if (RUN(0)) { phase_prologue(F); if (PROBE_DUP & 16) { __syncthreads(); phase_prologue(F); } }
    SEAM(0);
    for (int l = 0; l < DEPTH; ++l) {
        const int b = 2 + 13 * l;
        if (RUN(b + 0)) phase_norm1(F, lq_(l));
        SEAM_BG(b + 0, false);
        if (RUN(b + 1)) phase_gemm_in(F, lq_(l));
        SEAM_BG(b + 1, false);
        if (RUN(b + 2)) { phase_rec_c1(F, lq_(l)); phase_sgu(F, lq_(l)); if (PROBE_DUP & 1) { __syncthreads(); phase_rec_c1(F, lq_(l)); phase_sgu(F, lq_(l)); } if (PROBE_DUP & 64) { __syncthreads(); phase_sgu(F, lq_(l)); } }
        SEAM_BG(b + 2, false);
        if (RUN(b + 3)) { phase_rec_c2(F); if (PROBE_DUP & 4) phase_rec_c2(F); }
        SEAM_BG(b + 3, false);
        if (RUN(b + 5)) { phase_rec_c3(F, lq_(l)); if (PROBE_DUP & 2) { __syncthreads(); phase_rec_c3(F, lq_(l)); } if (PROBE_DUP & 128) { __syncthreads(); phase_rec_c3<1>(F, lq_(l)); } }
        SEAM_BG(b + 5, false);
        if (RUN(b + 6)) phase_gemm_out(F, lq_(l));
        SEAM_BG(b + 6, false);
        if (RUN(b + 7)) phase_norm2(F, lq_(l));
        SEAM_BG(b + 7, false);
        if (RUN(b + 8)) { phase_gather(F, lq_(l)); if (PROBE_DUP & 8) { __syncthreads(); phase_gather(F, lq_(l)); } }
        SEAM_BG(b + 8, false);
#if MOE_FUSED == 1
        if (RUN(b + 9)) phase_moe_fused(F, lq_(l));
        SEAM_BG(b + 9, false);
#elif MOE_FUSED == 2
        if (RUN(b + 9)) phase_moe_fused<1>(F, lq_(l));
        SEAM_BG(b + 9, false);
        if (RUN(b + 10)) phase_moe_fused<2>(F, lq_(l));
        SEAM_BG(b + 10, false);
#else
        if (RUN(b + 9)) phase_gemm_moe1(F, lq_(l));
        SEAM_BG(b + 9, false);
        if (RUN(b + 10)) phase_gemm_moe2(F, lq_(l));
        SEAM_BG(b + 10, false);
#endif
        if (RUN(b + 11)) phase_combine(F, lq_(l));
        SEAM_BG(b + 11, true);
        if (RUN(b + 12)) phase_gemm_pg(F, lq_(l));
        SEAM(b + 12);
    }
    if (RUN(54)) phase_final(F);
#undef RUN
#undef SEAM
}

#ifndef ONE_LAUNCH
#define ONE_LAUNCH 1
#endif
#ifndef CUTS
#define CUTS {0, 55}
#endif
#ifndef MFMA_MASK
#define MFMA_MASK 255
#endif
extern "C" void kernel_launch(void* const* d_in, const int* in_sizes, int n_in, void* d_out, int out_size, void* d_ws, size_t ws_size, hipStream_t stream) {
    if (n_in != 24 || out_size != T * D || ws_size < WS_END) { fprintf(stderr, "kernel_launch: unexpected shapes (n_in %d out %d ws %zu)\n", n_in, out_size, ws_size); return; }
    static_assert(CW_BAR + 60 * XCD_BAR_WORDS <= (int)(CTL_BYTES / 4), "barrier regions inside the zeroed control words");
    Params p{}; for (int i = 0; i < 24; ++i) p.in[i] = (const float*)d_in[i]; p.out = (float*)d_out; p.ws = (unsigned char*)d_ws;
    unsigned char* ws = p.ws;
    (void)hipMemsetAsync(ws + WS_CTL, 0, CTL_BYTES, stream);
    { static bool attr = false; if (!attr) { (void)hipFuncSetAttribute((const void*)k_mega, hipFuncAttributeMaxDynamicSharedMemorySize, LDS_BYTES); attr = true; }
      const int cuts[] = CUTS; const int ncut = (int)(sizeof(cuts) / sizeof(cuts[0]));
      for (int i = 0; i + 1 < ncut; ++i) { p.ph_lo = cuts[i]; p.ph_hi = cuts[i + 1]; p.li = i; p.pad = 0;
#if USE_CG_SYNC
          void* args[] = {&p}; hipError_t e = hipLaunchCooperativeKernel((const void*)k_mega, dim3(256), dim3(NTHR), args, LDS_BYTES, stream);
          if (e != hipSuccess) fprintf(stderr, "cooperative launch failed: %s\n", hipGetErrorName(e));
#else
          hipLaunchKernelGGL(k_mega, dim3(256), dim3(NTHR), LDS_BYTES, stream, p);
#endif
      }
    }
}
```

```cpp
#include <hip/hip_runtime.h>
#include <hip/hip_cooperative_groups.h>
#include <cstdio>
#include <cstdint>

#define GAS __attribute__((address_space(1)))
#define LAS __attribute__((address_space(3)))
typedef unsigned short bf16;
typedef float f32x4 __attribute__((ext_vector_type(4)));
typedef float f32x2 __attribute__((ext_vector_type(2)));
typedef unsigned u32x4 __attribute__((ext_vector_type(4)));
typedef unsigned u32x2 __attribute__((ext_vector_type(2)));
typedef short bf16x8 __attribute__((ext_vector_type(8)));

constexpr int T = 16384, D = 1024, DEPTH = 4, DIN = 3072, DREC = 512, DSGU = 512;
constexpr int NE = 32, DE = 512, PD = 256;
constexpr int RB = 256;
constexpr int CAP = 2 * T + NE * RB;
constexpr int NRBMAX = CAP / RB;
constexpr float EPS = 1e-6f;
constexpr int NWAVES = 8, NTHR = 512;

constexpr size_t MiB = 1u << 20, KiB = 1u << 10;
constexpr size_t WS_CTL = 0, CTL_BYTES = 1 * MiB;
constexpr size_t WS_MISC = 1 * MiB;
constexpr size_t MS_TOKE = WS_MISC + 0;
constexpr size_t MS_TOKW = WS_MISC + 128 * KiB;
constexpr size_t MS_SINFO = WS_MISC + 256 * KiB;
constexpr size_t MS_SDEST = WS_MISC + 384 * KiB;
constexpr size_t MS_RSTDPE = WS_MISC + 512 * KiB;
constexpr size_t MS_BLKBASE = WS_MISC + 576 * KiB;
constexpr size_t MS_LB = WS_MISC + 608 * KiB;
constexpr size_t MS_BLKE = WS_MISC + 640 * KiB;
constexpr size_t MS_DC = WS_MISC + 1 * MiB;
constexpr size_t MS_WRT = WS_MISC + 2 * MiB;
constexpr size_t MS_SGUW = WS_MISC + 3 * MiB;
constexpr size_t MS_MM = WS_MISC + 4 * MiB;
constexpr size_t MS_PTOT = WS_MISC + 5 * MiB;
constexpr size_t WS_WIN = 16 * MiB;
constexpr size_t WS_WOUT = 40 * MiB;
constexpr size_t WS_WGU = 48 * MiB;
constexpr size_t WS_WD = 304 * MiB;
constexpr size_t WS_WPG = 432 * MiB;
constexpr size_t WS_WPE = 440 * MiB;
constexpr size_t WS_PB = 442 * MiB;
constexpr size_t WS_H = 474 * MiB;
constexpr size_t WS_XN = 538 * MiB;
constexpr size_t WS_O = 570 * MiB;
constexpr size_t WS_PE = 602 * MiB;
constexpr size_t WS_R1 = 730 * MiB;
constexpr size_t WS_Z = WS_R1;
constexpr size_t WS_UT = WS_R1 + 96 * MiB;
constexpr size_t WS_ST = WS_R1 + 128 * MiB;
constexpr size_t WS_ORAW = WS_R1 + 96 * MiB;
constexpr size_t WS_VN = WS_R1 + 128 * MiB;
constexpr size_t WS_XB = WS_R1;
constexpr size_t WS_HB = WS_R1 + 80 * MiB;
constexpr size_t WS_Y = WS_R1 + 120 * MiB;
constexpr size_t WS_LTOT = 930 * MiB;
constexpr size_t WS_END = 934 * MiB;
constexpr int CW_CNT = 64;
constexpr int CW_BGQ = 1024;
constexpr int CW_DONE = 2048;
constexpr int CW_BAR = 4096;

constexpr int RING_BYTES = 131072, MISC_OFF = RING_BYTES, LDS_BYTES = 147456;

#ifndef PROBE_DUP
#define PROBE_DUP 0
#endif
#ifndef MOE_FUSED
#define MOE_FUSED 1
#endif
#ifndef USE_CG_SYNC
#define USE_CG_SYNC 0
#endif
struct Params { const float* in[24]; float* out; unsigned char* ws; int ph_lo, ph_hi, li, pad; };

#define LDS_WAIT() asm volatile("s_waitcnt lgkmcnt(0)" ::: "memory")
template <int M> __device__ __forceinline__ float shx(float v) { static_assert(M >= 1 && M < 32, "swizzle xor mask");
    return __int_as_float(__builtin_amdgcn_ds_swizzle(__float_as_int(v), (M << 10) | 0x1F)); }
__device__ __forceinline__ float halves_sum(float v) {
    return __int_as_float(__builtin_amdgcn_readlane(__float_as_int(v), 0)) + __int_as_float(__builtin_amdgcn_readlane(__float_as_int(v), 32)); }
__device__ __forceinline__ float wave_sum(float v) {
    v += shx<1>(v); v += shx<2>(v); v += shx<4>(v); v += shx<8>(v); v += shx<16>(v);
    return halves_sum(v);
}
typedef __bf16 bf16x2_t __attribute__((ext_vector_type(2)));
__device__ __forceinline__ unsigned pk2(float lo, float hi) { const bf16x2_t v = __builtin_convertvector((f32x2){lo, hi}, bf16x2_t); return __builtin_bit_cast(unsigned, v); }
__device__ __forceinline__ unsigned f2bf(float f) { return pk2(f, f) & 0xffffu; }
__device__ __forceinline__ float bflo(unsigned w) { return __uint_as_float(w << 16); }
__device__ __forceinline__ float bfhi(unsigned w) { return __uint_as_float(w & 0xffff0000u); }
__device__ __forceinline__ float bf2f(bf16 b) { return __uint_as_float(((unsigned)b) << 16); }
__device__ __forceinline__ float fexp(float x) { return __builtin_amdgcn_exp2f(x * 1.4426950408889634f); }
__device__ __forceinline__ float flog(float x) { return __builtin_amdgcn_logf(x) * 0.6931471805599453f; }
__device__ __forceinline__ float frcp(float x) { return __builtin_amdgcn_rcpf(x); }
__device__ __forceinline__ float frsq(float x) { return __builtin_amdgcn_rsqf(x); }
__device__ __forceinline__ float sigmoid_(float x) { return frcp(1.f + fexp(-x)); }
__device__ __forceinline__ float silu_(float x) { return x * sigmoid_(x); }
__device__ __forceinline__ float gelu_(float x) { const float K1 = 2.f * 0.7978845608028654f * 1.4426950408889634f, K3 = K1 * 0.044715f;
    const float r = frcp(__builtin_amdgcn_exp2f(x * (K1 + K3 * (x * x))) + 1.f); return x - x * r; }

struct Frame {
    LAS unsigned char* lds; unsigned char* ws; const float* const* in; float* out;
    int wave, blk, G;
};
__device__ __forceinline__ int lane_now() { int l; asm volatile("v_mbcnt_lo_u32_b32 %0, -1, 0\n\tv_mbcnt_hi_u32_b32 %0, -1, %0" : "=v"(l)); return l; }
#define PH_TID() int ph_wave = F.wave; asm volatile("" : "+s"(ph_wave)); const int lane = lane_now(); (void)lane; const int tid = (ph_wave << 6) | lane; (void)tid

struct ConvJob { const float* W; const float* g; bf16* WT; int K, N, k0, n0, mode; };
constexpr int TL_IN = 16 * 12, TL_OUT = 16 * 4, TL_G = 32 * 16 * 2, TL_D = 32 * 8 * 4, TL_PG = 16 * 4, TL_PE = 4 * 4;
constexpr int TL_LAYER = TL_IN + TL_OUT + 2 * TL_G + TL_D + TL_PG + TL_PE;
__device__ __forceinline__ ConvJob conv_job(const Frame& F, int it) {
    unsigned char* ws = F.ws; const int l = it / TL_LAYER; int r = it % TL_LAYER; ConvJob j;
    if (r < TL_IN) { j.W = F.in[3] + (size_t)l * D * DIN; j.g = F.in[2] + l * D; j.WT = (bf16*)(ws + WS_WIN) + (size_t)l * DIN * D; j.K = D; j.N = DIN; j.k0 = 64 * (r / 12); j.n0 = 256 * (r % 12); j.mode = 0; return j; } r -= TL_IN;
    if (r < TL_OUT) { j.W = F.in[10] + (size_t)l * D * D; j.g = nullptr; j.WT = (bf16*)(ws + WS_WOUT) + (size_t)l * D * D; j.K = D; j.N = D; j.k0 = 64 * (r / 4); j.n0 = 256 * (r % 4); j.mode = 0; return j; } r -= TL_OUT;
    if (r < 2 * TL_G) { const int up = r >= TL_G; if (up) r -= TL_G; const int e = r / 32, rr = r % 32;
        j.W = F.in[up ? 17 : 16] + (size_t)(l * NE + e) * D * DE; j.g = F.in[11] + l * D; j.WT = (bf16*)(ws + WS_WGU) + (size_t)(l * NE + e) * 1024 * 1024; j.K = D; j.N = DE; j.k0 = 64 * (rr / 2); j.n0 = 256 * (rr % 2); j.mode = 1 + up; return j; } r -= 2 * TL_G;
    if (r < TL_D) { const int e = r / 32, rr = r % 32; j.W = F.in[18] + (size_t)(l * NE + e) * DE * D; j.g = nullptr; j.WT = (bf16*)(ws + WS_WD) + (size_t)(l * NE + e) * D * DE; j.K = DE; j.N = D; j.k0 = 64 * (rr / 4); j.n0 = 256 * (rr % 4); j.mode = 0; return j; } r -= TL_D;
    if (r < TL_PG) { j.W = F.in[20] + (size_t)l * D * D; j.g = F.in[19] + l * D; j.WT = (bf16*)(ws + WS_WPG) + (size_t)l * D * D; j.K = D; j.N = D; j.k0 = 64 * (r / 4); j.n0 = 256 * (r % 4); j.mode = 0; return j; } r -= TL_PG;
    j.W = F.in[21] + (size_t)l * PD * D; j.g = nullptr; j.WT = (bf16*)(ws + WS_WPE) + (size_t)l * D * PD; j.K = PD; j.N = D; j.k0 = 64 * (r / 4); j.n0 = 256 * (r % 4); j.mode = 0; return j;
}
__device__ __forceinline__ void conv_load(const ConvJob& j, int wave, int lane, f32x4 (&v)[8]) {
#pragma unroll
    for (int i = 0; i < 8; ++i) { const int row = 8 * wave + i; v[i] = *(const f32x4*)(j.W + (size_t)(j.k0 + row) * j.N + j.n0 + 4 * lane); if (j.g) v[i] = v[i] * j.g[j.k0 + row]; }
}
constexpr int NDEF = 384, NDEF1 = 128, NBG = 3024;
constexpr int NREST = TL_LAYER - NDEF - NBG, NPRO = TL_LAYER + 3 * NREST;
__device__ __forceinline__ int pro_tile(int f) { if (NREST == 0 || f < TL_LAYER) return f; f -= TL_LAYER; const int l = 1 + f / (NREST ? NREST : 1); return l * TL_LAYER + NDEF + NBG + f % (NREST ? NREST : 1); }
template <class M> __device__ __forceinline__ void conv_run(const Frame& F, int first, int stride, int count, M tile_of) {
    PH_TID();
    LAS float* tile = (LAS float*)F.lds;
    const int wave = ph_wave;
    int f = first; f32x4 v[8]; ConvJob cur{}, nxt{};
    if (f < count) { cur = conv_job(F, tile_of(f)); conv_load(cur, wave, lane, v); }
    while (f < count) {
#pragma unroll
        for (int i = 0; i < 8; ++i) { LAS float* d = tile + (8 * wave + i) * 257 + 4 * lane; d[0] = v[i].x; d[1] = v[i].y; d[2] = v[i].z; d[3] = v[i].w; }
        __syncthreads();
        const int fn = f + stride; if (fn < count) { nxt = conv_job(F, tile_of(fn)); conv_load(nxt, wave, lane, v); }
#pragma unroll
        for (int q = 0; q < 4; ++q) { const int nn = 32 * wave + 8 * q + (lane >> 3), c = lane & 7; const LAS float* sp = tile + (8 * c) * 257 + nn;
            u32x4 o; o.x = pk2(sp[0 * 257], sp[1 * 257]); o.y = pk2(sp[2 * 257], sp[3 * 257]); o.z = pk2(sp[4 * 257], sp[5 * 257]); o.w = pk2(sp[6 * 257], sp[7 * 257]);
            const int n = cur.n0 + nn; const int drow = cur.mode == 0 ? n : ((n >> 7) * 256 + (n & 127) + (cur.mode == 2 ? 128 : 0));
            *(u32x4*)(cur.WT + (size_t)drow * cur.K + cur.k0 + 8 * c) = o; }
        __syncthreads();
        cur = nxt; f = fn;
    }
}
__device__ __forceinline__ void conv_deferred(const Frame& F, int lnext, int r0, int r1, int first, int idle) {
    if (lnext >= DEPTH || F.blk < first) return;
    conv_run(F, F.blk - first, idle, r1 - r0, [=](int f) { return lnext * TL_LAYER + r0 + f; });
}
__device__ __forceinline__ void phase_prologue(const Frame& F) {
    PH_TID();
    unsigned char* ws = F.ws;
    conv_run(F, F.blk, F.G, NPRO, [](int f) { return pro_tile(f); });
    { const f32x4* src = (const f32x4*)F.in[1]; u32x4* dst = (u32x4*)(ws + WS_PB); const size_t n8 = (size_t)DEPTH * T * PD / 8;
      for (size_t i = (size_t)F.blk * NTHR + tid; i < n8; i += (size_t)F.G * NTHR) { const f32x4 a = src[2 * i], b = src[2 * i + 1]; u32x4 o; o.x = pk2(a.x, a.y); o.y = pk2(a.z, a.w); o.z = pk2(b.x, b.y); o.w = pk2(b.z, b.w); dst[i] = o; } }
    { float* wrt = (float*)(ws + MS_WRT);
      for (int i = F.blk * NTHR + tid; i < DEPTH * 36 * D; i += F.G * NTHR) { const int k = i % D, n = (i / D) % 36, l = i / (36 * D);
          const float w = n < 4 ? F.in[12][((size_t)l * D + k) * 4 + n] : F.in[14][((size_t)l * D + k) * NE + (n - 4)]; wrt[i] = w * F.in[11][l * D + k]; } }
    { bf16* wb = (bf16*)(ws + MS_SGUW); for (int i = F.blk * NTHR + tid; i < DEPTH * 4 * 128 * 128; i += F.G * NTHR) { const int tc = (i >> 7) & 127, sp = i & 127; wb[i] = sp <= tc ? (bf16)f2bf(F.in[8][i]) : (bf16)0; } }
    if (F.blk == 0 && tid < DREC) { const int c = tid; float v[DEPTH], m = -1e30f;
#pragma unroll
        for (int l = 0; l < DEPTH; ++l) { v[l] = F.in[4][l * DREC + c]; m = fmaxf(m, v[l]); }
        float s = 0.f;
#pragma unroll
        for (int l = 0; l < DEPTH; ++l) { v[l] = fexp(v[l] - m); s += v[l]; }
        float* lb = (float*)(ws + MS_LB); float acc = 0.f;
#pragma unroll
        for (int l = 0; l < DEPTH; ++l) { if (l > 0) acc += v[l] / s; lb[l * DREC + c] = acc; } }
}

__device__ __forceinline__ void load_row(const float* row, int lane, f32x4 (&v)[4]) { const f32x4* r = (const f32x4*)row + lane;
#pragma unroll
    for (int j = 0; j < 4; ++j) v[j] = r[64 * j]; }
__device__ __forceinline__ void load_row_bf(const bf16* row, int lane, f32x4 (&v)[4]) { const u32x2* r = (const u32x2*)row + lane;
#pragma unroll
    for (int j = 0; j < 4; ++j) { const u32x2 x = r[64 * j]; v[j] = (f32x4){bflo(x.x), bfhi(x.x), bflo(x.y), bfhi(x.y)}; } }
__device__ __forceinline__ float row_sumsq(const f32x4 (&v)[4]) { float s = 0.f;
#pragma unroll
    for (int j = 0; j < 4; ++j) s += (v[j].x * v[j].x + v[j].y * v[j].y) + (v[j].z * v[j].z + v[j].w * v[j].w);
    return wave_sum(s); }
__device__ __forceinline__ void store_row_bf16(bf16* orow, int lane, const f32x4 (&v)[4], float s) { u32x2* o = (u32x2*)orow + lane;
#pragma unroll
    for (int j = 0; j < 4; ++j) { u32x2 w; w.x = pk2(v[j].x * s, v[j].y * s); w.y = pk2(v[j].z * s, v[j].w * s); o[64 * j] = w; } }

__device__ __forceinline__ void phase_norm1(const Frame& F, int l) {
    PH_TID();
    bf16* XN = (bf16*)(F.ws + WS_XN); bf16* h = (bf16*)(F.ws + WS_H); const float* x = F.in[0];
    const int gw = F.blk * NWAVES + ph_wave, NGW = F.G * NWAVES;
    for (int t = gw; t < T; t += NGW) { f32x4 v[4];
        if (l == 0) { load_row(x + (size_t)t * D, lane, v); store_row_bf16(h + (size_t)t * D, lane, v, 1.f); } else load_row_bf(h + (size_t)t * D, lane, v);
        const float rstd = frsq(row_sumsq(v) * (1.f / D) + EPS); store_row_bf16(XN + (size_t)t * D, lane, v, rstd); }
}
__device__ __forceinline__ float bfly8(const float (&r)[8], int lane) {
    const bool b2 = lane & 4, b1 = lane & 2, b0 = lane & 1; float a[4], c[2];
#pragma unroll
    for (int i = 0; i < 4; ++i) { const float keep = b2 ? r[i + 4] : r[i], send = b2 ? r[i] : r[i + 4]; a[i] = keep + shx<4>(send); }
#pragma unroll
    for (int i = 0; i < 2; ++i) { const float keep = b1 ? a[i + 2] : a[i], send = b1 ? a[i] : a[i + 2]; c[i] = keep + shx<2>(send); }
    const float keep = b0 ? c[1] : c[0], send = b0 ? c[0] : c[1]; float d = keep + shx<1>(send);
    d += shx<8>(d); d += shx<16>(d);
    return d + __int_as_float(__builtin_amdgcn_ds_bpermute((lane ^ 32) << 2, __float_as_int(d)));
}
__device__ __forceinline__ void phase_norm2(const Frame& F, int l) {
    PH_TID();
    unsigned char* ws = F.ws;
    unsigned* hist = (unsigned*)(F.lds + MISC_OFF + 256);
    if (tid < 32) hist[tid] = 0u;
    __syncthreads();
    const bf16* h = (const bf16*)(ws + WS_H); bf16* XN = (bf16*)(ws + WS_XN);
    const float* WrT = (const float*)(ws + MS_WRT) + (size_t)l * 36 * D;
    const float* b_rg = F.in[13] + l * 4; const float* b_re = F.in[15] + l * NE;
    int* tok_e = (int*)(ws + MS_TOKE); float* tok_w = (float*)(ws + MS_TOKW); unsigned* sinfo = (unsigned*)(ws + MS_SINFO);
    const int RPB = T / F.G, RPW = RPB / NWAVES;
    for (int i0 = 0; i0 < RPW; i0 += 8) {
        const int t0 = F.blk * RPB + ph_wave * RPW + i0;
        f32x4 v[8][4]; float ss[8];
#pragma unroll
        for (int r = 0; r < 8; ++r) { load_row_bf(h + (size_t)(t0 + r) * D, lane, v[r]); float q = 0.f;
#pragma unroll
            for (int j = 0; j < 4; ++j) q += (v[r][j].x * v[r][j].x + v[r][j].y * v[r][j].y) + (v[r][j].z * v[r][j].z + v[r][j].w * v[r][j].w);
            ss[r] = q; }
        const float rstd_mine = frsq(bfly8(ss, lane) * (1.f / D) + EPS);
#pragma unroll
        for (int r = 0; r < 8; ++r) { const float rs = __int_as_float(__builtin_amdgcn_readlane(__float_as_int(rstd_mine), r)); store_row_bf16(XN + (size_t)(t0 + r) * D, lane, v[r], rs); }
        LAS float* lgw = (LAS float*)(F.lds + 4096) + ph_wave * (36 * 8);
#pragma unroll 2
        for (int n = 0; n < 36; ++n) { const f32x4* wr = (const f32x4*)(WrT + (size_t)n * D) + lane; const f32x4 w0 = wr[0], w1 = wr[64], w2 = wr[128], w3 = wr[192]; float pr[8];
#pragma unroll
            for (int r = 0; r < 8; ++r) pr[r] = ((v[r][0].x * w0.x + v[r][0].y * w0.y) + (v[r][0].z * w0.z + v[r][0].w * w0.w)) + ((v[r][1].x * w1.x + v[r][1].y * w1.y) + (v[r][1].z * w1.z + v[r][1].w * w1.w))
                                                 + ((v[r][2].x * w2.x + v[r][2].y * w2.y) + (v[r][2].z * w2.z + v[r][2].w * w2.w)) + ((v[r][3].x * w3.x + v[r][3].y * w3.y) + (v[r][3].z * w3.z + v[r][3].w * w3.w));
            const float val = bfly8(pr, lane) * rstd_mine; if (lane < 8) lgw[n * 8 + lane] = val; }
        const int row = lane & 7;
        float lg4[4], lgb[4];
#pragma unroll
        for (int j = 0; j < 4; ++j) { lg4[j] = lgw[j * 8 + row]; lgb[j] = lg4[j] + b_rg[j]; }
        int gs = 0; float gm = lgb[0];
#pragma unroll
        for (int j = 1; j < 4; ++j) if (lgb[j] > gm) { gm = lgb[j]; gs = j; }
        float mx = fmaxf(fmaxf(lg4[0], lg4[1]), fmaxf(lg4[2], lg4[3])), se = 0.f, lsel = lg4[0];
#pragma unroll
        for (int j = 0; j < 4; ++j) { se += fexp(lg4[j] - mx); if (j == gs) lsel = lg4[j]; }
        const float g_w = fexp(lsel - mx) * frcp(se);
        float le[8], leb[8];
#pragma unroll
        for (int j = 0; j < 8; ++j) { le[j] = lgw[(4 + gs * 8 + j) * 8 + row]; leb[j] = le[j] + b_re[gs * 8 + j]; }
        int s0 = 0; float m0 = leb[0];
#pragma unroll
        for (int j = 1; j < 8; ++j) if (leb[j] > m0) { m0 = leb[j]; s0 = j; }
        int s1 = -1; float m1 = -3.0e38f;
#pragma unroll
        for (int j = 0; j < 8; ++j) if (j != s0 && leb[j] > m1) { m1 = leb[j]; s1 = j; }
        if (s1 < 0) s1 = (s0 == 0) ? 1 : 0;
        float la = le[0], lb2 = le[0];
#pragma unroll
        for (int j = 1; j < 8; ++j) { if (j == s0) la = le[j]; if (j == s1) lb2 = le[j]; }
        const float wa = frcp(1.f + fexp(lb2 - la)), wb = 1.f - wa;
        if (lane < 8) { const int t = t0 + lane;
            const int e0 = gs * 8 + s0, e1 = gs * 8 + s1;
            const unsigned r0 = atomicAdd(&hist[e0], 1u), r1 = atomicAdd(&hist[e1], 1u);
            tok_e[2 * t] = e0; tok_e[2 * t + 1] = e1; tok_w[2 * t] = g_w * wa; tok_w[2 * t + 1] = g_w * wb;
            sinfo[2 * t] = ((unsigned)F.blk << 16) | r0; sinfo[2 * t + 1] = ((unsigned)F.blk << 16) | r1;
        }
    }
    __syncthreads();
    if (tid < 32) { unsigned* cnt = (unsigned*)(ws + WS_CTL) + CW_CNT + l * 32;
        const unsigned base = __hip_atomic_fetch_add(cnt + tid, hist[tid], __ATOMIC_RELAXED, __HIP_MEMORY_SCOPE_AGENT);
        ((unsigned*)(ws + MS_BLKBASE))[F.blk * 32 + tid] = base; }
}
__device__ __forceinline__ void phase_gather(const Frame& F, int l) {
    PH_TID();
    unsigned char* ws = F.ws;
    int* ps = (int*)(F.lds + MISC_OFF + 512);
    if (tid == 0) { unsigned* cnt = (unsigned*)(ws + WS_CTL) + CW_CNT + l * 32; int* blke = (int*)(ws + MS_BLKE) + l * 256; int acc = 0;
        for (int e = 0; e < NE; ++e) { const int c = (int)__hip_atomic_load(cnt + e, __ATOMIC_RELAXED, __HIP_MEMORY_SCOPE_AGENT); ps[e] = acc; const int pad = (c + RB - 1) / RB * RB;
            if (F.blk == 0) for (int rb = acc / RB; rb < (acc + pad) / RB; ++rb) blke[rb] = e;
            acc += pad; }
        if (F.blk == 0) blke[255] = acc / RB; }
    __syncthreads();
    const int* tok_e = (const int*)(ws + MS_TOKE); const unsigned* sinfo = (const unsigned*)(ws + MS_SINFO); const unsigned* bbase = (const unsigned*)(ws + MS_BLKBASE);
    int* sdest = (int*)(ws + MS_SDEST); const bf16* XN = (const bf16*)(ws + WS_XN); bf16* XB = (bf16*)(ws + WS_XB);
    const int gw = F.blk * NWAVES + ph_wave, NGW = F.G * NWAVES;
    for (int t = gw; t < T; t += NGW) {
        const u32x4* src = (const u32x4*)(XN + (size_t)t * D) + lane; const u32x4 a = src[0], b = src[64];
#pragma unroll
        for (int j = 0; j < 2; ++j) { const int e = tok_e[2 * t + j]; const unsigned info = sinfo[2 * t + j];
            const int dest = ps[e] + (int)bbase[(info >> 16) * 32 + e] + (int)(info & 0xffffu);
            if (lane == 0) sdest[2 * t + j] = dest;
            u32x4* dst = (u32x4*)(XB + (size_t)dest * D) + lane; dst[0] = a; dst[64] = b; }
    }
}
__device__ __forceinline__ void phase_combine(const Frame& F, int l) {
    PH_TID();
    unsigned char* ws = F.ws;
    bf16* h = (bf16*)(ws + WS_H); bf16* XN = (bf16*)(ws + WS_XN); const bf16* Y = (const bf16*)(ws + WS_Y); const bf16* PE = (const bf16*)(ws + WS_PE) + (size_t)l * T * D;
    const int* sdest = (const int*)(ws + MS_SDEST); const float* tok_w = (const float*)(ws + MS_TOKW); float* rstd_pe = (float*)(ws + MS_RSTDPE);
    const int gw = F.blk * NWAVES + ph_wave, NGW = F.G * NWAVES;
    struct Rows { u32x2 h[4], y0[4], y1[4], pe[4]; };
    auto fetch = [&](int t, int d0, int d1, Rows& r) {
        const u32x2* hp = (const u32x2*)(h + (size_t)t * D) + lane; const u32x2* y0 = (const u32x2*)(Y + (size_t)d0 * D) + lane; const u32x2* y1 = (const u32x2*)(Y + (size_t)d1 * D) + lane; const u32x2* pe = (const u32x2*)(PE + (size_t)t * D) + lane;
#pragma unroll
        for (int j = 0; j < 4; ++j) { r.h[j] = hp[64 * j]; r.y0[j] = y0[64 * j]; r.y1[j] = y1[64 * j]; r.pe[j] = pe[64 * j]; } };
    int t = gw; if (t >= T) return;
    Rows cur; int d0n = 0, d1n = 0; float w0 = tok_w[2 * t], w1 = tok_w[2 * t + 1], w0n = 0.f, w1n = 0.f;
    fetch(t, sdest[2 * t], sdest[2 * t + 1], cur);
    if (t + NGW < T) { d0n = sdest[2 * (t + NGW)]; d1n = sdest[2 * (t + NGW) + 1]; w0n = tok_w[2 * (t + NGW)]; w1n = tok_w[2 * (t + NGW) + 1]; }
    for (; t < T; t += NGW) {
        Rows nxt = cur; const float w0c = w0, w1c = w1; const bool more = t + NGW < T;
        if (more) { fetch(t + NGW, d0n, d1n, nxt); w0 = w0n; w1 = w1n;
            if (t + 2 * NGW < T) { d0n = sdest[2 * (t + 2 * NGW)]; d1n = sdest[2 * (t + 2 * NGW) + 1]; w0n = tok_w[2 * (t + 2 * NGW)]; w1n = tok_w[2 * (t + 2 * NGW) + 1]; } }
        f32x4 v[4]; float sp = 0.f;
#pragma unroll
        for (int j = 0; j < 4; ++j) { const u32x2 x = cur.h[j], a = cur.y0[j], b = cur.y1[j], c = cur.pe[j];
            v[j] = (f32x4){bflo(x.x) + (w0c * bflo(a.x) + w1c * bflo(b.x)), bfhi(x.x) + (w0c * bfhi(a.x) + w1c * bfhi(b.x)), bflo(x.y) + (w0c * bflo(a.y) + w1c * bflo(b.y)), bfhi(x.y) + (w0c * bfhi(a.y) + w1c * bfhi(b.y))};
            const float p0 = bflo(c.x), p1 = bfhi(c.x), p2 = bflo(c.y), p3 = bfhi(c.y); sp += (p0 * p0 + p1 * p1) + (p2 * p2 + p3 * p3); }
        store_row_bf16(h + (size_t)t * D, lane, v, 1.f);
        const float rstd = frsq(row_sumsq(v) * (1.f / D) + EPS); store_row_bf16(XN + (size_t)t * D, lane, v, rstd);
        sp = wave_sum(sp); if (lane == 0) rstd_pe[t] = frsq(sp * (1.f / D) + EPS);
        cur = nxt;
    }
}
__device__ __forceinline__ void phase_final(const Frame& F) {
    PH_TID();
    const bf16* h = (const bf16*)(F.ws + WS_H); const float* nf = F.in[23];
    const int gw = F.blk * NWAVES + ph_wave, NGW = F.G * NWAVES;
    for (int t = gw; t < T; t += NGW) { f32x4 v[4]; load_row_bf(h + (size_t)t * D, lane, v); const float rstd = frsq(row_sumsq(v) * (1.f / D) + EPS);
        f32x4* o = (f32x4*)(F.out + (size_t)t * D) + lane; const f32x4* g = (const f32x4*)nf + lane;
#pragma unroll
        for (int j = 0; j < 4; ++j) o[64 * j] = v[j] * rstd * g[64 * j]; }
}


namespace pg8 {
constexpr int BM = 256, BK = 64, HALF = 128, HTB = HALF * BK * 2, STAGE_BYTES = 8 * HTB, NXCD = 8, WGM = 8;
__host__ __device__ __forceinline__ int lds_byte(int r, int c) { const int st = (r >> 4) * 2 + (c >> 5), rr = r & 15, cc = c & 31, ob = rr * 64 + cc * 2; return st * 1024 + (ob ^ (((ob >> 9) & 1) << 5)); }
__host__ __device__ __forceinline__ void stage_rc(int b, int& R, int& C) { const int st = b / 1024, sb = b % 1024, swz = sb ^ (((sb >> 9) & 1) << 5); R = (st >> 1) * 16 + swz / 64; C = (st & 1) * 32 + (swz % 64) / 2; }
__host__ __device__ __forceinline__ int perm32(int rho) { const int n = rho >> 4, i = rho & 15; return 8 * (i >> 2) + 4 * n + (i & 3); }
struct Unit { int pm, pn; const char* A; const char* B; };
__device__ __forceinline__ void static_map(int wgid, int nM, int nN, int& pm, int& pn) {
    const int nwg = nM * nN; { const int q = nwg / NXCD, r = nwg % NXCD, xcd = wgid % NXCD, off = wgid / NXCD; wgid = (xcd < r ? xcd * (q + 1) : r * (q + 1) + (xcd - r) * q) + off; }
    const int nig = WGM * nN, gid = wgid / nig, fm = gid * WGM, gsz = (nM - fm) < WGM ? (nM - fm) : WGM;
    pm = fm + ((wgid % nig) % gsz); pn = (wgid % nig) / gsz;
}
struct DenseOrder { static constexpr bool DEPS = false;
    const char* A; const char* Bt; int nM, nN, nL, G, c; size_t tstep;
    __device__ void init(const void* A_, const void* Bt_, int M, int N, int K, int nL_, int G_, int c_) { A = (const char*)A_; Bt = (const char*)Bt_; nM = M / BM; nN = N / BM; nL = nL_; G = G_; c = c_; tstep = (size_t)BM * K * 2; }
    __device__ bool next(int i, Unit& u) const { const long L = (long)i * G + c; const int per = nM * nN; if (L >= (long)per * nL) return false;
        const int l = (int)(L / per); int pm, pn; static_map((int)(L % per), nM, nN, pm, pn); u.pm = l * nM + pm; u.pn = pn; u.A = A + (size_t)u.pm * tstep; u.B = Bt + (size_t)(l * nN + pn) * tstep; return true; }
};
struct MoeOrder { static constexpr bool DEPS = false;
    const char* A; const char* W; const int* blke; int nrb, nN, G, c, e0, e1, e2; size_t a_tstep, w_estride, b_tstep;
    __device__ void init(const void* A_, const void* W_, const int* blke_, int K, int nN_, size_t w_estride_bytes, int G_, int c_) { A = (const char*)A_; W = (const char*)W_; blke = blke_; nrb = __builtin_amdgcn_readfirstlane(blke_[255]); nN = nN_; G = G_; c = c_;
        a_tstep = (size_t)BM * K * 2; b_tstep = a_tstep; w_estride = w_estride_bytes;
        const int r0 = c / nN, r1 = (G + c) / nN, r2 = (2 * G + c) / nN; const int x0 = blke_[r0 < 255 ? r0 : 254], x1 = blke_[r1 < 255 ? r1 : 254], x2 = blke_[r2 < 255 ? r2 : 254];
        e0 = __builtin_amdgcn_readfirstlane(x0); e1 = __builtin_amdgcn_readfirstlane(x1); e2 = __builtin_amdgcn_readfirstlane(x2); }
    __device__ bool next(int i, Unit& u) const { const long L = (long)i * G + c; if (L >= (long)nrb * nN) return false; const int rb = (int)(L / nN), pn = (int)(L % nN);
        const int ex = i == 0 ? e0 : i == 1 ? e1 : i == 2 ? e2 : __builtin_amdgcn_readfirstlane(blke[rb]);
        u.pm = rb; u.pn = pn; u.A = A + (size_t)rb * a_tstep; u.B = W + (size_t)ex * w_estride + (size_t)pn * b_tstep; return true; }
};
__device__ __forceinline__ unsigned ag_ld(const unsigned* p)        { return __hip_atomic_load(p, __ATOMIC_RELAXED, __HIP_MEMORY_SCOPE_AGENT); }
__device__ __forceinline__ unsigned ag_add(unsigned* p, unsigned v) { return __hip_atomic_fetch_add(p, v, __ATOMIC_RELAXED, __HIP_MEMORY_SCOPE_AGENT); }
struct MoeDepOrder { static constexpr bool DEPS = true;
    const char* A; const char* W; const int* blke; const unsigned* done; int nrb, nN, G, c, e0, e1, e2; size_t a_tstep, w_estride, b_tstep;
    __device__ void init(const void* A_, const void* W_, const int* blke_, const unsigned* done_, int K, int nN_, size_t w_estride_bytes, int G_, int c_) { A = (const char*)A_; W = (const char*)W_; blke = blke_; done = done_;
        nrb = __builtin_amdgcn_readfirstlane(blke_[255]); nN = nN_; G = G_; c = c_; a_tstep = (size_t)BM * K * 2; b_tstep = a_tstep; w_estride = w_estride_bytes;
        const int r0 = c / nN, r1 = (G + c) / nN, r2 = (2 * G + c) / nN; const int x0 = blke_[r0 < 255 ? r0 : 254], x1 = blke_[r1 < 255 ? r1 : 254], x2 = blke_[r2 < 255 ? r2 : 254];
        e0 = __builtin_amdgcn_readfirstlane(x0); e1 = __builtin_amdgcn_readfirstlane(x1); e2 = __builtin_amdgcn_readfirstlane(x2); }
    __device__ bool next(int i, Unit& u) const { const long L = (long)i * G + c; if (L >= (long)nrb * nN) return false; const int rb = (int)(L / nN), pn = (int)(L % nN);
        const int ex = i == 0 ? e0 : i == 1 ? e1 : i == 2 ? e2 : __builtin_amdgcn_readfirstlane(blke[rb]);
        u.pm = rb; u.pn = pn; u.A = A + (size_t)rb * a_tstep; u.B = W + (size_t)ex * w_estride + (size_t)pn * b_tstep; return true; }
    __device__ void wait(const Unit& u, int wid) const {
        if (wid == 0 && lane_now() == 0) { while (ag_ld(done + u.pm) < 4u) __builtin_amdgcn_s_sleep(1); __builtin_amdgcn_fence(__ATOMIC_ACQUIRE, "agent"); } }
};
struct RangeOrder { static constexpr bool DEPS = false;
    const char* A; const char* Bt; int nM, nN, j0, n; size_t tstep;
    __device__ void init(const void* A_, const void* Bt_, int M, int N, int K, int j0_, int n_) { A = (const char*)A_; Bt = (const char*)Bt_; nM = M / BM; nN = N / BM; j0 = j0_; n = n_; tstep = (size_t)BM * K * 2; }
    __device__ bool next(int i, Unit& u) const { if (i >= n) return false; int pm, pn; static_map(j0 + i, nM, nN, pm, pn); u.pm = pm; u.pn = pn; u.A = A + (size_t)pm * tstep; u.B = Bt + (size_t)pn * tstep; return true; }
};
__device__ __forceinline__ unsigned cvt_pk_bf16(float lo, float hi) { return pk2(lo, hi); }
struct EpiBf16 { static constexpr bool PERM = true, ACC_INIT = false, SIGNAL = false; bf16* O; int ldc;
    __device__ __forceinline__ void operator()(const f32x4 (&acc)[2][2][4][2], const Unit& u, int wr, int wc, int, int) const {
        const int t2 = lane_now(), fr = t2 & 15, fq = t2 >> 4;
        const int row0 = u.pm * BM + wr * 64 + fr, col0 = u.pn * BM + wc * 32 + 8 * fq;
#pragma unroll
        for (int ai = 0; ai < 2; ++ai)
#pragma unroll
            for (int m = 0; m < 4; ++m) { bf16* rowp = O + (size_t)(row0 + ai * HALF + m * 16) * ldc + col0;
#pragma unroll
                for (int bj = 0; bj < 2; ++bj) { const f32x4 v0 = acc[ai][bj][m][0], v1 = acc[ai][bj][m][1];
                    u32x4 w; w.x = cvt_pk_bf16(v0[0], v0[1]); w.y = cvt_pk_bf16(v0[2], v0[3]); w.z = cvt_pk_bf16(v1[0], v1[1]); w.w = cvt_pk_bf16(v1[2], v1[3]);
                    *(u32x4*)(rowp + bj * HALF) = w; } }
    } };
struct EpiResid { static constexpr bool PERM = true, ACC_INIT = true, SIGNAL = false; bf16* h;
    __device__ __forceinline__ void init(f32x4 (&acc)[2][2][4][2], const Unit& u, int wr, int wc, int fr, int fq) const {
        const int row0 = u.pm * BM + wr * 64 + fr, col0 = u.pn * BM + wc * 32 + 8 * fq;
#pragma unroll
        for (int ai = 0; ai < 2; ++ai)
#pragma unroll
            for (int m = 0; m < 4; ++m) { const bf16* rowp = h + (size_t)(row0 + ai * HALF + m * 16) * D + col0;
#pragma unroll
                for (int bj = 0; bj < 2; ++bj) { const u32x4 x = *(const u32x4*)(rowp + bj * HALF);
                    acc[ai][bj][m][0] = (f32x4){bflo(x.x), bfhi(x.x), bflo(x.y), bfhi(x.y)}; acc[ai][bj][m][1] = (f32x4){bflo(x.z), bfhi(x.z), bflo(x.w), bfhi(x.w)}; } }
    }
    __device__ __forceinline__ void operator()(const f32x4 (&acc)[2][2][4][2], const Unit& u, int wr, int wc, int fr, int fq) const {
        asm volatile("" : "+v"(fr), "+v"(fq));
        const int row0 = u.pm * BM + wr * 64 + fr, col0 = u.pn * BM + wc * 32 + 8 * fq;
#pragma unroll
        for (int ai = 0; ai < 2; ++ai)
#pragma unroll
            for (int m = 0; m < 4; ++m) { bf16* rowp = h + (size_t)(row0 + ai * HALF + m * 16) * D + col0;
#pragma unroll
                for (int bj = 0; bj < 2; ++bj) { const f32x4 v0 = acc[ai][bj][m][0], v1 = acc[ai][bj][m][1];
                    u32x4 w; w.x = cvt_pk_bf16(v0[0], v0[1]); w.y = cvt_pk_bf16(v0[2], v0[3]); w.z = cvt_pk_bf16(v1[0], v1[1]); w.w = cvt_pk_bf16(v1[2], v1[3]);
                    *(u32x4*)(rowp + bj * HALF) = w; } }
    } };
struct EpiGateUp { static constexpr bool PERM = true, ACC_INIT = false, SIGNAL = false; bf16* H;
    __device__ __forceinline__ void operator()(const f32x4 (&acc)[2][2][4][2], const Unit& u, int wr, int wc, int, int) const {
        const int t2 = lane_now(), fr = t2 & 15, fq = t2 >> 4;
        const int row0 = u.pm * BM + wr * 64 + fr, col0 = u.pn * HALF + wc * 32 + 8 * fq;
#pragma unroll
        for (int ai = 0; ai < 2; ++ai)
#pragma unroll
            for (int m = 0; m < 4; ++m) { bf16* rowp = H + (size_t)(row0 + ai * HALF + m * 16) * DE + col0; float v[8];
#pragma unroll
                for (int n = 0; n < 2; ++n)
#pragma unroll
                    for (int j = 0; j < 4; ++j) v[4 * n + j] = silu_(acc[ai][0][m][n][j]) * acc[ai][1][m][n][j];
                u32x4 w; w.x = cvt_pk_bf16(v[0], v[1]); w.y = cvt_pk_bf16(v[2], v[3]); w.z = cvt_pk_bf16(v[4], v[5]); w.w = cvt_pk_bf16(v[6], v[7]);
                *(u32x4*)rowp = w; }
    } };
struct EpiGateUpPub { static constexpr bool PERM = true, ACC_INIT = false, SIGNAL = true; __amdgpu_buffer_rsrc_t rs; unsigned* done;
    __device__ __forceinline__ void operator()(const f32x4 (&acc)[2][2][4][2], const Unit& u, int wr, int wc, int fr, int fq) const {
        asm volatile("" : "+v"(fr), "+v"(fq));
        const int row0 = u.pm * BM + wr * 64 + fr, col0 = u.pn * HALF + wc * 32 + 8 * fq;
#pragma unroll
        for (int ai = 0; ai < 2; ++ai)
#pragma unroll
            for (int m = 0; m < 4; ++m) { const unsigned off = (unsigned)(((row0 + ai * HALF + m * 16) * DE + col0) * 2); float v[8];
#pragma unroll
                for (int n = 0; n < 2; ++n)
#pragma unroll
                    for (int j = 0; j < 4; ++j) v[4 * n + j] = silu_(acc[ai][0][m][n][j]) * acc[ai][1][m][n][j];
                u32x4 w; w.x = cvt_pk_bf16(v[0], v[1]); w.y = cvt_pk_bf16(v[2], v[3]); w.z = cvt_pk_bf16(v[4], v[5]); w.w = cvt_pk_bf16(v[6], v[7]);
                __builtin_amdgcn_raw_buffer_store_b128(w, rs, off, 0, 16); }
    }
    __device__ __forceinline__ void signal(const Unit& u) const { (void)ag_add(done + u.pm, 1u); }
};
struct EpiPG { static constexpr bool PERM = true, ACC_INIT = false, SIGNAL = false; bf16* h; const bf16* PE; const float* rstd_pe; const float* norm_pe;
    __device__ __forceinline__ void operator()(const f32x4 (&acc)[2][2][4][2], const Unit& u, int wr, int wc, int, int) const {
        const int t2 = lane_now(), fr = t2 & 15, fq = t2 >> 4;
        const int row0 = u.pm * BM + wr * 64 + fr, col0 = u.pn * BM + wc * 32 + 8 * fq;
        f32x4 nv[2][2];
#pragma unroll
        for (int bj = 0; bj < 2; ++bj)
#pragma unroll
            for (int n = 0; n < 2; ++n) nv[bj][n] = *(const f32x4*)(norm_pe + col0 + bj * HALF + 4 * n);
#pragma unroll
        for (int ai = 0; ai < 2; ++ai) {
            u32x4 pe[4][2], hx[4][2]; float rs[4];
#pragma unroll
            for (int m = 0; m < 4; ++m) { const int row = row0 + ai * HALF + m * 16; rs[m] = rstd_pe[row];
#pragma unroll
                for (int bj = 0; bj < 2; ++bj) { const size_t o = (size_t)row * D + col0 + bj * HALF; pe[m][bj] = *(const u32x4*)(PE + o); hx[m][bj] = *(const u32x4*)(h + o); } }
#pragma unroll
            for (int m = 0; m < 4; ++m) { const int row = row0 + ai * HALF + m * 16;
#pragma unroll
                for (int bj = 0; bj < 2; ++bj) { const size_t o = (size_t)row * D + col0 + bj * HALF; const u32x4 p = pe[m][bj], x = hx[m][bj];
                    f32x4 h0 = (f32x4){bflo(x.x), bfhi(x.x), bflo(x.y), bfhi(x.y)}, h1 = (f32x4){bflo(x.z), bfhi(x.z), bflo(x.w), bfhi(x.w)}; const f32x4 a0 = acc[ai][bj][m][0], a1 = acc[ai][bj][m][1];
                    const f32x4 e0 = (f32x4){bflo(p.x), bfhi(p.x), bflo(p.y), bfhi(p.y)} * rs[m] * nv[bj][0], e1 = (f32x4){bflo(p.z), bfhi(p.z), bflo(p.w), bfhi(p.w)} * rs[m] * nv[bj][1];
                    h0 += (f32x4){sigmoid_(a0[0]), sigmoid_(a0[1]), sigmoid_(a0[2]), sigmoid_(a0[3])} * e0; h1 += (f32x4){sigmoid_(a1[0]), sigmoid_(a1[1]), sigmoid_(a1[2]), sigmoid_(a1[3])} * e1;
                    u32x4 w; w.x = pk2(h0[0], h0[1]); w.y = pk2(h0[2], h0[3]); w.z = pk2(h1[0], h1[1]); w.w = pk2(h1[2], h1[3]); *(u32x4*)(h + o) = w; } } }
    } };

template <class Epi, class Sched>
__device__ __forceinline__ void gemm_phase(int wave, LAS unsigned char* lds, int K, const Sched& S, const Epi& E) {
    int wid = wave; asm volatile("" : "+s"(wid));
    const int lane = lane_now(), tid = (wid << 6) | lane, wr = wid >> 2, wc = wid & 3, fr = lane & 15, fq = lane >> 4;
    const int nt = K / BK;
    unsigned voffA[2], voffB[2];
#pragma unroll
    for (int i = 0; i < 2; ++i) { int R, C; stage_rc(tid * 16 + i * 8192, R, C); const int Rb = Epi::PERM ? ((R & ~31) + perm32(R & 31)) : R;
        voffA[i] = (unsigned)(R * K + C) * 2u; voffB[i] = (unsigned)(Rb * K + C) * 2u; }
    const size_t kstep = (size_t)(BK * 2);
    const size_t hstep = (size_t)HALF * K * 2;
    const unsigned ldsw = (unsigned)wid * 1024u;
    const int aoff = lds_byte(wr * 64 + fr, fq * 8), boff = lds_byte(wc * 32 + fr, fq * 8);
#define PG8_SA(b, h) (((b) * 2 + (h)) * HTB)
#define PG8_SB(b, h) ((4 + (b) * 2 + (h)) * HTB)
#define PG8_STAGE(bufoff, gbase, voff) do { _Pragma("unroll") for (int _i = 0; _i < 2; ++_i) \
        __builtin_amdgcn_global_load_lds((const unsigned*)((const char*)(gbase) + (voff)[_i]), (LAS unsigned*)(lds + (bufoff) + ldsw + _i * 8192), 16, 0, 0); } while (0)
#define PG8_LDA(dst, b, h) do { _Pragma("unroll") for (int m = 0; m < 4; ++m) _Pragma("unroll") for (int k = 0; k < 2; ++k) dst[m][k] = *(const LAS bf16x8*)(lds + PG8_SA(b, h) + aoff + m * 2048 + k * 1024); } while (0)
#define PG8_LDB(dst, b, h) do { _Pragma("unroll") for (int n = 0; n < 2; ++n) _Pragma("unroll") for (int k = 0; k < 2; ++k) dst[n][k] = *(const LAS bf16x8*)(lds + PG8_SB(b, h) + boff + n * 2048 + k * 1024); } while (0)
#define PG8_MMA(ai, bj, At, Bt) do { __builtin_amdgcn_s_setprio(1); _Pragma("unroll") for (int m = 0; m < 4; ++m) _Pragma("unroll") for (int n = 0; n < 2; ++n) _Pragma("unroll") for (int k = 0; k < 2; ++k) \
        acc[ai][bj][m][n] = __builtin_amdgcn_mfma_f32_16x16x32_bf16(Bt[n][k], At[m][k], acc[ai][bj][m][n], 0, 0, 0); __builtin_amdgcn_s_setprio(0); } while (0)
#define PG8_WAIT_V(n) asm volatile("s_waitcnt vmcnt(" #n ")" ::: "memory")
#define PG8_WAIT_L(n) asm volatile("s_waitcnt lgkmcnt(" #n ")" ::: "memory")
#define PG8_BAR __builtin_amdgcn_s_barrier()
#define PG8_SCHED __builtin_amdgcn_sched_barrier(0)
    Unit cur, nxt; int ui = 0;
    if (!S.next(0, cur)) return;
    if constexpr (Sched::DEPS) { S.wait(cur, wid); PG8_BAR; }
    f32x4 acc[2][2][4][2];
    if constexpr (Epi::ACC_INIT) E.init(acc, cur, wr, wc, fr, fq);
    else {
#pragma unroll
    for (int a = 0; a < 2; ++a)
#pragma unroll
        for (int b = 0; b < 2; ++b)
#pragma unroll
            for (int m = 0; m < 4; ++m)
#pragma unroll
                for (int n = 0; n < 2; ++n) acc[a][b][m][n] = (f32x4){0.f, 0.f, 0.f, 0.f}; }
    bf16x8 At[4][2], B0[2][2], B1[2][2];
    const char* cA = cur.A; const char* cB = cur.B;
    PG8_STAGE(PG8_SB(0, 0), cB, voffB); PG8_STAGE(PG8_SB(0, 1), cB + hstep, voffB); PG8_STAGE(PG8_SA(0, 0), cA, voffA); PG8_STAGE(PG8_SA(0, 1), cA + hstep, voffA);
    if (wr == 1) PG8_BAR;
    PG8_WAIT_V(2); PG8_BAR;
    PG8_STAGE(PG8_SB(1, 0), cB + kstep, voffB); PG8_STAGE(PG8_SA(1, 0), cA + kstep, voffA); PG8_STAGE(PG8_SB(1, 1), cB + hstep + kstep, voffB);
    PG8_WAIT_V(6); PG8_BAR;
    for (;;) {
        const bool has_next = S.next(ui + 1, nxt);
        const char* nA = has_next ? nxt.A : cA; const char* nB = has_next ? nxt.B : cB;
#pragma nounroll
        for (int t = 0; t < nt; t += 2) {
            const bool last = (t == nt - 2);
            if constexpr (Sched::DEPS) { if (last && has_next) S.wait(nxt, wid); }
            const char* a1 = cA + (size_t)(t + 1) * kstep;
            const char* a2 = last ? nA : cA + (size_t)(t + 2) * kstep; const char* b2 = last ? nB : cB + (size_t)(t + 2) * kstep;
            const char* a3 = a2 + kstep; const char* b3 = b2 + kstep;
            PG8_LDB(B0, 0, 0); PG8_LDB(B1, 0, 1); PG8_SCHED; PG8_LDA(At, 0, 0); PG8_STAGE(PG8_SA(1, 1), a1 + hstep, voffA);
            PG8_WAIT_V(8); PG8_WAIT_L(0); PG8_BAR; PG8_MMA(0, 0, At, B0); PG8_MMA(0, 1, At, B1); PG8_BAR; PG8_SCHED;
            PG8_LDA(At, 0, 1); PG8_STAGE(PG8_SB(0, 0), b2, voffB); PG8_STAGE(PG8_SB(0, 1), b2 + hstep, voffB); PG8_STAGE(PG8_SA(0, 0), a2, voffA);
            PG8_WAIT_V(8); PG8_WAIT_L(0); PG8_BAR; PG8_MMA(1, 0, At, B0); PG8_MMA(1, 1, At, B1); PG8_BAR; PG8_SCHED;
            PG8_LDB(B0, 1, 0); PG8_LDB(B1, 1, 1); PG8_SCHED; PG8_LDA(At, 1, 0); PG8_STAGE(PG8_SA(0, 1), a2 + hstep, voffA);
            PG8_WAIT_V(8); PG8_WAIT_L(0); PG8_BAR; PG8_MMA(0, 0, At, B0); PG8_MMA(0, 1, At, B1); PG8_BAR; PG8_SCHED;
            PG8_LDA(At, 1, 1); PG8_STAGE(PG8_SB(1, 0), b3, voffB); PG8_STAGE(PG8_SB(1, 1), b3 + hstep, voffB); PG8_STAGE(PG8_SA(1, 0), a3, voffA);
            PG8_WAIT_V(8); PG8_WAIT_L(0); PG8_BAR; PG8_MMA(1, 0, At, B0); PG8_MMA(1, 1, At, B1); PG8_BAR; PG8_SCHED;
        }
        if (wr == 0) PG8_BAR;
        E(acc, cur, wr, wc, fr, fq);
        if constexpr (Epi::SIGNAL) { PG8_WAIT_V(0); PG8_BAR; if (tid == 0) E.signal(cur); }
        if (!has_next) break;
        if constexpr (Epi::ACC_INIT) E.init(acc, nxt, wr, wc, fr, fq);
        else {
#pragma unroll
        for (int a = 0; a < 2; ++a)
#pragma unroll
            for (int b = 0; b < 2; ++b)
#pragma unroll
                for (int m = 0; m < 4; ++m)
#pragma unroll
                    for (int n = 0; n < 2; ++n) acc[a][b][m][n] = (f32x4){0.f, 0.f, 0.f, 0.f}; }
        cur = nxt; cA = nA; cB = nB; ++ui;
        if (wr == 1) PG8_BAR;
    }
    PG8_WAIT_V(0);
    PG8_BAR;
#undef PG8_SA
#undef PG8_SB
#undef PG8_STAGE
#undef PG8_LDA
#undef PG8_LDB
#undef PG8_MMA
#undef PG8_WAIT_V
#undef PG8_WAIT_L
#undef PG8_BAR
#undef PG8_SCHED
}
}

__device__ __forceinline__ void phase_gemm_pe(const Frame& F) {
    pg8::DenseOrder S; S.init(F.ws + WS_PB, F.ws + WS_WPE, T, D, PD, DEPTH, F.G, F.blk); pg8::EpiBf16 E{(bf16*)(F.ws + WS_PE), D};
    pg8::gemm_phase(F.wave, F.lds, PD, S, E);
}
__device__ __forceinline__ void phase_gemm_in(const Frame& F, int l) {
    pg8::DenseOrder S; S.init(F.ws + WS_XN, (bf16*)(F.ws + WS_WIN) + (size_t)l * DIN * D, T, DIN, D, 1, F.G, F.blk); pg8::EpiBf16 E{(bf16*)(F.ws + WS_Z), DIN};
    pg8::gemm_phase(F.wave, F.lds, D, S, E);
}
__device__ __forceinline__ void phase_gemm_out(const Frame& F, int l) {
    pg8::DenseOrder S; S.init(F.ws + WS_O, (bf16*)(F.ws + WS_WOUT) + (size_t)l * D * D, T, D, D, 1, F.G, F.blk); pg8::EpiResid E{(bf16*)(F.ws + WS_H)};
    pg8::gemm_phase(F.wave, F.lds, D, S, E);
}
__device__ __forceinline__ void phase_gemm_moe1(const Frame& F, int l) {
    pg8::MoeOrder S; S.init(F.ws + WS_XB, (bf16*)(F.ws + WS_WGU) + (size_t)l * NE * 1024 * 1024, (const int*)(F.ws + MS_BLKE) + l * 256, D, 4, (size_t)1024 * 1024 * 2, F.G, F.blk); pg8::EpiGateUp E{(bf16*)(F.ws + WS_HB)};
    pg8::gemm_phase(F.wave, F.lds, D, S, E);
    { const int nun = S.nrb * 4, rem = nun % F.G, few = (rem == 0 || F.G - rem < 64), idle = few ? F.G : F.G - rem, first = few ? 0 : rem;
      if (F.blk >= first) { pg8::DenseOrder P; P.init((const bf16*)(F.ws + WS_PB) + (size_t)l * T * PD, (const bf16*)(F.ws + WS_WPE) + (size_t)l * D * PD, T, D, PD, 1, idle, F.blk - first);
          pg8::EpiBf16 EP{(bf16*)(F.ws + WS_PE) + (size_t)l * T * D, D}; pg8::gemm_phase(F.wave, F.lds, PD, P, EP); }
      conv_deferred(F, l + 1, 0, NDEF1, first, idle); }
}
__device__ __forceinline__ void phase_gemm_moe2(const Frame& F, int l) {
    pg8::MoeOrder S; S.init(F.ws + WS_HB, (bf16*)(F.ws + WS_WD) + (size_t)l * NE * D * DE, (const int*)(F.ws + MS_BLKE) + l * 256, DE, 4, (size_t)D * DE * 2, F.G, F.blk); pg8::EpiBf16 E{(bf16*)(F.ws + WS_Y), D};
    pg8::gemm_phase(F.wave, F.lds, DE, S, E);
    { const int nun = S.nrb * 4, rem = nun % F.G, few = (rem == 0 || F.G - rem < 64), idle = few ? F.G : F.G - rem, first = few ? 0 : rem;
      conv_deferred(F, l + 1, NDEF1, NDEF, first, idle); }
}
#ifndef MOE_CPE
#define MOE_CPE 5
#endif
#ifndef MOE_CTL
#define MOE_CTL 4
#endif
#ifndef MOE_X1
#define MOE_X1 16
#define MOE_X2 8
#endif
template <int MODE = 0> __device__ __forceinline__ void phase_moe_fused(const Frame& F, int l) {
    unsigned char* ws = F.ws; const int G = F.G, blk = F.blk;
    const int* blke = (const int*)(ws + MS_BLKE) + l * 256;
    unsigned* done = (unsigned*)(ws + WS_CTL) + CW_DONE + l * 256;
    const int nrb = __builtin_amdgcn_readfirstlane(blke[255]), nu = 4 * nrb, e1 = nu % G;
    if constexpr (MODE == 1) { pg8::MoeOrder S; S.init(ws + WS_XB, (bf16*)(ws + WS_WGU) + (size_t)l * NE * 1024 * 1024, blke, D, 4, (size_t)1024 * 1024 * 2, G, blk);
      pg8::EpiGateUp E{(bf16*)(ws + WS_HB)}; pg8::gemm_phase(F.wave, F.lds, D, S, E); return; }
    if constexpr (MODE == 0) { pg8::MoeOrder S; S.init(ws + WS_XB, (bf16*)(ws + WS_WGU) + (size_t)l * NE * 1024 * 1024, blke, D, 4, (size_t)1024 * 1024 * 2, G, blk);
      pg8::EpiGateUpPub E{__builtin_amdgcn_make_buffer_rsrc(ws + WS_HB, 0, (int)((size_t)CAP * DE * 2), 0x00020000), done};
      pg8::gemm_phase(F.wave, F.lds, D, S, E); }
    if constexpr (MODE == 2) { pg8::MoeOrder S; S.init(ws + WS_HB, (bf16*)(ws + WS_WD) + (size_t)l * NE * D * DE, blke, DE, 4, (size_t)D * DE * 2, G, blk >= e1 ? blk - e1 : blk - e1 + G);
      pg8::EpiBf16 E{(bf16*)(ws + WS_Y), D}; pg8::gemm_phase(F.wave, F.lds, DE, S, E); }
    if constexpr (MODE == 0) { pg8::MoeDepOrder S; S.init(ws + WS_HB, (bf16*)(ws + WS_WD) + (size_t)l * NE * D * DE, blke, done, DE, 4, (size_t)D * DE * 2, G, blk >= e1 ? blk - e1 : blk - e1 + G);
      pg8::EpiBf16 E{(bf16*)(ws + WS_Y), D};
      pg8::gemm_phase(F.wave, F.lds, DE, S, E); }
    { const int nt = (l + 1 < DEPTH) ? NDEF : 0, ftot = 256 * MOE_CPE + nt * MOE_CTL;
      const int wrap = 2 * e1 > G ? 2 * e1 - G : 0;
      auto cls = [&](int x, int& c24, int& c16, int& c8, int& c0) {
          const int cA = x < e1 ? x : e1, cAB = x < wrap ? x : wrap;
          int cB = x - e1; cB = cB < 0 ? 0 : cB; if (!wrap) cB = cB > e1 ? e1 : cB; cB += cAB;
          c24 = cAB; c16 = cA - cAB; c8 = cB - cAB; c0 = x - c24 - c16 - c8; };
      auto fill = [&](int x, int lv) { int c24, c16, c8, c0; cls(x, c24, c16, c8, c0);
          return c0 * lv + c8 * (lv > MOE_X2 ? lv - MOE_X2 : 0) + c16 * (lv > MOE_X1 ? lv - MOE_X1 : 0) + c24 * (lv > MOE_X1 + MOE_X2 ? lv - MOE_X1 - MOE_X2 : 0); };
      int lv = 1; while (fill(G, lv) < ftot) ++lv;
      const int B0 = fill(blk, lv), B1 = fill(blk + 1, lv);
      const int pe_tot = 256 * MOE_CPE;
      int j0 = (B0 + MOE_CPE - 1) / MOE_CPE, j1 = (B1 + MOE_CPE - 1) / MOE_CPE; j0 = j0 < 256 ? j0 : 256; j1 = j1 < 256 ? j1 : 256;
      int t0 = B0 > pe_tot ? (B0 - pe_tot + MOE_CTL - 1) / MOE_CTL : 0, t1 = B1 > pe_tot ? (B1 - pe_tot + MOE_CTL - 1) / MOE_CTL : 0; t0 = t0 < nt ? t0 : nt; t1 = t1 < nt ? t1 : nt;
      if (j1 > j0) { pg8::RangeOrder P; P.init((const bf16*)(ws + WS_PB) + (size_t)l * T * PD, (const bf16*)(ws + WS_WPE) + (size_t)l * D * PD, T, D, PD, j0, j1 - j0);
          pg8::EpiBf16 EP{(bf16*)(ws + WS_PE) + (size_t)l * T * D, D}; pg8::gemm_phase(F.wave, F.lds, PD, P, EP); }
      if (t1 > t0) { const int base = (l + 1) * TL_LAYER + t0; conv_run(F, 0, 1, t1 - t0, [=](int f) { return base + f; }); } }
}
__device__ __forceinline__ void phase_gemm_pg(const Frame& F, int l) {
    pg8::DenseOrder S; S.init(F.ws + WS_XN, (bf16*)(F.ws + WS_WPG) + (size_t)l * D * D, T, D, D, 1, F.G, F.blk);
    pg8::EpiPG E{(bf16*)(F.ws + WS_H), (const bf16*)(F.ws + WS_PE) + (size_t)l * T * D, (const float*)(F.ws + MS_RSTDPE), F.in[22] + l * D};
    pg8::gemm_phase(F.wave, F.lds, D, S, E);
}

typedef short s16x4 __attribute__((ext_vector_type(4)));
__device__ __forceinline__ bf16x8 tr_frag(LAS unsigned char* p_lo, LAS unsigned char* p_hi) {
    const s16x4 lo = __builtin_amdgcn_ds_read_tr16_b64_v4i16((LAS s16x4*)p_lo), hi = __builtin_amdgcn_ds_read_tr16_b64_v4i16((LAS s16x4*)p_hi);
    return __builtin_shufflevector(lo, hi, 0, 1, 2, 3, 4, 5, 6, 7); }
#define MFMA16(a, b, c) __builtin_amdgcn_mfma_f32_16x16x32_bf16((a), (b), (c), 0, 0, 0)
constexpr int RP = 272;
constexpr int VP = 1040;

__device__ __forceinline__ void phase_rec_c1(const Frame& F, int l) {
    PH_TID();
    unsigned char* ws = F.ws; const bf16* Z = (const bf16*)(ws + WS_Z);
    bf16* UT = (bf16*)(ws + WS_UT); float* DC = (float*)(ws + MS_DC); float* MM = (float*)(ws + MS_MM);
    const float* lb = (const float*)(ws + MS_LB) + l * DREC;
    LAS unsigned char* KD = F.lds; LAS unsigned char* IM = F.lds + 128 * RP; LAS float* totx = (LAS float*)(F.lds + 256 * RP);
    const int wave = ph_wave, ch = tid & 255, half = tid >> 8, hl = ch >> 7, k = ch & 127, g = lane >> 4, li = lane & 15, q = li >> 2, p = li & 3;
    const int hG = F.G / 2, nmine = (F.G == 256) ? (F.blk < hG ? 4 : 0) : (F.blk < 512 ? (512 - F.blk + F.G - 1) / F.G : 0);
    const int ustep = (F.G == 256) ? hG : F.G;
    u32x4 pf[4], pi[4];
    auto fetch = [&](int unit) { const int c = unit >> 1, hp = unit & 1;
#pragma unroll
        for (int j = 0; j < 4; ++j) { const int idx = tid + 512 * j, hl2 = idx >> 10, row = (idx >> 4) & 63, cc = idx & 15;
            const bf16* src = Z + (size_t)(c * 64 + row) * DIN + 512 + (2 * hp + hl2) * 128 + cc * 8; pf[j] = *(const u32x4*)src; pi[j] = *(const u32x4*)(src + 512); } };
    if (nmine > 0) fetch(F.blk);
    for (int ui = 0; ui < nmine; ++ui) {
        const int unit = F.blk + ui * ustep;
        const int c = unit >> 1, hp = unit & 1, hh = 2 * hp + hl;
#pragma unroll
        for (int j = 0; j < 4; ++j) { const int idx = tid + 512 * j, hl2 = idx >> 10, row = (idx >> 4) & 63, cc = idx & 15; const int dst = (hl2 * 64 + row) * RP + cc * 16;
            *(LAS u32x4*)(KD + dst) = pf[j]; *(LAS u32x4*)(IM + dst) = pi[j]; }
        __syncthreads();
        if (ui + 1 < nmine) fetch(unit + ustep);
        const float lbk = lb[hh * 128 + k];
        float cs[32], kk[32]; float run = 1.f;
#pragma unroll
        for (int t = 0; t < 32; ++t) { const float fz = bf2f(*(const LAS bf16*)(KD + (hl * 64 + 32 * half + t) * RP + 2 * k)); const float sg = sigmoid_(fz); run *= lbk + (1.f - lbk) * sg; cs[t] = run; kk[t] = (1.f - lbk) * (1.f - sg); }
        totx[half * 256 + ch] = run;
        __syncthreads();
        const float other = totx[(1 - half) * 256 + ch]; const float p63 = run * other; const float base_p = half == 0 ? p63 : run;
#pragma unroll
        for (int t = 0; t < 32; ++t) *(LAS bf16*)(KD + (hl * 64 + 32 * half + t) * RP + 2 * k) = (bf16)f2bf(kk[t] * base_p * frcp(fmaxf(cs[t], 1e-30f)));
        if (half == 0) { DC[(c * 4 + hh) * 128 + k] = p63; MM[(c * 4 + hh) * 128 + k] = run; }
        __syncthreads();
        { const int whl = wave >> 2, kt0 = 2 * (wave & 3), whh = 2 * hp + whl;
          f32x4 acc[2][8];
#pragma unroll
          for (int i = 0; i < 2; ++i)
#pragma unroll
              for (int vt = 0; vt < 8; ++vt) acc[i][vt] = (f32x4){0.f, 0.f, 0.f, 0.f};
          LAS unsigned char* kdb = KD + whl * 64 * RP; LAS unsigned char* imb = IM + whl * 64 * RP;
#pragma unroll
          for (int a = 0; a < 2; ++a) { const unsigned ro = (unsigned)((32 * a + 8 * g + q) * RP);
              bf16x8 Af[2];
#pragma unroll
              for (int i = 0; i < 2; ++i) { const unsigned co = (unsigned)((16 * (kt0 + i) + 4 * p) * 2); Af[i] = tr_frag(kdb + ro + co, kdb + ro + 4 * RP + co); }
#pragma unroll
              for (int vt = 0; vt < 8; ++vt) { const unsigned co = (unsigned)((16 * vt + 4 * p) * 2); const bf16x8 Bf = tr_frag(imb + ro + co, imb + ro + 4 * RP + co);
#pragma unroll
                  for (int i = 0; i < 2; ++i) acc[i][vt] = MFMA16(Af[i], Bf, acc[i][vt]); } }
#pragma unroll
          for (int i = 0; i < 2; ++i)
#pragma unroll
              for (int vt = 0; vt < 8; ++vt) { u32x2 w; w.x = pg8::cvt_pk_bf16(acc[i][vt][0], acc[i][vt][1]); w.y = pg8::cvt_pk_bf16(acc[i][vt][2], acc[i][vt][3]);
                  *(u32x2*)(UT + ((size_t)(c * 4 + whh) * 128 + 16 * vt + li) * 128 + 16 * (kt0 + i) + 4 * g) = w; } }
        __syncthreads();
    }
}
__device__ __forceinline__ void phase_rec_c2a(const Frame& F) {
    PH_TID();
    unsigned char* ws = F.ws; const unsigned* UT = (const unsigned*)(ws + WS_UT); const float* DC = (const float*)(ws + MS_DC);
    f32x2* LT = (f32x2*)(ws + WS_LTOT); float* PT = (float*)(ws + MS_PTOT);
    for (int it = F.blk * NTHR + tid; it < 16 * 32768; it += F.G * NTHR) {
        const int gs = it >> 15, e = it & 32767, hh = e >> 13, v = (e >> 6) & 127, k0 = 2 * (e & 63);
        float S0 = 0.f, S1 = 0.f, P0 = 1.f, P1 = 1.f;
#pragma unroll
        for (int cc = 0; cc < 16; ++cc) { const int c = 16 * gs + cc; const unsigned u = UT[(size_t)c * 32768 + e]; const f32x2 d = *(const f32x2*)(DC + (c * 4 + hh) * 128 + k0);
            S0 = d.x * S0 + bflo(u); S1 = d.y * S1 + bfhi(u); P0 *= d.x; P1 *= d.y; }
        LT[it] = (f32x2){S0, S1};
        if (v == 0) *(f32x2*)(PT + (gs * 4 + hh) * 128 + k0) = (f32x2){P0, P1};
    }
}
__device__ __forceinline__ void phase_rec_c2c(const Frame& F) {
    PH_TID();
    unsigned char* ws = F.ws; const unsigned* UT = (const unsigned*)(ws + WS_UT); unsigned* ST = (unsigned*)(ws + WS_ST); const float* DC = (const float*)(ws + MS_DC); const float* MM = (const float*)(ws + MS_MM);
    const f32x2* LT = (const f32x2*)(ws + WS_LTOT); const float* PT = (const float*)(ws + MS_PTOT);
    for (int it = F.blk * NTHR + tid; it < 16 * 32768; it += F.G * NTHR) {
        const int gs = it >> 15, e = it & 32767, hh = e >> 13, k0 = 2 * (e & 63);
        float C0 = 0.f, C1 = 0.f;
        for (int g2 = 0; g2 < gs; ++g2) { const f32x2 pt = *(const f32x2*)(PT + (g2 * 4 + hh) * 128 + k0); const f32x2 lt = LT[g2 * 32768 + e]; C0 = pt.x * C0 + lt.x; C1 = pt.y * C1 + lt.y; }
#pragma unroll
        for (int cc = 0; cc < 16; ++cc) { const int c = 16 * gs + cc; const f32x2 mm = *(const f32x2*)(MM + (c * 4 + hh) * 128 + k0);
            ST[(size_t)c * 32768 + e] = pk2(C0 * mm.x, C1 * mm.y);
            const unsigned u = UT[(size_t)c * 32768 + e]; const f32x2 d = *(const f32x2*)(DC + (c * 4 + hh) * 128 + k0);
            C0 = d.x * C0 + bflo(u); C1 = d.y * C1 + bfhi(u); }
    }
}
__device__ __forceinline__ void phase_rec_c2(const Frame& F) {
    PH_TID();
    unsigned char* ws = F.ws; const int w = ph_wave;
    LAS float* tot = (LAS float*)F.lds;
    for (int unit = F.blk; unit < 256; unit += F.G) {
        const int hh = unit >> 6; const unsigned eo = (unsigned)(unit * 128 + lane), ko = (unsigned)(hh * 128 + 2 * lane);
        const unsigned* ut = (const unsigned*)(ws + WS_UT) + (size_t)(32 * w) * 32768; unsigned* st = (unsigned*)(ws + WS_ST) + (size_t)(32 * w) * 32768;
        const float* dc = (const float*)(ws + MS_DC) + (32 * w) * 512; const float* mmp = (const float*)(ws + MS_MM) + (32 * w) * 512;
        asm volatile("" : "+s"(ut), "+s"(st), "+s"(dc), "+s"(mmp));
        unsigned ua[32], ub[32]; f32x2 d[32], m0[16], m1[16];
#pragma unroll
        for (int cc = 0; cc < 32; ++cc) { ua[cc] = (ut + cc * 32768)[eo]; ub[cc] = (ut + cc * 32768 + 64)[eo]; d[cc] = *(const f32x2*)((dc + cc * 512) + ko); }
        __builtin_amdgcn_sched_barrier(0);
        float a0 = 0.f, a1 = 0.f, b0 = 0.f, b1 = 0.f, p0 = 1.f, p1 = 1.f;
#pragma unroll
        for (int cc = 0; cc < 32; ++cc) { a0 = d[cc].x * a0 + bflo(ua[cc]); a1 = d[cc].y * a1 + bfhi(ua[cc]); b0 = d[cc].x * b0 + bflo(ub[cc]); b1 = d[cc].y * b1 + bfhi(ub[cc]); p0 *= d[cc].x; p1 *= d[cc].y; }
        { LAS float* tw = tot + w * 384 + lane; tw[0] = a0; tw[64] = a1; tw[128] = b0; tw[192] = b1; tw[256] = p0; tw[320] = p1; }
        __builtin_amdgcn_sched_barrier(0);
#pragma unroll
        for (int cc = 0; cc < 16; ++cc) m0[cc] = *(const f32x2*)((mmp + cc * 512) + ko);
        __builtin_amdgcn_sched_barrier(0);
        __syncthreads();
        float A0 = 0.f, A1 = 0.f, B0 = 0.f, B1 = 0.f;
        for (int g2 = 0; g2 < w; ++g2) { const LAS float* tw = tot + g2 * 384 + lane; const float q0 = tw[256], q1 = tw[320]; A0 = q0 * A0 + tw[0]; A1 = q1 * A1 + tw[64]; B0 = q0 * B0 + tw[128]; B1 = q1 * B1 + tw[192]; }
        __builtin_amdgcn_sched_barrier(0);
#pragma unroll
        for (int cc = 0; cc < 16; ++cc) m1[cc] = *(const f32x2*)((mmp + (16 + cc) * 512) + ko);
        __builtin_amdgcn_sched_barrier(0);
#pragma unroll
        for (int cc = 0; cc < 32; ++cc) { const f32x2 mm = cc < 16 ? m0[cc & 15] : m1[cc & 15];
            (st + cc * 32768)[eo] = pk2(A0 * mm.x, A1 * mm.y); (st + cc * 32768 + 64)[eo] = pk2(B0 * mm.x, B1 * mm.y);
            unsigned xa = ua[cc], xb = ub[cc]; asm volatile("" : "+v"(xa), "+v"(xb));
            A0 = d[cc].x * A0 + bflo(xa); A1 = d[cc].y * A1 + bfhi(xa); B0 = d[cc].x * B0 + bflo(xb); B1 = d[cc].y * B1 + bfhi(xb);
            asm volatile("" : "+v"(A0), "+v"(A1), "+v"(B0), "+v"(B1) :: "memory"); }
        __syncthreads();
    }
}
template <int PV = 0> __device__ __forceinline__ void phase_rec_c3(const Frame& F, int l) {
    PH_TID();
    unsigned char* ws = F.ws; const bf16* Z = (const bf16*)(ws + WS_Z); const bf16* ST = (const bf16*)(ws + WS_ST); bf16* O = (bf16*)(ws + WS_O);
    const float* lb = (const float*)(ws + MS_LB) + l * DREC; const float* ogain = F.in[5] + l * 128;
    LAS unsigned char* QT = F.lds; LAS unsigned char* KT = F.lds + 128 * RP; LAS unsigned char* IM = F.lds + 256 * RP;
    const int wave = ph_wave, ch = tid & 255, half = tid >> 8, hl = ch >> 7, k = ch & 127, g = lane >> 4, li = lane & 15, q = li >> 2, p = li & 3;
    u32x4 pq[4], pf[4];
    const unsigned tvo = (unsigned)((tid >> 4) * DIN + (tid & 15) * 8), tlo = (unsigned)((tid >> 4) * RP + (tid & 15) * 16);
    auto fetch = [&](int unit) { const bf16* zc = Z + (size_t)(unit >> 1) * 64 * DIN + (unit & 1) * 256;
#pragma unroll
        for (int j = 0; j < 4; ++j) { const bf16* src = zc + (32 * (j & 1)) * DIN + (j >> 1) * 128; pq[j] = *(const u32x4*)(src + tvo); pf[j] = *(const u32x4*)(src + 512 + tvo); } };
    if (F.blk < 512) fetch(F.blk);
    for (int unit = F.blk; unit < 512; unit += F.G) {
        const int c = unit >> 1, hp = unit & 1, hh = 2 * hp + hl;
#pragma unroll
        for (int j = 0; j < 4; ++j) { const int dst = ((j >> 1) * 64 + 32 * (j & 1)) * RP;
            *(LAS u32x4*)(QT + dst + tlo) = pq[j]; *(LAS u32x4*)(KT + dst + tlo) = pf[j]; }
        u32x4 vi[4];
        { const bf16* zc = Z + (size_t)c * 64 * DIN + hp * 256 + 1024;
#pragma unroll
          for (int j = 0; j < 4; ++j) vi[j] = *(const u32x4*)(zc + (32 * (j & 1)) * DIN + (j >> 1) * 128 + tvo); }
        __syncthreads();
        { const float lbk = lb[hh * 128 + k]; const int col = (hl * 64 + 32 * half) * RP + 2 * k;
          float cs[32], kk[32], qs[32]; float run = 1.f;
#pragma unroll
          for (int t = 0; t < 32; ++t) { const float fz = bf2f(*(const LAS bf16*)(KT + col + t * RP)); const float sg = sigmoid_(fz); run *= lbk + (1.f - lbk) * sg; cs[t] = run; kk[t] = (1.f - lbk) * (1.f - sg);
              qs[t] = silu_(bf2f(*(const LAS bf16*)(QT + col + t * RP))); }
          const float inv = half == 0 ? frcp(fmaxf(run, 1e-30f)) : 1.f;
#pragma unroll
          for (int t = 0; t < 32; ++t) { const float ex = cs[t] * inv; const int off = col + t * RP;
              *(LAS bf16*)(QT + off) = (bf16)f2bf(qs[t] * ex); *(LAS bf16*)(KT + off) = (bf16)f2bf(kk[t] * frcp(fmaxf(ex, 1e-30f))); } }
#pragma unroll
        for (int j = 0; j < 4; ++j) *(LAS u32x4*)(IM + ((j >> 1) * 64 + 32 * (j & 1)) * RP + tlo) = vi[j];
        const int whl = wave >> 2, tt = wave & 3, whh = 2 * hp + whl;
        bf16x8 Sf[8][4];
#pragma unroll
        for (int vt = 0; vt < 8; ++vt)
#pragma unroll
            for (int a = 0; a < 4; ++a) Sf[vt][a] = *(const bf16x8*)(ST + ((size_t)(c * 4 + whh) * 128 + 16 * vt + li) * 128 + 32 * a + 8 * g);
        __syncthreads();
        if (PV != 1) {
          bf16 gz[8][4];
#pragma unroll
          for (int vt = 0; vt < 8; ++vt)
#pragma unroll
              for (int r = 0; r < 4; ++r) gz[vt][r] = Z[((size_t)c * 64 + 16 * tt + 4 * g + r) * DIN + 1536 + whh * 128 + 16 * vt + li];
          bf16x8 Qf[4];
#pragma unroll
          for (int a = 0; a < 4; ++a) Qf[a] = *(const LAS bf16x8*)(QT + (whl * 64 + 16 * tt + li) * RP + (32 * a + 8 * g) * 2);
          unsigned pw[4][2];
#pragma unroll
          for (int st = 0; st < 4; ++st) { pw[st][0] = 0u; pw[st][1] = 0u;
              { f32x4 s = (f32x4){0.f, 0.f, 0.f, 0.f};
#pragma unroll
                  for (int a = 0; a < 4; ++a) { const bf16x8 Kf = *(const LAS bf16x8*)(KT + (whl * 64 + 16 * st + li) * RP + (32 * a + 8 * g) * 2); s = MFMA16(Kf, Qf[a], s); }
                  if (st == tt) {
#pragma unroll
                      for (int r = 0; r < 4; ++r) if (4 * g + r > li) s[r] = 0.f; }
                  pw[st][0] = st <= tt ? pg8::cvt_pk_bf16(s[0], s[1]) : 0u; pw[st][1] = st <= tt ? pg8::cvt_pk_bf16(s[2], s[3]) : 0u; } }
          f32x4 acc[8];
#pragma unroll
          for (int vt = 0; vt < 8; ++vt) { acc[vt] = (f32x4){0.f, 0.f, 0.f, 0.f};
#pragma unroll
              for (int a = 0; a < 4; ++a) acc[vt] = MFMA16(Qf[a], Sf[vt][a], acc[vt]); }
          __builtin_amdgcn_sched_barrier(0);
          if (unit + F.G < 512) fetch(unit + F.G);
          __builtin_amdgcn_sched_barrier(0);
          LAS unsigned char* imb = IM + whl * 64 * RP;
#pragma unroll
          for (int a = 0; a < 2; ++a) { const u32x4 pv = (u32x4){pw[2 * a][0], pw[2 * a][1], pw[2 * a + 1][0], pw[2 * a + 1][1]}; const bf16x8 Pf = __builtin_bit_cast(bf16x8, pv);
              const unsigned ro = (unsigned)((32 * a + 4 * g + q) * RP);
#pragma unroll
              for (int vt = 0; vt < 8; ++vt) { const unsigned co = (unsigned)((16 * vt + 4 * p) * 2); const bf16x8 If = tr_frag(imb + ro + co, imb + ro + 16 * RP + co); acc[vt] = MFMA16(Pf, If, acc[vt]); } }
          float rs[4];
#pragma unroll
          for (int r = 0; r < 4; ++r) { float ss = 0.f;
#pragma unroll
              for (int vt = 0; vt < 8; ++vt) ss += acc[vt][r] * acc[vt][r];
              ss += shx<1>(ss); ss += shx<2>(ss); ss += shx<4>(ss); ss += shx<8>(ss); rs[r] = frsq(ss * (1.f / 128.f) + EPS); }
#pragma unroll
          for (int vt = 0; vt < 8; ++vt) { const float og = ogain[16 * vt + li];
#pragma unroll
              for (int r = 0; r < 4; ++r) { const size_t t = (size_t)c * 64 + 16 * tt + 4 * g + r; const float gv = bf2f(gz[vt][r]);
                  O[t * D + whh * 128 + 16 * vt + li] = (bf16)f2bf(acc[vt][r] * rs[r] * og * silu_(gv)); } } }
        __syncthreads();
    }
}
__device__ __forceinline__ void phase_sgu(const Frame& F, int l) {
    PH_TID();
    unsigned char* ws = F.ws; const bf16* Z = (const bf16*)(ws + WS_Z); bf16* O = (bf16*)(ws + WS_O);
    const bf16* Wb = (const bf16*)(ws + MS_SGUW) + (size_t)l * 4 * 128 * 128; const float* sb = F.in[9] + l * 4 * 128;
    LAS unsigned char* VN = F.lds;
    const int wave = ph_wave, g = lane >> 4, li = lane & 15, q = li >> 2, p = li & 3;
    for (int unit = (F.blk + F.G / 2) % F.G; unit < 128; unit += F.G) {
        float lg[8], lbv[8];
#pragma unroll
        for (int j = 0; j < 8; ++j) { lg[j] = F.in[6][l * DSGU + 8 * lane + j]; lbv[j] = F.in[7][l * DSGU + 8 * lane + j]; }
        u32x4 raw[16];
#pragma unroll
        for (int i = 0; i < 16; ++i) raw[i] = *(const u32x4*)(Z + ((size_t)unit * 128 + 16 * wave + i) * DIN + 2560 + 8 * lane);
#pragma unroll
        for (int i = 0; i < 16; ++i) { const int s = 16 * wave + i; const u32x4 r = raw[i];
            float x[8] = {gelu_(bflo(r.x)), gelu_(bfhi(r.x)), gelu_(bflo(r.y)), gelu_(bfhi(r.y)), gelu_(bflo(r.z)), gelu_(bfhi(r.z)), gelu_(bflo(r.w)), gelu_(bfhi(r.w))};
            float sm = 0.f, qq = 0.f;
#pragma unroll
            for (int j = 0; j < 8; ++j) { sm += x[j]; qq += x[j] * x[j]; }
            sm += shx<1>(sm); qq += shx<1>(qq); sm += shx<2>(sm); qq += shx<2>(qq); sm += shx<4>(sm); qq += shx<4>(qq); sm += shx<8>(sm); qq += shx<8>(qq); sm += shx<16>(sm); qq += shx<16>(qq);
            const float mu = halves_sum(sm) * (1.f / 512.f); const float var = fmaxf(halves_sum(qq) * (1.f / 512.f) - mu * mu, 0.f);
            const float rstd = frsq(var + EPS);
#pragma unroll
            for (int j = 0; j < 8; ++j) x[j] = (x[j] - mu) * rstd * lg[j] + lbv[j];
            u32x4 o; o.x = pk2(x[0], x[1]); o.y = pk2(x[2], x[3]); o.z = pk2(x[4], x[5]); o.w = pk2(x[6], x[7]);
            *(LAS u32x4*)(VN + s * VP + lane * 16) = o; }
        __syncthreads();
        { const int hh = wave >> 1, dh = wave & 1; const bf16* W = Wb + (size_t)hh * 128 * 128;
          LAS unsigned char* vnb = VN;
#pragma unroll 1
          for (int dp = 0; dp < 2; ++dp) {
          bf16x8 Wf[2][8];
#pragma unroll
          for (int a = 0; a < 2; ++a)
#pragma unroll
              for (int ti = 0; ti < 8; ++ti) if (ti >= 2 * a) Wf[a][ti] = *(const bf16x8*)(W + (size_t)(16 * ti + li) * 128 + 32 * a + 8 * g);
          u32x2 uu[8][2]; float bs[8];
#pragma unroll
          for (int ti = 0; ti < 8; ++ti) { bs[ti] = sb[hh * 128 + 16 * ti + li];
#pragma unroll
              for (int dt = 0; dt < 2; ++dt) uu[ti][dt] = *(const u32x2*)(Z + ((size_t)unit * 128 + 16 * ti + li) * DIN + 2048 + hh * 128 + 64 * dh + 16 * (2 * dp + dt) + 4 * g); }
          f32x4 acc[2][8];
#pragma unroll
          for (int dt = 0; dt < 2; ++dt)
#pragma unroll
              for (int ti = 0; ti < 8; ++ti) acc[dt][ti] = (f32x4){0.f, 0.f, 0.f, 0.f};
#pragma unroll
          for (int a = 0; a < 4; ++a) { const unsigned ro = (unsigned)((32 * a + 8 * g + q) * VP);
              bf16x8 Af[2];
#pragma unroll
              for (int dt = 0; dt < 2; ++dt) { const unsigned co = (unsigned)((hh * 128 + 64 * dh + 16 * (2 * dp + dt) + 4 * p) * 2); Af[dt] = tr_frag(vnb + ro + co, vnb + ro + 4 * VP + co); }
#pragma unroll
              for (int ti = 0; ti < 8; ++ti) if (ti >= 2 * a) {
                  const bf16x8 Bf = a < 2 ? Wf[a < 2 ? a : 0][ti] : *(const bf16x8*)(W + (size_t)(16 * ti + li) * 128 + 32 * a + 8 * g);
#pragma unroll
                  for (int dt = 0; dt < 2; ++dt) acc[dt][ti] = MFMA16(Af[dt], Bf, acc[dt][ti]); } }
#pragma unroll
          for (int ti = 0; ti < 8; ++ti) { const size_t t = (size_t)unit * 128 + 16 * ti + li; const float bias = bs[ti];
#pragma unroll
              for (int dt = 0; dt < 2; ++dt) { const int col = hh * 128 + 64 * dh + 16 * (2 * dp + dt) + 4 * g; const u32x2 u = uu[ti][dt];
                  u32x2 w; w.x = pk2((acc[dt][ti][0] + bias) * gelu_(bflo(u.x)), (acc[dt][ti][1] + bias) * gelu_(bfhi(u.x))); w.y = pk2((acc[dt][ti][2] + bias) * gelu_(bflo(u.y)), (acc[dt][ti][3] + bias) * gelu_(bfhi(u.y)));
                  *(u32x2*)(O + t * D + 512 + col) = w; } } } }
        __syncthreads();
    }
}

#define XB_TMO      128
#define XB_XCNT(j)  (256  + 64 * (j))
#define XB_XSUB(j)  (1280 + 64 * (j))
#define XB_XGEN(j)  (2304 + 64 * (j))
#define XB_TOP      3328
#define XB_TOPGEN   3392
#define XCD_BAR_WORDS 3456
#define XB_SPIN_CAP (1u << 18)
__device__ __forceinline__ unsigned xb_ld(unsigned* p)              { return __hip_atomic_load(p, __ATOMIC_RELAXED, __HIP_MEMORY_SCOPE_AGENT); }
__device__ __forceinline__ unsigned xb_add(unsigned* p, unsigned v) { return __hip_atomic_fetch_add(p, v, __ATOMIC_RELAXED, __HIP_MEMORY_SCOPE_AGENT); }
__device__ __forceinline__ unsigned xb_xcc_id() { return (unsigned)__builtin_amdgcn_s_getreg((3 << 11) | 20) & 0xFu; }
#define XB_SPIN(cond, bar) do { unsigned _sp = 0; while (cond) { __builtin_amdgcn_s_sleep(1); \
    if ((++_sp & 255u) == 0u) { if (xb_ld(&(bar)[XB_TMO])) break; if (_sp > XB_SPIN_CAP) { atomicAdd(&(bar)[XB_TMO], 1u); break; } } } } while (0)
struct XcdBarrier { unsigned* bar; unsigned x; volatile LAS unsigned* st; int wave; };
__device__ __forceinline__ XcdBarrier xcd_barrier_post(unsigned* bar, volatile LAS unsigned* st, int wave) {
    XcdBarrier b; b.bar = bar; b.x = xb_xcc_id(); b.st = st; b.wave = wave;
    if (wave == 0 && lane_now() == 0) (void)xb_add(&bar[XB_XCNT(b.x)], 1u);
    return b;
}
__device__ __forceinline__ void xcd_barrier_complete(unsigned* bar, unsigned x, unsigned& nloc, unsigned& nx) {
    const unsigned G = gridDim.x * gridDim.y * gridDim.z;
    unsigned sum, cnt, mine, sp = 0u;
    for (;;) {
        sum = 0u; cnt = 0u; mine = 0u;
#pragma unroll
        for (unsigned j = 0; j < 16; ++j) { const unsigned c = xb_ld(&bar[XB_XCNT(j)]); sum += c; cnt += (c > 0u) ? 1u : 0u; mine = (j == x) ? c : mine; }
        if (sum == G) break;
        __builtin_amdgcn_s_sleep(1);
        if ((++sp & 255u) == 0u) { if (xb_ld(&bar[XB_TMO])) break; if (sp > XB_SPIN_CAP) { atomicAdd(&bar[XB_TMO], 1u); break; } }
    }
    nloc = mine > 0u ? mine : 1u; nx = cnt > 0u ? cnt : 1u;
}
__device__ __forceinline__ void xcd_barrier(const XcdBarrier& b) {
    asm volatile("s_waitcnt vmcnt(0)" ::: "memory");
    __syncthreads();
    if (b.wave == 0 && lane_now() == 0) {
        unsigned* bar = b.bar;
        __builtin_amdgcn_s_waitcnt(0);
        unsigned nloc = b.st[0], nx = b.st[1];
        if (nloc == 0u) { xcd_barrier_complete(bar, b.x, nloc, nx); b.st[0] = nloc; b.st[1] = nx; }
        const unsigned old = xb_add(&bar[XB_XSUB(b.x)], 1u);
        const unsigned gen = old / nloc;
        if (old + 1u == (gen + 1u) * nloc) {
            __builtin_amdgcn_fence(__ATOMIC_RELEASE, "agent");
            asm volatile("s_waitcnt vmcnt(0)" ::: "memory");
            const unsigned og = xb_add(&bar[XB_TOP], 1u);
            const unsigned tg = og / nx;
            if (og + 1u == (tg + 1u) * nx) xb_add(&bar[XB_TOPGEN], 1u);
            else XB_SPIN(xb_ld(&bar[XB_TOPGEN]) == tg, bar);
            __builtin_amdgcn_fence(__ATOMIC_ACQUIRE, "agent");
            xb_add(&bar[XB_XGEN(b.x)], 1u);
            asm volatile("s_waitcnt vmcnt(0)" ::: "memory");
        } else {
            XB_SPIN(xb_ld(&bar[XB_XGEN(b.x)]) == gen, bar);
            __builtin_amdgcn_fence(__ATOMIC_ACQUIRE, "agent");
            asm volatile("s_waitcnt vmcnt(0)" ::: "memory");
        }
    }
    __syncthreads();
}


__device__ __forceinline__ void xcd_barrier_bg(const XcdBarrier& b, const Frame& F, int lnext, bool drain) {
    asm volatile("s_waitcnt vmcnt(0)" ::: "memory");
    __syncthreads();
    volatile LAS unsigned* sx = b.st + 4;
    unsigned* q = (unsigned*)(F.ws + WS_CTL) + CW_BGQ + lnext * 64;
    if (b.wave == 0 && lane_now() == 0) {
        unsigned* bar = b.bar;
        __builtin_amdgcn_s_waitcnt(0);
        unsigned nloc = b.st[0], nx = b.st[1];
        if (nloc == 0u) { xcd_barrier_complete(bar, b.x, nloc, nx); b.st[0] = nloc; b.st[1] = nx; }
        const unsigned old = xb_add(&bar[XB_XSUB(b.x)], 1u);
        const unsigned gen = old / nloc;
        const bool leader = (old + 1u == (gen + 1u) * nloc);
        unsigned ti = 0u; if (!leader) { const unsigned k = xb_add(q, 1u); if (k < (unsigned)NBG) ti = k + 1u; }
        sx[0] = leader ? 1u : 0u; sx[1] = gen; sx[2] = ti;
    }
    __syncthreads();
    if (__builtin_amdgcn_readfirstlane(sx[0]) == 0u) {
        unsigned ti = (unsigned)__builtin_amdgcn_readfirstlane(sx[2]);
        while (ti != 0u) {
            const int it = lnext * TL_LAYER + NDEF + (int)ti - 1;
            conv_run(F, 0, 1, 1, [=](int) { return it; });
            if (!drain) break;
            if (b.wave == 0 && lane_now() == 0) { const unsigned k = xb_add(q, 1u); sx[2] = k < (unsigned)NBG ? k + 1u : 0u; }
            __syncthreads();
            ti = (unsigned)__builtin_amdgcn_readfirstlane(sx[2]);
            __syncthreads();
        }
    }
    if (b.wave == 0 && lane_now() == 0) {
        unsigned* bar = b.bar; const unsigned gen = sx[1], nx = b.st[1];
        asm volatile("s_waitcnt vmcnt(0)" ::: "memory");
        if (sx[0] != 0u) {
            __builtin_amdgcn_fence(__ATOMIC_RELEASE, "agent");
            asm volatile("s_waitcnt vmcnt(0)" ::: "memory");
            const unsigned og = xb_add(&bar[XB_TOP], 1u);
            const unsigned tg = og / nx;
            if (og + 1u == (tg + 1u) * nx) xb_add(&bar[XB_TOPGEN], 1u);
            else XB_SPIN(xb_ld(&bar[XB_TOPGEN]) == tg, bar);
            __builtin_amdgcn_fence(__ATOMIC_ACQUIRE, "agent");
            xb_add(&bar[XB_XGEN(b.x)], 1u);
            asm volatile("s_waitcnt vmcnt(0)" ::: "memory");
        } else {
            XB_SPIN(xb_ld(&bar[XB_XGEN(b.x)]) == gen, bar);
            __builtin_amdgcn_fence(__ATOMIC_ACQUIRE, "agent");
            asm volatile("s_waitcnt vmcnt(0)" ::: "memory");
        }
    }
    __syncthreads();
}

__device__ __forceinline__ bool opq(Frame& F) { asm volatile("" : "+s"(F.ws), "+s"(F.blk), "+s"(F.out), "+s"(F.G)); return true; }
__device__ __forceinline__ int lq_(int l) { asm volatile("" : "+s"(l)); return l; }
__global__ void __launch_bounds__(NTHR, 2) k_mega(Params p) {
    extern __shared__ __attribute__((aligned(16))) unsigned char lds[];
    Frame F; F.lds = (LAS unsigned char*)lds; F.ws = p.ws; F.in = p.in; F.out = p.out; F.wave = __builtin_amdgcn_readfirstlane(threadIdx.x >> 6); F.blk = blockIdx.x; F.G = gridDim.x;
    volatile LAS unsigned* st = (volatile LAS unsigned*)(F.lds + LDS_BYTES - 32);
    if (threadIdx.x < 8) st[threadIdx.x] = 0u;
    __syncthreads();
#if USE_CG_SYNC
#define GRID_BAR() cooperative_groups::this_grid().sync()
#else
    const XcdBarrier bar = xcd_barrier_post((unsigned*)(p.ws + WS_CTL) + CW_BAR + p.li * XCD_BAR_WORDS, st, F.wave);
#define GRID_BAR() xcd_barrier(bar)
#endif
    const int lo = p.ph_lo, hi = p.ph_hi;
#define RUN(k) (lo <= (k) && (k) < hi && opq(F))
#define SEAM(k) do { if (RUN(k) && RUN((k) + 1)) GRID_BAR(); } while (0)
#define SEAM_BG(k, drain) do { if (RUN(k) && RUN((k) + 1)) { if (!USE_CG_SYNC && l + 1 < DEPTH) xcd_barrier_bg(bar, F, l + 1, drain); else GRID_BAR(); } } while (0)
    if (RUN(0)) { phase_prologue(F); if (PROBE_DUP & 16) { __syncthreads(); phase_prologue(F); } }
    SEAM(0);
    for (int l = 0; l < DEPTH; ++l) {
        const int b = 2 + 13 * l;
        if (RUN(b + 0)) phase_norm1(F, lq_(l));
        SEAM_BG(b + 0, false);
        if (RUN(b + 1)) phase_gemm_in(F, lq_(l));
        SEAM_BG(b + 1, false);
        if (RUN(b + 2)) { phase_rec_c1(F, lq_(l)); phase_sgu(F, lq_(l)); if (PROBE_DUP & 1) { __syncthreads(); phase_rec_c1(F, lq_(l)); phase_sgu(F, lq_(l)); } if (PROBE_DUP & 64) { __syncthreads(); phase_sgu(F, lq_(l)); } }
        SEAM_BG(b + 2, false);
        if (RUN(b + 3)) { phase_rec_c2(F); if (PROBE_DUP & 4) phase_rec_c2(F); }
        SEAM_BG(b + 3, false);
        if (RUN(b + 5)) { phase_rec_c3(F, lq_(l)); if (PROBE_DUP & 2) { __syncthreads(); phase_rec_c3(F, lq_(l)); } if (PROBE_DUP & 128) { __syncthreads(); phase_rec_c3<1>(F, lq_(l)); } }
        SEAM_BG(b + 5, false);
        if (RUN(b + 6)) phase_gemm_out(F, lq_(l));
        SEAM_BG(b + 6, false);
        if (RUN(b + 7)) phase_norm2(F, lq_(l));
        SEAM_BG(b + 7, false);
        if (RUN(b + 8)) { phase_gather(F, lq_(l)); if (PROBE_DUP & 8) { __syncthreads(); phase_gather(F, lq_(l)); } }
        SEAM_BG(b + 8, false);
#if MOE_FUSED == 1
        if (RUN(b + 9)) phase_moe_fused(F, lq_(l));
        SEAM_BG(b + 9, false);
#elif MOE_FUSED == 2
        if (RUN(b + 9)) phase_moe_fused<1>(F, lq_(l));
        SEAM_BG(b + 9, false);
        if (RUN(b + 10)) phase_moe_fused<2>(F, lq_(l));
        SEAM_BG(b + 10, false);
#else
        if (RUN(b + 9)) phase_gemm_moe1(F, lq_(l));
        SEAM_BG(b + 9, false);
        if (RUN(b + 10)) phase_gemm_moe2(F, lq_(l));
        SEAM_BG(b + 10, false);
#endif
        if (RUN(b + 11)) phase_combine(F, lq_(l));
        SEAM_BG(b + 11, true);
        if (RUN(b + 12)) phase_gemm_pg(F, lq_(l));
        SEAM(b + 12);
    }
    if (RUN(54)) phase_final(F);
#undef RUN
#undef SEAM
}

#ifndef ONE_LAUNCH
#define ONE_LAUNCH 1
#endif
#ifndef CUTS
#define CUTS {0, 55}
#endif
#ifndef MFMA_MASK
#define MFMA_MASK 255
#endif
extern "C" void kernel_launch(void* const* d_in, const int* in_sizes, int n_in, void* d_out, int out_size, void* d_ws, size_t ws_size, hipStream_t stream) {
    if (n_in != 24 || out_size != T * D || ws_size < WS_END) { fprintf(stderr, "kernel_launch: unexpected shapes (n_in %d out %d ws %zu)\n", n_in, out_size, ws_size); return; }
    static_assert(CW_BAR + 60 * XCD_BAR_WORDS <= (int)(CTL_BYTES / 4), "barrier regions inside the zeroed control words");
    Params p{}; for (int i = 0; i < 24; ++i) p.in[i] = (const float*)d_in[i]; p.out = (float*)d_out; p.ws = (unsigned char*)d_ws;
    unsigned char* ws = p.ws;
    (void)hipMemsetAsync(ws + WS_CTL, 0, CTL_BYTES, stream);
    { static bool attr = false; if (!attr) { (void)hipFuncSetAttribute((const void*)k_mega, hipFuncAttributeMaxDynamicSharedMemorySize, LDS_BYTES); attr = true; }
      const int cuts[] = CUTS; const int ncut = (int)(sizeof(cuts) / sizeof(cuts[0]));
      for (int i = 0; i + 1 < ncut; ++i) { p.ph_lo = cuts[i]; p.ph_hi = cuts[i + 1]; p.li = i; p.pad = 0;
#if USE_CG_SYNC
          void* args[] = {&p}; hipError_t e = hipLaunchCooperativeKernel((const void*)k_mega, dim3(256), dim3(NTHR), args, LDS_BYTES, stream);
          if (e != hipSuccess) fprintf(stderr, "cooperative launch failed: %s\n", hipGetErrorName(e));
#else
          hipLaunchKernelGGL(k_mega, dim3(256), dim3(NTHR), LDS_BYTES, stream, p);
#endif
      }
    }
}
```

```cpp
#include <hip/hip_runtime.h>
#include <hip/hip_cooperative_groups.h>
#include <cstdio>
#include <cstdint>

#define GAS __attribute__((address_space(1)))
#define LAS __attribute__((address_space(3)))
typedef unsigned short bf16;
typedef float f32x4 __attribute__((ext_vector_type(4)));
typedef float f32x2 __attribute__((ext_vector_type(2)));
typedef unsigned u32x4 __attribute__((ext_vector_type(4)));
typedef unsigned u32x2 __attribute__((ext_vector_type(2)));
typedef short bf16x8 __attribute__((ext_vector_type(8)));

constexpr int T = 16384, D = 1024, DEPTH = 4, DIN = 3072, DREC = 512, DSGU = 512;
constexpr int NE = 32, DE = 512, PD = 256;
constexpr int RB = 256;
constexpr int CAP = 2 * T + NE * RB;
constexpr int NRBMAX = CAP / RB;
constexpr float EPS = 1e-6f;
constexpr int NWAVES = 8, NTHR = 512;

constexpr size_t MiB = 1u << 20, KiB = 1u << 10;
constexpr size_t WS_CTL = 0, CTL_BYTES = 1 * MiB;
constexpr size_t WS_MISC = 1 * MiB;
constexpr size_t MS_TOKE = WS_MISC + 0;
constexpr size_t MS_TOKW = WS_MISC + 128 * KiB;
constexpr size_t MS_SINFO = WS_MISC + 256 * KiB;
constexpr size_t MS_SDEST = WS_MISC + 384 * KiB;
constexpr size_t MS_RSTDPE = WS_MISC + 512 * KiB;
constexpr size_t MS_BLKBASE = WS_MISC + 576 * KiB;
constexpr size_t MS_LB = WS_MISC + 608 * KiB;
constexpr size_t MS_BLKE = WS_MISC + 640 * KiB;
constexpr size_t MS_DC = WS_MISC + 1 * MiB;
constexpr size_t MS_WRT = WS_MISC + 2 * MiB;
constexpr size_t MS_SGUW = WS_MISC + 3 * MiB;
constexpr size_t MS_MM = WS_MISC + 4 * MiB;
constexpr size_t MS_PTOT = WS_MISC + 5 * MiB;
constexpr size_t WS_WIN = 16 * MiB;
constexpr size_t WS_WOUT = 40 * MiB;
constexpr size_t WS_WGU = 48 * MiB;
constexpr size_t WS_WD = 304 * MiB;
constexpr size_t WS_WPG = 432 * MiB;
constexpr size_t WS_WPE = 440 * MiB;
constexpr size_t WS_PB = 442 * MiB;
constexpr size_t WS_H = 474 * MiB;
constexpr size_t WS_XN = 538 * MiB;
constexpr size_t WS_O = 570 * MiB;
constexpr size_t WS_PE = 602 * MiB;
constexpr size_t WS_R1 = 730 * MiB;
constexpr size_t WS_Z = WS_R1;
constexpr size_t WS_UT = WS_R1 + 96 * MiB;
constexpr size_t WS_ST = WS_R1 + 128 * MiB;
constexpr size_t WS_ORAW = WS_R1 + 96 * MiB;
constexpr size_t WS_VN = WS_R1 + 128 * MiB;
constexpr size_t WS_XB = WS_R1;
constexpr size_t WS_HB = WS_R1 + 80 * MiB;
constexpr size_t WS_Y = WS_R1 + 120 * MiB;
constexpr size_t WS_LTOT = 930 * MiB;
constexpr size_t WS_END = 934 * MiB;
constexpr int CW_CNT = 64;
constexpr int CW_BGQ = 1024;
constexpr int CW_DONE = 2048;
constexpr int CW_BAR = 4096;

constexpr int RING_BYTES = 131072, MISC_OFF = RING_BYTES, LDS_BYTES = 147456;

#ifndef PROBE_DUP
#define PROBE_DUP 0
#endif
#ifndef MOE_VBLK
#define MOE_VBLK 1
#endif
#ifndef MOE_FUSED
#define MOE_FUSED 1
#endif
#ifndef USE_CG_SYNC
#define USE_CG_SYNC 0
#endif
struct Params { const float* in[24]; float* out; unsigned char* ws; int ph_lo, ph_hi, li, pad; };

#define LDS_WAIT() asm volatile("s_waitcnt lgkmcnt(0)" ::: "memory")
template <int M> __device__ __forceinline__ float shx(float v) { static_assert(M >= 1 && M < 32, "swizzle xor mask");
    return __int_as_float(__builtin_amdgcn_ds_swizzle(__float_as_int(v), (M << 10) | 0x1F)); }
__device__ __forceinline__ float halves_sum(float v) {
    return __int_as_float(__builtin_amdgcn_readlane(__float_as_int(v), 0)) + __int_as_float(__builtin_amdgcn_readlane(__float_as_int(v), 32)); }
__device__ __forceinline__ float wave_sum(float v) {
    v += shx<1>(v); v += shx<2>(v); v += shx<4>(v); v += shx<8>(v); v += shx<16>(v);
    return halves_sum(v);
}
typedef __bf16 bf16x2_t __attribute__((ext_vector_type(2)));
__device__ __forceinline__ unsigned pk2(float lo, float hi) { const bf16x2_t v = __builtin_convertvector((f32x2){lo, hi}, bf16x2_t); return __builtin_bit_cast(unsigned, v); }
__device__ __forceinline__ unsigned f2bf(float f) { return pk2(f, f) & 0xffffu; }
__device__ __forceinline__ float bflo(unsigned w) { return __uint_as_float(w << 16); }
__device__ __forceinline__ float bfhi(unsigned w) { return __uint_as_float(w & 0xffff0000u); }
__device__ __forceinline__ float bf2f(bf16 b) { return __uint_as_float(((unsigned)b) << 16); }
__device__ __forceinline__ float fexp(float x) { return __builtin_amdgcn_exp2f(x * 1.4426950408889634f); }
__device__ __forceinline__ float flog(float x) { return __builtin_amdgcn_logf(x) * 0.6931471805599453f; }
__device__ __forceinline__ float frcp(float x) { return __builtin_amdgcn_rcpf(x); }
__device__ __forceinline__ float frsq(float x) { return __builtin_amdgcn_rsqf(x); }
__device__ __forceinline__ float sigmoid_(float x) { return frcp(1.f + fexp(-x)); }
__device__ __forceinline__ float silu_(float x) { return x * sigmoid_(x); }
__device__ __forceinline__ float gelu_(float x) { const float K1 = 2.f * 0.7978845608028654f * 1.4426950408889634f, K3 = K1 * 0.044715f;
    const float r = frcp(__builtin_amdgcn_exp2f(x * (K1 + K3 * (x * x))) + 1.f); return x - x * r; }

struct Frame {
    LAS unsigned char* lds; unsigned char* ws; const float* const* in; float* out;
    int wave, blk, G;
};
__device__ __forceinline__ int lane_now() { int l; asm volatile("v_mbcnt_lo_u32_b32 %0, -1, 0\n\tv_mbcnt_hi_u32_b32 %0, -1, %0" : "=v"(l)); return l; }
__device__ __forceinline__ int vblk(int b) { return 4 * (8 * (b & 7) + (b >> 5)) + ((b >> 3) & 3); }
#define PH_TID() int ph_wave = F.wave; asm volatile("" : "+s"(ph_wave)); const int lane = lane_now(); (void)lane; const int tid = (ph_wave << 6) | lane; (void)tid

struct ConvJob { const float* W; const float* g; bf16* WT; int K, N, k0, n0, mode; };
constexpr int TL_IN = 16 * 12, TL_OUT = 16 * 4, TL_G = 32 * 16 * 2, TL_D = 32 * 8 * 4, TL_PG = 16 * 4, TL_PE = 4 * 4;
constexpr int TL_LAYER = TL_IN + TL_OUT + 2 * TL_G + TL_D + TL_PG + TL_PE;
__device__ __forceinline__ ConvJob conv_job(const Frame& F, int it) {
    unsigned char* ws = F.ws; const int l = it / TL_LAYER; int r = it % TL_LAYER; ConvJob j;
    if (r < TL_IN) { j.W = F.in[3] + (size_t)l * D * DIN; j.g = F.in[2] + l * D; j.WT = (bf16*)(ws + WS_WIN) + (size_t)l * DIN * D; j.K = D; j.N = DIN; j.k0 = 64 * (r / 12); j.n0 = 256 * (r % 12); j.mode = 0; return j; } r -= TL_IN;
    if (r < TL_OUT) { j.W = F.in[10] + (size_t)l * D * D; j.g = nullptr; j.WT = (bf16*)(ws + WS_WOUT) + (size_t)l * D * D; j.K = D; j.N = D; j.k0 = 64 * (r / 4); j.n0 = 256 * (r % 4); j.mode = 0; return j; } r -= TL_OUT;
    if (r < 2 * TL_G) { const int up = r >= TL_G; if (up) r -= TL_G; const int e = r / 32, rr = r % 32;
        j.W = F.in[up ? 17 : 16] + (size_t)(l * NE + e) * D * DE; j.g = F.in[11] + l * D; j.WT = (bf16*)(ws + WS_WGU) + (size_t)(l * NE + e) * 1024 * 1024; j.K = D; j.N = DE; j.k0 = 64 * (rr / 2); j.n0 = 256 * (rr % 2); j.mode = 1 + up; return j; } r -= 2 * TL_G;
    if (r < TL_D) { const int e = r / 32, rr = r % 32; j.W = F.in[18] + (size_t)(l * NE + e) * DE * D; j.g = nullptr; j.WT = (bf16*)(ws + WS_WD) + (size_t)(l * NE + e) * D * DE; j.K = DE; j.N = D; j.k0 = 64 * (rr / 4); j.n0 = 256 * (rr % 4); j.mode = 0; return j; } r -= TL_D;
    if (r < TL_PG) { j.W = F.in[20] + (size_t)l * D * D; j.g = F.in[19] + l * D; j.WT = (bf16*)(ws + WS_WPG) + (size_t)l * D * D; j.K = D; j.N = D; j.k0 = 64 * (r / 4); j.n0 = 256 * (r % 4); j.mode = 0; return j; } r -= TL_PG;
    j.W = F.in[21] + (size_t)l * PD * D; j.g = nullptr; j.WT = (bf16*)(ws + WS_WPE) + (size_t)l * D * PD; j.K = PD; j.N = D; j.k0 = 64 * (r / 4); j.n0 = 256 * (r % 4); j.mode = 0; return j;
}
__device__ __forceinline__ void conv_load(const ConvJob& j, int wave, int lane, f32x4 (&v)[8]) {
#pragma unroll
    for (int i = 0; i < 8; ++i) { const int row = 8 * wave + i; v[i] = *(const f32x4*)(j.W + (size_t)(j.k0 + row) * j.N + j.n0 + 4 * lane); if (j.g) v[i] = v[i] * j.g[j.k0 + row]; }
}
constexpr int NDEF = 384, NDEF1 = 128, NBG = 3024;
constexpr int NREST = TL_LAYER - NDEF - NBG, NPRO = TL_LAYER + 3 * NREST;
__device__ __forceinline__ int pro_tile(int f) { if (NREST == 0 || f < TL_LAYER) return f; f -= TL_LAYER; const int l = 1 + f / (NREST ? NREST : 1); return l * TL_LAYER + NDEF + NBG + f % (NREST ? NREST : 1); }
template <class M> __device__ __forceinline__ void conv_run(const Frame& F, int first, int stride, int count, M tile_of) {
    PH_TID();
    LAS float* tile = (LAS float*)F.lds;
    const int wave = ph_wave;
    int f = first; f32x4 v[8]; ConvJob cur{}, nxt{};
    if (f < count) { cur = conv_job(F, tile_of(f)); conv_load(cur, wave, lane, v); }
    while (f < count) {
#pragma unroll
        for (int i = 0; i < 8; ++i) { LAS float* d = tile + (8 * wave + i) * 257 + 4 * lane; d[0] = v[i].x; d[1] = v[i].y; d[2] = v[i].z; d[3] = v[i].w; }
        __syncthreads();
        const int fn = f + stride; if (fn < count) { nxt = conv_job(F, tile_of(fn)); conv_load(nxt, wave, lane, v); }
#pragma unroll
        for (int q = 0; q < 4; ++q) { const int nn = 32 * wave + 8 * q + (lane >> 3), c = lane & 7; const LAS float* sp = tile + (8 * c) * 257 + nn;
            u32x4 o; o.x = pk2(sp[0 * 257], sp[1 * 257]); o.y = pk2(sp[2 * 257], sp[3 * 257]); o.z = pk2(sp[4 * 257], sp[5 * 257]); o.w = pk2(sp[6 * 257], sp[7 * 257]);
            const int n = cur.n0 + nn; const int drow = cur.mode == 0 ? n : ((n >> 7) * 256 + (n & 127) + (cur.mode == 2 ? 128 : 0));
            *(u32x4*)(cur.WT + (size_t)drow * cur.K + cur.k0 + 8 * c) = o; }
        __syncthreads();
        cur = nxt; f = fn;
    }
}
__device__ __forceinline__ void conv_deferred(const Frame& F, int lnext, int r0, int r1, int first, int idle) {
    if (lnext >= DEPTH || F.blk < first) return;
    conv_run(F, F.blk - first, idle, r1 - r0, [=](int f) { return lnext * TL_LAYER + r0 + f; });
}
__device__ __forceinline__ void phase_prologue(const Frame& F) {
    PH_TID();
    unsigned char* ws = F.ws;
    conv_run(F, F.blk, F.G, NPRO, [](int f) { return pro_tile(f); });
    { const f32x4* src = (const f32x4*)F.in[1]; u32x4* dst = (u32x4*)(ws + WS_PB); const size_t n8 = (size_t)DEPTH * T * PD / 8;
      for (size_t i = (size_t)F.blk * NTHR + tid; i < n8; i += (size_t)F.G * NTHR) { const f32x4 a = src[2 * i], b = src[2 * i + 1]; u32x4 o; o.x = pk2(a.x, a.y); o.y = pk2(a.z, a.w); o.z = pk2(b.x, b.y); o.w = pk2(b.z, b.w); dst[i] = o; } }
    { float* wrt = (float*)(ws + MS_WRT);
      for (int i = F.blk * NTHR + tid; i < DEPTH * 36 * D; i += F.G * NTHR) { const int k = i % D, n = (i / D) % 36, l = i / (36 * D);
          const float w = n < 4 ? F.in[12][((size_t)l * D + k) * 4 + n] : F.in[14][((size_t)l * D + k) * NE + (n - 4)]; wrt[i] = w * F.in[11][l * D + k]; } }
    { bf16* wb = (bf16*)(ws + MS_SGUW); for (int i = F.blk * NTHR + tid; i < DEPTH * 4 * 128 * 128; i += F.G * NTHR) { const int tc = (i >> 7) & 127, sp = i & 127; wb[i] = sp <= tc ? (bf16)f2bf(F.in[8][i]) : (bf16)0; } }
    if (F.blk == 0 && tid < DREC) { const int c = tid; float v[DEPTH], m = -1e30f;
#pragma unroll
        for (int l = 0; l < DEPTH; ++l) { v[l] = F.in[4][l * DREC + c]; m = fmaxf(m, v[l]); }
        float s = 0.f;
#pragma unroll
        for (int l = 0; l < DEPTH; ++l) { v[l] = fexp(v[l] - m); s += v[l]; }
        float* lb = (float*)(ws + MS_LB); float acc = 0.f;
#pragma unroll
        for (int l = 0; l < DEPTH; ++l) { if (l > 0) acc += v[l] / s; lb[l * DREC + c] = acc; } }
}

__device__ __forceinline__ void load_row(const float* row, int lane, f32x4 (&v)[4]) { const f32x4* r = (const f32x4*)row + lane;
#pragma unroll
    for (int j = 0; j < 4; ++j) v[j] = r[64 * j]; }
__device__ __forceinline__ void load_row_bf(const bf16* row, int lane, f32x4 (&v)[4]) { const u32x2* r = (const u32x2*)row + lane;
#pragma unroll
    for (int j = 0; j < 4; ++j) { const u32x2 x = r[64 * j]; v[j] = (f32x4){bflo(x.x), bfhi(x.x), bflo(x.y), bfhi(x.y)}; } }
__device__ __forceinline__ float row_sumsq(const f32x4 (&v)[4]) { float s = 0.f;
#pragma unroll
    for (int j = 0; j < 4; ++j) s += (v[j].x * v[j].x + v[j].y * v[j].y) + (v[j].z * v[j].z + v[j].w * v[j].w);
    return wave_sum(s); }
__device__ __forceinline__ void store_row_bf16(bf16* orow, int lane, const f32x4 (&v)[4], float s) { u32x2* o = (u32x2*)orow + lane;
#pragma unroll
    for (int j = 0; j < 4; ++j) { u32x2 w; w.x = pk2(v[j].x * s, v[j].y * s); w.y = pk2(v[j].z * s, v[j].w * s); o[64 * j] = w; } }

__device__ __forceinline__ void phase_norm1(const Frame& F, int l) {
    PH_TID();
    bf16* XN = (bf16*)(F.ws + WS_XN); bf16* h = (bf16*)(F.ws + WS_H); const float* x = F.in[0];
    const int gw = F.blk * NWAVES + ph_wave, NGW = F.G * NWAVES;
    for (int t = gw; t < T; t += NGW) { f32x4 v[4];
        if (l == 0) { load_row(x + (size_t)t * D, lane, v); store_row_bf16(h + (size_t)t * D, lane, v, 1.f); } else load_row_bf(h + (size_t)t * D, lane, v);
        const float rstd = frsq(row_sumsq(v) * (1.f / D) + EPS); store_row_bf16(XN + (size_t)t * D, lane, v, rstd); }
}
__device__ __forceinline__ float bfly8(const float (&r)[8], int lane) {
    const bool b2 = lane & 4, b1 = lane & 2, b0 = lane & 1; float a[4], c[2];
#pragma unroll
    for (int i = 0; i < 4; ++i) { const float keep = b2 ? r[i + 4] : r[i], send = b2 ? r[i] : r[i + 4]; a[i] = keep + shx<4>(send); }
#pragma unroll
    for (int i = 0; i < 2; ++i) { const float keep = b1 ? a[i + 2] : a[i], send = b1 ? a[i] : a[i + 2]; c[i] = keep + shx<2>(send); }
    const float keep = b0 ? c[1] : c[0], send = b0 ? c[0] : c[1]; float d = keep + shx<1>(send);
    d += shx<8>(d); d += shx<16>(d);
    return d + __int_as_float(__builtin_amdgcn_ds_bpermute((lane ^ 32) << 2, __float_as_int(d)));
}
__device__ __forceinline__ void phase_norm2(const Frame& F, int l) {
    PH_TID();
    unsigned char* ws = F.ws;
    unsigned* hist = (unsigned*)(F.lds + MISC_OFF + 256);
    if (tid < 32) hist[tid] = 0u;
    __syncthreads();
    const bf16* h = (const bf16*)(ws + WS_H); bf16* XN = (bf16*)(ws + WS_XN);
    const float* WrT = (const float*)(ws + MS_WRT) + (size_t)l * 36 * D;
    const float* b_rg = F.in[13] + l * 4; const float* b_re = F.in[15] + l * NE;
    int* tok_e = (int*)(ws + MS_TOKE); float* tok_w = (float*)(ws + MS_TOKW); unsigned* sinfo = (unsigned*)(ws + MS_SINFO);
    const int RPB = T / F.G, RPW = RPB / NWAVES;
    for (int i0 = 0; i0 < RPW; i0 += 8) {
        const int t0 = F.blk * RPB + ph_wave * RPW + i0;
        f32x4 v[8][4]; float ss[8];
#pragma unroll
        for (int r = 0; r < 8; ++r) { load_row_bf(h + (size_t)(t0 + r) * D, lane, v[r]); float q = 0.f;
#pragma unroll
            for (int j = 0; j < 4; ++j) q += (v[r][j].x * v[r][j].x + v[r][j].y * v[r][j].y) + (v[r][j].z * v[r][j].z + v[r][j].w * v[r][j].w);
            ss[r] = q; }
        const float rstd_mine = frsq(bfly8(ss, lane) * (1.f / D) + EPS);
#pragma unroll
        for (int r = 0; r < 8; ++r) { const float rs = __int_as_float(__builtin_amdgcn_readlane(__float_as_int(rstd_mine), r)); store_row_bf16(XN + (size_t)(t0 + r) * D, lane, v[r], rs); }
        LAS float* lgw = (LAS float*)(F.lds + 4096) + ph_wave * (36 * 8);
#pragma unroll 2
        for (int n = 0; n < 36; ++n) { const f32x4* wr = (const f32x4*)(WrT + (size_t)n * D) + lane; const f32x4 w0 = wr[0], w1 = wr[64], w2 = wr[128], w3 = wr[192]; float pr[8];
#pragma unroll
            for (int r = 0; r < 8; ++r) pr[r] = ((v[r][0].x * w0.x + v[r][0].y * w0.y) + (v[r][0].z * w0.z + v[r][0].w * w0.w)) + ((v[r][1].x * w1.x + v[r][1].y * w1.y) + (v[r][1].z * w1.z + v[r][1].w * w1.w))
                                                 + ((v[r][2].x * w2.x + v[r][2].y * w2.y) + (v[r][2].z * w2.z + v[r][2].w * w2.w)) + ((v[r][3].x * w3.x + v[r][3].y * w3.y) + (v[r][3].z * w3.z + v[r][3].w * w3.w));
            const float val = bfly8(pr, lane) * rstd_mine; if (lane < 8) lgw[n * 8 + lane] = val; }
        const int row = lane & 7;
        float lg4[4], lgb[4];
#pragma unroll
        for (int j = 0; j < 4; ++j) { lg4[j] = lgw[j * 8 + row]; lgb[j] = lg4[j] + b_rg[j]; }
        int gs = 0; float gm = lgb[0];
#pragma unroll
        for (int j = 1; j < 4; ++j) if (lgb[j] > gm) { gm = lgb[j]; gs = j; }
        float mx = fmaxf(fmaxf(lg4[0], lg4[1]), fmaxf(lg4[2], lg4[3])), se = 0.f, lsel = lg4[0];
#pragma unroll
        for (int j = 0; j < 4; ++j) { se += fexp(lg4[j] - mx); if (j == gs) lsel = lg4[j]; }
        const float g_w = fexp(lsel - mx) * frcp(se);
        float le[8], leb[8];
#pragma unroll
        for (int j = 0; j < 8; ++j) { le[j] = lgw[(4 + gs * 8 + j) * 8 + row]; leb[j] = le[j] + b_re[gs * 8 + j]; }
        int s0 = 0; float m0 = leb[0];
#pragma unroll
        for (int j = 1; j < 8; ++j) if (leb[j] > m0) { m0 = leb[j]; s0 = j; }
        int s1 = -1; float m1 = -3.0e38f;
#pragma unroll
        for (int j = 0; j < 8; ++j) if (j != s0 && leb[j] > m1) { m1 = leb[j]; s1 = j; }
        if (s1 < 0) s1 = (s0 == 0) ? 1 : 0;
        float la = le[0], lb2 = le[0];
#pragma unroll
        for (int j = 1; j < 8; ++j) { if (j == s0) la = le[j]; if (j == s1) lb2 = le[j]; }
        const float wa = frcp(1.f + fexp(lb2 - la)), wb = 1.f - wa;
        if (lane < 8) { const int t = t0 + lane;
            const int e0 = gs * 8 + s0, e1 = gs * 8 + s1;
            const unsigned r0 = atomicAdd(&hist[e0], 1u), r1 = atomicAdd(&hist[e1], 1u);
            tok_e[2 * t] = e0; tok_e[2 * t + 1] = e1; tok_w[2 * t] = g_w * wa; tok_w[2 * t + 1] = g_w * wb;
            sinfo[2 * t] = ((unsigned)F.blk << 16) | r0; sinfo[2 * t + 1] = ((unsigned)F.blk << 16) | r1;
        }
    }
    __syncthreads();
    if (tid < 32) { unsigned* cnt = (unsigned*)(ws + WS_CTL) + CW_CNT + l * 32;
        const unsigned base = __hip_atomic_fetch_add(cnt + tid, hist[tid], __ATOMIC_RELAXED, __HIP_MEMORY_SCOPE_AGENT);
        ((unsigned*)(ws + MS_BLKBASE))[F.blk * 32 + tid] = base; }
}
__device__ __forceinline__ void phase_gather(const Frame& F, int l) {
    PH_TID();
    unsigned char* ws = F.ws;
    int* ps = (int*)(F.lds + MISC_OFF + 512);
    if (tid == 0) { unsigned* cnt = (unsigned*)(ws + WS_CTL) + CW_CNT + l * 32; int* blke = (int*)(ws + MS_BLKE) + l * 256; int acc = 0;
        for (int e = 0; e < NE; ++e) { const int c = (int)__hip_atomic_load(cnt + e, __ATOMIC_RELAXED, __HIP_MEMORY_SCOPE_AGENT); ps[e] = acc; const int pad = (c + RB - 1) / RB * RB;
            if (F.blk == 0) for (int rb = acc / RB; rb < (acc + pad) / RB; ++rb) blke[rb] = e;
            acc += pad; }
        if (F.blk == 0) blke[255] = acc / RB; }
    __syncthreads();
    const int* tok_e = (const int*)(ws + MS_TOKE); const unsigned* sinfo = (const unsigned*)(ws + MS_SINFO); const unsigned* bbase = (const unsigned*)(ws + MS_BLKBASE);
    int* sdest = (int*)(ws + MS_SDEST); const bf16* XN = (const bf16*)(ws + WS_XN); bf16* XB = (bf16*)(ws + WS_XB);
    const int gw = F.blk * NWAVES + ph_wave, NGW = F.G * NWAVES;
    for (int t = gw; t < T; t += NGW) {
        const u32x4* src = (const u32x4*)(XN + (size_t)t * D) + lane; const u32x4 a = src[0], b = src[64];
#pragma unroll
        for (int j = 0; j < 2; ++j) { const int e = tok_e[2 * t + j]; const unsigned info = sinfo[2 * t + j];
            const int dest = ps[e] + (int)bbase[(info >> 16) * 32 + e] + (int)(info & 0xffffu);
            if (lane == 0) sdest[2 * t + j] = dest;
            u32x4* dst = (u32x4*)(XB + (size_t)dest * D) + lane; dst[0] = a; dst[64] = b; }
    }
}
__device__ __forceinline__ void phase_combine(const Frame& F, int l) {
    PH_TID();
    unsigned char* ws = F.ws;
    bf16* h = (bf16*)(ws + WS_H); bf16* XN = (bf16*)(ws + WS_XN); const bf16* Y = (const bf16*)(ws + WS_Y); const bf16* PE = (const bf16*)(ws + WS_PE) + (size_t)l * T * D;
    const int* sdest = (const int*)(ws + MS_SDEST); const float* tok_w = (const float*)(ws + MS_TOKW); float* rstd_pe = (float*)(ws + MS_RSTDPE);
    const int gw = F.blk * NWAVES + ph_wave, NGW = F.G * NWAVES;
    struct Rows { u32x2 h[4], y0[4], y1[4], pe[4]; };
    auto fetch = [&](int t, int d0, int d1, Rows& r) {
        const u32x2* hp = (const u32x2*)(h + (size_t)t * D) + lane; const u32x2* y0 = (const u32x2*)(Y + (size_t)d0 * D) + lane; const u32x2* y1 = (const u32x2*)(Y + (size_t)d1 * D) + lane; const u32x2* pe = (const u32x2*)(PE + (size_t)t * D) + lane;
#pragma unroll
        for (int j = 0; j < 4; ++j) { r.h[j] = hp[64 * j]; r.y0[j] = y0[64 * j]; r.y1[j] = y1[64 * j]; r.pe[j] = pe[64 * j]; } };
    int t = gw; if (t >= T) return;
    Rows cur; int d0n = 0, d1n = 0; float w0 = tok_w[2 * t], w1 = tok_w[2 * t + 1], w0n = 0.f, w1n = 0.f;
    fetch(t, sdest[2 * t], sdest[2 * t + 1], cur);
    if (t + NGW < T) { d0n = sdest[2 * (t + NGW)]; d1n = sdest[2 * (t + NGW) + 1]; w0n = tok_w[2 * (t + NGW)]; w1n = tok_w[2 * (t + NGW) + 1]; }
    for (; t < T; t += NGW) {
        Rows nxt = cur; const float w0c = w0, w1c = w1; const bool more = t + NGW < T;
        if (more) { fetch(t + NGW, d0n, d1n, nxt); w0 = w0n; w1 = w1n;
            if (t + 2 * NGW < T) { d0n = sdest[2 * (t + 2 * NGW)]; d1n = sdest[2 * (t + 2 * NGW) + 1]; w0n = tok_w[2 * (t + 2 * NGW)]; w1n = tok_w[2 * (t + 2 * NGW) + 1]; } }
        f32x4 v[4]; float sp = 0.f;
#pragma unroll
        for (int j = 0; j < 4; ++j) { const u32x2 x = cur.h[j], a = cur.y0[j], b = cur.y1[j], c = cur.pe[j];
            v[j] = (f32x4){bflo(x.x) + (w0c * bflo(a.x) + w1c * bflo(b.x)), bfhi(x.x) + (w0c * bfhi(a.x) + w1c * bfhi(b.x)), bflo(x.y) + (w0c * bflo(a.y) + w1c * bflo(b.y)), bfhi(x.y) + (w0c * bfhi(a.y) + w1c * bfhi(b.y))};
            const float p0 = bflo(c.x), p1 = bfhi(c.x), p2 = bflo(c.y), p3 = bfhi(c.y); sp += (p0 * p0 + p1 * p1) + (p2 * p2 + p3 * p3); }
        store_row_bf16(h + (size_t)t * D, lane, v, 1.f);
        const float rstd = frsq(row_sumsq(v) * (1.f / D) + EPS); store_row_bf16(XN + (size_t)t * D, lane, v, rstd);
        sp = wave_sum(sp); if (lane == 0) rstd_pe[t] = frsq(sp * (1.f / D) + EPS);
        cur = nxt;
    }
}
__device__ __forceinline__ void phase_final(const Frame& F) {
    PH_TID();
    const bf16* h = (const bf16*)(F.ws + WS_H); const float* nf = F.in[23];
    const int gw = F.blk * NWAVES + ph_wave, NGW = F.G * NWAVES;
    for (int t = gw; t < T; t += NGW) { f32x4 v[4]; load_row_bf(h + (size_t)t * D, lane, v); const float rstd = frsq(row_sumsq(v) * (1.f / D) + EPS);
        f32x4* o = (f32x4*)(F.out + (size_t)t * D) + lane; const f32x4* g = (const f32x4*)nf + lane;
#pragma unroll
        for (int j = 0; j < 4; ++j) o[64 * j] = v[j] * rstd * g[64 * j]; }
}


namespace pg8 {
constexpr int BM = 256, BK = 64, HALF = 128, HTB = HALF * BK * 2, STAGE_BYTES = 8 * HTB, NXCD = 8, WGM = 8;
__host__ __device__ __forceinline__ int lds_byte(int r, int c) { const int st = (r >> 4) * 2 + (c >> 5), rr = r & 15, cc = c & 31, ob = rr * 64 + cc * 2; return st * 1024 + (ob ^ (((ob >> 9) & 1) << 5)); }
__host__ __device__ __forceinline__ void stage_rc(int b, int& R, int& C) { const int st = b / 1024, sb = b % 1024, swz = sb ^ (((sb >> 9) & 1) << 5); R = (st >> 1) * 16 + swz / 64; C = (st & 1) * 32 + (swz % 64) / 2; }
__host__ __device__ __forceinline__ int perm32(int rho) { const int n = rho >> 4, i = rho & 15; return 8 * (i >> 2) + 4 * n + (i & 3); }
struct Unit { int pm, pn; const char* A; const char* B; };
__device__ __forceinline__ void static_map(int wgid, int nM, int nN, int& pm, int& pn) {
    const int nwg = nM * nN; { const int q = nwg / NXCD, r = nwg % NXCD, xcd = wgid % NXCD, off = wgid / NXCD; wgid = (xcd < r ? xcd * (q + 1) : r * (q + 1) + (xcd - r) * q) + off; }
    const int nig = WGM * nN, gid = wgid / nig, fm = gid * WGM, gsz = (nM - fm) < WGM ? (nM - fm) : WGM;
    pm = fm + ((wgid % nig) % gsz); pn = (wgid % nig) / gsz;
}
struct DenseOrder { static constexpr bool DEPS = false;
    const char* A; const char* Bt; int nM, nN, nL, G, c; size_t tstep;
    __device__ void init(const void* A_, const void* Bt_, int M, int N, int K, int nL_, int G_, int c_) { A = (const char*)A_; Bt = (const char*)Bt_; nM = M / BM; nN = N / BM; nL = nL_; G = G_; c = c_; tstep = (size_t)BM * K * 2; }
    __device__ bool next(int i, Unit& u) const { const long L = (long)i * G + c; const int per = nM * nN; if (L >= (long)per * nL) return false;
        const int l = (int)(L / per); int pm, pn; static_map((int)(L % per), nM, nN, pm, pn); u.pm = l * nM + pm; u.pn = pn; u.A = A + (size_t)u.pm * tstep; u.B = Bt + (size_t)(l * nN + pn) * tstep; return true; }
};
struct MoeOrder { static constexpr bool DEPS = false;
    const char* A; const char* W; const int* blke; int nrb, nN, G, c, e0, e1, e2; size_t a_tstep, w_estride, b_tstep;
    __device__ void init(const void* A_, const void* W_, const int* blke_, int K, int nN_, size_t w_estride_bytes, int G_, int c_) { A = (const char*)A_; W = (const char*)W_; blke = blke_; nrb = __builtin_amdgcn_readfirstlane(blke_[255]); nN = nN_; G = G_; c = c_;
        a_tstep = (size_t)BM * K * 2; b_tstep = a_tstep; w_estride = w_estride_bytes;
        const int r0 = c / nN, r1 = (G + c) / nN, r2 = (2 * G + c) / nN; const int x0 = blke_[r0 < 255 ? r0 : 254], x1 = blke_[r1 < 255 ? r1 : 254], x2 = blke_[r2 < 255 ? r2 : 254];
        e0 = __builtin_amdgcn_readfirstlane(x0); e1 = __builtin_amdgcn_readfirstlane(x1); e2 = __builtin_amdgcn_readfirstlane(x2); }
    __device__ bool next(int i, Unit& u) const { const long L = (long)i * G + c; if (L >= (long)nrb * nN) return false; const int rb = (int)(L / nN), pn = (int)(L % nN);
        const int ex = i == 0 ? e0 : i == 1 ? e1 : i == 2 ? e2 : __builtin_amdgcn_readfirstlane(blke[rb]);
        u.pm = rb; u.pn = pn; u.A = A + (size_t)rb * a_tstep; u.B = W + (size_t)ex * w_estride + (size_t)pn * b_tstep; return true; }
};
__device__ __forceinline__ unsigned ag_ld(const unsigned* p)        { return __hip_atomic_load(p, __ATOMIC_RELAXED, __HIP_MEMORY_SCOPE_AGENT); }
__device__ __forceinline__ unsigned ag_add(unsigned* p, unsigned v) { return __hip_atomic_fetch_add(p, v, __ATOMIC_RELAXED, __HIP_MEMORY_SCOPE_AGENT); }
struct MoeDepOrder { static constexpr bool DEPS = true;
    const char* A; const char* W; const int* blke; const unsigned* done; int nrb, nN, G, c, e0, e1, e2; size_t a_tstep, w_estride, b_tstep;
    __device__ void init(const void* A_, const void* W_, const int* blke_, const unsigned* done_, int K, int nN_, size_t w_estride_bytes, int G_, int c_) { A = (const char*)A_; W = (const char*)W_; blke = blke_; done = done_;
        nrb = __builtin_amdgcn_readfirstlane(blke_[255]); nN = nN_; G = G_; c = c_; a_tstep = (size_t)BM * K * 2; b_tstep = a_tstep; w_estride = w_estride_bytes;
        const int r0 = c / nN, r1 = (G + c) / nN, r2 = (2 * G + c) / nN; const int x0 = blke_[r0 < 255 ? r0 : 254], x1 = blke_[r1 < 255 ? r1 : 254], x2 = blke_[r2 < 255 ? r2 : 254];
        e0 = __builtin_amdgcn_readfirstlane(x0); e1 = __builtin_amdgcn_readfirstlane(x1); e2 = __builtin_amdgcn_readfirstlane(x2); }
    __device__ bool next(int i, Unit& u) const { const long L = (long)i * G + c; if (L >= (long)nrb * nN) return false; const int rb = (int)(L / nN), pn = (int)(L % nN);
        const int ex = i == 0 ? e0 : i == 1 ? e1 : i == 2 ? e2 : __builtin_amdgcn_readfirstlane(blke[rb]);
        u.pm = rb; u.pn = pn; u.A = A + (size_t)rb * a_tstep; u.B = W + (size_t)ex * w_estride + (size_t)pn * b_tstep; return true; }
    __device__ void wait(const Unit& u, int wid) const {
        if (wid == 0 && lane_now() == 0) { while (ag_ld(done + u.pm) < 4u) __builtin_amdgcn_s_sleep(1); __builtin_amdgcn_fence(__ATOMIC_ACQUIRE, "agent"); } }
};
struct RangeOrder { static constexpr bool DEPS = false;
    const char* A; const char* Bt; int nM, nN, j0, n; size_t tstep;
    __device__ void init(const void* A_, const void* Bt_, int M, int N, int K, int j0_, int n_) { A = (const char*)A_; Bt = (const char*)Bt_; nM = M / BM; nN = N / BM; j0 = j0_; n = n_; tstep = (size_t)BM * K * 2; }
    __device__ bool next(int i, Unit& u) const { if (i >= n) return false; int pm, pn; static_map(j0 + i, nM, nN, pm, pn); u.pm = pm; u.pn = pn; u.A = A + (size_t)pm * tstep; u.B = Bt + (size_t)pn * tstep; return true; }
};
__device__ __forceinline__ unsigned cvt_pk_bf16(float lo, float hi) { return pk2(lo, hi); }
struct EpiBf16 { static constexpr bool PERM = true, ACC_INIT = false, SIGNAL = false; bf16* O; int ldc;
    __device__ __forceinline__ void operator()(const f32x4 (&acc)[2][2][4][2], const Unit& u, int wr, int wc, int, int) const {
        const int t2 = lane_now(), fr = t2 & 15, fq = t2 >> 4;
        const int row0 = u.pm * BM + wr * 64 + fr, col0 = u.pn * BM + wc * 32 + 8 * fq;
#pragma unroll
        for (int ai = 0; ai < 2; ++ai)
#pragma unroll
            for (int m = 0; m < 4; ++m) { bf16* rowp = O + (size_t)(row0 + ai * HALF + m * 16) * ldc + col0;
#pragma unroll
                for (int bj = 0; bj < 2; ++bj) { const f32x4 v0 = acc[ai][bj][m][0], v1 = acc[ai][bj][m][1];
                    u32x4 w; w.x = cvt_pk_bf16(v0[0], v0[1]); w.y = cvt_pk_bf16(v0[2], v0[3]); w.z = cvt_pk_bf16(v1[0], v1[1]); w.w = cvt_pk_bf16(v1[2], v1[3]);
                    *(u32x4*)(rowp + bj * HALF) = w; } }
    } };
struct EpiResid { static constexpr bool PERM = true, ACC_INIT = true, SIGNAL = false; bf16* h;
    __device__ __forceinline__ void init(f32x4 (&acc)[2][2][4][2], const Unit& u, int wr, int wc, int fr, int fq) const {
        const int row0 = u.pm * BM + wr * 64 + fr, col0 = u.pn * BM + wc * 32 + 8 * fq;
#pragma unroll
        for (int ai = 0; ai < 2; ++ai)
#pragma unroll
            for (int m = 0; m < 4; ++m) { const bf16* rowp = h + (size_t)(row0 + ai * HALF + m * 16) * D + col0;
#pragma unroll
                for (int bj = 0; bj < 2; ++bj) { const u32x4 x = *(const u32x4*)(rowp + bj * HALF);
                    acc[ai][bj][m][0] = (f32x4){bflo(x.x), bfhi(x.x), bflo(x.y), bfhi(x.y)}; acc[ai][bj][m][1] = (f32x4){bflo(x.z), bfhi(x.z), bflo(x.w), bfhi(x.w)}; } }
    }
    __device__ __forceinline__ void operator()(const f32x4 (&acc)[2][2][4][2], const Unit& u, int wr, int wc, int fr, int fq) const {
        asm volatile("" : "+v"(fr), "+v"(fq));
        const int row0 = u.pm * BM + wr * 64 + fr, col0 = u.pn * BM + wc * 32 + 8 * fq;
#pragma unroll
        for (int ai = 0; ai < 2; ++ai)
#pragma unroll
            for (int m = 0; m < 4; ++m) { bf16* rowp = h + (size_t)(row0 + ai * HALF + m * 16) * D + col0;
#pragma unroll
                for (int bj = 0; bj < 2; ++bj) { const f32x4 v0 = acc[ai][bj][m][0], v1 = acc[ai][bj][m][1];
                    u32x4 w; w.x = cvt_pk_bf16(v0[0], v0[1]); w.y = cvt_pk_bf16(v0[2], v0[3]); w.z = cvt_pk_bf16(v1[0], v1[1]); w.w = cvt_pk_bf16(v1[2], v1[3]);
                    *(u32x4*)(rowp + bj * HALF) = w; } }
    } };
struct EpiGateUp { static constexpr bool PERM = true, ACC_INIT = false, SIGNAL = false; bf16* H;
    __device__ __forceinline__ void operator()(const f32x4 (&acc)[2][2][4][2], const Unit& u, int wr, int wc, int, int) const {
        const int t2 = lane_now(), fr = t2 & 15, fq = t2 >> 4;
        const int row0 = u.pm * BM + wr * 64 + fr, col0 = u.pn * HALF + wc * 32 + 8 * fq;
#pragma unroll
        for (int ai = 0; ai < 2; ++ai)
#pragma unroll
            for (int m = 0; m < 4; ++m) { bf16* rowp = H + (size_t)(row0 + ai * HALF + m * 16) * DE + col0; float v[8];
#pragma unroll
                for (int n = 0; n < 2; ++n)
#pragma unroll
                    for (int j = 0; j < 4; ++j) v[4 * n + j] = silu_(acc[ai][0][m][n][j]) * acc[ai][1][m][n][j];
                u32x4 w; w.x = cvt_pk_bf16(v[0], v[1]); w.y = cvt_pk_bf16(v[2], v[3]); w.z = cvt_pk_bf16(v[4], v[5]); w.w = cvt_pk_bf16(v[6], v[7]);
                *(u32x4*)rowp = w; }
    } };
struct EpiGateUpPub { static constexpr bool PERM = true, ACC_INIT = false, SIGNAL = true; __amdgpu_buffer_rsrc_t rs; unsigned* done;
    __device__ __forceinline__ void operator()(const f32x4 (&acc)[2][2][4][2], const Unit& u, int wr, int wc, int fr, int fq) const {
        asm volatile("" : "+v"(fr), "+v"(fq));
        const int row0 = u.pm * BM + wr * 64 + fr, col0 = u.pn * HALF + wc * 32 + 8 * fq;
#pragma unroll
        for (int ai = 0; ai < 2; ++ai)
#pragma unroll
            for (int m = 0; m < 4; ++m) { const unsigned off = (unsigned)(((row0 + ai * HALF + m * 16) * DE + col0) * 2); float v[8];
#pragma unroll
                for (int n = 0; n < 2; ++n)
#pragma unroll
                    for (int j = 0; j < 4; ++j) v[4 * n + j] = silu_(acc[ai][0][m][n][j]) * acc[ai][1][m][n][j];
                u32x4 w; w.x = cvt_pk_bf16(v[0], v[1]); w.y = cvt_pk_bf16(v[2], v[3]); w.z = cvt_pk_bf16(v[4], v[5]); w.w = cvt_pk_bf16(v[6], v[7]);
                __builtin_amdgcn_raw_buffer_store_b128(w, rs, off, 0, 16); }
    }
    __device__ __forceinline__ void signal(const Unit& u) const { (void)ag_add(done + u.pm, 1u); }
};
struct EpiPG { static constexpr bool PERM = true, ACC_INIT = false, SIGNAL = false; bf16* h; const bf16* PE; const float* rstd_pe; const float* norm_pe;
    __device__ __forceinline__ void operator()(const f32x4 (&acc)[2][2][4][2], const Unit& u, int wr, int wc, int, int) const {
        const int t2 = lane_now(), fr = t2 & 15, fq = t2 >> 4;
        const int row0 = u.pm * BM + wr * 64 + fr, col0 = u.pn * BM + wc * 32 + 8 * fq;
        f32x4 nv[2][2];
#pragma unroll
        for (int bj = 0; bj < 2; ++bj)
#pragma unroll
            for (int n = 0; n < 2; ++n) nv[bj][n] = *(const f32x4*)(norm_pe + col0 + bj * HALF + 4 * n);
#pragma unroll
        for (int ai = 0; ai < 2; ++ai) {
            u32x4 pe[4][2], hx[4][2]; float rs[4];
#pragma unroll
            for (int m = 0; m < 4; ++m) { const int row = row0 + ai * HALF + m * 16; rs[m] = rstd_pe[row];
#pragma unroll
                for (int bj = 0; bj < 2; ++bj) { const size_t o = (size_t)row * D + col0 + bj * HALF; pe[m][bj] = *(const u32x4*)(PE + o); hx[m][bj] = *(const u32x4*)(h + o); } }
#pragma unroll
            for (int m = 0; m < 4; ++m) { const int row = row0 + ai * HALF + m * 16;
#pragma unroll
                for (int bj = 0; bj < 2; ++bj) { const size_t o = (size_t)row * D + col0 + bj * HALF; const u32x4 p = pe[m][bj], x = hx[m][bj];
                    f32x4 h0 = (f32x4){bflo(x.x), bfhi(x.x), bflo(x.y), bfhi(x.y)}, h1 = (f32x4){bflo(x.z), bfhi(x.z), bflo(x.w), bfhi(x.w)}; const f32x4 a0 = acc[ai][bj][m][0], a1 = acc[ai][bj][m][1];
                    const f32x4 e0 = (f32x4){bflo(p.x), bfhi(p.x), bflo(p.y), bfhi(p.y)} * rs[m] * nv[bj][0], e1 = (f32x4){bflo(p.z), bfhi(p.z), bflo(p.w), bfhi(p.w)} * rs[m] * nv[bj][1];
                    h0 += (f32x4){sigmoid_(a0[0]), sigmoid_(a0[1]), sigmoid_(a0[2]), sigmoid_(a0[3])} * e0; h1 += (f32x4){sigmoid_(a1[0]), sigmoid_(a1[1]), sigmoid_(a1[2]), sigmoid_(a1[3])} * e1;
                    u32x4 w; w.x = pk2(h0[0], h0[1]); w.y = pk2(h0[2], h0[3]); w.z = pk2(h1[0], h1[1]); w.w = pk2(h1[2], h1[3]); *(u32x4*)(h + o) = w; } } }
    } };

template <class Epi, class Sched>
__device__ __forceinline__ void gemm_phase(int wave, LAS unsigned char* lds, int K, const Sched& S, const Epi& E) {
    int wid = wave; asm volatile("" : "+s"(wid));
    const int lane = lane_now(), tid = (wid << 6) | lane, wr = wid >> 2, wc = wid & 3, fr = lane & 15, fq = lane >> 4;
    const int nt = K / BK;
    unsigned voffA[2], voffB[2];
#pragma unroll
    for (int i = 0; i < 2; ++i) { int R, C; stage_rc(tid * 16 + i * 8192, R, C); const int Rb = Epi::PERM ? ((R & ~31) + perm32(R & 31)) : R;
        voffA[i] = (unsigned)(R * K + C) * 2u; voffB[i] = (unsigned)(Rb * K + C) * 2u; }
    const size_t kstep = (size_t)(BK * 2);
    const size_t hstep = (size_t)HALF * K * 2;
    const unsigned ldsw = (unsigned)wid * 1024u;
    const int aoff = lds_byte(wr * 64 + fr, fq * 8), boff = lds_byte(wc * 32 + fr, fq * 8);
#define PG8_SA(b, h) (((b) * 2 + (h)) * HTB)
#define PG8_SB(b, h) ((4 + (b) * 2 + (h)) * HTB)
#define PG8_STAGE(bufoff, gbase, voff) do { _Pragma("unroll") for (int _i = 0; _i < 2; ++_i) \
        __builtin_amdgcn_global_load_lds((const unsigned*)((const char*)(gbase) + (voff)[_i]), (LAS unsigned*)(lds + (bufoff) + ldsw + _i * 8192), 16, 0, 0); } while (0)
#define PG8_LDA(dst, b, h) do { _Pragma("unroll") for (int m = 0; m < 4; ++m) _Pragma("unroll") for (int k = 0; k < 2; ++k) dst[m][k] = *(const LAS bf16x8*)(lds + PG8_SA(b, h) + aoff + m * 2048 + k * 1024); } while (0)
#define PG8_LDB(dst, b, h) do { _Pragma("unroll") for (int n = 0; n < 2; ++n) _Pragma("unroll") for (int k = 0; k < 2; ++k) dst[n][k] = *(const LAS bf16x8*)(lds + PG8_SB(b, h) + boff + n * 2048 + k * 1024); } while (0)
#define PG8_MMA(ai, bj, At, Bt) do { __builtin_amdgcn_s_setprio(1); _Pragma("unroll") for (int m = 0; m < 4; ++m) _Pragma("unroll") for (int n = 0; n < 2; ++n) _Pragma("unroll") for (int k = 0; k < 2; ++k) \
        acc[ai][bj][m][n] = __builtin_amdgcn_mfma_f32_16x16x32_bf16(Bt[n][k], At[m][k], acc[ai][bj][m][n], 0, 0, 0); __builtin_amdgcn_s_setprio(0); } while (0)
#define PG8_WAIT_V(n) asm volatile("s_waitcnt vmcnt(" #n ")" ::: "memory")
#define PG8_WAIT_L(n) asm volatile("s_waitcnt lgkmcnt(" #n ")" ::: "memory")
#define PG8_BAR __builtin_amdgcn_s_barrier()
#define PG8_SCHED __builtin_amdgcn_sched_barrier(0)
    Unit cur, nxt; int ui = 0;
    if (!S.next(0, cur)) return;
    if constexpr (Sched::DEPS) { S.wait(cur, wid); PG8_BAR; }
    f32x4 acc[2][2][4][2];
    if constexpr (Epi::ACC_INIT) E.init(acc, cur, wr, wc, fr, fq);
    else {
#pragma unroll
    for (int a = 0; a < 2; ++a)
#pragma unroll
        for (int b = 0; b < 2; ++b)
#pragma unroll
            for (int m = 0; m < 4; ++m)
#pragma unroll
                for (int n = 0; n < 2; ++n) acc[a][b][m][n] = (f32x4){0.f, 0.f, 0.f, 0.f}; }
    bf16x8 At[4][2], B0[2][2], B1[2][2];
    const char* cA = cur.A; const char* cB = cur.B;
    PG8_STAGE(PG8_SB(0, 0), cB, voffB); PG8_STAGE(PG8_SB(0, 1), cB + hstep, voffB); PG8_STAGE(PG8_SA(0, 0), cA, voffA); PG8_STAGE(PG8_SA(0, 1), cA + hstep, voffA);
    if (wr == 1) PG8_BAR;
    PG8_WAIT_V(2); PG8_BAR;
    PG8_STAGE(PG8_SB(1, 0), cB + kstep, voffB); PG8_STAGE(PG8_SA(1, 0), cA + kstep, voffA); PG8_STAGE(PG8_SB(1, 1), cB + hstep + kstep, voffB);
    PG8_WAIT_V(6); PG8_BAR;
    for (;;) {
        const bool has_next = S.next(ui + 1, nxt);
        const char* nA = has_next ? nxt.A : cA; const char* nB = has_next ? nxt.B : cB;
#pragma nounroll
        for (int t = 0; t < nt; t += 2) {
            const bool last = (t == nt - 2);
            if constexpr (Sched::DEPS) { if (last && has_next) S.wait(nxt, wid); }
            const char* a1 = cA + (size_t)(t + 1) * kstep;
            const char* a2 = last ? nA : cA + (size_t)(t + 2) * kstep; const char* b2 = last ? nB : cB + (size_t)(t + 2) * kstep;
            const char* a3 = a2 + kstep; const char* b3 = b2 + kstep;
            PG8_LDB(B0, 0, 0); PG8_LDB(B1, 0, 1); PG8_SCHED; PG8_LDA(At, 0, 0); PG8_STAGE(PG8_SA(1, 1), a1 + hstep, voffA);
            PG8_WAIT_V(8); PG8_WAIT_L(0); PG8_BAR; PG8_MMA(0, 0, At, B0); PG8_MMA(0, 1, At, B1); PG8_BAR; PG8_SCHED;
            PG8_LDA(At, 0, 1); PG8_STAGE(PG8_SB(0, 0), b2, voffB); PG8_STAGE(PG8_SB(0, 1), b2 + hstep, voffB); PG8_STAGE(PG8_SA(0, 0), a2, voffA);
            PG8_WAIT_V(8); PG8_WAIT_L(0); PG8_BAR; PG8_MMA(1, 0, At, B0); PG8_MMA(1, 1, At, B1); PG8_BAR; PG8_SCHED;
            PG8_LDB(B0, 1, 0); PG8_LDB(B1, 1, 1); PG8_SCHED; PG8_LDA(At, 1, 0); PG8_STAGE(PG8_SA(0, 1), a2 + hstep, voffA);
            PG8_WAIT_V(8); PG8_WAIT_L(0); PG8_BAR; PG8_MMA(0, 0, At, B0); PG8_MMA(0, 1, At, B1); PG8_BAR; PG8_SCHED;
            PG8_LDA(At, 1, 1); PG8_STAGE(PG8_SB(1, 0), b3, voffB); PG8_STAGE(PG8_SB(1, 1), b3 + hstep, voffB); PG8_STAGE(PG8_SA(1, 0), a3, voffA);
            PG8_WAIT_V(8); PG8_WAIT_L(0); PG8_BAR; PG8_MMA(1, 0, At, B0); PG8_MMA(1, 1, At, B1); PG8_BAR; PG8_SCHED;
        }
        if (wr == 0) PG8_BAR;
        E(acc, cur, wr, wc, fr, fq);
        if constexpr (Epi::SIGNAL) { PG8_WAIT_V(0); PG8_BAR; if (tid == 0) E.signal(cur); }
        if (!has_next) break;
        if constexpr (Epi::ACC_INIT) E.init(acc, nxt, wr, wc, fr, fq);
        else {
#pragma unroll
        for (int a = 0; a < 2; ++a)
#pragma unroll
            for (int b = 0; b < 2; ++b)
#pragma unroll
                for (int m = 0; m < 4; ++m)
#pragma unroll
                    for (int n = 0; n < 2; ++n) acc[a][b][m][n] = (f32x4){0.f, 0.f, 0.f, 0.f}; }
        cur = nxt; cA = nA; cB = nB; ++ui;
        if (wr == 1) PG8_BAR;
    }
    PG8_WAIT_V(0);
    PG8_BAR;
#undef PG8_SA
#undef PG8_SB
#undef PG8_STAGE
#undef PG8_LDA
#undef PG8_LDB
#undef PG8_MMA
#undef PG8_WAIT_V
#undef PG8_WAIT_L
#undef PG8_BAR
#undef PG8_SCHED
}
}

__device__ __forceinline__ void phase_gemm_pe(const Frame& F) {
    pg8::DenseOrder S; S.init(F.ws + WS_PB, F.ws + WS_WPE, T, D, PD, DEPTH, F.G, F.blk); pg8::EpiBf16 E{(bf16*)(F.ws + WS_PE), D};
    pg8::gemm_phase(F.wave, F.lds, PD, S, E);
}
__device__ __forceinline__ void phase_gemm_in(const Frame& F, int l) {
    pg8::DenseOrder S; S.init(F.ws + WS_XN, (bf16*)(F.ws + WS_WIN) + (size_t)l * DIN * D, T, DIN, D, 1, F.G, F.blk); pg8::EpiBf16 E{(bf16*)(F.ws + WS_Z), DIN};
    pg8::gemm_phase(F.wave, F.lds, D, S, E);
}
__device__ __forceinline__ void phase_gemm_out(const Frame& F, int l) {
    pg8::DenseOrder S; S.init(F.ws + WS_O, (bf16*)(F.ws + WS_WOUT) + (size_t)l * D * D, T, D, D, 1, F.G, F.blk); pg8::EpiResid E{(bf16*)(F.ws + WS_H)};
    pg8::gemm_phase(F.wave, F.lds, D, S, E);
}
__device__ __forceinline__ void phase_gemm_moe1(const Frame& F, int l) {
    pg8::MoeOrder S; S.init(F.ws + WS_XB, (bf16*)(F.ws + WS_WGU) + (size_t)l * NE * 1024 * 1024, (const int*)(F.ws + MS_BLKE) + l * 256, D, 4, (size_t)1024 * 1024 * 2, F.G, F.blk); pg8::EpiGateUp E{(bf16*)(F.ws + WS_HB)};
    pg8::gemm_phase(F.wave, F.lds, D, S, E);
    { const int nun = S.nrb * 4, rem = nun % F.G, few = (rem == 0 || F.G - rem < 64), idle = few ? F.G : F.G - rem, first = few ? 0 : rem;
      if (F.blk >= first) { pg8::DenseOrder P; P.init((const bf16*)(F.ws + WS_PB) + (size_t)l * T * PD, (const bf16*)(F.ws + WS_WPE) + (size_t)l * D * PD, T, D, PD, 1, idle, F.blk - first);
          pg8::EpiBf16 EP{(bf16*)(F.ws + WS_PE) + (size_t)l * T * D, D}; pg8::gemm_phase(F.wave, F.lds, PD, P, EP); }
      conv_deferred(F, l + 1, 0, NDEF1, first, idle); }
}
__device__ __forceinline__ void phase_gemm_moe2(const Frame& F, int l) {
    pg8::MoeOrder S; S.init(F.ws + WS_HB, (bf16*)(F.ws + WS_WD) + (size_t)l * NE * D * DE, (const int*)(F.ws + MS_BLKE) + l * 256, DE, 4, (size_t)D * DE * 2, F.G, F.blk); pg8::EpiBf16 E{(bf16*)(F.ws + WS_Y), D};
    pg8::gemm_phase(F.wave, F.lds, DE, S, E);
    { const int nun = S.nrb * 4, rem = nun % F.G, few = (rem == 0 || F.G - rem < 64), idle = few ? F.G : F.G - rem, first = few ? 0 : rem;
      conv_deferred(F, l + 1, NDEF1, NDEF, first, idle); }
}
#ifndef MOE_CPE
#define MOE_CPE 5
#endif
#ifndef MOE_CTL
#define MOE_CTL 4
#endif
#ifndef MOE_X1
#define MOE_X1 16
#define MOE_X2 8
#endif
template <int MODE = 0> __device__ __forceinline__ void phase_moe_fused(const Frame& F, int l) {
    unsigned char* ws = F.ws; const int G = F.G, blk = (MOE_VBLK && F.G == 256) ? vblk(F.blk) : F.blk;
    const int* blke = (const int*)(ws + MS_BLKE) + l * 256;
    unsigned* done = (unsigned*)(ws + WS_CTL) + CW_DONE + l * 256;
    const int nrb = __builtin_amdgcn_readfirstlane(blke[255]), nu = 4 * nrb, e1 = nu % G;
    if constexpr (MODE == 1) { pg8::MoeOrder S; S.init(ws + WS_XB, (bf16*)(ws + WS_WGU) + (size_t)l * NE * 1024 * 1024, blke, D, 4, (size_t)1024 * 1024 * 2, G, blk);
      pg8::EpiGateUp E{(bf16*)(ws + WS_HB)}; pg8::gemm_phase(F.wave, F.lds, D, S, E); return; }
    if constexpr (MODE == 0) { pg8::MoeOrder S; S.init(ws + WS_XB, (bf16*)(ws + WS_WGU) + (size_t)l * NE * 1024 * 1024, blke, D, 4, (size_t)1024 * 1024 * 2, G, blk);
      pg8::EpiGateUpPub E{__builtin_amdgcn_make_buffer_rsrc(ws + WS_HB, 0, (int)((size_t)CAP * DE * 2), 0x00020000), done};
      pg8::gemm_phase(F.wave, F.lds, D, S, E); }
    if constexpr (MODE == 2) { pg8::MoeOrder S; S.init(ws + WS_HB, (bf16*)(ws + WS_WD) + (size_t)l * NE * D * DE, blke, DE, 4, (size_t)D * DE * 2, G, blk >= e1 ? blk - e1 : blk - e1 + G);
      pg8::EpiBf16 E{(bf16*)(ws + WS_Y), D}; pg8::gemm_phase(F.wave, F.lds, DE, S, E); }
    if constexpr (MODE == 0) { pg8::MoeDepOrder S; S.init(ws + WS_HB, (bf16*)(ws + WS_WD) + (size_t)l * NE * D * DE, blke, done, DE, 4, (size_t)D * DE * 2, G, blk >= e1 ? blk - e1 : blk - e1 + G);
      pg8::EpiBf16 E{(bf16*)(ws + WS_Y), D};
      pg8::gemm_phase(F.wave, F.lds, DE, S, E); }
    { const int nt = (l + 1 < DEPTH) ? NDEF : 0, ftot = 256 * MOE_CPE + nt * MOE_CTL;
      const int wrap = 2 * e1 > G ? 2 * e1 - G : 0;
      auto cls = [&](int x, int& c24, int& c16, int& c8, int& c0) {
          const int cA = x < e1 ? x : e1, cAB = x < wrap ? x : wrap;
          int cB = x - e1; cB = cB < 0 ? 0 : cB; if (!wrap) cB = cB > e1 ? e1 : cB; cB += cAB;
          c24 = cAB; c16 = cA - cAB; c8 = cB - cAB; c0 = x - c24 - c16 - c8; };
      auto fill = [&](int x, int lv) { int c24, c16, c8, c0; cls(x, c24, c16, c8, c0);
          return c0 * lv + c8 * (lv > MOE_X2 ? lv - MOE_X2 : 0) + c16 * (lv > MOE_X1 ? lv - MOE_X1 : 0) + c24 * (lv > MOE_X1 + MOE_X2 ? lv - MOE_X1 - MOE_X2 : 0); };
      int lv = 1; while (fill(G, lv) < ftot) ++lv;
      const int B0 = fill(blk, lv), B1 = fill(blk + 1, lv);
      const int pe_tot = 256 * MOE_CPE;
      int j0 = (B0 + MOE_CPE - 1) / MOE_CPE, j1 = (B1 + MOE_CPE - 1) / MOE_CPE; j0 = j0 < 256 ? j0 : 256; j1 = j1 < 256 ? j1 : 256;
      int t0 = B0 > pe_tot ? (B0 - pe_tot + MOE_CTL - 1) / MOE_CTL : 0, t1 = B1 > pe_tot ? (B1 - pe_tot + MOE_CTL - 1) / MOE_CTL : 0; t0 = t0 < nt ? t0 : nt; t1 = t1 < nt ? t1 : nt;
      if (j1 > j0) { pg8::RangeOrder P; P.init((const bf16*)(ws + WS_PB) + (size_t)l * T * PD, (const bf16*)(ws + WS_WPE) + (size_t)l * D * PD, T, D, PD, j0, j1 - j0);
          pg8::EpiBf16 EP{(bf16*)(ws + WS_PE) + (size_t)l * T * D, D}; pg8::gemm_phase(F.wave, F.lds, PD, P, EP); }
      if (t1 > t0) { const int base = (l + 1) * TL_LAYER + t0; conv_run(F, 0, 1, t1 - t0, [=](int f) { return base + f; }); } }
}
__device__ __forceinline__ void phase_gemm_pg(const Frame& F, int l) {
    pg8::DenseOrder S; S.init(F.ws + WS_XN, (bf16*)(F.ws + WS_WPG) + (size_t)l * D * D, T, D, D, 1, F.G, F.blk);
    pg8::EpiPG E{(bf16*)(F.ws + WS_H), (const bf16*)(F.ws + WS_PE) + (size_t)l * T * D, (const float*)(F.ws + MS_RSTDPE), F.in[22] + l * D};
    pg8::gemm_phase(F.wave, F.lds, D, S, E);
}

typedef short s16x4 __attribute__((ext_vector_type(4)));
__device__ __forceinline__ bf16x8 tr_frag(LAS unsigned char* p_lo, LAS unsigned char* p_hi) {
    const s16x4 lo = __builtin_amdgcn_ds_read_tr16_b64_v4i16((LAS s16x4*)p_lo), hi = __builtin_amdgcn_ds_read_tr16_b64_v4i16((LAS s16x4*)p_hi);
    return __builtin_shufflevector(lo, hi, 0, 1, 2, 3, 4, 5, 6, 7); }
#define MFMA16(a, b, c) __builtin_amdgcn_mfma_f32_16x16x32_bf16((a), (b), (c), 0, 0, 0)
constexpr int RP = 272;
constexpr int VP = 1040;

__device__ __forceinline__ void phase_rec_c1(const Frame& F, int l) {
    PH_TID();
    unsigned char* ws = F.ws; const bf16* Z = (const bf16*)(ws + WS_Z);
    bf16* UT = (bf16*)(ws + WS_UT); float* DC = (float*)(ws + MS_DC); float* MM = (float*)(ws + MS_MM);
    const float* lb = (const float*)(ws + MS_LB) + l * DREC;
    LAS unsigned char* KD = F.lds; LAS unsigned char* IM = F.lds + 128 * RP; LAS float* totx = (LAS float*)(F.lds + 256 * RP);
    const int wave = ph_wave, ch = tid & 255, half = tid >> 8, hl = ch >> 7, k = ch & 127, g = lane >> 4, li = lane & 15, q = li >> 2, p = li & 3;
    const int hG = F.G / 2, nmine = (F.G == 256) ? (F.blk < hG ? 4 : 0) : (F.blk < 512 ? (512 - F.blk + F.G - 1) / F.G : 0);
    const int ustep = (F.G == 256) ? hG : F.G;
    u32x4 pf[4], pi[4];
    auto fetch = [&](int unit) { const int c = unit >> 1, hp = unit & 1;
#pragma unroll
        for (int j = 0; j < 4; ++j) { const int idx = tid + 512 * j, hl2 = idx >> 10, row = (idx >> 4) & 63, cc = idx & 15;
            const bf16* src = Z + (size_t)(c * 64 + row) * DIN + 512 + (2 * hp + hl2) * 128 + cc * 8; pf[j] = *(const u32x4*)src; pi[j] = *(const u32x4*)(src + 512); } };
    if (nmine > 0) fetch(F.blk);
    for (int ui = 0; ui < nmine; ++ui) {
        const int unit = F.blk + ui * ustep;
        const int c = unit >> 1, hp = unit & 1, hh = 2 * hp + hl;
#pragma unroll
        for (int j = 0; j < 4; ++j) { const int idx = tid + 512 * j, hl2 = idx >> 10, row = (idx >> 4) & 63, cc = idx & 15; const int dst = (hl2 * 64 + row) * RP + cc * 16;
            *(LAS u32x4*)(KD + dst) = pf[j]; *(LAS u32x4*)(IM + dst) = pi[j]; }
        __syncthreads();
        if (ui + 1 < nmine) fetch(unit + ustep);
        const float lbk = lb[hh * 128 + k];
        float cs[32], kk[32]; float run = 1.f;
#pragma unroll
        for (int t = 0; t < 32; ++t) { const float fz = bf2f(*(const LAS bf16*)(KD + (hl * 64 + 32 * half + t) * RP + 2 * k)); const float sg = sigmoid_(fz); run *= lbk + (1.f - lbk) * sg; cs[t] = run; kk[t] = (1.f - lbk) * (1.f - sg); }
        totx[half * 256 + ch] = run;
        __syncthreads();
        const float other = totx[(1 - half) * 256 + ch]; const float p63 = run * other; const float base_p = half == 0 ? p63 : run;
#pragma unroll
        for (int t = 0; t < 32; ++t) *(LAS bf16*)(KD + (hl * 64 + 32 * half + t) * RP + 2 * k) = (bf16)f2bf(kk[t] * base_p * frcp(fmaxf(cs[t], 1e-30f)));
        if (half == 0) { DC[(c * 4 + hh) * 128 + k] = p63; MM[(c * 4 + hh) * 128 + k] = run; }
        __syncthreads();
        { const int whl = wave >> 2, kt0 = 2 * (wave & 3), whh = 2 * hp + whl;
          f32x4 acc[2][8];
#pragma unroll
          for (int i = 0; i < 2; ++i)
#pragma unroll
              for (int vt = 0; vt < 8; ++vt) acc[i][vt] = (f32x4){0.f, 0.f, 0.f, 0.f};
          LAS unsigned char* kdb = KD + whl * 64 * RP; LAS unsigned char* imb = IM + whl * 64 * RP;
#pragma unroll
          for (int a = 0; a < 2; ++a) { const unsigned ro = (unsigned)((32 * a + 8 * g + q) * RP);
              bf16x8 Af[2];
#pragma unroll
              for (int i = 0; i < 2; ++i) { const unsigned co = (unsigned)((16 * (kt0 + i) + 4 * p) * 2); Af[i] = tr_frag(kdb + ro + co, kdb + ro + 4 * RP + co); }
#pragma unroll
              for (int vt = 0; vt < 8; ++vt) { const unsigned co = (unsigned)((16 * vt + 4 * p) * 2); const bf16x8 Bf = tr_frag(imb + ro + co, imb + ro + 4 * RP + co);
#pragma unroll
                  for (int i = 0; i < 2; ++i) acc[i][vt] = MFMA16(Af[i], Bf, acc[i][vt]); } }
#pragma unroll
          for (int i = 0; i < 2; ++i)
#pragma unroll
              for (int vt = 0; vt < 8; ++vt) { u32x2 w; w.x = pg8::cvt_pk_bf16(acc[i][vt][0], acc[i][vt][1]); w.y = pg8::cvt_pk_bf16(acc[i][vt][2], acc[i][vt][3]);
                  *(u32x2*)(UT + ((size_t)(c * 4 + whh) * 128 + 16 * vt + li) * 128 + 16 * (kt0 + i) + 4 * g) = w; } }
        __syncthreads();
    }
}
__device__ __forceinline__ void phase_rec_c2a(const Frame& F) {
    PH_TID();
    unsigned char* ws = F.ws; const unsigned* UT = (const unsigned*)(ws + WS_UT); const float* DC = (const float*)(ws + MS_DC);
    f32x2* LT = (f32x2*)(ws + WS_LTOT); float* PT = (float*)(ws + MS_PTOT);
    for (int it = F.blk * NTHR + tid; it < 16 * 32768; it += F.G * NTHR) {
        const int gs = it >> 15, e = it & 32767, hh = e >> 13, v = (e >> 6) & 127, k0 = 2 * (e & 63);
        float S0 = 0.f, S1 = 0.f, P0 = 1.f, P1 = 1.f;
#pragma unroll
        for (int cc = 0; cc < 16; ++cc) { const int c = 16 * gs + cc; const unsigned u = UT[(size_t)c * 32768 + e]; const f32x2 d = *(const f32x2*)(DC + (c * 4 + hh) * 128 + k0);
            S0 = d.x * S0 + bflo(u); S1 = d.y * S1 + bfhi(u); P0 *= d.x; P1 *= d.y; }
        LT[it] = (f32x2){S0, S1};
        if (v == 0) *(f32x2*)(PT + (gs * 4 + hh) * 128 + k0) = (f32x2){P0, P1};
    }
}
__device__ __forceinline__ void phase_rec_c2c(const Frame& F) {
    PH_TID();
    unsigned char* ws = F.ws; const unsigned* UT = (const unsigned*)(ws + WS_UT); unsigned* ST = (unsigned*)(ws + WS_ST); const float* DC = (const float*)(ws + MS_DC); const float* MM = (const float*)(ws + MS_MM);
    const f32x2* LT = (const f32x2*)(ws + WS_LTOT); const float* PT = (const float*)(ws + MS_PTOT);
    for (int it = F.blk * NTHR + tid; it < 16 * 32768; it += F.G * NTHR) {
        const int gs = it >> 15, e = it & 32767, hh = e >> 13, k0 = 2 * (e & 63);
        float C0 = 0.f, C1 = 0.f;
        for (int g2 = 0; g2 < gs; ++g2) { const f32x2 pt = *(const f32x2*)(PT + (g2 * 4 + hh) * 128 + k0); const f32x2 lt = LT[g2 * 32768 + e]; C0 = pt.x * C0 + lt.x; C1 = pt.y * C1 + lt.y; }
#pragma unroll
        for (int cc = 0; cc < 16; ++cc) { const int c = 16 * gs + cc; const f32x2 mm = *(const f32x2*)(MM + (c * 4 + hh) * 128 + k0);
            ST[(size_t)c * 32768 + e] = pk2(C0 * mm.x, C1 * mm.y);
            const unsigned u = UT[(size_t)c * 32768 + e]; const f32x2 d = *(const f32x2*)(DC + (c * 4 + hh) * 128 + k0);
            C0 = d.x * C0 + bflo(u); C1 = d.y * C1 + bfhi(u); }
    }
}
__device__ __forceinline__ void phase_rec_c2(const Frame& F) {
    PH_TID();
    unsigned char* ws = F.ws; const int w = ph_wave;
    LAS float* tot = (LAS float*)F.lds;
    for (int unit = F.blk; unit < 256; unit += F.G) {
        const int hh = unit >> 6; const unsigned eo = (unsigned)(unit * 128 + lane), ko = (unsigned)(hh * 128 + 2 * lane);
        const unsigned* ut = (const unsigned*)(ws + WS_UT) + (size_t)(32 * w) * 32768; unsigned* st = (unsigned*)(ws + WS_ST) + (size_t)(32 * w) * 32768;
        const float* dc = (const float*)(ws + MS_DC) + (32 * w) * 512; const float* mmp = (const float*)(ws + MS_MM) + (32 * w) * 512;
        asm volatile("" : "+s"(ut), "+s"(st), "+s"(dc), "+s"(mmp));
        unsigned ua[32], ub[32]; f32x2 d[32], m0[16], m1[16];
#pragma unroll
        for (int cc = 0; cc < 32; ++cc) { ua[cc] = (ut + cc * 32768)[eo]; ub[cc] = (ut + cc * 32768 + 64)[eo]; d[cc] = *(const f32x2*)((dc + cc * 512) + ko); }
        __builtin_amdgcn_sched_barrier(0);
        float a0 = 0.f, a1 = 0.f, b0 = 0.f, b1 = 0.f, p0 = 1.f, p1 = 1.f;
#pragma unroll
        for (int cc = 0; cc < 32; ++cc) { a0 = d[cc].x * a0 + bflo(ua[cc]); a1 = d[cc].y * a1 + bfhi(ua[cc]); b0 = d[cc].x * b0 + bflo(ub[cc]); b1 = d[cc].y * b1 + bfhi(ub[cc]); p0 *= d[cc].x; p1 *= d[cc].y; }
        { LAS float* tw = tot + w * 384 + lane; tw[0] = a0; tw[64] = a1; tw[128] = b0; tw[192] = b1; tw[256] = p0; tw[320] = p1; }
        __builtin_amdgcn_sched_barrier(0);
#pragma unroll
        for (int cc = 0; cc < 16; ++cc) m0[cc] = *(const f32x2*)((mmp + cc * 512) + ko);
        __builtin_amdgcn_sched_barrier(0);
        __syncthreads();
        float A0 = 0.f, A1 = 0.f, B0 = 0.f, B1 = 0.f;
        for (int g2 = 0; g2 < w; ++g2) { const LAS float* tw = tot + g2 * 384 + lane; const float q0 = tw[256], q1 = tw[320]; A0 = q0 * A0 + tw[0]; A1 = q1 * A1 + tw[64]; B0 = q0 * B0 + tw[128]; B1 = q1 * B1 + tw[192]; }
        __builtin_amdgcn_sched_barrier(0);
#pragma unroll
        for (int cc = 0; cc < 16; ++cc) m1[cc] = *(const f32x2*)((mmp + (16 + cc) * 512) + ko);
        __builtin_amdgcn_sched_barrier(0);
#pragma unroll
        for (int cc = 0; cc < 32; ++cc) { const f32x2 mm = cc < 16 ? m0[cc & 15] : m1[cc & 15];
            (st + cc * 32768)[eo] = pk2(A0 * mm.x, A1 * mm.y); (st + cc * 32768 + 64)[eo] = pk2(B0 * mm.x, B1 * mm.y);
            unsigned xa = ua[cc], xb = ub[cc]; asm volatile("" : "+v"(xa), "+v"(xb));
            A0 = d[cc].x * A0 + bflo(xa); A1 = d[cc].y * A1 + bfhi(xa); B0 = d[cc].x * B0 + bflo(xb); B1 = d[cc].y * B1 + bfhi(xb);
            asm volatile("" : "+v"(A0), "+v"(A1), "+v"(B0), "+v"(B1) :: "memory"); }
        __syncthreads();
    }
}
template <int PV = 0> __device__ __forceinline__ void phase_rec_c3(const Frame& F, int l) {
    PH_TID();
    unsigned char* ws = F.ws; const bf16* Z = (const bf16*)(ws + WS_Z); const bf16* ST = (const bf16*)(ws + WS_ST); bf16* O = (bf16*)(ws + WS_O);
    const float* lb = (const float*)(ws + MS_LB) + l * DREC; const float* ogain = F.in[5] + l * 128;
    LAS unsigned char* QT = F.lds; LAS unsigned char* KT = F.lds + 128 * RP; LAS unsigned char* IM = F.lds + 256 * RP;
    const int wave = ph_wave, ch = tid & 255, half = tid >> 8, hl = ch >> 7, k = ch & 127, g = lane >> 4, li = lane & 15, q = li >> 2, p = li & 3;
    u32x4 pq[4], pf[4];
    const unsigned tvo = (unsigned)((tid >> 4) * DIN + (tid & 15) * 8), tlo = (unsigned)((tid >> 4) * RP + (tid & 15) * 16);
    auto fetch = [&](int unit) { const bf16* zc = Z + (size_t)(unit >> 1) * 64 * DIN + (unit & 1) * 256;
#pragma unroll
        for (int j = 0; j < 4; ++j) { const bf16* src = zc + (32 * (j & 1)) * DIN + (j >> 1) * 128; pq[j] = *(const u32x4*)(src + tvo); pf[j] = *(const u32x4*)(src + 512 + tvo); } };
    if (F.blk < 512) fetch(F.blk);
    for (int unit = F.blk; unit < 512; unit += F.G) {
        const int c = unit >> 1, hp = unit & 1, hh = 2 * hp + hl;
#pragma unroll
        for (int j = 0; j < 4; ++j) { const int dst = ((j >> 1) * 64 + 32 * (j & 1)) * RP;
            *(LAS u32x4*)(QT + dst + tlo) = pq[j]; *(LAS u32x4*)(KT + dst + tlo) = pf[j]; }
        u32x4 vi[4];
        { const bf16* zc = Z + (size_t)c * 64 * DIN + hp * 256 + 1024;
#pragma unroll
          for (int j = 0; j < 4; ++j) vi[j] = *(const u32x4*)(zc + (32 * (j & 1)) * DIN + (j >> 1) * 128 + tvo); }
        __syncthreads();
        { const float lbk = lb[hh * 128 + k]; const int col = (hl * 64 + 32 * half) * RP + 2 * k;
          float cs[32], kk[32], qs[32]; float run = 1.f;
#pragma unroll
          for (int t = 0; t < 32; ++t) { const float fz = bf2f(*(const LAS bf16*)(KT + col + t * RP)); const float sg = sigmoid_(fz); run *= lbk + (1.f - lbk) * sg; cs[t] = run; kk[t] = (1.f - lbk) * (1.f - sg);
              qs[t] = silu_(bf2f(*(const LAS bf16*)(QT + col + t * RP))); }
          const float inv = half == 0 ? frcp(fmaxf(run, 1e-30f)) : 1.f;
#pragma unroll
          for (int t = 0; t < 32; ++t) { const float ex = cs[t] * inv; const int off = col + t * RP;
              *(LAS bf16*)(QT + off) = (bf16)f2bf(qs[t] * ex); *(LAS bf16*)(KT + off) = (bf16)f2bf(kk[t] * frcp(fmaxf(ex, 1e-30f))); } }
#pragma unroll
        for (int j = 0; j < 4; ++j) *(LAS u32x4*)(IM + ((j >> 1) * 64 + 32 * (j & 1)) * RP + tlo) = vi[j];
        const int whl = wave >> 2, tt = wave & 3, whh = 2 * hp + whl;
        bf16x8 Sf[8][4];
#pragma unroll
        for (int vt = 0; vt < 8; ++vt)
#pragma unroll
            for (int a = 0; a < 4; ++a) Sf[vt][a] = *(const bf16x8*)(ST + ((size_t)(c * 4 + whh) * 128 + 16 * vt + li) * 128 + 32 * a + 8 * g);
        __syncthreads();
        if (PV != 1) {
          bf16 gz[8][4];
#pragma unroll
          for (int vt = 0; vt < 8; ++vt)
#pragma unroll
              for (int r = 0; r < 4; ++r) gz[vt][r] = Z[((size_t)c * 64 + 16 * tt + 4 * g + r) * DIN + 1536 + whh * 128 + 16 * vt + li];
          bf16x8 Qf[4];
#pragma unroll
          for (int a = 0; a < 4; ++a) Qf[a] = *(const LAS bf16x8*)(QT + (whl * 64 + 16 * tt + li) * RP + (32 * a + 8 * g) * 2);
          unsigned pw[4][2];
#pragma unroll
          for (int st = 0; st < 4; ++st) { pw[st][0] = 0u; pw[st][1] = 0u;
              { f32x4 s = (f32x4){0.f, 0.f, 0.f, 0.f};
#pragma unroll
                  for (int a = 0; a < 4; ++a) { const bf16x8 Kf = *(const LAS bf16x8*)(KT + (whl * 64 + 16 * st + li) * RP + (32 * a + 8 * g) * 2); s = MFMA16(Kf, Qf[a], s); }
                  if (st == tt) {
#pragma unroll
                      for (int r = 0; r < 4; ++r) if (4 * g + r > li) s[r] = 0.f; }
                  pw[st][0] = st <= tt ? pg8::cvt_pk_bf16(s[0], s[1]) : 0u; pw[st][1] = st <= tt ? pg8::cvt_pk_bf16(s[2], s[3]) : 0u; } }
          f32x4 acc[8];
#pragma unroll
          for (int vt = 0; vt < 8; ++vt) { acc[vt] = (f32x4){0.f, 0.f, 0.f, 0.f};
#pragma unroll
              for (int a = 0; a < 4; ++a) acc[vt] = MFMA16(Qf[a], Sf[vt][a], acc[vt]); }
          __builtin_amdgcn_sched_barrier(0);
          if (unit + F.G < 512) fetch(unit + F.G);
          __builtin_amdgcn_sched_barrier(0);
          LAS unsigned char* imb = IM + whl * 64 * RP;
#pragma unroll
          for (int a = 0; a < 2; ++a) { const u32x4 pv = (u32x4){pw[2 * a][0], pw[2 * a][1], pw[2 * a + 1][0], pw[2 * a + 1][1]}; const bf16x8 Pf = __builtin_bit_cast(bf16x8, pv);
              const unsigned ro = (unsigned)((32 * a + 4 * g + q) * RP);
#pragma unroll
              for (int vt = 0; vt < 8; ++vt) { const unsigned co = (unsigned)((16 * vt + 4 * p) * 2); const bf16x8 If = tr_frag(imb + ro + co, imb + ro + 16 * RP + co); acc[vt] = MFMA16(Pf, If, acc[vt]); } }
          float rs[4];
#pragma unroll
          for (int r = 0; r < 4; ++r) { float ss = 0.f;
#pragma unroll
              for (int vt = 0; vt < 8; ++vt) ss += acc[vt][r] * acc[vt][r];
              ss += shx<1>(ss); ss += shx<2>(ss); ss += shx<4>(ss); ss += shx<8>(ss); rs[r] = frsq(ss * (1.f / 128.f) + EPS); }
#pragma unroll
          for (int vt = 0; vt < 8; ++vt) { const float og = ogain[16 * vt + li];
#pragma unroll
              for (int r = 0; r < 4; ++r) { const size_t t = (size_t)c * 64 + 16 * tt + 4 * g + r; const float gv = bf2f(gz[vt][r]);
                  O[t * D + whh * 128 + 16 * vt + li] = (bf16)f2bf(acc[vt][r] * rs[r] * og * silu_(gv)); } } }
        __syncthreads();
    }
}
__device__ __forceinline__ void phase_sgu(const Frame& F, int l) {
    PH_TID();
    unsigned char* ws = F.ws; const bf16* Z = (const bf16*)(ws + WS_Z); bf16* O = (bf16*)(ws + WS_O);
    const bf16* Wb = (const bf16*)(ws + MS_SGUW) + (size_t)l * 4 * 128 * 128; const float* sb = F.in[9] + l * 4 * 128;
    LAS unsigned char* VN = F.lds;
    const int wave = ph_wave, g = lane >> 4, li = lane & 15, q = li >> 2, p = li & 3;
    for (int unit = (F.blk + F.G / 2) % F.G; unit < 128; unit += F.G) {
        float lg[8], lbv[8];
#pragma unroll
        for (int j = 0; j < 8; ++j) { lg[j] = F.in[6][l * DSGU + 8 * lane + j]; lbv[j] = F.in[7][l * DSGU + 8 * lane + j]; }
        u32x4 raw[16];
#pragma unroll
        for (int i = 0; i < 16; ++i) raw[i] = *(const u32x4*)(Z + ((size_t)unit * 128 + 16 * wave + i) * DIN + 2560 + 8 * lane);
#pragma unroll
        for (int i = 0; i < 16; ++i) { const int s = 16 * wave + i; const u32x4 r = raw[i];
            float x[8] = {gelu_(bflo(r.x)), gelu_(bfhi(r.x)), gelu_(bflo(r.y)), gelu_(bfhi(r.y)), gelu_(bflo(r.z)), gelu_(bfhi(r.z)), gelu_(bflo(r.w)), gelu_(bfhi(r.w))};
            float sm = 0.f, qq = 0.f;
#pragma unroll
            for (int j = 0; j < 8; ++j) { sm += x[j]; qq += x[j] * x[j]; }
            sm += shx<1>(sm); qq += shx<1>(qq); sm += shx<2>(sm); qq += shx<2>(qq); sm += shx<4>(sm); qq += shx<4>(qq); sm += shx<8>(sm); qq += shx<8>(qq); sm += shx<16>(sm); qq += shx<16>(qq);
            const float mu = halves_sum(sm) * (1.f / 512.f); const float var = fmaxf(halves_sum(qq) * (1.f / 512.f) - mu * mu, 0.f);
            const float rstd = frsq(var + EPS);
#pragma unroll
            for (int j = 0; j < 8; ++j) x[j] = (x[j] - mu) * rstd * lg[j] + lbv[j];
            u32x4 o; o.x = pk2(x[0], x[1]); o.y = pk2(x[2], x[3]); o.z = pk2(x[4], x[5]); o.w = pk2(x[6], x[7]);
            *(LAS u32x4*)(VN + s * VP + lane * 16) = o; }
        __syncthreads();
        { const int hh = wave >> 1, dh = wave & 1; const bf16* W = Wb + (size_t)hh * 128 * 128;
          LAS unsigned char* vnb = VN;
#pragma unroll 1
          for (int dp = 0; dp < 2; ++dp) {
          bf16x8 Wf[2][8];
#pragma unroll
          for (int a = 0; a < 2; ++a)
#pragma unroll
              for (int ti = 0; ti < 8; ++ti) if (ti >= 2 * a) Wf[a][ti] = *(const bf16x8*)(W + (size_t)(16 * ti + li) * 128 + 32 * a + 8 * g);
          u32x2 uu[8][2]; float bs[8];
#pragma unroll
          for (int ti = 0; ti < 8; ++ti) { bs[ti] = sb[hh * 128 + 16 * ti + li];
#pragma unroll
              for (int dt = 0; dt < 2; ++dt) uu[ti][dt] = *(const u32x2*)(Z + ((size_t)unit * 128 + 16 * ti + li) * DIN + 2048 + hh * 128 + 64 * dh + 16 * (2 * dp + dt) + 4 * g); }
          f32x4 acc[2][8];
#pragma unroll
          for (int dt = 0; dt < 2; ++dt)
#pragma unroll
              for (int ti = 0; ti < 8; ++ti) acc[dt][ti] = (f32x4){0.f, 0.f, 0.f, 0.f};
#pragma unroll
          for (int a = 0; a < 4; ++a) { const unsigned ro = (unsigned)((32 * a + 8 * g + q) * VP);
              bf16x8 Af[2];
#pragma unroll
              for (int dt = 0; dt < 2; ++dt) { const unsigned co = (unsigned)((hh * 128 + 64 * dh + 16 * (2 * dp + dt) + 4 * p) * 2); Af[dt] = tr_frag(vnb + ro + co, vnb + ro + 4 * VP + co); }
#pragma unroll
              for (int ti = 0; ti < 8; ++ti) if (ti >= 2 * a) {
                  const bf16x8 Bf = a < 2 ? Wf[a < 2 ? a : 0][ti] : *(const bf16x8*)(W + (size_t)(16 * ti + li) * 128 + 32 * a + 8 * g);
#pragma unroll
                  for (int dt = 0; dt < 2; ++dt) acc[dt][ti] = MFMA16(Af[dt], Bf, acc[dt][ti]); } }
#pragma unroll
          for (int ti = 0; ti < 8; ++ti) { const size_t t = (size_t)unit * 128 + 16 * ti + li; const float bias = bs[ti];
#pragma unroll
              for (int dt = 0; dt < 2; ++dt) { const int col = hh * 128 + 64 * dh + 16 * (2 * dp + dt) + 4 * g; const u32x2 u = uu[ti][dt];
                  u32x2 w; w.x = pk2((acc[dt][ti][0] + bias) * gelu_(bflo(u.x)), (acc[dt][ti][1] + bias) * gelu_(bfhi(u.x))); w.y = pk2((acc[dt][ti][2] + bias) * gelu_(bflo(u.y)), (acc[dt][ti][3] + bias) * gelu_(bfhi(u.y)));
                  *(u32x2*)(O + t * D + 512 + col) = w; } } } }
        __syncthreads();
    }
}

#define XB_TMO      128
#define XB_XCNT(j)  (256  + 64 * (j))
#define XB_XSUB(j)  (1280 + 64 * (j))
#define XB_XGEN(j)  (2304 + 64 * (j))
#define XB_TOP      3328
#define XB_TOPGEN   3392
#define XCD_BAR_WORDS 3456
#define XB_SPIN_CAP (1u << 18)
__device__ __forceinline__ unsigned xb_ld(unsigned* p)              { return __hip_atomic_load(p, __ATOMIC_RELAXED, __HIP_MEMORY_SCOPE_AGENT); }
__device__ __forceinline__ unsigned xb_add(unsigned* p, unsigned v) { return __hip_atomic_fetch_add(p, v, __ATOMIC_RELAXED, __HIP_MEMORY_SCOPE_AGENT); }
__device__ __forceinline__ unsigned xb_xcc_id() { return (unsigned)__builtin_amdgcn_s_getreg((3 << 11) | 20) & 0xFu; }
#define XB_SPIN(cond, bar) do { unsigned _sp = 0; while (cond) { __builtin_amdgcn_s_sleep(1); \
    if ((++_sp & 255u) == 0u) { if (xb_ld(&(bar)[XB_TMO])) break; if (_sp > XB_SPIN_CAP) { atomicAdd(&(bar)[XB_TMO], 1u); break; } } } } while (0)
struct XcdBarrier { unsigned* bar; unsigned x; volatile LAS unsigned* st; int wave; };
__device__ __forceinline__ XcdBarrier xcd_barrier_post(unsigned* bar, volatile LAS unsigned* st, int wave) {
    XcdBarrier b; b.bar = bar; b.x = xb_xcc_id(); b.st = st; b.wave = wave;
    if (wave == 0 && lane_now() == 0) (void)xb_add(&bar[XB_XCNT(b.x)], 1u);
    return b;
}
__device__ __forceinline__ void xcd_barrier_complete(unsigned* bar, unsigned x, unsigned& nloc, unsigned& nx) {
    const unsigned G = gridDim.x * gridDim.y * gridDim.z;
    unsigned sum, cnt, mine, sp = 0u;
    for (;;) {
        sum = 0u; cnt = 0u; mine = 0u;
#pragma unroll
        for (unsigned j = 0; j < 16; ++j) { const unsigned c = xb_ld(&bar[XB_XCNT(j)]); sum += c; cnt += (c > 0u) ? 1u : 0u; mine = (j == x) ? c : mine; }
        if (sum == G) break;
        __builtin_amdgcn_s_sleep(1);
        if ((++sp & 255u) == 0u) { if (xb_ld(&bar[XB_TMO])) break; if (sp > XB_SPIN_CAP) { atomicAdd(&bar[XB_TMO], 1u); break; } }
    }
    nloc = mine > 0u ? mine : 1u; nx = cnt > 0u ? cnt : 1u;
}
__device__ __forceinline__ void xcd_barrier(const XcdBarrier& b) {
    asm volatile("s_waitcnt vmcnt(0)" ::: "memory");
    __syncthreads();
    if (b.wave == 0 && lane_now() == 0) {
        unsigned* bar = b.bar;
        __builtin_amdgcn_s_waitcnt(0);
        unsigned nloc = b.st[0], nx = b.st[1];
        if (nloc == 0u) { xcd_barrier_complete(bar, b.x, nloc, nx); b.st[0] = nloc; b.st[1] = nx; }
        const unsigned old = xb_add(&bar[XB_XSUB(b.x)], 1u);
        const unsigned gen = old / nloc;
        if (old + 1u == (gen + 1u) * nloc) {
            __builtin_amdgcn_fence(__ATOMIC_RELEASE, "agent");
            asm volatile("s_waitcnt vmcnt(0)" ::: "memory");
            const unsigned og = xb_add(&bar[XB_TOP], 1u);
            const unsigned tg = og / nx;
            if (og + 1u == (tg + 1u) * nx) xb_add(&bar[XB_TOPGEN], 1u);
            else XB_SPIN(xb_ld(&bar[XB_TOPGEN]) == tg, bar);
            __builtin_amdgcn_fence(__ATOMIC_ACQUIRE, "agent");
            xb_add(&bar[XB_XGEN(b.x)], 1u);
            asm volatile("s_waitcnt vmcnt(0)" ::: "memory");
        } else {
            XB_SPIN(xb_ld(&bar[XB_XGEN(b.x)]) == gen, bar);
            __builtin_amdgcn_fence(__ATOMIC_ACQUIRE, "agent");
            asm volatile("s_waitcnt vmcnt(0)" ::: "memory");
        }
    }
    __syncthreads();
}


__device__ __forceinline__ void xcd_barrier_bg(const XcdBarrier& b, const Frame& F, int lnext, bool drain) {
    asm volatile("s_waitcnt vmcnt(0)" ::: "memory");
    __syncthreads();
    volatile LAS unsigned* sx = b.st + 4;
    unsigned* q = (unsigned*)(F.ws + WS_CTL) + CW_BGQ + lnext * 64;
    if (b.wave == 0 && lane_now() == 0) {
        unsigned* bar = b.bar;
        __builtin_amdgcn_s_waitcnt(0);
        unsigned nloc = b.st[0], nx = b.st[1];
        if (nloc == 0u) { xcd_barrier_complete(bar, b.x, nloc, nx); b.st[0] = nloc; b.st[1] = nx; }
        const unsigned old = xb_add(&bar[XB_XSUB(b.x)], 1u);
        const unsigned gen = old / nloc;
        const bool leader = (old + 1u == (gen + 1u) * nloc);
        unsigned ti = 0u; if (!leader) { const unsigned k = xb_add(q, 1u); if (k < (unsigned)NBG) ti = k + 1u; }
        sx[0] = leader ? 1u : 0u; sx[1] = gen; sx[2] = ti;
    }
    __syncthreads();
    if (__builtin_amdgcn_readfirstlane(sx[0]) == 0u) {
        unsigned ti = (unsigned)__builtin_amdgcn_readfirstlane(sx[2]);
        while (ti != 0u) {
            const int it = lnext * TL_LAYER + NDEF + (int)ti - 1;
            conv_run(F, 0, 1, 1, [=](int) { return it; });
            if (!drain) break;
            if (b.wave == 0 && lane_now() == 0) { const unsigned k = xb_add(q, 1u); sx[2] = k < (unsigned)NBG ? k + 1u : 0u; }
            __syncthreads();
            ti = (unsigned)__builtin_amdgcn_readfirstlane(sx[2]);
            __syncthreads();
        }
    }
    if (b.wave == 0 && lane_now() == 0) {
        unsigned* bar = b.bar; const unsigned gen = sx[1], nx = b.st[1];
        asm volatile("s_waitcnt vmcnt(0)" ::: "memory");
        if (sx[0] != 0u) {
            __builtin_amdgcn_fence(__ATOMIC_RELEASE, "agent");
            asm volatile("s_waitcnt vmcnt(0)" ::: "memory");
            const unsigned og = xb_add(&bar[XB_TOP], 1u);
            const unsigned tg = og / nx;
            if (og + 1u == (tg + 1u) * nx) xb_add(&bar[XB_TOPGEN], 1u);
            else XB_SPIN(xb_ld(&bar[XB_TOPGEN]) == tg, bar);
            __builtin_amdgcn_fence(__ATOMIC_ACQUIRE, "agent");
            xb_add(&bar[XB_XGEN(b.x)], 1u);
            asm volatile("s_waitcnt vmcnt(0)" ::: "memory");
        } else {
            XB_SPIN(xb_ld(&bar[XB_XGEN(b.x)]) == gen, bar);
            __builtin_amdgcn_fence(__ATOMIC_ACQUIRE, "agent");
            asm volatile("s_waitcnt vmcnt(0)" ::: "memory");
        }
    }
    __syncthreads();
}

__device__ __forceinline__ bool opq(Frame& F) { asm volatile("" : "+s"(F.ws), "+s"(F.blk), "+s"(F.out), "+s"(F.G)); return true; }
__device__ __forceinline__ int lq_(int l) { asm volatile("" : "+s"(l)); return l; }
__global__ void __launch_bounds__(NTHR, 2) k_mega(Params p) {
    extern __shared__ __attribute__((aligned(16))) unsigned char lds[];
    Frame F; F.lds = (LAS unsigned char*)lds; F.ws = p.ws; F.in = p.in; F.out = p.out; F.wave = __builtin_amdgcn_readfirstlane(threadIdx.x >> 6); F.blk = blockIdx.x; F.G = gridDim.x;
    volatile LAS unsigned* st = (volatile LAS unsigned*)(F.lds + LDS_BYTES - 32);
    if (threadIdx.x < 8) st[threadIdx.x] = 0u;
    __syncthreads();
#if USE_CG_SYNC
#define GRID_BAR() cooperative_groups::this_grid().sync()
#else
    const XcdBarrier bar = xcd_barrier_post((unsigned*)(p.ws + WS_CTL) + CW_BAR + p.li * XCD_BAR_WORDS, st, F.wave);
#define GRID_BAR() xcd_barrier(bar)
#endif
    const int lo = p.ph_lo, hi = p.ph_hi;
#define RUN(k) (lo <= (k) && (k) < hi && opq(F))
#define SEAM(k) do { if (RUN(k) && RUN((k) + 1)) GRID_BAR(); } while (0)
#define SEAM_BG(k, drain) do { if (RUN(k) && RUN((k) + 1)) { if (!USE_CG_SYNC && l + 1 < DEPTH) xcd_barrier_bg(bar, F, l + 1, drain); else GRID_BAR(); } } while (0)
    if (RUN(0)) { phase_prologue(F); if (PROBE_DUP & 16) { __syncthreads(); phase_prologue(F); } }
    SEAM(0);
    for (int l = 0; l < DEPTH; ++l) {
        const int b = 2 + 13 * l;
        if (RUN(b + 0)) phase_norm1(F, lq_(l));
        SEAM_BG(b + 0, false);
        if (RUN(b + 1)) phase_gemm_in(F, lq_(l));
        SEAM_BG(b + 1, false);
        if (RUN(b + 2)) { phase_rec_c1(F, lq_(l)); phase_sgu(F, lq_(l)); if (PROBE_DUP & 1) { __syncthreads(); phase_rec_c1(F, lq_(l)); phase_sgu(F, lq_(l)); } if (PROBE_DUP & 64) { __syncthreads(); phase_sgu(F, lq_(l)); } }
        SEAM_BG(b + 2, false);
        if (RUN(b + 3)) { phase_rec_c2(F); if (PROBE_DUP & 4) phase_rec_c2(F); }
        SEAM_BG(b + 3, false);
        if (RUN(b + 5)) { phase_rec_c3(F, lq_(l)); if (PROBE_DUP & 2) { __syncthreads(); phase_rec_c3(F, lq_(l)); } if (PROBE_DUP & 128) { __syncthreads(); phase_rec_c3<1>(F, lq_(l)); } }
        SEAM_BG(b + 5, false);
        if (RUN(b + 6)) phase_gemm_out(F, lq_(l));
        SEAM_BG(b + 6, false);
        if (RUN(b + 7)) phase_norm2(F, lq_(l));
        SEAM_BG(b + 7, false);
        if (RUN(b + 8)) { phase_gather(F, lq_(l)); if (PROBE_DUP & 8) { __syncthreads(); phase_gather(F, lq_(l)); } }
        SEAM_BG(b + 8, false);
#if MOE_FUSED == 1
        if (RUN(b + 9)) phase_moe_fused(F, lq_(l));
        SEAM_BG(b + 9, false);
#elif MOE_FUSED == 2
        if (RUN(b + 9)) phase_moe_fused<1>(F, lq_(l));
        SEAM_BG(b + 9, false);
        if (RUN(b + 10)) phase_moe_fused<2>(F, lq_(l));
        SEAM_BG(b + 10, false);
#else
        if (RUN(b + 9)) phase_gemm_moe1(F, lq_(l));
        SEAM_BG(b + 9, false);
        if (RUN(b + 10)) phase_gemm_moe2(F, lq_(l));
        SEAM_BG(b + 10, false);
#endif
        if (RUN(b + 11)) phase_combine(F, lq_(l));
        SEAM_BG(b + 11, true);
        if (RUN(b + 12)) phase_gemm_pg(F, lq_(l));
        SEAM(b + 12);
    }
    if (RUN(54)) phase_final(F);
#undef RUN
#undef SEAM
}

#ifndef ONE_LAUNCH
#define ONE_LAUNCH 1
#endif
#ifndef CUTS
#define CUTS {0, 55}
#endif
#ifndef MFMA_MASK
#define MFMA_MASK 255
#endif
extern "C" void kernel_launch(void* const* d_in, const int* in_sizes, int n_in, void* d_out, int out_size, void* d_ws, size_t ws_size, hipStream_t stream) {
    if (n_in != 24 || out_size != T * D || ws_size < WS_END) { fprintf(stderr, "kernel_launch: unexpected shapes (n_in %d out %d ws %zu)\n", n_in, out_size, ws_size); return; }
    static_assert(CW_BAR + 60 * XCD_BAR_WORDS <= (int)(CTL_BYTES / 4), "barrier regions inside the zeroed control words");
    Params p{}; for (int i = 0; i < 24; ++i) p.in[i] = (const float*)d_in[i]; p.out = (float*)d_out; p.ws = (unsigned char*)d_ws;
    unsigned char* ws = p.ws;
    (void)hipMemsetAsync(ws + WS_CTL, 0, CTL_BYTES, stream);
    { static bool attr = false; if (!attr) { (void)hipFuncSetAttribute((const void*)k_mega, hipFuncAttributeMaxDynamicSharedMemorySize, LDS_BYTES); attr = true; }
      const int cuts[] = CUTS; const int ncut = (int)(sizeof(cuts) / sizeof(cuts[0]));
      for (int i = 0; i + 1 < ncut; ++i) { p.ph_lo = cuts[i]; p.ph_hi = cuts[i + 1]; p.li = i; p.pad = 0;
#if USE_CG_SYNC
          void* args[] = {&p}; hipError_t e = hipLaunchCooperativeKernel((const void*)k_mega, dim3(256), dim3(NTHR), args, LDS_BYTES, stream);
          if (e != hipSuccess) fprintf(stderr, "cooperative launch failed: %s\n", hipGetErrorName(e));
#else
          hipLaunchKernelGGL(k_mega, dim3(256), dim3(NTHR), LDS_BYTES, stream, p);
#endif
      }
    }
}
```

```cpp
#include <hip/hip_runtime.h>
#include <hip/hip_cooperative_groups.h>
#include <cstdio>
#include <cstdint>

#define GAS __attribute__((address_space(1)))
#define LAS __attribute__((address_space(3)))
typedef unsigned short bf16;
typedef float f32x4 __attribute__((ext_vector_type(4)));
typedef float f32x2 __attribute__((ext_vector_type(2)));
typedef unsigned u32x4 __attribute__((ext_vector_type(4)));
typedef unsigned u32x2 __attribute__((ext_vector_type(2)));
typedef short bf16x8 __attribute__((ext_vector_type(8)));

constexpr int T = 16384, D = 1024, DEPTH = 4, DIN = 3072, DREC = 512, DSGU = 512;
constexpr int NE = 32, DE = 512, PD = 256;
constexpr int RB = 256;
constexpr int CAP = 2 * T + NE * RB;
constexpr int NRBMAX = CAP / RB;
constexpr float EPS = 1e-6f;
constexpr int NWAVES = 8, NTHR = 512;

constexpr size_t MiB = 1u << 20, KiB = 1u << 10;
constexpr size_t WS_CTL = 0, CTL_BYTES = 1 * MiB;
constexpr size_t WS_MISC = 1 * MiB;
constexpr size_t MS_TOKE = WS_MISC + 0;
constexpr size_t MS_TOKW = WS_MISC + 128 * KiB;
constexpr size_t MS_SINFO = WS_MISC + 256 * KiB;
constexpr size_t MS_SDEST = WS_MISC + 384 * KiB;
constexpr size_t MS_RSTDPE = WS_MISC + 512 * KiB;
constexpr size_t MS_BLKBASE = WS_MISC + 576 * KiB;
constexpr size_t MS_LB = WS_MISC + 608 * KiB;
constexpr size_t MS_RSTD2 = WS_MISC + 704 * KiB;
constexpr size_t MS_BLKE = WS_MISC + 640 * KiB;
constexpr size_t MS_DC = WS_MISC + 1 * MiB;
constexpr size_t MS_WRT = WS_MISC + 2 * MiB;
constexpr size_t MS_SGUW = WS_MISC + 3 * MiB;
constexpr size_t MS_MM = WS_MISC + 4 * MiB;
constexpr size_t MS_PTOT = WS_MISC + 5 * MiB;
constexpr size_t WS_WIN = 16 * MiB;
constexpr size_t WS_WOUT = 40 * MiB;
constexpr size_t WS_WGU = 48 * MiB;
constexpr size_t WS_WD = 304 * MiB;
constexpr size_t WS_WPG = 432 * MiB;
constexpr size_t WS_WPE = 440 * MiB;
constexpr size_t WS_PB = 442 * MiB;
constexpr size_t WS_H = 474 * MiB;
constexpr size_t WS_XN = 538 * MiB;
constexpr size_t WS_O = 570 * MiB;
constexpr size_t WS_PE = 602 * MiB;
constexpr size_t WS_R1 = 730 * MiB;
constexpr size_t WS_Z = WS_R1;
constexpr size_t WS_UT = WS_R1 + 96 * MiB;
constexpr size_t WS_ST = WS_R1 + 128 * MiB;
constexpr size_t WS_ORAW = WS_R1 + 96 * MiB;
constexpr size_t WS_VN = WS_R1 + 128 * MiB;
constexpr size_t WS_XB = WS_R1;
constexpr size_t WS_HB = WS_R1 + 80 * MiB;
constexpr size_t WS_Y = WS_R1 + 120 * MiB;
constexpr size_t WS_LTOT = 930 * MiB;
constexpr size_t WS_END = 934 * MiB;
constexpr int CW_CNT = 64;
constexpr int CW_BGQ = 1024;
constexpr int CW_DONE = 2048;
constexpr int CW_BAR = 4096;

constexpr int RING_BYTES = 131072, MISC_OFF = RING_BYTES, LDS_BYTES = 147456;

#ifndef PROBE_DUP
#define PROBE_DUP 0
#endif
#ifndef MOE_VBLK
#define MOE_VBLK 1
#endif
#ifndef MOE_FUSED
#define MOE_FUSED 1
#endif
#ifndef USE_CG_SYNC
#define USE_CG_SYNC 0
#endif
struct Params { const float* in[24]; float* out; unsigned char* ws; int ph_lo, ph_hi, li, pad; };

#define LDS_WAIT() asm volatile("s_waitcnt lgkmcnt(0)" ::: "memory")
template <int M> __device__ __forceinline__ float shx(float v) { static_assert(M >= 1 && M < 32, "swizzle xor mask");
    return __int_as_float(__builtin_amdgcn_ds_swizzle(__float_as_int(v), (M << 10) | 0x1F)); }
__device__ __forceinline__ float halves_sum(float v) {
    return __int_as_float(__builtin_amdgcn_readlane(__float_as_int(v), 0)) + __int_as_float(__builtin_amdgcn_readlane(__float_as_int(v), 32)); }
__device__ __forceinline__ float wave_sum(float v) {
    v += shx<1>(v); v += shx<2>(v); v += shx<4>(v); v += shx<8>(v); v += shx<16>(v);
    return halves_sum(v);
}
typedef __bf16 bf16x2_t __attribute__((ext_vector_type(2)));
__device__ __forceinline__ unsigned pk2(float lo, float hi) { const bf16x2_t v = __builtin_convertvector((f32x2){lo, hi}, bf16x2_t); return __builtin_bit_cast(unsigned, v); }
__device__ __forceinline__ unsigned f2bf(float f) { return pk2(f, f) & 0xffffu; }
__device__ __forceinline__ float bflo(unsigned w) { return __uint_as_float(w << 16); }
__device__ __forceinline__ float bfhi(unsigned w) { return __uint_as_float(w & 0xffff0000u); }
__device__ __forceinline__ float bf2f(bf16 b) { return __uint_as_float(((unsigned)b) << 16); }
__device__ __forceinline__ float fexp(float x) { return __builtin_amdgcn_exp2f(x * 1.4426950408889634f); }
__device__ __forceinline__ float flog(float x) { return __builtin_amdgcn_logf(x) * 0.6931471805599453f; }
__device__ __forceinline__ float frcp(float x) { return __builtin_amdgcn_rcpf(x); }
__device__ __forceinline__ float frsq(float x) { return __builtin_amdgcn_rsqf(x); }
__device__ __forceinline__ float sigmoid_(float x) { return frcp(1.f + fexp(-x)); }
__device__ __forceinline__ float silu_(float x) { return x * sigmoid_(x); }
__device__ __forceinline__ float gelu_(float x) { const float K1 = 2.f * 0.7978845608028654f * 1.4426950408889634f, K3 = K1 * 0.044715f;
    const float r = frcp(__builtin_amdgcn_exp2f(x * (K1 + K3 * (x * x))) + 1.f); return x - x * r; }

struct Frame {
    LAS unsigned char* lds; unsigned char* ws; const float* const* in; float* out;
    int wave, blk, G;
};
__device__ __forceinline__ int lane_now() { int l; asm volatile("v_mbcnt_lo_u32_b32 %0, -1, 0\n\tv_mbcnt_hi_u32_b32 %0, -1, %0" : "=v"(l)); return l; }
__device__ __forceinline__ int vblk(int b) { return 4 * (8 * (b & 7) + (b >> 5)) + ((b >> 3) & 3); }
#define PH_TID() int ph_wave = F.wave; asm volatile("" : "+s"(ph_wave)); const int lane = lane_now(); (void)lane; const int tid = (ph_wave << 6) | lane; (void)tid

struct ConvJob { const float* W; const float* g; bf16* WT; int K, N, k0, n0, mode; };
constexpr int TL_IN = 16 * 12, TL_OUT = 16 * 4, TL_G = 32 * 16 * 2, TL_D = 32 * 8 * 4, TL_PG = 16 * 4, TL_PE = 4 * 4;
constexpr int TL_LAYER = TL_IN + TL_OUT + 2 * TL_G + TL_D + TL_PG + TL_PE;
__device__ __forceinline__ ConvJob conv_job(const Frame& F, int it) {
    unsigned char* ws = F.ws; const int l = it / TL_LAYER; int r = it % TL_LAYER; ConvJob j;
    if (r < TL_IN) { j.W = F.in[3] + (size_t)l * D * DIN; j.g = F.in[2] + l * D; j.WT = (bf16*)(ws + WS_WIN) + (size_t)l * DIN * D; j.K = D; j.N = DIN; j.k0 = 64 * (r / 12); j.n0 = 256 * (r % 12); j.mode = 0; return j; } r -= TL_IN;
    if (r < TL_OUT) { j.W = F.in[10] + (size_t)l * D * D; j.g = nullptr; j.WT = (bf16*)(ws + WS_WOUT) + (size_t)l * D * D; j.K = D; j.N = D; j.k0 = 64 * (r / 4); j.n0 = 256 * (r % 4); j.mode = 0; return j; } r -= TL_OUT;
    if (r < 2 * TL_G) { const int up = r >= TL_G; if (up) r -= TL_G; const int e = r / 32, rr = r % 32;
        j.W = F.in[up ? 17 : 16] + (size_t)(l * NE + e) * D * DE; j.g = F.in[11] + l * D; j.WT = (bf16*)(ws + WS_WGU) + (size_t)(l * NE + e) * 1024 * 1024; j.K = D; j.N = DE; j.k0 = 64 * (rr / 2); j.n0 = 256 * (rr % 2); j.mode = 1 + up; return j; } r -= 2 * TL_G;
    if (r < TL_D) { const int e = r / 32, rr = r % 32; j.W = F.in[18] + (size_t)(l * NE + e) * DE * D; j.g = nullptr; j.WT = (bf16*)(ws + WS_WD) + (size_t)(l * NE + e) * D * DE; j.K = DE; j.N = D; j.k0 = 64 * (rr / 4); j.n0 = 256 * (rr % 4); j.mode = 0; return j; } r -= TL_D;
    if (r < TL_PG) { j.W = F.in[20] + (size_t)l * D * D; j.g = F.in[19] + l * D; j.WT = (bf16*)(ws + WS_WPG) + (size_t)l * D * D; j.K = D; j.N = D; j.k0 = 64 * (r / 4); j.n0 = 256 * (r % 4); j.mode = 0; return j; } r -= TL_PG;
    j.W = F.in[21] + (size_t)l * PD * D; j.g = nullptr; j.WT = (bf16*)(ws + WS_WPE) + (size_t)l * D * PD; j.K = PD; j.N = D; j.k0 = 64 * (r / 4); j.n0 = 256 * (r % 4); j.mode = 0; return j;
}
__device__ __forceinline__ void conv_load(const ConvJob& j, int wave, int lane, f32x4 (&v)[8]) {
#pragma unroll
    for (int i = 0; i < 8; ++i) { const int row = 8 * wave + i; v[i] = *(const f32x4*)(j.W + (size_t)(j.k0 + row) * j.N + j.n0 + 4 * lane); if (j.g) v[i] = v[i] * j.g[j.k0 + row]; }
}
constexpr int NDEF = 384, NDEF1 = 128, NBG = 3024;
constexpr int NREST = TL_LAYER - NDEF - NBG, NPRO = TL_LAYER + 3 * NREST;
__device__ __forceinline__ int pro_tile(int f) { if (NREST == 0 || f < TL_LAYER) return f; f -= TL_LAYER; const int l = 1 + f / (NREST ? NREST : 1); return l * TL_LAYER + NDEF + NBG + f % (NREST ? NREST : 1); }
template <class M> __device__ __forceinline__ void conv_run(const Frame& F, int first, int stride, int count, M tile_of) {
    PH_TID();
    LAS float* tile = (LAS float*)F.lds;
    const int wave = ph_wave;
    int f = first; f32x4 v[8]; ConvJob cur{}, nxt{};
    if (f < count) { cur = conv_job(F, tile_of(f)); conv_load(cur, wave, lane, v); }
    while (f < count) {
#pragma unroll
        for (int i = 0; i < 8; ++i) { LAS float* d = tile + (8 * wave + i) * 257 + 4 * lane; d[0] = v[i].x; d[1] = v[i].y; d[2] = v[i].z; d[3] = v[i].w; }
        __syncthreads();
        const int fn = f + stride; if (fn < count) { nxt = conv_job(F, tile_of(fn)); conv_load(nxt, wave, lane, v); }
#pragma unroll
        for (int q = 0; q < 4; ++q) { const int nn = 32 * wave + 8 * q + (lane >> 3), c = lane & 7; const LAS float* sp = tile + (8 * c) * 257 + nn;
            u32x4 o; o.x = pk2(sp[0 * 257], sp[1 * 257]); o.y = pk2(sp[2 * 257], sp[3 * 257]); o.z = pk2(sp[4 * 257], sp[5 * 257]); o.w = pk2(sp[6 * 257], sp[7 * 257]);
            const int n = cur.n0 + nn; const int drow = cur.mode == 0 ? n : ((n >> 7) * 256 + (n & 127) + (cur.mode == 2 ? 128 : 0));
            *(u32x4*)(cur.WT + (size_t)drow * cur.K + cur.k0 + 8 * c) = o; }
        __syncthreads();
        cur = nxt; f = fn;
    }
}
__device__ __forceinline__ void conv_deferred(const Frame& F, int lnext, int r0, int r1, int first, int idle) {
    if (lnext >= DEPTH || F.blk < first) return;
    conv_run(F, F.blk - first, idle, r1 - r0, [=](int f) { return lnext * TL_LAYER + r0 + f; });
}
__device__ __forceinline__ void phase_prologue(const Frame& F) {
    PH_TID();
    unsigned char* ws = F.ws;
    conv_run(F, F.blk, F.G, NPRO, [](int f) { return pro_tile(f); });
    { const f32x4* src = (const f32x4*)F.in[1]; u32x4* dst = (u32x4*)(ws + WS_PB); const size_t n8 = (size_t)DEPTH * T * PD / 8;
      for (size_t i = (size_t)F.blk * NTHR + tid; i < n8; i += (size_t)F.G * NTHR) { const f32x4 a = src[2 * i], b = src[2 * i + 1]; u32x4 o; o.x = pk2(a.x, a.y); o.y = pk2(a.z, a.w); o.z = pk2(b.x, b.y); o.w = pk2(b.z, b.w); dst[i] = o; } }
    { float* wrt = (float*)(ws + MS_WRT);
      for (int i = F.blk * NTHR + tid; i < DEPTH * 36 * D; i += F.G * NTHR) { const int k = i % D, n = (i / D) % 36, l = i / (36 * D);
          const float w = n < 4 ? F.in[12][((size_t)l * D + k) * 4 + n] : F.in[14][((size_t)l * D + k) * NE + (n - 4)]; wrt[i] = w * F.in[11][l * D + k]; } }
    { bf16* wb = (bf16*)(ws + MS_SGUW); for (int i = F.blk * NTHR + tid; i < DEPTH * 4 * 128 * 128; i += F.G * NTHR) { const int tc = (i >> 7) & 127, sp = i & 127; wb[i] = sp <= tc ? (bf16)f2bf(F.in[8][i]) : (bf16)0; } }
    if (F.blk == 0 && tid < DREC) { const int c = tid; float v[DEPTH], m = -1e30f;
#pragma unroll
        for (int l = 0; l < DEPTH; ++l) { v[l] = F.in[4][l * DREC + c]; m = fmaxf(m, v[l]); }
        float s = 0.f;
#pragma unroll
        for (int l = 0; l < DEPTH; ++l) { v[l] = fexp(v[l] - m); s += v[l]; }
        float* lb = (float*)(ws + MS_LB); float acc = 0.f;
#pragma unroll
        for (int l = 0; l < DEPTH; ++l) { if (l > 0) acc += v[l] / s; lb[l * DREC + c] = acc; } }
}

__device__ __forceinline__ void load_row(const float* row, int lane, f32x4 (&v)[4]) { const f32x4* r = (const f32x4*)row + lane;
#pragma unroll
    for (int j = 0; j < 4; ++j) v[j] = r[64 * j]; }
__device__ __forceinline__ void load_row_bf(const bf16* row, int lane, f32x4 (&v)[4]) { const u32x2* r = (const u32x2*)row + lane;
#pragma unroll
    for (int j = 0; j < 4; ++j) { const u32x2 x = r[64 * j]; v[j] = (f32x4){bflo(x.x), bfhi(x.x), bflo(x.y), bfhi(x.y)}; } }
__device__ __forceinline__ float row_sumsq(const f32x4 (&v)[4]) { float s = 0.f;
#pragma unroll
    for (int j = 0; j < 4; ++j) s += (v[j].x * v[j].x + v[j].y * v[j].y) + (v[j].z * v[j].z + v[j].w * v[j].w);
    return wave_sum(s); }
__device__ __forceinline__ void store_row_bf16(bf16* orow, int lane, const f32x4 (&v)[4], float s) { u32x2* o = (u32x2*)orow + lane;
#pragma unroll
    for (int j = 0; j < 4; ++j) { u32x2 w; w.x = pk2(v[j].x * s, v[j].y * s); w.y = pk2(v[j].z * s, v[j].w * s); o[64 * j] = w; } }

__device__ __forceinline__ void phase_norm1(const Frame& F, int l) {
    PH_TID();
    bf16* XN = (bf16*)(F.ws + WS_XN); bf16* h = (bf16*)(F.ws + WS_H); const float* x = F.in[0];
    const int gw = F.blk * NWAVES + ph_wave, NGW = F.G * NWAVES;
    for (int t = gw; t < T; t += NGW) { f32x4 v[4];
        if (l == 0) { load_row(x + (size_t)t * D, lane, v); store_row_bf16(h + (size_t)t * D, lane, v, 1.f); } else load_row_bf(h + (size_t)t * D, lane, v);
        const float rstd = frsq(row_sumsq(v) * (1.f / D) + EPS); store_row_bf16(XN + (size_t)t * D, lane, v, rstd); }
}
__device__ __forceinline__ float bfly8(const float (&r)[8], int lane) {
    const bool b2 = lane & 4, b1 = lane & 2, b0 = lane & 1; float a[4], c[2];
#pragma unroll
    for (int i = 0; i < 4; ++i) { const float keep = b2 ? r[i + 4] : r[i], send = b2 ? r[i] : r[i + 4]; a[i] = keep + shx<4>(send); }
#pragma unroll
    for (int i = 0; i < 2; ++i) { const float keep = b1 ? a[i + 2] : a[i], send = b1 ? a[i] : a[i + 2]; c[i] = keep + shx<2>(send); }
    const float keep = b0 ? c[1] : c[0], send = b0 ? c[0] : c[1]; float d = keep + shx<1>(send);
    d += shx<8>(d); d += shx<16>(d);
    return d + __int_as_float(__builtin_amdgcn_ds_bpermute((lane ^ 32) << 2, __float_as_int(d)));
}
__device__ __forceinline__ void phase_norm2(const Frame& F, int l) {
    PH_TID();
    unsigned char* ws = F.ws;
    unsigned* hist = (unsigned*)(F.lds + MISC_OFF + 256);
    if (tid < 32) hist[tid] = 0u;
    __syncthreads();
    const bf16* h = (const bf16*)(ws + WS_H); bf16* XN = (bf16*)(ws + WS_XN);
    const float* WrT = (const float*)(ws + MS_WRT) + (size_t)l * 36 * D;
    const float* b_rg = F.in[13] + l * 4; const float* b_re = F.in[15] + l * NE;
    int* tok_e = (int*)(ws + MS_TOKE); float* tok_w = (float*)(ws + MS_TOKW); unsigned* sinfo = (unsigned*)(ws + MS_SINFO);
    const int RPB = T / F.G, RPW = RPB / NWAVES;
    for (int i0 = 0; i0 < RPW; i0 += 8) {
        const int t0 = F.blk * RPB + ph_wave * RPW + i0;
        f32x4 v[8][4]; float ss[8];
#pragma unroll
        for (int r = 0; r < 8; ++r) { load_row_bf(h + (size_t)(t0 + r) * D, lane, v[r]); float q = 0.f;
#pragma unroll
            for (int j = 0; j < 4; ++j) q += (v[r][j].x * v[r][j].x + v[r][j].y * v[r][j].y) + (v[r][j].z * v[r][j].z + v[r][j].w * v[r][j].w);
            ss[r] = q; }
        const float rstd_mine = frsq(bfly8(ss, lane) * (1.f / D) + EPS);
        if (lane < 8) ((float*)(ws + MS_RSTD2))[t0 + lane] = rstd_mine;
        LAS float* lgw = (LAS float*)(F.lds + 4096) + ph_wave * (36 * 8);
#pragma unroll 2
        for (int n = 0; n < 36; ++n) { const f32x4* wr = (const f32x4*)(WrT + (size_t)n * D) + lane; const f32x4 w0 = wr[0], w1 = wr[64], w2 = wr[128], w3 = wr[192]; float pr[8];
#pragma unroll
            for (int r = 0; r < 8; ++r) pr[r] = ((v[r][0].x * w0.x + v[r][0].y * w0.y) + (v[r][0].z * w0.z + v[r][0].w * w0.w)) + ((v[r][1].x * w1.x + v[r][1].y * w1.y) + (v[r][1].z * w1.z + v[r][1].w * w1.w))
                                                 + ((v[r][2].x * w2.x + v[r][2].y * w2.y) + (v[r][2].z * w2.z + v[r][2].w * w2.w)) + ((v[r][3].x * w3.x + v[r][3].y * w3.y) + (v[r][3].z * w3.z + v[r][3].w * w3.w));
            const float val = bfly8(pr, lane) * rstd_mine; if (lane < 8) lgw[n * 8 + lane] = val; }
        const int row = lane & 7;
        float lg4[4], lgb[4];
#pragma unroll
        for (int j = 0; j < 4; ++j) { lg4[j] = lgw[j * 8 + row]; lgb[j] = lg4[j] + b_rg[j]; }
        int gs = 0; float gm = lgb[0];
#pragma unroll
        for (int j = 1; j < 4; ++j) if (lgb[j] > gm) { gm = lgb[j]; gs = j; }
        float mx = fmaxf(fmaxf(lg4[0], lg4[1]), fmaxf(lg4[2], lg4[3])), se = 0.f, lsel = lg4[0];
#pragma unroll
        for (int j = 0; j < 4; ++j) { se += fexp(lg4[j] - mx); if (j == gs) lsel = lg4[j]; }
        const float g_w = fexp(lsel - mx) * frcp(se);
        float le[8], leb[8];
#pragma unroll
        for (int j = 0; j < 8; ++j) { le[j] = lgw[(4 + gs * 8 + j) * 8 + row]; leb[j] = le[j] + b_re[gs * 8 + j]; }
        int s0 = 0; float m0 = leb[0];
#pragma unroll
        for (int j = 1; j < 8; ++j) if (leb[j] > m0) { m0 = leb[j]; s0 = j; }
        int s1 = -1; float m1 = -3.0e38f;
#pragma unroll
        for (int j = 0; j < 8; ++j) if (j != s0 && leb[j] > m1) { m1 = leb[j]; s1 = j; }
        if (s1 < 0) s1 = (s0 == 0) ? 1 : 0;
        float la = le[0], lb2 = le[0];
#pragma unroll
        for (int j = 1; j < 8; ++j) { if (j == s0) la = le[j]; if (j == s1) lb2 = le[j]; }
        const float wa = frcp(1.f + fexp(lb2 - la)), wb = 1.f - wa;
        if (lane < 8) { const int t = t0 + lane;
            const int e0 = gs * 8 + s0, e1 = gs * 8 + s1;
            const unsigned r0 = atomicAdd(&hist[e0], 1u), r1 = atomicAdd(&hist[e1], 1u);
            tok_e[2 * t] = e0; tok_e[2 * t + 1] = e1; tok_w[2 * t] = g_w * wa; tok_w[2 * t + 1] = g_w * wb;
            sinfo[2 * t] = ((unsigned)F.blk << 16) | r0; sinfo[2 * t + 1] = ((unsigned)F.blk << 16) | r1;
        }
    }
    __syncthreads();
    if (tid < 32) { unsigned* cnt = (unsigned*)(ws + WS_CTL) + CW_CNT + l * 32;
        const unsigned base = __hip_atomic_fetch_add(cnt + tid, hist[tid], __ATOMIC_RELAXED, __HIP_MEMORY_SCOPE_AGENT);
        ((unsigned*)(ws + MS_BLKBASE))[F.blk * 32 + tid] = base; }
}
__device__ __forceinline__ void phase_gather(const Frame& F, int l) {
    PH_TID();
    unsigned char* ws = F.ws;
    int* ps = (int*)(F.lds + MISC_OFF + 512);
    if (tid == 0) { unsigned* cnt = (unsigned*)(ws + WS_CTL) + CW_CNT + l * 32; int* blke = (int*)(ws + MS_BLKE) + l * 256; int acc = 0;
        for (int e = 0; e < NE; ++e) { const int c = (int)__hip_atomic_load(cnt + e, __ATOMIC_RELAXED, __HIP_MEMORY_SCOPE_AGENT); ps[e] = acc; const int pad = (c + RB - 1) / RB * RB;
            if (F.blk == 0) for (int rb = acc / RB; rb < (acc + pad) / RB; ++rb) blke[rb] = e;
            acc += pad; }
        if (F.blk == 0) blke[255] = acc / RB; }
    __syncthreads();
    const int* tok_e = (const int*)(ws + MS_TOKE); const unsigned* sinfo = (const unsigned*)(ws + MS_SINFO); const unsigned* bbase = (const unsigned*)(ws + MS_BLKBASE);
    int* sdest = (int*)(ws + MS_SDEST); const bf16* hres = (const bf16*)(ws + WS_H); const float* rstd2 = (const float*)(ws + MS_RSTD2); bf16* XB = (bf16*)(ws + WS_XB);
    const int gw = F.blk * NWAVES + ph_wave, NGW = F.G * NWAVES;
    for (int t = gw; t < T; t += NGW) {
        const u32x4* src = (const u32x4*)(hres + (size_t)t * D) + lane; const u32x4 ha = src[0], hb = src[64]; const float rs = rstd2[t];
        u32x4 a, b;
        a.x = pk2(bflo(ha.x) * rs, bfhi(ha.x) * rs); a.y = pk2(bflo(ha.y) * rs, bfhi(ha.y) * rs); a.z = pk2(bflo(ha.z) * rs, bfhi(ha.z) * rs); a.w = pk2(bflo(ha.w) * rs, bfhi(ha.w) * rs);
        b.x = pk2(bflo(hb.x) * rs, bfhi(hb.x) * rs); b.y = pk2(bflo(hb.y) * rs, bfhi(hb.y) * rs); b.z = pk2(bflo(hb.z) * rs, bfhi(hb.z) * rs); b.w = pk2(bflo(hb.w) * rs, bfhi(hb.w) * rs);
#pragma unroll
        for (int j = 0; j < 2; ++j) { const int e = tok_e[2 * t + j]; const unsigned info = sinfo[2 * t + j];
            const int dest = ps[e] + (int)bbase[(info >> 16) * 32 + e] + (int)(info & 0xffffu);
            if (lane == 0) sdest[2 * t + j] = dest;
            u32x4* dst = (u32x4*)(XB + (size_t)dest * D) + lane; dst[0] = a; dst[64] = b; }
    }
}
__device__ __forceinline__ void phase_combine(const Frame& F, int l) {
    PH_TID();
    unsigned char* ws = F.ws;
    bf16* h = (bf16*)(ws + WS_H); bf16* XN = (bf16*)(ws + WS_XN); const bf16* Y = (const bf16*)(ws + WS_Y); const bf16* PE = (const bf16*)(ws + WS_PE) + (size_t)l * T * D;
    const int* sdest = (const int*)(ws + MS_SDEST); const float* tok_w = (const float*)(ws + MS_TOKW); float* rstd_pe = (float*)(ws + MS_RSTDPE);
    const int gw = F.blk * NWAVES + ph_wave, NGW = F.G * NWAVES;
    struct Rows { u32x2 h[4], y0[4], y1[4], pe[4]; };
    auto fetch = [&](int t, int d0, int d1, Rows& r) {
        const u32x2* hp = (const u32x2*)(h + (size_t)t * D) + lane; const u32x2* y0 = (const u32x2*)(Y + (size_t)d0 * D) + lane; const u32x2* y1 = (const u32x2*)(Y + (size_t)d1 * D) + lane; const u32x2* pe = (const u32x2*)(PE + (size_t)t * D) + lane;
#pragma unroll
        for (int j = 0; j < 4; ++j) { r.h[j] = hp[64 * j]; r.y0[j] = y0[64 * j]; r.y1[j] = y1[64 * j]; r.pe[j] = pe[64 * j]; } };
    int t = gw; if (t >= T) return;
    Rows cur; int d0n = 0, d1n = 0; float w0 = tok_w[2 * t], w1 = tok_w[2 * t + 1], w0n = 0.f, w1n = 0.f;
    fetch(t, sdest[2 * t], sdest[2 * t + 1], cur);
    if (t + NGW < T) { d0n = sdest[2 * (t + NGW)]; d1n = sdest[2 * (t + NGW) + 1]; w0n = tok_w[2 * (t + NGW)]; w1n = tok_w[2 * (t + NGW) + 1]; }
    for (; t < T; t += NGW) {
        Rows nxt = cur; const float w0c = w0, w1c = w1; const bool more = t + NGW < T;
        if (more) { fetch(t + NGW, d0n, d1n, nxt); w0 = w0n; w1 = w1n;
            if (t + 2 * NGW < T) { d0n = sdest[2 * (t + 2 * NGW)]; d1n = sdest[2 * (t + 2 * NGW) + 1]; w0n = tok_w[2 * (t + 2 * NGW)]; w1n = tok_w[2 * (t + 2 * NGW) + 1]; } }
        f32x4 v[4]; float sp = 0.f;
#pragma unroll
        for (int j = 0; j < 4; ++j) { const u32x2 x = cur.h[j], a = cur.y0[j], b = cur.y1[j], c = cur.pe[j];
            v[j] = (f32x4){bflo(x.x) + (w0c * bflo(a.x) + w1c * bflo(b.x)), bfhi(x.x) + (w0c * bfhi(a.x) + w1c * bfhi(b.x)), bflo(x.y) + (w0c * bflo(a.y) + w1c * bflo(b.y)), bfhi(x.y) + (w0c * bfhi(a.y) + w1c * bfhi(b.y))};
            const float p0 = bflo(c.x), p1 = bfhi(c.x), p2 = bflo(c.y), p3 = bfhi(c.y); sp += (p0 * p0 + p1 * p1) + (p2 * p2 + p3 * p3); }
        store_row_bf16(h + (size_t)t * D, lane, v, 1.f);
        const float rstd = frsq(row_sumsq(v) * (1.f / D) + EPS); store_row_bf16(XN + (size_t)t * D, lane, v, rstd);
        sp = wave_sum(sp); if (lane == 0) rstd_pe[t] = frsq(sp * (1.f / D) + EPS);
        cur = nxt;
    }
}
__device__ __forceinline__ void phase_final(const Frame& F) {
    PH_TID();
    const bf16* h = (const bf16*)(F.ws + WS_H); const float* nf = F.in[23];
    const int gw = F.blk * NWAVES + ph_wave, NGW = F.G * NWAVES;
    for (int t = gw; t < T; t += NGW) { f32x4 v[4]; load_row_bf(h + (size_t)t * D, lane, v); const float rstd = frsq(row_sumsq(v) * (1.f / D) + EPS);
        f32x4* o = (f32x4*)(F.out + (size_t)t * D) + lane; const f32x4* g = (const f32x4*)nf + lane;
#pragma unroll
        for (int j = 0; j < 4; ++j) o[64 * j] = v[j] * rstd * g[64 * j]; }
}


namespace pg8 {
constexpr int BM = 256, BK = 64, HALF = 128, HTB = HALF * BK * 2, STAGE_BYTES = 8 * HTB, NXCD = 8, WGM = 8;
__host__ __device__ __forceinline__ int lds_byte(int r, int c) { const int st = (r >> 4) * 2 + (c >> 5), rr = r & 15, cc = c & 31, ob = rr * 64 + cc * 2; return st * 1024 + (ob ^ (((ob >> 9) & 1) << 5)); }
__host__ __device__ __forceinline__ void stage_rc(int b, int& R, int& C) { const int st = b / 1024, sb = b % 1024, swz = sb ^ (((sb >> 9) & 1) << 5); R = (st >> 1) * 16 + swz / 64; C = (st & 1) * 32 + (swz % 64) / 2; }
__host__ __device__ __forceinline__ int perm32(int rho) { const int n = rho >> 4, i = rho & 15; return 8 * (i >> 2) + 4 * n + (i & 3); }
struct Unit { int pm, pn; const char* A; const char* B; };
__device__ __forceinline__ void static_map(int wgid, int nM, int nN, int& pm, int& pn) {
    const int nwg = nM * nN; { const int q = nwg / NXCD, r = nwg % NXCD, xcd = wgid % NXCD, off = wgid / NXCD; wgid = (xcd < r ? xcd * (q + 1) : r * (q + 1) + (xcd - r) * q) + off; }
    const int nig = WGM * nN, gid = wgid / nig, fm = gid * WGM, gsz = (nM - fm) < WGM ? (nM - fm) : WGM;
    pm = fm + ((wgid % nig) % gsz); pn = (wgid % nig) / gsz;
}
struct DenseOrder { static constexpr bool DEPS = false;
    const char* A; const char* Bt; int nM, nN, nL, G, c; size_t tstep;
    __device__ void init(const void* A_, const void* Bt_, int M, int N, int K, int nL_, int G_, int c_) { A = (const char*)A_; Bt = (const char*)Bt_; nM = M / BM; nN = N / BM; nL = nL_; G = G_; c = c_; tstep = (size_t)BM * K * 2; }
    __device__ bool next(int i, Unit& u) const { const long L = (long)i * G + c; const int per = nM * nN; if (L >= (long)per * nL) return false;
        const int l = (int)(L / per); int pm, pn; static_map((int)(L % per), nM, nN, pm, pn); u.pm = l * nM + pm; u.pn = pn; u.A = A + (size_t)u.pm * tstep; u.B = Bt + (size_t)(l * nN + pn) * tstep; return true; }
};
struct MoeOrder { static constexpr bool DEPS = false;
    const char* A; const char* W; const int* blke; int nrb, nN, G, c, e0, e1, e2; size_t a_tstep, w_estride, b_tstep;
    __device__ void init(const void* A_, const void* W_, const int* blke_, int K, int nN_, size_t w_estride_bytes, int G_, int c_) { A = (const char*)A_; W = (const char*)W_; blke = blke_; nrb = __builtin_amdgcn_readfirstlane(blke_[255]); nN = nN_; G = G_; c = c_;
        a_tstep = (size_t)BM * K * 2; b_tstep = a_tstep; w_estride = w_estride_bytes;
        const int r0 = c / nN, r1 = (G + c) / nN, r2 = (2 * G + c) / nN; const int x0 = blke_[r0 < 255 ? r0 : 254], x1 = blke_[r1 < 255 ? r1 : 254], x2 = blke_[r2 < 255 ? r2 : 254];
        e0 = __builtin_amdgcn_readfirstlane(x0); e1 = __builtin_amdgcn_readfirstlane(x1); e2 = __builtin_amdgcn_readfirstlane(x2); }
    __device__ bool next(int i, Unit& u) const { const long L = (long)i * G + c; if (L >= (long)nrb * nN) return false; const int rb = (int)(L / nN), pn = (int)(L % nN);
        const int ex = i == 0 ? e0 : i == 1 ? e1 : i == 2 ? e2 : __builtin_amdgcn_readfirstlane(blke[rb]);
        u.pm = rb; u.pn = pn; u.A = A + (size_t)rb * a_tstep; u.B = W + (size_t)ex * w_estride + (size_t)pn * b_tstep; return true; }
};
__device__ __forceinline__ unsigned ag_ld(const unsigned* p)        { return __hip_atomic_load(p, __ATOMIC_RELAXED, __HIP_MEMORY_SCOPE_AGENT); }
__device__ __forceinline__ unsigned ag_add(unsigned* p, unsigned v) { return __hip_atomic_fetch_add(p, v, __ATOMIC_RELAXED, __HIP_MEMORY_SCOPE_AGENT); }
struct MoeDepOrder { static constexpr bool DEPS = true;
    const char* A; const char* W; const int* blke; const unsigned* done; int nrb, nN, G, c, e0, e1, e2; size_t a_tstep, w_estride, b_tstep;
    __device__ void init(const void* A_, const void* W_, const int* blke_, const unsigned* done_, int K, int nN_, size_t w_estride_bytes, int G_, int c_) { A = (const char*)A_; W = (const char*)W_; blke = blke_; done = done_;
        nrb = __builtin_amdgcn_readfirstlane(blke_[255]); nN = nN_; G = G_; c = c_; a_tstep = (size_t)BM * K * 2; b_tstep = a_tstep; w_estride = w_estride_bytes;
        const int r0 = c / nN, r1 = (G + c) / nN, r2 = (2 * G + c) / nN; const int x0 = blke_[r0 < 255 ? r0 : 254], x1 = blke_[r1 < 255 ? r1 : 254], x2 = blke_[r2 < 255 ? r2 : 254];
        e0 = __builtin_amdgcn_readfirstlane(x0); e1 = __builtin_amdgcn_readfirstlane(x1); e2 = __builtin_amdgcn_readfirstlane(x2); }
    __device__ bool next(int i, Unit& u) const { const long L = (long)i * G + c; if (L >= (long)nrb * nN) return false; const int rb = (int)(L / nN), pn = (int)(L % nN);
        const int ex = i == 0 ? e0 : i == 1 ? e1 : i == 2 ? e2 : __builtin_amdgcn_readfirstlane(blke[rb]);
        u.pm = rb; u.pn = pn; u.A = A + (size_t)rb * a_tstep; u.B = W + (size_t)ex * w_estride + (size_t)pn * b_tstep; return true; }
    __device__ void wait(const Unit& u, int wid) const {
        if (wid == 0 && lane_now() == 0) { while (ag_ld(done + u.pm) < 4u) __builtin_amdgcn_s_sleep(1); __builtin_amdgcn_fence(__ATOMIC_ACQUIRE, "agent"); } }
};
struct RangeOrder { static constexpr bool DEPS = false;
    const char* A; const char* Bt; int nM, nN, j0, n; size_t tstep;
    __device__ void init(const void* A_, const void* Bt_, int M, int N, int K, int j0_, int n_) { A = (const char*)A_; Bt = (const char*)Bt_; nM = M / BM; nN = N / BM; j0 = j0_; n = n_; tstep = (size_t)BM * K * 2; }
    __device__ bool next(int i, Unit& u) const { if (i >= n) return false; int pm, pn; static_map(j0 + i, nM, nN, pm, pn); u.pm = pm; u.pn = pn; u.A = A + (size_t)pm * tstep; u.B = Bt + (size_t)pn * tstep; return true; }
};
__device__ __forceinline__ unsigned cvt_pk_bf16(float lo, float hi) { return pk2(lo, hi); }
struct EpiBf16 { static constexpr bool PERM = true, ACC_INIT = false, SIGNAL = false; bf16* O; int ldc;
    __device__ __forceinline__ void operator()(const f32x4 (&acc)[2][2][4][2], const Unit& u, int wr, int wc, int, int) const {
        const int t2 = lane_now(), fr = t2 & 15, fq = t2 >> 4;
        const int row0 = u.pm * BM + wr * 64 + fr, col0 = u.pn * BM + wc * 32 + 8 * fq;
#pragma unroll
        for (int ai = 0; ai < 2; ++ai)
#pragma unroll
            for (int m = 0; m < 4; ++m) { bf16* rowp = O + (size_t)(row0 + ai * HALF + m * 16) * ldc + col0;
#pragma unroll
                for (int bj = 0; bj < 2; ++bj) { const f32x4 v0 = acc[ai][bj][m][0], v1 = acc[ai][bj][m][1];
                    u32x4 w; w.x = cvt_pk_bf16(v0[0], v0[1]); w.y = cvt_pk_bf16(v0[2], v0[3]); w.z = cvt_pk_bf16(v1[0], v1[1]); w.w = cvt_pk_bf16(v1[2], v1[3]);
                    *(u32x4*)(rowp + bj * HALF) = w; } }
    } };
struct EpiResid { static constexpr bool PERM = true, ACC_INIT = true, SIGNAL = false; bf16* h;
    __device__ __forceinline__ void init(f32x4 (&acc)[2][2][4][2], const Unit& u, int wr, int wc, int fr, int fq) const {
        const int row0 = u.pm * BM + wr * 64 + fr, col0 = u.pn * BM + wc * 32 + 8 * fq;
#pragma unroll
        for (int ai = 0; ai < 2; ++ai)
#pragma unroll
            for (int m = 0; m < 4; ++m) { const bf16* rowp = h + (size_t)(row0 + ai * HALF + m * 16) * D + col0;
#pragma unroll
                for (int bj = 0; bj < 2; ++bj) { const u32x4 x = *(const u32x4*)(rowp + bj * HALF);
                    acc[ai][bj][m][0] = (f32x4){bflo(x.x), bfhi(x.x), bflo(x.y), bfhi(x.y)}; acc[ai][bj][m][1] = (f32x4){bflo(x.z), bfhi(x.z), bflo(x.w), bfhi(x.w)}; } }
    }
    __device__ __forceinline__ void operator()(const f32x4 (&acc)[2][2][4][2], const Unit& u, int wr, int wc, int fr, int fq) const {
        asm volatile("" : "+v"(fr), "+v"(fq));
        const int row0 = u.pm * BM + wr * 64 + fr, col0 = u.pn * BM + wc * 32 + 8 * fq;
#pragma unroll
        for (int ai = 0; ai < 2; ++ai)
#pragma unroll
            for (int m = 0; m < 4; ++m) { bf16* rowp = h + (size_t)(row0 + ai * HALF + m * 16) * D + col0;
#pragma unroll
                for (int bj = 0; bj < 2; ++bj) { const f32x4 v0 = acc[ai][bj][m][0], v1 = acc[ai][bj][m][1];
                    u32x4 w; w.x = cvt_pk_bf16(v0[0], v0[1]); w.y = cvt_pk_bf16(v0[2], v0[3]); w.z = cvt_pk_bf16(v1[0], v1[1]); w.w = cvt_pk_bf16(v1[2], v1[3]);
                    *(u32x4*)(rowp + bj * HALF) = w; } }
    } };
struct EpiGateUp { static constexpr bool PERM = true, ACC_INIT = false, SIGNAL = false; bf16* H;
    __device__ __forceinline__ void operator()(const f32x4 (&acc)[2][2][4][2], const Unit& u, int wr, int wc, int, int) const {
        const int t2 = lane_now(), fr = t2 & 15, fq = t2 >> 4;
        const int row0 = u.pm * BM + wr * 64 + fr, col0 = u.pn * HALF + wc * 32 + 8 * fq;
#pragma unroll
        for (int ai = 0; ai < 2; ++ai)
#pragma unroll
            for (int m = 0; m < 4; ++m) { bf16* rowp = H + (size_t)(row0 + ai * HALF + m * 16) * DE + col0; float v[8];
#pragma unroll
                for (int n = 0; n < 2; ++n)
#pragma unroll
                    for (int j = 0; j < 4; ++j) v[4 * n + j] = silu_(acc[ai][0][m][n][j]) * acc[ai][1][m][n][j];
                u32x4 w; w.x = cvt_pk_bf16(v[0], v[1]); w.y = cvt_pk_bf16(v[2], v[3]); w.z = cvt_pk_bf16(v[4], v[5]); w.w = cvt_pk_bf16(v[6], v[7]);
                *(u32x4*)rowp = w; }
    } };
struct EpiGateUpPub { static constexpr bool PERM = true, ACC_INIT = false, SIGNAL = true; __amdgpu_buffer_rsrc_t rs; unsigned* done;
    __device__ __forceinline__ void operator()(const f32x4 (&acc)[2][2][4][2], const Unit& u, int wr, int wc, int fr, int fq) const {
        asm volatile("" : "+v"(fr), "+v"(fq));
        const int row0 = u.pm * BM + wr * 64 + fr, col0 = u.pn * HALF + wc * 32 + 8 * fq;
#pragma unroll
        for (int ai = 0; ai < 2; ++ai)
#pragma unroll
            for (int m = 0; m < 4; ++m) { const unsigned off = (unsigned)(((row0 + ai * HALF + m * 16) * DE + col0) * 2); float v[8];
#pragma unroll
                for (int n = 0; n < 2; ++n)
#pragma unroll
                    for (int j = 0; j < 4; ++j) v[4 * n + j] = silu_(acc[ai][0][m][n][j]) * acc[ai][1][m][n][j];
                u32x4 w; w.x = cvt_pk_bf16(v[0], v[1]); w.y = cvt_pk_bf16(v[2], v[3]); w.z = cvt_pk_bf16(v[4], v[5]); w.w = cvt_pk_bf16(v[6], v[7]);
                __builtin_amdgcn_raw_buffer_store_b128(w, rs, off, 0, 16); }
    }
    __device__ __forceinline__ void signal(const Unit& u) const { (void)ag_add(done + u.pm, 1u); }
};
struct EpiPG { static constexpr bool PERM = true, ACC_INIT = false, SIGNAL = false; bf16* h; const bf16* PE; const float* rstd_pe; const float* norm_pe;
    __device__ __forceinline__ void operator()(const f32x4 (&acc)[2][2][4][2], const Unit& u, int wr, int wc, int, int) const {
        const int t2 = lane_now(), fr = t2 & 15, fq = t2 >> 4;
        const int row0 = u.pm * BM + wr * 64 + fr, col0 = u.pn * BM + wc * 32 + 8 * fq;
        f32x4 nv[2][2];
#pragma unroll
        for (int bj = 0; bj < 2; ++bj)
#pragma unroll
            for (int n = 0; n < 2; ++n) nv[bj][n] = *(const f32x4*)(norm_pe + col0 + bj * HALF + 4 * n);
#pragma unroll
        for (int ai = 0; ai < 2; ++ai) {
            u32x4 pe[4][2], hx[4][2]; float rs[4];
#pragma unroll
            for (int m = 0; m < 4; ++m) { const int row = row0 + ai * HALF + m * 16; rs[m] = rstd_pe[row];
#pragma unroll
                for (int bj = 0; bj < 2; ++bj) { const size_t o = (size_t)row * D + col0 + bj * HALF; pe[m][bj] = *(const u32x4*)(PE + o); hx[m][bj] = *(const u32x4*)(h + o); } }
#pragma unroll
            for (int m = 0; m < 4; ++m) { const int row = row0 + ai * HALF + m * 16;
#pragma unroll
                for (int bj = 0; bj < 2; ++bj) { const size_t o = (size_t)row * D + col0 + bj * HALF; const u32x4 p = pe[m][bj], x = hx[m][bj];
                    f32x4 h0 = (f32x4){bflo(x.x), bfhi(x.x), bflo(x.y), bfhi(x.y)}, h1 = (f32x4){bflo(x.z), bfhi(x.z), bflo(x.w), bfhi(x.w)}; const f32x4 a0 = acc[ai][bj][m][0], a1 = acc[ai][bj][m][1];
                    const f32x4 e0 = (f32x4){bflo(p.x), bfhi(p.x), bflo(p.y), bfhi(p.y)} * rs[m] * nv[bj][0], e1 = (f32x4){bflo(p.z), bfhi(p.z), bflo(p.w), bfhi(p.w)} * rs[m] * nv[bj][1];
                    h0 += (f32x4){sigmoid_(a0[0]), sigmoid_(a0[1]), sigmoid_(a0[2]), sigmoid_(a0[3])} * e0; h1 += (f32x4){sigmoid_(a1[0]), sigmoid_(a1[1]), sigmoid_(a1[2]), sigmoid_(a1[3])} * e1;
                    u32x4 w; w.x = pk2(h0[0], h0[1]); w.y = pk2(h0[2], h0[3]); w.z = pk2(h1[0], h1[1]); w.w = pk2(h1[2], h1[3]); *(u32x4*)(h + o) = w; } } }
    } };

template <class Epi, class Sched>
__device__ __forceinline__ void gemm_phase(int wave, LAS unsigned char* lds, int K, const Sched& S, const Epi& E) {
    int wid = wave; asm volatile("" : "+s"(wid));
    const int lane = lane_now(), tid = (wid << 6) | lane, wr = wid >> 2, wc = wid & 3, fr = lane & 15, fq = lane >> 4;
    const int nt = K / BK;
    unsigned voffA[2], voffB[2];
#pragma unroll
    for (int i = 0; i < 2; ++i) { int R, C; stage_rc(tid * 16 + i * 8192, R, C); const int Rb = Epi::PERM ? ((R & ~31) + perm32(R & 31)) : R;
        voffA[i] = (unsigned)(R * K + C) * 2u; voffB[i] = (unsigned)(Rb * K + C) * 2u; }
    const size_t kstep = (size_t)(BK * 2);
    const size_t hstep = (size_t)HALF * K * 2;
    const unsigned ldsw = (unsigned)wid * 1024u;
    const int aoff = lds_byte(wr * 64 + fr, fq * 8), boff = lds_byte(wc * 32 + fr, fq * 8);
#define PG8_SA(b, h) (((b) * 2 + (h)) * HTB)
#define PG8_SB(b, h) ((4 + (b) * 2 + (h)) * HTB)
#define PG8_STAGE(bufoff, gbase, voff) do { _Pragma("unroll") for (int _i = 0; _i < 2; ++_i) \
        __builtin_amdgcn_global_load_lds((const unsigned*)((const char*)(gbase) + (voff)[_i]), (LAS unsigned*)(lds + (bufoff) + ldsw + _i * 8192), 16, 0, 0); } while (0)
#define PG8_LDA(dst, b, h) do { _Pragma("unroll") for (int m = 0; m < 4; ++m) _Pragma("unroll") for (int k = 0; k < 2; ++k) dst[m][k] = *(const LAS bf16x8*)(lds + PG8_SA(b, h) + aoff + m * 2048 + k * 1024); } while (0)
#define PG8_LDB(dst, b, h) do { _Pragma("unroll") for (int n = 0; n < 2; ++n) _Pragma("unroll") for (int k = 0; k < 2; ++k) dst[n][k] = *(const LAS bf16x8*)(lds + PG8_SB(b, h) + boff + n * 2048 + k * 1024); } while (0)
#define PG8_MMA(ai, bj, At, Bt) do { __builtin_amdgcn_s_setprio(1); _Pragma("unroll") for (int m = 0; m < 4; ++m) _Pragma("unroll") for (int n = 0; n < 2; ++n) _Pragma("unroll") for (int k = 0; k < 2; ++k) \
        acc[ai][bj][m][n] = __builtin_amdgcn_mfma_f32_16x16x32_bf16(Bt[n][k], At[m][k], acc[ai][bj][m][n], 0, 0, 0); __builtin_amdgcn_s_setprio(0); } while (0)
#define PG8_WAIT_V(n) asm volatile("s_waitcnt vmcnt(" #n ")" ::: "memory")
#define PG8_WAIT_L(n) asm volatile("s_waitcnt lgkmcnt(" #n ")" ::: "memory")
#define PG8_BAR __builtin_amdgcn_s_barrier()
#define PG8_SCHED __builtin_amdgcn_sched_barrier(0)
    Unit cur, nxt; int ui = 0;
    if (!S.next(0, cur)) return;
    if constexpr (Sched::DEPS) { S.wait(cur, wid); PG8_BAR; }
    f32x4 acc[2][2][4][2];
    if constexpr (Epi::ACC_INIT) E.init(acc, cur, wr, wc, fr, fq);
    else {
#pragma unroll
    for (int a = 0; a < 2; ++a)
#pragma unroll
        for (int b = 0; b < 2; ++b)
#pragma unroll
            for (int m = 0; m < 4; ++m)
#pragma unroll
                for (int n = 0; n < 2; ++n) acc[a][b][m][n] = (f32x4){0.f, 0.f, 0.f, 0.f}; }
    bf16x8 At[4][2], B0[2][2], B1[2][2];
    const char* cA = cur.A; const char* cB = cur.B;
    PG8_STAGE(PG8_SB(0, 0), cB, voffB); PG8_STAGE(PG8_SB(0, 1), cB + hstep, voffB); PG8_STAGE(PG8_SA(0, 0), cA, voffA); PG8_STAGE(PG8_SA(0, 1), cA + hstep, voffA);
    if (wr == 1) PG8_BAR;
    PG8_WAIT_V(2); PG8_BAR;
    PG8_STAGE(PG8_SB(1, 0), cB + kstep, voffB); PG8_STAGE(PG8_SA(1, 0), cA + kstep, voffA); PG8_STAGE(PG8_SB(1, 1), cB + hstep + kstep, voffB);
    PG8_WAIT_V(6); PG8_BAR;
    for (;;) {
        const bool has_next = S.next(ui + 1, nxt);
        const char* nA = has_next ? nxt.A : cA; const char* nB = has_next ? nxt.B : cB;
#pragma nounroll
        for (int t = 0; t < nt; t += 2) {
            const bool last = (t == nt - 2);
            if constexpr (Sched::DEPS) { if (last && has_next) S.wait(nxt, wid); }
            const char* a1 = cA + (size_t)(t + 1) * kstep;
            const char* a2 = last ? nA : cA + (size_t)(t + 2) * kstep; const char* b2 = last ? nB : cB + (size_t)(t + 2) * kstep;
            const char* a3 = a2 + kstep; const char* b3 = b2 + kstep;
            PG8_LDB(B0, 0, 0); PG8_LDB(B1, 0, 1); PG8_SCHED; PG8_LDA(At, 0, 0); PG8_STAGE(PG8_SA(1, 1), a1 + hstep, voffA);
            PG8_WAIT_V(8); PG8_WAIT_L(0); PG8_BAR; PG8_MMA(0, 0, At, B0); PG8_MMA(0, 1, At, B1); PG8_BAR; PG8_SCHED;
            PG8_LDA(At, 0, 1); PG8_STAGE(PG8_SB(0, 0), b2, voffB); PG8_STAGE(PG8_SB(0, 1), b2 + hstep, voffB); PG8_STAGE(PG8_SA(0, 0), a2, voffA);
            PG8_WAIT_V(8); PG8_WAIT_L(0); PG8_BAR; PG8_MMA(1, 0, At, B0); PG8_MMA(1, 1, At, B1); PG8_BAR; PG8_SCHED;
            PG8_LDB(B0, 1, 0); PG8_LDB(B1, 1, 1); PG8_SCHED; PG8_LDA(At, 1, 0); PG8_STAGE(PG8_SA(0, 1), a2 + hstep, voffA);
            PG8_WAIT_V(8); PG8_WAIT_L(0); PG8_BAR; PG8_MMA(0, 0, At, B0); PG8_MMA(0, 1, At, B1); PG8_BAR; PG8_SCHED;
            PG8_LDA(At, 1, 1); PG8_STAGE(PG8_SB(1, 0), b3, voffB); PG8_STAGE(PG8_SB(1, 1), b3 + hstep, voffB); PG8_STAGE(PG8_SA(1, 0), a3, voffA);
            PG8_WAIT_V(8); PG8_WAIT_L(0); PG8_BAR; PG8_MMA(1, 0, At, B0); PG8_MMA(1, 1, At, B1); PG8_BAR; PG8_SCHED;
        }
        if (wr == 0) PG8_BAR;
        E(acc, cur, wr, wc, fr, fq);
        if constexpr (Epi::SIGNAL) { PG8_WAIT_V(0); PG8_BAR; if (tid == 0) E.signal(cur); }
        if (!has_next) break;
        if constexpr (Epi::ACC_INIT) E.init(acc, nxt, wr, wc, fr, fq);
        else {
#pragma unroll
        for (int a = 0; a < 2; ++a)
#pragma unroll
            for (int b = 0; b < 2; ++b)
#pragma unroll
                for (int m = 0; m < 4; ++m)
#pragma unroll
                    for (int n = 0; n < 2; ++n) acc[a][b][m][n] = (f32x4){0.f, 0.f, 0.f, 0.f}; }
        cur = nxt; cA = nA; cB = nB; ++ui;
        if (wr == 1) PG8_BAR;
    }
    PG8_WAIT_V(0);
    PG8_BAR;
#undef PG8_SA
#undef PG8_SB
#undef PG8_STAGE
#undef PG8_LDA
#undef PG8_LDB
#undef PG8_MMA
#undef PG8_WAIT_V
#undef PG8_WAIT_L
#undef PG8_BAR
#undef PG8_SCHED
}
}

__device__ __forceinline__ void phase_gemm_pe(const Frame& F) {
    pg8::DenseOrder S; S.init(F.ws + WS_PB, F.ws + WS_WPE, T, D, PD, DEPTH, F.G, F.blk); pg8::EpiBf16 E{(bf16*)(F.ws + WS_PE), D};
    pg8::gemm_phase(F.wave, F.lds, PD, S, E);
}
__device__ __forceinline__ void phase_gemm_in(const Frame& F, int l) {
    pg8::DenseOrder S; S.init(F.ws + WS_XN, (bf16*)(F.ws + WS_WIN) + (size_t)l * DIN * D, T, DIN, D, 1, F.G, F.blk); pg8::EpiBf16 E{(bf16*)(F.ws + WS_Z), DIN};
    pg8::gemm_phase(F.wave, F.lds, D, S, E);
}
__device__ __forceinline__ void phase_gemm_out(const Frame& F, int l) {
    pg8::DenseOrder S; S.init(F.ws + WS_O, (bf16*)(F.ws + WS_WOUT) + (size_t)l * D * D, T, D, D, 1, F.G, F.blk); pg8::EpiResid E{(bf16*)(F.ws + WS_H)};
    pg8::gemm_phase(F.wave, F.lds, D, S, E);
}
__device__ __forceinline__ void phase_gemm_moe1(const Frame& F, int l) {
    pg8::MoeOrder S; S.init(F.ws + WS_XB, (bf16*)(F.ws + WS_WGU) + (size_t)l * NE * 1024 * 1024, (const int*)(F.ws + MS_BLKE) + l * 256, D, 4, (size_t)1024 * 1024 * 2, F.G, F.blk); pg8::EpiGateUp E{(bf16*)(F.ws + WS_HB)};
    pg8::gemm_phase(F.wave, F.lds, D, S, E);
    { const int nun = S.nrb * 4, rem = nun % F.G, few = (rem == 0 || F.G - rem < 64), idle = few ? F.G : F.G - rem, first = few ? 0 : rem;
      if (F.blk >= first) { pg8::DenseOrder P; P.init((const bf16*)(F.ws + WS_PB) + (size_t)l * T * PD, (const bf16*)(F.ws + WS_WPE) + (size_t)l * D * PD, T, D, PD, 1, idle, F.blk - first);
          pg8::EpiBf16 EP{(bf16*)(F.ws + WS_PE) + (size_t)l * T * D, D}; pg8::gemm_phase(F.wave, F.lds, PD, P, EP); }
      conv_deferred(F, l + 1, 0, NDEF1, first, idle); }
}
__device__ __forceinline__ void phase_gemm_moe2(const Frame& F, int l) {
    pg8::MoeOrder S; S.init(F.ws + WS_HB, (bf16*)(F.ws + WS_WD) + (size_t)l * NE * D * DE, (const int*)(F.ws + MS_BLKE) + l * 256, DE, 4, (size_t)D * DE * 2, F.G, F.blk); pg8::EpiBf16 E{(bf16*)(F.ws + WS_Y), D};
    pg8::gemm_phase(F.wave, F.lds, DE, S, E);
    { const int nun = S.nrb * 4, rem = nun % F.G, few = (rem == 0 || F.G - rem < 64), idle = few ? F.G : F.G - rem, first = few ? 0 : rem;
      conv_deferred(F, l + 1, NDEF1, NDEF, first, idle); }
}
#ifndef MOE_CPE
#define MOE_CPE 5
#endif
#ifndef MOE_CTL
#define MOE_CTL 4
#endif
#ifndef MOE_X1
#define MOE_X1 16
#define MOE_X2 8
#endif
template <int MODE = 0> __device__ __forceinline__ void phase_moe_fused(const Frame& F, int l) {
    unsigned char* ws = F.ws; const int G = F.G, blk = (MOE_VBLK && F.G == 256) ? vblk(F.blk) : F.blk;
    const int* blke = (const int*)(ws + MS_BLKE) + l * 256;
    unsigned* done = (unsigned*)(ws + WS_CTL) + CW_DONE + l * 256;
    const int nrb = __builtin_amdgcn_readfirstlane(blke[255]), nu = 4 * nrb, e1 = nu % G;
    if constexpr (MODE == 1) { pg8::MoeOrder S; S.init(ws + WS_XB, (bf16*)(ws + WS_WGU) + (size_t)l * NE * 1024 * 1024, blke, D, 4, (size_t)1024 * 1024 * 2, G, blk);
      pg8::EpiGateUp E{(bf16*)(ws + WS_HB)}; pg8::gemm_phase(F.wave, F.lds, D, S, E); return; }
    if constexpr (MODE == 0) { pg8::MoeOrder S; S.init(ws + WS_XB, (bf16*)(ws + WS_WGU) + (size_t)l * NE * 1024 * 1024, blke, D, 4, (size_t)1024 * 1024 * 2, G, blk);
      pg8::EpiGateUpPub E{__builtin_amdgcn_make_buffer_rsrc(ws + WS_HB, 0, (int)((size_t)CAP * DE * 2), 0x00020000), done};
      pg8::gemm_phase(F.wave, F.lds, D, S, E); }
    if constexpr (MODE == 2) { pg8::MoeOrder S; S.init(ws + WS_HB, (bf16*)(ws + WS_WD) + (size_t)l * NE * D * DE, blke, DE, 4, (size_t)D * DE * 2, G, blk >= e1 ? blk - e1 : blk - e1 + G);
      pg8::EpiBf16 E{(bf16*)(ws + WS_Y), D}; pg8::gemm_phase(F.wave, F.lds, DE, S, E); }
    if constexpr (MODE == 0) { pg8::MoeDepOrder S; S.init(ws + WS_HB, (bf16*)(ws + WS_WD) + (size_t)l * NE * D * DE, blke, done, DE, 4, (size_t)D * DE * 2, G, blk >= e1 ? blk - e1 : blk - e1 + G);
      pg8::EpiBf16 E{(bf16*)(ws + WS_Y), D};
      pg8::gemm_phase(F.wave, F.lds, DE, S, E); }
    { const int nt = (l + 1 < DEPTH) ? NDEF : 0, ftot = 256 * MOE_CPE + nt * MOE_CTL;
      const int wrap = 2 * e1 > G ? 2 * e1 - G : 0;
      auto cls = [&](int x, int& c24, int& c16, int& c8, int& c0) {
          const int cA = x < e1 ? x : e1, cAB = x < wrap ? x : wrap;
          int cB = x - e1; cB = cB < 0 ? 0 : cB; if (!wrap) cB = cB > e1 ? e1 : cB; cB += cAB;
          c24 = cAB; c16 = cA - cAB; c8 = cB - cAB; c0 = x - c24 - c16 - c8; };
      auto fill = [&](int x, int lv) { int c24, c16, c8, c0; cls(x, c24, c16, c8, c0);
          return c0 * lv + c8 * (lv > MOE_X2 ? lv - MOE_X2 : 0) + c16 * (lv > MOE_X1 ? lv - MOE_X1 : 0) + c24 * (lv > MOE_X1 + MOE_X2 ? lv - MOE_X1 - MOE_X2 : 0); };
      int lv = 1; while (fill(G, lv) < ftot) ++lv;
      const int B0 = fill(blk, lv), B1 = fill(blk + 1, lv);
      const int pe_tot = 256 * MOE_CPE;
      int j0 = (B0 + MOE_CPE - 1) / MOE_CPE, j1 = (B1 + MOE_CPE - 1) / MOE_CPE; j0 = j0 < 256 ? j0 : 256; j1 = j1 < 256 ? j1 : 256;
      int t0 = B0 > pe_tot ? (B0 - pe_tot + MOE_CTL - 1) / MOE_CTL : 0, t1 = B1 > pe_tot ? (B1 - pe_tot + MOE_CTL - 1) / MOE_CTL : 0; t0 = t0 < nt ? t0 : nt; t1 = t1 < nt ? t1 : nt;
      if (j1 > j0) { pg8::RangeOrder P; P.init((const bf16*)(ws + WS_PB) + (size_t)l * T * PD, (const bf16*)(ws + WS_WPE) + (size_t)l * D * PD, T, D, PD, j0, j1 - j0);
          pg8::EpiBf16 EP{(bf16*)(ws + WS_PE) + (size_t)l * T * D, D}; pg8::gemm_phase(F.wave, F.lds, PD, P, EP); }
      if (t1 > t0) { const int base = (l + 1) * TL_LAYER + t0; conv_run(F, 0, 1, t1 - t0, [=](int f) { return base + f; }); } }
}
__device__ __forceinline__ void phase_gemm_pg(const Frame& F, int l) {
    pg8::DenseOrder S; S.init(F.ws + WS_XN, (bf16*)(F.ws + WS_WPG) + (size_t)l * D * D, T, D, D, 1, F.G, F.blk);
    pg8::EpiPG E{(bf16*)(F.ws + WS_H), (const bf16*)(F.ws + WS_PE) + (size_t)l * T * D, (const float*)(F.ws + MS_RSTDPE), F.in[22] + l * D};
    pg8::gemm_phase(F.wave, F.lds, D, S, E);
}

typedef short s16x4 __attribute__((ext_vector_type(4)));
__device__ __forceinline__ bf16x8 tr_frag(LAS unsigned char* p_lo, LAS unsigned char* p_hi) {
    const s16x4 lo = __builtin_amdgcn_ds_read_tr16_b64_v4i16((LAS s16x4*)p_lo), hi = __builtin_amdgcn_ds_read_tr16_b64_v4i16((LAS s16x4*)p_hi);
    return __builtin_shufflevector(lo, hi, 0, 1, 2, 3, 4, 5, 6, 7); }
#define MFMA16(a, b, c) __builtin_amdgcn_mfma_f32_16x16x32_bf16((a), (b), (c), 0, 0, 0)
constexpr int RP = 272;
constexpr int VP = 1040;

__device__ __forceinline__ void phase_rec_c1(const Frame& F, int l) {
    PH_TID();
    unsigned char* ws = F.ws; const bf16* Z = (const bf16*)(ws + WS_Z);
    bf16* UT = (bf16*)(ws + WS_UT); float* DC = (float*)(ws + MS_DC); float* MM = (float*)(ws + MS_MM);
    const float* lb = (const float*)(ws + MS_LB) + l * DREC;
    LAS unsigned char* KD = F.lds; LAS unsigned char* IM = F.lds + 128 * RP; LAS float* totx = (LAS float*)(F.lds + 256 * RP);
    const int wave = ph_wave, ch = tid & 255, half = tid >> 8, hl = ch >> 7, k = ch & 127, g = lane >> 4, li = lane & 15, q = li >> 2, p = li & 3;
    const int hG = F.G / 2, nmine = (F.G == 256) ? (F.blk < hG ? 4 : 0) : (F.blk < 512 ? (512 - F.blk + F.G - 1) / F.G : 0);
    const int ustep = (F.G == 256) ? hG : F.G;
    u32x4 pf[4], pi[4];
    auto fetch = [&](int unit) { const int c = unit >> 1, hp = unit & 1;
#pragma unroll
        for (int j = 0; j < 4; ++j) { const int idx = tid + 512 * j, hl2 = idx >> 10, row = (idx >> 4) & 63, cc = idx & 15;
            const bf16* src = Z + (size_t)(c * 64 + row) * DIN + 512 + (2 * hp + hl2) * 128 + cc * 8; pf[j] = *(const u32x4*)src; pi[j] = *(const u32x4*)(src + 512); } };
    if (nmine > 0) fetch(F.blk);
    for (int ui = 0; ui < nmine; ++ui) {
        const int unit = F.blk + ui * ustep;
        const int c = unit >> 1, hp = unit & 1, hh = 2 * hp + hl;
#pragma unroll
        for (int j = 0; j < 4; ++j) { const int idx = tid + 512 * j, hl2 = idx >> 10, row = (idx >> 4) & 63, cc = idx & 15; const int dst = (hl2 * 64 + row) * RP + cc * 16;
            *(LAS u32x4*)(KD + dst) = pf[j]; *(LAS u32x4*)(IM + dst) = pi[j]; }
        __syncthreads();
        if (ui + 1 < nmine) fetch(unit + ustep);
        const float lbk = lb[hh * 128 + k];
        float cs[32], kk[32]; float run = 1.f;
#pragma unroll
        for (int t = 0; t < 32; ++t) { const float fz = bf2f(*(const LAS bf16*)(KD + (hl * 64 + 32 * half + t) * RP + 2 * k)); const float sg = sigmoid_(fz); run *= lbk + (1.f - lbk) * sg; cs[t] = run; kk[t] = (1.f - lbk) * (1.f - sg); }
        totx[half * 256 + ch] = run;
        __syncthreads();
        const float other = totx[(1 - half) * 256 + ch]; const float p63 = run * other; const float base_p = half == 0 ? p63 : run;
#pragma unroll
        for (int t = 0; t < 32; ++t) *(LAS bf16*)(KD + (hl * 64 + 32 * half + t) * RP + 2 * k) = (bf16)f2bf(kk[t] * base_p * frcp(fmaxf(cs[t], 1e-30f)));
        if (half == 0) { DC[(c * 4 + hh) * 128 + k] = p63; MM[(c * 4 + hh) * 128 + k] = run; }
        __syncthreads();
        { const int whl = wave >> 2, kt0 = 2 * (wave & 3), whh = 2 * hp + whl;
          f32x4 acc[2][8];
#pragma unroll
          for (int i = 0; i < 2; ++i)
#pragma unroll
              for (int vt = 0; vt < 8; ++vt) acc[i][vt] = (f32x4){0.f, 0.f, 0.f, 0.f};
          LAS unsigned char* kdb = KD + whl * 64 * RP; LAS unsigned char* imb = IM + whl * 64 * RP;
#pragma unroll
          for (int a = 0; a < 2; ++a) { const unsigned ro = (unsigned)((32 * a + 8 * g + q) * RP);
              bf16x8 Af[2];
#pragma unroll
              for (int i = 0; i < 2; ++i) { const unsigned co = (unsigned)((16 * (kt0 + i) + 4 * p) * 2); Af[i] = tr_frag(kdb + ro + co, kdb + ro + 4 * RP + co); }
#pragma unroll
              for (int vt = 0; vt < 8; ++vt) { const unsigned co = (unsigned)((16 * vt + 4 * p) * 2); const bf16x8 Bf = tr_frag(imb + ro + co, imb + ro + 4 * RP + co);
#pragma unroll
                  for (int i = 0; i < 2; ++i) acc[i][vt] = MFMA16(Af[i], Bf, acc[i][vt]); } }
#pragma unroll
          for (int i = 0; i < 2; ++i)
#pragma unroll
              for (int vt = 0; vt < 8; ++vt) { u32x2 w; w.x = pg8::cvt_pk_bf16(acc[i][vt][0], acc[i][vt][1]); w.y = pg8::cvt_pk_bf16(acc[i][vt][2], acc[i][vt][3]);
                  *(u32x2*)(UT + ((size_t)(c * 4 + whh) * 128 + 16 * vt + li) * 128 + 16 * (kt0 + i) + 4 * g) = w; } }
        __syncthreads();
    }
}
__device__ __forceinline__ void phase_rec_c2a(const Frame& F) {
    PH_TID();
    unsigned char* ws = F.ws; const unsigned* UT = (const unsigned*)(ws + WS_UT); const float* DC = (const float*)(ws + MS_DC);
    f32x2* LT = (f32x2*)(ws + WS_LTOT); float* PT = (float*)(ws + MS_PTOT);
    for (int it = F.blk * NTHR + tid; it < 16 * 32768; it += F.G * NTHR) {
        const int gs = it >> 15, e = it & 32767, hh = e >> 13, v = (e >> 6) & 127, k0 = 2 * (e & 63);
        float S0 = 0.f, S1 = 0.f, P0 = 1.f, P1 = 1.f;
#pragma unroll
        for (int cc = 0; cc < 16; ++cc) { const int c = 16 * gs + cc; const unsigned u = UT[(size_t)c * 32768 + e]; const f32x2 d = *(const f32x2*)(DC + (c * 4 + hh) * 128 + k0);
            S0 = d.x * S0 + bflo(u); S1 = d.y * S1 + bfhi(u); P0 *= d.x; P1 *= d.y; }
        LT[it] = (f32x2){S0, S1};
        if (v == 0) *(f32x2*)(PT + (gs * 4 + hh) * 128 + k0) = (f32x2){P0, P1};
    }
}
__device__ __forceinline__ void phase_rec_c2c(const Frame& F) {
    PH_TID();
    unsigned char* ws = F.ws; const unsigned* UT = (const unsigned*)(ws + WS_UT); unsigned* ST = (unsigned*)(ws + WS_ST); const float* DC = (const float*)(ws + MS_DC); const float* MM = (const float*)(ws + MS_MM);
    const f32x2* LT = (const f32x2*)(ws + WS_LTOT); const float* PT = (const float*)(ws + MS_PTOT);
    for (int it = F.blk * NTHR + tid; it < 16 * 32768; it += F.G * NTHR) {
        const int gs = it >> 15, e = it & 32767, hh = e >> 13, k0 = 2 * (e & 63);
        float C0 = 0.f, C1 = 0.f;
        for (int g2 = 0; g2 < gs; ++g2) { const f32x2 pt = *(const f32x2*)(PT + (g2 * 4 + hh) * 128 + k0); const f32x2 lt = LT[g2 * 32768 + e]; C0 = pt.x * C0 + lt.x; C1 = pt.y * C1 + lt.y; }
#pragma unroll
        for (int cc = 0; cc < 16; ++cc) { const int c = 16 * gs + cc; const f32x2 mm = *(const f32x2*)(MM + (c * 4 + hh) * 128 + k0);
            ST[(size_t)c * 32768 + e] = pk2(C0 * mm.x, C1 * mm.y);
            const unsigned u = UT[(size_t)c * 32768 + e]; const f32x2 d = *(const f32x2*)(DC + (c * 4 + hh) * 128 + k0);
            C0 = d.x * C0 + bflo(u); C1 = d.y * C1 + bfhi(u); }
    }
}
__device__ __forceinline__ void phase_rec_c2(const Frame& F) {
    PH_TID();
    unsigned char* ws = F.ws; const int w = ph_wave;
    LAS float* tot = (LAS float*)F.lds;
    for (int unit = F.blk; unit < 256; unit += F.G) {
        const int hh = unit >> 6; const unsigned eo = (unsigned)(unit * 128 + lane), ko = (unsigned)(hh * 128 + 2 * lane);
        const unsigned* ut = (const unsigned*)(ws + WS_UT) + (size_t)(32 * w) * 32768; unsigned* st = (unsigned*)(ws + WS_ST) + (size_t)(32 * w) * 32768;
        const float* dc = (const float*)(ws + MS_DC) + (32 * w) * 512; const float* mmp = (const float*)(ws + MS_MM) + (32 * w) * 512;
        asm volatile("" : "+s"(ut), "+s"(st), "+s"(dc), "+s"(mmp));
        unsigned ua[32], ub[32]; f32x2 d[32], m0[16], m1[16];
#pragma unroll
        for (int cc = 0; cc < 32; ++cc) { ua[cc] = (ut + cc * 32768)[eo]; ub[cc] = (ut + cc * 32768 + 64)[eo]; d[cc] = *(const f32x2*)((dc + cc * 512) + ko); }
        __builtin_amdgcn_sched_barrier(0);
        float a0 = 0.f, a1 = 0.f, b0 = 0.f, b1 = 0.f, p0 = 1.f, p1 = 1.f;
#pragma unroll
        for (int cc = 0; cc < 32; ++cc) { a0 = d[cc].x * a0 + bflo(ua[cc]); a1 = d[cc].y * a1 + bfhi(ua[cc]); b0 = d[cc].x * b0 + bflo(ub[cc]); b1 = d[cc].y * b1 + bfhi(ub[cc]); p0 *= d[cc].x; p1 *= d[cc].y; }
        { LAS float* tw = tot + w * 384 + lane; tw[0] = a0; tw[64] = a1; tw[128] = b0; tw[192] = b1; tw[256] = p0; tw[320] = p1; }
        __builtin_amdgcn_sched_barrier(0);
#pragma unroll
        for (int cc = 0; cc < 16; ++cc) m0[cc] = *(const f32x2*)((mmp + cc * 512) + ko);
        __builtin_amdgcn_sched_barrier(0);
        __syncthreads();
        float A0 = 0.f, A1 = 0.f, B0 = 0.f, B1 = 0.f;
        for (int g2 = 0; g2 < w; ++g2) { const LAS float* tw = tot + g2 * 384 + lane; const float q0 = tw[256], q1 = tw[320]; A0 = q0 * A0 + tw[0]; A1 = q1 * A1 + tw[64]; B0 = q0 * B0 + tw[128]; B1 = q1 * B1 + tw[192]; }
        __builtin_amdgcn_sched_barrier(0);
#pragma unroll
        for (int cc = 0; cc < 16; ++cc) m1[cc] = *(const f32x2*)((mmp + (16 + cc) * 512) + ko);
        __builtin_amdgcn_sched_barrier(0);
#pragma unroll
        for (int cc = 0; cc < 32; ++cc) { const f32x2 mm = cc < 16 ? m0[cc & 15] : m1[cc & 15];
            (st + cc * 32768)[eo] = pk2(A0 * mm.x, A1 * mm.y); (st + cc * 32768 + 64)[eo] = pk2(B0 * mm.x, B1 * mm.y);
            unsigned xa = ua[cc], xb = ub[cc]; asm volatile("" : "+v"(xa), "+v"(xb));
            A0 = d[cc].x * A0 + bflo(xa); A1 = d[cc].y * A1 + bfhi(xa); B0 = d[cc].x * B0 + bflo(xb); B1 = d[cc].y * B1 + bfhi(xb);
            asm volatile("" : "+v"(A0), "+v"(A1), "+v"(B0), "+v"(B1) :: "memory"); }
        __syncthreads();
    }
}
template <int PV = 0> __device__ __forceinline__ void phase_rec_c3(const Frame& F, int l) {
    PH_TID();
    unsigned char* ws = F.ws; const bf16* Z = (const bf16*)(ws + WS_Z); const bf16* ST = (const bf16*)(ws + WS_ST); bf16* O = (bf16*)(ws + WS_O);
    const float* lb = (const float*)(ws + MS_LB) + l * DREC; const float* ogain = F.in[5] + l * 128;
    LAS unsigned char* QT = F.lds; LAS unsigned char* KT = F.lds + 128 * RP; LAS unsigned char* IM = F.lds + 256 * RP;
    const int wave = ph_wave, ch = tid & 255, half = tid >> 8, hl = ch >> 7, k = ch & 127, g = lane >> 4, li = lane & 15, q = li >> 2, p = li & 3;
    u32x4 pq[4], pf[4];
    const unsigned tvo = (unsigned)((tid >> 4) * DIN + (tid & 15) * 8), tlo = (unsigned)((tid >> 4) * RP + (tid & 15) * 16);
    auto fetch = [&](int unit) { const bf16* zc = Z + (size_t)(unit >> 1) * 64 * DIN + (unit & 1) * 256;
#pragma unroll
        for (int j = 0; j < 4; ++j) { const bf16* src = zc + (32 * (j & 1)) * DIN + (j >> 1) * 128; pq[j] = *(const u32x4*)(src + tvo); pf[j] = *(const u32x4*)(src + 512 + tvo); } };
    if (F.blk < 512) fetch(F.blk);
    for (int unit = F.blk; unit < 512; unit += F.G) {
        const int c = unit >> 1, hp = unit & 1, hh = 2 * hp + hl;
#pragma unroll
        for (int j = 0; j < 4; ++j) { const int dst = ((j >> 1) * 64 + 32 * (j & 1)) * RP;
            *(LAS u32x4*)(QT + dst + tlo) = pq[j]; *(LAS u32x4*)(KT + dst + tlo) = pf[j]; }
        u32x4 vi[4];
        { const bf16* zc = Z + (size_t)c * 64 * DIN + hp * 256 + 1024;
#pragma unroll
          for (int j = 0; j < 4; ++j) vi[j] = *(const u32x4*)(zc + (32 * (j & 1)) * DIN + (j >> 1) * 128 + tvo); }
        __syncthreads();
        { const float lbk = lb[hh * 128 + k]; const int col = (hl * 64 + 32 * half) * RP + 2 * k;
          float cs[32], kk[32], qs[32]; float run = 1.f;
#pragma unroll
          for (int t = 0; t < 32; ++t) { const float fz = bf2f(*(const LAS bf16*)(KT + col + t * RP)); const float sg = sigmoid_(fz); run *= lbk + (1.f - lbk) * sg; cs[t] = run; kk[t] = (1.f - lbk) * (1.f - sg);
              qs[t] = silu_(bf2f(*(const LAS bf16*)(QT + col + t * RP))); }
          const float inv = half == 0 ? frcp(fmaxf(run, 1e-30f)) : 1.f;
#pragma unroll
          for (int t = 0; t < 32; ++t) { const float ex = cs[t] * inv; const int off = col + t * RP;
              *(LAS bf16*)(QT + off) = (bf16)f2bf(qs[t] * ex); *(LAS bf16*)(KT + off) = (bf16)f2bf(kk[t] * frcp(fmaxf(ex, 1e-30f))); } }
#pragma unroll
        for (int j = 0; j < 4; ++j) *(LAS u32x4*)(IM + ((j >> 1) * 64 + 32 * (j & 1)) * RP + tlo) = vi[j];
        const int whl = wave >> 2, tt = wave & 3, whh = 2 * hp + whl;
        bf16x8 Sf[8][4];
#pragma unroll
        for (int vt = 0; vt < 8; ++vt)
#pragma unroll
            for (int a = 0; a < 4; ++a) Sf[vt][a] = *(const bf16x8*)(ST + ((size_t)(c * 4 + whh) * 128 + 16 * vt + li) * 128 + 32 * a + 8 * g);
        __syncthreads();
        if (PV != 1) {
          bf16 gz[8][4];
#pragma unroll
          for (int vt = 0; vt < 8; ++vt)
#pragma unroll
              for (int r = 0; r < 4; ++r) gz[vt][r] = Z[((size_t)c * 64 + 16 * tt + 4 * g + r) * DIN + 1536 + whh * 128 + 16 * vt + li];
          bf16x8 Qf[4];
#pragma unroll
          for (int a = 0; a < 4; ++a) Qf[a] = *(const LAS bf16x8*)(QT + (whl * 64 + 16 * tt + li) * RP + (32 * a + 8 * g) * 2);
          unsigned pw[4][2];
#pragma unroll
          for (int st = 0; st < 4; ++st) { pw[st][0] = 0u; pw[st][1] = 0u;
              { f32x4 s = (f32x4){0.f, 0.f, 0.f, 0.f};
#pragma unroll
                  for (int a = 0; a < 4; ++a) { const bf16x8 Kf = *(const LAS bf16x8*)(KT + (whl * 64 + 16 * st + li) * RP + (32 * a + 8 * g) * 2); s = MFMA16(Kf, Qf[a], s); }
                  if (st == tt) {
#pragma unroll
                      for (int r = 0; r < 4; ++r) if (4 * g + r > li) s[r] = 0.f; }
                  pw[st][0] = st <= tt ? pg8::cvt_pk_bf16(s[0], s[1]) : 0u; pw[st][1] = st <= tt ? pg8::cvt_pk_bf16(s[2], s[3]) : 0u; } }
          f32x4 acc[8];
#pragma unroll
          for (int vt = 0; vt < 8; ++vt) { acc[vt] = (f32x4){0.f, 0.f, 0.f, 0.f};
#pragma unroll
              for (int a = 0; a < 4; ++a) acc[vt] = MFMA16(Qf[a], Sf[vt][a], acc[vt]); }
          __builtin_amdgcn_sched_barrier(0);
          if (unit + F.G < 512) fetch(unit + F.G);
          __builtin_amdgcn_sched_barrier(0);
          LAS unsigned char* imb = IM + whl * 64 * RP;
#pragma unroll
          for (int a = 0; a < 2; ++a) { const u32x4 pv = (u32x4){pw[2 * a][0], pw[2 * a][1], pw[2 * a + 1][0], pw[2 * a + 1][1]}; const bf16x8 Pf = __builtin_bit_cast(bf16x8, pv);
              const unsigned ro = (unsigned)((32 * a + 4 * g + q) * RP);
#pragma unroll
              for (int vt = 0; vt < 8; ++vt) { const unsigned co = (unsigned)((16 * vt + 4 * p) * 2); const bf16x8 If = tr_frag(imb + ro + co, imb + ro + 16 * RP + co); acc[vt] = MFMA16(Pf, If, acc[vt]); } }
          float rs[4];
#pragma unroll
          for (int r = 0; r < 4; ++r) { float ss = 0.f;
#pragma unroll
              for (int vt = 0; vt < 8; ++vt) ss += acc[vt][r] * acc[vt][r];
              ss += shx<1>(ss); ss += shx<2>(ss); ss += shx<4>(ss); ss += shx<8>(ss); rs[r] = frsq(ss * (1.f / 128.f) + EPS); }
#pragma unroll
          for (int vt = 0; vt < 8; ++vt) { const float og = ogain[16 * vt + li];
#pragma unroll
              for (int r = 0; r < 4; ++r) { const size_t t = (size_t)c * 64 + 16 * tt + 4 * g + r; const float gv = bf2f(gz[vt][r]);
                  O[t * D + whh * 128 + 16 * vt + li] = (bf16)f2bf(acc[vt][r] * rs[r] * og * silu_(gv)); } } }
        __syncthreads();
    }
}
__device__ __forceinline__ void phase_sgu(const Frame& F, int l) {
    PH_TID();
    unsigned char* ws = F.ws; const bf16* Z = (const bf16*)(ws + WS_Z); bf16* O = (bf16*)(ws + WS_O);
    const bf16* Wb = (const bf16*)(ws + MS_SGUW) + (size_t)l * 4 * 128 * 128; const float* sb = F.in[9] + l * 4 * 128;
    LAS unsigned char* VN = F.lds;
    const int wave = ph_wave, g = lane >> 4, li = lane & 15, q = li >> 2, p = li & 3;
    for (int unit = (F.blk + F.G / 2) % F.G; unit < 128; unit += F.G) {
        float lg[8], lbv[8];
#pragma unroll
        for (int j = 0; j < 8; ++j) { lg[j] = F.in[6][l * DSGU + 8 * lane + j]; lbv[j] = F.in[7][l * DSGU + 8 * lane + j]; }
        u32x4 raw[16];
#pragma unroll
        for (int i = 0; i < 16; ++i) raw[i] = *(const u32x4*)(Z + ((size_t)unit * 128 + 16 * wave + i) * DIN + 2560 + 8 * lane);
#pragma unroll
        for (int i = 0; i < 16; ++i) { const int s = 16 * wave + i; const u32x4 r = raw[i];
            float x[8] = {gelu_(bflo(r.x)), gelu_(bfhi(r.x)), gelu_(bflo(r.y)), gelu_(bfhi(r.y)), gelu_(bflo(r.z)), gelu_(bfhi(r.z)), gelu_(bflo(r.w)), gelu_(bfhi(r.w))};
            float sm = 0.f, qq = 0.f;
#pragma unroll
            for (int j = 0; j < 8; ++j) { sm += x[j]; qq += x[j] * x[j]; }
            sm += shx<1>(sm); qq += shx<1>(qq); sm += shx<2>(sm); qq += shx<2>(qq); sm += shx<4>(sm); qq += shx<4>(qq); sm += shx<8>(sm); qq += shx<8>(qq); sm += shx<16>(sm); qq += shx<16>(qq);
            const float mu = halves_sum(sm) * (1.f / 512.f); const float var = fmaxf(halves_sum(qq) * (1.f / 512.f) - mu * mu, 0.f);
            const float rstd = frsq(var + EPS);
#pragma unroll
            for (int j = 0; j < 8; ++j) x[j] = (x[j] - mu) * rstd * lg[j] + lbv[j];
            u32x4 o; o.x = pk2(x[0], x[1]); o.y = pk2(x[2], x[3]); o.z = pk2(x[4], x[5]); o.w = pk2(x[6], x[7]);
            *(LAS u32x4*)(VN + s * VP + lane * 16) = o; }
        __syncthreads();
        { const int hh = wave >> 1, dh = wave & 1; const bf16* W = Wb + (size_t)hh * 128 * 128;
          LAS unsigned char* vnb = VN;
#pragma unroll 1
          for (int dp = 0; dp < 2; ++dp) {
          bf16x8 Wf[2][8];
#pragma unroll
          for (int a = 0; a < 2; ++a)
#pragma unroll
              for (int ti = 0; ti < 8; ++ti) if (ti >= 2 * a) Wf[a][ti] = *(const bf16x8*)(W + (size_t)(16 * ti + li) * 128 + 32 * a + 8 * g);
          u32x2 uu[8][2]; float bs[8];
#pragma unroll
          for (int ti = 0; ti < 8; ++ti) { bs[ti] = sb[hh * 128 + 16 * ti + li];
#pragma unroll
              for (int dt = 0; dt < 2; ++dt) uu[ti][dt] = *(const u32x2*)(Z + ((size_t)unit * 128 + 16 * ti + li) * DIN + 2048 + hh * 128 + 64 * dh + 16 * (2 * dp + dt) + 4 * g); }
          f32x4 acc[2][8];
#pragma unroll
          for (int dt = 0; dt < 2; ++dt)
#pragma unroll
              for (int ti = 0; ti < 8; ++ti) acc[dt][ti] = (f32x4){0.f, 0.f, 0.f, 0.f};
#pragma unroll
          for (int a = 0; a < 4; ++a) { const unsigned ro = (unsigned)((32 * a + 8 * g + q) * VP);
              bf16x8 Af[2];
#pragma unroll
              for (int dt = 0; dt < 2; ++dt) { const unsigned co = (unsigned)((hh * 128 + 64 * dh + 16 * (2 * dp + dt) + 4 * p) * 2); Af[dt] = tr_frag(vnb + ro + co, vnb + ro + 4 * VP + co); }
#pragma unroll
              for (int ti = 0; ti < 8; ++ti) if (ti >= 2 * a) {
                  const bf16x8 Bf = a < 2 ? Wf[a < 2 ? a : 0][ti] : *(const bf16x8*)(W + (size_t)(16 * ti + li) * 128 + 32 * a + 8 * g);
#pragma unroll
                  for (int dt = 0; dt < 2; ++dt) acc[dt][ti] = MFMA16(Af[dt], Bf, acc[dt][ti]); } }
#pragma unroll
          for (int ti = 0; ti < 8; ++ti) { const size_t t = (size_t)unit * 128 + 16 * ti + li; const float bias = bs[ti];
#pragma unroll
              for (int dt = 0; dt < 2; ++dt) { const int col = hh * 128 + 64 * dh + 16 * (2 * dp + dt) + 4 * g; const u32x2 u = uu[ti][dt];
                  u32x2 w; w.x = pk2((acc[dt][ti][0] + bias) * gelu_(bflo(u.x)), (acc[dt][ti][1] + bias) * gelu_(bfhi(u.x))); w.y = pk2((acc[dt][ti][2] + bias) * gelu_(bflo(u.y)), (acc[dt][ti][3] + bias) * gelu_(bfhi(u.y)));
                  *(u32x2*)(O + t * D + 512 + col) = w; } } } }
        __syncthreads();
    }
}

#define XB_TMO      128
#define XB_XCNT(j)  (256  + 64 * (j))
#define XB_XSUB(j)  (1280 + 64 * (j))
#define XB_XGEN(j)  (2304 + 64 * (j))
#define XB_TOP      3328
#define XB_TOPGEN   3392
#define XCD_BAR_WORDS 3456
#define XB_SPIN_CAP (1u << 18)
__device__ __forceinline__ unsigned xb_ld(unsigned* p)              { return __hip_atomic_load(p, __ATOMIC_RELAXED, __HIP_MEMORY_SCOPE_AGENT); }
__device__ __forceinline__ unsigned xb_add(unsigned* p, unsigned v) { return __hip_atomic_fetch_add(p, v, __ATOMIC_RELAXED, __HIP_MEMORY_SCOPE_AGENT); }
__device__ __forceinline__ unsigned xb_xcc_id() { return (unsigned)__builtin_amdgcn_s_getreg((3 << 11) | 20) & 0xFu; }
#define XB_SPIN(cond, bar) do { unsigned _sp = 0; while (cond) { __builtin_amdgcn_s_sleep(1); \
    if ((++_sp & 255u) == 0u) { if (xb_ld(&(bar)[XB_TMO])) break; if (_sp > XB_SPIN_CAP) { atomicAdd(&(bar)[XB_TMO], 1u); break; } } } } while (0)
struct XcdBarrier { unsigned* bar; unsigned x; volatile LAS unsigned* st; int wave; };
__device__ __forceinline__ XcdBarrier xcd_barrier_post(unsigned* bar, volatile LAS unsigned* st, int wave) {
    XcdBarrier b; b.bar = bar; b.x = xb_xcc_id(); b.st = st; b.wave = wave;
    if (wave == 0 && lane_now() == 0) (void)xb_add(&bar[XB_XCNT(b.x)], 1u);
    return b;
}
__device__ __forceinline__ void xcd_barrier_complete(unsigned* bar, unsigned x, unsigned& nloc, unsigned& nx) {
    const unsigned G = gridDim.x * gridDim.y * gridDim.z;
    unsigned sum, cnt, mine, sp = 0u;
    for (;;) {
        sum = 0u; cnt = 0u; mine = 0u;
#pragma unroll
        for (unsigned j = 0; j < 16; ++j) { const unsigned c = xb_ld(&bar[XB_XCNT(j)]); sum += c; cnt += (c > 0u) ? 1u : 0u; mine = (j == x) ? c : mine; }
        if (sum == G) break;
        __builtin_amdgcn_s_sleep(1);
        if ((++sp & 255u) == 0u) { if (xb_ld(&bar[XB_TMO])) break; if (sp > XB_SPIN_CAP) { atomicAdd(&bar[XB_TMO], 1u); break; } }
    }
    nloc = mine > 0u ? mine : 1u; nx = cnt > 0u ? cnt : 1u;
}
__device__ __forceinline__ void xcd_barrier(const XcdBarrier& b) {
    asm volatile("s_waitcnt vmcnt(0)" ::: "memory");
    __syncthreads();
    if (b.wave == 0 && lane_now() == 0) {
        unsigned* bar = b.bar;
        __builtin_amdgcn_s_waitcnt(0);
        unsigned nloc = b.st[0], nx = b.st[1];
        if (nloc == 0u) { xcd_barrier_complete(bar, b.x, nloc, nx); b.st[0] = nloc; b.st[1] = nx; }
        const unsigned old = xb_add(&bar[XB_XSUB(b.x)], 1u);
        const unsigned gen = old / nloc;
        if (old + 1u == (gen + 1u) * nloc) {
            __builtin_amdgcn_fence(__ATOMIC_RELEASE, "agent");
            asm volatile("s_waitcnt vmcnt(0)" ::: "memory");
            const unsigned og = xb_add(&bar[XB_TOP], 1u);
            const unsigned tg = og / nx;
            if (og + 1u == (tg + 1u) * nx) xb_add(&bar[XB_TOPGEN], 1u);
            else XB_SPIN(xb_ld(&bar[XB_TOPGEN]) == tg, bar);
            __builtin_amdgcn_fence(__ATOMIC_ACQUIRE, "agent");
            xb_add(&bar[XB_XGEN(b.x)], 1u);
            asm volatile("s_waitcnt vmcnt(0)" ::: "memory");
        } else {
            XB_SPIN(xb_ld(&bar[XB_XGEN(b.x)]) == gen, bar);
            __builtin_amdgcn_fence(__ATOMIC_ACQUIRE, "agent");
            asm volatile("s_waitcnt vmcnt(0)" ::: "memory");
        }
    }
    __syncthreads();
}


__device__ __forceinline__ void xcd_barrier_bg(const XcdBarrier& b, const Frame& F, int lnext, bool drain) {
    asm volatile("s_waitcnt vmcnt(0)" ::: "memory");
    __syncthreads();
    volatile LAS unsigned* sx = b.st + 4;
    unsigned* q = (unsigned*)(F.ws + WS_CTL) + CW_BGQ + lnext * 64;
    if (b.wave == 0 && lane_now() == 0) {
        unsigned* bar = b.bar;
        __builtin_amdgcn_s_waitcnt(0);
        unsigned nloc = b.st[0], nx = b.st[1];
        if (nloc == 0u) { xcd_barrier_complete(bar, b.x, nloc, nx); b.st[0] = nloc; b.st[1] = nx; }
        const unsigned old = xb_add(&bar[XB_XSUB(b.x)], 1u);
        const unsigned gen = old / nloc;
        const bool leader = (old + 1u == (gen + 1u) * nloc);
        unsigned ti = 0u; if (!leader) { const unsigned k = xb_add(q, 1u); if (k < (unsigned)NBG) ti = k + 1u; }
        sx[0] = leader ? 1u : 0u; sx[1] = gen; sx[2] = ti;
    }
    __syncthreads();
    if (__builtin_amdgcn_readfirstlane(sx[0]) == 0u) {
        unsigned ti = (unsigned)__builtin_amdgcn_readfirstlane(sx[2]);
        while (ti != 0u) {
            const int it = lnext * TL_LAYER + NDEF + (int)ti - 1;
            conv_run(F, 0, 1, 1, [=](int) { return it; });
            if (!drain) break;
            if (b.wave == 0 && lane_now() == 0) { const unsigned k = xb_add(q, 1u); sx[2] = k < (unsigned)NBG ? k + 1u : 0u; }
            __syncthreads();
            ti = (unsigned)__builtin_amdgcn_readfirstlane(sx[2]);
            __syncthreads();
        }
    }
    if (b.wave == 0 && lane_now() == 0) {
        unsigned* bar = b.bar; const unsigned gen = sx[1], nx = b.st[1];
        asm volatile("s_waitcnt vmcnt(0)" ::: "memory");
        if (sx[0] != 0u) {
            __builtin_amdgcn_fence(__ATOMIC_RELEASE, "agent");
            asm volatile("s_waitcnt vmcnt(0)" ::: "memory");
            const unsigned og = xb_add(&bar[XB_TOP], 1u);
            const unsigned tg = og / nx;
            if (og + 1u == (tg + 1u) * nx) xb_add(&bar[XB_TOPGEN], 1u);
            else XB_SPIN(xb_ld(&bar[XB_TOPGEN]) == tg, bar);
            __builtin_amdgcn_fence(__ATOMIC_ACQUIRE, "agent");
            xb_add(&bar[XB_XGEN(b.x)], 1u);
            asm volatile("s_waitcnt vmcnt(0)" ::: "memory");
        } else {
            XB_SPIN(xb_ld(&bar[XB_XGEN(b.x)]) == gen, bar);
            __builtin_amdgcn_fence(__ATOMIC_ACQUIRE, "agent");
            asm volatile("s_waitcnt vmcnt(0)" ::: "memory");
        }
    }
    __syncthreads();
}

__device__ __forceinline__ bool opq(Frame& F) { asm volatile("" : "+s"(F.ws), "+s"(F.blk), "+s"(F.out), "+s"(F.G)); return true; }
__device__ __forceinline__ int lq_(int l) { asm volatile("" : "+s"(l)); return l; }
__global__ void __launch_bounds__(NTHR, 2) k_mega(Params p) {
    extern __shared__ __attribute__((aligned(16))) unsigned char lds[];
    Frame F; F.lds = (LAS unsigned char*)lds; F.ws = p.ws; F.in = p.in; F.out = p.out; F.wave = __builtin_amdgcn_readfirstlane(threadIdx.x >> 6); F.blk = blockIdx.x; F.G = gridDim.x;
    volatile LAS unsigned* st = (volatile LAS unsigned*)(F.lds + LDS_BYTES - 32);
    if (threadIdx.x < 8) st[threadIdx.x] = 0u;
    __syncthreads();
#if USE_CG_SYNC
#define GRID_BAR() cooperative_groups::this_grid().sync()
#else
    const XcdBarrier bar = xcd_barrier_post((unsigned*)(p.ws + WS_CTL) + CW_BAR + p.li * XCD_BAR_WORDS, st, F.wave);
#define GRID_BAR() xcd_barrier(bar)
#endif
    const int lo = p.ph_lo, hi = p.ph_hi;
#define RUN(k) (lo <= (k) && (k) < hi && opq(F))
#define SEAM(k) do { if (RUN(k) && RUN((k) + 1)) GRID_BAR(); } while (0)
#define SEAM_BG(k, drain) do { if (RUN(k) && RUN((k) + 1)) { if (!USE_CG_SYNC && l + 1 < DEPTH) xcd_barrier_bg(bar, F, l + 1, drain); else GRID_BAR(); } } while (0)
    if (RUN(0)) { phase_prologue(F); if (PROBE_DUP & 16) { __syncthreads(); phase_prologue(F); } }
    SEAM(0);
    for (int l = 0; l < DEPTH; ++l) {
        const int b = 2 + 13 * l;
        if (RUN(b + 0)) phase_norm1(F, lq_(l));
        SEAM_BG(b + 0, false);
        if (RUN(b + 1)) phase_gemm_in(F, lq_(l));
        SEAM_BG(b + 1, false);
        if (RUN(b + 2)) { phase_rec_c1(F, lq_(l)); phase_sgu(F, lq_(l)); if (PROBE_DUP & 1) { __syncthreads(); phase_rec_c1(F, lq_(l)); phase_sgu(F, lq_(l)); } if (PROBE_DUP & 64) { __syncthreads(); phase_sgu(F, lq_(l)); } }
        SEAM_BG(b + 2, false);
        if (RUN(b + 3)) { phase_rec_c2(F); if (PROBE_DUP & 4) phase_rec_c2(F); }
        SEAM_BG(b + 3, false);
        if (RUN(b + 5)) { phase_rec_c3(F, lq_(l)); if (PROBE_DUP & 2) { __syncthreads(); phase_rec_c3(F, lq_(l)); } if (PROBE_DUP & 128) { __syncthreads(); phase_rec_c3<1>(F, lq_(l)); } }
        SEAM_BG(b + 5, false);
        if (RUN(b + 6)) phase_gemm_out(F, lq_(l));
        SEAM_BG(b + 6, false);
        if (RUN(b + 7)) phase_norm2(F, lq_(l));
        SEAM_BG(b + 7, false);
        if (RUN(b + 8)) { phase_gather(F, lq_(l)); if (PROBE_DUP & 8) { __syncthreads(); phase_gather(F, lq_(l)); } }
        SEAM_BG(b + 8, false);
#if MOE_FUSED == 1
        if (RUN(b + 9)) phase_moe_fused(F, lq_(l));
        SEAM_BG(b + 9, false);
#elif MOE_FUSED == 2
        if (RUN(b + 9)) phase_moe_fused<1>(F, lq_(l));
        SEAM_BG(b + 9, false);
        if (RUN(b + 10)) phase_moe_fused<2>(F, lq_(l));
        SEAM_BG(b + 10, false);
#else
        if (RUN(b + 9)) phase_gemm_moe1(F, lq_(l));
        SEAM_BG(b + 9, false);
        if (RUN(b + 10)) phase_gemm_moe2(F, lq_(l));
        SEAM_BG(b + 10, false);
#endif
        if (RUN(b + 11)) phase_combine(F, lq_(l));
        SEAM_BG(b + 11, true);
        if (RUN(b + 12)) phase_gemm_pg(F, lq_(l));
        SEAM(b + 12);
    }
    if (RUN(54)) phase_final(F);
#undef RUN
#undef SEAM
}

#ifndef ONE_LAUNCH
#define ONE_LAUNCH 1
#endif
#ifndef CUTS
#define CUTS {0, 55}
#endif
#ifndef MFMA_MASK
#define MFMA_MASK 255
#endif
extern "C" void kernel_launch(void* const* d_in, const int* in_sizes, int n_in, void* d_out, int out_size, void* d_ws, size_t ws_size, hipStream_t stream) {
    if (n_in != 24 || out_size != T * D || ws_size < WS_END) { fprintf(stderr, "kernel_launch: unexpected shapes (n_in %d out %d ws %zu)\n", n_in, out_size, ws_size); return; }
    static_assert(CW_BAR + 60 * XCD_BAR_WORDS <= (int)(CTL_BYTES / 4), "barrier regions inside the zeroed control words");
    Params p{}; for (int i = 0; i < 24; ++i) p.in[i] = (const float*)d_in[i]; p.out = (float*)d_out; p.ws = (unsigned char*)d_ws;
    unsigned char* ws = p.ws;
    (void)hipMemsetAsync(ws + WS_CTL, 0, CTL_BYTES, stream);
    { static bool attr = false; if (!attr) { (void)hipFuncSetAttribute((const void*)k_mega, hipFuncAttributeMaxDynamicSharedMemorySize, LDS_BYTES); attr = true; }
      const int cuts[] = CUTS; const int ncut = (int)(sizeof(cuts) / sizeof(cuts[0]));
      for (int i = 0; i + 1 < ncut; ++i) { p.ph_lo = cuts[i]; p.ph_hi = cuts[i + 1]; p.li = i; p.pad = 0;
#if USE_CG_SYNC
          void* args[] = {&p}; hipError_t e = hipLaunchCooperativeKernel((const void*)k_mega, dim3(256), dim3(NTHR), args, LDS_BYTES, stream);
          if (e != hipSuccess) fprintf(stderr, "cooperative launch failed: %s\n", hipGetErrorName(e));
#else
          hipLaunchKernelGGL(k_mega, dim3(256), dim3(NTHR), LDS_BYTES, stream, p);
#endif
      }
    }
}
```

```cpp
#include <hip/hip_runtime.h>
#include <hip/hip_cooperative_groups.h>
#include <cstdio>
#include <cstdint>

#define GAS __attribute__((address_space(1)))
#define LAS __attribute__((address_space(3)))
typedef unsigned short bf16;
typedef float f32x4 __attribute__((ext_vector_type(4)));
typedef float f32x2 __attribute__((ext_vector_type(2)));
typedef unsigned u32x4 __attribute__((ext_vector_type(4)));
typedef unsigned u32x2 __attribute__((ext_vector_type(2)));
typedef short bf16x8 __attribute__((ext_vector_type(8)));

constexpr int T = 16384, D = 1024, DEPTH = 4, DIN = 3072, DREC = 512, DSGU = 512;
constexpr int NE = 32, DE = 512, PD = 256;
constexpr int RB = 256;
constexpr int CAP = 2 * T + NE * RB;
constexpr int NRBMAX = CAP / RB;
constexpr float EPS = 1e-6f;
constexpr int NWAVES = 8, NTHR = 512;

constexpr size_t MiB = 1u << 20, KiB = 1u << 10;
constexpr size_t WS_CTL = 0, CTL_BYTES = 1 * MiB;
constexpr size_t WS_MISC = 1 * MiB;
constexpr size_t MS_TOKE = WS_MISC + 0;
constexpr size_t MS_TOKW = WS_MISC + 128 * KiB;
constexpr size_t MS_SINFO = WS_MISC + 256 * KiB;
constexpr size_t MS_SDEST = WS_MISC + 384 * KiB;
constexpr size_t MS_RSTDPE = WS_MISC + 512 * KiB;
constexpr size_t MS_BLKBASE = WS_MISC + 576 * KiB;
constexpr size_t MS_LB = WS_MISC + 608 * KiB;
constexpr size_t MS_RSTD2 = WS_MISC + 704 * KiB;
constexpr size_t MS_RSTD1 = WS_MISC + 768 * KiB;
constexpr size_t MS_PART = WS_MISC + 6 * MiB;
constexpr size_t MS_BLKE = WS_MISC + 640 * KiB;
constexpr size_t MS_DC = WS_MISC + 1 * MiB;
constexpr size_t MS_WRT = WS_MISC + 2 * MiB;
constexpr size_t MS_SGUW = WS_MISC + 3 * MiB;
constexpr size_t MS_MM = WS_MISC + 4 * MiB;
constexpr size_t MS_PTOT = WS_MISC + 5 * MiB;
constexpr size_t WS_WIN = 16 * MiB;
constexpr size_t WS_WOUT = 40 * MiB;
constexpr size_t WS_WGU = 48 * MiB;
constexpr size_t WS_WD = 304 * MiB;
constexpr size_t WS_WPG = 432 * MiB;
constexpr size_t WS_WPE = 440 * MiB;
constexpr size_t WS_PB = 442 * MiB;
constexpr size_t WS_H = 474 * MiB;
constexpr size_t WS_XN = 538 * MiB;
constexpr size_t WS_O = 570 * MiB;
constexpr size_t WS_PE = 602 * MiB;
constexpr size_t WS_R1 = 730 * MiB;
constexpr size_t WS_Z = WS_R1;
constexpr size_t WS_UT = WS_R1 + 96 * MiB;
constexpr size_t WS_ST = WS_R1 + 128 * MiB;
constexpr size_t WS_ORAW = WS_R1 + 96 * MiB;
constexpr size_t WS_VN = WS_R1 + 128 * MiB;
constexpr size_t WS_XB = WS_R1;
constexpr size_t WS_HB = WS_R1 + 80 * MiB;
constexpr size_t WS_Y = WS_R1 + 120 * MiB;
constexpr size_t WS_LTOT = 930 * MiB;
constexpr size_t WS_END = 934 * MiB;
constexpr int CW_CNT = 64;
constexpr int CW_BGQ = 1024;
constexpr int CW_DONE = 2048;
constexpr int CW_BAR = 4096;

constexpr int RING_BYTES = 131072, MISC_OFF = RING_BYTES, LDS_BYTES = 147456;

#ifndef PROBE_DUP
#define PROBE_DUP 0
#endif
#ifndef MOE_VBLK
#define MOE_VBLK 1
#endif
#ifndef MOE_FUSED
#define MOE_FUSED 1
#endif
#ifndef USE_CG_SYNC
#define USE_CG_SYNC 0
#endif
struct Params { const float* in[24]; float* out; unsigned char* ws; int ph_lo, ph_hi, li, pad; };

#define LDS_WAIT() asm volatile("s_waitcnt lgkmcnt(0)" ::: "memory")
template <int M> __device__ __forceinline__ float shx(float v) { static_assert(M >= 1 && M < 32, "swizzle xor mask");
    return __int_as_float(__builtin_amdgcn_ds_swizzle(__float_as_int(v), (M << 10) | 0x1F)); }
__device__ __forceinline__ float halves_sum(float v) {
    return __int_as_float(__builtin_amdgcn_readlane(__float_as_int(v), 0)) + __int_as_float(__builtin_amdgcn_readlane(__float_as_int(v), 32)); }
__device__ __forceinline__ float wave_sum(float v) {
    v += shx<1>(v); v += shx<2>(v); v += shx<4>(v); v += shx<8>(v); v += shx<16>(v);
    return halves_sum(v);
}
typedef __bf16 bf16x2_t __attribute__((ext_vector_type(2)));
__device__ __forceinline__ unsigned pk2(float lo, float hi) { const bf16x2_t v = __builtin_convertvector((f32x2){lo, hi}, bf16x2_t); return __builtin_bit_cast(unsigned, v); }
__device__ __forceinline__ unsigned f2bf(float f) { return pk2(f, f) & 0xffffu; }
__device__ __forceinline__ float bflo(unsigned w) { return __uint_as_float(w << 16); }
__device__ __forceinline__ float bfhi(unsigned w) { return __uint_as_float(w & 0xffff0000u); }
__device__ __forceinline__ float bf2f(bf16 b) { return __uint_as_float(((unsigned)b) << 16); }
__device__ __forceinline__ float fexp(float x) { return __builtin_amdgcn_exp2f(x * 1.4426950408889634f); }
__device__ __forceinline__ float flog(float x) { return __builtin_amdgcn_logf(x) * 0.6931471805599453f; }
__device__ __forceinline__ float frcp(float x) { return __builtin_amdgcn_rcpf(x); }
__device__ __forceinline__ float frsq(float x) { return __builtin_amdgcn_rsqf(x); }
__device__ __forceinline__ float sigmoid_(float x) { return frcp(1.f + fexp(-x)); }
__device__ __forceinline__ float silu_(float x) { return x * sigmoid_(x); }
__device__ __forceinline__ float gelu_(float x) { const float K1 = 2.f * 0.7978845608028654f * 1.4426950408889634f, K3 = K1 * 0.044715f;
    const float r = frcp(__builtin_amdgcn_exp2f(x * (K1 + K3 * (x * x))) + 1.f); return x - x * r; }

struct Frame {
    LAS unsigned char* lds; unsigned char* ws; const float* const* in; float* out;
    int wave, blk, G;
};
__device__ __forceinline__ int lane_now() { int l; asm volatile("v_mbcnt_lo_u32_b32 %0, -1, 0\n\tv_mbcnt_hi_u32_b32 %0, -1, %0" : "=v"(l)); return l; }
__device__ __forceinline__ int vblk(int b) { return 4 * (8 * (b & 7) + (b >> 5)) + ((b >> 3) & 3); }
#define PH_TID() int ph_wave = F.wave; asm volatile("" : "+s"(ph_wave)); const int lane = lane_now(); (void)lane; const int tid = (ph_wave << 6) | lane; (void)tid

struct ConvJob { const float* W; const float* g; bf16* WT; int K, N, k0, n0, mode; };
constexpr int TL_IN = 16 * 12, TL_OUT = 16 * 4, TL_G = 32 * 16 * 2, TL_D = 32 * 8 * 4, TL_PG = 16 * 4, TL_PE = 4 * 4;
constexpr int TL_LAYER = TL_IN + TL_OUT + 2 * TL_G + TL_D + TL_PG + TL_PE;
__device__ __forceinline__ ConvJob conv_job(const Frame& F, int it) {
    unsigned char* ws = F.ws; const int l = it / TL_LAYER; int r = it % TL_LAYER; ConvJob j;
    if (r < TL_IN) { j.W = F.in[3] + (size_t)l * D * DIN; j.g = F.in[2] + l * D; j.WT = (bf16*)(ws + WS_WIN) + (size_t)l * DIN * D; j.K = D; j.N = DIN; j.k0 = 64 * (r / 12); j.n0 = 256 * (r % 12); j.mode = 0; return j; } r -= TL_IN;
    if (r < TL_OUT) { j.W = F.in[10] + (size_t)l * D * D; j.g = nullptr; j.WT = (bf16*)(ws + WS_WOUT) + (size_t)l * D * D; j.K = D; j.N = D; j.k0 = 64 * (r / 4); j.n0 = 256 * (r % 4); j.mode = 0; return j; } r -= TL_OUT;
    if (r < 2 * TL_G) { const int up = r >= TL_G; if (up) r -= TL_G; const int e = r / 32, rr = r % 32;
        j.W = F.in[up ? 17 : 16] + (size_t)(l * NE + e) * D * DE; j.g = F.in[11] + l * D; j.WT = (bf16*)(ws + WS_WGU) + (size_t)(l * NE + e) * 1024 * 1024; j.K = D; j.N = DE; j.k0 = 64 * (rr / 2); j.n0 = 256 * (rr % 2); j.mode = 1 + up; return j; } r -= 2 * TL_G;
    if (r < TL_D) { const int e = r / 32, rr = r % 32; j.W = F.in[18] + (size_t)(l * NE + e) * DE * D; j.g = nullptr; j.WT = (bf16*)(ws + WS_WD) + (size_t)(l * NE + e) * D * DE; j.K = DE; j.N = D; j.k0 = 64 * (rr / 4); j.n0 = 256 * (rr % 4); j.mode = 0; return j; } r -= TL_D;
    if (r < TL_PG) { j.W = F.in[20] + (size_t)l * D * D; j.g = F.in[19] + l * D; j.WT = (bf16*)(ws + WS_WPG) + (size_t)l * D * D; j.K = D; j.N = D; j.k0 = 64 * (r / 4); j.n0 = 256 * (r % 4); j.mode = 0; return j; } r -= TL_PG;
    j.W = F.in[21] + (size_t)l * PD * D; j.g = nullptr; j.WT = (bf16*)(ws + WS_WPE) + (size_t)l * D * PD; j.K = PD; j.N = D; j.k0 = 64 * (r / 4); j.n0 = 256 * (r % 4); j.mode = 0; return j;
}
__device__ __forceinline__ void conv_load(const ConvJob& j, int wave, int lane, f32x4 (&v)[8]) {
#pragma unroll
    for (int i = 0; i < 8; ++i) { const int row = 8 * wave + i; v[i] = *(const f32x4*)(j.W + (size_t)(j.k0 + row) * j.N + j.n0 + 4 * lane); if (j.g) v[i] = v[i] * j.g[j.k0 + row]; }
}
constexpr int NDEF = 384, NDEF1 = 128, NBG = 3024;
constexpr int NREST = TL_LAYER - NDEF - NBG, NPRO = TL_LAYER + 3 * NREST;
__device__ __forceinline__ int pro_tile(int f) { if (NREST == 0 || f < TL_LAYER) return f; f -= TL_LAYER; const int l = 1 + f / (NREST ? NREST : 1); return l * TL_LAYER + NDEF + NBG + f % (NREST ? NREST : 1); }
template <class M> __device__ __forceinline__ void conv_run(const Frame& F, int first, int stride, int count, M tile_of) {
    PH_TID();
    LAS float* tile = (LAS float*)F.lds;
    const int wave = ph_wave;
    int f = first; f32x4 v[8]; ConvJob cur{}, nxt{};
    if (f < count) { cur = conv_job(F, tile_of(f)); conv_load(cur, wave, lane, v); }
    while (f < count) {
#pragma unroll
        for (int i = 0; i < 8; ++i) { LAS float* d = tile + (8 * wave + i) * 257 + 4 * lane; d[0] = v[i].x; d[1] = v[i].y; d[2] = v[i].z; d[3] = v[i].w; }
        __syncthreads();
        const int fn = f + stride; if (fn < count) { nxt = conv_job(F, tile_of(fn)); conv_load(nxt, wave, lane, v); }
#pragma unroll
        for (int q = 0; q < 4; ++q) { const int nn = 32 * wave + 8 * q + (lane >> 3), c = lane & 7; const LAS float* sp = tile + (8 * c) * 257 + nn;
            u32x4 o; o.x = pk2(sp[0 * 257], sp[1 * 257]); o.y = pk2(sp[2 * 257], sp[3 * 257]); o.z = pk2(sp[4 * 257], sp[5 * 257]); o.w = pk2(sp[6 * 257], sp[7 * 257]);
            const int n = cur.n0 + nn; const int drow = cur.mode == 0 ? n : ((n >> 7) * 256 + (n & 127) + (cur.mode == 2 ? 128 : 0));
            *(u32x4*)(cur.WT + (size_t)drow * cur.K + cur.k0 + 8 * c) = o; }
        __syncthreads();
        cur = nxt; f = fn;
    }
}
__device__ __forceinline__ void conv_deferred(const Frame& F, int lnext, int r0, int r1, int first, int idle) {
    if (lnext >= DEPTH || F.blk < first) return;
    conv_run(F, F.blk - first, idle, r1 - r0, [=](int f) { return lnext * TL_LAYER + r0 + f; });
}
__device__ __forceinline__ void phase_prologue(const Frame& F) {
    PH_TID();
    unsigned char* ws = F.ws;
    conv_run(F, F.blk, F.G, NPRO, [](int f) { return pro_tile(f); });
    { const f32x4* src = (const f32x4*)F.in[1]; u32x4* dst = (u32x4*)(ws + WS_PB); const size_t n8 = (size_t)DEPTH * T * PD / 8;
      for (size_t i = (size_t)F.blk * NTHR + tid; i < n8; i += (size_t)F.G * NTHR) { const f32x4 a = src[2 * i], b = src[2 * i + 1]; u32x4 o; o.x = pk2(a.x, a.y); o.y = pk2(a.z, a.w); o.z = pk2(b.x, b.y); o.w = pk2(b.z, b.w); dst[i] = o; } }
    { float* wrt = (float*)(ws + MS_WRT);
      for (int i = F.blk * NTHR + tid; i < DEPTH * 36 * D; i += F.G * NTHR) { const int k = i % D, n = (i / D) % 36, l = i / (36 * D);
          const float w = n < 4 ? F.in[12][((size_t)l * D + k) * 4 + n] : F.in[14][((size_t)l * D + k) * NE + (n - 4)]; wrt[i] = w * F.in[11][l * D + k]; } }
    { bf16* wb = (bf16*)(ws + MS_SGUW); for (int i = F.blk * NTHR + tid; i < DEPTH * 4 * 128 * 128; i += F.G * NTHR) { const int tc = (i >> 7) & 127, sp = i & 127; wb[i] = sp <= tc ? (bf16)f2bf(F.in[8][i]) : (bf16)0; } }
    if (F.blk == 0 && tid < DREC) { const int c = tid; float v[DEPTH], m = -1e30f;
#pragma unroll
        for (int l = 0; l < DEPTH; ++l) { v[l] = F.in[4][l * DREC + c]; m = fmaxf(m, v[l]); }
        float s = 0.f;
#pragma unroll
        for (int l = 0; l < DEPTH; ++l) { v[l] = fexp(v[l] - m); s += v[l]; }
        float* lb = (float*)(ws + MS_LB); float acc = 0.f;
#pragma unroll
        for (int l = 0; l < DEPTH; ++l) { if (l > 0) acc += v[l] / s; lb[l * DREC + c] = acc; } }
}

__device__ __forceinline__ void load_row(const float* row, int lane, f32x4 (&v)[4]) { const f32x4* r = (const f32x4*)row + lane;
#pragma unroll
    for (int j = 0; j < 4; ++j) v[j] = r[64 * j]; }
__device__ __forceinline__ void load_row_bf(const bf16* row, int lane, f32x4 (&v)[4]) { const u32x2* r = (const u32x2*)row + lane;
#pragma unroll
    for (int j = 0; j < 4; ++j) { const u32x2 x = r[64 * j]; v[j] = (f32x4){bflo(x.x), bfhi(x.x), bflo(x.y), bfhi(x.y)}; } }
__device__ __forceinline__ float row_sumsq(const f32x4 (&v)[4]) { float s = 0.f;
#pragma unroll
    for (int j = 0; j < 4; ++j) s += (v[j].x * v[j].x + v[j].y * v[j].y) + (v[j].z * v[j].z + v[j].w * v[j].w);
    return wave_sum(s); }
__device__ __forceinline__ void store_row_bf16(bf16* orow, int lane, const f32x4 (&v)[4], float s) { u32x2* o = (u32x2*)orow + lane;
#pragma unroll
    for (int j = 0; j < 4; ++j) { u32x2 w; w.x = pk2(v[j].x * s, v[j].y * s); w.y = pk2(v[j].z * s, v[j].w * s); o[64 * j] = w; } }

__device__ __forceinline__ void phase_norm1(const Frame& F, int l) {
    PH_TID();
    float* rstd1 = (float*)(F.ws + MS_RSTD1); bf16* h = (bf16*)(F.ws + WS_H); const float* x = F.in[0];
    const int gw = F.blk * NWAVES + ph_wave, NGW = F.G * NWAVES;
    for (int t = gw; t < T; t += NGW) { f32x4 v[4];
        if (l == 0) { load_row(x + (size_t)t * D, lane, v); store_row_bf16(h + (size_t)t * D, lane, v, 1.f); } else load_row_bf(h + (size_t)t * D, lane, v);
        const float rstd = frsq(row_sumsq(v) * (1.f / D) + EPS); if (lane == 0) rstd1[t] = rstd; }
}
__device__ __forceinline__ float bfly8(const float (&r)[8], int lane) {
    const bool b2 = lane & 4, b1 = lane & 2, b0 = lane & 1; float a[4], c[2];
#pragma unroll
    for (int i = 0; i < 4; ++i) { const float keep = b2 ? r[i + 4] : r[i], send = b2 ? r[i] : r[i + 4]; a[i] = keep + shx<4>(send); }
#pragma unroll
    for (int i = 0; i < 2; ++i) { const float keep = b1 ? a[i + 2] : a[i], send = b1 ? a[i] : a[i + 2]; c[i] = keep + shx<2>(send); }
    const float keep = b0 ? c[1] : c[0], send = b0 ? c[0] : c[1]; float d = keep + shx<1>(send);
    d += shx<8>(d); d += shx<16>(d);
    return d + __int_as_float(__builtin_amdgcn_ds_bpermute((lane ^ 32) << 2, __float_as_int(d)));
}
__device__ __forceinline__ void phase_norm2(const Frame& F, int l) {
    PH_TID();
    unsigned char* ws = F.ws;
    unsigned* hist = (unsigned*)(F.lds + MISC_OFF + 256);
    if (tid < 32) hist[tid] = 0u;
    __syncthreads();
    const bf16* h = (const bf16*)(ws + WS_H); bf16* XN = (bf16*)(ws + WS_XN);
    const float* WrT = (const float*)(ws + MS_WRT) + (size_t)l * 36 * D;
    const float* b_rg = F.in[13] + l * 4; const float* b_re = F.in[15] + l * NE;
    int* tok_e = (int*)(ws + MS_TOKE); float* tok_w = (float*)(ws + MS_TOKW); unsigned* sinfo = (unsigned*)(ws + MS_SINFO);
    const int RPB = T / F.G, RPW = RPB / NWAVES;
    for (int i0 = 0; i0 < RPW; i0 += 8) {
        const int t0 = F.blk * RPB + ph_wave * RPW + i0;
        f32x4 v[8][4]; float ss[8];
#pragma unroll
        for (int r = 0; r < 8; ++r) { load_row_bf(h + (size_t)(t0 + r) * D, lane, v[r]); float q = 0.f;
#pragma unroll
            for (int j = 0; j < 4; ++j) q += (v[r][j].x * v[r][j].x + v[r][j].y * v[r][j].y) + (v[r][j].z * v[r][j].z + v[r][j].w * v[r][j].w);
            ss[r] = q; }
        const float rstd_mine = frsq(bfly8(ss, lane) * (1.f / D) + EPS);
        if (lane < 8) ((float*)(ws + MS_RSTD2))[t0 + lane] = rstd_mine;
        LAS float* lgw = (LAS float*)(F.lds + 4096) + ph_wave * (36 * 8);
#pragma unroll 2
        for (int n = 0; n < 36; ++n) { const f32x4* wr = (const f32x4*)(WrT + (size_t)n * D) + lane; const f32x4 w0 = wr[0], w1 = wr[64], w2 = wr[128], w3 = wr[192]; float pr[8];
#pragma unroll
            for (int r = 0; r < 8; ++r) pr[r] = ((v[r][0].x * w0.x + v[r][0].y * w0.y) + (v[r][0].z * w0.z + v[r][0].w * w0.w)) + ((v[r][1].x * w1.x + v[r][1].y * w1.y) + (v[r][1].z * w1.z + v[r][1].w * w1.w))
                                                 + ((v[r][2].x * w2.x + v[r][2].y * w2.y) + (v[r][2].z * w2.z + v[r][2].w * w2.w)) + ((v[r][3].x * w3.x + v[r][3].y * w3.y) + (v[r][3].z * w3.z + v[r][3].w * w3.w));
            const float val = bfly8(pr, lane) * rstd_mine; if (lane < 8) lgw[n * 8 + lane] = val; }
        const int row = lane & 7;
        float lg4[4], lgb[4];
#pragma unroll
        for (int j = 0; j < 4; ++j) { lg4[j] = lgw[j * 8 + row]; lgb[j] = lg4[j] + b_rg[j]; }
        int gs = 0; float gm = lgb[0];
#pragma unroll
        for (int j = 1; j < 4; ++j) if (lgb[j] > gm) { gm = lgb[j]; gs = j; }
        float mx = fmaxf(fmaxf(lg4[0], lg4[1]), fmaxf(lg4[2], lg4[3])), se = 0.f, lsel = lg4[0];
#pragma unroll
        for (int j = 0; j < 4; ++j) { se += fexp(lg4[j] - mx); if (j == gs) lsel = lg4[j]; }
        const float g_w = fexp(lsel - mx) * frcp(se);
        float le[8], leb[8];
#pragma unroll
        for (int j = 0; j < 8; ++j) { le[j] = lgw[(4 + gs * 8 + j) * 8 + row]; leb[j] = le[j] + b_re[gs * 8 + j]; }
        int s0 = 0; float m0 = leb[0];
#pragma unroll
        for (int j = 1; j < 8; ++j) if (leb[j] > m0) { m0 = leb[j]; s0 = j; }
        int s1 = -1; float m1 = -3.0e38f;
#pragma unroll
        for (int j = 0; j < 8; ++j) if (j != s0 && leb[j] > m1) { m1 = leb[j]; s1 = j; }
        if (s1 < 0) s1 = (s0 == 0) ? 1 : 0;
        float la = le[0], lb2 = le[0];
#pragma unroll
        for (int j = 1; j < 8; ++j) { if (j == s0) la = le[j]; if (j == s1) lb2 = le[j]; }
        const float wa = frcp(1.f + fexp(lb2 - la)), wb = 1.f - wa;
        if (lane < 8) { const int t = t0 + lane;
            const int e0 = gs * 8 + s0, e1 = gs * 8 + s1;
            const unsigned r0 = atomicAdd(&hist[e0], 1u), r1 = atomicAdd(&hist[e1], 1u);
            tok_e[2 * t] = e0; tok_e[2 * t + 1] = e1; tok_w[2 * t] = g_w * wa; tok_w[2 * t + 1] = g_w * wb;
            sinfo[2 * t] = ((unsigned)F.blk << 16) | r0; sinfo[2 * t + 1] = ((unsigned)F.blk << 16) | r1;
        }
    }
    __syncthreads();
    if (tid < 32) { unsigned* cnt = (unsigned*)(ws + WS_CTL) + CW_CNT + l * 32;
        const unsigned base = __hip_atomic_fetch_add(cnt + tid, hist[tid], __ATOMIC_RELAXED, __HIP_MEMORY_SCOPE_AGENT);
        ((unsigned*)(ws + MS_BLKBASE))[F.blk * 32 + tid] = base; }
}
__device__ __forceinline__ void phase_gather(const Frame& F, int l) {
    PH_TID();
    unsigned char* ws = F.ws;
    int* ps = (int*)(F.lds + MISC_OFF + 512);
    if (tid == 0) { unsigned* cnt = (unsigned*)(ws + WS_CTL) + CW_CNT + l * 32; int* blke = (int*)(ws + MS_BLKE) + l * 256; int acc = 0;
        for (int e = 0; e < NE; ++e) { const int c = (int)__hip_atomic_load(cnt + e, __ATOMIC_RELAXED, __HIP_MEMORY_SCOPE_AGENT); ps[e] = acc; const int pad = (c + RB - 1) / RB * RB;
            if (F.blk == 0) for (int rb = acc / RB; rb < (acc + pad) / RB; ++rb) blke[rb] = e;
            acc += pad; }
        if (F.blk == 0) blke[255] = acc / RB; }
    __syncthreads();
    const int* tok_e = (const int*)(ws + MS_TOKE); const unsigned* sinfo = (const unsigned*)(ws + MS_SINFO); const unsigned* bbase = (const unsigned*)(ws + MS_BLKBASE);
    int* sdest = (int*)(ws + MS_SDEST); const bf16* hres = (const bf16*)(ws + WS_H); const float* rstd2 = (const float*)(ws + MS_RSTD2); bf16* XB = (bf16*)(ws + WS_XB);
    const int gw = F.blk * NWAVES + ph_wave, NGW = F.G * NWAVES;
    for (int t = gw; t < T; t += NGW) {
        const u32x4* src = (const u32x4*)(hres + (size_t)t * D) + lane; const u32x4 ha = src[0], hb = src[64]; const float rs = rstd2[t];
        u32x4 a, b;
        a.x = pk2(bflo(ha.x) * rs, bfhi(ha.x) * rs); a.y = pk2(bflo(ha.y) * rs, bfhi(ha.y) * rs); a.z = pk2(bflo(ha.z) * rs, bfhi(ha.z) * rs); a.w = pk2(bflo(ha.w) * rs, bfhi(ha.w) * rs);
        b.x = pk2(bflo(hb.x) * rs, bfhi(hb.x) * rs); b.y = pk2(bflo(hb.y) * rs, bfhi(hb.y) * rs); b.z = pk2(bflo(hb.z) * rs, bfhi(hb.z) * rs); b.w = pk2(bflo(hb.w) * rs, bfhi(hb.w) * rs);
#pragma unroll
        for (int j = 0; j < 2; ++j) { const int e = tok_e[2 * t + j]; const unsigned info = sinfo[2 * t + j];
            const int dest = ps[e] + (int)bbase[(info >> 16) * 32 + e] + (int)(info & 0xffffu);
            if (lane == 0) sdest[2 * t + j] = dest;
            u32x4* dst = (u32x4*)(XB + (size_t)dest * D) + lane; dst[0] = a; dst[64] = b; }
    }
}
__device__ __forceinline__ void phase_combine(const Frame& F, int l) {
    PH_TID();
    unsigned char* ws = F.ws;
    bf16* h = (bf16*)(ws + WS_H); bf16* XN = (bf16*)(ws + WS_XN); const bf16* Y = (const bf16*)(ws + WS_Y); const bf16* PE = (const bf16*)(ws + WS_PE) + (size_t)l * T * D;
    const int* sdest = (const int*)(ws + MS_SDEST); const float* tok_w = (const float*)(ws + MS_TOKW); float* rstd_pe = (float*)(ws + MS_RSTDPE);
    const int gw = F.blk * NWAVES + ph_wave, NGW = F.G * NWAVES;
    struct Rows { u32x2 h[4], y0[4], y1[4], pe[4]; };
    auto fetch = [&](int t, int d0, int d1, Rows& r) {
        const u32x2* hp = (const u32x2*)(h + (size_t)t * D) + lane; const u32x2* y0 = (const u32x2*)(Y + (size_t)d0 * D) + lane; const u32x2* y1 = (const u32x2*)(Y + (size_t)d1 * D) + lane; const u32x2* pe = (const u32x2*)(PE + (size_t)t * D) + lane;
#pragma unroll
        for (int j = 0; j < 4; ++j) { r.h[j] = hp[64 * j]; r.y0[j] = y0[64 * j]; r.y1[j] = y1[64 * j]; r.pe[j] = pe[64 * j]; } };
    int t = gw; if (t >= T) return;
    Rows cur; int d0n = 0, d1n = 0; float w0 = tok_w[2 * t], w1 = tok_w[2 * t + 1], w0n = 0.f, w1n = 0.f;
    fetch(t, sdest[2 * t], sdest[2 * t + 1], cur);
    if (t + NGW < T) { d0n = sdest[2 * (t + NGW)]; d1n = sdest[2 * (t + NGW) + 1]; w0n = tok_w[2 * (t + NGW)]; w1n = tok_w[2 * (t + NGW) + 1]; }
    for (; t < T; t += NGW) {
        Rows nxt = cur; const float w0c = w0, w1c = w1; const bool more = t + NGW < T;
        if (more) { fetch(t + NGW, d0n, d1n, nxt); w0 = w0n; w1 = w1n;
            if (t + 2 * NGW < T) { d0n = sdest[2 * (t + 2 * NGW)]; d1n = sdest[2 * (t + 2 * NGW) + 1]; w0n = tok_w[2 * (t + 2 * NGW)]; w1n = tok_w[2 * (t + 2 * NGW) + 1]; } }
        f32x4 v[4]; float sp = 0.f;
#pragma unroll
        for (int j = 0; j < 4; ++j) { const u32x2 x = cur.h[j], a = cur.y0[j], b = cur.y1[j], c = cur.pe[j];
            v[j] = (f32x4){bflo(x.x) + (w0c * bflo(a.x) + w1c * bflo(b.x)), bfhi(x.x) + (w0c * bfhi(a.x) + w1c * bfhi(b.x)), bflo(x.y) + (w0c * bflo(a.y) + w1c * bflo(b.y)), bfhi(x.y) + (w0c * bfhi(a.y) + w1c * bfhi(b.y))};
            const float p0 = bflo(c.x), p1 = bfhi(c.x), p2 = bflo(c.y), p3 = bfhi(c.y); sp += (p0 * p0 + p1 * p1) + (p2 * p2 + p3 * p3); }
        store_row_bf16(h + (size_t)t * D, lane, v, 1.f);
        const float rstd = frsq(row_sumsq(v) * (1.f / D) + EPS); store_row_bf16(XN + (size_t)t * D, lane, v, rstd);
        sp = wave_sum(sp); if (lane == 0) rstd_pe[t] = frsq(sp * (1.f / D) + EPS);
        cur = nxt;
    }
}
__device__ __forceinline__ void phase_final(const Frame& F) {
    PH_TID();
    const bf16* h = (const bf16*)(F.ws + WS_H); const float* nf = F.in[23];
    const int gw = F.blk * NWAVES + ph_wave, NGW = F.G * NWAVES;
    for (int t = gw; t < T; t += NGW) { f32x4 v[4]; load_row_bf(h + (size_t)t * D, lane, v); const float rstd = frsq(row_sumsq(v) * (1.f / D) + EPS);
        f32x4* o = (f32x4*)(F.out + (size_t)t * D) + lane; const f32x4* g = (const f32x4*)nf + lane;
#pragma unroll
        for (int j = 0; j < 4; ++j) o[64 * j] = v[j] * rstd * g[64 * j]; }
}


namespace pg8 {
constexpr int BM = 256, BK = 64, HALF = 128, HTB = HALF * BK * 2, STAGE_BYTES = 8 * HTB, NXCD = 8, WGM = 8;
__host__ __device__ __forceinline__ int lds_byte(int r, int c) { const int st = (r >> 4) * 2 + (c >> 5), rr = r & 15, cc = c & 31, ob = rr * 64 + cc * 2; return st * 1024 + (ob ^ (((ob >> 9) & 1) << 5)); }
__host__ __device__ __forceinline__ void stage_rc(int b, int& R, int& C) { const int st = b / 1024, sb = b % 1024, swz = sb ^ (((sb >> 9) & 1) << 5); R = (st >> 1) * 16 + swz / 64; C = (st & 1) * 32 + (swz % 64) / 2; }
__host__ __device__ __forceinline__ int perm32(int rho) { const int n = rho >> 4, i = rho & 15; return 8 * (i >> 2) + 4 * n + (i & 3); }
struct Unit { int pm, pn; const char* A; const char* B; };
__device__ __forceinline__ void static_map(int wgid, int nM, int nN, int& pm, int& pn) {
    const int nwg = nM * nN; { const int q = nwg / NXCD, r = nwg % NXCD, xcd = wgid % NXCD, off = wgid / NXCD; wgid = (xcd < r ? xcd * (q + 1) : r * (q + 1) + (xcd - r) * q) + off; }
    const int nig = WGM * nN, gid = wgid / nig, fm = gid * WGM, gsz = (nM - fm) < WGM ? (nM - fm) : WGM;
    pm = fm + ((wgid % nig) % gsz); pn = (wgid % nig) / gsz;
}
struct DenseOrder { static constexpr bool DEPS = false;
    const char* A; const char* Bt; int nM, nN, nL, G, c; size_t tstep;
    __device__ void init(const void* A_, const void* Bt_, int M, int N, int K, int nL_, int G_, int c_) { A = (const char*)A_; Bt = (const char*)Bt_; nM = M / BM; nN = N / BM; nL = nL_; G = G_; c = c_; tstep = (size_t)BM * K * 2; }
    __device__ bool next(int i, Unit& u) const { const long L = (long)i * G + c; const int per = nM * nN; if (L >= (long)per * nL) return false;
        const int l = (int)(L / per); int pm, pn; static_map((int)(L % per), nM, nN, pm, pn); u.pm = l * nM + pm; u.pn = pn; u.A = A + (size_t)u.pm * tstep; u.B = Bt + (size_t)(l * nN + pn) * tstep; return true; }
};
struct MoeOrder { static constexpr bool DEPS = false;
    const char* A; const char* W; const int* blke; int nrb, nN, G, c, e0, e1, e2; size_t a_tstep, w_estride, b_tstep;
    __device__ void init(const void* A_, const void* W_, const int* blke_, int K, int nN_, size_t w_estride_bytes, int G_, int c_) { A = (const char*)A_; W = (const char*)W_; blke = blke_; nrb = __builtin_amdgcn_readfirstlane(blke_[255]); nN = nN_; G = G_; c = c_;
        a_tstep = (size_t)BM * K * 2; b_tstep = a_tstep; w_estride = w_estride_bytes;
        const int r0 = c / nN, r1 = (G + c) / nN, r2 = (2 * G + c) / nN; const int x0 = blke_[r0 < 255 ? r0 : 254], x1 = blke_[r1 < 255 ? r1 : 254], x2 = blke_[r2 < 255 ? r2 : 254];
        e0 = __builtin_amdgcn_readfirstlane(x0); e1 = __builtin_amdgcn_readfirstlane(x1); e2 = __builtin_amdgcn_readfirstlane(x2); }
    __device__ bool next(int i, Unit& u) const { const long L = (long)i * G + c; if (L >= (long)nrb * nN) return false; const int rb = (int)(L / nN), pn = (int)(L % nN);
        const int ex = i == 0 ? e0 : i == 1 ? e1 : i == 2 ? e2 : __builtin_amdgcn_readfirstlane(blke[rb]);
        u.pm = rb; u.pn = pn; u.A = A + (size_t)rb * a_tstep; u.B = W + (size_t)ex * w_estride + (size_t)pn * b_tstep; return true; }
};
__device__ __forceinline__ unsigned ag_ld(const unsigned* p)        { return __hip_atomic_load(p, __ATOMIC_RELAXED, __HIP_MEMORY_SCOPE_AGENT); }
__device__ __forceinline__ unsigned ag_add(unsigned* p, unsigned v) { return __hip_atomic_fetch_add(p, v, __ATOMIC_RELAXED, __HIP_MEMORY_SCOPE_AGENT); }
struct MoeDepOrder { static constexpr bool DEPS = true;
    const char* A; const char* W; const int* blke; const unsigned* done; int nrb, nN, G, c, e0, e1, e2; size_t a_tstep, w_estride, b_tstep;
    __device__ void init(const void* A_, const void* W_, const int* blke_, const unsigned* done_, int K, int nN_, size_t w_estride_bytes, int G_, int c_) { A = (const char*)A_; W = (const char*)W_; blke = blke_; done = done_;
        nrb = __builtin_amdgcn_readfirstlane(blke_[255]); nN = nN_; G = G_; c = c_; a_tstep = (size_t)BM * K * 2; b_tstep = a_tstep; w_estride = w_estride_bytes;
        const int r0 = c / nN, r1 = (G + c) / nN, r2 = (2 * G + c) / nN; const int x0 = blke_[r0 < 255 ? r0 : 254], x1 = blke_[r1 < 255 ? r1 : 254], x2 = blke_[r2 < 255 ? r2 : 254];
        e0 = __builtin_amdgcn_readfirstlane(x0); e1 = __builtin_amdgcn_readfirstlane(x1); e2 = __builtin_amdgcn_readfirstlane(x2); }
    __device__ bool next(int i, Unit& u) const { const long L = (long)i * G + c; if (L >= (long)nrb * nN) return false; const int rb = (int)(L / nN), pn = (int)(L % nN);
        const int ex = i == 0 ? e0 : i == 1 ? e1 : i == 2 ? e2 : __builtin_amdgcn_readfirstlane(blke[rb]);
        u.pm = rb; u.pn = pn; u.A = A + (size_t)rb * a_tstep; u.B = W + (size_t)ex * w_estride + (size_t)pn * b_tstep; return true; }
    __device__ void wait(const Unit& u, int wid) const {
        if (wid == 0 && lane_now() == 0) { while (ag_ld(done + u.pm) < 4u) __builtin_amdgcn_s_sleep(1); __builtin_amdgcn_fence(__ATOMIC_ACQUIRE, "agent"); } }
};
struct RangeOrder { static constexpr bool DEPS = false;
    const char* A; const char* Bt; int nM, nN, j0, n; size_t tstep;
    __device__ void init(const void* A_, const void* Bt_, int M, int N, int K, int j0_, int n_) { A = (const char*)A_; Bt = (const char*)Bt_; nM = M / BM; nN = N / BM; j0 = j0_; n = n_; tstep = (size_t)BM * K * 2; }
    __device__ bool next(int i, Unit& u) const { if (i >= n) return false; int pm, pn; static_map(j0 + i, nM, nN, pm, pn); u.pm = pm; u.pn = pn; u.A = A + (size_t)pm * tstep; u.B = Bt + (size_t)pn * tstep; return true; }
};
__device__ __forceinline__ unsigned cvt_pk_bf16(float lo, float hi) { return pk2(lo, hi); }
struct EpiBf16 { static constexpr bool PERM = true, ACC_INIT = false, SIGNAL = false; bf16* O; int ldc;
    __device__ __forceinline__ void operator()(const f32x4 (&acc)[2][2][4][2], const Unit& u, int wr, int wc, int, int) const {
        const int t2 = lane_now(), fr = t2 & 15, fq = t2 >> 4;
        const int row0 = u.pm * BM + wr * 64 + fr, col0 = u.pn * BM + wc * 32 + 8 * fq;
#pragma unroll
        for (int ai = 0; ai < 2; ++ai)
#pragma unroll
            for (int m = 0; m < 4; ++m) { bf16* rowp = O + (size_t)(row0 + ai * HALF + m * 16) * ldc + col0;
#pragma unroll
                for (int bj = 0; bj < 2; ++bj) { const f32x4 v0 = acc[ai][bj][m][0], v1 = acc[ai][bj][m][1];
                    u32x4 w; w.x = cvt_pk_bf16(v0[0], v0[1]); w.y = cvt_pk_bf16(v0[2], v0[3]); w.z = cvt_pk_bf16(v1[0], v1[1]); w.w = cvt_pk_bf16(v1[2], v1[3]);
                    *(u32x4*)(rowp + bj * HALF) = w; } }
    } };
struct EpiBf16Rs { static constexpr bool PERM = true, ACC_INIT = false, SIGNAL = false; bf16* O; int ldc; const float* rs; const float* part;
    __device__ __forceinline__ void operator()(const f32x4 (&acc)[2][2][4][2], const Unit& u, int wr, int wc, int, int) const {
        const int t2 = lane_now(), fr = t2 & 15, fq = t2 >> 4;
        const int row0 = u.pm * BM + wr * 64 + fr, col0 = u.pn * BM + wc * 32 + 8 * fq;
#pragma unroll
        for (int ai = 0; ai < 2; ++ai)
#pragma unroll
            for (int m = 0; m < 4; ++m) { const int row = row0 + ai * HALF + m * 16; const float r = part ? frsq(((part[row] + part[T + row]) + (part[2 * T + row] + part[3 * T + row])) * (1.f / D) + EPS) : rs[row]; bf16* rowp = O + (size_t)row * ldc + col0;
#pragma unroll
                for (int bj = 0; bj < 2; ++bj) { const f32x4 v0 = acc[ai][bj][m][0] * r, v1 = acc[ai][bj][m][1] * r;
                    u32x4 w; w.x = cvt_pk_bf16(v0[0], v0[1]); w.y = cvt_pk_bf16(v0[2], v0[3]); w.z = cvt_pk_bf16(v1[0], v1[1]); w.w = cvt_pk_bf16(v1[2], v1[3]);
                    *(u32x4*)(rowp + bj * HALF) = w; } }
    } };
struct EpiResid { static constexpr bool PERM = true, ACC_INIT = true, SIGNAL = false; bf16* h;
    __device__ __forceinline__ void init(f32x4 (&acc)[2][2][4][2], const Unit& u, int wr, int wc, int fr, int fq) const {
        const int row0 = u.pm * BM + wr * 64 + fr, col0 = u.pn * BM + wc * 32 + 8 * fq;
#pragma unroll
        for (int ai = 0; ai < 2; ++ai)
#pragma unroll
            for (int m = 0; m < 4; ++m) { const bf16* rowp = h + (size_t)(row0 + ai * HALF + m * 16) * D + col0;
#pragma unroll
                for (int bj = 0; bj < 2; ++bj) { const u32x4 x = *(const u32x4*)(rowp + bj * HALF);
                    acc[ai][bj][m][0] = (f32x4){bflo(x.x), bfhi(x.x), bflo(x.y), bfhi(x.y)}; acc[ai][bj][m][1] = (f32x4){bflo(x.z), bfhi(x.z), bflo(x.w), bfhi(x.w)}; } }
    }
    __device__ __forceinline__ void operator()(const f32x4 (&acc)[2][2][4][2], const Unit& u, int wr, int wc, int fr, int fq) const {
        asm volatile("" : "+v"(fr), "+v"(fq));
        const int row0 = u.pm * BM + wr * 64 + fr, col0 = u.pn * BM + wc * 32 + 8 * fq;
#pragma unroll
        for (int ai = 0; ai < 2; ++ai)
#pragma unroll
            for (int m = 0; m < 4; ++m) { bf16* rowp = h + (size_t)(row0 + ai * HALF + m * 16) * D + col0;
#pragma unroll
                for (int bj = 0; bj < 2; ++bj) { const f32x4 v0 = acc[ai][bj][m][0], v1 = acc[ai][bj][m][1];
                    u32x4 w; w.x = cvt_pk_bf16(v0[0], v0[1]); w.y = cvt_pk_bf16(v0[2], v0[3]); w.z = cvt_pk_bf16(v1[0], v1[1]); w.w = cvt_pk_bf16(v1[2], v1[3]);
                    *(u32x4*)(rowp + bj * HALF) = w; } }
    } };
struct EpiGateUp { static constexpr bool PERM = true, ACC_INIT = false, SIGNAL = false; bf16* H;
    __device__ __forceinline__ void operator()(const f32x4 (&acc)[2][2][4][2], const Unit& u, int wr, int wc, int, int) const {
        const int t2 = lane_now(), fr = t2 & 15, fq = t2 >> 4;
        const int row0 = u.pm * BM + wr * 64 + fr, col0 = u.pn * HALF + wc * 32 + 8 * fq;
#pragma unroll
        for (int ai = 0; ai < 2; ++ai)
#pragma unroll
            for (int m = 0; m < 4; ++m) { bf16* rowp = H + (size_t)(row0 + ai * HALF + m * 16) * DE + col0; float v[8];
#pragma unroll
                for (int n = 0; n < 2; ++n)
#pragma unroll
                    for (int j = 0; j < 4; ++j) v[4 * n + j] = silu_(acc[ai][0][m][n][j]) * acc[ai][1][m][n][j];
                u32x4 w; w.x = cvt_pk_bf16(v[0], v[1]); w.y = cvt_pk_bf16(v[2], v[3]); w.z = cvt_pk_bf16(v[4], v[5]); w.w = cvt_pk_bf16(v[6], v[7]);
                *(u32x4*)rowp = w; }
    } };
struct EpiGateUpPub { static constexpr bool PERM = true, ACC_INIT = false, SIGNAL = true; __amdgpu_buffer_rsrc_t rs; unsigned* done;
    __device__ __forceinline__ void operator()(const f32x4 (&acc)[2][2][4][2], const Unit& u, int wr, int wc, int fr, int fq) const {
        asm volatile("" : "+v"(fr), "+v"(fq));
        const int row0 = u.pm * BM + wr * 64 + fr, col0 = u.pn * HALF + wc * 32 + 8 * fq;
#pragma unroll
        for (int ai = 0; ai < 2; ++ai)
#pragma unroll
            for (int m = 0; m < 4; ++m) { const unsigned off = (unsigned)(((row0 + ai * HALF + m * 16) * DE + col0) * 2); float v[8];
#pragma unroll
                for (int n = 0; n < 2; ++n)
#pragma unroll
                    for (int j = 0; j < 4; ++j) v[4 * n + j] = silu_(acc[ai][0][m][n][j]) * acc[ai][1][m][n][j];
                u32x4 w; w.x = cvt_pk_bf16(v[0], v[1]); w.y = cvt_pk_bf16(v[2], v[3]); w.z = cvt_pk_bf16(v[4], v[5]); w.w = cvt_pk_bf16(v[6], v[7]);
                __builtin_amdgcn_raw_buffer_store_b128(w, rs, off, 0, 16); }
    }
    __device__ __forceinline__ void signal(const Unit& u) const { (void)ag_add(done + u.pm, 1u); }
};
struct EpiPG { static constexpr bool PERM = true, ACC_INIT = false, SIGNAL = false; bf16* h; const bf16* PE; const float* rstd_pe; const float* norm_pe; LAS float* red; float* part;
    __device__ __forceinline__ void operator()(const f32x4 (&acc)[2][2][4][2], const Unit& u, int wr, int wc, int, int) const {
        const int t2 = lane_now(), fr = t2 & 15, fq = t2 >> 4;
        const int row0 = u.pm * BM + wr * 64 + fr, col0 = u.pn * BM + wc * 32 + 8 * fq;
        f32x4 nv[2][2];
#pragma unroll
        for (int bj = 0; bj < 2; ++bj)
#pragma unroll
            for (int n = 0; n < 2; ++n) nv[bj][n] = *(const f32x4*)(norm_pe + col0 + bj * HALF + 4 * n);
        float sq[2][4];
#pragma unroll
        for (int ai = 0; ai < 2; ++ai)
#pragma unroll
        for (int mh = 0; mh < 2; ++mh) {
            u32x4 pe[4][2], hx[4][2]; float rs[4];
#pragma unroll
            for (int m = 2 * mh; m < 2 * mh + 2; ++m) { const int row = row0 + ai * HALF + m * 16; rs[m] = rstd_pe[row];
#pragma unroll
                for (int bj = 0; bj < 2; ++bj) { const size_t o = (size_t)row * D + col0 + bj * HALF; pe[m][bj] = *(const u32x4*)(PE + o); hx[m][bj] = *(const u32x4*)(h + o); } }
#pragma unroll
            for (int m = 2 * mh; m < 2 * mh + 2; ++m) { const int row = row0 + ai * HALF + m * 16; float q = 0.f;
#pragma unroll
                for (int bj = 0; bj < 2; ++bj) { const size_t o = (size_t)row * D + col0 + bj * HALF; const u32x4 p = pe[m][bj], x = hx[m][bj];
                    f32x4 h0 = (f32x4){bflo(x.x), bfhi(x.x), bflo(x.y), bfhi(x.y)}, h1 = (f32x4){bflo(x.z), bfhi(x.z), bflo(x.w), bfhi(x.w)}; const f32x4 a0 = acc[ai][bj][m][0], a1 = acc[ai][bj][m][1];
                    const f32x4 e0 = (f32x4){bflo(p.x), bfhi(p.x), bflo(p.y), bfhi(p.y)} * rs[m] * nv[bj][0], e1 = (f32x4){bflo(p.z), bfhi(p.z), bflo(p.w), bfhi(p.w)} * rs[m] * nv[bj][1];
                    h0 += (f32x4){sigmoid_(a0[0]), sigmoid_(a0[1]), sigmoid_(a0[2]), sigmoid_(a0[3])} * e0; h1 += (f32x4){sigmoid_(a1[0]), sigmoid_(a1[1]), sigmoid_(a1[2]), sigmoid_(a1[3])} * e1;
                    u32x4 w; w.x = pk2(h0[0], h0[1]); w.y = pk2(h0[2], h0[3]); w.z = pk2(h1[0], h1[1]); w.w = pk2(h1[2], h1[3]); *(u32x4*)(h + o) = w;
                    q += (bflo(w.x) * bflo(w.x) + bfhi(w.x) * bfhi(w.x)) + (bflo(w.y) * bflo(w.y) + bfhi(w.y) * bfhi(w.y)) + (bflo(w.z) * bflo(w.z) + bfhi(w.z) * bfhi(w.z)) + (bflo(w.w) * bflo(w.w) + bfhi(w.w) * bfhi(w.w)); }
                sq[ai][m] = q; } }
#pragma unroll
        for (int ai = 0; ai < 2; ++ai)
#pragma unroll
            for (int m = 0; m < 4; ++m) { float q = sq[ai][m]; q += shx<16>(q); q += __int_as_float(__builtin_amdgcn_ds_bpermute((t2 ^ 32) << 2, __float_as_int(q)));
                if (fq == 0) red[wc * 256 + ai * HALF + wr * 64 + m * 16 + fr] = q; }
        asm volatile("s_waitcnt lgkmcnt(0)" ::: "memory");
        __builtin_amdgcn_s_barrier();
        { const int tt = (wr * 4 + wc) * 64 + t2; if (tt < 256) part[(size_t)u.pn * T + u.pm * BM + tt] = (red[tt] + red[256 + tt]) + (red[512 + tt] + red[768 + tt]); }
    } };

template <class Epi, class Sched>
__device__ __forceinline__ void gemm_phase(int wave, LAS unsigned char* lds, int K, const Sched& S, const Epi& E) {
    int wid = wave; asm volatile("" : "+s"(wid));
    const int lane = lane_now(), tid = (wid << 6) | lane, wr = wid >> 2, wc = wid & 3, fr = lane & 15, fq = lane >> 4;
    const int nt = K / BK;
    unsigned voffA[2], voffB[2];
#pragma unroll
    for (int i = 0; i < 2; ++i) { int R, C; stage_rc(tid * 16 + i * 8192, R, C); const int Rb = Epi::PERM ? ((R & ~31) + perm32(R & 31)) : R;
        voffA[i] = (unsigned)(R * K + C) * 2u; voffB[i] = (unsigned)(Rb * K + C) * 2u; }
    const size_t kstep = (size_t)(BK * 2);
    const size_t hstep = (size_t)HALF * K * 2;
    const unsigned ldsw = (unsigned)wid * 1024u;
    const int aoff = lds_byte(wr * 64 + fr, fq * 8), boff = lds_byte(wc * 32 + fr, fq * 8);
#define PG8_SA(b, h) (((b) * 2 + (h)) * HTB)
#define PG8_SB(b, h) ((4 + (b) * 2 + (h)) * HTB)
#define PG8_STAGE(bufoff, gbase, voff) do { _Pragma("unroll") for (int _i = 0; _i < 2; ++_i) \
        __builtin_amdgcn_global_load_lds((const unsigned*)((const char*)(gbase) + (voff)[_i]), (LAS unsigned*)(lds + (bufoff) + ldsw + _i * 8192), 16, 0, 0); } while (0)
#define PG8_LDA(dst, b, h) do { _Pragma("unroll") for (int m = 0; m < 4; ++m) _Pragma("unroll") for (int k = 0; k < 2; ++k) dst[m][k] = *(const LAS bf16x8*)(lds + PG8_SA(b, h) + aoff + m * 2048 + k * 1024); } while (0)
#define PG8_LDB(dst, b, h) do { _Pragma("unroll") for (int n = 0; n < 2; ++n) _Pragma("unroll") for (int k = 0; k < 2; ++k) dst[n][k] = *(const LAS bf16x8*)(lds + PG8_SB(b, h) + boff + n * 2048 + k * 1024); } while (0)
#define PG8_MMA(ai, bj, At, Bt) do { __builtin_amdgcn_s_setprio(1); _Pragma("unroll") for (int m = 0; m < 4; ++m) _Pragma("unroll") for (int n = 0; n < 2; ++n) _Pragma("unroll") for (int k = 0; k < 2; ++k) \
        acc[ai][bj][m][n] = __builtin_amdgcn_mfma_f32_16x16x32_bf16(Bt[n][k], At[m][k], acc[ai][bj][m][n], 0, 0, 0); __builtin_amdgcn_s_setprio(0); } while (0)
#define PG8_WAIT_V(n) asm volatile("s_waitcnt vmcnt(" #n ")" ::: "memory")
#define PG8_WAIT_L(n) asm volatile("s_waitcnt lgkmcnt(" #n ")" ::: "memory")
#define PG8_BAR __builtin_amdgcn_s_barrier()
#define PG8_SCHED __builtin_amdgcn_sched_barrier(0)
    Unit cur, nxt; int ui = 0;
    if (!S.next(0, cur)) return;
    if constexpr (Sched::DEPS) { S.wait(cur, wid); PG8_BAR; }
    f32x4 acc[2][2][4][2];
    if constexpr (Epi::ACC_INIT) E.init(acc, cur, wr, wc, fr, fq);
    else {
#pragma unroll
    for (int a = 0; a < 2; ++a)
#pragma unroll
        for (int b = 0; b < 2; ++b)
#pragma unroll
            for (int m = 0; m < 4; ++m)
#pragma unroll
                for (int n = 0; n < 2; ++n) acc[a][b][m][n] = (f32x4){0.f, 0.f, 0.f, 0.f}; }
    bf16x8 At[4][2], B0[2][2], B1[2][2];
    const char* cA = cur.A; const char* cB = cur.B;
    PG8_STAGE(PG8_SB(0, 0), cB, voffB); PG8_STAGE(PG8_SB(0, 1), cB + hstep, voffB); PG8_STAGE(PG8_SA(0, 0), cA, voffA); PG8_STAGE(PG8_SA(0, 1), cA + hstep, voffA);
    if (wr == 1) PG8_BAR;
    PG8_WAIT_V(2); PG8_BAR;
    PG8_STAGE(PG8_SB(1, 0), cB + kstep, voffB); PG8_STAGE(PG8_SA(1, 0), cA + kstep, voffA); PG8_STAGE(PG8_SB(1, 1), cB + hstep + kstep, voffB);
    PG8_WAIT_V(6); PG8_BAR;
    for (;;) {
        const bool has_next = S.next(ui + 1, nxt);
        const char* nA = has_next ? nxt.A : cA; const char* nB = has_next ? nxt.B : cB;
#pragma nounroll
        for (int t = 0; t < nt; t += 2) {
            const bool last = (t == nt - 2);
            if constexpr (Sched::DEPS) { if (last && has_next) S.wait(nxt, wid); }
            const char* a1 = cA + (size_t)(t + 1) * kstep;
            const char* a2 = last ? nA : cA + (size_t)(t + 2) * kstep; const char* b2 = last ? nB : cB + (size_t)(t + 2) * kstep;
            const char* a3 = a2 + kstep; const char* b3 = b2 + kstep;
            PG8_LDB(B0, 0, 0); PG8_LDB(B1, 0, 1); PG8_SCHED; PG8_LDA(At, 0, 0); PG8_STAGE(PG8_SA(1, 1), a1 + hstep, voffA);
            PG8_WAIT_V(8); PG8_WAIT_L(0); PG8_BAR; PG8_MMA(0, 0, At, B0); PG8_MMA(0, 1, At, B1); PG8_BAR; PG8_SCHED;
            PG8_LDA(At, 0, 1); PG8_STAGE(PG8_SB(0, 0), b2, voffB); PG8_STAGE(PG8_SB(0, 1), b2 + hstep, voffB); PG8_STAGE(PG8_SA(0, 0), a2, voffA);
            PG8_WAIT_V(8); PG8_WAIT_L(0); PG8_BAR; PG8_MMA(1, 0, At, B0); PG8_MMA(1, 1, At, B1); PG8_BAR; PG8_SCHED;
            PG8_LDB(B0, 1, 0); PG8_LDB(B1, 1, 1); PG8_SCHED; PG8_LDA(At, 1, 0); PG8_STAGE(PG8_SA(0, 1), a2 + hstep, voffA);
            PG8_WAIT_V(8); PG8_WAIT_L(0); PG8_BAR; PG8_MMA(0, 0, At, B0); PG8_MMA(0, 1, At, B1); PG8_BAR; PG8_SCHED;
            PG8_LDA(At, 1, 1); PG8_STAGE(PG8_SB(1, 0), b3, voffB); PG8_STAGE(PG8_SB(1, 1), b3 + hstep, voffB); PG8_STAGE(PG8_SA(1, 0), a3, voffA);
            PG8_WAIT_V(8); PG8_WAIT_L(0); PG8_BAR; PG8_MMA(1, 0, At, B0); PG8_MMA(1, 1, At, B1); PG8_BAR; PG8_SCHED;
        }
        if (wr == 0) PG8_BAR;
        E(acc, cur, wr, wc, fr, fq);
        if constexpr (Epi::SIGNAL) { PG8_WAIT_V(0); PG8_BAR; if (tid == 0) E.signal(cur); }
        if (!has_next) break;
        if constexpr (Epi::ACC_INIT) E.init(acc, nxt, wr, wc, fr, fq);
        else {
#pragma unroll
        for (int a = 0; a < 2; ++a)
#pragma unroll
            for (int b = 0; b < 2; ++b)
#pragma unroll
                for (int m = 0; m < 4; ++m)
#pragma unroll
                    for (int n = 0; n < 2; ++n) acc[a][b][m][n] = (f32x4){0.f, 0.f, 0.f, 0.f}; }
        cur = nxt; cA = nA; cB = nB; ++ui;
        if (wr == 1) PG8_BAR;
    }
    PG8_WAIT_V(0);
    PG8_BAR;
#undef PG8_SA
#undef PG8_SB
#undef PG8_STAGE
#undef PG8_LDA
#undef PG8_LDB
#undef PG8_MMA
#undef PG8_WAIT_V
#undef PG8_WAIT_L
#undef PG8_BAR
#undef PG8_SCHED
}
}

__device__ __forceinline__ void phase_gemm_pe(const Frame& F) {
    pg8::DenseOrder S; S.init(F.ws + WS_PB, F.ws + WS_WPE, T, D, PD, DEPTH, F.G, F.blk); pg8::EpiBf16 E{(bf16*)(F.ws + WS_PE), D};
    pg8::gemm_phase(F.wave, F.lds, PD, S, E);
}
__device__ __forceinline__ void phase_gemm_in(const Frame& F, int l) {
    pg8::DenseOrder S; S.init(F.ws + WS_H, (bf16*)(F.ws + WS_WIN) + (size_t)l * DIN * D, T, DIN, D, 1, F.G, F.blk); pg8::EpiBf16Rs E{(bf16*)(F.ws + WS_Z), DIN, (const float*)(F.ws + MS_RSTD1), l > 0 ? (const float*)(F.ws + MS_PART) : (const float*)nullptr};
    pg8::gemm_phase(F.wave, F.lds, D, S, E);
}
__device__ __forceinline__ void phase_gemm_out(const Frame& F, int l) {
    pg8::DenseOrder S; S.init(F.ws + WS_O, (bf16*)(F.ws + WS_WOUT) + (size_t)l * D * D, T, D, D, 1, F.G, F.blk); pg8::EpiResid E{(bf16*)(F.ws + WS_H)};
    pg8::gemm_phase(F.wave, F.lds, D, S, E);
}
__device__ __forceinline__ void phase_gemm_moe1(const Frame& F, int l) {
    pg8::MoeOrder S; S.init(F.ws + WS_XB, (bf16*)(F.ws + WS_WGU) + (size_t)l * NE * 1024 * 1024, (const int*)(F.ws + MS_BLKE) + l * 256, D, 4, (size_t)1024 * 1024 * 2, F.G, F.blk); pg8::EpiGateUp E{(bf16*)(F.ws + WS_HB)};
    pg8::gemm_phase(F.wave, F.lds, D, S, E);
    { const int nun = S.nrb * 4, rem = nun % F.G, few = (rem == 0 || F.G - rem < 64), idle = few ? F.G : F.G - rem, first = few ? 0 : rem;
      if (F.blk >= first) { pg8::DenseOrder P; P.init((const bf16*)(F.ws + WS_PB) + (size_t)l * T * PD, (const bf16*)(F.ws + WS_WPE) + (size_t)l * D * PD, T, D, PD, 1, idle, F.blk - first);
          pg8::EpiBf16 EP{(bf16*)(F.ws + WS_PE) + (size_t)l * T * D, D}; pg8::gemm_phase(F.wave, F.lds, PD, P, EP); }
      conv_deferred(F, l + 1, 0, NDEF1, first, idle); }
}
__device__ __forceinline__ void phase_gemm_moe2(const Frame& F, int l) {
    pg8::MoeOrder S; S.init(F.ws + WS_HB, (bf16*)(F.ws + WS_WD) + (size_t)l * NE * D * DE, (const int*)(F.ws + MS_BLKE) + l * 256, DE, 4, (size_t)D * DE * 2, F.G, F.blk); pg8::EpiBf16 E{(bf16*)(F.ws + WS_Y), D};
    pg8::gemm_phase(F.wave, F.lds, DE, S, E);
    { const int nun = S.nrb * 4, rem = nun % F.G, few = (rem == 0 || F.G - rem < 64), idle = few ? F.G : F.G - rem, first = few ? 0 : rem;
      conv_deferred(F, l + 1, NDEF1, NDEF, first, idle); }
}
#ifndef MOE_CPE
#define MOE_CPE 5
#endif
#ifndef MOE_CTL
#define MOE_CTL 4
#endif
#ifndef MOE_X1
#define MOE_X1 16
#define MOE_X2 8
#endif
template <int MODE = 0> __device__ __forceinline__ void phase_moe_fused(const Frame& F, int l) {
    unsigned char* ws = F.ws; const int G = F.G, blk = (MOE_VBLK && F.G == 256) ? vblk(F.blk) : F.blk;
    const int* blke = (const int*)(ws + MS_BLKE) + l * 256;
    unsigned* done = (unsigned*)(ws + WS_CTL) + CW_DONE + l * 256;
    const int nrb = __builtin_amdgcn_readfirstlane(blke[255]), nu = 4 * nrb, e1 = nu % G;
    if constexpr (MODE == 1) { pg8::MoeOrder S; S.init(ws + WS_XB, (bf16*)(ws + WS_WGU) + (size_t)l * NE * 1024 * 1024, blke, D, 4, (size_t)1024 * 1024 * 2, G, blk);
      pg8::EpiGateUp E{(bf16*)(ws + WS_HB)}; pg8::gemm_phase(F.wave, F.lds, D, S, E); return; }
    if constexpr (MODE == 0) { pg8::MoeOrder S; S.init(ws + WS_XB, (bf16*)(ws + WS_WGU) + (size_t)l * NE * 1024 * 1024, blke, D, 4, (size_t)1024 * 1024 * 2, G, blk);
      pg8::EpiGateUpPub E{__builtin_amdgcn_make_buffer_rsrc(ws + WS_HB, 0, (int)((size_t)CAP * DE * 2), 0x00020000), done};
      pg8::gemm_phase(F.wave, F.lds, D, S, E); }
    if constexpr (MODE == 2) { pg8::MoeOrder S; S.init(ws + WS_HB, (bf16*)(ws + WS_WD) + (size_t)l * NE * D * DE, blke, DE, 4, (size_t)D * DE * 2, G, blk >= e1 ? blk - e1 : blk - e1 + G);
      pg8::EpiBf16 E{(bf16*)(ws + WS_Y), D}; pg8::gemm_phase(F.wave, F.lds, DE, S, E); }
    if constexpr (MODE == 0) { pg8::MoeDepOrder S; S.init(ws + WS_HB, (bf16*)(ws + WS_WD) + (size_t)l * NE * D * DE, blke, done, DE, 4, (size_t)D * DE * 2, G, blk >= e1 ? blk - e1 : blk - e1 + G);
      pg8::EpiBf16 E{(bf16*)(ws + WS_Y), D};
      pg8::gemm_phase(F.wave, F.lds, DE, S, E); }
    { const int nt = (l + 1 < DEPTH) ? NDEF : 0, ftot = 256 * MOE_CPE + nt * MOE_CTL;
      const int wrap = 2 * e1 > G ? 2 * e1 - G : 0;
      auto cls = [&](int x, int& c24, int& c16, int& c8, int& c0) {
          const int cA = x < e1 ? x : e1, cAB = x < wrap ? x : wrap;
          int cB = x - e1; cB = cB < 0 ? 0 : cB; if (!wrap) cB = cB > e1 ? e1 : cB; cB += cAB;
          c24 = cAB; c16 = cA - cAB; c8 = cB - cAB; c0 = x - c24 - c16 - c8; };
      auto fill = [&](int x, int lv) { int c24, c16, c8, c0; cls(x, c24, c16, c8, c0);
          return c0 * lv + c8 * (lv > MOE_X2 ? lv - MOE_X2 : 0) + c16 * (lv > MOE_X1 ? lv - MOE_X1 : 0) + c24 * (lv > MOE_X1 + MOE_X2 ? lv - MOE_X1 - MOE_X2 : 0); };
      int lv = 1; while (fill(G, lv) < ftot) ++lv;
      const int B0 = fill(blk, lv), B1 = fill(blk + 1, lv);
      const int pe_tot = 256 * MOE_CPE;
      int j0 = (B0 + MOE_CPE - 1) / MOE_CPE, j1 = (B1 + MOE_CPE - 1) / MOE_CPE; j0 = j0 < 256 ? j0 : 256; j1 = j1 < 256 ? j1 : 256;
      int t0 = B0 > pe_tot ? (B0 - pe_tot + MOE_CTL - 1) / MOE_CTL : 0, t1 = B1 > pe_tot ? (B1 - pe_tot + MOE_CTL - 1) / MOE_CTL : 0; t0 = t0 < nt ? t0 : nt; t1 = t1 < nt ? t1 : nt;
      if (j1 > j0) { pg8::RangeOrder P; P.init((const bf16*)(ws + WS_PB) + (size_t)l * T * PD, (const bf16*)(ws + WS_WPE) + (size_t)l * D * PD, T, D, PD, j0, j1 - j0);
          pg8::EpiBf16 EP{(bf16*)(ws + WS_PE) + (size_t)l * T * D, D}; pg8::gemm_phase(F.wave, F.lds, PD, P, EP); }
      if (t1 > t0) { const int base = (l + 1) * TL_LAYER + t0; conv_run(F, 0, 1, t1 - t0, [=](int f) { return base + f; }); } }
}
__device__ __forceinline__ void phase_gemm_pg(const Frame& F, int l) {
    pg8::DenseOrder S; S.init(F.ws + WS_XN, (bf16*)(F.ws + WS_WPG) + (size_t)l * D * D, T, D, D, 1, F.G, F.blk);
    pg8::EpiPG E{(bf16*)(F.ws + WS_H), (const bf16*)(F.ws + WS_PE) + (size_t)l * T * D, (const float*)(F.ws + MS_RSTDPE), F.in[22] + l * D, (LAS float*)(F.lds + MISC_OFF + 4096), (float*)(F.ws + MS_PART)};
    pg8::gemm_phase(F.wave, F.lds, D, S, E);
}

typedef short s16x4 __attribute__((ext_vector_type(4)));
__device__ __forceinline__ bf16x8 tr_frag(LAS unsigned char* p_lo, LAS unsigned char* p_hi) {
    const s16x4 lo = __builtin_amdgcn_ds_read_tr16_b64_v4i16((LAS s16x4*)p_lo), hi = __builtin_amdgcn_ds_read_tr16_b64_v4i16((LAS s16x4*)p_hi);
    return __builtin_shufflevector(lo, hi, 0, 1, 2, 3, 4, 5, 6, 7); }
#define MFMA16(a, b, c) __builtin_amdgcn_mfma_f32_16x16x32_bf16((a), (b), (c), 0, 0, 0)
constexpr int RP = 272;
constexpr int VP = 1040;

__device__ __forceinline__ void phase_rec_c1(const Frame& F, int l) {
    PH_TID();
    unsigned char* ws = F.ws; const bf16* Z = (const bf16*)(ws + WS_Z);
    bf16* UT = (bf16*)(ws + WS_UT); float* DC = (float*)(ws + MS_DC); float* MM = (float*)(ws + MS_MM);
    const float* lb = (const float*)(ws + MS_LB) + l * DREC;
    LAS unsigned char* KD = F.lds; LAS unsigned char* IM = F.lds + 128 * RP; LAS float* totx = (LAS float*)(F.lds + 256 * RP);
    const int wave = ph_wave, ch = tid & 255, half = tid >> 8, hl = ch >> 7, k = ch & 127, g = lane >> 4, li = lane & 15, q = li >> 2, p = li & 3;
    const int hG = F.G / 2, nmine = (F.G == 256) ? (F.blk < hG ? 4 : 0) : (F.blk < 512 ? (512 - F.blk + F.G - 1) / F.G : 0);
    const int ustep = (F.G == 256) ? hG : F.G;
    u32x4 pf[4], pi[4];
    auto fetch = [&](int unit) { const int c = unit >> 1, hp = unit & 1;
#pragma unroll
        for (int j = 0; j < 4; ++j) { const int idx = tid + 512 * j, hl2 = idx >> 10, row = (idx >> 4) & 63, cc = idx & 15;
            const bf16* src = Z + (size_t)(c * 64 + row) * DIN + 512 + (2 * hp + hl2) * 128 + cc * 8; pf[j] = *(const u32x4*)src; pi[j] = *(const u32x4*)(src + 512); } };
    if (nmine > 0) fetch(F.blk);
    for (int ui = 0; ui < nmine; ++ui) {
        const int unit = F.blk + ui * ustep;
        const int c = unit >> 1, hp = unit & 1, hh = 2 * hp + hl;
#pragma unroll
        for (int j = 0; j < 4; ++j) { const int idx = tid + 512 * j, hl2 = idx >> 10, row = (idx >> 4) & 63, cc = idx & 15; const int dst = (hl2 * 64 + row) * RP + cc * 16;
            *(LAS u32x4*)(KD + dst) = pf[j]; *(LAS u32x4*)(IM + dst) = pi[j]; }
        __syncthreads();
        if (ui + 1 < nmine) fetch(unit + ustep);
        const float lbk = lb[hh * 128 + k];
        float cs[32], kk[32]; float run = 1.f;
#pragma unroll
        for (int t = 0; t < 32; ++t) { const float fz = bf2f(*(const LAS bf16*)(KD + (hl * 64 + 32 * half + t) * RP + 2 * k)); const float sg = sigmoid_(fz); run *= lbk + (1.f - lbk) * sg; cs[t] = run; kk[t] = (1.f - lbk) * (1.f - sg); }
        totx[half * 256 + ch] = run;
        __syncthreads();
        const float other = totx[(1 - half) * 256 + ch]; const float p63 = run * other; const float base_p = half == 0 ? p63 : run;
#pragma unroll
        for (int t = 0; t < 32; ++t) *(LAS bf16*)(KD + (hl * 64 + 32 * half + t) * RP + 2 * k) = (bf16)f2bf(kk[t] * base_p * frcp(fmaxf(cs[t], 1e-30f)));
        if (half == 0) { DC[(c * 4 + hh) * 128 + k] = p63; MM[(c * 4 + hh) * 128 + k] = run; }
        __syncthreads();
        { const int whl = wave >> 2, kt0 = 2 * (wave & 3), whh = 2 * hp + whl;
          f32x4 acc[2][8];
#pragma unroll
          for (int i = 0; i < 2; ++i)
#pragma unroll
              for (int vt = 0; vt < 8; ++vt) acc[i][vt] = (f32x4){0.f, 0.f, 0.f, 0.f};
          LAS unsigned char* kdb = KD + whl * 64 * RP; LAS unsigned char* imb = IM + whl * 64 * RP;
#pragma unroll
          for (int a = 0; a < 2; ++a) { const unsigned ro = (unsigned)((32 * a + 8 * g + q) * RP);
              bf16x8 Af[2];
#pragma unroll
              for (int i = 0; i < 2; ++i) { const unsigned co = (unsigned)((16 * (kt0 + i) + 4 * p) * 2); Af[i] = tr_frag(kdb + ro + co, kdb + ro + 4 * RP + co); }
#pragma unroll
              for (int vt = 0; vt < 8; ++vt) { const unsigned co = (unsigned)((16 * vt + 4 * p) * 2); const bf16x8 Bf = tr_frag(imb + ro + co, imb + ro + 4 * RP + co);
#pragma unroll
                  for (int i = 0; i < 2; ++i) acc[i][vt] = MFMA16(Af[i], Bf, acc[i][vt]); } }
#pragma unroll
          for (int i = 0; i < 2; ++i)
#pragma unroll
              for (int vt = 0; vt < 8; ++vt) { u32x2 w; w.x = pg8::cvt_pk_bf16(acc[i][vt][0], acc[i][vt][1]); w.y = pg8::cvt_pk_bf16(acc[i][vt][2], acc[i][vt][3]);
                  *(u32x2*)(UT + ((size_t)(c * 4 + whh) * 128 + 16 * vt + li) * 128 + 16 * (kt0 + i) + 4 * g) = w; } }
        __syncthreads();
    }
}
__device__ __forceinline__ void phase_rec_c2a(const Frame& F) {
    PH_TID();
    unsigned char* ws = F.ws; const unsigned* UT = (const unsigned*)(ws + WS_UT); const float* DC = (const float*)(ws + MS_DC);
    f32x2* LT = (f32x2*)(ws + WS_LTOT); float* PT = (float*)(ws + MS_PTOT);
    for (int it = F.blk * NTHR + tid; it < 16 * 32768; it += F.G * NTHR) {
        const int gs = it >> 15, e = it & 32767, hh = e >> 13, v = (e >> 6) & 127, k0 = 2 * (e & 63);
        float S0 = 0.f, S1 = 0.f, P0 = 1.f, P1 = 1.f;
#pragma unroll
        for (int cc = 0; cc < 16; ++cc) { const int c = 16 * gs + cc; const unsigned u = UT[(size_t)c * 32768 + e]; const f32x2 d = *(const f32x2*)(DC + (c * 4 + hh) * 128 + k0);
            S0 = d.x * S0 + bflo(u); S1 = d.y * S1 + bfhi(u); P0 *= d.x; P1 *= d.y; }
        LT[it] = (f32x2){S0, S1};
        if (v == 0) *(f32x2*)(PT + (gs * 4 + hh) * 128 + k0) = (f32x2){P0, P1};
    }
}
__device__ __forceinline__ void phase_rec_c2c(const Frame& F) {
    PH_TID();
    unsigned char* ws = F.ws; const unsigned* UT = (const unsigned*)(ws + WS_UT); unsigned* ST = (unsigned*)(ws + WS_ST); const float* DC = (const float*)(ws + MS_DC); const float* MM = (const float*)(ws + MS_MM);
    const f32x2* LT = (const f32x2*)(ws + WS_LTOT); const float* PT = (const float*)(ws + MS_PTOT);
    for (int it = F.blk * NTHR + tid; it < 16 * 32768; it += F.G * NTHR) {
        const int gs = it >> 15, e = it & 32767, hh = e >> 13, k0 = 2 * (e & 63);
        float C0 = 0.f, C1 = 0.f;
        for (int g2 = 0; g2 < gs; ++g2) { const f32x2 pt = *(const f32x2*)(PT + (g2 * 4 + hh) * 128 + k0); const f32x2 lt = LT[g2 * 32768 + e]; C0 = pt.x * C0 + lt.x; C1 = pt.y * C1 + lt.y; }
#pragma unroll
        for (int cc = 0; cc < 16; ++cc) { const int c = 16 * gs + cc; const f32x2 mm = *(const f32x2*)(MM + (c * 4 + hh) * 128 + k0);
            ST[(size_t)c * 32768 + e] = pk2(C0 * mm.x, C1 * mm.y);
            const unsigned u = UT[(size_t)c * 32768 + e]; const f32x2 d = *(const f32x2*)(DC + (c * 4 + hh) * 128 + k0);
            C0 = d.x * C0 + bflo(u); C1 = d.y * C1 + bfhi(u); }
    }
}
__device__ __forceinline__ void phase_rec_c2(const Frame& F) {
    PH_TID();
    unsigned char* ws = F.ws; const int w = ph_wave;
    LAS float* tot = (LAS float*)F.lds;
    for (int unit = F.blk; unit < 256; unit += F.G) {
        const int hh = unit >> 6; const unsigned eo = (unsigned)(unit * 128 + lane), ko = (unsigned)(hh * 128 + 2 * lane);
        const unsigned* ut = (const unsigned*)(ws + WS_UT) + (size_t)(32 * w) * 32768; unsigned* st = (unsigned*)(ws + WS_ST) + (size_t)(32 * w) * 32768;
        const float* dc = (const float*)(ws + MS_DC) + (32 * w) * 512; const float* mmp = (const float*)(ws + MS_MM) + (32 * w) * 512;
        asm volatile("" : "+s"(ut), "+s"(st), "+s"(dc), "+s"(mmp));
        unsigned ua[32], ub[32]; f32x2 d[32], m0[16], m1[16];
#pragma unroll
        for (int cc = 0; cc < 32; ++cc) { ua[cc] = (ut + cc * 32768)[eo]; ub[cc] = (ut + cc * 32768 + 64)[eo]; d[cc] = *(const f32x2*)((dc + cc * 512) + ko); }
        __builtin_amdgcn_sched_barrier(0);
        float a0 = 0.f, a1 = 0.f, b0 = 0.f, b1 = 0.f, p0 = 1.f, p1 = 1.f;
#pragma unroll
        for (int cc = 0; cc < 32; ++cc) { a0 = d[cc].x * a0 + bflo(ua[cc]); a1 = d[cc].y * a1 + bfhi(ua[cc]); b0 = d[cc].x * b0 + bflo(ub[cc]); b1 = d[cc].y * b1 + bfhi(ub[cc]); p0 *= d[cc].x; p1 *= d[cc].y; }
        { LAS float* tw = tot + w * 384 + lane; tw[0] = a0; tw[64] = a1; tw[128] = b0; tw[192] = b1; tw[256] = p0; tw[320] = p1; }
        __builtin_amdgcn_sched_barrier(0);
#pragma unroll
        for (int cc = 0; cc < 16; ++cc) m0[cc] = *(const f32x2*)((mmp + cc * 512) + ko);
        __builtin_amdgcn_sched_barrier(0);
        __syncthreads();
        float A0 = 0.f, A1 = 0.f, B0 = 0.f, B1 = 0.f;
        for (int g2 = 0; g2 < w; ++g2) { const LAS float* tw = tot + g2 * 384 + lane; const float q0 = tw[256], q1 = tw[320]; A0 = q0 * A0 + tw[0]; A1 = q1 * A1 + tw[64]; B0 = q0 * B0 + tw[128]; B1 = q1 * B1 + tw[192]; }
        __builtin_amdgcn_sched_barrier(0);
#pragma unroll
        for (int cc = 0; cc < 16; ++cc) m1[cc] = *(const f32x2*)((mmp + (16 + cc) * 512) + ko);
        __builtin_amdgcn_sched_barrier(0);
#pragma unroll
        for (int cc = 0; cc < 32; ++cc) { const f32x2 mm = cc < 16 ? m0[cc & 15] : m1[cc & 15];
            (st + cc * 32768)[eo] = pk2(A0 * mm.x, A1 * mm.y); (st + cc * 32768 + 64)[eo] = pk2(B0 * mm.x, B1 * mm.y);
            unsigned xa = ua[cc], xb = ub[cc]; asm volatile("" : "+v"(xa), "+v"(xb));
            A0 = d[cc].x * A0 + bflo(xa); A1 = d[cc].y * A1 + bfhi(xa); B0 = d[cc].x * B0 + bflo(xb); B1 = d[cc].y * B1 + bfhi(xb);
            asm volatile("" : "+v"(A0), "+v"(A1), "+v"(B0), "+v"(B1) :: "memory"); }
        __syncthreads();
    }
}
template <int PV = 0> __device__ __forceinline__ void phase_rec_c3(const Frame& F, int l) {
    PH_TID();
    unsigned char* ws = F.ws; const bf16* Z = (const bf16*)(ws + WS_Z); const bf16* ST = (const bf16*)(ws + WS_ST); bf16* O = (bf16*)(ws + WS_O);
    const float* lb = (const float*)(ws + MS_LB) + l * DREC; const float* ogain = F.in[5] + l * 128;
    LAS unsigned char* QT = F.lds; LAS unsigned char* KT = F.lds + 128 * RP; LAS unsigned char* IM = F.lds + 256 * RP;
    const int wave = ph_wave, ch = tid & 255, half = tid >> 8, hl = ch >> 7, k = ch & 127, g = lane >> 4, li = lane & 15, q = li >> 2, p = li & 3;
    u32x4 pq[4], pf[4];
    const unsigned tvo = (unsigned)((tid >> 4) * DIN + (tid & 15) * 8), tlo = (unsigned)((tid >> 4) * RP + (tid & 15) * 16);
    auto fetch = [&](int unit) { const bf16* zc = Z + (size_t)(unit >> 1) * 64 * DIN + (unit & 1) * 256;
#pragma unroll
        for (int j = 0; j < 4; ++j) { const bf16* src = zc + (32 * (j & 1)) * DIN + (j >> 1) * 128; pq[j] = *(const u32x4*)(src + tvo); pf[j] = *(const u32x4*)(src + 512 + tvo); } };
    if (F.blk < 512) fetch(F.blk);
    for (int unit = F.blk; unit < 512; unit += F.G) {
        const int c = unit >> 1, hp = unit & 1, hh = 2 * hp + hl;
#pragma unroll
        for (int j = 0; j < 4; ++j) { const int dst = ((j >> 1) * 64 + 32 * (j & 1)) * RP;
            *(LAS u32x4*)(QT + dst + tlo) = pq[j]; *(LAS u32x4*)(KT + dst + tlo) = pf[j]; }
        u32x4 vi[4];
        { const bf16* zc = Z + (size_t)c * 64 * DIN + hp * 256 + 1024;
#pragma unroll
          for (int j = 0; j < 4; ++j) vi[j] = *(const u32x4*)(zc + (32 * (j & 1)) * DIN + (j >> 1) * 128 + tvo); }
        __syncthreads();
        { const float lbk = lb[hh * 128 + k]; const int col = (hl * 64 + 32 * half) * RP + 2 * k;
          float cs[32], kk[32], qs[32]; float run = 1.f;
#pragma unroll
          for (int t = 0; t < 32; ++t) { const float fz = bf2f(*(const LAS bf16*)(KT + col + t * RP)); const float sg = sigmoid_(fz); run *= lbk + (1.f - lbk) * sg; cs[t] = run; kk[t] = (1.f - lbk) * (1.f - sg);
              qs[t] = silu_(bf2f(*(const LAS bf16*)(QT + col + t * RP))); }
          const float inv = half == 0 ? frcp(fmaxf(run, 1e-30f)) : 1.f;
#pragma unroll
          for (int t = 0; t < 32; ++t) { const float ex = cs[t] * inv; const int off = col + t * RP;
              *(LAS bf16*)(QT + off) = (bf16)f2bf(qs[t] * ex); *(LAS bf16*)(KT + off) = (bf16)f2bf(kk[t] * frcp(fmaxf(ex, 1e-30f))); } }
#pragma unroll
        for (int j = 0; j < 4; ++j) *(LAS u32x4*)(IM + ((j >> 1) * 64 + 32 * (j & 1)) * RP + tlo) = vi[j];
        const int whl = wave >> 2, tt = wave & 3, whh = 2 * hp + whl;
        bf16x8 Sf[8][4];
#pragma unroll
        for (int vt = 0; vt < 8; ++vt)
#pragma unroll
            for (int a = 0; a < 4; ++a) Sf[vt][a] = *(const bf16x8*)(ST + ((size_t)(c * 4 + whh) * 128 + 16 * vt + li) * 128 + 32 * a + 8 * g);
        __syncthreads();
        if (PV != 1) {
          bf16 gz[8][4];
#pragma unroll
          for (int vt = 0; vt < 8; ++vt)
#pragma unroll
              for (int r = 0; r < 4; ++r) gz[vt][r] = Z[((size_t)c * 64 + 16 * tt + 4 * g + r) * DIN + 1536 + whh * 128 + 16 * vt + li];
          bf16x8 Qf[4];
#pragma unroll
          for (int a = 0; a < 4; ++a) Qf[a] = *(const LAS bf16x8*)(QT + (whl * 64 + 16 * tt + li) * RP + (32 * a + 8 * g) * 2);
          unsigned pw[4][2];
#pragma unroll
          for (int st = 0; st < 4; ++st) { pw[st][0] = 0u; pw[st][1] = 0u;
              { f32x4 s = (f32x4){0.f, 0.f, 0.f, 0.f};
#pragma unroll
                  for (int a = 0; a < 4; ++a) { const bf16x8 Kf = *(const LAS bf16x8*)(KT + (whl * 64 + 16 * st + li) * RP + (32 * a + 8 * g) * 2); s = MFMA16(Kf, Qf[a], s); }
                  if (st == tt) {
#pragma unroll
                      for (int r = 0; r < 4; ++r) if (4 * g + r > li) s[r] = 0.f; }
                  pw[st][0] = st <= tt ? pg8::cvt_pk_bf16(s[0], s[1]) : 0u; pw[st][1] = st <= tt ? pg8::cvt_pk_bf16(s[2], s[3]) : 0u; } }
          f32x4 acc[8];
#pragma unroll
          for (int vt = 0; vt < 8; ++vt) { acc[vt] = (f32x4){0.f, 0.f, 0.f, 0.f};
#pragma unroll
              for (int a = 0; a < 4; ++a) acc[vt] = MFMA16(Qf[a], Sf[vt][a], acc[vt]); }
          __builtin_amdgcn_sched_barrier(0);
          if (unit + F.G < 512) fetch(unit + F.G);
          __builtin_amdgcn_sched_barrier(0);
          LAS unsigned char* imb = IM + whl * 64 * RP;
#pragma unroll
          for (int a = 0; a < 2; ++a) { const u32x4 pv = (u32x4){pw[2 * a][0], pw[2 * a][1], pw[2 * a + 1][0], pw[2 * a + 1][1]}; const bf16x8 Pf = __builtin_bit_cast(bf16x8, pv);
              const unsigned ro = (unsigned)((32 * a + 4 * g + q) * RP);
#pragma unroll
              for (int vt = 0; vt < 8; ++vt) { const unsigned co = (unsigned)((16 * vt + 4 * p) * 2); const bf16x8 If = tr_frag(imb + ro + co, imb + ro + 16 * RP + co); acc[vt] = MFMA16(Pf, If, acc[vt]); } }
          float rs[4];
#pragma unroll
          for (int r = 0; r < 4; ++r) { float ss = 0.f;
#pragma unroll
              for (int vt = 0; vt < 8; ++vt) ss += acc[vt][r] * acc[vt][r];
              ss += shx<1>(ss); ss += shx<2>(ss); ss += shx<4>(ss); ss += shx<8>(ss); rs[r] = frsq(ss * (1.f / 128.f) + EPS); }
#pragma unroll
          for (int vt = 0; vt < 8; ++vt) { const float og = ogain[16 * vt + li];
#pragma unroll
              for (int r = 0; r < 4; ++r) { const size_t t = (size_t)c * 64 + 16 * tt + 4 * g + r; const float gv = bf2f(gz[vt][r]);
                  O[t * D + whh * 128 + 16 * vt + li] = (bf16)f2bf(acc[vt][r] * rs[r] * og * silu_(gv)); } } }
        __syncthreads();
    }
}
__device__ __forceinline__ void phase_sgu(const Frame& F, int l) {
    PH_TID();
    unsigned char* ws = F.ws; const bf16* Z = (const bf16*)(ws + WS_Z); bf16* O = (bf16*)(ws + WS_O);
    const bf16* Wb = (const bf16*)(ws + MS_SGUW) + (size_t)l * 4 * 128 * 128; const float* sb = F.in[9] + l * 4 * 128;
    LAS unsigned char* VN = F.lds;
    const int wave = ph_wave, g = lane >> 4, li = lane & 15, q = li >> 2, p = li & 3;
    for (int unit = (F.blk + F.G / 2) % F.G; unit < 128; unit += F.G) {
        float lg[8], lbv[8];
#pragma unroll
        for (int j = 0; j < 8; ++j) { lg[j] = F.in[6][l * DSGU + 8 * lane + j]; lbv[j] = F.in[7][l * DSGU + 8 * lane + j]; }
        u32x4 raw[16];
#pragma unroll
        for (int i = 0; i < 16; ++i) raw[i] = *(const u32x4*)(Z + ((size_t)unit * 128 + 16 * wave + i) * DIN + 2560 + 8 * lane);
#pragma unroll
        for (int i = 0; i < 16; ++i) { const int s = 16 * wave + i; const u32x4 r = raw[i];
            float x[8] = {gelu_(bflo(r.x)), gelu_(bfhi(r.x)), gelu_(bflo(r.y)), gelu_(bfhi(r.y)), gelu_(bflo(r.z)), gelu_(bfhi(r.z)), gelu_(bflo(r.w)), gelu_(bfhi(r.w))};
            float sm = 0.f, qq = 0.f;
#pragma unroll
            for (int j = 0; j < 8; ++j) { sm += x[j]; qq += x[j] * x[j]; }
            sm += shx<1>(sm); qq += shx<1>(qq); sm += shx<2>(sm); qq += shx<2>(qq); sm += shx<4>(sm); qq += shx<4>(qq); sm += shx<8>(sm); qq += shx<8>(qq); sm += shx<16>(sm); qq += shx<16>(qq);
            const float mu = halves_sum(sm) * (1.f / 512.f); const float var = fmaxf(halves_sum(qq) * (1.f / 512.f) - mu * mu, 0.f);
            const float rstd = frsq(var + EPS);
#pragma unroll
            for (int j = 0; j < 8; ++j) x[j] = (x[j] - mu) * rstd * lg[j] + lbv[j];
            u32x4 o; o.x = pk2(x[0], x[1]); o.y = pk2(x[2], x[3]); o.z = pk2(x[4], x[5]); o.w = pk2(x[6], x[7]);
            *(LAS u32x4*)(VN + s * VP + lane * 16) = o; }
        __syncthreads();
        { const int hh = wave >> 1, dh = wave & 1; const bf16* W = Wb + (size_t)hh * 128 * 128;
          LAS unsigned char* vnb = VN;
#pragma unroll 1
          for (int dp = 0; dp < 2; ++dp) {
          bf16x8 Wf[2][8];
#pragma unroll
          for (int a = 0; a < 2; ++a)
#pragma unroll
              for (int ti = 0; ti < 8; ++ti) if (ti >= 2 * a) Wf[a][ti] = *(const bf16x8*)(W + (size_t)(16 * ti + li) * 128 + 32 * a + 8 * g);
          u32x2 uu[8][2]; float bs[8];
#pragma unroll
          for (int ti = 0; ti < 8; ++ti) { bs[ti] = sb[hh * 128 + 16 * ti + li];
#pragma unroll
              for (int dt = 0; dt < 2; ++dt) uu[ti][dt] = *(const u32x2*)(Z + ((size_t)unit * 128 + 16 * ti + li) * DIN + 2048 + hh * 128 + 64 * dh + 16 * (2 * dp + dt) + 4 * g); }
          f32x4 acc[2][8];
#pragma unroll
          for (int dt = 0; dt < 2; ++dt)
#pragma unroll
              for (int ti = 0; ti < 8; ++ti) acc[dt][ti] = (f32x4){0.f, 0.f, 0.f, 0.f};
#pragma unroll
          for (int a = 0; a < 4; ++a) { const unsigned ro = (unsigned)((32 * a + 8 * g + q) * VP);
              bf16x8 Af[2];
#pragma unroll
              for (int dt = 0; dt < 2; ++dt) { const unsigned co = (unsigned)((hh * 128 + 64 * dh + 16 * (2 * dp + dt) + 4 * p) * 2); Af[dt] = tr_frag(vnb + ro + co, vnb + ro + 4 * VP + co); }
#pragma unroll
              for (int ti = 0; ti < 8; ++ti) if (ti >= 2 * a) {
                  const bf16x8 Bf = a < 2 ? Wf[a < 2 ? a : 0][ti] : *(const bf16x8*)(W + (size_t)(16 * ti + li) * 128 + 32 * a + 8 * g);
#pragma unroll
                  for (int dt = 0; dt < 2; ++dt) acc[dt][ti] = MFMA16(Af[dt], Bf, acc[dt][ti]); } }
#pragma unroll
          for (int ti = 0; ti < 8; ++ti) { const size_t t = (size_t)unit * 128 + 16 * ti + li; const float bias = bs[ti];
#pragma unroll
              for (int dt = 0; dt < 2; ++dt) { const int col = hh * 128 + 64 * dh + 16 * (2 * dp + dt) + 4 * g; const u32x2 u = uu[ti][dt];
                  u32x2 w; w.x = pk2((acc[dt][ti][0] + bias) * gelu_(bflo(u.x)), (acc[dt][ti][1] + bias) * gelu_(bfhi(u.x))); w.y = pk2((acc[dt][ti][2] + bias) * gelu_(bflo(u.y)), (acc[dt][ti][3] + bias) * gelu_(bfhi(u.y)));
                  *(u32x2*)(O + t * D + 512 + col) = w; } } } }
        __syncthreads();
    }
}

#define XB_TMO      128
#define XB_XCNT(j)  (256  + 64 * (j))
#define XB_XSUB(j)  (1280 + 64 * (j))
#define XB_XGEN(j)  (2304 + 64 * (j))
#define XB_TOP      3328
#define XB_TOPGEN   3392
#define XCD_BAR_WORDS 3456
#define XB_SPIN_CAP (1u << 18)
__device__ __forceinline__ unsigned xb_ld(unsigned* p)              { return __hip_atomic_load(p, __ATOMIC_RELAXED, __HIP_MEMORY_SCOPE_AGENT); }
__device__ __forceinline__ unsigned xb_add(unsigned* p, unsigned v) { return __hip_atomic_fetch_add(p, v, __ATOMIC_RELAXED, __HIP_MEMORY_SCOPE_AGENT); }
__device__ __forceinline__ unsigned xb_xcc_id() { return (unsigned)__builtin_amdgcn_s_getreg((3 << 11) | 20) & 0xFu; }
#define XB_SPIN(cond, bar) do { unsigned _sp = 0; while (cond) { __builtin_amdgcn_s_sleep(1); \
    if ((++_sp & 255u) == 0u) { if (xb_ld(&(bar)[XB_TMO])) break; if (_sp > XB_SPIN_CAP) { atomicAdd(&(bar)[XB_TMO], 1u); break; } } } } while (0)
struct XcdBarrier { unsigned* bar; unsigned x; volatile LAS unsigned* st; int wave; };
__device__ __forceinline__ XcdBarrier xcd_barrier_post(unsigned* bar, volatile LAS unsigned* st, int wave) {
    XcdBarrier b; b.bar = bar; b.x = xb_xcc_id(); b.st = st; b.wave = wave;
    if (wave == 0 && lane_now() == 0) (void)xb_add(&bar[XB_XCNT(b.x)], 1u);
    return b;
}
__device__ __forceinline__ void xcd_barrier_complete(unsigned* bar, unsigned x, unsigned& nloc, unsigned& nx) {
    const unsigned G = gridDim.x * gridDim.y * gridDim.z;
    unsigned sum, cnt, mine, sp = 0u;
    for (;;) {
        sum = 0u; cnt = 0u; mine = 0u;
#pragma unroll
        for (unsigned j = 0; j < 16; ++j) { const unsigned c = xb_ld(&bar[XB_XCNT(j)]); sum += c; cnt += (c > 0u) ? 1u : 0u; mine = (j == x) ? c : mine; }
        if (sum == G) break;
        __builtin_amdgcn_s_sleep(1);
        if ((++sp & 255u) == 0u) { if (xb_ld(&bar[XB_TMO])) break; if (sp > XB_SPIN_CAP) { atomicAdd(&bar[XB_TMO], 1u); break; } }
    }
    nloc = mine > 0u ? mine : 1u; nx = cnt > 0u ? cnt : 1u;
}
__device__ __forceinline__ void xcd_barrier(const XcdBarrier& b) {
    asm volatile("s_waitcnt vmcnt(0)" ::: "memory");
    __syncthreads();
    if (b.wave == 0 && lane_now() == 0) {
        unsigned* bar = b.bar;
        __builtin_amdgcn_s_waitcnt(0);
        unsigned nloc = b.st[0], nx = b.st[1];
        if (nloc == 0u) { xcd_barrier_complete(bar, b.x, nloc, nx); b.st[0] = nloc; b.st[1] = nx; }
        const unsigned old = xb_add(&bar[XB_XSUB(b.x)], 1u);
        const unsigned gen = old / nloc;
        if (old + 1u == (gen + 1u) * nloc) {
            __builtin_amdgcn_fence(__ATOMIC_RELEASE, "agent");
            asm volatile("s_waitcnt vmcnt(0)" ::: "memory");
            const unsigned og = xb_add(&bar[XB_TOP], 1u);
            const unsigned tg = og / nx;
            if (og + 1u == (tg + 1u) * nx) xb_add(&bar[XB_TOPGEN], 1u);
            else XB_SPIN(xb_ld(&bar[XB_TOPGEN]) == tg, bar);
            __builtin_amdgcn_fence(__ATOMIC_ACQUIRE, "agent");
            xb_add(&bar[XB_XGEN(b.x)], 1u);
            asm volatile("s_waitcnt vmcnt(0)" ::: "memory");
        } else {
            XB_SPIN(xb_ld(&bar[XB_XGEN(b.x)]) == gen, bar);
            __builtin_amdgcn_fence(__ATOMIC_ACQUIRE, "agent");
            asm volatile("s_waitcnt vmcnt(0)" ::: "memory");
        }
    }
    __syncthreads();
}


__device__ __forceinline__ void xcd_barrier_bg(const XcdBarrier& b, const Frame& F, int lnext, bool drain) {
    asm volatile("s_waitcnt vmcnt(0)" ::: "memory");
    __syncthreads();
    volatile LAS unsigned* sx = b.st + 4;
    unsigned* q = (unsigned*)(F.ws + WS_CTL) + CW_BGQ + lnext * 64;
    if (b.wave == 0 && lane_now() == 0) {
        unsigned* bar = b.bar;
        __builtin_amdgcn_s_waitcnt(0);
        unsigned nloc = b.st[0], nx = b.st[1];
        if (nloc == 0u) { xcd_barrier_complete(bar, b.x, nloc, nx); b.st[0] = nloc; b.st[1] = nx; }
        const unsigned old = xb_add(&bar[XB_XSUB(b.x)], 1u);
        const unsigned gen = old / nloc;
        const bool leader = (old + 1u == (gen + 1u) * nloc);
        unsigned ti = 0u; if (!leader) { const unsigned k = xb_add(q, 1u); if (k < (unsigned)NBG) ti = k + 1u; }
        sx[0] = leader ? 1u : 0u; sx[1] = gen; sx[2] = ti;
    }
    __syncthreads();
    if (__builtin_amdgcn_readfirstlane(sx[0]) == 0u) {
        unsigned ti = (unsigned)__builtin_amdgcn_readfirstlane(sx[2]);
        while (ti != 0u) {
            const int it = lnext * TL_LAYER + NDEF + (int)ti - 1;
            conv_run(F, 0, 1, 1, [=](int) { return it; });
            if (b.wave == 0 && lane_now() == 0) {
                unsigned nt = 0u;
                if (drain || xb_ld(&b.bar[XB_XGEN(b.x)]) == sx[1]) { const unsigned k = xb_add(q, 1u); if (k < (unsigned)NBG) nt = k + 1u; }
                sx[2] = nt; }
            __syncthreads();
            ti = (unsigned)__builtin_amdgcn_readfirstlane(sx[2]);
            __syncthreads();
        }
    }
    if (b.wave == 0 && lane_now() == 0) {
        unsigned* bar = b.bar; const unsigned gen = sx[1], nx = b.st[1];
        asm volatile("s_waitcnt vmcnt(0)" ::: "memory");
        if (sx[0] != 0u) {
            __builtin_amdgcn_fence(__ATOMIC_RELEASE, "agent");
            asm volatile("s_waitcnt vmcnt(0)" ::: "memory");
            const unsigned og = xb_add(&bar[XB_TOP], 1u);
            const unsigned tg = og / nx;
            if (og + 1u == (tg + 1u) * nx) xb_add(&bar[XB_TOPGEN], 1u);
            else XB_SPIN(xb_ld(&bar[XB_TOPGEN]) == tg, bar);
            __builtin_amdgcn_fence(__ATOMIC_ACQUIRE, "agent");
            xb_add(&bar[XB_XGEN(b.x)], 1u);
            asm volatile("s_waitcnt vmcnt(0)" ::: "memory");
        } else {
            XB_SPIN(xb_ld(&bar[XB_XGEN(b.x)]) == gen, bar);
            __builtin_amdgcn_fence(__ATOMIC_ACQUIRE, "agent");
            asm volatile("s_waitcnt vmcnt(0)" ::: "memory");
        }
    }
    __syncthreads();
}

__device__ __forceinline__ bool opq(Frame& F) { asm volatile("" : "+s"(F.ws), "+s"(F.blk), "+s"(F.out), "+s"(F.G)); return true; }
__device__ __forceinline__ int lq_(int l) { asm volatile("" : "+s"(l)); return l; }
__global__ void __launch_bounds__(NTHR, 2) k_mega(Params p) {
    extern __shared__ __attribute__((aligned(16))) unsigned char lds[];
    Frame F; F.lds = (LAS unsigned char*)lds; F.ws = p.ws; F.in = p.in; F.out = p.out; F.wave = __builtin_amdgcn_readfirstlane(threadIdx.x >> 6); F.blk = blockIdx.x; F.G = gridDim.x;
    volatile LAS unsigned* st = (volatile LAS unsigned*)(F.lds + LDS_BYTES - 32);
    if (threadIdx.x < 8) st[threadIdx.x] = 0u;
    __syncthreads();
#if USE_CG_SYNC
#define GRID_BAR() cooperative_groups::this_grid().sync()
#else
    const XcdBarrier bar = xcd_barrier_post((unsigned*)(p.ws + WS_CTL) + CW_BAR + p.li * XCD_BAR_WORDS, st, F.wave);
#define GRID_BAR() xcd_barrier(bar)
#endif
    const int lo = p.ph_lo, hi = p.ph_hi;
#define RUN(k) (lo <= (k) && (k) < hi && opq(F))
#define SEAM(k) do { if (RUN(k) && RUN((k) + 1)) GRID_BAR(); } while (0)
#define SEAM_BG(k, drain) do { if (RUN(k) && RUN((k) + 1)) { if (!USE_CG_SYNC && l + 1 < DEPTH) xcd_barrier_bg(bar, F, l + 1, drain); else GRID_BAR(); } } while (0)
    if (RUN(0)) { phase_prologue(F); if (PROBE_DUP & 16) { __syncthreads(); phase_prologue(F); } }
    SEAM(0);
    { const int l = 0, b = 2; if (RUN(b + 0)) phase_norm1(F, lq_(l));
      SEAM_BG(b + 0, false); }
    for (int l = 0; l < DEPTH; ++l) {
        const int b = 2 + 13 * l;
        if (RUN(b + 1)) phase_gemm_in(F, lq_(l));
        SEAM_BG(b + 1, false);
        if (RUN(b + 2)) { phase_rec_c1(F, lq_(l)); phase_sgu(F, lq_(l)); if (PROBE_DUP & 1) { __syncthreads(); phase_rec_c1(F, lq_(l)); phase_sgu(F, lq_(l)); } if (PROBE_DUP & 64) { __syncthreads(); phase_sgu(F, lq_(l)); } }
        SEAM_BG(b + 2, false);
        if (RUN(b + 3)) { phase_rec_c2(F); if (PROBE_DUP & 4) phase_rec_c2(F); }
        SEAM_BG(b + 3, false);
        if (RUN(b + 5)) { phase_rec_c3(F, lq_(l)); if (PROBE_DUP & 2) { __syncthreads(); phase_rec_c3(F, lq_(l)); } if (PROBE_DUP & 128) { __syncthreads(); phase_rec_c3<1>(F, lq_(l)); } }
        SEAM_BG(b + 5, false);
        if (RUN(b + 6)) phase_gemm_out(F, lq_(l));
        SEAM_BG(b + 6, false);
        if (RUN(b + 7)) phase_norm2(F, lq_(l));
        SEAM_BG(b + 7, false);
        if (RUN(b + 8)) { phase_gather(F, lq_(l)); if (PROBE_DUP & 8) { __syncthreads(); phase_gather(F, lq_(l)); } }
        SEAM_BG(b + 8, false);
#if MOE_FUSED == 1
        if (RUN(b + 9)) phase_moe_fused(F, lq_(l));
        SEAM_BG(b + 9, false);
#elif MOE_FUSED == 2
        if (RUN(b + 9)) phase_moe_fused<1>(F, lq_(l));
        SEAM_BG(b + 9, false);
        if (RUN(b + 10)) phase_moe_fused<2>(F, lq_(l));
        SEAM_BG(b + 10, false);
#else
        if (RUN(b + 9)) phase_gemm_moe1(F, lq_(l));
        SEAM_BG(b + 9, false);
        if (RUN(b + 10)) phase_gemm_moe2(F, lq_(l));
        SEAM_BG(b + 10, false);
#endif
        if (RUN(b + 11)) phase_combine(F, lq_(l));
        SEAM_BG(b + 11, true);
        if (RUN(b + 12)) phase_gemm_pg(F, lq_(l));
        SEAM(b + 12);
    }
    if (RUN(54)) phase_final(F);
#undef RUN
#undef SEAM
}

#ifndef ONE_LAUNCH
#define ONE_LAUNCH 1
#endif
#ifndef CUTS
#define CUTS {0, 55}
#endif
#ifndef MFMA_MASK
#define MFMA_MASK 255
#endif
extern "C" void kernel_launch(void* const* d_in, const int* in_sizes, int n_in, void* d_out, int out_size, void* d_ws, size_t ws_size, hipStream_t stream) {
    if (n_in != 24 || out_size != T * D || ws_size < WS_END) { fprintf(stderr, "kernel_launch: unexpected shapes (n_in %d out %d ws %zu)\n", n_in, out_size, ws_size); return; }
    static_assert(CW_BAR + 60 * XCD_BAR_WORDS <= (int)(CTL_BYTES / 4), "barrier regions inside the zeroed control words");
    Params p{}; for (int i = 0; i < 24; ++i) p.in[i] = (const float*)d_in[i]; p.out = (float*)d_out; p.ws = (unsigned char*)d_ws;
    unsigned char* ws = p.ws;
    (void)hipMemsetAsync(ws + WS_CTL, 0, CTL_BYTES, stream);
    { static bool attr = false; if (!attr) { (void)hipFuncSetAttribute((const void*)k_mega, hipFuncAttributeMaxDynamicSharedMemorySize, LDS_BYTES); attr = true; }
      const int cuts[] = CUTS; const int ncut = (int)(sizeof(cuts) / sizeof(cuts[0]));
      for (int i = 0; i + 1 < ncut; ++i) { p.ph_lo = cuts[i]; p.ph_hi = cuts[i + 1]; p.li = i; p.pad = 0;
#if USE_CG_SYNC
          void* args[] = {&p}; hipError_t e = hipLaunchCooperativeKernel((const void*)k_mega, dim3(256), dim3(NTHR), args, LDS_BYTES, stream);
          if (e != hipSuccess) fprintf(stderr, "cooperative launch failed: %s\n", hipGetErrorName(e));
#else
          hipLaunchKernelGGL(k_mega, dim3(256), dim3(NTHR), LDS_BYTES, stream, p);
#endif
      }
    }
}
```

```cpp
#include <hip/hip_runtime.h>
#include <hip/hip_cooperative_groups.h>
#include <cstdio>
#include <cstdint>

#define GAS __attribute__((address_space(1)))
#define LAS __attribute__((address_space(3)))
typedef unsigned short bf16;
typedef float f32x4 __attribute__((ext_vector_type(4)));
typedef float f32x2 __attribute__((ext_vector_type(2)));
typedef unsigned u32x4 __attribute__((ext_vector_type(4)));
typedef unsigned u32x2 __attribute__((ext_vector_type(2)));
typedef short bf16x8 __attribute__((ext_vector_type(8)));

constexpr int T = 16384, D = 1024, DEPTH = 4, DIN = 3072, DREC = 512, DSGU = 512;
constexpr int NE = 32, DE = 512, PD = 256;
constexpr int RB = 256;
constexpr int CAP = 2 * T + NE * RB;
constexpr int NRBMAX = CAP / RB;
constexpr float EPS = 1e-6f;
constexpr int NWAVES = 8, NTHR = 512;

constexpr size_t MiB = 1u << 20, KiB = 1u << 10;
constexpr size_t WS_CTL = 0, CTL_BYTES = 1 * MiB;
constexpr size_t WS_MISC = 1 * MiB;
constexpr size_t MS_TOKE = WS_MISC + 0;
constexpr size_t MS_TOKW = WS_MISC + 128 * KiB;
constexpr size_t MS_SINFO = WS_MISC + 256 * KiB;
constexpr size_t MS_SDEST = WS_MISC + 384 * KiB;
constexpr size_t MS_RSTDPE = WS_MISC + 512 * KiB;
constexpr size_t MS_BLKBASE = WS_MISC + 576 * KiB;
constexpr size_t MS_LB = WS_MISC + 608 * KiB;
constexpr size_t MS_RSTD2 = WS_MISC + 704 * KiB;
constexpr size_t MS_RSTD1 = WS_MISC + 768 * KiB;
constexpr size_t MS_PART = WS_MISC + 6 * MiB;
constexpr size_t MS_BLKE = WS_MISC + 640 * KiB;
constexpr size_t MS_DC = WS_MISC + 1 * MiB;
constexpr size_t MS_WRT = WS_MISC + 2 * MiB;
constexpr size_t MS_SGUW = WS_MISC + 3 * MiB;
constexpr size_t MS_MM = WS_MISC + 4 * MiB;
constexpr size_t MS_PTOT = WS_MISC + 5 * MiB;
constexpr size_t WS_WIN = 16 * MiB;
constexpr size_t WS_WOUT = 40 * MiB;
constexpr size_t WS_WGU = 48 * MiB;
constexpr size_t WS_WD = 304 * MiB;
constexpr size_t WS_WPG = 432 * MiB;
constexpr size_t WS_WPE = 440 * MiB;
constexpr size_t WS_PB = 442 * MiB;
constexpr size_t WS_H = 474 * MiB;
constexpr size_t WS_XN = 538 * MiB;
constexpr size_t WS_O = 570 * MiB;
constexpr size_t WS_PE = 602 * MiB;
constexpr size_t WS_R1 = 730 * MiB;
constexpr size_t WS_Z = WS_R1;
constexpr size_t WS_UT = WS_R1 + 96 * MiB;
constexpr size_t WS_ST = WS_R1 + 128 * MiB;
constexpr size_t WS_ORAW = WS_R1 + 96 * MiB;
constexpr size_t WS_VN = WS_R1 + 128 * MiB;
constexpr size_t WS_XB = WS_R1;
constexpr size_t WS_HB = WS_R1 + 80 * MiB;
constexpr size_t WS_Y = WS_R1 + 120 * MiB;
constexpr size_t WS_LTOT = 930 * MiB;
constexpr size_t WS_END = 934 * MiB;
constexpr int CW_CNT = 64;
constexpr int CW_BGQ = 1024;
constexpr int CW_DONE = 2048;
constexpr int CW_BAR = 4096;

constexpr int RING_BYTES = 131072, MISC_OFF = RING_BYTES, LDS_BYTES = 147456;

#ifndef PROBE_DUP
#define PROBE_DUP 0
#endif
#ifndef MOE_VBLK
#define MOE_VBLK 1
#endif
#ifndef MOE_FUSED
#define MOE_FUSED 1
#endif
#ifndef USE_CG_SYNC
#define USE_CG_SYNC 0
#endif
struct Params { const float* in[24]; float* out; unsigned char* ws; int ph_lo, ph_hi, li, pad; };

#define LDS_WAIT() asm volatile("s_waitcnt lgkmcnt(0)" ::: "memory")
template <int M> __device__ __forceinline__ float shx(float v) { static_assert(M >= 1 && M < 32, "swizzle xor mask");
    return __int_as_float(__builtin_amdgcn_ds_swizzle(__float_as_int(v), (M << 10) | 0x1F)); }
__device__ __forceinline__ float halves_sum(float v) {
    return __int_as_float(__builtin_amdgcn_readlane(__float_as_int(v), 0)) + __int_as_float(__builtin_amdgcn_readlane(__float_as_int(v), 32)); }
__device__ __forceinline__ float wave_sum(float v) {
    v += shx<1>(v); v += shx<2>(v); v += shx<4>(v); v += shx<8>(v); v += shx<16>(v);
    return halves_sum(v);
}
typedef __bf16 bf16x2_t __attribute__((ext_vector_type(2)));
__device__ __forceinline__ unsigned pk2(float lo, float hi) { const bf16x2_t v = __builtin_convertvector((f32x2){lo, hi}, bf16x2_t); return __builtin_bit_cast(unsigned, v); }
__device__ __forceinline__ unsigned f2bf(float f) { return pk2(f, f) & 0xffffu; }
__device__ __forceinline__ float bflo(unsigned w) { return __uint_as_float(w << 16); }
__device__ __forceinline__ float bfhi(unsigned w) { return __uint_as_float(w & 0xffff0000u); }
__device__ __forceinline__ float bf2f(bf16 b) { return __uint_as_float(((unsigned)b) << 16); }
__device__ __forceinline__ float fexp(float x) { return __builtin_amdgcn_exp2f(x * 1.4426950408889634f); }
__device__ __forceinline__ float flog(float x) { return __builtin_amdgcn_logf(x) * 0.6931471805599453f; }
__device__ __forceinline__ float frcp(float x) { return __builtin_amdgcn_rcpf(x); }
__device__ __forceinline__ float frsq(float x) { return __builtin_amdgcn_rsqf(x); }
__device__ __forceinline__ float sigmoid_(float x) { return frcp(1.f + fexp(-x)); }
__device__ __forceinline__ float silu_(float x) { return x * sigmoid_(x); }
__device__ __forceinline__ float gelu_(float x) { const float K1 = 2.f * 0.7978845608028654f * 1.4426950408889634f, K3 = K1 * 0.044715f;
    const float r = frcp(__builtin_amdgcn_exp2f(x * (K1 + K3 * (x * x))) + 1.f); return x - x * r; }

struct Frame {
    LAS unsigned char* lds; unsigned char* ws; const float* const* in; float* out;
    int wave, blk, G;
};
__device__ __forceinline__ int lane_now() { int l; asm volatile("v_mbcnt_lo_u32_b32 %0, -1, 0\n\tv_mbcnt_hi_u32_b32 %0, -1, %0" : "=v"(l)); return l; }
__device__ __forceinline__ int vblk(int b) { return 4 * (8 * (b & 7) + (b >> 5)) + ((b >> 3) & 3); }
#define PH_TID() int ph_wave = F.wave; asm volatile("" : "+s"(ph_wave)); const int lane = lane_now(); (void)lane; const int tid = (ph_wave << 6) | lane; (void)tid

struct ConvJob { const float* W; const float* g; bf16* WT; int K, N, k0, n0, mode; };
constexpr int TL_IN = 16 * 12, TL_OUT = 16 * 4, TL_G = 32 * 16 * 2, TL_D = 32 * 8 * 4, TL_PG = 16 * 4, TL_PE = 4 * 4;
constexpr int TL_LAYER = TL_IN + TL_OUT + 2 * TL_G + TL_D + TL_PG + TL_PE;
__device__ __forceinline__ ConvJob conv_job(const Frame& F, int it) {
    unsigned char* ws = F.ws; const int l = it / TL_LAYER; int r = it % TL_LAYER; ConvJob j;
    if (r < TL_IN) { j.W = F.in[3] + (size_t)l * D * DIN; j.g = F.in[2] + l * D; j.WT = (bf16*)(ws + WS_WIN) + (size_t)l * DIN * D; j.K = D; j.N = DIN; j.k0 = 64 * (r / 12); j.n0 = 256 * (r % 12); j.mode = 0; return j; } r -= TL_IN;
    if (r < TL_OUT) { j.W = F.in[10] + (size_t)l * D * D; j.g = nullptr; j.WT = (bf16*)(ws + WS_WOUT) + (size_t)l * D * D; j.K = D; j.N = D; j.k0 = 64 * (r / 4); j.n0 = 256 * (r % 4); j.mode = 0; return j; } r -= TL_OUT;
    if (r < 2 * TL_G) { const int up = r >= TL_G; if (up) r -= TL_G; const int e = r / 32, rr = r % 32;
        j.W = F.in[up ? 17 : 16] + (size_t)(l * NE + e) * D * DE; j.g = F.in[11] + l * D; j.WT = (bf16*)(ws + WS_WGU) + (size_t)(l * NE + e) * 1024 * 1024; j.K = D; j.N = DE; j.k0 = 64 * (rr / 2); j.n0 = 256 * (rr % 2); j.mode = 1 + up; return j; } r -= 2 * TL_G;
    if (r < TL_D) { const int e = r / 32, rr = r % 32; j.W = F.in[18] + (size_t)(l * NE + e) * DE * D; j.g = nullptr; j.WT = (bf16*)(ws + WS_WD) + (size_t)(l * NE + e) * D * DE; j.K = DE; j.N = D; j.k0 = 64 * (rr / 4); j.n0 = 256 * (rr % 4); j.mode = 0; return j; } r -= TL_D;
    if (r < TL_PG) { j.W = F.in[20] + (size_t)l * D * D; j.g = F.in[19] + l * D; j.WT = (bf16*)(ws + WS_WPG) + (size_t)l * D * D; j.K = D; j.N = D; j.k0 = 64 * (r / 4); j.n0 = 256 * (r % 4); j.mode = 0; return j; } r -= TL_PG;
    j.W = F.in[21] + (size_t)l * PD * D; j.g = nullptr; j.WT = (bf16*)(ws + WS_WPE) + (size_t)l * D * PD; j.K = PD; j.N = D; j.k0 = 64 * (r / 4); j.n0 = 256 * (r % 4); j.mode = 0; return j;
}
__device__ __forceinline__ void conv_load(const ConvJob& j, int wave, int lane, f32x4 (&v)[8]) {
#pragma unroll
    for (int i = 0; i < 8; ++i) { const int row = 8 * wave + i; v[i] = *(const f32x4*)(j.W + (size_t)(j.k0 + row) * j.N + j.n0 + 4 * lane); if (j.g) v[i] = v[i] * j.g[j.k0 + row]; }
}
constexpr int NDEF = 0, NDEF1 = 0, NBG = 3408;
constexpr int NREST = TL_LAYER - NDEF - NBG, NPRO = TL_LAYER + 3 * NREST;
__device__ __forceinline__ int pro_tile(int f) { if (NREST == 0 || f < TL_LAYER) return f; f -= TL_LAYER; const int l = 1 + f / (NREST ? NREST : 1); return l * TL_LAYER + NDEF + NBG + f % (NREST ? NREST : 1); }
template <class M> __device__ __forceinline__ void conv_run(const Frame& F, int first, int stride, int count, M tile_of) {
    PH_TID();
    LAS float* tile = (LAS float*)F.lds;
    const int wave = ph_wave;
    int f = first; f32x4 v[8]; ConvJob cur{}, nxt{};
    if (f < count) { cur = conv_job(F, tile_of(f)); conv_load(cur, wave, lane, v); }
    while (f < count) {
#pragma unroll
        for (int i = 0; i < 8; ++i) { LAS float* d = tile + (8 * wave + i) * 257 + 4 * lane; d[0] = v[i].x; d[1] = v[i].y; d[2] = v[i].z; d[3] = v[i].w; }
        __syncthreads();
        const int fn = f + stride; if (fn < count) { nxt = conv_job(F, tile_of(fn)); conv_load(nxt, wave, lane, v); }
#pragma unroll
        for (int q = 0; q < 4; ++q) { const int nn = 32 * wave + 8 * q + (lane >> 3), c = lane & 7; const LAS float* sp = tile + (8 * c) * 257 + nn;
            u32x4 o; o.x = pk2(sp[0 * 257], sp[1 * 257]); o.y = pk2(sp[2 * 257], sp[3 * 257]); o.z = pk2(sp[4 * 257], sp[5 * 257]); o.w = pk2(sp[6 * 257], sp[7 * 257]);
            const int n = cur.n0 + nn; const int drow = cur.mode == 0 ? n : ((n >> 7) * 256 + (n & 127) + (cur.mode == 2 ? 128 : 0));
            *(u32x4*)(cur.WT + (size_t)drow * cur.K + cur.k0 + 8 * c) = o; }
        __syncthreads();
        cur = nxt; f = fn;
    }
}
__device__ __forceinline__ void conv_deferred(const Frame& F, int lnext, int r0, int r1, int first, int idle) {
    if (lnext >= DEPTH || F.blk < first) return;
    conv_run(F, F.blk - first, idle, r1 - r0, [=](int f) { return lnext * TL_LAYER + r0 + f; });
}
__device__ __forceinline__ void phase_prologue(const Frame& F) {
    PH_TID();
    unsigned char* ws = F.ws;
    conv_run(F, F.blk, F.G, NPRO, [](int f) { return pro_tile(f); });
    { const f32x4* src = (const f32x4*)F.in[1]; u32x4* dst = (u32x4*)(ws + WS_PB); const size_t n8 = (size_t)DEPTH * T * PD / 8;
      for (size_t i = (size_t)F.blk * NTHR + tid; i < n8; i += (size_t)F.G * NTHR) { const f32x4 a = src[2 * i], b = src[2 * i + 1]; u32x4 o; o.x = pk2(a.x, a.y); o.y = pk2(a.z, a.w); o.z = pk2(b.x, b.y); o.w = pk2(b.z, b.w); dst[i] = o; } }
    { float* wrt = (float*)(ws + MS_WRT);
      for (int i = F.blk * NTHR + tid; i < DEPTH * 36 * D; i += F.G * NTHR) { const int k = i % D, n = (i / D) % 36, l = i / (36 * D);
          const float w = n < 4 ? F.in[12][((size_t)l * D + k) * 4 + n] : F.in[14][((size_t)l * D + k) * NE + (n - 4)]; wrt[i] = w * F.in[11][l * D + k]; } }
    { bf16* wb = (bf16*)(ws + MS_SGUW); for (int i = F.blk * NTHR + tid; i < DEPTH * 4 * 128 * 128; i += F.G * NTHR) { const int tc = (i >> 7) & 127, sp = i & 127; wb[i] = sp <= tc ? (bf16)f2bf(F.in[8][i]) : (bf16)0; } }
    if (F.blk == 0 && tid < DREC) { const int c = tid; float v[DEPTH], m = -1e30f;
#pragma unroll
        for (int l = 0; l < DEPTH; ++l) { v[l] = F.in[4][l * DREC + c]; m = fmaxf(m, v[l]); }
        float s = 0.f;
#pragma unroll
        for (int l = 0; l < DEPTH; ++l) { v[l] = fexp(v[l] - m); s += v[l]; }
        float* lb = (float*)(ws + MS_LB); float acc = 0.f;
#pragma unroll
        for (int l = 0; l < DEPTH; ++l) { if (l > 0) acc += v[l] / s; lb[l * DREC + c] = acc; } }
}

__device__ __forceinline__ void load_row(const float* row, int lane, f32x4 (&v)[4]) { const f32x4* r = (const f32x4*)row + lane;
#pragma unroll
    for (int j = 0; j < 4; ++j) v[j] = r[64 * j]; }
__device__ __forceinline__ void load_row_bf(const bf16* row, int lane, f32x4 (&v)[4]) { const u32x2* r = (const u32x2*)row + lane;
#pragma unroll
    for (int j = 0; j < 4; ++j) { const u32x2 x = r[64 * j]; v[j] = (f32x4){bflo(x.x), bfhi(x.x), bflo(x.y), bfhi(x.y)}; } }
__device__ __forceinline__ float row_sumsq(const f32x4 (&v)[4]) { float s = 0.f;
#pragma unroll
    for (int j = 0; j < 4; ++j) s += (v[j].x * v[j].x + v[j].y * v[j].y) + (v[j].z * v[j].z + v[j].w * v[j].w);
    return wave_sum(s); }
__device__ __forceinline__ void store_row_bf16(bf16* orow, int lane, const f32x4 (&v)[4], float s) { u32x2* o = (u32x2*)orow + lane;
#pragma unroll
    for (int j = 0; j < 4; ++j) { u32x2 w; w.x = pk2(v[j].x * s, v[j].y * s); w.y = pk2(v[j].z * s, v[j].w * s); o[64 * j] = w; } }

__device__ __forceinline__ void phase_norm1(const Frame& F, int l) {
    PH_TID();
    float* rstd1 = (float*)(F.ws + MS_RSTD1); bf16* h = (bf16*)(F.ws + WS_H); const float* x = F.in[0];
    const int gw = F.blk * NWAVES + ph_wave, NGW = F.G * NWAVES;
    for (int t = gw; t < T; t += NGW) { f32x4 v[4];
        if (l == 0) { load_row(x + (size_t)t * D, lane, v); store_row_bf16(h + (size_t)t * D, lane, v, 1.f); } else load_row_bf(h + (size_t)t * D, lane, v);
        const float rstd = frsq(row_sumsq(v) * (1.f / D) + EPS); if (lane == 0) rstd1[t] = rstd; }
}
__device__ __forceinline__ float bfly8(const float (&r)[8], int lane) {
    const bool b2 = lane & 4, b1 = lane & 2, b0 = lane & 1; float a[4], c[2];
#pragma unroll
    for (int i = 0; i < 4; ++i) { const float keep = b2 ? r[i + 4] : r[i], send = b2 ? r[i] : r[i + 4]; a[i] = keep + shx<4>(send); }
#pragma unroll
    for (int i = 0; i < 2; ++i) { const float keep = b1 ? a[i + 2] : a[i], send = b1 ? a[i] : a[i + 2]; c[i] = keep + shx<2>(send); }
    const float keep = b0 ? c[1] : c[0], send = b0 ? c[0] : c[1]; float d = keep + shx<1>(send);
    d += shx<8>(d); d += shx<16>(d);
    return d + __int_as_float(__builtin_amdgcn_ds_bpermute((lane ^ 32) << 2, __float_as_int(d)));
}
__device__ __forceinline__ void phase_norm2(const Frame& F, int l) {
    PH_TID();
    unsigned char* ws = F.ws;
    unsigned* hist = (unsigned*)(F.lds + MISC_OFF + 256);
    if (tid < 32) hist[tid] = 0u;
    __syncthreads();
    const bf16* h = (const bf16*)(ws + WS_H); bf16* XN = (bf16*)(ws + WS_XN);
    const float* WrT = (const float*)(ws + MS_WRT) + (size_t)l * 36 * D;
    const float* b_rg = F.in[13] + l * 4; const float* b_re = F.in[15] + l * NE;
    int* tok_e = (int*)(ws + MS_TOKE); float* tok_w = (float*)(ws + MS_TOKW); unsigned* sinfo = (unsigned*)(ws + MS_SINFO);
    const int RPB = T / F.G, RPW = RPB / NWAVES;
    for (int i0 = 0; i0 < RPW; i0 += 8) {
        const int t0 = F.blk * RPB + ph_wave * RPW + i0;
        f32x4 v[8][4]; float ss[8];
#pragma unroll
        for (int r = 0; r < 8; ++r) { load_row_bf(h + (size_t)(t0 + r) * D, lane, v[r]); float q = 0.f;
#pragma unroll
            for (int j = 0; j < 4; ++j) q += (v[r][j].x * v[r][j].x + v[r][j].y * v[r][j].y) + (v[r][j].z * v[r][j].z + v[r][j].w * v[r][j].w);
            ss[r] = q; }
        const float rstd_mine = frsq(bfly8(ss, lane) * (1.f / D) + EPS);
        if (lane < 8) ((float*)(ws + MS_RSTD2))[t0 + lane] = rstd_mine;
        LAS float* lgw = (LAS float*)(F.lds + 4096) + ph_wave * (36 * 8);
#pragma unroll 2
        for (int n = 0; n < 36; ++n) { const f32x4* wr = (const f32x4*)(WrT + (size_t)n * D) + lane; const f32x4 w0 = wr[0], w1 = wr[64], w2 = wr[128], w3 = wr[192]; float pr[8];
#pragma unroll
            for (int r = 0; r < 8; ++r) pr[r] = ((v[r][0].x * w0.x + v[r][0].y * w0.y) + (v[r][0].z * w0.z + v[r][0].w * w0.w)) + ((v[r][1].x * w1.x + v[r][1].y * w1.y) + (v[r][1].z * w1.z + v[r][1].w * w1.w))
                                                 + ((v[r][2].x * w2.x + v[r][2].y * w2.y) + (v[r][2].z * w2.z + v[r][2].w * w2.w)) + ((v[r][3].x * w3.x + v[r][3].y * w3.y) + (v[r][3].z * w3.z + v[r][3].w * w3.w));
            const float val = bfly8(pr, lane) * rstd_mine; if (lane < 8) lgw[n * 8 + lane] = val; }
        const int row = lane & 7;
        float lg4[4], lgb[4];
#pragma unroll
        for (int j = 0; j < 4; ++j) { lg4[j] = lgw[j * 8 + row]; lgb[j] = lg4[j] + b_rg[j]; }
        int gs = 0; float gm = lgb[0];
#pragma unroll
        for (int j = 1; j < 4; ++j) if (lgb[j] > gm) { gm = lgb[j]; gs = j; }
        float mx = fmaxf(fmaxf(lg4[0], lg4[1]), fmaxf(lg4[2], lg4[3])), se = 0.f, lsel = lg4[0];
#pragma unroll
        for (int j = 0; j < 4; ++j) { se += fexp(lg4[j] - mx); if (j == gs) lsel = lg4[j]; }
        const float g_w = fexp(lsel - mx) * frcp(se);
        float le[8], leb[8];
#pragma unroll
        for (int j = 0; j < 8; ++j) { le[j] = lgw[(4 + gs * 8 + j) * 8 + row]; leb[j] = le[j] + b_re[gs * 8 + j]; }
        int s0 = 0; float m0 = leb[0];
#pragma unroll
        for (int j = 1; j < 8; ++j) if (leb[j] > m0) { m0 = leb[j]; s0 = j; }
        int s1 = -1; float m1 = -3.0e38f;
#pragma unroll
        for (int j = 0; j < 8; ++j) if (j != s0 && leb[j] > m1) { m1 = leb[j]; s1 = j; }
        if (s1 < 0) s1 = (s0 == 0) ? 1 : 0;
        float la = le[0], lb2 = le[0];
#pragma unroll
        for (int j = 1; j < 8; ++j) { if (j == s0) la = le[j]; if (j == s1) lb2 = le[j]; }
        const float wa = frcp(1.f + fexp(lb2 - la)), wb = 1.f - wa;
        if (lane < 8) { const int t = t0 + lane;
            const int e0 = gs * 8 + s0, e1 = gs * 8 + s1;
            const unsigned r0 = atomicAdd(&hist[e0], 1u), r1 = atomicAdd(&hist[e1], 1u);
            tok_e[2 * t] = e0; tok_e[2 * t + 1] = e1; tok_w[2 * t] = g_w * wa; tok_w[2 * t + 1] = g_w * wb;
            sinfo[2 * t] = ((unsigned)F.blk << 16) | r0; sinfo[2 * t + 1] = ((unsigned)F.blk << 16) | r1;
        }
    }
    __syncthreads();
    if (tid < 32) { unsigned* cnt = (unsigned*)(ws + WS_CTL) + CW_CNT + l * 32;
        const unsigned base = __hip_atomic_fetch_add(cnt + tid, hist[tid], __ATOMIC_RELAXED, __HIP_MEMORY_SCOPE_AGENT);
        ((unsigned*)(ws + MS_BLKBASE))[F.blk * 32 + tid] = base; }
}
__device__ __forceinline__ void phase_gather(const Frame& F, int l) {
    PH_TID();
    unsigned char* ws = F.ws;
    int* ps = (int*)(F.lds + MISC_OFF + 512);
    if (tid == 0) { unsigned* cnt = (unsigned*)(ws + WS_CTL) + CW_CNT + l * 32; int* blke = (int*)(ws + MS_BLKE) + l * 256; int acc = 0;
        for (int e = 0; e < NE; ++e) { const int c = (int)__hip_atomic_load(cnt + e, __ATOMIC_RELAXED, __HIP_MEMORY_SCOPE_AGENT); ps[e] = acc; const int pad = (c + RB - 1) / RB * RB;
            if (F.blk == 0) for (int rb = acc / RB; rb < (acc + pad) / RB; ++rb) blke[rb] = e;
            acc += pad; }
        if (F.blk == 0) blke[255] = acc / RB; }
    __syncthreads();
    const int* tok_e = (const int*)(ws + MS_TOKE); const unsigned* sinfo = (const unsigned*)(ws + MS_SINFO); const unsigned* bbase = (const unsigned*)(ws + MS_BLKBASE);
    int* sdest = (int*)(ws + MS_SDEST); const bf16* hres = (const bf16*)(ws + WS_H); const float* rstd2 = (const float*)(ws + MS_RSTD2); bf16* XB = (bf16*)(ws + WS_XB);
    const int gw = F.blk * NWAVES + ph_wave, NGW = F.G * NWAVES;
    for (int t = gw; t < T; t += NGW) {
        const u32x4* src = (const u32x4*)(hres + (size_t)t * D) + lane; const u32x4 ha = src[0], hb = src[64]; const float rs = rstd2[t];
        u32x4 a, b;
        a.x = pk2(bflo(ha.x) * rs, bfhi(ha.x) * rs); a.y = pk2(bflo(ha.y) * rs, bfhi(ha.y) * rs); a.z = pk2(bflo(ha.z) * rs, bfhi(ha.z) * rs); a.w = pk2(bflo(ha.w) * rs, bfhi(ha.w) * rs);
        b.x = pk2(bflo(hb.x) * rs, bfhi(hb.x) * rs); b.y = pk2(bflo(hb.y) * rs, bfhi(hb.y) * rs); b.z = pk2(bflo(hb.z) * rs, bfhi(hb.z) * rs); b.w = pk2(bflo(hb.w) * rs, bfhi(hb.w) * rs);
#pragma unroll
        for (int j = 0; j < 2; ++j) { const int e = tok_e[2 * t + j]; const unsigned info = sinfo[2 * t + j];
            const int dest = ps[e] + (int)bbase[(info >> 16) * 32 + e] + (int)(info & 0xffffu);
            if (lane == 0) sdest[2 * t + j] = dest;
            u32x4* dst = (u32x4*)(XB + (size_t)dest * D) + lane; dst[0] = a; dst[64] = b; }
    }
}
__device__ __forceinline__ void phase_combine(const Frame& F, int l) {
    PH_TID();
    unsigned char* ws = F.ws;
    bf16* h = (bf16*)(ws + WS_H); bf16* XN = (bf16*)(ws + WS_XN); const bf16* Y = (const bf16*)(ws + WS_Y); const bf16* PE = (const bf16*)(ws + WS_PE) + (size_t)l * T * D;
    const int* sdest = (const int*)(ws + MS_SDEST); const float* tok_w = (const float*)(ws + MS_TOKW); float* rstd_pe = (float*)(ws + MS_RSTDPE);
    const int gw = F.blk * NWAVES + ph_wave, NGW = F.G * NWAVES;
    struct Rows { u32x2 h[4], y0[4], y1[4], pe[4]; };
    auto fetch = [&](int t, int d0, int d1, Rows& r) {
        const u32x2* hp = (const u32x2*)(h + (size_t)t * D) + lane; const u32x2* y0 = (const u32x2*)(Y + (size_t)d0 * D) + lane; const u32x2* y1 = (const u32x2*)(Y + (size_t)d1 * D) + lane; const u32x2* pe = (const u32x2*)(PE + (size_t)t * D) + lane;
#pragma unroll
        for (int j = 0; j < 4; ++j) { r.h[j] = hp[64 * j]; r.y0[j] = y0[64 * j]; r.y1[j] = y1[64 * j]; r.pe[j] = pe[64 * j]; } };
    int t = gw; if (t >= T) return;
    Rows cur; int d0n = 0, d1n = 0; float w0 = tok_w[2 * t], w1 = tok_w[2 * t + 1], w0n = 0.f, w1n = 0.f;
    fetch(t, sdest[2 * t], sdest[2 * t + 1], cur);
    if (t + NGW < T) { d0n = sdest[2 * (t + NGW)]; d1n = sdest[2 * (t + NGW) + 1]; w0n = tok_w[2 * (t + NGW)]; w1n = tok_w[2 * (t + NGW) + 1]; }
    for (; t < T; t += NGW) {
        Rows nxt = cur; const float w0c = w0, w1c = w1; const bool more = t + NGW < T;
        if (more) { fetch(t + NGW, d0n, d1n, nxt); w0 = w0n; w1 = w1n;
            if (t + 2 * NGW < T) { d0n = sdest[2 * (t + 2 * NGW)]; d1n = sdest[2 * (t + 2 * NGW) + 1]; w0n = tok_w[2 * (t + 2 * NGW)]; w1n = tok_w[2 * (t + 2 * NGW) + 1]; } }
        f32x4 v[4]; float sp = 0.f;
#pragma unroll
        for (int j = 0; j < 4; ++j) { const u32x2 x = cur.h[j], a = cur.y0[j], b = cur.y1[j], c = cur.pe[j];
            v[j] = (f32x4){bflo(x.x) + (w0c * bflo(a.x) + w1c * bflo(b.x)), bfhi(x.x) + (w0c * bfhi(a.x) + w1c * bfhi(b.x)), bflo(x.y) + (w0c * bflo(a.y) + w1c * bflo(b.y)), bfhi(x.y) + (w0c * bfhi(a.y) + w1c * bfhi(b.y))};
            const float p0 = bflo(c.x), p1 = bfhi(c.x), p2 = bflo(c.y), p3 = bfhi(c.y); sp += (p0 * p0 + p1 * p1) + (p2 * p2 + p3 * p3); }
        store_row_bf16(h + (size_t)t * D, lane, v, 1.f);
        const float rstd = frsq(row_sumsq(v) * (1.f / D) + EPS); store_row_bf16(XN + (size_t)t * D, lane, v, rstd);
        sp = wave_sum(sp); if (lane == 0) rstd_pe[t] = frsq(sp * (1.f / D) + EPS);
        cur = nxt;
    }
}
__device__ __forceinline__ void phase_final(const Frame& F) {
    PH_TID();
    const bf16* h = (const bf16*)(F.ws + WS_H); const float* nf = F.in[23];
    const int gw = F.blk * NWAVES + ph_wave, NGW = F.G * NWAVES;
    for (int t = gw; t < T; t += NGW) { f32x4 v[4]; load_row_bf(h + (size_t)t * D, lane, v); const float rstd = frsq(row_sumsq(v) * (1.f / D) + EPS);
        f32x4* o = (f32x4*)(F.out + (size_t)t * D) + lane; const f32x4* g = (const f32x4*)nf + lane;
#pragma unroll
        for (int j = 0; j < 4; ++j) o[64 * j] = v[j] * rstd * g[64 * j]; }
}


namespace pg8 {
constexpr int BM = 256, BK = 64, HALF = 128, HTB = HALF * BK * 2, STAGE_BYTES = 8 * HTB, NXCD = 8, WGM = 8;
__host__ __device__ __forceinline__ int lds_byte(int r, int c) { const int st = (r >> 4) * 2 + (c >> 5), rr = r & 15, cc = c & 31, ob = rr * 64 + cc * 2; return st * 1024 + (ob ^ (((ob >> 9) & 1) << 5)); }
__host__ __device__ __forceinline__ void stage_rc(int b, int& R, int& C) { const int st = b / 1024, sb = b % 1024, swz = sb ^ (((sb >> 9) & 1) << 5); R = (st >> 1) * 16 + swz / 64; C = (st & 1) * 32 + (swz % 64) / 2; }
__host__ __device__ __forceinline__ int perm32(int rho) { const int n = rho >> 4, i = rho & 15; return 8 * (i >> 2) + 4 * n + (i & 3); }
struct Unit { int pm, pn; const char* A; const char* B; };
__device__ __forceinline__ void static_map(int wgid, int nM, int nN, int& pm, int& pn) {
    const int nwg = nM * nN; { const int q = nwg / NXCD, r = nwg % NXCD, xcd = wgid % NXCD, off = wgid / NXCD; wgid = (xcd < r ? xcd * (q + 1) : r * (q + 1) + (xcd - r) * q) + off; }
    const int nig = WGM * nN, gid = wgid / nig, fm = gid * WGM, gsz = (nM - fm) < WGM ? (nM - fm) : WGM;
    pm = fm + ((wgid % nig) % gsz); pn = (wgid % nig) / gsz;
}
struct DenseOrder { static constexpr bool DEPS = false;
    const char* A; const char* Bt; int nM, nN, nL, G, c; size_t tstep;
    __device__ void init(const void* A_, const void* Bt_, int M, int N, int K, int nL_, int G_, int c_) { A = (const char*)A_; Bt = (const char*)Bt_; nM = M / BM; nN = N / BM; nL = nL_; G = G_; c = c_; tstep = (size_t)BM * K * 2; }
    __device__ bool next(int i, Unit& u) const { const long L = (long)i * G + c; const int per = nM * nN; if (L >= (long)per * nL) return false;
        const int l = (int)(L / per); int pm, pn; static_map((int)(L % per), nM, nN, pm, pn); u.pm = l * nM + pm; u.pn = pn; u.A = A + (size_t)u.pm * tstep; u.B = Bt + (size_t)(l * nN + pn) * tstep; return true; }
};
struct MoeOrder { static constexpr bool DEPS = false;
    const char* A; const char* W; const int* blke; int nrb, nN, G, c, e0, e1, e2; size_t a_tstep, w_estride, b_tstep;
    __device__ void init(const void* A_, const void* W_, const int* blke_, int K, int nN_, size_t w_estride_bytes, int G_, int c_) { A = (const char*)A_; W = (const char*)W_; blke = blke_; nrb = __builtin_amdgcn_readfirstlane(blke_[255]); nN = nN_; G = G_; c = c_;
        a_tstep = (size_t)BM * K * 2; b_tstep = a_tstep; w_estride = w_estride_bytes;
        const int r0 = c / nN, r1 = (G + c) / nN, r2 = (2 * G + c) / nN; const int x0 = blke_[r0 < 255 ? r0 : 254], x1 = blke_[r1 < 255 ? r1 : 254], x2 = blke_[r2 < 255 ? r2 : 254];
        e0 = __builtin_amdgcn_readfirstlane(x0); e1 = __builtin_amdgcn_readfirstlane(x1); e2 = __builtin_amdgcn_readfirstlane(x2); }
    __device__ bool next(int i, Unit& u) const { const long L = (long)i * G + c; if (L >= (long)nrb * nN) return false; const int rb = (int)(L / nN), pn = (int)(L % nN);
        const int ex = i == 0 ? e0 : i == 1 ? e1 : i == 2 ? e2 : __builtin_amdgcn_readfirstlane(blke[rb]);
        u.pm = rb; u.pn = pn; u.A = A + (size_t)rb * a_tstep; u.B = W + (size_t)ex * w_estride + (size_t)pn * b_tstep; return true; }
};
__device__ __forceinline__ unsigned ag_ld(const unsigned* p)        { return __hip_atomic_load(p, __ATOMIC_RELAXED, __HIP_MEMORY_SCOPE_AGENT); }
__device__ __forceinline__ unsigned ag_add(unsigned* p, unsigned v) { return __hip_atomic_fetch_add(p, v, __ATOMIC_RELAXED, __HIP_MEMORY_SCOPE_AGENT); }
struct MoeDepOrder { static constexpr bool DEPS = true;
    const char* A; const char* W; const int* blke; const unsigned* done; int nrb, nN, G, c, e0, e1, e2; size_t a_tstep, w_estride, b_tstep;
    __device__ void init(const void* A_, const void* W_, const int* blke_, const unsigned* done_, int K, int nN_, size_t w_estride_bytes, int G_, int c_) { A = (const char*)A_; W = (const char*)W_; blke = blke_; done = done_;
        nrb = __builtin_amdgcn_readfirstlane(blke_[255]); nN = nN_; G = G_; c = c_; a_tstep = (size_t)BM * K * 2; b_tstep = a_tstep; w_estride = w_estride_bytes;
        const int r0 = c / nN, r1 = (G + c) / nN, r2 = (2 * G + c) / nN; const int x0 = blke_[r0 < 255 ? r0 : 254], x1 = blke_[r1 < 255 ? r1 : 254], x2 = blke_[r2 < 255 ? r2 : 254];
        e0 = __builtin_amdgcn_readfirstlane(x0); e1 = __builtin_amdgcn_readfirstlane(x1); e2 = __builtin_amdgcn_readfirstlane(x2); }
    __device__ bool next(int i, Unit& u) const { const long L = (long)i * G + c; if (L >= (long)nrb * nN) return false; const int rb = (int)(L / nN), pn = (int)(L % nN);
        const int ex = i == 0 ? e0 : i == 1 ? e1 : i == 2 ? e2 : __builtin_amdgcn_readfirstlane(blke[rb]);
        u.pm = rb; u.pn = pn; u.A = A + (size_t)rb * a_tstep; u.B = W + (size_t)ex * w_estride + (size_t)pn * b_tstep; return true; }
    __device__ void wait(const Unit& u, int wid) const {
        if (wid == 0 && lane_now() == 0) { while (ag_ld(done + u.pm) < 4u) __builtin_amdgcn_s_sleep(1); __builtin_amdgcn_fence(__ATOMIC_ACQUIRE, "agent"); } }
};
struct RangeOrder { static constexpr bool DEPS = false;
    const char* A; const char* Bt; int nM, nN, j0, n; size_t tstep;
    __device__ void init(const void* A_, const void* Bt_, int M, int N, int K, int j0_, int n_) { A = (const char*)A_; Bt = (const char*)Bt_; nM = M / BM; nN = N / BM; j0 = j0_; n = n_; tstep = (size_t)BM * K * 2; }
    __device__ bool next(int i, Unit& u) const { if (i >= n) return false; int pm, pn; static_map(j0 + i, nM, nN, pm, pn); u.pm = pm; u.pn = pn; u.A = A + (size_t)pm * tstep; u.B = Bt + (size_t)pn * tstep; return true; }
};
__device__ __forceinline__ unsigned cvt_pk_bf16(float lo, float hi) { return pk2(lo, hi); }
struct EpiBf16 { static constexpr bool PERM = true, ACC_INIT = false, SIGNAL = false; bf16* O; int ldc;
    __device__ __forceinline__ void operator()(const f32x4 (&acc)[2][2][4][2], const Unit& u, int wr, int wc, int, int) const {
        const int t2 = lane_now(), fr = t2 & 15, fq = t2 >> 4;
        const int row0 = u.pm * BM + wr * 64 + fr, col0 = u.pn * BM + wc * 32 + 8 * fq;
#pragma unroll
        for (int ai = 0; ai < 2; ++ai)
#pragma unroll
            for (int m = 0; m < 4; ++m) { bf16* rowp = O + (size_t)(row0 + ai * HALF + m * 16) * ldc + col0;
#pragma unroll
                for (int bj = 0; bj < 2; ++bj) { const f32x4 v0 = acc[ai][bj][m][0], v1 = acc[ai][bj][m][1];
                    u32x4 w; w.x = cvt_pk_bf16(v0[0], v0[1]); w.y = cvt_pk_bf16(v0[2], v0[3]); w.z = cvt_pk_bf16(v1[0], v1[1]); w.w = cvt_pk_bf16(v1[2], v1[3]);
                    *(u32x4*)(rowp + bj * HALF) = w; } }
    } };
struct EpiBf16Rs { static constexpr bool PERM = true, ACC_INIT = false, SIGNAL = false; bf16* O; int ldc; const float* rs; const float* part;
    __device__ __forceinline__ void operator()(const f32x4 (&acc)[2][2][4][2], const Unit& u, int wr, int wc, int, int) const {
        const int t2 = lane_now(), fr = t2 & 15, fq = t2 >> 4;
        const int row0 = u.pm * BM + wr * 64 + fr, col0 = u.pn * BM + wc * 32 + 8 * fq;
#pragma unroll
        for (int ai = 0; ai < 2; ++ai)
#pragma unroll
            for (int m = 0; m < 4; ++m) { const int row = row0 + ai * HALF + m * 16; const float r = part ? frsq(((part[row] + part[T + row]) + (part[2 * T + row] + part[3 * T + row])) * (1.f / D) + EPS) : rs[row]; bf16* rowp = O + (size_t)row * ldc + col0;
#pragma unroll
                for (int bj = 0; bj < 2; ++bj) { const f32x4 v0 = acc[ai][bj][m][0] * r, v1 = acc[ai][bj][m][1] * r;
                    u32x4 w; w.x = cvt_pk_bf16(v0[0], v0[1]); w.y = cvt_pk_bf16(v0[2], v0[3]); w.z = cvt_pk_bf16(v1[0], v1[1]); w.w = cvt_pk_bf16(v1[2], v1[3]);
                    *(u32x4*)(rowp + bj * HALF) = w; } }
    } };
struct EpiResid { static constexpr bool PERM = true, ACC_INIT = true, SIGNAL = false; bf16* h;
    __device__ __forceinline__ void init(f32x4 (&acc)[2][2][4][2], const Unit& u, int wr, int wc, int fr, int fq) const {
        const int row0 = u.pm * BM + wr * 64 + fr, col0 = u.pn * BM + wc * 32 + 8 * fq;
#pragma unroll
        for (int ai = 0; ai < 2; ++ai)
#pragma unroll
            for (int m = 0; m < 4; ++m) { const bf16* rowp = h + (size_t)(row0 + ai * HALF + m * 16) * D + col0;
#pragma unroll
                for (int bj = 0; bj < 2; ++bj) { const u32x4 x = *(const u32x4*)(rowp + bj * HALF);
                    acc[ai][bj][m][0] = (f32x4){bflo(x.x), bfhi(x.x), bflo(x.y), bfhi(x.y)}; acc[ai][bj][m][1] = (f32x4){bflo(x.z), bfhi(x.z), bflo(x.w), bfhi(x.w)}; } }
    }
    __device__ __forceinline__ void operator()(const f32x4 (&acc)[2][2][4][2], const Unit& u, int wr, int wc, int fr, int fq) const {
        asm volatile("" : "+v"(fr), "+v"(fq));
        const int row0 = u.pm * BM + wr * 64 + fr, col0 = u.pn * BM + wc * 32 + 8 * fq;
#pragma unroll
        for (int ai = 0; ai < 2; ++ai)
#pragma unroll
            for (int m = 0; m < 4; ++m) { bf16* rowp = h + (size_t)(row0 + ai * HALF + m * 16) * D + col0;
#pragma unroll
                for (int bj = 0; bj < 2; ++bj) { const f32x4 v0 = acc[ai][bj][m][0], v1 = acc[ai][bj][m][1];
                    u32x4 w; w.x = cvt_pk_bf16(v0[0], v0[1]); w.y = cvt_pk_bf16(v0[2], v0[3]); w.z = cvt_pk_bf16(v1[0], v1[1]); w.w = cvt_pk_bf16(v1[2], v1[3]);
                    *(u32x4*)(rowp + bj * HALF) = w; } }
    } };
struct EpiGateUp { static constexpr bool PERM = true, ACC_INIT = false, SIGNAL = false; bf16* H;
    __device__ __forceinline__ void operator()(const f32x4 (&acc)[2][2][4][2], const Unit& u, int wr, int wc, int, int) const {
        const int t2 = lane_now(), fr = t2 & 15, fq = t2 >> 4;
        const int row0 = u.pm * BM + wr * 64 + fr, col0 = u.pn * HALF + wc * 32 + 8 * fq;
#pragma unroll
        for (int ai = 0; ai < 2; ++ai)
#pragma unroll
            for (int m = 0; m < 4; ++m) { bf16* rowp = H + (size_t)(row0 + ai * HALF + m * 16) * DE + col0; float v[8];
#pragma unroll
                for (int n = 0; n < 2; ++n)
#pragma unroll
                    for (int j = 0; j < 4; ++j) v[4 * n + j] = silu_(acc[ai][0][m][n][j]) * acc[ai][1][m][n][j];
                u32x4 w; w.x = cvt_pk_bf16(v[0], v[1]); w.y = cvt_pk_bf16(v[2], v[3]); w.z = cvt_pk_bf16(v[4], v[5]); w.w = cvt_pk_bf16(v[6], v[7]);
                *(u32x4*)rowp = w; }
    } };
struct EpiGateUpPub { static constexpr bool PERM = true, ACC_INIT = false, SIGNAL = true; __amdgpu_buffer_rsrc_t rs; unsigned* done;
    __device__ __forceinline__ void operator()(const f32x4 (&acc)[2][2][4][2], const Unit& u, int wr, int wc, int fr, int fq) const {
        asm volatile("" : "+v"(fr), "+v"(fq));
        const int row0 = u.pm * BM + wr * 64 + fr, col0 = u.pn * HALF + wc * 32 + 8 * fq;
#pragma unroll
        for (int ai = 0; ai < 2; ++ai)
#pragma unroll
            for (int m = 0; m < 4; ++m) { const unsigned off = (unsigned)(((row0 + ai * HALF + m * 16) * DE + col0) * 2); float v[8];
#pragma unroll
                for (int n = 0; n < 2; ++n)
#pragma unroll
                    for (int j = 0; j < 4; ++j) v[4 * n + j] = silu_(acc[ai][0][m][n][j]) * acc[ai][1][m][n][j];
                u32x4 w; w.x = cvt_pk_bf16(v[0], v[1]); w.y = cvt_pk_bf16(v[2], v[3]); w.z = cvt_pk_bf16(v[4], v[5]); w.w = cvt_pk_bf16(v[6], v[7]);
                __builtin_amdgcn_raw_buffer_store_b128(w, rs, off, 0, 16); }
    }
    __device__ __forceinline__ void signal(const Unit& u) const { (void)ag_add(done + u.pm, 1u); }
};
struct EpiPG { static constexpr bool PERM = true, ACC_INIT = false, SIGNAL = false; bf16* h; const bf16* PE; const float* rstd_pe; const float* norm_pe; LAS float* red; float* part;
    __device__ __forceinline__ void operator()(const f32x4 (&acc)[2][2][4][2], const Unit& u, int wr, int wc, int, int) const {
        const int t2 = lane_now(), fr = t2 & 15, fq = t2 >> 4;
        const int row0 = u.pm * BM + wr * 64 + fr, col0 = u.pn * BM + wc * 32 + 8 * fq;
        f32x4 nv[2][2];
#pragma unroll
        for (int bj = 0; bj < 2; ++bj)
#pragma unroll
            for (int n = 0; n < 2; ++n) nv[bj][n] = *(const f32x4*)(norm_pe + col0 + bj * HALF + 4 * n);
        float sq[2][4];
#pragma unroll
        for (int ai = 0; ai < 2; ++ai)
#pragma unroll
        for (int mh = 0; mh < 2; ++mh) {
            u32x4 pe[4][2], hx[4][2]; float rs[4];
#pragma unroll
            for (int m = 2 * mh; m < 2 * mh + 2; ++m) { const int row = row0 + ai * HALF + m * 16; rs[m] = rstd_pe[row];
#pragma unroll
                for (int bj = 0; bj < 2; ++bj) { const size_t o = (size_t)row * D + col0 + bj * HALF; pe[m][bj] = *(const u32x4*)(PE + o); hx[m][bj] = *(const u32x4*)(h + o); } }
#pragma unroll
            for (int m = 2 * mh; m < 2 * mh + 2; ++m) { const int row = row0 + ai * HALF + m * 16; float q = 0.f;
#pragma unroll
                for (int bj = 0; bj < 2; ++bj) { const size_t o = (size_t)row * D + col0 + bj * HALF; const u32x4 p = pe[m][bj], x = hx[m][bj];
                    f32x4 h0 = (f32x4){bflo(x.x), bfhi(x.x), bflo(x.y), bfhi(x.y)}, h1 = (f32x4){bflo(x.z), bfhi(x.z), bflo(x.w), bfhi(x.w)}; const f32x4 a0 = acc[ai][bj][m][0], a1 = acc[ai][bj][m][1];
                    const f32x4 e0 = (f32x4){bflo(p.x), bfhi(p.x), bflo(p.y), bfhi(p.y)} * rs[m] * nv[bj][0], e1 = (f32x4){bflo(p.z), bfhi(p.z), bflo(p.w), bfhi(p.w)} * rs[m] * nv[bj][1];
                    h0 += (f32x4){sigmoid_(a0[0]), sigmoid_(a0[1]), sigmoid_(a0[2]), sigmoid_(a0[3])} * e0; h1 += (f32x4){sigmoid_(a1[0]), sigmoid_(a1[1]), sigmoid_(a1[2]), sigmoid_(a1[3])} * e1;
                    u32x4 w; w.x = pk2(h0[0], h0[1]); w.y = pk2(h0[2], h0[3]); w.z = pk2(h1[0], h1[1]); w.w = pk2(h1[2], h1[3]); *(u32x4*)(h + o) = w;
                    q += (bflo(w.x) * bflo(w.x) + bfhi(w.x) * bfhi(w.x)) + (bflo(w.y) * bflo(w.y) + bfhi(w.y) * bfhi(w.y)) + (bflo(w.z) * bflo(w.z) + bfhi(w.z) * bfhi(w.z)) + (bflo(w.w) * bflo(w.w) + bfhi(w.w) * bfhi(w.w)); }
                sq[ai][m] = q; } }
#pragma unroll
        for (int ai = 0; ai < 2; ++ai)
#pragma unroll
            for (int m = 0; m < 4; ++m) { float q = sq[ai][m]; q += shx<16>(q); q += __int_as_float(__builtin_amdgcn_ds_bpermute((t2 ^ 32) << 2, __float_as_int(q)));
                if (fq == 0) red[wc * 256 + ai * HALF + wr * 64 + m * 16 + fr] = q; }
        asm volatile("s_waitcnt lgkmcnt(0)" ::: "memory");
        __builtin_amdgcn_s_barrier();
        { const int tt = (wr * 4 + wc) * 64 + t2; if (tt < 256) part[(size_t)u.pn * T + u.pm * BM + tt] = (red[tt] + red[256 + tt]) + (red[512 + tt] + red[768 + tt]); }
    } };

template <class Epi, class Sched>
__device__ __forceinline__ void gemm_phase(int wave, LAS unsigned char* lds, int K, const Sched& S, const Epi& E) {
    int wid = wave; asm volatile("" : "+s"(wid));
    const int lane = lane_now(), tid = (wid << 6) | lane, wr = wid >> 2, wc = wid & 3, fr = lane & 15, fq = lane >> 4;
    const int nt = K / BK;
    unsigned voffA[2], voffB[2];
#pragma unroll
    for (int i = 0; i < 2; ++i) { int R, C; stage_rc(tid * 16 + i * 8192, R, C); const int Rb = Epi::PERM ? ((R & ~31) + perm32(R & 31)) : R;
        voffA[i] = (unsigned)(R * K + C) * 2u; voffB[i] = (unsigned)(Rb * K + C) * 2u; }
    const size_t kstep = (size_t)(BK * 2);
    const size_t hstep = (size_t)HALF * K * 2;
    const unsigned ldsw = (unsigned)wid * 1024u;
    const int aoff = lds_byte(wr * 64 + fr, fq * 8), boff = lds_byte(wc * 32 + fr, fq * 8);
#define PG8_SA(b, h) (((b) * 2 + (h)) * HTB)
#define PG8_SB(b, h) ((4 + (b) * 2 + (h)) * HTB)
#define PG8_STAGE(bufoff, gbase, voff) do { _Pragma("unroll") for (int _i = 0; _i < 2; ++_i) \
        __builtin_amdgcn_global_load_lds((const unsigned*)((const char*)(gbase) + (voff)[_i]), (LAS unsigned*)(lds + (bufoff) + ldsw + _i * 8192), 16, 0, 0); } while (0)
#define PG8_LDA(dst, b, h) do { _Pragma("unroll") for (int m = 0; m < 4; ++m) _Pragma("unroll") for (int k = 0; k < 2; ++k) dst[m][k] = *(const LAS bf16x8*)(lds + PG8_SA(b, h) + aoff + m * 2048 + k * 1024); } while (0)
#define PG8_LDB(dst, b, h) do { _Pragma("unroll") for (int n = 0; n < 2; ++n) _Pragma("unroll") for (int k = 0; k < 2; ++k) dst[n][k] = *(const LAS bf16x8*)(lds + PG8_SB(b, h) + boff + n * 2048 + k * 1024); } while (0)
#define PG8_MMA(ai, bj, At, Bt) do { __builtin_amdgcn_s_setprio(1); _Pragma("unroll") for (int m = 0; m < 4; ++m) _Pragma("unroll") for (int n = 0; n < 2; ++n) _Pragma("unroll") for (int k = 0; k < 2; ++k) \
        acc[ai][bj][m][n] = __builtin_amdgcn_mfma_f32_16x16x32_bf16(Bt[n][k], At[m][k], acc[ai][bj][m][n], 0, 0, 0); __builtin_amdgcn_s_setprio(0); } while (0)
#define PG8_WAIT_V(n) asm volatile("s_waitcnt vmcnt(" #n ")" ::: "memory")
#define PG8_WAIT_L(n) asm volatile("s_waitcnt lgkmcnt(" #n ")" ::: "memory")
#define PG8_BAR __builtin_amdgcn_s_barrier()
#define PG8_SCHED __builtin_amdgcn_sched_barrier(0)
    Unit cur, nxt; int ui = 0;
    if (!S.next(0, cur)) return;
    if constexpr (Sched::DEPS) { S.wait(cur, wid); PG8_BAR; }
    f32x4 acc[2][2][4][2];
    if constexpr (Epi::ACC_INIT) E.init(acc, cur, wr, wc, fr, fq);
    else {
#pragma unroll
    for (int a = 0; a < 2; ++a)
#pragma unroll
        for (int b = 0; b < 2; ++b)
#pragma unroll
            for (int m = 0; m < 4; ++m)
#pragma unroll
                for (int n = 0; n < 2; ++n) acc[a][b][m][n] = (f32x4){0.f, 0.f, 0.f, 0.f}; }
    bf16x8 At[4][2], B0[2][2], B1[2][2];
    const char* cA = cur.A; const char* cB = cur.B;
    PG8_STAGE(PG8_SB(0, 0), cB, voffB); PG8_STAGE(PG8_SB(0, 1), cB + hstep, voffB); PG8_STAGE(PG8_SA(0, 0), cA, voffA); PG8_STAGE(PG8_SA(0, 1), cA + hstep, voffA);
    if (wr == 1) PG8_BAR;
    PG8_WAIT_V(2); PG8_BAR;
    PG8_STAGE(PG8_SB(1, 0), cB + kstep, voffB); PG8_STAGE(PG8_SA(1, 0), cA + kstep, voffA); PG8_STAGE(PG8_SB(1, 1), cB + hstep + kstep, voffB);
    PG8_WAIT_V(6); PG8_BAR;
    for (;;) {
        const bool has_next = S.next(ui + 1, nxt);
        const char* nA = has_next ? nxt.A : cA; const char* nB = has_next ? nxt.B : cB;
#pragma nounroll
        for (int t = 0; t < nt; t += 2) {
            const bool last = (t == nt - 2);
            if constexpr (Sched::DEPS) { if (last && has_next) S.wait(nxt, wid); }
            const char* a1 = cA + (size_t)(t + 1) * kstep;
            const char* a2 = last ? nA : cA + (size_t)(t + 2) * kstep; const char* b2 = last ? nB : cB + (size_t)(t + 2) * kstep;
            const char* a3 = a2 + kstep; const char* b3 = b2 + kstep;
            PG8_LDB(B0, 0, 0); PG8_LDB(B1, 0, 1); PG8_SCHED; PG8_LDA(At, 0, 0); PG8_STAGE(PG8_SA(1, 1), a1 + hstep, voffA);
            PG8_WAIT_V(8); PG8_WAIT_L(0); PG8_BAR; PG8_MMA(0, 0, At, B0); PG8_MMA(0, 1, At, B1); PG8_BAR; PG8_SCHED;
            PG8_LDA(At, 0, 1); PG8_STAGE(PG8_SB(0, 0), b2, voffB); PG8_STAGE(PG8_SB(0, 1), b2 + hstep, voffB); PG8_STAGE(PG8_SA(0, 0), a2, voffA);
            PG8_WAIT_V(8); PG8_WAIT_L(0); PG8_BAR; PG8_MMA(1, 0, At, B0); PG8_MMA(1, 1, At, B1); PG8_BAR; PG8_SCHED;
            PG8_LDB(B0, 1, 0); PG8_LDB(B1, 1, 1); PG8_SCHED; PG8_LDA(At, 1, 0); PG8_STAGE(PG8_SA(0, 1), a2 + hstep, voffA);
            PG8_WAIT_V(8); PG8_WAIT_L(0); PG8_BAR; PG8_MMA(0, 0, At, B0); PG8_MMA(0, 1, At, B1); PG8_BAR; PG8_SCHED;
            PG8_LDA(At, 1, 1); PG8_STAGE(PG8_SB(1, 0), b3, voffB); PG8_STAGE(PG8_SB(1, 1), b3 + hstep, voffB); PG8_STAGE(PG8_SA(1, 0), a3, voffA);
            PG8_WAIT_V(8); PG8_WAIT_L(0); PG8_BAR; PG8_MMA(1, 0, At, B0); PG8_MMA(1, 1, At, B1); PG8_BAR; PG8_SCHED;
        }
        if (wr == 0) PG8_BAR;
        E(acc, cur, wr, wc, fr, fq);
        if constexpr (Epi::SIGNAL) { PG8_WAIT_V(0); PG8_BAR; if (tid == 0) E.signal(cur); }
        if (!has_next) break;
        if constexpr (Epi::ACC_INIT) E.init(acc, nxt, wr, wc, fr, fq);
        else {
#pragma unroll
        for (int a = 0; a < 2; ++a)
#pragma unroll
            for (int b = 0; b < 2; ++b)
#pragma unroll
                for (int m = 0; m < 4; ++m)
#pragma unroll
                    for (int n = 0; n < 2; ++n) acc[a][b][m][n] = (f32x4){0.f, 0.f, 0.f, 0.f}; }
        cur = nxt; cA = nA; cB = nB; ++ui;
        if (wr == 1) PG8_BAR;
    }
    PG8_WAIT_V(0);
    PG8_BAR;
#undef PG8_SA
#undef PG8_SB
#undef PG8_STAGE
#undef PG8_LDA
#undef PG8_LDB
#undef PG8_MMA
#undef PG8_WAIT_V
#undef PG8_WAIT_L
#undef PG8_BAR
#undef PG8_SCHED
}
}

__device__ __forceinline__ void phase_gemm_pe(const Frame& F) {
    pg8::DenseOrder S; S.init(F.ws + WS_PB, F.ws + WS_WPE, T, D, PD, DEPTH, F.G, F.blk); pg8::EpiBf16 E{(bf16*)(F.ws + WS_PE), D};
    pg8::gemm_phase(F.wave, F.lds, PD, S, E);
}
__device__ __forceinline__ void phase_gemm_in(const Frame& F, int l) {
    pg8::DenseOrder S; S.init(F.ws + WS_H, (bf16*)(F.ws + WS_WIN) + (size_t)l * DIN * D, T, DIN, D, 1, F.G, F.blk); pg8::EpiBf16Rs E{(bf16*)(F.ws + WS_Z), DIN, (const float*)(F.ws + MS_RSTD1), l > 0 ? (const float*)(F.ws + MS_PART) : (const float*)nullptr};
    pg8::gemm_phase(F.wave, F.lds, D, S, E);
}
__device__ __forceinline__ void phase_gemm_out(const Frame& F, int l) {
    pg8::DenseOrder S; S.init(F.ws + WS_O, (bf16*)(F.ws + WS_WOUT) + (size_t)l * D * D, T, D, D, 1, F.G, F.blk); pg8::EpiResid E{(bf16*)(F.ws + WS_H)};
    pg8::gemm_phase(F.wave, F.lds, D, S, E);
}
__device__ __forceinline__ void phase_gemm_moe1(const Frame& F, int l) {
    pg8::MoeOrder S; S.init(F.ws + WS_XB, (bf16*)(F.ws + WS_WGU) + (size_t)l * NE * 1024 * 1024, (const int*)(F.ws + MS_BLKE) + l * 256, D, 4, (size_t)1024 * 1024 * 2, F.G, F.blk); pg8::EpiGateUp E{(bf16*)(F.ws + WS_HB)};
    pg8::gemm_phase(F.wave, F.lds, D, S, E);
    { const int nun = S.nrb * 4, rem = nun % F.G, few = (rem == 0 || F.G - rem < 64), idle = few ? F.G : F.G - rem, first = few ? 0 : rem;
      if (F.blk >= first) { pg8::DenseOrder P; P.init((const bf16*)(F.ws + WS_PB) + (size_t)l * T * PD, (const bf16*)(F.ws + WS_WPE) + (size_t)l * D * PD, T, D, PD, 1, idle, F.blk - first);
          pg8::EpiBf16 EP{(bf16*)(F.ws + WS_PE) + (size_t)l * T * D, D}; pg8::gemm_phase(F.wave, F.lds, PD, P, EP); }
      conv_deferred(F, l + 1, 0, NDEF1, first, idle); }
}
__device__ __forceinline__ void phase_gemm_moe2(const Frame& F, int l) {
    pg8::MoeOrder S; S.init(F.ws + WS_HB, (bf16*)(F.ws + WS_WD) + (size_t)l * NE * D * DE, (const int*)(F.ws + MS_BLKE) + l * 256, DE, 4, (size_t)D * DE * 2, F.G, F.blk); pg8::EpiBf16 E{(bf16*)(F.ws + WS_Y), D};
    pg8::gemm_phase(F.wave, F.lds, DE, S, E);
    { const int nun = S.nrb * 4, rem = nun % F.G, few = (rem == 0 || F.G - rem < 64), idle = few ? F.G : F.G - rem, first = few ? 0 : rem;
      conv_deferred(F, l + 1, NDEF1, NDEF, first, idle); }
}
#ifndef MOE_CPE
#define MOE_CPE 5
#endif
#ifndef MOE_CTL
#define MOE_CTL 4
#endif
#ifndef MOE_X1
#define MOE_X1 16
#define MOE_X2 8
#endif
template <int MODE = 0> __device__ __forceinline__ void phase_moe_fused(const Frame& F, int l) {
    unsigned char* ws = F.ws; const int G = F.G, blk = (MOE_VBLK && F.G == 256) ? vblk(F.blk) : F.blk;
    const int* blke = (const int*)(ws + MS_BLKE) + l * 256;
    unsigned* done = (unsigned*)(ws + WS_CTL) + CW_DONE + l * 256;
    const int nrb = __builtin_amdgcn_readfirstlane(blke[255]), nu = 4 * nrb, e1 = nu % G;
    if constexpr (MODE == 1) { pg8::MoeOrder S; S.init(ws + WS_XB, (bf16*)(ws + WS_WGU) + (size_t)l * NE * 1024 * 1024, blke, D, 4, (size_t)1024 * 1024 * 2, G, blk);
      pg8::EpiGateUp E{(bf16*)(ws + WS_HB)}; pg8::gemm_phase(F.wave, F.lds, D, S, E); return; }
    if constexpr (MODE == 0) { pg8::MoeOrder S; S.init(ws + WS_XB, (bf16*)(ws + WS_WGU) + (size_t)l * NE * 1024 * 1024, blke, D, 4, (size_t)1024 * 1024 * 2, G, blk);
      pg8::EpiGateUpPub E{__builtin_amdgcn_make_buffer_rsrc(ws + WS_HB, 0, (int)((size_t)CAP * DE * 2), 0x00020000), done};
      pg8::gemm_phase(F.wave, F.lds, D, S, E); }
    if constexpr (MODE == 2) { pg8::MoeOrder S; S.init(ws + WS_HB, (bf16*)(ws + WS_WD) + (size_t)l * NE * D * DE, blke, DE, 4, (size_t)D * DE * 2, G, blk >= e1 ? blk - e1 : blk - e1 + G);
      pg8::EpiBf16 E{(bf16*)(ws + WS_Y), D}; pg8::gemm_phase(F.wave, F.lds, DE, S, E); }
    if constexpr (MODE == 0) { pg8::MoeDepOrder S; S.init(ws + WS_HB, (bf16*)(ws + WS_WD) + (size_t)l * NE * D * DE, blke, done, DE, 4, (size_t)D * DE * 2, G, blk >= e1 ? blk - e1 : blk - e1 + G);
      pg8::EpiBf16 E{(bf16*)(ws + WS_Y), D};
      pg8::gemm_phase(F.wave, F.lds, DE, S, E); }
    { const int nt = (l + 1 < DEPTH) ? NDEF : 0, ftot = 256 * MOE_CPE + nt * MOE_CTL;
      const int wrap = 2 * e1 > G ? 2 * e1 - G : 0;
      auto cls = [&](int x, int& c24, int& c16, int& c8, int& c0) {
          const int cA = x < e1 ? x : e1, cAB = x < wrap ? x : wrap;
          int cB = x - e1; cB = cB < 0 ? 0 : cB; if (!wrap) cB = cB > e1 ? e1 : cB; cB += cAB;
          c24 = cAB; c16 = cA - cAB; c8 = cB - cAB; c0 = x - c24 - c16 - c8; };
      auto fill = [&](int x, int lv) { int c24, c16, c8, c0; cls(x, c24, c16, c8, c0);
          return c0 * lv + c8 * (lv > MOE_X2 ? lv - MOE_X2 : 0) + c16 * (lv > MOE_X1 ? lv - MOE_X1 : 0) + c24 * (lv > MOE_X1 + MOE_X2 ? lv - MOE_X1 - MOE_X2 : 0); };
      int lv = 1; while (fill(G, lv) < ftot) ++lv;
      const int B0 = fill(blk, lv), B1 = fill(blk + 1, lv);
      const int pe_tot = 256 * MOE_CPE;
      int j0 = (B0 + MOE_CPE - 1) / MOE_CPE, j1 = (B1 + MOE_CPE - 1) / MOE_CPE; j0 = j0 < 256 ? j0 : 256; j1 = j1 < 256 ? j1 : 256;
      int t0 = B0 > pe_tot ? (B0 - pe_tot + MOE_CTL - 1) / MOE_CTL : 0, t1 = B1 > pe_tot ? (B1 - pe_tot + MOE_CTL - 1) / MOE_CTL : 0; t0 = t0 < nt ? t0 : nt; t1 = t1 < nt ? t1 : nt;
      if (j1 > j0) { pg8::RangeOrder P; P.init((const bf16*)(ws + WS_PB) + (size_t)l * T * PD, (const bf16*)(ws + WS_WPE) + (size_t)l * D * PD, T, D, PD, j0, j1 - j0);
          pg8::EpiBf16 EP{(bf16*)(ws + WS_PE) + (size_t)l * T * D, D}; pg8::gemm_phase(F.wave, F.lds, PD, P, EP); }
      if (t1 > t0) { const int base = (l + 1) * TL_LAYER + t0; conv_run(F, 0, 1, t1 - t0, [=](int f) { return base + f; }); } }
}
__device__ __forceinline__ void phase_gemm_pg(const Frame& F, int l) {
    pg8::DenseOrder S; S.init(F.ws + WS_XN, (bf16*)(F.ws + WS_WPG) + (size_t)l * D * D, T, D, D, 1, F.G, F.blk);
    pg8::EpiPG E{(bf16*)(F.ws + WS_H), (const bf16*)(F.ws + WS_PE) + (size_t)l * T * D, (const float*)(F.ws + MS_RSTDPE), F.in[22] + l * D, (LAS float*)(F.lds + MISC_OFF + 4096), (float*)(F.ws + MS_PART)};
    pg8::gemm_phase(F.wave, F.lds, D, S, E);
}

typedef short s16x4 __attribute__((ext_vector_type(4)));
__device__ __forceinline__ bf16x8 tr_frag(LAS unsigned char* p_lo, LAS unsigned char* p_hi) {
    const s16x4 lo = __builtin_amdgcn_ds_read_tr16_b64_v4i16((LAS s16x4*)p_lo), hi = __builtin_amdgcn_ds_read_tr16_b64_v4i16((LAS s16x4*)p_hi);
    return __builtin_shufflevector(lo, hi, 0, 1, 2, 3, 4, 5, 6, 7); }
#define MFMA16(a, b, c) __builtin_amdgcn_mfma_f32_16x16x32_bf16((a), (b), (c), 0, 0, 0)
constexpr int RP = 272;
constexpr int VP = 1040;

__device__ __forceinline__ void phase_rec_c1(const Frame& F, int l) {
    PH_TID();
    unsigned char* ws = F.ws; const bf16* Z = (const bf16*)(ws + WS_Z);
    bf16* UT = (bf16*)(ws + WS_UT); float* DC = (float*)(ws + MS_DC); float* MM = (float*)(ws + MS_MM);
    const float* lb = (const float*)(ws + MS_LB) + l * DREC;
    LAS unsigned char* KD = F.lds; LAS unsigned char* IM = F.lds + 128 * RP; LAS float* totx = (LAS float*)(F.lds + 256 * RP);
    const int wave = ph_wave, ch = tid & 255, half = tid >> 8, hl = ch >> 7, k = ch & 127, g = lane >> 4, li = lane & 15, q = li >> 2, p = li & 3;
    const int hG = F.G / 2, nmine = (F.G == 256) ? (F.blk < hG ? 4 : 0) : (F.blk < 512 ? (512 - F.blk + F.G - 1) / F.G : 0);
    const int ustep = (F.G == 256) ? hG : F.G;
    u32x4 pf[4], pi[4];
    auto fetch = [&](int unit) { const int c = unit >> 1, hp = unit & 1;
#pragma unroll
        for (int j = 0; j < 4; ++j) { const int idx = tid + 512 * j, hl2 = idx >> 10, row = (idx >> 4) & 63, cc = idx & 15;
            const bf16* src = Z + (size_t)(c * 64 + row) * DIN + 512 + (2 * hp + hl2) * 128 + cc * 8; pf[j] = *(const u32x4*)src; pi[j] = *(const u32x4*)(src + 512); } };
    if (nmine > 0) fetch(F.blk);
    for (int ui = 0; ui < nmine; ++ui) {
        const int unit = F.blk + ui * ustep;
        const int c = unit >> 1, hp = unit & 1, hh = 2 * hp + hl;
#pragma unroll
        for (int j = 0; j < 4; ++j) { const int idx = tid + 512 * j, hl2 = idx >> 10, row = (idx >> 4) & 63, cc = idx & 15; const int dst = (hl2 * 64 + row) * RP + cc * 16;
            *(LAS u32x4*)(KD + dst) = pf[j]; *(LAS u32x4*)(IM + dst) = pi[j]; }
        __syncthreads();
        if (ui + 1 < nmine) fetch(unit + ustep);
        const float lbk = lb[hh * 128 + k];
        float cs[32], kk[32]; float run = 1.f;
#pragma unroll
        for (int t = 0; t < 32; ++t) { const float fz = bf2f(*(const LAS bf16*)(KD + (hl * 64 + 32 * half + t) * RP + 2 * k)); const float sg = sigmoid_(fz); run *= lbk + (1.f - lbk) * sg; cs[t] = run; kk[t] = (1.f - lbk) * (1.f - sg); }
        totx[half * 256 + ch] = run;
        __syncthreads();
        const float other = totx[(1 - half) * 256 + ch]; const float p63 = run * other; const float base_p = half == 0 ? p63 : run;
#pragma unroll
        for (int t = 0; t < 32; ++t) *(LAS bf16*)(KD + (hl * 64 + 32 * half + t) * RP + 2 * k) = (bf16)f2bf(kk[t] * base_p * frcp(fmaxf(cs[t], 1e-30f)));
        if (half == 0) { DC[(c * 4 + hh) * 128 + k] = p63; MM[(c * 4 + hh) * 128 + k] = run; }
        __syncthreads();
        { const int whl = wave >> 2, kt0 = 2 * (wave & 3), whh = 2 * hp + whl;
          f32x4 acc[2][8];
#pragma unroll
          for (int i = 0; i < 2; ++i)
#pragma unroll
              for (int vt = 0; vt < 8; ++vt) acc[i][vt] = (f32x4){0.f, 0.f, 0.f, 0.f};
          LAS unsigned char* kdb = KD + whl * 64 * RP; LAS unsigned char* imb = IM + whl * 64 * RP;
#pragma unroll
          for (int a = 0; a < 2; ++a) { const unsigned ro = (unsigned)((32 * a + 8 * g + q) * RP);
              bf16x8 Af[2];
#pragma unroll
              for (int i = 0; i < 2; ++i) { const unsigned co = (unsigned)((16 * (kt0 + i) + 4 * p) * 2); Af[i] = tr_frag(kdb + ro + co, kdb + ro + 4 * RP + co); }
#pragma unroll
              for (int vt = 0; vt < 8; ++vt) { const unsigned co = (unsigned)((16 * vt + 4 * p) * 2); const bf16x8 Bf = tr_frag(imb + ro + co, imb + ro + 4 * RP + co);
#pragma unroll
                  for (int i = 0; i < 2; ++i) acc[i][vt] = MFMA16(Af[i], Bf, acc[i][vt]); } }
#pragma unroll
          for (int i = 0; i < 2; ++i)
#pragma unroll
              for (int vt = 0; vt < 8; ++vt) { u32x2 w; w.x = pg8::cvt_pk_bf16(acc[i][vt][0], acc[i][vt][1]); w.y = pg8::cvt_pk_bf16(acc[i][vt][2], acc[i][vt][3]);
                  *(u32x2*)(UT + ((size_t)(c * 4 + whh) * 128 + 16 * vt + li) * 128 + 16 * (kt0 + i) + 4 * g) = w; } }
        __syncthreads();
    }
}
__device__ __forceinline__ void phase_rec_c2a(const Frame& F) {
    PH_TID();
    unsigned char* ws = F.ws; const unsigned* UT = (const unsigned*)(ws + WS_UT); const float* DC = (const float*)(ws + MS_DC);
    f32x2* LT = (f32x2*)(ws + WS_LTOT); float* PT = (float*)(ws + MS_PTOT);
    for (int it = F.blk * NTHR + tid; it < 16 * 32768; it += F.G * NTHR) {
        const int gs = it >> 15, e = it & 32767, hh = e >> 13, v = (e >> 6) & 127, k0 = 2 * (e & 63);
        float S0 = 0.f, S1 = 0.f, P0 = 1.f, P1 = 1.f;
#pragma unroll
        for (int cc = 0; cc < 16; ++cc) { const int c = 16 * gs + cc; const unsigned u = UT[(size_t)c * 32768 + e]; const f32x2 d = *(const f32x2*)(DC + (c * 4 + hh) * 128 + k0);
            S0 = d.x * S0 + bflo(u); S1 = d.y * S1 + bfhi(u); P0 *= d.x; P1 *= d.y; }
        LT[it] = (f32x2){S0, S1};
        if (v == 0) *(f32x2*)(PT + (gs * 4 + hh) * 128 + k0) = (f32x2){P0, P1};
    }
}
__device__ __forceinline__ void phase_rec_c2c(const Frame& F) {
    PH_TID();
    unsigned char* ws = F.ws; const unsigned* UT = (const unsigned*)(ws + WS_UT); unsigned* ST = (unsigned*)(ws + WS_ST); const float* DC = (const float*)(ws + MS_DC); const float* MM = (const float*)(ws + MS_MM);
    const f32x2* LT = (const f32x2*)(ws + WS_LTOT); const float* PT = (const float*)(ws + MS_PTOT);
    for (int it = F.blk * NTHR + tid; it < 16 * 32768; it += F.G * NTHR) {
        const int gs = it >> 15, e = it & 32767, hh = e >> 13, k0 = 2 * (e & 63);
        float C0 = 0.f, C1 = 0.f;
        for (int g2 = 0; g2 < gs; ++g2) { const f32x2 pt = *(const f32x2*)(PT + (g2 * 4 + hh) * 128 + k0); const f32x2 lt = LT[g2 * 32768 + e]; C0 = pt.x * C0 + lt.x; C1 = pt.y * C1 + lt.y; }
#pragma unroll
        for (int cc = 0; cc < 16; ++cc) { const int c = 16 * gs + cc; const f32x2 mm = *(const f32x2*)(MM + (c * 4 + hh) * 128 + k0);
            ST[(size_t)c * 32768 + e] = pk2(C0 * mm.x, C1 * mm.y);
            const unsigned u = UT[(size_t)c * 32768 + e]; const f32x2 d = *(const f32x2*)(DC + (c * 4 + hh) * 128 + k0);
            C0 = d.x * C0 + bflo(u); C1 = d.y * C1 + bfhi(u); }
    }
}
__device__ __forceinline__ void phase_rec_c2(const Frame& F) {
    PH_TID();
    unsigned char* ws = F.ws; const int w = ph_wave;
    LAS float* tot = (LAS float*)F.lds;
    for (int unit = F.blk; unit < 256; unit += F.G) {
        const int hh = unit >> 6; const unsigned eo = (unsigned)(unit * 128 + lane), ko = (unsigned)(hh * 128 + 2 * lane);
        const unsigned* ut = (const unsigned*)(ws + WS_UT) + (size_t)(32 * w) * 32768; unsigned* st = (unsigned*)(ws + WS_ST) + (size_t)(32 * w) * 32768;
        const float* dc = (const float*)(ws + MS_DC) + (32 * w) * 512; const float* mmp = (const float*)(ws + MS_MM) + (32 * w) * 512;
        asm volatile("" : "+s"(ut), "+s"(st), "+s"(dc), "+s"(mmp));
        unsigned ua[32], ub[32]; f32x2 d[32], m0[16], m1[16];
#pragma unroll
        for (int cc = 0; cc < 32; ++cc) { ua[cc] = (ut + cc * 32768)[eo]; ub[cc] = (ut + cc * 32768 + 64)[eo]; d[cc] = *(const f32x2*)((dc + cc * 512) + ko); }
        __builtin_amdgcn_sched_barrier(0);
        float a0 = 0.f, a1 = 0.f, b0 = 0.f, b1 = 0.f, p0 = 1.f, p1 = 1.f;
#pragma unroll
        for (int cc = 0; cc < 32; ++cc) { a0 = d[cc].x * a0 + bflo(ua[cc]); a1 = d[cc].y * a1 + bfhi(ua[cc]); b0 = d[cc].x * b0 + bflo(ub[cc]); b1 = d[cc].y * b1 + bfhi(ub[cc]); p0 *= d[cc].x; p1 *= d[cc].y; }
        { LAS float* tw = tot + w * 384 + lane; tw[0] = a0; tw[64] = a1; tw[128] = b0; tw[192] = b1; tw[256] = p0; tw[320] = p1; }
        __builtin_amdgcn_sched_barrier(0);
#pragma unroll
        for (int cc = 0; cc < 16; ++cc) m0[cc] = *(const f32x2*)((mmp + cc * 512) + ko);
        __builtin_amdgcn_sched_barrier(0);
        __syncthreads();
        float A0 = 0.f, A1 = 0.f, B0 = 0.f, B1 = 0.f;
        for (int g2 = 0; g2 < w; ++g2) { const LAS float* tw = tot + g2 * 384 + lane; const float q0 = tw[256], q1 = tw[320]; A0 = q0 * A0 + tw[0]; A1 = q1 * A1 + tw[64]; B0 = q0 * B0 + tw[128]; B1 = q1 * B1 + tw[192]; }
        __builtin_amdgcn_sched_barrier(0);
#pragma unroll
        for (int cc = 0; cc < 16; ++cc) m1[cc] = *(const f32x2*)((mmp + (16 + cc) * 512) + ko);
        __builtin_amdgcn_sched_barrier(0);
#pragma unroll
        for (int cc = 0; cc < 32; ++cc) { const f32x2 mm = cc < 16 ? m0[cc & 15] : m1[cc & 15];
            (st + cc * 32768)[eo] = pk2(A0 * mm.x, A1 * mm.y); (st + cc * 32768 + 64)[eo] = pk2(B0 * mm.x, B1 * mm.y);
            unsigned xa = ua[cc], xb = ub[cc]; asm volatile("" : "+v"(xa), "+v"(xb));
            A0 = d[cc].x * A0 + bflo(xa); A1 = d[cc].y * A1 + bfhi(xa); B0 = d[cc].x * B0 + bflo(xb); B1 = d[cc].y * B1 + bfhi(xb);
            asm volatile("" : "+v"(A0), "+v"(A1), "+v"(B0), "+v"(B1) :: "memory"); }
        __syncthreads();
    }
}
template <int PV = 0> __device__ __forceinline__ void phase_rec_c3(const Frame& F, int l) {
    PH_TID();
    unsigned char* ws = F.ws; const bf16* Z = (const bf16*)(ws + WS_Z); const bf16* ST = (const bf16*)(ws + WS_ST); bf16* O = (bf16*)(ws + WS_O);
    const float* lb = (const float*)(ws + MS_LB) + l * DREC; const float* ogain = F.in[5] + l * 128;
    LAS unsigned char* QT = F.lds; LAS unsigned char* KT = F.lds + 128 * RP; LAS unsigned char* IM = F.lds + 256 * RP;
    const int wave = ph_wave, ch = tid & 255, half = tid >> 8, hl = ch >> 7, k = ch & 127, g = lane >> 4, li = lane & 15, q = li >> 2, p = li & 3;
    u32x4 pq[4], pf[4];
    const unsigned tvo = (unsigned)((tid >> 4) * DIN + (tid & 15) * 8), tlo = (unsigned)((tid >> 4) * RP + (tid & 15) * 16);
    auto fetch = [&](int unit) { const bf16* zc = Z + (size_t)(unit >> 1) * 64 * DIN + (unit & 1) * 256;
#pragma unroll
        for (int j = 0; j < 4; ++j) { const bf16* src = zc + (32 * (j & 1)) * DIN + (j >> 1) * 128; pq[j] = *(const u32x4*)(src + tvo); pf[j] = *(const u32x4*)(src + 512 + tvo); } };
    if (F.blk < 512) fetch(F.blk);
    for (int unit = F.blk; unit < 512; unit += F.G) {
        const int c = unit >> 1, hp = unit & 1, hh = 2 * hp + hl;
#pragma unroll
        for (int j = 0; j < 4; ++j) { const int dst = ((j >> 1) * 64 + 32 * (j & 1)) * RP;
            *(LAS u32x4*)(QT + dst + tlo) = pq[j]; *(LAS u32x4*)(KT + dst + tlo) = pf[j]; }
        u32x4 vi[4];
        { const bf16* zc = Z + (size_t)c * 64 * DIN + hp * 256 + 1024;
#pragma unroll
          for (int j = 0; j < 4; ++j) vi[j] = *(const u32x4*)(zc + (32 * (j & 1)) * DIN + (j >> 1) * 128 + tvo); }
        __syncthreads();
        { const float lbk = lb[hh * 128 + k]; const int col = (hl * 64 + 32 * half) * RP + 2 * k;
          float cs[32], kk[32], qs[32]; float run = 1.f;
#pragma unroll
          for (int t = 0; t < 32; ++t) { const float fz = bf2f(*(const LAS bf16*)(KT + col + t * RP)); const float sg = sigmoid_(fz); run *= lbk + (1.f - lbk) * sg; cs[t] = run; kk[t] = (1.f - lbk) * (1.f - sg);
              qs[t] = silu_(bf2f(*(const LAS bf16*)(QT + col + t * RP))); }
          const float inv = half == 0 ? frcp(fmaxf(run, 1e-30f)) : 1.f;
#pragma unroll
          for (int t = 0; t < 32; ++t) { const float ex = cs[t] * inv; const int off = col + t * RP;
              *(LAS bf16*)(QT + off) = (bf16)f2bf(qs[t] * ex); *(LAS bf16*)(KT + off) = (bf16)f2bf(kk[t] * frcp(fmaxf(ex, 1e-30f))); } }
#pragma unroll
        for (int j = 0; j < 4; ++j) *(LAS u32x4*)(IM + ((j >> 1) * 64 + 32 * (j & 1)) * RP + tlo) = vi[j];
        const int whl = wave >> 2, tt = wave & 3, whh = 2 * hp + whl;
        bf16x8 Sf[8][4];
#pragma unroll
        for (int vt = 0; vt < 8; ++vt)
#pragma unroll
            for (int a = 0; a < 4; ++a) Sf[vt][a] = *(const bf16x8*)(ST + ((size_t)(c * 4 + whh) * 128 + 16 * vt + li) * 128 + 32 * a + 8 * g);
        __syncthreads();
        if (PV != 1) {
          bf16 gz[8][4];
#pragma unroll
          for (int vt = 0; vt < 8; ++vt)
#pragma unroll
              for (int r = 0; r < 4; ++r) gz[vt][r] = Z[((size_t)c * 64 + 16 * tt + 4 * g + r) * DIN + 1536 + whh * 128 + 16 * vt + li];
          bf16x8 Qf[4];
#pragma unroll
          for (int a = 0; a < 4; ++a) Qf[a] = *(const LAS bf16x8*)(QT + (whl * 64 + 16 * tt + li) * RP + (32 * a + 8 * g) * 2);
          unsigned pw[4][2];
#pragma unroll
          for (int st = 0; st < 4; ++st) { pw[st][0] = 0u; pw[st][1] = 0u;
              { f32x4 s = (f32x4){0.f, 0.f, 0.f, 0.f};
#pragma unroll
                  for (int a = 0; a < 4; ++a) { const bf16x8 Kf = *(const LAS bf16x8*)(KT + (whl * 64 + 16 * st + li) * RP + (32 * a + 8 * g) * 2); s = MFMA16(Kf, Qf[a], s); }
                  if (st == tt) {
#pragma unroll
                      for (int r = 0; r < 4; ++r) if (4 * g + r > li) s[r] = 0.f; }
                  pw[st][0] = st <= tt ? pg8::cvt_pk_bf16(s[0], s[1]) : 0u; pw[st][1] = st <= tt ? pg8::cvt_pk_bf16(s[2], s[3]) : 0u; } }
          f32x4 acc[8];
#pragma unroll
          for (int vt = 0; vt < 8; ++vt) { acc[vt] = (f32x4){0.f, 0.f, 0.f, 0.f};
#pragma unroll
              for (int a = 0; a < 4; ++a) acc[vt] = MFMA16(Qf[a], Sf[vt][a], acc[vt]); }
          __builtin_amdgcn_sched_barrier(0);
          if (unit + F.G < 512) fetch(unit + F.G);
          __builtin_amdgcn_sched_barrier(0);
          LAS unsigned char* imb = IM + whl * 64 * RP;
#pragma unroll
          for (int a = 0; a < 2; ++a) { const u32x4 pv = (u32x4){pw[2 * a][0], pw[2 * a][1], pw[2 * a + 1][0], pw[2 * a + 1][1]}; const bf16x8 Pf = __builtin_bit_cast(bf16x8, pv);
              const unsigned ro = (unsigned)((32 * a + 4 * g + q) * RP);
#pragma unroll
              for (int vt = 0; vt < 8; ++vt) { const unsigned co = (unsigned)((16 * vt + 4 * p) * 2); const bf16x8 If = tr_frag(imb + ro + co, imb + ro + 16 * RP + co); acc[vt] = MFMA16(Pf, If, acc[vt]); } }
          float rs[4];
#pragma unroll
          for (int r = 0; r < 4; ++r) { float ss = 0.f;
#pragma unroll
              for (int vt = 0; vt < 8; ++vt) ss += acc[vt][r] * acc[vt][r];
              ss += shx<1>(ss); ss += shx<2>(ss); ss += shx<4>(ss); ss += shx<8>(ss); rs[r] = frsq(ss * (1.f / 128.f) + EPS); }
#pragma unroll
          for (int vt = 0; vt < 8; ++vt) { const float og = ogain[16 * vt + li];
#pragma unroll
              for (int r = 0; r < 4; ++r) { const size_t t = (size_t)c * 64 + 16 * tt + 4 * g + r; const float gv = bf2f(gz[vt][r]);
                  O[t * D + whh * 128 + 16 * vt + li] = (bf16)f2bf(acc[vt][r] * rs[r] * og * silu_(gv)); } } }
        __syncthreads();
    }
}
__device__ __forceinline__ void phase_sgu(const Frame& F, int l) {
    PH_TID();
    unsigned char* ws = F.ws; const bf16* Z = (const bf16*)(ws + WS_Z); bf16* O = (bf16*)(ws + WS_O);
    const bf16* Wb = (const bf16*)(ws + MS_SGUW) + (size_t)l * 4 * 128 * 128; const float* sb = F.in[9] + l * 4 * 128;
    LAS unsigned char* VN = F.lds;
    const int wave = ph_wave, g = lane >> 4, li = lane & 15, q = li >> 2, p = li & 3;
    for (int unit = (F.blk + F.G / 2) % F.G; unit < 128; unit += F.G) {
        float lg[8], lbv[8];
#pragma unroll
        for (int j = 0; j < 8; ++j) { lg[j] = F.in[6][l * DSGU + 8 * lane + j]; lbv[j] = F.in[7][l * DSGU + 8 * lane + j]; }
        u32x4 raw[16];
#pragma unroll
        for (int i = 0; i < 16; ++i) raw[i] = *(const u32x4*)(Z + ((size_t)unit * 128 + 16 * wave + i) * DIN + 2560 + 8 * lane);
#pragma unroll
        for (int i = 0; i < 16; ++i) { const int s = 16 * wave + i; const u32x4 r = raw[i];
            float x[8] = {gelu_(bflo(r.x)), gelu_(bfhi(r.x)), gelu_(bflo(r.y)), gelu_(bfhi(r.y)), gelu_(bflo(r.z)), gelu_(bfhi(r.z)), gelu_(bflo(r.w)), gelu_(bfhi(r.w))};
            float sm = 0.f, qq = 0.f;
#pragma unroll
            for (int j = 0; j < 8; ++j) { sm += x[j]; qq += x[j] * x[j]; }
            sm += shx<1>(sm); qq += shx<1>(qq); sm += shx<2>(sm); qq += shx<2>(qq); sm += shx<4>(sm); qq += shx<4>(qq); sm += shx<8>(sm); qq += shx<8>(qq); sm += shx<16>(sm); qq += shx<16>(qq);
            const float mu = halves_sum(sm) * (1.f / 512.f); const float var = fmaxf(halves_sum(qq) * (1.f / 512.f) - mu * mu, 0.f);
            const float rstd = frsq(var + EPS);
#pragma unroll
            for (int j = 0; j < 8; ++j) x[j] = (x[j] - mu) * rstd * lg[j] + lbv[j];
            u32x4 o; o.x = pk2(x[0], x[1]); o.y = pk2(x[2], x[3]); o.z = pk2(x[4], x[5]); o.w = pk2(x[6], x[7]);
            *(LAS u32x4*)(VN + s * VP + lane * 16) = o; }
        __syncthreads();
        { const int hh = wave >> 1, dh = wave & 1; const bf16* W = Wb + (size_t)hh * 128 * 128;
          LAS unsigned char* vnb = VN;
#pragma unroll 1
          for (int dp = 0; dp < 2; ++dp) {
          bf16x8 Wf[2][8];
#pragma unroll
          for (int a = 0; a < 2; ++a)
#pragma unroll
              for (int ti = 0; ti < 8; ++ti) if (ti >= 2 * a) Wf[a][ti] = *(const bf16x8*)(W + (size_t)(16 * ti + li) * 128 + 32 * a + 8 * g);
          u32x2 uu[8][2]; float bs[8];
#pragma unroll
          for (int ti = 0; ti < 8; ++ti) { bs[ti] = sb[hh * 128 + 16 * ti + li];
#pragma unroll
              for (int dt = 0; dt < 2; ++dt) uu[ti][dt] = *(const u32x2*)(Z + ((size_t)unit * 128 + 16 * ti + li) * DIN + 2048 + hh * 128 + 64 * dh + 16 * (2 * dp + dt) + 4 * g); }
          f32x4 acc[2][8];
#pragma unroll
          for (int dt = 0; dt < 2; ++dt)
#pragma unroll
              for (int ti = 0; ti < 8; ++ti) acc[dt][ti] = (f32x4){0.f, 0.f, 0.f, 0.f};
#pragma unroll
          for (int a = 0; a < 4; ++a) { const unsigned ro = (unsigned)((32 * a + 8 * g + q) * VP);
              bf16x8 Af[2];
#pragma unroll
              for (int dt = 0; dt < 2; ++dt) { const unsigned co = (unsigned)((hh * 128 + 64 * dh + 16 * (2 * dp + dt) + 4 * p) * 2); Af[dt] = tr_frag(vnb + ro + co, vnb + ro + 4 * VP + co); }
#pragma unroll
              for (int ti = 0; ti < 8; ++ti) if (ti >= 2 * a) {
                  const bf16x8 Bf = a < 2 ? Wf[a < 2 ? a : 0][ti] : *(const bf16x8*)(W + (size_t)(16 * ti + li) * 128 + 32 * a + 8 * g);
#pragma unroll
                  for (int dt = 0; dt < 2; ++dt) acc[dt][ti] = MFMA16(Af[dt], Bf, acc[dt][ti]); } }
#pragma unroll
          for (int ti = 0; ti < 8; ++ti) { const size_t t = (size_t)unit * 128 + 16 * ti + li; const float bias = bs[ti];
#pragma unroll
              for (int dt = 0; dt < 2; ++dt) { const int col = hh * 128 + 64 * dh + 16 * (2 * dp + dt) + 4 * g; const u32x2 u = uu[ti][dt];
                  u32x2 w; w.x = pk2((acc[dt][ti][0] + bias) * gelu_(bflo(u.x)), (acc[dt][ti][1] + bias) * gelu_(bfhi(u.x))); w.y = pk2((acc[dt][ti][2] + bias) * gelu_(bflo(u.y)), (acc[dt][ti][3] + bias) * gelu_(bfhi(u.y)));
                  *(u32x2*)(O + t * D + 512 + col) = w; } } } }
        __syncthreads();
    }
}

#define XB_TMO      128
#define XB_XCNT(j)  (256  + 64 * (j))
#define XB_XSUB(j)  (1280 + 64 * (j))
#define XB_XGEN(j)  (2304 + 64 * (j))
#define XB_TOP      3328
#define XB_TOPGEN   3392
#define XCD_BAR_WORDS 3456
#define XB_SPIN_CAP (1u << 18)
__device__ __forceinline__ unsigned xb_ld(unsigned* p)              { return __hip_atomic_load(p, __ATOMIC_RELAXED, __HIP_MEMORY_SCOPE_AGENT); }
__device__ __forceinline__ unsigned xb_add(unsigned* p, unsigned v) { return __hip_atomic_fetch_add(p, v, __ATOMIC_RELAXED, __HIP_MEMORY_SCOPE_AGENT); }
__device__ __forceinline__ unsigned xb_xcc_id() { return (unsigned)__builtin_amdgcn_s_getreg((3 << 11) | 20) & 0xFu; }
#define XB_SPIN(cond, bar) do { unsigned _sp = 0; while (cond) { __builtin_amdgcn_s_sleep(1); \
    if ((++_sp & 255u) == 0u) { if (xb_ld(&(bar)[XB_TMO])) break; if (_sp > XB_SPIN_CAP) { atomicAdd(&(bar)[XB_TMO], 1u); break; } } } } while (0)
struct XcdBarrier { unsigned* bar; unsigned x; volatile LAS unsigned* st; int wave; };
__device__ __forceinline__ XcdBarrier xcd_barrier_post(unsigned* bar, volatile LAS unsigned* st, int wave) {
    XcdBarrier b; b.bar = bar; b.x = xb_xcc_id(); b.st = st; b.wave = wave;
    if (wave == 0 && lane_now() == 0) (void)xb_add(&bar[XB_XCNT(b.x)], 1u);
    return b;
}
__device__ __forceinline__ void xcd_barrier_complete(unsigned* bar, unsigned x, unsigned& nloc, unsigned& nx) {
    const unsigned G = gridDim.x * gridDim.y * gridDim.z;
    unsigned sum, cnt, mine, sp = 0u;
    for (;;) {
        sum = 0u; cnt = 0u; mine = 0u;
#pragma unroll
        for (unsigned j = 0; j < 16; ++j) { const unsigned c = xb_ld(&bar[XB_XCNT(j)]); sum += c; cnt += (c > 0u) ? 1u : 0u; mine = (j == x) ? c : mine; }
        if (sum == G) break;
        __builtin_amdgcn_s_sleep(1);
        if ((++sp & 255u) == 0u) { if (xb_ld(&bar[XB_TMO])) break; if (sp > XB_SPIN_CAP) { atomicAdd(&bar[XB_TMO], 1u); break; } }
    }
    nloc = mine > 0u ? mine : 1u; nx = cnt > 0u ? cnt : 1u;
}
__device__ __forceinline__ void xcd_barrier(const XcdBarrier& b) {
    asm volatile("s_waitcnt vmcnt(0)" ::: "memory");
    __syncthreads();
    if (b.wave == 0 && lane_now() == 0) {
        unsigned* bar = b.bar;
        __builtin_amdgcn_s_waitcnt(0);
        unsigned nloc = b.st[0], nx = b.st[1];
        if (nloc == 0u) { xcd_barrier_complete(bar, b.x, nloc, nx); b.st[0] = nloc; b.st[1] = nx; }
        const unsigned old = xb_add(&bar[XB_XSUB(b.x)], 1u);
        const unsigned gen = old / nloc;
        if (old + 1u == (gen + 1u) * nloc) {
            __builtin_amdgcn_fence(__ATOMIC_RELEASE, "agent");
            asm volatile("s_waitcnt vmcnt(0)" ::: "memory");
            const unsigned og = xb_add(&bar[XB_TOP], 1u);
            const unsigned tg = og / nx;
            if (og + 1u == (tg + 1u) * nx) xb_add(&bar[XB_TOPGEN], 1u);
            else XB_SPIN(xb_ld(&bar[XB_TOPGEN]) == tg, bar);
            __builtin_amdgcn_fence(__ATOMIC_ACQUIRE, "agent");
            xb_add(&bar[XB_XGEN(b.x)], 1u);
            asm volatile("s_waitcnt vmcnt(0)" ::: "memory");
        } else {
            XB_SPIN(xb_ld(&bar[XB_XGEN(b.x)]) == gen, bar);
            __builtin_amdgcn_fence(__ATOMIC_ACQUIRE, "agent");
            asm volatile("s_waitcnt vmcnt(0)" ::: "memory");
        }
    }
    __syncthreads();
}


__device__ __forceinline__ void xcd_barrier_bg(const XcdBarrier& b, const Frame& F, int lnext, bool drain) {
    asm volatile("s_waitcnt vmcnt(0)" ::: "memory");
    __syncthreads();
    volatile LAS unsigned* sx = b.st + 4;
    unsigned* q = (unsigned*)(F.ws + WS_CTL) + CW_BGQ + lnext * 64;
    if (b.wave == 0 && lane_now() == 0) {
        unsigned* bar = b.bar;
        __builtin_amdgcn_s_waitcnt(0);
        unsigned nloc = b.st[0], nx = b.st[1];
        if (nloc == 0u) { xcd_barrier_complete(bar, b.x, nloc, nx); b.st[0] = nloc; b.st[1] = nx; }
        const unsigned old = xb_add(&bar[XB_XSUB(b.x)], 1u);
        const unsigned gen = old / nloc;
        const bool leader = (old + 1u == (gen + 1u) * nloc);
        unsigned ti = 0u; if (!leader) { const unsigned k = xb_add(q, 1u); if (k < (unsigned)NBG) ti = k + 1u; }
        sx[0] = leader ? 1u : 0u; sx[1] = gen; sx[2] = ti;
    }
    __syncthreads();
    if (__builtin_amdgcn_readfirstlane(sx[0]) == 0u) {
        unsigned ti = (unsigned)__builtin_amdgcn_readfirstlane(sx[2]);
        while (ti != 0u) {
            const int it = lnext * TL_LAYER + NDEF + (int)ti - 1;
            conv_run(F, 0, 1, 1, [=](int) { return it; });
            if (b.wave == 0 && lane_now() == 0) {
                unsigned nt = 0u;
                if (drain || xb_ld(&b.bar[XB_XGEN(b.x)]) == sx[1]) { const unsigned k = xb_add(q, 1u); if (k < (unsigned)NBG) nt = k + 1u; }
                sx[2] = nt; }
            __syncthreads();
            ti = (unsigned)__builtin_amdgcn_readfirstlane(sx[2]);
            __syncthreads();
        }
    }
    if (b.wave == 0 && lane_now() == 0) {
        unsigned* bar = b.bar; const unsigned gen = sx[1], nx = b.st[1];
        asm volatile("s_waitcnt vmcnt(0)" ::: "memory");
        if (sx[0] != 0u) {
            __builtin_amdgcn_fence(__ATOMIC_RELEASE, "agent");
            asm volatile("s_waitcnt vmcnt(0)" ::: "memory");
            const unsigned og = xb_add(&bar[XB_TOP], 1u);
            const unsigned tg = og / nx;
            if (og + 1u == (tg + 1u) * nx) xb_add(&bar[XB_TOPGEN], 1u);
            else XB_SPIN(xb_ld(&bar[XB_TOPGEN]) == tg, bar);
            __builtin_amdgcn_fence(__ATOMIC_ACQUIRE, "agent");
            xb_add(&bar[XB_XGEN(b.x)], 1u);
            asm volatile("s_waitcnt vmcnt(0)" ::: "memory");
        } else {
            XB_SPIN(xb_ld(&bar[XB_XGEN(b.x)]) == gen, bar);
            __builtin_amdgcn_fence(__ATOMIC_ACQUIRE, "agent");
            asm volatile("s_waitcnt vmcnt(0)" ::: "memory");
        }
    }
    __syncthreads();
}

__device__ __forceinline__ bool opq(Frame& F) { asm volatile("" : "+s"(F.ws), "+s"(F.blk), "+s"(F.out), "+s"(F.G)); return true; }
__device__ __forceinline__ int lq_(int l) { asm volatile("" : "+s"(l)); return l; }
__global__ void __launch_bounds__(NTHR, 2) k_mega(Params p) {
    extern __shared__ __attribute__((aligned(16))) unsigned char lds[];
    Frame F; F.lds = (LAS unsigned char*)lds; F.ws = p.ws; F.in = p.in; F.out = p.out; F.wave = __builtin_amdgcn_readfirstlane(threadIdx.x >> 6); F.blk = blockIdx.x; F.G = gridDim.x;
    volatile LAS unsigned* st = (volatile LAS unsigned*)(F.lds + LDS_BYTES - 32);
    if (threadIdx.x < 8) st[threadIdx.x] = 0u;
    __syncthreads();
#if USE_CG_SYNC
#define GRID_BAR() cooperative_groups::this_grid().sync()
#else
    const XcdBarrier bar = xcd_barrier_post((unsigned*)(p.ws + WS_CTL) + CW_BAR + p.li * XCD_BAR_WORDS, st, F.wave);
#define GRID_BAR() xcd_barrier(bar)
#endif
    const int lo = p.ph_lo, hi = p.ph_hi;
#define RUN(k) (lo <= (k) && (k) < hi && opq(F))
#define SEAM(k) do { if (RUN(k) && RUN((k) + 1)) GRID_BAR(); } while (0)
#define SEAM_BG(k, drain) do { if (RUN(k) && RUN((k) + 1)) { if (!USE_CG_SYNC && l + 1 < DEPTH) xcd_barrier_bg(bar, F, l + 1, drain); else GRID_BAR(); } } while (0)
    if (RUN(0)) { phase_prologue(F); if (PROBE_DUP & 16) { __syncthreads(); phase_prologue(F); } }
    SEAM(0);
    { const int l = 0, b = 2; if (RUN(b + 0)) phase_norm1(F, lq_(l));
      SEAM_BG(b + 0, false); }
    for (int l = 0; l < DEPTH; ++l) {
        const int b = 2 + 13 * l;
        if (RUN(b + 1)) phase_gemm_in(F, lq_(l));
        SEAM_BG(b + 1, false);
        if (RUN(b + 2)) { phase_rec_c1(F, lq_(l)); phase_sgu(F, lq_(l)); if (PROBE_DUP & 1) { __syncthreads(); phase_rec_c1(F, lq_(l)); phase_sgu(F, lq_(l)); } if (PROBE_DUP & 64) { __syncthreads(); phase_sgu(F, lq_(l)); } }
        SEAM_BG(b + 2, false);
        if (RUN(b + 3)) { phase_rec_c2(F); if (PROBE_DUP & 4) phase_rec_c2(F); }
        SEAM_BG(b + 3, false);
        if (RUN(b + 5)) { phase_rec_c3(F, lq_(l)); if (PROBE_DUP & 2) { __syncthreads(); phase_rec_c3(F, lq_(l)); } if (PROBE_DUP & 128) { __syncthreads(); phase_rec_c3<1>(F, lq_(l)); } }
        SEAM_BG(b + 5, false);
        if (RUN(b + 6)) phase_gemm_out(F, lq_(l));
        SEAM_BG(b + 6, false);
        if (RUN(b + 7)) phase_norm2(F, lq_(l));
        SEAM_BG(b + 7, false);
        if (RUN(b + 8)) { phase_gather(F, lq_(l)); if (PROBE_DUP & 8) { __syncthreads(); phase_gather(F, lq_(l)); } }
        SEAM_BG(b + 8, false);
#if MOE_FUSED == 1
        if (RUN(b + 9)) phase_moe_fused(F, lq_(l));
        SEAM_BG(b + 9, false);
#elif MOE_FUSED == 2
        if (RUN(b + 9)) phase_moe_fused<1>(F, lq_(l));
        SEAM_BG(b + 9, false);
        if (RUN(b + 10)) phase_moe_fused<2>(F, lq_(l));
        SEAM_BG(b + 10, false);
#else
        if (RUN(b + 9)) phase_gemm_moe1(F, lq_(l));
        SEAM_BG(b + 9, false);
        if (RUN(b + 10)) phase_gemm_moe2(F, lq_(l));
        SEAM_BG(b + 10, false);
#endif
        if (RUN(b + 11)) phase_combine(F, lq_(l));
        SEAM_BG(b + 11, true);
        if (RUN(b + 12)) phase_gemm_pg(F, lq_(l));
        SEAM(b + 12);
    }
    if (RUN(54)) phase_final(F);
#undef RUN
#undef SEAM
}

#ifndef ONE_LAUNCH
#define ONE_LAUNCH 1
#endif
#ifndef CUTS
#define CUTS {0, 55}
#endif
#ifndef MFMA_MASK
#define MFMA_MASK 255
#endif
extern "C" void kernel_launch(void* const* d_in, const int* in_sizes, int n_in, void* d_out, int out_size, void* d_ws, size_t ws_size, hipStream_t stream) {
    if (n_in != 24 || out_size != T * D || ws_size < WS_END) { fprintf(stderr, "kernel_launch: unexpected shapes (n_in %d out %d ws %zu)\n", n_in, out_size, ws_size); return; }
    static_assert(CW_BAR + 60 * XCD_BAR_WORDS <= (int)(CTL_BYTES / 4), "barrier regions inside the zeroed control words");
    Params p{}; for (int i = 0; i < 24; ++i) p.in[i] = (const float*)d_in[i]; p.out = (float*)d_out; p.ws = (unsigned char*)d_ws;
    unsigned char* ws = p.ws;
    (void)hipMemsetAsync(ws + WS_CTL, 0, CTL_BYTES, stream);
    { static bool attr = false; if (!attr) { (void)hipFuncSetAttribute((const void*)k_mega, hipFuncAttributeMaxDynamicSharedMemorySize, LDS_BYTES); attr = true; }
      const int cuts[] = CUTS; const int ncut = (int)(sizeof(cuts) / sizeof(cuts[0]));
      for (int i = 0; i + 1 < ncut; ++i) { p.ph_lo = cuts[i]; p.ph_hi = cuts[i + 1]; p.li = i; p.pad = 0;
#if USE_CG_SYNC
          void* args[] = {&p}; hipError_t e = hipLaunchCooperativeKernel((const void*)k_mega, dim3(256), dim3(NTHR), args, LDS_BYTES, stream);
          if (e != hipSuccess) fprintf(stderr, "cooperative launch failed: %s\n", hipGetErrorName(e));
#else
          hipLaunchKernelGGL(k_mega, dim3(256), dim3(NTHR), LDS_BYTES, stream, p);
#endif
      }
    }
}
```

```cpp
#include <hip/hip_runtime.h>
#include <hip/hip_cooperative_groups.h>
#include <cstdio>
#include <cstdint>

#define GAS __attribute__((address_space(1)))
#define LAS __attribute__((address_space(3)))
typedef unsigned short bf16;
typedef float f32x4 __attribute__((ext_vector_type(4)));
typedef float f32x2 __attribute__((ext_vector_type(2)));
typedef unsigned u32x4 __attribute__((ext_vector_type(4)));
typedef unsigned u32x2 __attribute__((ext_vector_type(2)));
typedef short bf16x8 __attribute__((ext_vector_type(8)));

constexpr int T = 16384, D = 1024, DEPTH = 4, DIN = 3072, DREC = 512, DSGU = 512;
constexpr int NE = 32, DE = 512, PD = 256;
constexpr int RB = 256;
constexpr int CAP = 2 * T + NE * RB;
constexpr int NRBMAX = CAP / RB;
constexpr float EPS = 1e-6f;
constexpr int NWAVES = 8, NTHR = 512;

constexpr size_t MiB = 1u << 20, KiB = 1u << 10;
constexpr size_t WS_CTL = 0, CTL_BYTES = 1 * MiB;
constexpr size_t WS_MISC = 1 * MiB;
constexpr size_t MS_TOKE = WS_MISC + 0;
constexpr size_t MS_TOKW = WS_MISC + 128 * KiB;
constexpr size_t MS_SINFO = WS_MISC + 256 * KiB;
constexpr size_t MS_SDEST = WS_MISC + 384 * KiB;
constexpr size_t MS_RSTDPE = WS_MISC + 512 * KiB;
constexpr size_t MS_BLKBASE = WS_MISC + 576 * KiB;
constexpr size_t MS_LB = WS_MISC + 608 * KiB;
constexpr size_t MS_RSTD2 = WS_MISC + 704 * KiB;
constexpr size_t MS_RSTD1 = WS_MISC + 768 * KiB;
constexpr size_t MS_PART = WS_MISC + 6 * MiB;
constexpr size_t MS_RSTD3 = WS_MISC + 832 * KiB;
constexpr size_t MS_BLKE = WS_MISC + 640 * KiB;
constexpr size_t MS_DC = WS_MISC + 1 * MiB;
constexpr size_t MS_WRT = WS_MISC + 2 * MiB;
constexpr size_t MS_SGUW = WS_MISC + 3 * MiB;
constexpr size_t MS_MM = WS_MISC + 4 * MiB;
constexpr size_t MS_PTOT = WS_MISC + 5 * MiB;
constexpr size_t WS_WIN = 16 * MiB;
constexpr size_t WS_WOUT = 40 * MiB;
constexpr size_t WS_WGU = 48 * MiB;
constexpr size_t WS_WD = 304 * MiB;
constexpr size_t WS_WPG = 432 * MiB;
constexpr size_t WS_WPE = 440 * MiB;
constexpr size_t WS_PB = 442 * MiB;
constexpr size_t WS_H = 474 * MiB;
constexpr size_t WS_XN = 538 * MiB;
constexpr size_t WS_O = 570 * MiB;
constexpr size_t WS_PE = 602 * MiB;
constexpr size_t WS_R1 = 730 * MiB;
constexpr size_t WS_Z = WS_R1;
constexpr size_t WS_UT = WS_R1 + 96 * MiB;
constexpr size_t WS_ST = WS_R1 + 128 * MiB;
constexpr size_t WS_ORAW = WS_R1 + 96 * MiB;
constexpr size_t WS_VN = WS_R1 + 128 * MiB;
constexpr size_t WS_XB = WS_R1;
constexpr size_t WS_HB = WS_R1 + 80 * MiB;
constexpr size_t WS_Y = WS_R1 + 120 * MiB;
constexpr size_t WS_LTOT = 930 * MiB;
constexpr size_t WS_END = 934 * MiB;
constexpr int CW_CNT = 64;
constexpr int CW_BGQ = 1024;
constexpr int CW_DONE = 2048;
constexpr int CW_BAR = 4096;

constexpr int RING_BYTES = 131072, MISC_OFF = RING_BYTES, LDS_BYTES = 147456;

#ifndef PROBE_DUP
#define PROBE_DUP 0
#endif
#ifndef MOE_VBLK
#define MOE_VBLK 1
#endif
#ifndef MOE_FUSED
#define MOE_FUSED 1
#endif
#ifndef USE_CG_SYNC
#define USE_CG_SYNC 0
#endif
struct Params { const float* in[24]; float* out; unsigned char* ws; int ph_lo, ph_hi, li, pad; };

#define LDS_WAIT() asm volatile("s_waitcnt lgkmcnt(0)" ::: "memory")
template <int M> __device__ __forceinline__ float shx(float v) { static_assert(M >= 1 && M < 32, "swizzle xor mask");
    return __int_as_float(__builtin_amdgcn_ds_swizzle(__float_as_int(v), (M << 10) | 0x1F)); }
__device__ __forceinline__ float halves_sum(float v) {
    return __int_as_float(__builtin_amdgcn_readlane(__float_as_int(v), 0)) + __int_as_float(__builtin_amdgcn_readlane(__float_as_int(v), 32)); }
__device__ __forceinline__ float wave_sum(float v) {
    v += shx<1>(v); v += shx<2>(v); v += shx<4>(v); v += shx<8>(v); v += shx<16>(v);
    return halves_sum(v);
}
typedef __bf16 bf16x2_t __attribute__((ext_vector_type(2)));
__device__ __forceinline__ unsigned pk2(float lo, float hi) { const bf16x2_t v = __builtin_convertvector((f32x2){lo, hi}, bf16x2_t); return __builtin_bit_cast(unsigned, v); }
__device__ __forceinline__ unsigned f2bf(float f) { return pk2(f, f) & 0xffffu; }
__device__ __forceinline__ float bflo(unsigned w) { return __uint_as_float(w << 16); }
__device__ __forceinline__ float bfhi(unsigned w) { return __uint_as_float(w & 0xffff0000u); }
__device__ __forceinline__ float bf2f(bf16 b) { return __uint_as_float(((unsigned)b) << 16); }
__device__ __forceinline__ float fexp(float x) { return __builtin_amdgcn_exp2f(x * 1.4426950408889634f); }
__device__ __forceinline__ float flog(float x) { return __builtin_amdgcn_logf(x) * 0.6931471805599453f; }
__device__ __forceinline__ float frcp(float x) { return __builtin_amdgcn_rcpf(x); }
__device__ __forceinline__ float frsq(float x) { return __builtin_amdgcn_rsqf(x); }
__device__ __forceinline__ float sigmoid_(float x) { return frcp(1.f + fexp(-x)); }
__device__ __forceinline__ float silu_(float x) { return x * sigmoid_(x); }
__device__ __forceinline__ float gelu_(float x) { const float K1 = 2.f * 0.7978845608028654f * 1.4426950408889634f, K3 = K1 * 0.044715f;
    const float r = frcp(__builtin_amdgcn_exp2f(x * (K1 + K3 * (x * x))) + 1.f); return x - x * r; }

struct Frame {
    LAS unsigned char* lds; unsigned char* ws; const float* const* in; float* out;
    int wave, blk, G;
};
__device__ __forceinline__ int lane_now() { int l; asm volatile("v_mbcnt_lo_u32_b32 %0, -1, 0\n\tv_mbcnt_hi_u32_b32 %0, -1, %0" : "=v"(l)); return l; }
__device__ __forceinline__ int vblk(int b) { return 4 * (8 * (b & 7) + (b >> 5)) + ((b >> 3) & 3); }
#define PH_TID() int ph_wave = F.wave; asm volatile("" : "+s"(ph_wave)); const int lane = lane_now(); (void)lane; const int tid = (ph_wave << 6) | lane; (void)tid

struct ConvJob { const float* W; const float* g; bf16* WT; int K, N, k0, n0, mode; };
constexpr int TL_IN = 16 * 12, TL_OUT = 16 * 4, TL_G = 32 * 16 * 2, TL_D = 32 * 8 * 4, TL_PG = 16 * 4, TL_PE = 4 * 4;
constexpr int TL_LAYER = TL_IN + TL_OUT + 2 * TL_G + TL_D + TL_PG + TL_PE;
__device__ __forceinline__ ConvJob conv_job(const Frame& F, int it) {
    unsigned char* ws = F.ws; const int l = it / TL_LAYER; int r = it % TL_LAYER; ConvJob j;
    if (r < TL_IN) { j.W = F.in[3] + (size_t)l * D * DIN; j.g = F.in[2] + l * D; j.WT = (bf16*)(ws + WS_WIN) + (size_t)l * DIN * D; j.K = D; j.N = DIN; j.k0 = 64 * (r / 12); j.n0 = 256 * (r % 12); j.mode = 0; return j; } r -= TL_IN;
    if (r < TL_OUT) { j.W = F.in[10] + (size_t)l * D * D; j.g = nullptr; j.WT = (bf16*)(ws + WS_WOUT) + (size_t)l * D * D; j.K = D; j.N = D; j.k0 = 64 * (r / 4); j.n0 = 256 * (r % 4); j.mode = 0; return j; } r -= TL_OUT;
    if (r < 2 * TL_G) { const int up = r >= TL_G; if (up) r -= TL_G; const int e = r / 32, rr = r % 32;
        j.W = F.in[up ? 17 : 16] + (size_t)(l * NE + e) * D * DE; j.g = F.in[11] + l * D; j.WT = (bf16*)(ws + WS_WGU) + (size_t)(l * NE + e) * 1024 * 1024; j.K = D; j.N = DE; j.k0 = 64 * (rr / 2); j.n0 = 256 * (rr % 2); j.mode = 1 + up; return j; } r -= 2 * TL_G;
    if (r < TL_D) { const int e = r / 32, rr = r % 32; j.W = F.in[18] + (size_t)(l * NE + e) * DE * D; j.g = nullptr; j.WT = (bf16*)(ws + WS_WD) + (size_t)(l * NE + e) * D * DE; j.K = DE; j.N = D; j.k0 = 64 * (rr / 4); j.n0 = 256 * (rr % 4); j.mode = 0; return j; } r -= TL_D;
    if (r < TL_PG) { j.W = F.in[20] + (size_t)l * D * D; j.g = F.in[19] + l * D; j.WT = (bf16*)(ws + WS_WPG) + (size_t)l * D * D; j.K = D; j.N = D; j.k0 = 64 * (r / 4); j.n0 = 256 * (r % 4); j.mode = 0; return j; } r -= TL_PG;
    j.W = F.in[21] + (size_t)l * PD * D; j.g = nullptr; j.WT = (bf16*)(ws + WS_WPE) + (size_t)l * D * PD; j.K = PD; j.N = D; j.k0 = 64 * (r / 4); j.n0 = 256 * (r % 4); j.mode = 0; return j;
}
__device__ __forceinline__ void conv_load(const ConvJob& j, int wave, int lane, f32x4 (&v)[8]) {
#pragma unroll
    for (int i = 0; i < 8; ++i) { const int row = 8 * wave + i; v[i] = *(const f32x4*)(j.W + (size_t)(j.k0 + row) * j.N + j.n0 + 4 * lane); if (j.g) v[i] = v[i] * j.g[j.k0 + row]; }
}
constexpr int NDEF = 0, NDEF1 = 0, NBG = 3408;
constexpr int NREST = TL_LAYER - NDEF - NBG, NPRO = TL_LAYER + 3 * NREST;
__device__ __forceinline__ int pro_tile(int f) { if (NREST == 0 || f < TL_LAYER) return f; f -= TL_LAYER; const int l = 1 + f / (NREST ? NREST : 1); return l * TL_LAYER + NDEF + NBG + f % (NREST ? NREST : 1); }
template <class M> __device__ __forceinline__ void conv_run(const Frame& F, int first, int stride, int count, M tile_of) {
    PH_TID();
    LAS float* tile = (LAS float*)F.lds;
    const int wave = ph_wave;
    int f = first; f32x4 v[8]; ConvJob cur{}, nxt{};
    if (f < count) { cur = conv_job(F, tile_of(f)); conv_load(cur, wave, lane, v); }
    while (f < count) {
#pragma unroll
        for (int i = 0; i < 8; ++i) { LAS float* d = tile + (8 * wave + i) * 257 + 4 * lane; d[0] = v[i].x; d[1] = v[i].y; d[2] = v[i].z; d[3] = v[i].w; }
        __syncthreads();
        const int fn = f + stride; if (fn < count) { nxt = conv_job(F, tile_of(fn)); conv_load(nxt, wave, lane, v); }
#pragma unroll
        for (int q = 0; q < 4; ++q) { const int nn = 32 * wave + 8 * q + (lane >> 3), c = lane & 7; const LAS float* sp = tile + (8 * c) * 257 + nn;
            u32x4 o; o.x = pk2(sp[0 * 257], sp[1 * 257]); o.y = pk2(sp[2 * 257], sp[3 * 257]); o.z = pk2(sp[4 * 257], sp[5 * 257]); o.w = pk2(sp[6 * 257], sp[7 * 257]);
            const int n = cur.n0 + nn; const int drow = cur.mode == 0 ? n : ((n >> 7) * 256 + (n & 127) + (cur.mode == 2 ? 128 : 0));
            *(u32x4*)(cur.WT + (size_t)drow * cur.K + cur.k0 + 8 * c) = o; }
        __syncthreads();
        cur = nxt; f = fn;
    }
}
__device__ __forceinline__ void conv_deferred(const Frame& F, int lnext, int r0, int r1, int first, int idle) {
    if (lnext >= DEPTH || F.blk < first) return;
    conv_run(F, F.blk - first, idle, r1 - r0, [=](int f) { return lnext * TL_LAYER + r0 + f; });
}
__device__ __forceinline__ void phase_prologue(const Frame& F) {
    PH_TID();
    unsigned char* ws = F.ws;
    conv_run(F, F.blk, F.G, NPRO, [](int f) { return pro_tile(f); });
    { const f32x4* src = (const f32x4*)F.in[1]; u32x4* dst = (u32x4*)(ws + WS_PB); const size_t n8 = (size_t)DEPTH * T * PD / 8;
      for (size_t i = (size_t)F.blk * NTHR + tid; i < n8; i += (size_t)F.G * NTHR) { const f32x4 a = src[2 * i], b = src[2 * i + 1]; u32x4 o; o.x = pk2(a.x, a.y); o.y = pk2(a.z, a.w); o.z = pk2(b.x, b.y); o.w = pk2(b.z, b.w); dst[i] = o; } }
    { float* wrt = (float*)(ws + MS_WRT);
      for (int i = F.blk * NTHR + tid; i < DEPTH * 36 * D; i += F.G * NTHR) { const int k = i % D, n = (i / D) % 36, l = i / (36 * D);
          const float w = n < 4 ? F.in[12][((size_t)l * D + k) * 4 + n] : F.in[14][((size_t)l * D + k) * NE + (n - 4)]; wrt[i] = w * F.in[11][l * D + k]; } }
    { bf16* wb = (bf16*)(ws + MS_SGUW); for (int i = F.blk * NTHR + tid; i < DEPTH * 4 * 128 * 128; i += F.G * NTHR) { const int tc = (i >> 7) & 127, sp = i & 127; wb[i] = sp <= tc ? (bf16)f2bf(F.in[8][i]) : (bf16)0; } }
    if (F.blk == 0 && tid < DREC) { const int c = tid; float v[DEPTH], m = -1e30f;
#pragma unroll
        for (int l = 0; l < DEPTH; ++l) { v[l] = F.in[4][l * DREC + c]; m = fmaxf(m, v[l]); }
        float s = 0.f;
#pragma unroll
        for (int l = 0; l < DEPTH; ++l) { v[l] = fexp(v[l] - m); s += v[l]; }
        float* lb = (float*)(ws + MS_LB); float acc = 0.f;
#pragma unroll
        for (int l = 0; l < DEPTH; ++l) { if (l > 0) acc += v[l] / s; lb[l * DREC + c] = acc; } }
}

__device__ __forceinline__ void load_row(const float* row, int lane, f32x4 (&v)[4]) { const f32x4* r = (const f32x4*)row + lane;
#pragma unroll
    for (int j = 0; j < 4; ++j) v[j] = r[64 * j]; }
__device__ __forceinline__ void load_row_bf(const bf16* row, int lane, f32x4 (&v)[4]) { const u32x2* r = (const u32x2*)row + lane;
#pragma unroll
    for (int j = 0; j < 4; ++j) { const u32x2 x = r[64 * j]; v[j] = (f32x4){bflo(x.x), bfhi(x.x), bflo(x.y), bfhi(x.y)}; } }
__device__ __forceinline__ float row_sumsq(const f32x4 (&v)[4]) { float s = 0.f;
#pragma unroll
    for (int j = 0; j < 4; ++j) s += (v[j].x * v[j].x + v[j].y * v[j].y) + (v[j].z * v[j].z + v[j].w * v[j].w);
    return wave_sum(s); }
__device__ __forceinline__ void store_row_bf16(bf16* orow, int lane, const f32x4 (&v)[4], float s) { u32x2* o = (u32x2*)orow + lane;
#pragma unroll
    for (int j = 0; j < 4; ++j) { u32x2 w; w.x = pk2(v[j].x * s, v[j].y * s); w.y = pk2(v[j].z * s, v[j].w * s); o[64 * j] = w; } }

__device__ __forceinline__ void phase_norm1(const Frame& F, int l) {
    PH_TID();
    float* rstd1 = (float*)(F.ws + MS_RSTD1); bf16* h = (bf16*)(F.ws + WS_H); const float* x = F.in[0];
    const int gw = F.blk * NWAVES + ph_wave, NGW = F.G * NWAVES;
    for (int t = gw; t < T; t += NGW) { f32x4 v[4];
        if (l == 0) { load_row(x + (size_t)t * D, lane, v); store_row_bf16(h + (size_t)t * D, lane, v, 1.f); } else load_row_bf(h + (size_t)t * D, lane, v);
        const float rstd = frsq(row_sumsq(v) * (1.f / D) + EPS); if (lane == 0) rstd1[t] = rstd; }
}
__device__ __forceinline__ float bfly8(const float (&r)[8], int lane) {
    const bool b2 = lane & 4, b1 = lane & 2, b0 = lane & 1; float a[4], c[2];
#pragma unroll
    for (int i = 0; i < 4; ++i) { const float keep = b2 ? r[i + 4] : r[i], send = b2 ? r[i] : r[i + 4]; a[i] = keep + shx<4>(send); }
#pragma unroll
    for (int i = 0; i < 2; ++i) { const float keep = b1 ? a[i + 2] : a[i], send = b1 ? a[i] : a[i + 2]; c[i] = keep + shx<2>(send); }
    const float keep = b0 ? c[1] : c[0], send = b0 ? c[0] : c[1]; float d = keep + shx<1>(send);
    d += shx<8>(d); d += shx<16>(d);
    return d + __int_as_float(__builtin_amdgcn_ds_bpermute((lane ^ 32) << 2, __float_as_int(d)));
}
__device__ __forceinline__ void phase_norm2(const Frame& F, int l) {
    PH_TID();
    unsigned char* ws = F.ws;
    unsigned* hist = (unsigned*)(F.lds + MISC_OFF + 256);
    if (tid < 32) hist[tid] = 0u;
    __syncthreads();
    const bf16* h = (const bf16*)(ws + WS_H); bf16* XN = (bf16*)(ws + WS_XN);
    const float* WrT = (const float*)(ws + MS_WRT) + (size_t)l * 36 * D;
    const float* b_rg = F.in[13] + l * 4; const float* b_re = F.in[15] + l * NE;
    int* tok_e = (int*)(ws + MS_TOKE); float* tok_w = (float*)(ws + MS_TOKW); unsigned* sinfo = (unsigned*)(ws + MS_SINFO);
    const int RPB = T / F.G, RPW = RPB / NWAVES;
    for (int i0 = 0; i0 < RPW; i0 += 8) {
        const int t0 = F.blk * RPB + ph_wave * RPW + i0;
        f32x4 v[8][4]; float ss[8];
#pragma unroll
        for (int r = 0; r < 8; ++r) { load_row_bf(h + (size_t)(t0 + r) * D, lane, v[r]); float q = 0.f;
#pragma unroll
            for (int j = 0; j < 4; ++j) q += (v[r][j].x * v[r][j].x + v[r][j].y * v[r][j].y) + (v[r][j].z * v[r][j].z + v[r][j].w * v[r][j].w);
            ss[r] = q; }
        const float rstd_mine = frsq(bfly8(ss, lane) * (1.f / D) + EPS);
        if (lane < 8) ((float*)(ws + MS_RSTD2))[t0 + lane] = rstd_mine;
        LAS float* lgw = (LAS float*)(F.lds + 4096) + ph_wave * (36 * 8);
#pragma unroll 2
        for (int n = 0; n < 36; ++n) { const f32x4* wr = (const f32x4*)(WrT + (size_t)n * D) + lane; const f32x4 w0 = wr[0], w1 = wr[64], w2 = wr[128], w3 = wr[192]; float pr[8];
#pragma unroll
            for (int r = 0; r < 8; ++r) pr[r] = ((v[r][0].x * w0.x + v[r][0].y * w0.y) + (v[r][0].z * w0.z + v[r][0].w * w0.w)) + ((v[r][1].x * w1.x + v[r][1].y * w1.y) + (v[r][1].z * w1.z + v[r][1].w * w1.w))
                                                 + ((v[r][2].x * w2.x + v[r][2].y * w2.y) + (v[r][2].z * w2.z + v[r][2].w * w2.w)) + ((v[r][3].x * w3.x + v[r][3].y * w3.y) + (v[r][3].z * w3.z + v[r][3].w * w3.w));
            const float val = bfly8(pr, lane) * rstd_mine; if (lane < 8) lgw[n * 8 + lane] = val; }
        const int row = lane & 7;
        float lg4[4], lgb[4];
#pragma unroll
        for (int j = 0; j < 4; ++j) { lg4[j] = lgw[j * 8 + row]; lgb[j] = lg4[j] + b_rg[j]; }
        int gs = 0; float gm = lgb[0];
#pragma unroll
        for (int j = 1; j < 4; ++j) if (lgb[j] > gm) { gm = lgb[j]; gs = j; }
        float mx = fmaxf(fmaxf(lg4[0], lg4[1]), fmaxf(lg4[2], lg4[3])), se = 0.f, lsel = lg4[0];
#pragma unroll
        for (int j = 0; j < 4; ++j) { se += fexp(lg4[j] - mx); if (j == gs) lsel = lg4[j]; }
        const float g_w = fexp(lsel - mx) * frcp(se);
        float le[8], leb[8];
#pragma unroll
        for (int j = 0; j < 8; ++j) { le[j] = lgw[(4 + gs * 8 + j) * 8 + row]; leb[j] = le[j] + b_re[gs * 8 + j]; }
        int s0 = 0; float m0 = leb[0];
#pragma unroll
        for (int j = 1; j < 8; ++j) if (leb[j] > m0) { m0 = leb[j]; s0 = j; }
        int s1 = -1; float m1 = -3.0e38f;
#pragma unroll
        for (int j = 0; j < 8; ++j) if (j != s0 && leb[j] > m1) { m1 = leb[j]; s1 = j; }
        if (s1 < 0) s1 = (s0 == 0) ? 1 : 0;
        float la = le[0], lb2 = le[0];
#pragma unroll
        for (int j = 1; j < 8; ++j) { if (j == s0) la = le[j]; if (j == s1) lb2 = le[j]; }
        const float wa = frcp(1.f + fexp(lb2 - la)), wb = 1.f - wa;
        if (lane < 8) { const int t = t0 + lane;
            const int e0 = gs * 8 + s0, e1 = gs * 8 + s1;
            const unsigned r0 = atomicAdd(&hist[e0], 1u), r1 = atomicAdd(&hist[e1], 1u);
            tok_e[2 * t] = e0; tok_e[2 * t + 1] = e1; tok_w[2 * t] = g_w * wa; tok_w[2 * t + 1] = g_w * wb;
            sinfo[2 * t] = ((unsigned)F.blk << 16) | r0; sinfo[2 * t + 1] = ((unsigned)F.blk << 16) | r1;
        }
    }
    __syncthreads();
    if (tid < 32) { unsigned* cnt = (unsigned*)(ws + WS_CTL) + CW_CNT + l * 32;
        const unsigned base = __hip_atomic_fetch_add(cnt + tid, hist[tid], __ATOMIC_RELAXED, __HIP_MEMORY_SCOPE_AGENT);
        ((unsigned*)(ws + MS_BLKBASE))[F.blk * 32 + tid] = base; }
}
__device__ __forceinline__ void phase_gather(const Frame& F, int l) {
    PH_TID();
    unsigned char* ws = F.ws;
    int* ps = (int*)(F.lds + MISC_OFF + 512);
    if (tid == 0) { unsigned* cnt = (unsigned*)(ws + WS_CTL) + CW_CNT + l * 32; int* blke = (int*)(ws + MS_BLKE) + l * 256; int acc = 0;
        for (int e = 0; e < NE; ++e) { const int c = (int)__hip_atomic_load(cnt + e, __ATOMIC_RELAXED, __HIP_MEMORY_SCOPE_AGENT); ps[e] = acc; const int pad = (c + RB - 1) / RB * RB;
            if (F.blk == 0) for (int rb = acc / RB; rb < (acc + pad) / RB; ++rb) blke[rb] = e;
            acc += pad; }
        if (F.blk == 0) blke[255] = acc / RB; }
    __syncthreads();
    const int* tok_e = (const int*)(ws + MS_TOKE); const unsigned* sinfo = (const unsigned*)(ws + MS_SINFO); const unsigned* bbase = (const unsigned*)(ws + MS_BLKBASE);
    int* sdest = (int*)(ws + MS_SDEST); const bf16* hres = (const bf16*)(ws + WS_H); const float* rstd2 = (const float*)(ws + MS_RSTD2); bf16* XB = (bf16*)(ws + WS_XB);
    const int gw = F.blk * NWAVES + ph_wave, NGW = F.G * NWAVES;
    for (int t = gw; t < T; t += NGW) {
        const u32x4* src = (const u32x4*)(hres + (size_t)t * D) + lane; const u32x4 ha = src[0], hb = src[64]; const float rs = rstd2[t];
        u32x4 a, b;
        a.x = pk2(bflo(ha.x) * rs, bfhi(ha.x) * rs); a.y = pk2(bflo(ha.y) * rs, bfhi(ha.y) * rs); a.z = pk2(bflo(ha.z) * rs, bfhi(ha.z) * rs); a.w = pk2(bflo(ha.w) * rs, bfhi(ha.w) * rs);
        b.x = pk2(bflo(hb.x) * rs, bfhi(hb.x) * rs); b.y = pk2(bflo(hb.y) * rs, bfhi(hb.y) * rs); b.z = pk2(bflo(hb.z) * rs, bfhi(hb.z) * rs); b.w = pk2(bflo(hb.w) * rs, bfhi(hb.w) * rs);
#pragma unroll
        for (int j = 0; j < 2; ++j) { const int e = tok_e[2 * t + j]; const unsigned info = sinfo[2 * t + j];
            const int dest = ps[e] + (int)bbase[(info >> 16) * 32 + e] + (int)(info & 0xffffu);
            if (lane == 0) sdest[2 * t + j] = dest;
            u32x4* dst = (u32x4*)(XB + (size_t)dest * D) + lane; dst[0] = a; dst[64] = b; }
    }
}
__device__ __forceinline__ void phase_combine(const Frame& F, int l) {
    PH_TID();
    unsigned char* ws = F.ws;
    bf16* h = (bf16*)(ws + WS_H); bf16* XN = (bf16*)(ws + WS_XN); const bf16* Y = (const bf16*)(ws + WS_Y); const bf16* PE = (const bf16*)(ws + WS_PE) + (size_t)l * T * D;
    const int* sdest = (const int*)(ws + MS_SDEST); const float* tok_w = (const float*)(ws + MS_TOKW); float* rstd_pe = (float*)(ws + MS_RSTDPE); float* rstd_pg = (float*)(ws + MS_RSTD3);
    const int gw = F.blk * NWAVES + ph_wave, NGW = F.G * NWAVES;
    struct Rows { u32x2 h[4], y0[4], y1[4], pe[4]; };
    auto fetch = [&](int t, int d0, int d1, Rows& r) {
        const u32x2* hp = (const u32x2*)(h + (size_t)t * D) + lane; const u32x2* y0 = (const u32x2*)(Y + (size_t)d0 * D) + lane; const u32x2* y1 = (const u32x2*)(Y + (size_t)d1 * D) + lane; const u32x2* pe = (const u32x2*)(PE + (size_t)t * D) + lane;
#pragma unroll
        for (int j = 0; j < 4; ++j) { r.h[j] = hp[64 * j]; r.y0[j] = y0[64 * j]; r.y1[j] = y1[64 * j]; r.pe[j] = pe[64 * j]; } };
    int t = gw; if (t >= T) return;
    Rows cur; int d0n = 0, d1n = 0; float w0 = tok_w[2 * t], w1 = tok_w[2 * t + 1], w0n = 0.f, w1n = 0.f;
    fetch(t, sdest[2 * t], sdest[2 * t + 1], cur);
    if (t + NGW < T) { d0n = sdest[2 * (t + NGW)]; d1n = sdest[2 * (t + NGW) + 1]; w0n = tok_w[2 * (t + NGW)]; w1n = tok_w[2 * (t + NGW) + 1]; }
    for (; t < T; t += NGW) {
        Rows nxt = cur; const float w0c = w0, w1c = w1; const bool more = t + NGW < T;
        if (more) { fetch(t + NGW, d0n, d1n, nxt); w0 = w0n; w1 = w1n;
            if (t + 2 * NGW < T) { d0n = sdest[2 * (t + 2 * NGW)]; d1n = sdest[2 * (t + 2 * NGW) + 1]; w0n = tok_w[2 * (t + 2 * NGW)]; w1n = tok_w[2 * (t + 2 * NGW) + 1]; } }
        f32x4 v[4]; float sp = 0.f;
#pragma unroll
        for (int j = 0; j < 4; ++j) { const u32x2 x = cur.h[j], a = cur.y0[j], b = cur.y1[j], c = cur.pe[j];
            v[j] = (f32x4){bflo(x.x) + (w0c * bflo(a.x) + w1c * bflo(b.x)), bfhi(x.x) + (w0c * bfhi(a.x) + w1c * bfhi(b.x)), bflo(x.y) + (w0c * bflo(a.y) + w1c * bflo(b.y)), bfhi(x.y) + (w0c * bfhi(a.y) + w1c * bfhi(b.y))};
            const float p0 = bflo(c.x), p1 = bfhi(c.x), p2 = bflo(c.y), p3 = bfhi(c.y); sp += (p0 * p0 + p1 * p1) + (p2 * p2 + p3 * p3); }
        store_row_bf16(XN + (size_t)t * D, lane, v, 1.f);
        const float rstd = frsq(row_sumsq(v) * (1.f / D) + EPS);
        sp = wave_sum(sp); if (lane == 0) { rstd_pe[t] = frsq(sp * (1.f / D) + EPS); rstd_pg[t] = rstd; }
        cur = nxt;
    }
}
__device__ __forceinline__ void phase_final(const Frame& F) {
    PH_TID();
    const bf16* h = (const bf16*)(F.ws + WS_H); const float* nf = F.in[23];
    const int gw = F.blk * NWAVES + ph_wave, NGW = F.G * NWAVES;
    for (int t = gw; t < T; t += NGW) { f32x4 v[4]; load_row_bf(h + (size_t)t * D, lane, v); const float rstd = frsq(row_sumsq(v) * (1.f / D) + EPS);
        f32x4* o = (f32x4*)(F.out + (size_t)t * D) + lane; const f32x4* g = (const f32x4*)nf + lane;
#pragma unroll
        for (int j = 0; j < 4; ++j) o[64 * j] = v[j] * rstd * g[64 * j]; }
}


namespace pg8 {
constexpr int BM = 256, BK = 64, HALF = 128, HTB = HALF * BK * 2, STAGE_BYTES = 8 * HTB, NXCD = 8, WGM = 8;
__host__ __device__ __forceinline__ int lds_byte(int r, int c) { const int st = (r >> 4) * 2 + (c >> 5), rr = r & 15, cc = c & 31, ob = rr * 64 + cc * 2; return st * 1024 + (ob ^ (((ob >> 9) & 1) << 5)); }
__host__ __device__ __forceinline__ void stage_rc(int b, int& R, int& C) { const int st = b / 1024, sb = b % 1024, swz = sb ^ (((sb >> 9) & 1) << 5); R = (st >> 1) * 16 + swz / 64; C = (st & 1) * 32 + (swz % 64) / 2; }
__host__ __device__ __forceinline__ int perm32(int rho) { const int n = rho >> 4, i = rho & 15; return 8 * (i >> 2) + 4 * n + (i & 3); }
struct Unit { int pm, pn; const char* A; const char* B; };
__device__ __forceinline__ void static_map(int wgid, int nM, int nN, int& pm, int& pn) {
    const int nwg = nM * nN; { const int q = nwg / NXCD, r = nwg % NXCD, xcd = wgid % NXCD, off = wgid / NXCD; wgid = (xcd < r ? xcd * (q + 1) : r * (q + 1) + (xcd - r) * q) + off; }
    const int nig = WGM * nN, gid = wgid / nig, fm = gid * WGM, gsz = (nM - fm) < WGM ? (nM - fm) : WGM;
    pm = fm + ((wgid % nig) % gsz); pn = (wgid % nig) / gsz;
}
struct DenseOrder { static constexpr bool DEPS = false;
    const char* A; const char* Bt; int nM, nN, nL, G, c; size_t tstep;
    __device__ void init(const void* A_, const void* Bt_, int M, int N, int K, int nL_, int G_, int c_) { A = (const char*)A_; Bt = (const char*)Bt_; nM = M / BM; nN = N / BM; nL = nL_; G = G_; c = c_; tstep = (size_t)BM * K * 2; }
    __device__ bool next(int i, Unit& u) const { const long L = (long)i * G + c; const int per = nM * nN; if (L >= (long)per * nL) return false;
        const int l = (int)(L / per); int pm, pn; static_map((int)(L % per), nM, nN, pm, pn); u.pm = l * nM + pm; u.pn = pn; u.A = A + (size_t)u.pm * tstep; u.B = Bt + (size_t)(l * nN + pn) * tstep; return true; }
};
struct MoeOrder { static constexpr bool DEPS = false;
    const char* A; const char* W; const int* blke; int nrb, nN, G, c, e0, e1, e2; size_t a_tstep, w_estride, b_tstep;
    __device__ void init(const void* A_, const void* W_, const int* blke_, int K, int nN_, size_t w_estride_bytes, int G_, int c_) { A = (const char*)A_; W = (const char*)W_; blke = blke_; nrb = __builtin_amdgcn_readfirstlane(blke_[255]); nN = nN_; G = G_; c = c_;
        a_tstep = (size_t)BM * K * 2; b_tstep = a_tstep; w_estride = w_estride_bytes;
        const int r0 = c / nN, r1 = (G + c) / nN, r2 = (2 * G + c) / nN; const int x0 = blke_[r0 < 255 ? r0 : 254], x1 = blke_[r1 < 255 ? r1 : 254], x2 = blke_[r2 < 255 ? r2 : 254];
        e0 = __builtin_amdgcn_readfirstlane(x0); e1 = __builtin_amdgcn_readfirstlane(x1); e2 = __builtin_amdgcn_readfirstlane(x2); }
    __device__ bool next(int i, Unit& u) const { const long L = (long)i * G + c; if (L >= (long)nrb * nN) return false; const int rb = (int)(L / nN), pn = (int)(L % nN);
        const int ex = i == 0 ? e0 : i == 1 ? e1 : i == 2 ? e2 : __builtin_amdgcn_readfirstlane(blke[rb]);
        u.pm = rb; u.pn = pn; u.A = A + (size_t)rb * a_tstep; u.B = W + (size_t)ex * w_estride + (size_t)pn * b_tstep; return true; }
};
__device__ __forceinline__ unsigned ag_ld(const unsigned* p)        { return __hip_atomic_load(p, __ATOMIC_RELAXED, __HIP_MEMORY_SCOPE_AGENT); }
__device__ __forceinline__ unsigned ag_add(unsigned* p, unsigned v) { return __hip_atomic_fetch_add(p, v, __ATOMIC_RELAXED, __HIP_MEMORY_SCOPE_AGENT); }
struct MoeDepOrder { static constexpr bool DEPS = true;
    const char* A; const char* W; const int* blke; const unsigned* done; int nrb, nN, G, c, e0, e1, e2; size_t a_tstep, w_estride, b_tstep;
    __device__ void init(const void* A_, const void* W_, const int* blke_, const unsigned* done_, int K, int nN_, size_t w_estride_bytes, int G_, int c_) { A = (const char*)A_; W = (const char*)W_; blke = blke_; done = done_;
        nrb = __builtin_amdgcn_readfirstlane(blke_[255]); nN = nN_; G = G_; c = c_; a_tstep = (size_t)BM * K * 2; b_tstep = a_tstep; w_estride = w_estride_bytes;
        const int r0 = c / nN, r1 = (G + c) / nN, r2 = (2 * G + c) / nN; const int x0 = blke_[r0 < 255 ? r0 : 254], x1 = blke_[r1 < 255 ? r1 : 254], x2 = blke_[r2 < 255 ? r2 : 254];
        e0 = __builtin_amdgcn_readfirstlane(x0); e1 = __builtin_amdgcn_readfirstlane(x1); e2 = __builtin_amdgcn_readfirstlane(x2); }
    __device__ bool next(int i, Unit& u) const { const long L = (long)i * G + c; if (L >= (long)nrb * nN) return false; const int rb = (int)(L / nN), pn = (int)(L % nN);
        const int ex = i == 0 ? e0 : i == 1 ? e1 : i == 2 ? e2 : __builtin_amdgcn_readfirstlane(blke[rb]);
        u.pm = rb; u.pn = pn; u.A = A + (size_t)rb * a_tstep; u.B = W + (size_t)ex * w_estride + (size_t)pn * b_tstep; return true; }
    __device__ void wait(const Unit& u, int wid) const {
        if (wid == 0 && lane_now() == 0) { while (ag_ld(done + u.pm) < 4u) __builtin_amdgcn_s_sleep(1); __builtin_amdgcn_fence(__ATOMIC_ACQUIRE, "agent"); } }
};
struct RangeOrder { static constexpr bool DEPS = false;
    const char* A; const char* Bt; int nM, nN, j0, n; size_t tstep;
    __device__ void init(const void* A_, const void* Bt_, int M, int N, int K, int j0_, int n_) { A = (const char*)A_; Bt = (const char*)Bt_; nM = M / BM; nN = N / BM; j0 = j0_; n = n_; tstep = (size_t)BM * K * 2; }
    __device__ bool next(int i, Unit& u) const { if (i >= n) return false; int pm, pn; static_map(j0 + i, nM, nN, pm, pn); u.pm = pm; u.pn = pn; u.A = A + (size_t)pm * tstep; u.B = Bt + (size_t)pn * tstep; return true; }
};
__device__ __forceinline__ unsigned cvt_pk_bf16(float lo, float hi) { return pk2(lo, hi); }
struct EpiBf16 { static constexpr bool PERM = true, ACC_INIT = false, SIGNAL = false; bf16* O; int ldc;
    __device__ __forceinline__ void operator()(const f32x4 (&acc)[2][2][4][2], const Unit& u, int wr, int wc, int, int) const {
        const int t2 = lane_now(), fr = t2 & 15, fq = t2 >> 4;
        const int row0 = u.pm * BM + wr * 64 + fr, col0 = u.pn * BM + wc * 32 + 8 * fq;
#pragma unroll
        for (int ai = 0; ai < 2; ++ai)
#pragma unroll
            for (int m = 0; m < 4; ++m) { bf16* rowp = O + (size_t)(row0 + ai * HALF + m * 16) * ldc + col0;
#pragma unroll
                for (int bj = 0; bj < 2; ++bj) { const f32x4 v0 = acc[ai][bj][m][0], v1 = acc[ai][bj][m][1];
                    u32x4 w; w.x = cvt_pk_bf16(v0[0], v0[1]); w.y = cvt_pk_bf16(v0[2], v0[3]); w.z = cvt_pk_bf16(v1[0], v1[1]); w.w = cvt_pk_bf16(v1[2], v1[3]);
                    *(u32x4*)(rowp + bj * HALF) = w; } }
    } };
struct EpiBf16Rs { static constexpr bool PERM = true, ACC_INIT = false, SIGNAL = false; bf16* O; int ldc; const float* rs; const float* part;
    __device__ __forceinline__ void operator()(const f32x4 (&acc)[2][2][4][2], const Unit& u, int wr, int wc, int, int) const {
        const int t2 = lane_now(), fr = t2 & 15, fq = t2 >> 4;
        const int row0 = u.pm * BM + wr * 64 + fr, col0 = u.pn * BM + wc * 32 + 8 * fq;
#pragma unroll
        for (int ai = 0; ai < 2; ++ai)
#pragma unroll
            for (int m = 0; m < 4; ++m) { const int row = row0 + ai * HALF + m * 16; const float r = part ? frsq(((part[row] + part[T + row]) + (part[2 * T + row] + part[3 * T + row])) * (1.f / D) + EPS) : rs[row]; bf16* rowp = O + (size_t)row * ldc + col0;
#pragma unroll
                for (int bj = 0; bj < 2; ++bj) { const f32x4 v0 = acc[ai][bj][m][0] * r, v1 = acc[ai][bj][m][1] * r;
                    u32x4 w; w.x = cvt_pk_bf16(v0[0], v0[1]); w.y = cvt_pk_bf16(v0[2], v0[3]); w.z = cvt_pk_bf16(v1[0], v1[1]); w.w = cvt_pk_bf16(v1[2], v1[3]);
                    *(u32x4*)(rowp + bj * HALF) = w; } }
    } };
struct EpiResid { static constexpr bool PERM = true, ACC_INIT = true, SIGNAL = false; bf16* h;
    __device__ __forceinline__ void init(f32x4 (&acc)[2][2][4][2], const Unit& u, int wr, int wc, int fr, int fq) const {
        const int row0 = u.pm * BM + wr * 64 + fr, col0 = u.pn * BM + wc * 32 + 8 * fq;
#pragma unroll
        for (int ai = 0; ai < 2; ++ai)
#pragma unroll
            for (int m = 0; m < 4; ++m) { const bf16* rowp = h + (size_t)(row0 + ai * HALF + m * 16) * D + col0;
#pragma unroll
                for (int bj = 0; bj < 2; ++bj) { const u32x4 x = *(const u32x4*)(rowp + bj * HALF);
                    acc[ai][bj][m][0] = (f32x4){bflo(x.x), bfhi(x.x), bflo(x.y), bfhi(x.y)}; acc[ai][bj][m][1] = (f32x4){bflo(x.z), bfhi(x.z), bflo(x.w), bfhi(x.w)}; } }
    }
    __device__ __forceinline__ void operator()(const f32x4 (&acc)[2][2][4][2], const Unit& u, int wr, int wc, int fr, int fq) const {
        asm volatile("" : "+v"(fr), "+v"(fq));
        const int row0 = u.pm * BM + wr * 64 + fr, col0 = u.pn * BM + wc * 32 + 8 * fq;
#pragma unroll
        for (int ai = 0; ai < 2; ++ai)
#pragma unroll
            for (int m = 0; m < 4; ++m) { bf16* rowp = h + (size_t)(row0 + ai * HALF + m * 16) * D + col0;
#pragma unroll
                for (int bj = 0; bj < 2; ++bj) { const f32x4 v0 = acc[ai][bj][m][0], v1 = acc[ai][bj][m][1];
                    u32x4 w; w.x = cvt_pk_bf16(v0[0], v0[1]); w.y = cvt_pk_bf16(v0[2], v0[3]); w.z = cvt_pk_bf16(v1[0], v1[1]); w.w = cvt_pk_bf16(v1[2], v1[3]);
                    *(u32x4*)(rowp + bj * HALF) = w; } }
    } };
struct EpiGateUp { static constexpr bool PERM = true, ACC_INIT = false, SIGNAL = false; bf16* H;
    __device__ __forceinline__ void operator()(const f32x4 (&acc)[2][2][4][2], const Unit& u, int wr, int wc, int, int) const {
        const int t2 = lane_now(), fr = t2 & 15, fq = t2 >> 4;
        const int row0 = u.pm * BM + wr * 64 + fr, col0 = u.pn * HALF + wc * 32 + 8 * fq;
#pragma unroll
        for (int ai = 0; ai < 2; ++ai)
#pragma unroll
            for (int m = 0; m < 4; ++m) { bf16* rowp = H + (size_t)(row0 + ai * HALF + m * 16) * DE + col0; float v[8];
#pragma unroll
                for (int n = 0; n < 2; ++n)
#pragma unroll
                    for (int j = 0; j < 4; ++j) v[4 * n + j] = silu_(acc[ai][0][m][n][j]) * acc[ai][1][m][n][j];
                u32x4 w; w.x = cvt_pk_bf16(v[0], v[1]); w.y = cvt_pk_bf16(v[2], v[3]); w.z = cvt_pk_bf16(v[4], v[5]); w.w = cvt_pk_bf16(v[6], v[7]);
                *(u32x4*)rowp = w; }
    } };
struct EpiGateUpPub { static constexpr bool PERM = true, ACC_INIT = false, SIGNAL = true; __amdgpu_buffer_rsrc_t rs; unsigned* done;
    __device__ __forceinline__ void operator()(const f32x4 (&acc)[2][2][4][2], const Unit& u, int wr, int wc, int fr, int fq) const {
        asm volatile("" : "+v"(fr), "+v"(fq));
        const int row0 = u.pm * BM + wr * 64 + fr, col0 = u.pn * HALF + wc * 32 + 8 * fq;
#pragma unroll
        for (int ai = 0; ai < 2; ++ai)
#pragma unroll
            for (int m = 0; m < 4; ++m) { const unsigned off = (unsigned)(((row0 + ai * HALF + m * 16) * DE + col0) * 2); float v[8];
#pragma unroll
                for (int n = 0; n < 2; ++n)
#pragma unroll
                    for (int j = 0; j < 4; ++j) v[4 * n + j] = silu_(acc[ai][0][m][n][j]) * acc[ai][1][m][n][j];
                u32x4 w; w.x = cvt_pk_bf16(v[0], v[1]); w.y = cvt_pk_bf16(v[2], v[3]); w.z = cvt_pk_bf16(v[4], v[5]); w.w = cvt_pk_bf16(v[6], v[7]);
                __builtin_amdgcn_raw_buffer_store_b128(w, rs, off, 0, 16); }
    }
    __device__ __forceinline__ void signal(const Unit& u) const { (void)ag_add(done + u.pm, 1u); }
};
struct EpiPG { static constexpr bool PERM = true, ACC_INIT = false, SIGNAL = false; bf16* h; const bf16* hin; const float* rstd_h; const bf16* PE; const float* rstd_pe; const float* norm_pe; LAS float* red; float* part;
    __device__ __forceinline__ void operator()(const f32x4 (&acc)[2][2][4][2], const Unit& u, int wr, int wc, int, int) const {
        const int t2 = lane_now(), fr = t2 & 15, fq = t2 >> 4;
        const int row0 = u.pm * BM + wr * 64 + fr, col0 = u.pn * BM + wc * 32 + 8 * fq;
        f32x4 nv[2][2];
#pragma unroll
        for (int bj = 0; bj < 2; ++bj)
#pragma unroll
            for (int n = 0; n < 2; ++n) nv[bj][n] = *(const f32x4*)(norm_pe + col0 + bj * HALF + 4 * n);
        float sq[2][4];
#pragma unroll
        for (int ai = 0; ai < 2; ++ai)
#pragma unroll
        for (int mh = 0; mh < 2; ++mh) {
            u32x4 pe[4][2], hx[4][2]; float rs[4], rh[4];
#pragma unroll
            for (int m = 2 * mh; m < 2 * mh + 2; ++m) { const int row = row0 + ai * HALF + m * 16; rs[m] = rstd_pe[row]; rh[m] = rstd_h[row];
#pragma unroll
                for (int bj = 0; bj < 2; ++bj) { const size_t o = (size_t)row * D + col0 + bj * HALF; pe[m][bj] = *(const u32x4*)(PE + o); hx[m][bj] = *(const u32x4*)(hin + o); } }
#pragma unroll
            for (int m = 2 * mh; m < 2 * mh + 2; ++m) { const int row = row0 + ai * HALF + m * 16; float q = 0.f;
#pragma unroll
                for (int bj = 0; bj < 2; ++bj) { const size_t o = (size_t)row * D + col0 + bj * HALF; const u32x4 p = pe[m][bj], x = hx[m][bj];
                    f32x4 h0 = (f32x4){bflo(x.x), bfhi(x.x), bflo(x.y), bfhi(x.y)}, h1 = (f32x4){bflo(x.z), bfhi(x.z), bflo(x.w), bfhi(x.w)}; const f32x4 a0 = acc[ai][bj][m][0] * rh[m], a1 = acc[ai][bj][m][1] * rh[m];
                    const f32x4 e0 = (f32x4){bflo(p.x), bfhi(p.x), bflo(p.y), bfhi(p.y)} * rs[m] * nv[bj][0], e1 = (f32x4){bflo(p.z), bfhi(p.z), bflo(p.w), bfhi(p.w)} * rs[m] * nv[bj][1];
                    h0 += (f32x4){sigmoid_(a0[0]), sigmoid_(a0[1]), sigmoid_(a0[2]), sigmoid_(a0[3])} * e0; h1 += (f32x4){sigmoid_(a1[0]), sigmoid_(a1[1]), sigmoid_(a1[2]), sigmoid_(a1[3])} * e1;
                    u32x4 w; w.x = pk2(h0[0], h0[1]); w.y = pk2(h0[2], h0[3]); w.z = pk2(h1[0], h1[1]); w.w = pk2(h1[2], h1[3]); *(u32x4*)(h + o) = w;
                    q += (bflo(w.x) * bflo(w.x) + bfhi(w.x) * bfhi(w.x)) + (bflo(w.y) * bflo(w.y) + bfhi(w.y) * bfhi(w.y)) + (bflo(w.z) * bflo(w.z) + bfhi(w.z) * bfhi(w.z)) + (bflo(w.w) * bflo(w.w) + bfhi(w.w) * bfhi(w.w)); }
                sq[ai][m] = q; } }
#pragma unroll
        for (int ai = 0; ai < 2; ++ai)
#pragma unroll
            for (int m = 0; m < 4; ++m) { float q = sq[ai][m]; q += shx<16>(q); q += __int_as_float(__builtin_amdgcn_ds_bpermute((t2 ^ 32) << 2, __float_as_int(q)));
                if (fq == 0) red[wc * 256 + ai * HALF + wr * 64 + m * 16 + fr] = q; }
        asm volatile("s_waitcnt lgkmcnt(0)" ::: "memory");
        __builtin_amdgcn_s_barrier();
        { const int tt = (wr * 4 + wc) * 64 + t2; if (tt < 256) part[(size_t)u.pn * T + u.pm * BM + tt] = (red[tt] + red[256 + tt]) + (red[512 + tt] + red[768 + tt]); }
    } };

template <class Epi, class Sched>
__device__ __forceinline__ void gemm_phase(int wave, LAS unsigned char* lds, int K, const Sched& S, const Epi& E) {
    int wid = wave; asm volatile("" : "+s"(wid));
    const int lane = lane_now(), tid = (wid << 6) | lane, wr = wid >> 2, wc = wid & 3, fr = lane & 15, fq = lane >> 4;
    const int nt = K / BK;
    unsigned voffA[2], voffB[2];
#pragma unroll
    for (int i = 0; i < 2; ++i) { int R, C; stage_rc(tid * 16 + i * 8192, R, C); const int Rb = Epi::PERM ? ((R & ~31) + perm32(R & 31)) : R;
        voffA[i] = (unsigned)(R * K + C) * 2u; voffB[i] = (unsigned)(Rb * K + C) * 2u; }
    const size_t kstep = (size_t)(BK * 2);
    const size_t hstep = (size_t)HALF * K * 2;
    const unsigned ldsw = (unsigned)wid * 1024u;
    const int aoff = lds_byte(wr * 64 + fr, fq * 8), boff = lds_byte(wc * 32 + fr, fq * 8);
#define PG8_SA(b, h) (((b) * 2 + (h)) * HTB)
#define PG8_SB(b, h) ((4 + (b) * 2 + (h)) * HTB)
#define PG8_STAGE(bufoff, gbase, voff) do { _Pragma("unroll") for (int _i = 0; _i < 2; ++_i) \
        __builtin_amdgcn_global_load_lds((const unsigned*)((const char*)(gbase) + (voff)[_i]), (LAS unsigned*)(lds + (bufoff) + ldsw + _i * 8192), 16, 0, 0); } while (0)
#define PG8_LDA(dst, b, h) do { _Pragma("unroll") for (int m = 0; m < 4; ++m) _Pragma("unroll") for (int k = 0; k < 2; ++k) dst[m][k] = *(const LAS bf16x8*)(lds + PG8_SA(b, h) + aoff + m * 2048 + k * 1024); } while (0)
#define PG8_LDB(dst, b, h) do { _Pragma("unroll") for (int n = 0; n < 2; ++n) _Pragma("unroll") for (int k = 0; k < 2; ++k) dst[n][k] = *(const LAS bf16x8*)(lds + PG8_SB(b, h) + boff + n * 2048 + k * 1024); } while (0)
#define PG8_MMA(ai, bj, At, Bt) do { __builtin_amdgcn_s_setprio(1); _Pragma("unroll") for (int m = 0; m < 4; ++m) _Pragma("unroll") for (int n = 0; n < 2; ++n) _Pragma("unroll") for (int k = 0; k < 2; ++k) \
        acc[ai][bj][m][n] = __builtin_amdgcn_mfma_f32_16x16x32_bf16(Bt[n][k], At[m][k], acc[ai][bj][m][n], 0, 0, 0); __builtin_amdgcn_s_setprio(0); } while (0)
#define PG8_WAIT_V(n) asm volatile("s_waitcnt vmcnt(" #n ")" ::: "memory")
#define PG8_WAIT_L(n) asm volatile("s_waitcnt lgkmcnt(" #n ")" ::: "memory")
#define PG8_BAR __builtin_amdgcn_s_barrier()
#define PG8_SCHED __builtin_amdgcn_sched_barrier(0)
    Unit cur, nxt; int ui = 0;
    if (!S.next(0, cur)) return;
    if constexpr (Sched::DEPS) { S.wait(cur, wid); PG8_BAR; }
    f32x4 acc[2][2][4][2];
    if constexpr (Epi::ACC_INIT) E.init(acc, cur, wr, wc, fr, fq);
    else {
#pragma unroll
    for (int a = 0; a < 2; ++a)
#pragma unroll
        for (int b = 0; b < 2; ++b)
#pragma unroll
            for (int m = 0; m < 4; ++m)
#pragma unroll
                for (int n = 0; n < 2; ++n) acc[a][b][m][n] = (f32x4){0.f, 0.f, 0.f, 0.f}; }
    bf16x8 At[4][2], B0[2][2], B1[2][2];
    const char* cA = cur.A; const char* cB = cur.B;
    PG8_STAGE(PG8_SB(0, 0), cB, voffB); PG8_STAGE(PG8_SB(0, 1), cB + hstep, voffB); PG8_STAGE(PG8_SA(0, 0), cA, voffA); PG8_STAGE(PG8_SA(0, 1), cA + hstep, voffA);
    if (wr == 1) PG8_BAR;
    PG8_WAIT_V(2); PG8_BAR;
    PG8_STAGE(PG8_SB(1, 0), cB + kstep, voffB); PG8_STAGE(PG8_SA(1, 0), cA + kstep, voffA); PG8_STAGE(PG8_SB(1, 1), cB + hstep + kstep, voffB);
    PG8_WAIT_V(6); PG8_BAR;
    for (;;) {
        const bool has_next = S.next(ui + 1, nxt);
        const char* nA = has_next ? nxt.A : cA; const char* nB = has_next ? nxt.B : cB;
#pragma nounroll
        for (int t = 0; t < nt; t += 2) {
            const bool last = (t == nt - 2);
            if constexpr (Sched::DEPS) { if (last && has_next) S.wait(nxt, wid); }
            const char* a1 = cA + (size_t)(t + 1) * kstep;
            const char* a2 = last ? nA : cA + (size_t)(t + 2) * kstep; const char* b2 = last ? nB : cB + (size_t)(t + 2) * kstep;
            const char* a3 = a2 + kstep; const char* b3 = b2 + kstep;
            PG8_LDB(B0, 0, 0); PG8_LDB(B1, 0, 1); PG8_SCHED; PG8_LDA(At, 0, 0); PG8_STAGE(PG8_SA(1, 1), a1 + hstep, voffA);
            PG8_WAIT_V(8); PG8_WAIT_L(0); PG8_BAR; PG8_MMA(0, 0, At, B0); PG8_MMA(0, 1, At, B1); PG8_BAR; PG8_SCHED;
            PG8_LDA(At, 0, 1); PG8_STAGE(PG8_SB(0, 0), b2, voffB); PG8_STAGE(PG8_SB(0, 1), b2 + hstep, voffB); PG8_STAGE(PG8_SA(0, 0), a2, voffA);
            PG8_WAIT_V(8); PG8_WAIT_L(0); PG8_BAR; PG8_MMA(1, 0, At, B0); PG8_MMA(1, 1, At, B1); PG8_BAR; PG8_SCHED;
            PG8_LDB(B0, 1, 0); PG8_LDB(B1, 1, 1); PG8_SCHED; PG8_LDA(At, 1, 0); PG8_STAGE(PG8_SA(0, 1), a2 + hstep, voffA);
            PG8_WAIT_V(8); PG8_WAIT_L(0); PG8_BAR; PG8_MMA(0, 0, At, B0); PG8_MMA(0, 1, At, B1); PG8_BAR; PG8_SCHED;
            PG8_LDA(At, 1, 1); PG8_STAGE(PG8_SB(1, 0), b3, voffB); PG8_STAGE(PG8_SB(1, 1), b3 + hstep, voffB); PG8_STAGE(PG8_SA(1, 0), a3, voffA);
            PG8_WAIT_V(8); PG8_WAIT_L(0); PG8_BAR; PG8_MMA(1, 0, At, B0); PG8_MMA(1, 1, At, B1); PG8_BAR; PG8_SCHED;
        }
        if (wr == 0) PG8_BAR;
        E(acc, cur, wr, wc, fr, fq);
        if constexpr (Epi::SIGNAL) { PG8_WAIT_V(0); PG8_BAR; if (tid == 0) E.signal(cur); }
        if (!has_next) break;
        if constexpr (Epi::ACC_INIT) E.init(acc, nxt, wr, wc, fr, fq);
        else {
#pragma unroll
        for (int a = 0; a < 2; ++a)
#pragma unroll
            for (int b = 0; b < 2; ++b)
#pragma unroll
                for (int m = 0; m < 4; ++m)
#pragma unroll
                    for (int n = 0; n < 2; ++n) acc[a][b][m][n] = (f32x4){0.f, 0.f, 0.f, 0.f}; }
        cur = nxt; cA = nA; cB = nB; ++ui;
        if (wr == 1) PG8_BAR;
    }
    PG8_WAIT_V(0);
    PG8_BAR;
#undef PG8_SA
#undef PG8_SB
#undef PG8_STAGE
#undef PG8_LDA
#undef PG8_LDB
#undef PG8_MMA
#undef PG8_WAIT_V
#undef PG8_WAIT_L
#undef PG8_BAR
#undef PG8_SCHED
}
}

__device__ __forceinline__ void phase_gemm_pe(const Frame& F) {
    pg8::DenseOrder S; S.init(F.ws + WS_PB, F.ws + WS_WPE, T, D, PD, DEPTH, F.G, F.blk); pg8::EpiBf16 E{(bf16*)(F.ws + WS_PE), D};
    pg8::gemm_phase(F.wave, F.lds, PD, S, E);
}
__device__ __forceinline__ void phase_gemm_in(const Frame& F, int l) {
    pg8::DenseOrder S; S.init(F.ws + WS_H, (bf16*)(F.ws + WS_WIN) + (size_t)l * DIN * D, T, DIN, D, 1, F.G, F.blk); pg8::EpiBf16Rs E{(bf16*)(F.ws + WS_Z), DIN, (const float*)(F.ws + MS_RSTD1), l > 0 ? (const float*)(F.ws + MS_PART) : (const float*)nullptr};
    pg8::gemm_phase(F.wave, F.lds, D, S, E);
}
__device__ __forceinline__ void phase_gemm_out(const Frame& F, int l) {
    pg8::DenseOrder S; S.init(F.ws + WS_O, (bf16*)(F.ws + WS_WOUT) + (size_t)l * D * D, T, D, D, 1, F.G, F.blk); pg8::EpiResid E{(bf16*)(F.ws + WS_H)};
    pg8::gemm_phase(F.wave, F.lds, D, S, E);
}
__device__ __forceinline__ void phase_gemm_moe1(const Frame& F, int l) {
    pg8::MoeOrder S; S.init(F.ws + WS_XB, (bf16*)(F.ws + WS_WGU) + (size_t)l * NE * 1024 * 1024, (const int*)(F.ws + MS_BLKE) + l * 256, D, 4, (size_t)1024 * 1024 * 2, F.G, F.blk); pg8::EpiGateUp E{(bf16*)(F.ws + WS_HB)};
    pg8::gemm_phase(F.wave, F.lds, D, S, E);
    { const int nun = S.nrb * 4, rem = nun % F.G, few = (rem == 0 || F.G - rem < 64), idle = few ? F.G : F.G - rem, first = few ? 0 : rem;
      if (F.blk >= first) { pg8::DenseOrder P; P.init((const bf16*)(F.ws + WS_PB) + (size_t)l * T * PD, (const bf16*)(F.ws + WS_WPE) + (size_t)l * D * PD, T, D, PD, 1, idle, F.blk - first);
          pg8::EpiBf16 EP{(bf16*)(F.ws + WS_PE) + (size_t)l * T * D, D}; pg8::gemm_phase(F.wave, F.lds, PD, P, EP); }
      conv_deferred(F, l + 1, 0, NDEF1, first, idle); }
}
__device__ __forceinline__ void phase_gemm_moe2(const Frame& F, int l) {
    pg8::MoeOrder S; S.init(F.ws + WS_HB, (bf16*)(F.ws + WS_WD) + (size_t)l * NE * D * DE, (const int*)(F.ws + MS_BLKE) + l * 256, DE, 4, (size_t)D * DE * 2, F.G, F.blk); pg8::EpiBf16 E{(bf16*)(F.ws + WS_Y), D};
    pg8::gemm_phase(F.wave, F.lds, DE, S, E);
    { const int nun = S.nrb * 4, rem = nun % F.G, few = (rem == 0 || F.G - rem < 64), idle = few ? F.G : F.G - rem, first = few ? 0 : rem;
      conv_deferred(F, l + 1, NDEF1, NDEF, first, idle); }
}
#ifndef MOE_CPE
#define MOE_CPE 5
#endif
#ifndef MOE_CTL
#define MOE_CTL 4
#endif
#ifndef MOE_X1
#define MOE_X1 16
#define MOE_X2 8
#endif
template <int MODE = 0> __device__ __forceinline__ void phase_moe_fused(const Frame& F, int l) {
    unsigned char* ws = F.ws; const int G = F.G, blk = (MOE_VBLK && F.G == 256) ? vblk(F.blk) : F.blk;
    const int* blke = (const int*)(ws + MS_BLKE) + l * 256;
    unsigned* done = (unsigned*)(ws + WS_CTL) + CW_DONE + l * 256;
    const int nrb = __builtin_amdgcn_readfirstlane(blke[255]), nu = 4 * nrb, e1 = nu % G;
    if constexpr (MODE == 1) { pg8::MoeOrder S; S.init(ws + WS_XB, (bf16*)(ws + WS_WGU) + (size_t)l * NE * 1024 * 1024, blke, D, 4, (size_t)1024 * 1024 * 2, G, blk);
      pg8::EpiGateUp E{(bf16*)(ws + WS_HB)}; pg8::gemm_phase(F.wave, F.lds, D, S, E); return; }
    if constexpr (MODE == 0) { pg8::MoeOrder S; S.init(ws + WS_XB, (bf16*)(ws + WS_WGU) + (size_t)l * NE * 1024 * 1024, blke, D, 4, (size_t)1024 * 1024 * 2, G, blk);
      pg8::EpiGateUpPub E{__builtin_amdgcn_make_buffer_rsrc(ws + WS_HB, 0, (int)((size_t)CAP * DE * 2), 0x00020000), done};
      pg8::gemm_phase(F.wave, F.lds, D, S, E); }
    if constexpr (MODE == 2) { pg8::MoeOrder S; S.init(ws + WS_HB, (bf16*)(ws + WS_WD) + (size_t)l * NE * D * DE, blke, DE, 4, (size_t)D * DE * 2, G, blk >= e1 ? blk - e1 : blk - e1 + G);
      pg8::EpiBf16 E{(bf16*)(ws + WS_Y), D}; pg8::gemm_phase(F.wave, F.lds, DE, S, E); }
    if constexpr (MODE == 0) { pg8::MoeDepOrder S; S.init(ws + WS_HB, (bf16*)(ws + WS_WD) + (size_t)l * NE * D * DE, blke, done, DE, 4, (size_t)D * DE * 2, G, blk >= e1 ? blk - e1 : blk - e1 + G);
      pg8::EpiBf16 E{(bf16*)(ws + WS_Y), D};
      pg8::gemm_phase(F.wave, F.lds, DE, S, E); }
    { const int nt = (l + 1 < DEPTH) ? NDEF : 0, ftot = 256 * MOE_CPE + nt * MOE_CTL;
      const int wrap = 2 * e1 > G ? 2 * e1 - G : 0;
      auto cls = [&](int x, int& c24, int& c16, int& c8, int& c0) {
          const int cA = x < e1 ? x : e1, cAB = x < wrap ? x : wrap;
          int cB = x - e1; cB = cB < 0 ? 0 : cB; if (!wrap) cB = cB > e1 ? e1 : cB; cB += cAB;
          c24 = cAB; c16 = cA - cAB; c8 = cB - cAB; c0 = x - c24 - c16 - c8; };
      auto fill = [&](int x, int lv) { int c24, c16, c8, c0; cls(x, c24, c16, c8, c0);
          return c0 * lv + c8 * (lv > MOE_X2 ? lv - MOE_X2 : 0) + c16 * (lv > MOE_X1 ? lv - MOE_X1 : 0) + c24 * (lv > MOE_X1 + MOE_X2 ? lv - MOE_X1 - MOE_X2 : 0); };
      int lv = 1; while (fill(G, lv) < ftot) ++lv;
      const int B0 = fill(blk, lv), B1 = fill(blk + 1, lv);
      const int pe_tot = 256 * MOE_CPE;
      int j0 = (B0 + MOE_CPE - 1) / MOE_CPE, j1 = (B1 + MOE_CPE - 1) / MOE_CPE; j0 = j0 < 256 ? j0 : 256; j1 = j1 < 256 ? j1 : 256;
      int t0 = B0 > pe_tot ? (B0 - pe_tot + MOE_CTL - 1) / MOE_CTL : 0, t1 = B1 > pe_tot ? (B1 - pe_tot + MOE_CTL - 1) / MOE_CTL : 0; t0 = t0 < nt ? t0 : nt; t1 = t1 < nt ? t1 : nt;
      if (j1 > j0) { pg8::RangeOrder P; P.init((const bf16*)(ws + WS_PB) + (size_t)l * T * PD, (const bf16*)(ws + WS_WPE) + (size_t)l * D * PD, T, D, PD, j0, j1 - j0);
          pg8::EpiBf16 EP{(bf16*)(ws + WS_PE) + (size_t)l * T * D, D}; pg8::gemm_phase(F.wave, F.lds, PD, P, EP); }
      if (t1 > t0) { const int base = (l + 1) * TL_LAYER + t0; conv_run(F, 0, 1, t1 - t0, [=](int f) { return base + f; }); } }
}
__device__ __forceinline__ void phase_gemm_pg(const Frame& F, int l) {
    pg8::DenseOrder S; S.init(F.ws + WS_XN, (bf16*)(F.ws + WS_WPG) + (size_t)l * D * D, T, D, D, 1, F.G, F.blk);
    pg8::EpiPG E{(bf16*)(F.ws + WS_H), (const bf16*)(F.ws + WS_XN), (const float*)(F.ws + MS_RSTD3), (const bf16*)(F.ws + WS_PE) + (size_t)l * T * D, (const float*)(F.ws + MS_RSTDPE), F.in[22] + l * D, (LAS float*)(F.lds + MISC_OFF + 4096), (float*)(F.ws + MS_PART)};
    pg8::gemm_phase(F.wave, F.lds, D, S, E);
}

typedef short s16x4 __attribute__((ext_vector_type(4)));
__device__ __forceinline__ bf16x8 tr_frag(LAS unsigned char* p_lo, LAS unsigned char* p_hi) {
    const s16x4 lo = __builtin_amdgcn_ds_read_tr16_b64_v4i16((LAS s16x4*)p_lo), hi = __builtin_amdgcn_ds_read_tr16_b64_v4i16((LAS s16x4*)p_hi);
    return __builtin_shufflevector(lo, hi, 0, 1, 2, 3, 4, 5, 6, 7); }
#define MFMA16(a, b, c) __builtin_amdgcn_mfma_f32_16x16x32_bf16((a), (b), (c), 0, 0, 0)
constexpr int RP = 272;
constexpr int VP = 1040;

__device__ __forceinline__ void phase_rec_c1(const Frame& F, int l) {
    PH_TID();
    unsigned char* ws = F.ws; const bf16* Z = (const bf16*)(ws + WS_Z);
    bf16* UT = (bf16*)(ws + WS_UT); float* DC = (float*)(ws + MS_DC); float* MM = (float*)(ws + MS_MM);
    const float* lb = (const float*)(ws + MS_LB) + l * DREC;
    LAS unsigned char* KD = F.lds; LAS unsigned char* IM = F.lds + 128 * RP; LAS float* totx = (LAS float*)(F.lds + 256 * RP);
    const int wave = ph_wave, ch = tid & 255, half = tid >> 8, hl = ch >> 7, k = ch & 127, g = lane >> 4, li = lane & 15, q = li >> 2, p = li & 3;
    const int hG = F.G / 2, nmine = (F.G == 256) ? (F.blk < hG ? 4 : 0) : (F.blk < 512 ? (512 - F.blk + F.G - 1) / F.G : 0);
    const int ustep = (F.G == 256) ? hG : F.G;
    u32x4 pf[4], pi[4];
    auto fetch = [&](int unit) { const int c = unit >> 1, hp = unit & 1;
#pragma unroll
        for (int j = 0; j < 4; ++j) { const int idx = tid + 512 * j, hl2 = idx >> 10, row = (idx >> 4) & 63, cc = idx & 15;
            const bf16* src = Z + (size_t)(c * 64 + row) * DIN + 512 + (2 * hp + hl2) * 128 + cc * 8; pf[j] = *(const u32x4*)src; pi[j] = *(const u32x4*)(src + 512); } };
    if (nmine > 0) fetch(F.blk);
    for (int ui = 0; ui < nmine; ++ui) {
        const int unit = F.blk + ui * ustep;
        const int c = unit >> 1, hp = unit & 1, hh = 2 * hp + hl;
#pragma unroll
        for (int j = 0; j < 4; ++j) { const int idx = tid + 512 * j, hl2 = idx >> 10, row = (idx >> 4) & 63, cc = idx & 15; const int dst = (hl2 * 64 + row) * RP + cc * 16;
            *(LAS u32x4*)(KD + dst) = pf[j]; *(LAS u32x4*)(IM + dst) = pi[j]; }
        __syncthreads();
        if (ui + 1 < nmine) fetch(unit + ustep);
        const float lbk = lb[hh * 128 + k];
        float cs[32], kk[32]; float run = 1.f;
#pragma unroll
        for (int t = 0; t < 32; ++t) { const float fz = bf2f(*(const LAS bf16*)(KD + (hl * 64 + 32 * half + t) * RP + 2 * k)); const float sg = sigmoid_(fz); run *= lbk + (1.f - lbk) * sg; cs[t] = run; kk[t] = (1.f - lbk) * (1.f - sg); }
        totx[half * 256 + ch] = run;
        __syncthreads();
        const float other = totx[(1 - half) * 256 + ch]; const float p63 = run * other; const float base_p = half == 0 ? p63 : run;
#pragma unroll
        for (int t = 0; t < 32; ++t) *(LAS bf16*)(KD + (hl * 64 + 32 * half + t) * RP + 2 * k) = (bf16)f2bf(kk[t] * base_p * frcp(fmaxf(cs[t], 1e-30f)));
        if (half == 0) { DC[(c * 4 + hh) * 128 + k] = p63; MM[(c * 4 + hh) * 128 + k] = run; }
        __syncthreads();
        { const int whl = wave >> 2, kt0 = 2 * (wave & 3), whh = 2 * hp + whl;
          f32x4 acc[2][8];
#pragma unroll
          for (int i = 0; i < 2; ++i)
#pragma unroll
              for (int vt = 0; vt < 8; ++vt) acc[i][vt] = (f32x4){0.f, 0.f, 0.f, 0.f};
          LAS unsigned char* kdb = KD + whl * 64 * RP; LAS unsigned char* imb = IM + whl * 64 * RP;
#pragma unroll
          for (int a = 0; a < 2; ++a) { const unsigned ro = (unsigned)((32 * a + 8 * g + q) * RP);
              bf16x8 Af[2];
#pragma unroll
              for (int i = 0; i < 2; ++i) { const unsigned co = (unsigned)((16 * (kt0 + i) + 4 * p) * 2); Af[i] = tr_frag(kdb + ro + co, kdb + ro + 4 * RP + co); }
#pragma unroll
              for (int vt = 0; vt < 8; ++vt) { const unsigned co = (unsigned)((16 * vt + 4 * p) * 2); const bf16x8 Bf = tr_frag(imb + ro + co, imb + ro + 4 * RP + co);
#pragma unroll
                  for (int i = 0; i < 2; ++i) acc[i][vt] = MFMA16(Af[i], Bf, acc[i][vt]); } }
#pragma unroll
          for (int i = 0; i < 2; ++i)
#pragma unroll
              for (int vt = 0; vt < 8; ++vt) { u32x2 w; w.x = pg8::cvt_pk_bf16(acc[i][vt][0], acc[i][vt][1]); w.y = pg8::cvt_pk_bf16(acc[i][vt][2], acc[i][vt][3]);
                  *(u32x2*)(UT + ((size_t)(c * 4 + whh) * 128 + 16 * vt + li) * 128 + 16 * (kt0 + i) + 4 * g) = w; } }
        __syncthreads();
    }
}
__device__ __forceinline__ void phase_rec_c2a(const Frame& F) {
    PH_TID();
    unsigned char* ws = F.ws; const unsigned* UT = (const unsigned*)(ws + WS_UT); const float* DC = (const float*)(ws + MS_DC);
    f32x2* LT = (f32x2*)(ws + WS_LTOT); float* PT = (float*)(ws + MS_PTOT);
    for (int it = F.blk * NTHR + tid; it < 16 * 32768; it += F.G * NTHR) {
        const int gs = it >> 15, e = it & 32767, hh = e >> 13, v = (e >> 6) & 127, k0 = 2 * (e & 63);
        float S0 = 0.f, S1 = 0.f, P0 = 1.f, P1 = 1.f;
#pragma unroll
        for (int cc = 0; cc < 16; ++cc) { const int c = 16 * gs + cc; const unsigned u = UT[(size_t)c * 32768 + e]; const f32x2 d = *(const f32x2*)(DC + (c * 4 + hh) * 128 + k0);
            S0 = d.x * S0 + bflo(u); S1 = d.y * S1 + bfhi(u); P0 *= d.x; P1 *= d.y; }
        LT[it] = (f32x2){S0, S1};
        if (v == 0) *(f32x2*)(PT + (gs * 4 + hh) * 128 + k0) = (f32x2){P0, P1};
    }
}
__device__ __forceinline__ void phase_rec_c2c(const Frame& F) {
    PH_TID();
    unsigned char* ws = F.ws; const unsigned* UT = (const unsigned*)(ws + WS_UT); unsigned* ST = (unsigned*)(ws + WS_ST); const float* DC = (const float*)(ws + MS_DC); const float* MM = (const float*)(ws + MS_MM);
    const f32x2* LT = (const f32x2*)(ws + WS_LTOT); const float* PT = (const float*)(ws + MS_PTOT);
    for (int it = F.blk * NTHR + tid; it < 16 * 32768; it += F.G * NTHR) {
        const int gs = it >> 15, e = it & 32767, hh = e >> 13, k0 = 2 * (e & 63);
        float C0 = 0.f, C1 = 0.f;
        for (int g2 = 0; g2 < gs; ++g2) { const f32x2 pt = *(const f32x2*)(PT + (g2 * 4 + hh) * 128 + k0); const f32x2 lt = LT[g2 * 32768 + e]; C0 = pt.x * C0 + lt.x; C1 = pt.y * C1 + lt.y; }
#pragma unroll
        for (int cc = 0; cc < 16; ++cc) { const int c = 16 * gs + cc; const f32x2 mm = *(const f32x2*)(MM + (c * 4 + hh) * 128 + k0);
            ST[(size_t)c * 32768 + e] = pk2(C0 * mm.x, C1 * mm.y);
            const unsigned u = UT[(size_t)c * 32768 + e]; const f32x2 d = *(const f32x2*)(DC + (c * 4 + hh) * 128 + k0);
            C0 = d.x * C0 + bflo(u); C1 = d.y * C1 + bfhi(u); }
    }
}
__device__ __forceinline__ void phase_rec_c2(const Frame& F) {
    PH_TID();
    unsigned char* ws = F.ws; const int w = ph_wave;
    LAS float* tot = (LAS float*)F.lds;
    for (int unit = F.blk; unit < 256; unit += F.G) {
        const int hh = unit >> 6; const unsigned eo = (unsigned)(unit * 128 + lane), ko = (unsigned)(hh * 128 + 2 * lane);
        const unsigned* ut = (const unsigned*)(ws + WS_UT) + (size_t)(32 * w) * 32768; unsigned* st = (unsigned*)(ws + WS_ST) + (size_t)(32 * w) * 32768;
        const float* dc = (const float*)(ws + MS_DC) + (32 * w) * 512; const float* mmp = (const float*)(ws + MS_MM) + (32 * w) * 512;
        asm volatile("" : "+s"(ut), "+s"(st), "+s"(dc), "+s"(mmp));
        unsigned ua[32], ub[32]; f32x2 d[32], m0[16], m1[16];
#pragma unroll
        for (int cc = 0; cc < 32; ++cc) { ua[cc] = (ut + cc * 32768)[eo]; ub[cc] = (ut + cc * 32768 + 64)[eo]; d[cc] = *(const f32x2*)((dc + cc * 512) + ko); }
        __builtin_amdgcn_sched_barrier(0);
        float a0 = 0.f, a1 = 0.f, b0 = 0.f, b1 = 0.f, p0 = 1.f, p1 = 1.f;
#pragma unroll
        for (int cc = 0; cc < 32; ++cc) { a0 = d[cc].x * a0 + bflo(ua[cc]); a1 = d[cc].y * a1 + bfhi(ua[cc]); b0 = d[cc].x * b0 + bflo(ub[cc]); b1 = d[cc].y * b1 + bfhi(ub[cc]); p0 *= d[cc].x; p1 *= d[cc].y; }
        { LAS float* tw = tot + w * 384 + lane; tw[0] = a0; tw[64] = a1; tw[128] = b0; tw[192] = b1; tw[256] = p0; tw[320] = p1; }
        __builtin_amdgcn_sched_barrier(0);
#pragma unroll
        for (int cc = 0; cc < 16; ++cc) m0[cc] = *(const f32x2*)((mmp + cc * 512) + ko);
        __builtin_amdgcn_sched_barrier(0);
        __syncthreads();
        float A0 = 0.f, A1 = 0.f, B0 = 0.f, B1 = 0.f;
        for (int g2 = 0; g2 < w; ++g2) { const LAS float* tw = tot + g2 * 384 + lane; const float q0 = tw[256], q1 = tw[320]; A0 = q0 * A0 + tw[0]; A1 = q1 * A1 + tw[64]; B0 = q0 * B0 + tw[128]; B1 = q1 * B1 + tw[192]; }
        __builtin_amdgcn_sched_barrier(0);
#pragma unroll
        for (int cc = 0; cc < 16; ++cc) m1[cc] = *(const f32x2*)((mmp + (16 + cc) * 512) + ko);
        __builtin_amdgcn_sched_barrier(0);
#pragma unroll
        for (int cc = 0; cc < 32; ++cc) { const f32x2 mm = cc < 16 ? m0[cc & 15] : m1[cc & 15];
            (st + cc * 32768)[eo] = pk2(A0 * mm.x, A1 * mm.y); (st + cc * 32768 + 64)[eo] = pk2(B0 * mm.x, B1 * mm.y);
            unsigned xa = ua[cc], xb = ub[cc]; asm volatile("" : "+v"(xa), "+v"(xb));
            A0 = d[cc].x * A0 + bflo(xa); A1 = d[cc].y * A1 + bfhi(xa); B0 = d[cc].x * B0 + bflo(xb); B1 = d[cc].y * B1 + bfhi(xb);
            asm volatile("" : "+v"(A0), "+v"(A1), "+v"(B0), "+v"(B1) :: "memory"); }
        __syncthreads();
    }
}
template <int PV = 0> __device__ __forceinline__ void phase_rec_c3(const Frame& F, int l) {
    PH_TID();
    unsigned char* ws = F.ws; const bf16* Z = (const bf16*)(ws + WS_Z); const bf16* ST = (const bf16*)(ws + WS_ST); bf16* O = (bf16*)(ws + WS_O);
    const float* lb = (const float*)(ws + MS_LB) + l * DREC; const float* ogain = F.in[5] + l * 128;
    LAS unsigned char* QT = F.lds; LAS unsigned char* KT = F.lds + 128 * RP; LAS unsigned char* IM = F.lds + 256 * RP;
    const int wave = ph_wave, ch = tid & 255, half = tid >> 8, hl = ch >> 7, k = ch & 127, g = lane >> 4, li = lane & 15, q = li >> 2, p = li & 3;
    u32x4 pq[4], pf[4];
    const unsigned tvo = (unsigned)((tid >> 4) * DIN + (tid & 15) * 8), tlo = (unsigned)((tid >> 4) * RP + (tid & 15) * 16);
    auto fetch = [&](int unit) { const bf16* zc = Z + (size_t)(unit >> 1) * 64 * DIN + (unit & 1) * 256;
#pragma unroll
        for (int j = 0; j < 4; ++j) { const bf16* src = zc + (32 * (j & 1)) * DIN + (j >> 1) * 128; pq[j] = *(const u32x4*)(src + tvo); pf[j] = *(const u32x4*)(src + 512 + tvo); } };
    if (F.blk < 512) fetch(F.blk);
    for (int unit = F.blk; unit < 512; unit += F.G) {
        const int c = unit >> 1, hp = unit & 1, hh = 2 * hp + hl;
#pragma unroll
        for (int j = 0; j < 4; ++j) { const int dst = ((j >> 1) * 64 + 32 * (j & 1)) * RP;
            *(LAS u32x4*)(QT + dst + tlo) = pq[j]; *(LAS u32x4*)(KT + dst + tlo) = pf[j]; }
        u32x4 vi[4];
        { const bf16* zc = Z + (size_t)c * 64 * DIN + hp * 256 + 1024;
#pragma unroll
          for (int j = 0; j < 4; ++j) vi[j] = *(const u32x4*)(zc + (32 * (j & 1)) * DIN + (j >> 1) * 128 + tvo); }
        __syncthreads();
        { const float lbk = lb[hh * 128 + k]; const int col = (hl * 64 + 32 * half) * RP + 2 * k;
          float cs[32], kk[32], qs[32]; float run = 1.f;
#pragma unroll
          for (int t = 0; t < 32; ++t) { const float fz = bf2f(*(const LAS bf16*)(KT + col + t * RP)); const float sg = sigmoid_(fz); run *= lbk + (1.f - lbk) * sg; cs[t] = run; kk[t] = (1.f - lbk) * (1.f - sg);
              qs[t] = silu_(bf2f(*(const LAS bf16*)(QT + col + t * RP))); }
          const float inv = half == 0 ? frcp(fmaxf(run, 1e-30f)) : 1.f;
#pragma unroll
          for (int t = 0; t < 32; ++t) { const float ex = cs[t] * inv; const int off = col + t * RP;
              *(LAS bf16*)(QT + off) = (bf16)f2bf(qs[t] * ex); *(LAS bf16*)(KT + off) = (bf16)f2bf(kk[t] * frcp(fmaxf(ex, 1e-30f))); } }
#pragma unroll
        for (int j = 0; j < 4; ++j) *(LAS u32x4*)(IM + ((j >> 1) * 64 + 32 * (j & 1)) * RP + tlo) = vi[j];
        const int whl = wave >> 2, tt = wave & 3, whh = 2 * hp + whl;
        bf16x8 Sf[8][4];
#pragma unroll
        for (int vt = 0; vt < 8; ++vt)
#pragma unroll
            for (int a = 0; a < 4; ++a) Sf[vt][a] = *(const bf16x8*)(ST + ((size_t)(c * 4 + whh) * 128 + 16 * vt + li) * 128 + 32 * a + 8 * g);
        __syncthreads();
        if (PV != 1) {
          bf16 gz[8][4];
#pragma unroll
          for (int vt = 0; vt < 8; ++vt)
#pragma unroll
              for (int r = 0; r < 4; ++r) gz[vt][r] = Z[((size_t)c * 64 + 16 * tt + 4 * g + r) * DIN + 1536 + whh * 128 + 16 * vt + li];
          bf16x8 Qf[4];
#pragma unroll
          for (int a = 0; a < 4; ++a) Qf[a] = *(const LAS bf16x8*)(QT + (whl * 64 + 16 * tt + li) * RP + (32 * a + 8 * g) * 2);
          unsigned pw[4][2];
#pragma unroll
          for (int st = 0; st < 4; ++st) { pw[st][0] = 0u; pw[st][1] = 0u;
              { f32x4 s = (f32x4){0.f, 0.f, 0.f, 0.f};
#pragma unroll
                  for (int a = 0; a < 4; ++a) { const bf16x8 Kf = *(const LAS bf16x8*)(KT + (whl * 64 + 16 * st + li) * RP + (32 * a + 8 * g) * 2); s = MFMA16(Kf, Qf[a], s); }
                  if (st == tt) {
#pragma unroll
                      for (int r = 0; r < 4; ++r) if (4 * g + r > li) s[r] = 0.f; }
                  pw[st][0] = st <= tt ? pg8::cvt_pk_bf16(s[0], s[1]) : 0u; pw[st][1] = st <= tt ? pg8::cvt_pk_bf16(s[2], s[3]) : 0u; } }
          f32x4 acc[8];
#pragma unroll
          for (int vt = 0; vt < 8; ++vt) { acc[vt] = (f32x4){0.f, 0.f, 0.f, 0.f};
#pragma unroll
              for (int a = 0; a < 4; ++a) acc[vt] = MFMA16(Qf[a], Sf[vt][a], acc[vt]); }
          __builtin_amdgcn_sched_barrier(0);
          if (unit + F.G < 512) fetch(unit + F.G);
          __builtin_amdgcn_sched_barrier(0);
          LAS unsigned char* imb = IM + whl * 64 * RP;
#pragma unroll
          for (int a = 0; a < 2; ++a) { const u32x4 pv = (u32x4){pw[2 * a][0], pw[2 * a][1], pw[2 * a + 1][0], pw[2 * a + 1][1]}; const bf16x8 Pf = __builtin_bit_cast(bf16x8, pv);
              const unsigned ro = (unsigned)((32 * a + 4 * g + q) * RP);
#pragma unroll
              for (int vt = 0; vt < 8; ++vt) { const unsigned co = (unsigned)((16 * vt + 4 * p) * 2); const bf16x8 If = tr_frag(imb + ro + co, imb + ro + 16 * RP + co); acc[vt] = MFMA16(Pf, If, acc[vt]); } }
          float rs[4];
#pragma unroll
          for (int r = 0; r < 4; ++r) { float ss = 0.f;
#pragma unroll
              for (int vt = 0; vt < 8; ++vt) ss += acc[vt][r] * acc[vt][r];
              ss += shx<1>(ss); ss += shx<2>(ss); ss += shx<4>(ss); ss += shx<8>(ss); rs[r] = frsq(ss * (1.f / 128.f) + EPS); }
#pragma unroll
          for (int vt = 0; vt < 8; ++vt) { const float og = ogain[16 * vt + li];
#pragma unroll
              for (int r = 0; r < 4; ++r) { const size_t t = (size_t)c * 64 + 16 * tt + 4 * g + r; const float gv = bf2f(gz[vt][r]);
                  O[t * D + whh * 128 + 16 * vt + li] = (bf16)f2bf(acc[vt][r] * rs[r] * og * silu_(gv)); } } }
        __syncthreads();
    }
}
__device__ __forceinline__ void phase_sgu(const Frame& F, int l) {
    PH_TID();
    unsigned char* ws = F.ws; const bf16* Z = (const bf16*)(ws + WS_Z); bf16* O = (bf16*)(ws + WS_O);
    const bf16* Wb = (const bf16*)(ws + MS_SGUW) + (size_t)l * 4 * 128 * 128; const float* sb = F.in[9] + l * 4 * 128;
    LAS unsigned char* VN = F.lds;
    const int wave = ph_wave, g = lane >> 4, li = lane & 15, q = li >> 2, p = li & 3;
    for (int unit = (F.blk + F.G / 2) % F.G; unit < 128; unit += F.G) {
        float lg[8], lbv[8];
#pragma unroll
        for (int j = 0; j < 8; ++j) { lg[j] = F.in[6][l * DSGU + 8 * lane + j]; lbv[j] = F.in[7][l * DSGU + 8 * lane + j]; }
        u32x4 raw[16];
#pragma unroll
        for (int i = 0; i < 16; ++i) raw[i] = *(const u32x4*)(Z + ((size_t)unit * 128 + 16 * wave + i) * DIN + 2560 + 8 * lane);
#pragma unroll
        for (int i = 0; i < 16; ++i) { const int s = 16 * wave + i; const u32x4 r = raw[i];
            float x[8] = {gelu_(bflo(r.x)), gelu_(bfhi(r.x)), gelu_(bflo(r.y)), gelu_(bfhi(r.y)), gelu_(bflo(r.z)), gelu_(bfhi(r.z)), gelu_(bflo(r.w)), gelu_(bfhi(r.w))};
            float sm = 0.f, qq = 0.f;
#pragma unroll
            for (int j = 0; j < 8; ++j) { sm += x[j]; qq += x[j] * x[j]; }
            sm += shx<1>(sm); qq += shx<1>(qq); sm += shx<2>(sm); qq += shx<2>(qq); sm += shx<4>(sm); qq += shx<4>(qq); sm += shx<8>(sm); qq += shx<8>(qq); sm += shx<16>(sm); qq += shx<16>(qq);
            const float mu = halves_sum(sm) * (1.f / 512.f); const float var = fmaxf(halves_sum(qq) * (1.f / 512.f) - mu * mu, 0.f);
            const float rstd = frsq(var + EPS);
#pragma unroll
            for (int j = 0; j < 8; ++j) x[j] = (x[j] - mu) * rstd * lg[j] + lbv[j];
            u32x4 o; o.x = pk2(x[0], x[1]); o.y = pk2(x[2], x[3]); o.z = pk2(x[4], x[5]); o.w = pk2(x[6], x[7]);
            *(LAS u32x4*)(VN + s * VP + lane * 16) = o; }
        __syncthreads();
        { const int hh = wave >> 1, dh = wave & 1; const bf16* W = Wb + (size_t)hh * 128 * 128;
          LAS unsigned char* vnb = VN;
#pragma unroll 1
          for (int dp = 0; dp < 2; ++dp) {
          bf16x8 Wf[2][8];
#pragma unroll
          for (int a = 0; a < 2; ++a)
#pragma unroll
              for (int ti = 0; ti < 8; ++ti) if (ti >= 2 * a) Wf[a][ti] = *(const bf16x8*)(W + (size_t)(16 * ti + li) * 128 + 32 * a + 8 * g);
          u32x2 uu[8][2]; float bs[8];
#pragma unroll
          for (int ti = 0; ti < 8; ++ti) { bs[ti] = sb[hh * 128 + 16 * ti + li];
#pragma unroll
              for (int dt = 0; dt < 2; ++dt) uu[ti][dt] = *(const u32x2*)(Z + ((size_t)unit * 128 + 16 * ti + li) * DIN + 2048 + hh * 128 + 64 * dh + 16 * (2 * dp + dt) + 4 * g); }
          f32x4 acc[2][8];
#pragma unroll
          for (int dt = 0; dt < 2; ++dt)
#pragma unroll
              for (int ti = 0; ti < 8; ++ti) acc[dt][ti] = (f32x4){0.f, 0.f, 0.f, 0.f};
#pragma unroll
          for (int a = 0; a < 4; ++a) { const unsigned ro = (unsigned)((32 * a + 8 * g + q) * VP);
              bf16x8 Af[2];
#pragma unroll
              for (int dt = 0; dt < 2; ++dt) { const unsigned co = (unsigned)((hh * 128 + 64 * dh + 16 * (2 * dp + dt) + 4 * p) * 2); Af[dt] = tr_frag(vnb + ro + co, vnb + ro + 4 * VP + co); }
#pragma unroll
              for (int ti = 0; ti < 8; ++ti) if (ti >= 2 * a) {
                  const bf16x8 Bf = a < 2 ? Wf[a < 2 ? a : 0][ti] : *(const bf16x8*)(W + (size_t)(16 * ti + li) * 128 + 32 * a + 8 * g);
#pragma unroll
                  for (int dt = 0; dt < 2; ++dt) acc[dt][ti] = MFMA16(Af[dt], Bf, acc[dt][ti]); } }
#pragma unroll
          for (int ti = 0; ti < 8; ++ti) { const size_t t = (size_t)unit * 128 + 16 * ti + li; const float bias = bs[ti];
#pragma unroll
              for (int dt = 0; dt < 2; ++dt) { const int col = hh * 128 + 64 * dh + 16 * (2 * dp + dt) + 4 * g; const u32x2 u = uu[ti][dt];
                  u32x2 w; w.x = pk2((acc[dt][ti][0] + bias) * gelu_(bflo(u.x)), (acc[dt][ti][1] + bias) * gelu_(bfhi(u.x))); w.y = pk2((acc[dt][ti][2] + bias) * gelu_(bflo(u.y)), (acc[dt][ti][3] + bias) * gelu_(bfhi(u.y)));
                  *(u32x2*)(O + t * D + 512 + col) = w; } } } }
        __syncthreads();
    }
}

#define XB_TMO      128
#define XB_XCNT(j)  (256  + 64 * (j))
#define XB_XSUB(j)  (1280 + 64 * (j))
#define XB_XGEN(j)  (2304 + 64 * (j))
#define XB_TOP      3328
#define XB_TOPGEN   3392
#define XCD_BAR_WORDS 3456
#define XB_SPIN_CAP (1u << 18)
__device__ __forceinline__ unsigned xb_ld(unsigned* p)              { return __hip_atomic_load(p, __ATOMIC_RELAXED, __HIP_MEMORY_SCOPE_AGENT); }
__device__ __forceinline__ unsigned xb_add(unsigned* p, unsigned v) { return __hip_atomic_fetch_add(p, v, __ATOMIC_RELAXED, __HIP_MEMORY_SCOPE_AGENT); }
__device__ __forceinline__ unsigned xb_xcc_id() { return (unsigned)__builtin_amdgcn_s_getreg((3 << 11) | 20) & 0xFu; }
#define XB_SPIN(cond, bar) do { unsigned _sp = 0; while (cond) { __builtin_amdgcn_s_sleep(1); \
    if ((++_sp & 255u) == 0u) { if (xb_ld(&(bar)[XB_TMO])) break; if (_sp > XB_SPIN_CAP) { atomicAdd(&(bar)[XB_TMO], 1u); break; } } } } while (0)
struct XcdBarrier { unsigned* bar; unsigned x; volatile LAS unsigned* st; int wave; };
__device__ __forceinline__ XcdBarrier xcd_barrier_post(unsigned* bar, volatile LAS unsigned* st, int wave) {
    XcdBarrier b; b.bar = bar; b.x = xb_xcc_id(); b.st = st; b.wave = wave;
    if (wave == 0 && lane_now() == 0) (void)xb_add(&bar[XB_XCNT(b.x)], 1u);
    return b;
}
__device__ __forceinline__ void xcd_barrier_complete(unsigned* bar, unsigned x, unsigned& nloc, unsigned& nx) {
    const unsigned G = gridDim.x * gridDim.y * gridDim.z;
    unsigned sum, cnt, mine, sp = 0u;
    for (;;) {
        sum = 0u; cnt = 0u; mine = 0u;
#pragma unroll
        for (unsigned j = 0; j < 16; ++j) { const unsigned c = xb_ld(&bar[XB_XCNT(j)]); sum += c; cnt += (c > 0u) ? 1u : 0u; mine = (j == x) ? c : mine; }
        if (sum == G) break;
        __builtin_amdgcn_s_sleep(1);
        if ((++sp & 255u) == 0u) { if (xb_ld(&bar[XB_TMO])) break; if (sp > XB_SPIN_CAP) { atomicAdd(&bar[XB_TMO], 1u); break; } }
    }
    nloc = mine > 0u ? mine : 1u; nx = cnt > 0u ? cnt : 1u;
}
__device__ __forceinline__ void xcd_barrier(const XcdBarrier& b) {
    asm volatile("s_waitcnt vmcnt(0)" ::: "memory");
    __syncthreads();
    if (b.wave == 0 && lane_now() == 0) {
        unsigned* bar = b.bar;
        __builtin_amdgcn_s_waitcnt(0);
        unsigned nloc = b.st[0], nx = b.st[1];
        if (nloc == 0u) { xcd_barrier_complete(bar, b.x, nloc, nx); b.st[0] = nloc; b.st[1] = nx; }
        const unsigned old = xb_add(&bar[XB_XSUB(b.x)], 1u);
        const unsigned gen = old / nloc;
        if (old + 1u == (gen + 1u) * nloc) {
            __builtin_amdgcn_fence(__ATOMIC_RELEASE, "agent");
            asm volatile("s_waitcnt vmcnt(0)" ::: "memory");
            const unsigned og = xb_add(&bar[XB_TOP], 1u);
            const unsigned tg = og / nx;
            if (og + 1u == (tg + 1u) * nx) xb_add(&bar[XB_TOPGEN], 1u);
            else XB_SPIN(xb_ld(&bar[XB_TOPGEN]) == tg, bar);
            __builtin_amdgcn_fence(__ATOMIC_ACQUIRE, "agent");
            xb_add(&bar[XB_XGEN(b.x)], 1u);
            asm volatile("s_waitcnt vmcnt(0)" ::: "memory");
        } else {
            XB_SPIN(xb_ld(&bar[XB_XGEN(b.x)]) == gen, bar);
            __builtin_amdgcn_fence(__ATOMIC_ACQUIRE, "agent");
            asm volatile("s_waitcnt vmcnt(0)" ::: "memory");
        }
    }
    __syncthreads();
}


__device__ __forceinline__ void xcd_barrier_bg(const XcdBarrier& b, const Frame& F, int lnext, bool drain) {
    asm volatile("s_waitcnt vmcnt(0)" ::: "memory");
    __syncthreads();
    volatile LAS unsigned* sx = b.st + 4;
    unsigned* q = (unsigned*)(F.ws + WS_CTL) + CW_BGQ + lnext * 64;
    if (b.wave == 0 && lane_now() == 0) {
        unsigned* bar = b.bar;
        __builtin_amdgcn_s_waitcnt(0);
        unsigned nloc = b.st[0], nx = b.st[1];
        if (nloc == 0u) { xcd_barrier_complete(bar, b.x, nloc, nx); b.st[0] = nloc; b.st[1] = nx; }
        const unsigned old = xb_add(&bar[XB_XSUB(b.x)], 1u);
        const unsigned gen = old / nloc;
        const bool leader = (old + 1u == (gen + 1u) * nloc);
        unsigned ti = 0u; if (!leader) { const unsigned k = xb_add(q, 1u); if (k < (unsigned)NBG) ti = k + 1u; }
        sx[0] = leader ? 1u : 0u; sx[1] = gen; sx[2] = ti;
    }
    __syncthreads();
    if (__builtin_amdgcn_readfirstlane(sx[0]) == 0u) {
        unsigned ti = (unsigned)__builtin_amdgcn_readfirstlane(sx[2]);
        while (ti != 0u) {
            const int it = lnext * TL_LAYER + NDEF + (int)ti - 1;
            conv_run(F, 0, 1, 1, [=](int) { return it; });
            if (b.wave == 0 && lane_now() == 0) {
                unsigned nt = 0u;
                if (drain || xb_ld(&b.bar[XB_XGEN(b.x)]) == sx[1]) { const unsigned k = xb_add(q, 1u); if (k < (unsigned)NBG) nt = k + 1u; }
                sx[2] = nt; }
            __syncthreads();
            ti = (unsigned)__builtin_amdgcn_readfirstlane(sx[2]);
            __syncthreads();
        }
    }
    if (b.wave == 0 && lane_now() == 0) {
        unsigned* bar = b.bar; const unsigned gen = sx[1], nx = b.st[1];
        asm volatile("s_waitcnt vmcnt(0)" ::: "memory");
        if (sx[0] != 0u) {
            __builtin_amdgcn_fence(__ATOMIC_RELEASE, "agent");
            asm volatile("s_waitcnt vmcnt(0)" ::: "memory");
            const unsigned og = xb_add(&bar[XB_TOP], 1u);
            const unsigned tg = og / nx;
            if (og + 1u == (tg + 1u) * nx) xb_add(&bar[XB_TOPGEN], 1u);
            else XB_SPIN(xb_ld(&bar[XB_TOPGEN]) == tg, bar);
            __builtin_amdgcn_fence(__ATOMIC_ACQUIRE, "agent");
            xb_add(&bar[XB_XGEN(b.x)], 1u);
            asm volatile("s_waitcnt vmcnt(0)" ::: "memory");
        } else {
            XB_SPIN(xb_ld(&bar[XB_XGEN(b.x)]) == gen, bar);
            __builtin_amdgcn_fence(__ATOMIC_ACQUIRE, "agent");
            asm volatile("s_waitcnt vmcnt(0)" ::: "memory");
        }
    }
    __syncthreads();
}

__device__ __forceinline__ bool opq(Frame& F) { asm volatile("" : "+s"(F.ws), "+s"(F.blk), "+s"(F.out), "+s"(F.G)); return true; }
__device__ __forceinline__ int lq_(int l) { asm volatile("" : "+s"(l)); return l; }
__global__ void __launch_bounds__(NTHR, 2) k_mega(Params p) {
    extern __shared__ __attribute__((aligned(16))) unsigned char lds[];
    Frame F; F.lds = (LAS unsigned char*)lds; F.ws = p.ws; F.in = p.in; F.out = p.out; F.wave = __builtin_amdgcn_readfirstlane(threadIdx.x >> 6); F.blk = blockIdx.x; F.G = gridDim.x;
    volatile LAS unsigned* st = (volatile LAS unsigned*)(F.lds + LDS_BYTES - 32);
    if (threadIdx.x < 8) st[threadIdx.x] = 0u;
    __syncthreads();
#if USE_CG_SYNC
#define GRID_BAR() cooperative_groups::this_grid().sync()
#else
    const XcdBarrier bar = xcd_barrier_post((unsigned*)(p.ws + WS_CTL) + CW_BAR + p.li * XCD_BAR_WORDS, st, F.wave);
#define GRID_BAR() xcd_barrier(bar)
#endif
    const int lo = p.ph_lo, hi = p.ph_hi;
#define RUN(k) (lo <= (k) && (k) < hi && opq(F))
#define SEAM(k) do { if (RUN(k) && RUN((k) + 1)) GRID_BAR(); } while (0)
#define SEAM_BG(k, drain) do { if (RUN(k) && RUN((k) + 1)) { if (!USE_CG_SYNC && l + 1 < DEPTH) xcd_barrier_bg(bar, F, l + 1, drain); else GRID_BAR(); } } while (0)
    if (RUN(0)) { phase_prologue(F); if (PROBE_DUP & 16) { __syncthreads(); phase_prologue(F); } }
    SEAM(0);
    { const int l = 0, b = 2; if (RUN(b + 0)) phase_norm1(F, lq_(l));
      SEAM_BG(b + 0, false); }
    for (int l = 0; l < DEPTH; ++l) {
        const int b = 2 + 13 * l;
        if (RUN(b + 1)) phase_gemm_in(F, lq_(l));
        SEAM_BG(b + 1, false);
        if (RUN(b + 2)) { phase_rec_c1(F, lq_(l)); phase_sgu(F, lq_(l)); if (PROBE_DUP & 1) { __syncthreads(); phase_rec_c1(F, lq_(l)); phase_sgu(F, lq_(l)); } if (PROBE_DUP & 64) { __syncthreads(); phase_sgu(F, lq_(l)); } }
        SEAM_BG(b + 2, false);
        if (RUN(b + 3)) { phase_rec_c2(F); if (PROBE_DUP & 4) phase_rec_c2(F); }
        SEAM_BG(b + 3, false);
        if (RUN(b + 5)) { phase_rec_c3(F, lq_(l)); if (PROBE_DUP & 2) { __syncthreads(); phase_rec_c3(F, lq_(l)); } if (PROBE_DUP & 128) { __syncthreads(); phase_rec_c3<1>(F, lq_(l)); } }
        SEAM_BG(b + 5, false);
        if (RUN(b + 6)) phase_gemm_out(F, lq_(l));
        SEAM_BG(b + 6, false);
        if (RUN(b + 7)) phase_norm2(F, lq_(l));
        SEAM_BG(b + 7, false);
        if (RUN(b + 8)) { phase_gather(F, lq_(l)); if (PROBE_DUP & 8) { __syncthreads(); phase_gather(F, lq_(l)); } }
        SEAM_BG(b + 8, false);
#if MOE_FUSED == 1
        if (RUN(b + 9)) phase_moe_fused(F, lq_(l));
        SEAM_BG(b + 9, false);
#elif MOE_FUSED == 2
        if (RUN(b + 9)) phase_moe_fused<1>(F, lq_(l));
        SEAM_BG(b + 9, false);
        if (RUN(b + 10)) phase_moe_fused<2>(F, lq_(l));
        SEAM_BG(b + 10, false);
#else
        if (RUN(b + 9)) phase_gemm_moe1(F, lq_(l));
        SEAM_BG(b + 9, false);
        if (RUN(b + 10)) phase_gemm_moe2(F, lq_(l));
        SEAM_BG(b + 10, false);
#endif
        if (RUN(b + 11)) phase_combine(F, lq_(l));
        SEAM_BG(b + 11, true);
        if (RUN(b + 12)) phase_gemm_pg(F, lq_(l));
        SEAM(b + 12);
    }
    if (RUN(54)) phase_final(F);
#undef RUN
#undef SEAM
}

#ifndef ONE_LAUNCH
#define ONE_LAUNCH 1
#endif
#ifndef CUTS
#define CUTS {0, 55}
#endif
#ifndef MFMA_MASK
#define MFMA_MASK 255
#endif
extern "C" void kernel_launch(void* const* d_in, const int* in_sizes, int n_in, void* d_out, int out_size, void* d_ws, size_t ws_size, hipStream_t stream) {
    if (n_in != 24 || out_size != T * D || ws_size < WS_END) { fprintf(stderr, "kernel_launch: unexpected shapes (n_in %d out %d ws %zu)\n", n_in, out_size, ws_size); return; }
    static_assert(CW_BAR + 60 * XCD_BAR_WORDS <= (int)(CTL_BYTES / 4), "barrier regions inside the zeroed control words");
    Params p{}; for (int i = 0; i < 24; ++i) p.in[i] = (const float*)d_in[i]; p.out = (float*)d_out; p.ws = (unsigned char*)d_ws;
    unsigned char* ws = p.ws;
    (void)hipMemsetAsync(ws + WS_CTL, 0, CTL_BYTES, stream);
    { static bool attr = false; if (!attr) { (void)hipFuncSetAttribute((const void*)k_mega, hipFuncAttributeMaxDynamicSharedMemorySize, LDS_BYTES); attr = true; }
      const int cuts[] = CUTS; const int ncut = (int)(sizeof(cuts) / sizeof(cuts[0]));
      for (int i = 0; i + 1 < ncut; ++i) { p.ph_lo = cuts[i]; p.ph_hi = cuts[i + 1]; p.li = i; p.pad = 0;
#if USE_CG_SYNC
          void* args[] = {&p}; hipError_t e = hipLaunchCooperativeKernel((const void*)k_mega, dim3(256), dim3(NTHR), args, LDS_BYTES, stream);
          if (e != hipSuccess) fprintf(stderr, "cooperative launch failed: %s\n", hipGetErrorName(e));
#else
          hipLaunchKernelGGL(k_mega, dim3(256), dim3(NTHR), LDS_BYTES, stream, p);
#endif
      }
    }
}
```

```cpp
#include <hip/hip_runtime.h>
#include <hip/hip_cooperative_groups.h>
#include <cstdio>
#include <cstdint>

#define GAS __attribute__((address_space(1)))
#define LAS __attribute__((address_space(3)))
typedef unsigned short bf16;
typedef float f32x4 __attribute__((ext_vector_type(4)));
typedef float f32x2 __attribute__((ext_vector_type(2)));
typedef unsigned u32x4 __attribute__((ext_vector_type(4)));
typedef unsigned u32x2 __attribute__((ext_vector_type(2)));
typedef short bf16x8 __attribute__((ext_vector_type(8)));

constexpr int T = 16384, D = 1024, DEPTH = 4, DIN = 3072, DREC = 512, DSGU = 512;
constexpr int NE = 32, DE = 512, PD = 256;
constexpr int RB = 256;
constexpr int CAP = 2 * T + NE * RB;
constexpr int NRBMAX = CAP / RB;
constexpr float EPS = 1e-6f;
constexpr int NWAVES = 8, NTHR = 512;

constexpr size_t MiB = 1u << 20, KiB = 1u << 10;
constexpr size_t WS_CTL = 0, CTL_BYTES = 1 * MiB;
constexpr size_t WS_MISC = 1 * MiB;
constexpr size_t MS_TOKE = WS_MISC + 0;
constexpr size_t MS_TOKW = WS_MISC + 128 * KiB;
constexpr size_t MS_SINFO = WS_MISC + 256 * KiB;
constexpr size_t MS_SDEST = WS_MISC + 384 * KiB;
constexpr size_t MS_RSTDPE = WS_MISC + 512 * KiB;
constexpr size_t MS_BLKBASE = WS_MISC + 576 * KiB;
constexpr size_t MS_LB = WS_MISC + 608 * KiB;
constexpr size_t MS_RSTD2 = WS_MISC + 704 * KiB;
constexpr size_t MS_RSTD1 = WS_MISC + 768 * KiB;
constexpr size_t MS_PART = WS_MISC + 6 * MiB;
constexpr size_t MS_RSTD3 = WS_MISC + 832 * KiB;
constexpr size_t MS_TOKOF = WS_MISC + 8 * MiB;
constexpr size_t MS_RSSLOT = WS_MISC + 8 * MiB + 256 * KiB;
constexpr size_t MS_BLKE = WS_MISC + 640 * KiB;
constexpr size_t MS_DC = WS_MISC + 1 * MiB;
constexpr size_t MS_WRT = WS_MISC + 2 * MiB;
constexpr size_t MS_SGUW = WS_MISC + 3 * MiB;
constexpr size_t MS_MM = WS_MISC + 4 * MiB;
constexpr size_t MS_PTOT = WS_MISC + 5 * MiB;
constexpr size_t WS_WIN = 16 * MiB;
constexpr size_t WS_WOUT = 40 * MiB;
constexpr size_t WS_WGU = 48 * MiB;
constexpr size_t WS_WD = 304 * MiB;
constexpr size_t WS_WPG = 432 * MiB;
constexpr size_t WS_WPE = 440 * MiB;
constexpr size_t WS_PB = 442 * MiB;
constexpr size_t WS_H = 474 * MiB;
constexpr size_t WS_XN = 538 * MiB;
constexpr size_t WS_O = 570 * MiB;
constexpr size_t WS_PE = 602 * MiB;
constexpr size_t WS_R1 = 730 * MiB;
constexpr size_t WS_Z = WS_R1;
constexpr size_t WS_UT = WS_R1 + 96 * MiB;
constexpr size_t WS_ST = WS_R1 + 128 * MiB;
constexpr size_t WS_ORAW = WS_R1 + 96 * MiB;
constexpr size_t WS_VN = WS_R1 + 128 * MiB;
constexpr size_t WS_XB = WS_R1;
constexpr size_t WS_HB = WS_R1 + 80 * MiB;
constexpr size_t WS_Y = WS_R1 + 120 * MiB;
constexpr size_t WS_LTOT = 930 * MiB;
constexpr size_t WS_END = 934 * MiB;
constexpr int CW_CNT = 64;
constexpr int CW_BGQ = 1024;
constexpr int CW_DONE = 2048;
constexpr int CW_BAR = 4096;

constexpr int RING_BYTES = 131072, MISC_OFF = RING_BYTES, LDS_BYTES = 147456;

#ifndef PROBE_DUP
#define PROBE_DUP 0
#endif
#ifndef MOE_VBLK
#define MOE_VBLK 1
#endif
#ifndef MOE_FUSED
#define MOE_FUSED 1
#endif
#ifndef USE_CG_SYNC
#define USE_CG_SYNC 0
#endif
struct Params { const float* in[24]; float* out; unsigned char* ws; int ph_lo, ph_hi, li, pad; };

#define LDS_WAIT() asm volatile("s_waitcnt lgkmcnt(0)" ::: "memory")
template <int M> __device__ __forceinline__ float shx(float v) { static_assert(M >= 1 && M < 32, "swizzle xor mask");
    return __int_as_float(__builtin_amdgcn_ds_swizzle(__float_as_int(v), (M << 10) | 0x1F)); }
__device__ __forceinline__ float halves_sum(float v) {
    return __int_as_float(__builtin_amdgcn_readlane(__float_as_int(v), 0)) + __int_as_float(__builtin_amdgcn_readlane(__float_as_int(v), 32)); }
__device__ __forceinline__ float wave_sum(float v) {
    v += shx<1>(v); v += shx<2>(v); v += shx<4>(v); v += shx<8>(v); v += shx<16>(v);
    return halves_sum(v);
}
typedef __bf16 bf16x2_t __attribute__((ext_vector_type(2)));
__device__ __forceinline__ unsigned pk2(float lo, float hi) { const bf16x2_t v = __builtin_convertvector((f32x2){lo, hi}, bf16x2_t); return __builtin_bit_cast(unsigned, v); }
__device__ __forceinline__ unsigned f2bf(float f) { return pk2(f, f) & 0xffffu; }
__device__ __forceinline__ float bflo(unsigned w) { return __uint_as_float(w << 16); }
__device__ __forceinline__ float bfhi(unsigned w) { return __uint_as_float(w & 0xffff0000u); }
__device__ __forceinline__ float bf2f(bf16 b) { return __uint_as_float(((unsigned)b) << 16); }
__device__ __forceinline__ float fexp(float x) { return __builtin_amdgcn_exp2f(x * 1.4426950408889634f); }
__device__ __forceinline__ float flog(float x) { return __builtin_amdgcn_logf(x) * 0.6931471805599453f; }
__device__ __forceinline__ float frcp(float x) { return __builtin_amdgcn_rcpf(x); }
__device__ __forceinline__ float frsq(float x) { return __builtin_amdgcn_rsqf(x); }
__device__ __forceinline__ float sigmoid_(float x) { return frcp(1.f + fexp(-x)); }
__device__ __forceinline__ float silu_(float x) { return x * sigmoid_(x); }
__device__ __forceinline__ float gelu_(float x) { const float K1 = 2.f * 0.7978845608028654f * 1.4426950408889634f, K3 = K1 * 0.044715f;
    const float r = frcp(__builtin_amdgcn_exp2f(x * (K1 + K3 * (x * x))) + 1.f); return x - x * r; }

struct Frame {
    LAS unsigned char* lds; unsigned char* ws; const float* const* in; float* out;
    int wave, blk, G;
};
__device__ __forceinline__ int lane_now() { int l; asm volatile("v_mbcnt_lo_u32_b32 %0, -1, 0\n\tv_mbcnt_hi_u32_b32 %0, -1, %0" : "=v"(l)); return l; }
__device__ __forceinline__ int vblk(int b) { return 4 * (8 * (b & 7) + (b >> 5)) + ((b >> 3) & 3); }
#define PH_TID() int ph_wave = F.wave; asm volatile("" : "+s"(ph_wave)); const int lane = lane_now(); (void)lane; const int tid = (ph_wave << 6) | lane; (void)tid

struct ConvJob { const float* W; const float* g; bf16* WT; int K, N, k0, n0, mode; };
constexpr int TL_IN = 16 * 12, TL_OUT = 16 * 4, TL_G = 32 * 16 * 2, TL_D = 32 * 8 * 4, TL_PG = 16 * 4, TL_PE = 4 * 4;
constexpr int TL_LAYER = TL_IN + TL_OUT + 2 * TL_G + TL_D + TL_PG + TL_PE;
__device__ __forceinline__ ConvJob conv_job(const Frame& F, int it) {
    unsigned char* ws = F.ws; const int l = it / TL_LAYER; int r = it % TL_LAYER; ConvJob j;
    if (r < TL_IN) { j.W = F.in[3] + (size_t)l * D * DIN; j.g = F.in[2] + l * D; j.WT = (bf16*)(ws + WS_WIN) + (size_t)l * DIN * D; j.K = D; j.N = DIN; j.k0 = 64 * (r / 12); j.n0 = 256 * (r % 12); j.mode = 0; return j; } r -= TL_IN;
    if (r < TL_OUT) { j.W = F.in[10] + (size_t)l * D * D; j.g = nullptr; j.WT = (bf16*)(ws + WS_WOUT) + (size_t)l * D * D; j.K = D; j.N = D; j.k0 = 64 * (r / 4); j.n0 = 256 * (r % 4); j.mode = 0; return j; } r -= TL_OUT;
    if (r < 2 * TL_G) { const int up = r >= TL_G; if (up) r -= TL_G; const int e = r / 32, rr = r % 32;
        j.W = F.in[up ? 17 : 16] + (size_t)(l * NE + e) * D * DE; j.g = F.in[11] + l * D; j.WT = (bf16*)(ws + WS_WGU) + (size_t)(l * NE + e) * 1024 * 1024; j.K = D; j.N = DE; j.k0 = 64 * (rr / 2); j.n0 = 256 * (rr % 2); j.mode = 1 + up; return j; } r -= 2 * TL_G;
    if (r < TL_D) { const int e = r / 32, rr = r % 32; j.W = F.in[18] + (size_t)(l * NE + e) * DE * D; j.g = nullptr; j.WT = (bf16*)(ws + WS_WD) + (size_t)(l * NE + e) * D * DE; j.K = DE; j.N = D; j.k0 = 64 * (rr / 4); j.n0 = 256 * (rr % 4); j.mode = 0; return j; } r -= TL_D;
    if (r < TL_PG) { j.W = F.in[20] + (size_t)l * D * D; j.g = F.in[19] + l * D; j.WT = (bf16*)(ws + WS_WPG) + (size_t)l * D * D; j.K = D; j.N = D; j.k0 = 64 * (r / 4); j.n0 = 256 * (r % 4); j.mode = 0; return j; } r -= TL_PG;
    j.W = F.in[21] + (size_t)l * PD * D; j.g = nullptr; j.WT = (bf16*)(ws + WS_WPE) + (size_t)l * D * PD; j.K = PD; j.N = D; j.k0 = 64 * (r / 4); j.n0 = 256 * (r % 4); j.mode = 0; return j;
}
__device__ __forceinline__ void conv_load(const ConvJob& j, int wave, int lane, f32x4 (&v)[8]) {
#pragma unroll
    for (int i = 0; i < 8; ++i) { const int row = 8 * wave + i; v[i] = *(const f32x4*)(j.W + (size_t)(j.k0 + row) * j.N + j.n0 + 4 * lane); if (j.g) v[i] = v[i] * j.g[j.k0 + row]; }
}
constexpr int NDEF = 0, NDEF1 = 0, NBG = 3408;
constexpr int NREST = TL_LAYER - NDEF - NBG, NPRO = TL_LAYER + 3 * NREST;
__device__ __forceinline__ int pro_tile(int f) { if (NREST == 0 || f < TL_LAYER) return f; f -= TL_LAYER; const int l = 1 + f / (NREST ? NREST : 1); return l * TL_LAYER + NDEF + NBG + f % (NREST ? NREST : 1); }
template <class M> __device__ __forceinline__ void conv_run(const Frame& F, int first, int stride, int count, M tile_of) {
    PH_TID();
    LAS float* tile = (LAS float*)F.lds;
    const int wave = ph_wave;
    int f = first; f32x4 v[8]; ConvJob cur{}, nxt{};
    if (f < count) { cur = conv_job(F, tile_of(f)); conv_load(cur, wave, lane, v); }
    while (f < count) {
#pragma unroll
        for (int i = 0; i < 8; ++i) { LAS float* d = tile + (8 * wave + i) * 257 + 4 * lane; d[0] = v[i].x; d[1] = v[i].y; d[2] = v[i].z; d[3] = v[i].w; }
        __syncthreads();
        const int fn = f + stride; if (fn < count) { nxt = conv_job(F, tile_of(fn)); conv_load(nxt, wave, lane, v); }
#pragma unroll
        for (int q = 0; q < 4; ++q) { const int nn = 32 * wave + 8 * q + (lane >> 3), c = lane & 7; const LAS float* sp = tile + (8 * c) * 257 + nn;
            u32x4 o; o.x = pk2(sp[0 * 257], sp[1 * 257]); o.y = pk2(sp[2 * 257], sp[3 * 257]); o.z = pk2(sp[4 * 257], sp[5 * 257]); o.w = pk2(sp[6 * 257], sp[7 * 257]);
            const int n = cur.n0 + nn; const int drow = cur.mode == 0 ? n : ((n >> 7) * 256 + (n & 127) + (cur.mode == 2 ? 128 : 0));
            *(u32x4*)(cur.WT + (size_t)drow * cur.K + cur.k0 + 8 * c) = o; }
        __syncthreads();
        cur = nxt; f = fn;
    }
}
__device__ __forceinline__ void conv_deferred(const Frame& F, int lnext, int r0, int r1, int first, int idle) {
    if (lnext >= DEPTH || F.blk < first) return;
    conv_run(F, F.blk - first, idle, r1 - r0, [=](int f) { return lnext * TL_LAYER + r0 + f; });
}
__device__ __forceinline__ void phase_prologue(const Frame& F) {
    PH_TID();
    unsigned char* ws = F.ws;
    conv_run(F, F.blk, F.G, NPRO, [](int f) { return pro_tile(f); });
    { const f32x4* src = (const f32x4*)F.in[1]; u32x4* dst = (u32x4*)(ws + WS_PB); const size_t n8 = (size_t)DEPTH * T * PD / 8;
      for (size_t i = (size_t)F.blk * NTHR + tid; i < n8; i += (size_t)F.G * NTHR) { const f32x4 a = src[2 * i], b = src[2 * i + 1]; u32x4 o; o.x = pk2(a.x, a.y); o.y = pk2(a.z, a.w); o.z = pk2(b.x, b.y); o.w = pk2(b.z, b.w); dst[i] = o; } }
    { float* wrt = (float*)(ws + MS_WRT);
      for (int i = F.blk * NTHR + tid; i < DEPTH * 36 * D; i += F.G * NTHR) { const int k = i % D, n = (i / D) % 36, l = i / (36 * D);
          const float w = n < 4 ? F.in[12][((size_t)l * D + k) * 4 + n] : F.in[14][((size_t)l * D + k) * NE + (n - 4)]; wrt[i] = w * F.in[11][l * D + k]; } }
    { bf16* wb = (bf16*)(ws + MS_SGUW); for (int i = F.blk * NTHR + tid; i < DEPTH * 4 * 128 * 128; i += F.G * NTHR) { const int tc = (i >> 7) & 127, sp = i & 127; wb[i] = sp <= tc ? (bf16)f2bf(F.in[8][i]) : (bf16)0; } }
    if (F.blk == 0 && tid < DREC) { const int c = tid; float v[DEPTH], m = -1e30f;
#pragma unroll
        for (int l = 0; l < DEPTH; ++l) { v[l] = F.in[4][l * DREC + c]; m = fmaxf(m, v[l]); }
        float s = 0.f;
#pragma unroll
        for (int l = 0; l < DEPTH; ++l) { v[l] = fexp(v[l] - m); s += v[l]; }
        float* lb = (float*)(ws + MS_LB); float acc = 0.f;
#pragma unroll
        for (int l = 0; l < DEPTH; ++l) { if (l > 0) acc += v[l] / s; lb[l * DREC + c] = acc; } }
}

__device__ __forceinline__ void load_row(const float* row, int lane, f32x4 (&v)[4]) { const f32x4* r = (const f32x4*)row + lane;
#pragma unroll
    for (int j = 0; j < 4; ++j) v[j] = r[64 * j]; }
__device__ __forceinline__ void load_row_bf(const bf16* row, int lane, f32x4 (&v)[4]) { const u32x2* r = (const u32x2*)row + lane;
#pragma unroll
    for (int j = 0; j < 4; ++j) { const u32x2 x = r[64 * j]; v[j] = (f32x4){bflo(x.x), bfhi(x.x), bflo(x.y), bfhi(x.y)}; } }
__device__ __forceinline__ float row_sumsq(const f32x4 (&v)[4]) { float s = 0.f;
#pragma unroll
    for (int j = 0; j < 4; ++j) s += (v[j].x * v[j].x + v[j].y * v[j].y) + (v[j].z * v[j].z + v[j].w * v[j].w);
    return wave_sum(s); }
__device__ __forceinline__ void store_row_bf16(bf16* orow, int lane, const f32x4 (&v)[4], float s) { u32x2* o = (u32x2*)orow + lane;
#pragma unroll
    for (int j = 0; j < 4; ++j) { u32x2 w; w.x = pk2(v[j].x * s, v[j].y * s); w.y = pk2(v[j].z * s, v[j].w * s); o[64 * j] = w; } }

__device__ __forceinline__ void phase_norm1(const Frame& F, int l) {
    PH_TID();
    float* rstd1 = (float*)(F.ws + MS_RSTD1); bf16* h = (bf16*)(F.ws + WS_H); const float* x = F.in[0];
    const int gw = F.blk * NWAVES + ph_wave, NGW = F.G * NWAVES;
    for (int t = gw; t < T; t += NGW) { f32x4 v[4];
        if (l == 0) { load_row(x + (size_t)t * D, lane, v); store_row_bf16(h + (size_t)t * D, lane, v, 1.f); } else load_row_bf(h + (size_t)t * D, lane, v);
        const float rstd = frsq(row_sumsq(v) * (1.f / D) + EPS); if (lane == 0) rstd1[t] = rstd; }
}
__device__ __forceinline__ float bfly8(const float (&r)[8], int lane) {
    const bool b2 = lane & 4, b1 = lane & 2, b0 = lane & 1; float a[4], c[2];
#pragma unroll
    for (int i = 0; i < 4; ++i) { const float keep = b2 ? r[i + 4] : r[i], send = b2 ? r[i] : r[i + 4]; a[i] = keep + shx<4>(send); }
#pragma unroll
    for (int i = 0; i < 2; ++i) { const float keep = b1 ? a[i + 2] : a[i], send = b1 ? a[i] : a[i + 2]; c[i] = keep + shx<2>(send); }
    const float keep = b0 ? c[1] : c[0], send = b0 ? c[0] : c[1]; float d = keep + shx<1>(send);
    d += shx<8>(d); d += shx<16>(d);
    return d + __int_as_float(__builtin_amdgcn_ds_bpermute((lane ^ 32) << 2, __float_as_int(d)));
}
__device__ __forceinline__ void phase_norm2(const Frame& F, int l) {
    PH_TID();
    unsigned char* ws = F.ws;
    unsigned* hist = (unsigned*)(F.lds + MISC_OFF + 256);
    if (tid < 32) hist[tid] = 0u;
    __syncthreads();
    const bf16* h = (const bf16*)(ws + WS_H); bf16* XN = (bf16*)(ws + WS_XN);
    const float* WrT = (const float*)(ws + MS_WRT) + (size_t)l * 36 * D;
    const float* b_rg = F.in[13] + l * 4; const float* b_re = F.in[15] + l * NE;
    int* tok_e = (int*)(ws + MS_TOKE); float* tok_w = (float*)(ws + MS_TOKW); unsigned* sinfo = (unsigned*)(ws + MS_SINFO);
    const int RPB = T / F.G, RPW = RPB / NWAVES;
    for (int i0 = 0; i0 < RPW; i0 += 8) {
        const int t0 = F.blk * RPB + ph_wave * RPW + i0;
        f32x4 v[8][4]; float ss[8];
#pragma unroll
        for (int r = 0; r < 8; ++r) { load_row_bf(h + (size_t)(t0 + r) * D, lane, v[r]); float q = 0.f;
#pragma unroll
            for (int j = 0; j < 4; ++j) q += (v[r][j].x * v[r][j].x + v[r][j].y * v[r][j].y) + (v[r][j].z * v[r][j].z + v[r][j].w * v[r][j].w);
            ss[r] = q; }
        const float rstd_mine = frsq(bfly8(ss, lane) * (1.f / D) + EPS);
        if (lane < 8) ((float*)(ws + MS_RSTD2))[t0 + lane] = rstd_mine;
        LAS float* lgw = (LAS float*)(F.lds + 4096) + ph_wave * (36 * 8);
#pragma unroll 2
        for (int n = 0; n < 36; ++n) { const f32x4* wr = (const f32x4*)(WrT + (size_t)n * D) + lane; const f32x4 w0 = wr[0], w1 = wr[64], w2 = wr[128], w3 = wr[192]; float pr[8];
#pragma unroll
            for (int r = 0; r < 8; ++r) pr[r] = ((v[r][0].x * w0.x + v[r][0].y * w0.y) + (v[r][0].z * w0.z + v[r][0].w * w0.w)) + ((v[r][1].x * w1.x + v[r][1].y * w1.y) + (v[r][1].z * w1.z + v[r][1].w * w1.w))
                                                 + ((v[r][2].x * w2.x + v[r][2].y * w2.y) + (v[r][2].z * w2.z + v[r][2].w * w2.w)) + ((v[r][3].x * w3.x + v[r][3].y * w3.y) + (v[r][3].z * w3.z + v[r][3].w * w3.w));
            const float val = bfly8(pr, lane) * rstd_mine; if (lane < 8) lgw[n * 8 + lane] = val; }
        const int row = lane & 7;
        float lg4[4], lgb[4];
#pragma unroll
        for (int j = 0; j < 4; ++j) { lg4[j] = lgw[j * 8 + row]; lgb[j] = lg4[j] + b_rg[j]; }
        int gs = 0; float gm = lgb[0];
#pragma unroll
        for (int j = 1; j < 4; ++j) if (lgb[j] > gm) { gm = lgb[j]; gs = j; }
        float mx = fmaxf(fmaxf(lg4[0], lg4[1]), fmaxf(lg4[2], lg4[3])), se = 0.f, lsel = lg4[0];
#pragma unroll
        for (int j = 0; j < 4; ++j) { se += fexp(lg4[j] - mx); if (j == gs) lsel = lg4[j]; }
        const float g_w = fexp(lsel - mx) * frcp(se);
        float le[8], leb[8];
#pragma unroll
        for (int j = 0; j < 8; ++j) { le[j] = lgw[(4 + gs * 8 + j) * 8 + row]; leb[j] = le[j] + b_re[gs * 8 + j]; }
        int s0 = 0; float m0 = leb[0];
#pragma unroll
        for (int j = 1; j < 8; ++j) if (leb[j] > m0) { m0 = leb[j]; s0 = j; }
        int s1 = -1; float m1 = -3.0e38f;
#pragma unroll
        for (int j = 0; j < 8; ++j) if (j != s0 && leb[j] > m1) { m1 = leb[j]; s1 = j; }
        if (s1 < 0) s1 = (s0 == 0) ? 1 : 0;
        float la = le[0], lb2 = le[0];
#pragma unroll
        for (int j = 1; j < 8; ++j) { if (j == s0) la = le[j]; if (j == s1) lb2 = le[j]; }
        const float wa = frcp(1.f + fexp(lb2 - la)), wb = 1.f - wa;
        if (lane < 8) { const int t = t0 + lane;
            const int e0 = gs * 8 + s0, e1 = gs * 8 + s1;
            const unsigned r0 = atomicAdd(&hist[e0], 1u), r1 = atomicAdd(&hist[e1], 1u);
            tok_e[2 * t] = e0; tok_e[2 * t + 1] = e1; tok_w[2 * t] = g_w * wa; tok_w[2 * t + 1] = g_w * wb;
            sinfo[2 * t] = ((unsigned)F.blk << 16) | r0; sinfo[2 * t + 1] = ((unsigned)F.blk << 16) | r1;
        }
    }
    __syncthreads();
    if (tid < 32) { unsigned* cnt = (unsigned*)(ws + WS_CTL) + CW_CNT + l * 32;
        const unsigned base = __hip_atomic_fetch_add(cnt + tid, hist[tid], __ATOMIC_RELAXED, __HIP_MEMORY_SCOPE_AGENT);
        ((unsigned*)(ws + MS_BLKBASE))[F.blk * 32 + tid] = base; }
}
__device__ __forceinline__ void phase_gather(const Frame& F, int l) {
    PH_TID();
    unsigned char* ws = F.ws;
    int* ps = (int*)(F.lds + MISC_OFF + 512); int* cs = ps + 32;
    if (tid == 0) { unsigned* cnt = (unsigned*)(ws + WS_CTL) + CW_CNT + l * 32; int* blke = (int*)(ws + MS_BLKE) + l * 256; int acc = 0;
        for (int e = 0; e < NE; ++e) { const int c = (int)__hip_atomic_load(cnt + e, __ATOMIC_RELAXED, __HIP_MEMORY_SCOPE_AGENT); ps[e] = acc; cs[e] = c; const int pad = (c + RB - 1) / RB * RB;
            if (F.blk == 0) for (int rb = acc / RB; rb < (acc + pad) / RB; ++rb) blke[rb] = e;
            acc += pad; }
        if (F.blk == 0) blke[255] = acc / RB; }
    __syncthreads();
    const int* tok_e = (const int*)(ws + MS_TOKE); const unsigned* sinfo = (const unsigned*)(ws + MS_SINFO); const unsigned* bbase = (const unsigned*)(ws + MS_BLKBASE);
    int* sdest = (int*)(ws + MS_SDEST); const float* rstd2 = (const float*)(ws + MS_RSTD2); int* tokof = (int*)(ws + MS_TOKOF); float* rsl = (float*)(ws + MS_RSSLOT);
    for (int i = F.blk * NTHR + tid; i < 2 * T; i += F.G * NTHR) { const int e = tok_e[i]; const unsigned info = sinfo[i];
        const int dest = ps[e] + (int)bbase[(info >> 16) * 32 + e] + (int)(info & 0xffffu);
        sdest[i] = dest; tokof[dest] = i >> 1; rsl[dest] = rstd2[i >> 1]; }
    for (int e = F.blk; e < NE; e += F.G) { const int p0 = ps[e] + cs[e], p1 = ps[e] + (cs[e] + RB - 1) / RB * RB;
        for (int sl = p0 + tid; sl < p1; sl += NTHR) { tokof[sl] = 0; rsl[sl] = 0.f; } }
}
__device__ __forceinline__ void phase_combine(const Frame& F, int l) {
    PH_TID();
    unsigned char* ws = F.ws;
    bf16* h = (bf16*)(ws + WS_H); bf16* XN = (bf16*)(ws + WS_XN); const bf16* Y = (const bf16*)(ws + WS_Y); const bf16* PE = (const bf16*)(ws + WS_PE) + (size_t)l * T * D;
    const int* sdest = (const int*)(ws + MS_SDEST); const float* tok_w = (const float*)(ws + MS_TOKW); float* rstd_pe = (float*)(ws + MS_RSTDPE); float* rstd_pg = (float*)(ws + MS_RSTD3);
    const int gw = F.blk * NWAVES + ph_wave, NGW = F.G * NWAVES;
    struct Rows { u32x2 h[4], y0[4], y1[4], pe[4]; };
    auto fetch = [&](int t, int d0, int d1, Rows& r) {
        const u32x2* hp = (const u32x2*)(h + (size_t)t * D) + lane; const u32x2* y0 = (const u32x2*)(Y + (size_t)d0 * D) + lane; const u32x2* y1 = (const u32x2*)(Y + (size_t)d1 * D) + lane; const u32x2* pe = (const u32x2*)(PE + (size_t)t * D) + lane;
#pragma unroll
        for (int j = 0; j < 4; ++j) { r.h[j] = hp[64 * j]; r.y0[j] = y0[64 * j]; r.y1[j] = y1[64 * j]; r.pe[j] = pe[64 * j]; } };
    int t = gw; if (t >= T) return;
    Rows cur; int d0n = 0, d1n = 0; float w0 = tok_w[2 * t], w1 = tok_w[2 * t + 1], w0n = 0.f, w1n = 0.f;
    fetch(t, sdest[2 * t], sdest[2 * t + 1], cur);
    if (t + NGW < T) { d0n = sdest[2 * (t + NGW)]; d1n = sdest[2 * (t + NGW) + 1]; w0n = tok_w[2 * (t + NGW)]; w1n = tok_w[2 * (t + NGW) + 1]; }
    for (; t < T; t += NGW) {
        Rows nxt = cur; const float w0c = w0, w1c = w1; const bool more = t + NGW < T;
        if (more) { fetch(t + NGW, d0n, d1n, nxt); w0 = w0n; w1 = w1n;
            if (t + 2 * NGW < T) { d0n = sdest[2 * (t + 2 * NGW)]; d1n = sdest[2 * (t + 2 * NGW) + 1]; w0n = tok_w[2 * (t + 2 * NGW)]; w1n = tok_w[2 * (t + 2 * NGW) + 1]; } }
        f32x4 v[4]; float sp = 0.f;
#pragma unroll
        for (int j = 0; j < 4; ++j) { const u32x2 x = cur.h[j], a = cur.y0[j], b = cur.y1[j], c = cur.pe[j];
            v[j] = (f32x4){bflo(x.x) + (w0c * bflo(a.x) + w1c * bflo(b.x)), bfhi(x.x) + (w0c * bfhi(a.x) + w1c * bfhi(b.x)), bflo(x.y) + (w0c * bflo(a.y) + w1c * bflo(b.y)), bfhi(x.y) + (w0c * bfhi(a.y) + w1c * bfhi(b.y))};
            const float p0 = bflo(c.x), p1 = bfhi(c.x), p2 = bflo(c.y), p3 = bfhi(c.y); sp += (p0 * p0 + p1 * p1) + (p2 * p2 + p3 * p3); }
        store_row_bf16(XN + (size_t)t * D, lane, v, 1.f);
        const float rstd = frsq(row_sumsq(v) * (1.f / D) + EPS);
        sp = wave_sum(sp); if (lane == 0) { rstd_pe[t] = frsq(sp * (1.f / D) + EPS); rstd_pg[t] = rstd; }
        cur = nxt;
    }
}
__device__ __forceinline__ void phase_final(const Frame& F) {
    PH_TID();
    const bf16* h = (const bf16*)(F.ws + WS_H); const float* nf = F.in[23];
    const int gw = F.blk * NWAVES + ph_wave, NGW = F.G * NWAVES;
    for (int t = gw; t < T; t += NGW) { f32x4 v[4]; load_row_bf(h + (size_t)t * D, lane, v); const float rstd = frsq(row_sumsq(v) * (1.f / D) + EPS);
        f32x4* o = (f32x4*)(F.out + (size_t)t * D) + lane; const f32x4* g = (const f32x4*)nf + lane;
#pragma unroll
        for (int j = 0; j < 4; ++j) o[64 * j] = v[j] * rstd * g[64 * j]; }
}


namespace pg8 {
constexpr int BM = 256, BK = 64, HALF = 128, HTB = HALF * BK * 2, STAGE_BYTES = 8 * HTB, NXCD = 8, WGM = 8;
__host__ __device__ __forceinline__ int lds_byte(int r, int c) { const int st = (r >> 4) * 2 + (c >> 5), rr = r & 15, cc = c & 31, ob = rr * 64 + cc * 2; return st * 1024 + (ob ^ (((ob >> 9) & 1) << 5)); }
__host__ __device__ __forceinline__ void stage_rc(int b, int& R, int& C) { const int st = b / 1024, sb = b % 1024, swz = sb ^ (((sb >> 9) & 1) << 5); R = (st >> 1) * 16 + swz / 64; C = (st & 1) * 32 + (swz % 64) / 2; }
__host__ __device__ __forceinline__ int perm32(int rho) { const int n = rho >> 4, i = rho & 15; return 8 * (i >> 2) + 4 * n + (i & 3); }
struct Unit { int pm, pn; const char* A; const char* B; };
__device__ __forceinline__ void static_map(int wgid, int nM, int nN, int& pm, int& pn) {
    const int nwg = nM * nN; { const int q = nwg / NXCD, r = nwg % NXCD, xcd = wgid % NXCD, off = wgid / NXCD; wgid = (xcd < r ? xcd * (q + 1) : r * (q + 1) + (xcd - r) * q) + off; }
    const int nig = WGM * nN, gid = wgid / nig, fm = gid * WGM, gsz = (nM - fm) < WGM ? (nM - fm) : WGM;
    pm = fm + ((wgid % nig) % gsz); pn = (wgid % nig) / gsz;
}
struct DenseOrder { static constexpr bool DEPS = false, GATHER = false;
    const char* A; const char* Bt; int nM, nN, nL, G, c; size_t tstep;
    __device__ void init(const void* A_, const void* Bt_, int M, int N, int K, int nL_, int G_, int c_) { A = (const char*)A_; Bt = (const char*)Bt_; nM = M / BM; nN = N / BM; nL = nL_; G = G_; c = c_; tstep = (size_t)BM * K * 2; }
    __device__ bool next(int i, Unit& u) const { const long L = (long)i * G + c; const int per = nM * nN; if (L >= (long)per * nL) return false;
        const int l = (int)(L / per); int pm, pn; static_map((int)(L % per), nM, nN, pm, pn); u.pm = l * nM + pm; u.pn = pn; u.A = A + (size_t)u.pm * tstep; u.B = Bt + (size_t)(l * nN + pn) * tstep; return true; }
};
struct MoeOrder { static constexpr bool DEPS = false, GATHER = false;
    const char* A; const char* W; const int* blke; int nrb, nN, G, c, e0, e1, e2; size_t a_tstep, w_estride, b_tstep;
    __device__ void init(const void* A_, const void* W_, const int* blke_, int K, int nN_, size_t w_estride_bytes, int G_, int c_) { A = (const char*)A_; W = (const char*)W_; blke = blke_; nrb = __builtin_amdgcn_readfirstlane(blke_[255]); nN = nN_; G = G_; c = c_;
        a_tstep = (size_t)BM * K * 2; b_tstep = a_tstep; w_estride = w_estride_bytes;
        const int r0 = c / nN, r1 = (G + c) / nN, r2 = (2 * G + c) / nN; const int x0 = blke_[r0 < 255 ? r0 : 254], x1 = blke_[r1 < 255 ? r1 : 254], x2 = blke_[r2 < 255 ? r2 : 254];
        e0 = __builtin_amdgcn_readfirstlane(x0); e1 = __builtin_amdgcn_readfirstlane(x1); e2 = __builtin_amdgcn_readfirstlane(x2); }
    __device__ bool next(int i, Unit& u) const { const long L = (long)i * G + c; if (L >= (long)nrb * nN) return false; const int rb = (int)(L / nN), pn = (int)(L % nN);
        const int ex = i == 0 ? e0 : i == 1 ? e1 : i == 2 ? e2 : __builtin_amdgcn_readfirstlane(blke[rb]);
        u.pm = rb; u.pn = pn; u.A = A + (size_t)rb * a_tstep; u.B = W + (size_t)ex * w_estride + (size_t)pn * b_tstep; return true; }
};
__device__ __forceinline__ unsigned ag_ld(const unsigned* p)        { return __hip_atomic_load(p, __ATOMIC_RELAXED, __HIP_MEMORY_SCOPE_AGENT); }
__device__ __forceinline__ unsigned ag_add(unsigned* p, unsigned v) { return __hip_atomic_fetch_add(p, v, __ATOMIC_RELAXED, __HIP_MEMORY_SCOPE_AGENT); }
struct MoeDepOrder { static constexpr bool DEPS = true, GATHER = false;
    const char* A; const char* W; const int* blke; const unsigned* done; int nrb, nN, G, c, e0, e1, e2; size_t a_tstep, w_estride, b_tstep;
    __device__ void init(const void* A_, const void* W_, const int* blke_, const unsigned* done_, int K, int nN_, size_t w_estride_bytes, int G_, int c_) { A = (const char*)A_; W = (const char*)W_; blke = blke_; done = done_;
        nrb = __builtin_amdgcn_readfirstlane(blke_[255]); nN = nN_; G = G_; c = c_; a_tstep = (size_t)BM * K * 2; b_tstep = a_tstep; w_estride = w_estride_bytes;
        const int r0 = c / nN, r1 = (G + c) / nN, r2 = (2 * G + c) / nN; const int x0 = blke_[r0 < 255 ? r0 : 254], x1 = blke_[r1 < 255 ? r1 : 254], x2 = blke_[r2 < 255 ? r2 : 254];
        e0 = __builtin_amdgcn_readfirstlane(x0); e1 = __builtin_amdgcn_readfirstlane(x1); e2 = __builtin_amdgcn_readfirstlane(x2); }
    __device__ bool next(int i, Unit& u) const { const long L = (long)i * G + c; if (L >= (long)nrb * nN) return false; const int rb = (int)(L / nN), pn = (int)(L % nN);
        const int ex = i == 0 ? e0 : i == 1 ? e1 : i == 2 ? e2 : __builtin_amdgcn_readfirstlane(blke[rb]);
        u.pm = rb; u.pn = pn; u.A = A + (size_t)rb * a_tstep; u.B = W + (size_t)ex * w_estride + (size_t)pn * b_tstep; return true; }
    __device__ void wait(const Unit& u, int wid) const {
        if (wid == 0 && lane_now() == 0) { while (ag_ld(done + u.pm) < 4u) __builtin_amdgcn_s_sleep(1); __builtin_amdgcn_fence(__ATOMIC_ACQUIRE, "agent"); } }
};
struct MoeGatherOrder { static constexpr bool DEPS = false, GATHER = true;
    const char* A; const char* W; const int* blke; const int* tokof; int nrb, nN, G, c, e0, e1, e2; size_t w_estride, b_tstep;
    __device__ void init(const void* A_, const void* W_, const int* blke_, const int* tokof_, int K, int nN_, size_t w_estride_bytes, int G_, int c_) { A = (const char*)A_; W = (const char*)W_; blke = blke_; tokof = tokof_;
        nrb = __builtin_amdgcn_readfirstlane(blke_[255]); nN = nN_; G = G_; c = c_; b_tstep = (size_t)BM * K * 2; w_estride = w_estride_bytes;
        const int r0 = c / nN, r1 = (G + c) / nN, r2 = (2 * G + c) / nN; const int x0 = blke_[r0 < 255 ? r0 : 254], x1 = blke_[r1 < 255 ? r1 : 254], x2 = blke_[r2 < 255 ? r2 : 254];
        e0 = __builtin_amdgcn_readfirstlane(x0); e1 = __builtin_amdgcn_readfirstlane(x1); e2 = __builtin_amdgcn_readfirstlane(x2); }
    __device__ bool next(int i, Unit& u) const { const long L = (long)i * G + c; if (L >= (long)nrb * nN) return false; const int rb = (int)(L / nN), pn = (int)(L % nN);
        const int ex = i == 0 ? e0 : i == 1 ? e1 : i == 2 ? e2 : __builtin_amdgcn_readfirstlane(blke[rb]);
        u.pm = rb; u.pn = pn; u.A = A; u.B = W + (size_t)ex * w_estride + (size_t)pn * b_tstep; return true; }
    __device__ void offsets(const Unit& u, int tid, int K, unsigned (&vo)[2][2]) const {
#pragma unroll
        for (int i = 0; i < 2; ++i) { int R, C; stage_rc(tid * 16 + i * 8192, R, C);
#pragma unroll
            for (int h = 0; h < 2; ++h) vo[h][i] = (unsigned)(tokof[u.pm * BM + h * HALF + R] * K + C) * 2u; } }
};
struct RangeOrder { static constexpr bool DEPS = false, GATHER = false;
    const char* A; const char* Bt; int nM, nN, j0, n; size_t tstep;
    __device__ void init(const void* A_, const void* Bt_, int M, int N, int K, int j0_, int n_) { A = (const char*)A_; Bt = (const char*)Bt_; nM = M / BM; nN = N / BM; j0 = j0_; n = n_; tstep = (size_t)BM * K * 2; }
    __device__ bool next(int i, Unit& u) const { if (i >= n) return false; int pm, pn; static_map(j0 + i, nM, nN, pm, pn); u.pm = pm; u.pn = pn; u.A = A + (size_t)pm * tstep; u.B = Bt + (size_t)pn * tstep; return true; }
};
__device__ __forceinline__ unsigned cvt_pk_bf16(float lo, float hi) { return pk2(lo, hi); }
struct EpiBf16 { static constexpr bool PERM = true, ACC_INIT = false, SIGNAL = false; bf16* O; int ldc;
    __device__ __forceinline__ void operator()(const f32x4 (&acc)[2][2][4][2], const Unit& u, int wr, int wc, int, int) const {
        const int t2 = lane_now(), fr = t2 & 15, fq = t2 >> 4;
        const int row0 = u.pm * BM + wr * 64 + fr, col0 = u.pn * BM + wc * 32 + 8 * fq;
#pragma unroll
        for (int ai = 0; ai < 2; ++ai)
#pragma unroll
            for (int m = 0; m < 4; ++m) { bf16* rowp = O + (size_t)(row0 + ai * HALF + m * 16) * ldc + col0;
#pragma unroll
                for (int bj = 0; bj < 2; ++bj) { const f32x4 v0 = acc[ai][bj][m][0], v1 = acc[ai][bj][m][1];
                    u32x4 w; w.x = cvt_pk_bf16(v0[0], v0[1]); w.y = cvt_pk_bf16(v0[2], v0[3]); w.z = cvt_pk_bf16(v1[0], v1[1]); w.w = cvt_pk_bf16(v1[2], v1[3]);
                    *(u32x4*)(rowp + bj * HALF) = w; } }
    } };
struct EpiBf16Rs { static constexpr bool PERM = true, ACC_INIT = false, SIGNAL = false; bf16* O; int ldc; const float* rs; const float* part;
    __device__ __forceinline__ void operator()(const f32x4 (&acc)[2][2][4][2], const Unit& u, int wr, int wc, int, int) const {
        const int t2 = lane_now(), fr = t2 & 15, fq = t2 >> 4;
        const int row0 = u.pm * BM + wr * 64 + fr, col0 = u.pn * BM + wc * 32 + 8 * fq;
#pragma unroll
        for (int ai = 0; ai < 2; ++ai)
#pragma unroll
            for (int m = 0; m < 4; ++m) { const int row = row0 + ai * HALF + m * 16; const float r = part ? frsq(((part[row] + part[T + row]) + (part[2 * T + row] + part[3 * T + row])) * (1.f / D) + EPS) : rs[row]; bf16* rowp = O + (size_t)row * ldc + col0;
#pragma unroll
                for (int bj = 0; bj < 2; ++bj) { const f32x4 v0 = acc[ai][bj][m][0] * r, v1 = acc[ai][bj][m][1] * r;
                    u32x4 w; w.x = cvt_pk_bf16(v0[0], v0[1]); w.y = cvt_pk_bf16(v0[2], v0[3]); w.z = cvt_pk_bf16(v1[0], v1[1]); w.w = cvt_pk_bf16(v1[2], v1[3]);
                    *(u32x4*)(rowp + bj * HALF) = w; } }
    } };
struct EpiResid { static constexpr bool PERM = true, ACC_INIT = true, SIGNAL = false; bf16* h;
    __device__ __forceinline__ void init(f32x4 (&acc)[2][2][4][2], const Unit& u, int wr, int wc, int fr, int fq) const {
        const int row0 = u.pm * BM + wr * 64 + fr, col0 = u.pn * BM + wc * 32 + 8 * fq;
#pragma unroll
        for (int ai = 0; ai < 2; ++ai)
#pragma unroll
            for (int m = 0; m < 4; ++m) { const bf16* rowp = h + (size_t)(row0 + ai * HALF + m * 16) * D + col0;
#pragma unroll
                for (int bj = 0; bj < 2; ++bj) { const u32x4 x = *(const u32x4*)(rowp + bj * HALF);
                    acc[ai][bj][m][0] = (f32x4){bflo(x.x), bfhi(x.x), bflo(x.y), bfhi(x.y)}; acc[ai][bj][m][1] = (f32x4){bflo(x.z), bfhi(x.z), bflo(x.w), bfhi(x.w)}; } }
    }
    __device__ __forceinline__ void operator()(const f32x4 (&acc)[2][2][4][2], const Unit& u, int wr, int wc, int fr, int fq) const {
        asm volatile("" : "+v"(fr), "+v"(fq));
        const int row0 = u.pm * BM + wr * 64 + fr, col0 = u.pn * BM + wc * 32 + 8 * fq;
#pragma unroll
        for (int ai = 0; ai < 2; ++ai)
#pragma unroll
            for (int m = 0; m < 4; ++m) { bf16* rowp = h + (size_t)(row0 + ai * HALF + m * 16) * D + col0;
#pragma unroll
                for (int bj = 0; bj < 2; ++bj) { const f32x4 v0 = acc[ai][bj][m][0], v1 = acc[ai][bj][m][1];
                    u32x4 w; w.x = cvt_pk_bf16(v0[0], v0[1]); w.y = cvt_pk_bf16(v0[2], v0[3]); w.z = cvt_pk_bf16(v1[0], v1[1]); w.w = cvt_pk_bf16(v1[2], v1[3]);
                    *(u32x4*)(rowp + bj * HALF) = w; } }
    } };
struct EpiGateUp { static constexpr bool PERM = true, ACC_INIT = false, SIGNAL = false; bf16* H;
    __device__ __forceinline__ void operator()(const f32x4 (&acc)[2][2][4][2], const Unit& u, int wr, int wc, int, int) const {
        const int t2 = lane_now(), fr = t2 & 15, fq = t2 >> 4;
        const int row0 = u.pm * BM + wr * 64 + fr, col0 = u.pn * HALF + wc * 32 + 8 * fq;
#pragma unroll
        for (int ai = 0; ai < 2; ++ai)
#pragma unroll
            for (int m = 0; m < 4; ++m) { bf16* rowp = H + (size_t)(row0 + ai * HALF + m * 16) * DE + col0; float v[8];
#pragma unroll
                for (int n = 0; n < 2; ++n)
#pragma unroll
                    for (int j = 0; j < 4; ++j) v[4 * n + j] = silu_(acc[ai][0][m][n][j]) * acc[ai][1][m][n][j];
                u32x4 w; w.x = cvt_pk_bf16(v[0], v[1]); w.y = cvt_pk_bf16(v[2], v[3]); w.z = cvt_pk_bf16(v[4], v[5]); w.w = cvt_pk_bf16(v[6], v[7]);
                *(u32x4*)rowp = w; }
    } };
struct EpiGateUpPub { static constexpr bool PERM = true, ACC_INIT = false, SIGNAL = true; __amdgpu_buffer_rsrc_t rs; unsigned* done; const float* rsl;
    __device__ __forceinline__ void operator()(const f32x4 (&acc)[2][2][4][2], const Unit& u, int wr, int wc, int fr, int fq) const {
        asm volatile("" : "+v"(fr), "+v"(fq));
        const int row0 = u.pm * BM + wr * 64 + fr, col0 = u.pn * HALF + wc * 32 + 8 * fq;
#pragma unroll
        for (int ai = 0; ai < 2; ++ai)
#pragma unroll
            for (int m = 0; m < 4; ++m) { const unsigned off = (unsigned)(((row0 + ai * HALF + m * 16) * DE + col0) * 2); float v[8]; const float r = rsl[row0 + ai * HALF + m * 16];
#pragma unroll
                for (int n = 0; n < 2; ++n)
#pragma unroll
                    for (int j = 0; j < 4; ++j) v[4 * n + j] = silu_(acc[ai][0][m][n][j] * r) * (acc[ai][1][m][n][j] * r);
                u32x4 w; w.x = cvt_pk_bf16(v[0], v[1]); w.y = cvt_pk_bf16(v[2], v[3]); w.z = cvt_pk_bf16(v[4], v[5]); w.w = cvt_pk_bf16(v[6], v[7]);
                __builtin_amdgcn_raw_buffer_store_b128(w, rs, off, 0, 16); }
    }
    __device__ __forceinline__ void signal(const Unit& u) const { (void)ag_add(done + u.pm, 1u); }
};
struct EpiPG { static constexpr bool PERM = true, ACC_INIT = false, SIGNAL = false; bf16* h; const bf16* hin; const float* rstd_h; const bf16* PE; const float* rstd_pe; const float* norm_pe; LAS float* red; float* part;
    __device__ __forceinline__ void operator()(const f32x4 (&acc)[2][2][4][2], const Unit& u, int wr, int wc, int, int) const {
        const int t2 = lane_now(), fr = t2 & 15, fq = t2 >> 4;
        const int row0 = u.pm * BM + wr * 64 + fr, col0 = u.pn * BM + wc * 32 + 8 * fq;
        f32x4 nv[2][2];
#pragma unroll
        for (int bj = 0; bj < 2; ++bj)
#pragma unroll
            for (int n = 0; n < 2; ++n) nv[bj][n] = *(const f32x4*)(norm_pe + col0 + bj * HALF + 4 * n);
        float sq[2][4];
#pragma unroll
        for (int ai = 0; ai < 2; ++ai)
#pragma unroll
        for (int mh = 0; mh < 2; ++mh) {
            u32x4 pe[4][2], hx[4][2]; float rs[4], rh[4];
#pragma unroll
            for (int m = 2 * mh; m < 2 * mh + 2; ++m) { const int row = row0 + ai * HALF + m * 16; rs[m] = rstd_pe[row]; rh[m] = rstd_h[row];
#pragma unroll
                for (int bj = 0; bj < 2; ++bj) { const size_t o = (size_t)row * D + col0 + bj * HALF; pe[m][bj] = *(const u32x4*)(PE + o); hx[m][bj] = *(const u32x4*)(hin + o); } }
#pragma unroll
            for (int m = 2 * mh; m < 2 * mh + 2; ++m) { const int row = row0 + ai * HALF + m * 16; float q = 0.f;
#pragma unroll
                for (int bj = 0; bj < 2; ++bj) { const size_t o = (size_t)row * D + col0 + bj * HALF; const u32x4 p = pe[m][bj], x = hx[m][bj];
                    f32x4 h0 = (f32x4){bflo(x.x), bfhi(x.x), bflo(x.y), bfhi(x.y)}, h1 = (f32x4){bflo(x.z), bfhi(x.z), bflo(x.w), bfhi(x.w)}; const f32x4 a0 = acc[ai][bj][m][0] * rh[m], a1 = acc[ai][bj][m][1] * rh[m];
                    const f32x4 e0 = (f32x4){bflo(p.x), bfhi(p.x), bflo(p.y), bfhi(p.y)} * rs[m] * nv[bj][0], e1 = (f32x4){bflo(p.z), bfhi(p.z), bflo(p.w), bfhi(p.w)} * rs[m] * nv[bj][1];
                    h0 += (f32x4){sigmoid_(a0[0]), sigmoid_(a0[1]), sigmoid_(a0[2]), sigmoid_(a0[3])} * e0; h1 += (f32x4){sigmoid_(a1[0]), sigmoid_(a1[1]), sigmoid_(a1[2]), sigmoid_(a1[3])} * e1;
                    u32x4 w; w.x = pk2(h0[0], h0[1]); w.y = pk2(h0[2], h0[3]); w.z = pk2(h1[0], h1[1]); w.w = pk2(h1[2], h1[3]); *(u32x4*)(h + o) = w;
                    q += (bflo(w.x) * bflo(w.x) + bfhi(w.x) * bfhi(w.x)) + (bflo(w.y) * bflo(w.y) + bfhi(w.y) * bfhi(w.y)) + (bflo(w.z) * bflo(w.z) + bfhi(w.z) * bfhi(w.z)) + (bflo(w.w) * bflo(w.w) + bfhi(w.w) * bfhi(w.w)); }
                sq[ai][m] = q; } }
#pragma unroll
        for (int ai = 0; ai < 2; ++ai)
#pragma unroll
            for (int m = 0; m < 4; ++m) { float q = sq[ai][m]; q += shx<16>(q); q += __int_as_float(__builtin_amdgcn_ds_bpermute((t2 ^ 32) << 2, __float_as_int(q)));
                if (fq == 0) red[wc * 256 + ai * HALF + wr * 64 + m * 16 + fr] = q; }
        asm volatile("s_waitcnt lgkmcnt(0)" ::: "memory");
        __builtin_amdgcn_s_barrier();
        { const int tt = (wr * 4 + wc) * 64 + t2; if (tt < 256) part[(size_t)u.pn * T + u.pm * BM + tt] = (red[tt] + red[256 + tt]) + (red[512 + tt] + red[768 + tt]); }
    } };

template <class Epi, class Sched>
__device__ __forceinline__ void gemm_phase(int wave, LAS unsigned char* lds, int K, const Sched& S, const Epi& E) {
    int wid = wave; asm volatile("" : "+s"(wid));
    const int lane = lane_now(), tid = (wid << 6) | lane, wr = wid >> 2, wc = wid & 3, fr = lane & 15, fq = lane >> 4;
    const int nt = K / BK;
    unsigned voffA[2], voffB[2];
#pragma unroll
    for (int i = 0; i < 2; ++i) { int R, C; stage_rc(tid * 16 + i * 8192, R, C); const int Rb = Epi::PERM ? ((R & ~31) + perm32(R & 31)) : R;
        voffA[i] = (unsigned)(R * K + C) * 2u; voffB[i] = (unsigned)(Rb * K + C) * 2u; }
    const size_t kstep = (size_t)(BK * 2);
    const size_t hstep = (size_t)HALF * K * 2;
    const unsigned ldsw = (unsigned)wid * 1024u;
    const int aoff = lds_byte(wr * 64 + fr, fq * 8), boff = lds_byte(wc * 32 + fr, fq * 8);
#define PG8_SA(b, h) (((b) * 2 + (h)) * HTB)
#define PG8_SB(b, h) ((4 + (b) * 2 + (h)) * HTB)
#define PG8_STAGE(bufoff, gbase, voff) do { _Pragma("unroll") for (int _i = 0; _i < 2; ++_i) \
        __builtin_amdgcn_global_load_lds((const unsigned*)((const char*)(gbase) + (voff)[_i]), (LAS unsigned*)(lds + (bufoff) + ldsw + _i * 8192), 16, 0, 0); } while (0)
#define PG8_STAGE_A(bufoff, gbase, half, nx) do { if constexpr (Sched::GATHER) { _Pragma("unroll") for (int _i = 0; _i < 2; ++_i) { const unsigned _o = (nx) ? nvoA[half][_i] : voA[half][_i]; \
        __builtin_amdgcn_global_load_lds((const unsigned*)((const char*)(gbase) + _o), (LAS unsigned*)(lds + (bufoff) + ldsw + _i * 8192), 16, 0, 0); } } else { PG8_STAGE(bufoff, (gbase) + (half) * hstep, voffA); } } while (0)
#define PG8_LDA(dst, b, h) do { _Pragma("unroll") for (int m = 0; m < 4; ++m) _Pragma("unroll") for (int k = 0; k < 2; ++k) dst[m][k] = *(const LAS bf16x8*)(lds + PG8_SA(b, h) + aoff + m * 2048 + k * 1024); } while (0)
#define PG8_LDB(dst, b, h) do { _Pragma("unroll") for (int n = 0; n < 2; ++n) _Pragma("unroll") for (int k = 0; k < 2; ++k) dst[n][k] = *(const LAS bf16x8*)(lds + PG8_SB(b, h) + boff + n * 2048 + k * 1024); } while (0)
#define PG8_MMA(ai, bj, At, Bt) do { __builtin_amdgcn_s_setprio(1); _Pragma("unroll") for (int m = 0; m < 4; ++m) _Pragma("unroll") for (int n = 0; n < 2; ++n) _Pragma("unroll") for (int k = 0; k < 2; ++k) \
        acc[ai][bj][m][n] = __builtin_amdgcn_mfma_f32_16x16x32_bf16(Bt[n][k], At[m][k], acc[ai][bj][m][n], 0, 0, 0); __builtin_amdgcn_s_setprio(0); } while (0)
#define PG8_WAIT_V(n) asm volatile("s_waitcnt vmcnt(" #n ")" ::: "memory")
#define PG8_WAIT_L(n) asm volatile("s_waitcnt lgkmcnt(" #n ")" ::: "memory")
#define PG8_BAR __builtin_amdgcn_s_barrier()
#define PG8_SCHED __builtin_amdgcn_sched_barrier(0)
    Unit cur, nxt; int ui = 0;
    unsigned voA[2][2] = {{0u, 0u}, {0u, 0u}}, nvoA[2][2] = {{0u, 0u}, {0u, 0u}}; (void)voA; (void)nvoA;
    if (!S.next(0, cur)) return;
    if constexpr (Sched::GATHER) S.offsets(cur, tid, K, voA);
    if constexpr (Sched::DEPS) { S.wait(cur, wid); PG8_BAR; }
    f32x4 acc[2][2][4][2];
    if constexpr (Epi::ACC_INIT) E.init(acc, cur, wr, wc, fr, fq);
    else {
#pragma unroll
    for (int a = 0; a < 2; ++a)
#pragma unroll
        for (int b = 0; b < 2; ++b)
#pragma unroll
            for (int m = 0; m < 4; ++m)
#pragma unroll
                for (int n = 0; n < 2; ++n) acc[a][b][m][n] = (f32x4){0.f, 0.f, 0.f, 0.f}; }
    bf16x8 At[4][2], B0[2][2], B1[2][2];
    const char* cA = cur.A; const char* cB = cur.B;
    PG8_STAGE(PG8_SB(0, 0), cB, voffB); PG8_STAGE(PG8_SB(0, 1), cB + hstep, voffB); PG8_STAGE_A(PG8_SA(0, 0), cA, 0, false); PG8_STAGE_A(PG8_SA(0, 1), cA, 1, false);
    if (wr == 1) PG8_BAR;
    PG8_WAIT_V(2); PG8_BAR;
    PG8_STAGE(PG8_SB(1, 0), cB + kstep, voffB); PG8_STAGE_A(PG8_SA(1, 0), cA + kstep, 0, false); PG8_STAGE(PG8_SB(1, 1), cB + hstep + kstep, voffB);
    PG8_WAIT_V(6); PG8_BAR;
    for (;;) {
        const bool has_next = S.next(ui + 1, nxt);
        if constexpr (Sched::GATHER) { if (has_next) S.offsets(nxt, tid, K, nvoA); }
        const char* nA = has_next ? nxt.A : cA; const char* nB = has_next ? nxt.B : cB;
#pragma nounroll
        for (int t = 0; t < nt; t += 2) {
            const bool last = (t == nt - 2);
            if constexpr (Sched::DEPS) { if (last && has_next) S.wait(nxt, wid); }
            const char* a1 = cA + (size_t)(t + 1) * kstep;
            const char* a2 = last ? nA : cA + (size_t)(t + 2) * kstep; const char* b2 = last ? nB : cB + (size_t)(t + 2) * kstep;
            const char* a3 = a2 + kstep; const char* b3 = b2 + kstep;
            PG8_LDB(B0, 0, 0); PG8_LDB(B1, 0, 1); PG8_SCHED; PG8_LDA(At, 0, 0); PG8_STAGE_A(PG8_SA(1, 1), a1, 1, false);
            PG8_WAIT_V(8); PG8_WAIT_L(0); PG8_BAR; PG8_MMA(0, 0, At, B0); PG8_MMA(0, 1, At, B1); PG8_BAR; PG8_SCHED;
            PG8_LDA(At, 0, 1); PG8_STAGE(PG8_SB(0, 0), b2, voffB); PG8_STAGE(PG8_SB(0, 1), b2 + hstep, voffB); PG8_STAGE_A(PG8_SA(0, 0), a2, 0, last);
            PG8_WAIT_V(8); PG8_WAIT_L(0); PG8_BAR; PG8_MMA(1, 0, At, B0); PG8_MMA(1, 1, At, B1); PG8_BAR; PG8_SCHED;
            PG8_LDB(B0, 1, 0); PG8_LDB(B1, 1, 1); PG8_SCHED; PG8_LDA(At, 1, 0); PG8_STAGE_A(PG8_SA(0, 1), a2, 1, last);
            PG8_WAIT_V(8); PG8_WAIT_L(0); PG8_BAR; PG8_MMA(0, 0, At, B0); PG8_MMA(0, 1, At, B1); PG8_BAR; PG8_SCHED;
            PG8_LDA(At, 1, 1); PG8_STAGE(PG8_SB(1, 0), b3, voffB); PG8_STAGE(PG8_SB(1, 1), b3 + hstep, voffB); PG8_STAGE_A(PG8_SA(1, 0), a3, 0, last);
            PG8_WAIT_V(8); PG8_WAIT_L(0); PG8_BAR; PG8_MMA(1, 0, At, B0); PG8_MMA(1, 1, At, B1); PG8_BAR; PG8_SCHED;
        }
        if (wr == 0) PG8_BAR;
        E(acc, cur, wr, wc, fr, fq);
        if constexpr (Epi::SIGNAL) { PG8_WAIT_V(0); PG8_BAR; if (tid == 0) E.signal(cur); }
        if (!has_next) break;
        if constexpr (Epi::ACC_INIT) E.init(acc, nxt, wr, wc, fr, fq);
        else {
#pragma unroll
        for (int a = 0; a < 2; ++a)
#pragma unroll
            for (int b = 0; b < 2; ++b)
#pragma unroll
                for (int m = 0; m < 4; ++m)
#pragma unroll
                    for (int n = 0; n < 2; ++n) acc[a][b][m][n] = (f32x4){0.f, 0.f, 0.f, 0.f}; }
        cur = nxt; cA = nA; cB = nB; ++ui;
        if constexpr (Sched::GATHER) { voA[0][0] = nvoA[0][0]; voA[0][1] = nvoA[0][1]; voA[1][0] = nvoA[1][0]; voA[1][1] = nvoA[1][1]; }
        if (wr == 1) PG8_BAR;
    }
    PG8_WAIT_V(0);
    PG8_BAR;
#undef PG8_SA
#undef PG8_SB
#undef PG8_STAGE
#undef PG8_STAGE_A
#undef PG8_LDA
#undef PG8_LDB
#undef PG8_MMA
#undef PG8_WAIT_V
#undef PG8_WAIT_L
#undef PG8_BAR
#undef PG8_SCHED
}
}

__device__ __forceinline__ void phase_gemm_pe(const Frame& F) {
    pg8::DenseOrder S; S.init(F.ws + WS_PB, F.ws + WS_WPE, T, D, PD, DEPTH, F.G, F.blk); pg8::EpiBf16 E{(bf16*)(F.ws + WS_PE), D};
    pg8::gemm_phase(F.wave, F.lds, PD, S, E);
}
__device__ __forceinline__ void phase_gemm_in(const Frame& F, int l) {
    pg8::DenseOrder S; S.init(F.ws + WS_H, (bf16*)(F.ws + WS_WIN) + (size_t)l * DIN * D, T, DIN, D, 1, F.G, F.blk); pg8::EpiBf16Rs E{(bf16*)(F.ws + WS_Z), DIN, (const float*)(F.ws + MS_RSTD1), l > 0 ? (const float*)(F.ws + MS_PART) : (const float*)nullptr};
    pg8::gemm_phase(F.wave, F.lds, D, S, E);
}
__device__ __forceinline__ void phase_gemm_out(const Frame& F, int l) {
    pg8::DenseOrder S; S.init(F.ws + WS_O, (bf16*)(F.ws + WS_WOUT) + (size_t)l * D * D, T, D, D, 1, F.G, F.blk); pg8::EpiResid E{(bf16*)(F.ws + WS_H)};
    pg8::gemm_phase(F.wave, F.lds, D, S, E);
}
__device__ __forceinline__ void phase_gemm_moe1(const Frame& F, int l) {
    pg8::MoeOrder S; S.init(F.ws + WS_XB, (bf16*)(F.ws + WS_WGU) + (size_t)l * NE * 1024 * 1024, (const int*)(F.ws + MS_BLKE) + l * 256, D, 4, (size_t)1024 * 1024 * 2, F.G, F.blk); pg8::EpiGateUp E{(bf16*)(F.ws + WS_HB)};
    pg8::gemm_phase(F.wave, F.lds, D, S, E);
    { const int nun = S.nrb * 4, rem = nun % F.G, few = (rem == 0 || F.G - rem < 64), idle = few ? F.G : F.G - rem, first = few ? 0 : rem;
      if (F.blk >= first) { pg8::DenseOrder P; P.init((const bf16*)(F.ws + WS_PB) + (size_t)l * T * PD, (const bf16*)(F.ws + WS_WPE) + (size_t)l * D * PD, T, D, PD, 1, idle, F.blk - first);
          pg8::EpiBf16 EP{(bf16*)(F.ws + WS_PE) + (size_t)l * T * D, D}; pg8::gemm_phase(F.wave, F.lds, PD, P, EP); }
      conv_deferred(F, l + 1, 0, NDEF1, first, idle); }
}
__device__ __forceinline__ void phase_gemm_moe2(const Frame& F, int l) {
    pg8::MoeOrder S; S.init(F.ws + WS_HB, (bf16*)(F.ws + WS_WD) + (size_t)l * NE * D * DE, (const int*)(F.ws + MS_BLKE) + l * 256, DE, 4, (size_t)D * DE * 2, F.G, F.blk); pg8::EpiBf16 E{(bf16*)(F.ws + WS_Y), D};
    pg8::gemm_phase(F.wave, F.lds, DE, S, E);
    { const int nun = S.nrb * 4, rem = nun % F.G, few = (rem == 0 || F.G - rem < 64), idle = few ? F.G : F.G - rem, first = few ? 0 : rem;
      conv_deferred(F, l + 1, NDEF1, NDEF, first, idle); }
}
#ifndef MOE_CPE
#define MOE_CPE 5
#endif
#ifndef MOE_CTL
#define MOE_CTL 4
#endif
#ifndef MOE_X1
#define MOE_X1 16
#define MOE_X2 8
#endif
template <int MODE = 0> __device__ __forceinline__ void phase_moe_fused(const Frame& F, int l) {
    unsigned char* ws = F.ws; const int G = F.G, blk = (MOE_VBLK && F.G == 256) ? vblk(F.blk) : F.blk;
    const int* blke = (const int*)(ws + MS_BLKE) + l * 256;
    unsigned* done = (unsigned*)(ws + WS_CTL) + CW_DONE + l * 256;
    const int nrb = __builtin_amdgcn_readfirstlane(blke[255]), nu = 4 * nrb, e1 = nu % G;
    if constexpr (MODE == 1) { pg8::MoeOrder S; S.init(ws + WS_XB, (bf16*)(ws + WS_WGU) + (size_t)l * NE * 1024 * 1024, blke, D, 4, (size_t)1024 * 1024 * 2, G, blk);
      pg8::EpiGateUp E{(bf16*)(ws + WS_HB)}; pg8::gemm_phase(F.wave, F.lds, D, S, E); return; }
    if constexpr (MODE == 0) { pg8::MoeGatherOrder S; S.init(ws + WS_H, (bf16*)(ws + WS_WGU) + (size_t)l * NE * 1024 * 1024, blke, (const int*)(ws + MS_TOKOF), D, 4, (size_t)1024 * 1024 * 2, G, blk);
      pg8::EpiGateUpPub E{__builtin_amdgcn_make_buffer_rsrc(ws + WS_HB, 0, (int)((size_t)CAP * DE * 2), 0x00020000), done, (const float*)(ws + MS_RSSLOT)};
      pg8::gemm_phase(F.wave, F.lds, D, S, E); }
    if constexpr (MODE == 2) { pg8::MoeOrder S; S.init(ws + WS_HB, (bf16*)(ws + WS_WD) + (size_t)l * NE * D * DE, blke, DE, 4, (size_t)D * DE * 2, G, blk >= e1 ? blk - e1 : blk - e1 + G);
      pg8::EpiBf16 E{(bf16*)(ws + WS_Y), D}; pg8::gemm_phase(F.wave, F.lds, DE, S, E); }
    if constexpr (MODE == 0) { pg8::MoeDepOrder S; S.init(ws + WS_HB, (bf16*)(ws + WS_WD) + (size_t)l * NE * D * DE, blke, done, DE, 4, (size_t)D * DE * 2, G, blk >= e1 ? blk - e1 : blk - e1 + G);
      pg8::EpiBf16 E{(bf16*)(ws + WS_Y), D};
      pg8::gemm_phase(F.wave, F.lds, DE, S, E); }
    { const int nt = (l + 1 < DEPTH) ? NDEF : 0, ftot = 256 * MOE_CPE + nt * MOE_CTL;
      const int wrap = 2 * e1 > G ? 2 * e1 - G : 0;
      auto cls = [&](int x, int& c24, int& c16, int& c8, int& c0) {
          const int cA = x < e1 ? x : e1, cAB = x < wrap ? x : wrap;
          int cB = x - e1; cB = cB < 0 ? 0 : cB; if (!wrap) cB = cB > e1 ? e1 : cB; cB += cAB;
          c24 = cAB; c16 = cA - cAB; c8 = cB - cAB; c0 = x - c24 - c16 - c8; };
      auto fill = [&](int x, int lv) { int c24, c16, c8, c0; cls(x, c24, c16, c8, c0);
          return c0 * lv + c8 * (lv > MOE_X2 ? lv - MOE_X2 : 0) + c16 * (lv > MOE_X1 ? lv - MOE_X1 : 0) + c24 * (lv > MOE_X1 + MOE_X2 ? lv - MOE_X1 - MOE_X2 : 0); };
      int lv = 1; while (fill(G, lv) < ftot) ++lv;
      const int B0 = fill(blk, lv), B1 = fill(blk + 1, lv);
      const int pe_tot = 256 * MOE_CPE;
      int j0 = (B0 + MOE_CPE - 1) / MOE_CPE, j1 = (B1 + MOE_CPE - 1) / MOE_CPE; j0 = j0 < 256 ? j0 : 256; j1 = j1 < 256 ? j1 : 256;
      int t0 = B0 > pe_tot ? (B0 - pe_tot + MOE_CTL - 1) / MOE_CTL : 0, t1 = B1 > pe_tot ? (B1 - pe_tot + MOE_CTL - 1) / MOE_CTL : 0; t0 = t0 < nt ? t0 : nt; t1 = t1 < nt ? t1 : nt;
      if (j1 > j0) { pg8::RangeOrder P; P.init((const bf16*)(ws + WS_PB) + (size_t)l * T * PD, (const bf16*)(ws + WS_WPE) + (size_t)l * D * PD, T, D, PD, j0, j1 - j0);
          pg8::EpiBf16 EP{(bf16*)(ws + WS_PE) + (size_t)l * T * D, D}; pg8::gemm_phase(F.wave, F.lds, PD, P, EP); }
      if (t1 > t0) { const int base = (l + 1) * TL_LAYER + t0; conv_run(F, 0, 1, t1 - t0, [=](int f) { return base + f; }); } }
}
__device__ __forceinline__ void phase_gemm_pg(const Frame& F, int l) {
    pg8::DenseOrder S; S.init(F.ws + WS_XN, (bf16*)(F.ws + WS_WPG) + (size_t)l * D * D, T, D, D, 1, F.G, F.blk);
    pg8::EpiPG E{(bf16*)(F.ws + WS_H), (const bf16*)(F.ws + WS_XN), (const float*)(F.ws + MS_RSTD3), (const bf16*)(F.ws + WS_PE) + (size_t)l * T * D, (const float*)(F.ws + MS_RSTDPE), F.in[22] + l * D, (LAS float*)(F.lds + MISC_OFF + 4096), (float*)(F.ws + MS_PART)};
    pg8::gemm_phase(F.wave, F.lds, D, S, E);
}

typedef short s16x4 __attribute__((ext_vector_type(4)));
__device__ __forceinline__ bf16x8 tr_frag(LAS unsigned char* p_lo, LAS unsigned char* p_hi) {
    const s16x4 lo = __builtin_amdgcn_ds_read_tr16_b64_v4i16((LAS s16x4*)p_lo), hi = __builtin_amdgcn_ds_read_tr16_b64_v4i16((LAS s16x4*)p_hi);
    return __builtin_shufflevector(lo, hi, 0, 1, 2, 3, 4, 5, 6, 7); }
#define MFMA16(a, b, c) __builtin_amdgcn_mfma_f32_16x16x32_bf16((a), (b), (c), 0, 0, 0)
constexpr int RP = 272;
constexpr int VP = 1040;

__device__ __forceinline__ void phase_rec_c1(const Frame& F, int l) {
    PH_TID();
    unsigned char* ws = F.ws; const bf16* Z = (const bf16*)(ws + WS_Z);
    bf16* UT = (bf16*)(ws + WS_UT); float* DC = (float*)(ws + MS_DC); float* MM = (float*)(ws + MS_MM);
    const float* lb = (const float*)(ws + MS_LB) + l * DREC;
    LAS unsigned char* KD = F.lds; LAS unsigned char* IM = F.lds + 128 * RP; LAS float* totx = (LAS float*)(F.lds + 256 * RP);
    const int wave = ph_wave, ch = tid & 255, half = tid >> 8, hl = ch >> 7, k = ch & 127, g = lane >> 4, li = lane & 15, q = li >> 2, p = li & 3;
    const int hG = F.G / 2, nmine = (F.G == 256) ? (F.blk < hG ? 4 : 0) : (F.blk < 512 ? (512 - F.blk + F.G - 1) / F.G : 0);
    const int ustep = (F.G == 256) ? hG : F.G;
    u32x4 pf[4], pi[4];
    auto fetch = [&](int unit) { const int c = unit >> 1, hp = unit & 1;
#pragma unroll
        for (int j = 0; j < 4; ++j) { const int idx = tid + 512 * j, hl2 = idx >> 10, row = (idx >> 4) & 63, cc = idx & 15;
            const bf16* src = Z + (size_t)(c * 64 + row) * DIN + 512 + (2 * hp + hl2) * 128 + cc * 8; pf[j] = *(const u32x4*)src; pi[j] = *(const u32x4*)(src + 512); } };
    if (nmine > 0) fetch(F.blk);
    for (int ui = 0; ui < nmine; ++ui) {
        const int unit = F.blk + ui * ustep;
        const int c = unit >> 1, hp = unit & 1, hh = 2 * hp + hl;
#pragma unroll
        for (int j = 0; j < 4; ++j) { const int idx = tid + 512 * j, hl2 = idx >> 10, row = (idx >> 4) & 63, cc = idx & 15; const int dst = (hl2 * 64 + row) * RP + cc * 16;
            *(LAS u32x4*)(KD + dst) = pf[j]; *(LAS u32x4*)(IM + dst) = pi[j]; }
        __syncthreads();
        if (ui + 1 < nmine) fetch(unit + ustep);
        const float lbk = lb[hh * 128 + k];
        float cs[32], kk[32]; float run = 1.f;
#pragma unroll
        for (int t = 0; t < 32; ++t) { const float fz = bf2f(*(const LAS bf16*)(KD + (hl * 64 + 32 * half + t) * RP + 2 * k)); const float sg = sigmoid_(fz); run *= lbk + (1.f - lbk) * sg; cs[t] = run; kk[t] = (1.f - lbk) * (1.f - sg); }
        totx[half * 256 + ch] = run;
        __syncthreads();
        const float other = totx[(1 - half) * 256 + ch]; const float p63 = run * other; const float base_p = half == 0 ? p63 : run;
#pragma unroll
        for (int t = 0; t < 32; ++t) *(LAS bf16*)(KD + (hl * 64 + 32 * half + t) * RP + 2 * k) = (bf16)f2bf(kk[t] * base_p * frcp(fmaxf(cs[t], 1e-30f)));
        if (half == 0) { DC[(c * 4 + hh) * 128 + k] = p63; MM[(c * 4 + hh) * 128 + k] = run; }
        __syncthreads();
        { const int whl = wave >> 2, kt0 = 2 * (wave & 3), whh = 2 * hp + whl;
          f32x4 acc[2][8];
#pragma unroll
          for (int i = 0; i < 2; ++i)
#pragma unroll
              for (int vt = 0; vt < 8; ++vt) acc[i][vt] = (f32x4){0.f, 0.f, 0.f, 0.f};
          LAS unsigned char* kdb = KD + whl * 64 * RP; LAS unsigned char* imb = IM + whl * 64 * RP;
#pragma unroll
          for (int a = 0; a < 2; ++a) { const unsigned ro = (unsigned)((32 * a + 8 * g + q) * RP);
              bf16x8 Af[2];
#pragma unroll
              for (int i = 0; i < 2; ++i) { const unsigned co = (unsigned)((16 * (kt0 + i) + 4 * p) * 2); Af[i] = tr_frag(kdb + ro + co, kdb + ro + 4 * RP + co); }
#pragma unroll
              for (int vt = 0; vt < 8; ++vt) { const unsigned co = (unsigned)((16 * vt + 4 * p) * 2); const bf16x8 Bf = tr_frag(imb + ro + co, imb + ro + 4 * RP + co);
#pragma unroll
                  for (int i = 0; i < 2; ++i) acc[i][vt] = MFMA16(Af[i], Bf, acc[i][vt]); } }
#pragma unroll
          for (int i = 0; i < 2; ++i)
#pragma unroll
              for (int vt = 0; vt < 8; ++vt) { u32x2 w; w.x = pg8::cvt_pk_bf16(acc[i][vt][0], acc[i][vt][1]); w.y = pg8::cvt_pk_bf16(acc[i][vt][2], acc[i][vt][3]);
                  *(u32x2*)(UT + ((size_t)(c * 4 + whh) * 128 + 16 * vt + li) * 128 + 16 * (kt0 + i) + 4 * g) = w; } }
        __syncthreads();
    }
}
__device__ __forceinline__ void phase_rec_c2a(const Frame& F) {
    PH_TID();
    unsigned char* ws = F.ws; const unsigned* UT = (const unsigned*)(ws + WS_UT); const float* DC = (const float*)(ws + MS_DC);
    f32x2* LT = (f32x2*)(ws + WS_LTOT); float* PT = (float*)(ws + MS_PTOT);
    for (int it = F.blk * NTHR + tid; it < 16 * 32768; it += F.G * NTHR) {
        const int gs = it >> 15, e = it & 32767, hh = e >> 13, v = (e >> 6) & 127, k0 = 2 * (e & 63);
        float S0 = 0.f, S1 = 0.f, P0 = 1.f, P1 = 1.f;
#pragma unroll
        for (int cc = 0; cc < 16; ++cc) { const int c = 16 * gs + cc; const unsigned u = UT[(size_t)c * 32768 + e]; const f32x2 d = *(const f32x2*)(DC + (c * 4 + hh) * 128 + k0);
            S0 = d.x * S0 + bflo(u); S1 = d.y * S1 + bfhi(u); P0 *= d.x; P1 *= d.y; }
        LT[it] = (f32x2){S0, S1};
        if (v == 0) *(f32x2*)(PT + (gs * 4 + hh) * 128 + k0) = (f32x2){P0, P1};
    }
}
__device__ __forceinline__ void phase_rec_c2c(const Frame& F) {
    PH_TID();
    unsigned char* ws = F.ws; const unsigned* UT = (const unsigned*)(ws + WS_UT); unsigned* ST = (unsigned*)(ws + WS_ST); const float* DC = (const float*)(ws + MS_DC); const float* MM = (const float*)(ws + MS_MM);
    const f32x2* LT = (const f32x2*)(ws + WS_LTOT); const float* PT = (const float*)(ws + MS_PTOT);
    for (int it = F.blk * NTHR + tid; it < 16 * 32768; it += F.G * NTHR) {
        const int gs = it >> 15, e = it & 32767, hh = e >> 13, k0 = 2 * (e & 63);
        float C0 = 0.f, C1 = 0.f;
        for (int g2 = 0; g2 < gs; ++g2) { const f32x2 pt = *(const f32x2*)(PT + (g2 * 4 + hh) * 128 + k0); const f32x2 lt = LT[g2 * 32768 + e]; C0 = pt.x * C0 + lt.x; C1 = pt.y * C1 + lt.y; }
#pragma unroll
        for (int cc = 0; cc < 16; ++cc) { const int c = 16 * gs + cc; const f32x2 mm = *(const f32x2*)(MM + (c * 4 + hh) * 128 + k0);
            ST[(size_t)c * 32768 + e] = pk2(C0 * mm.x, C1 * mm.y);
            const unsigned u = UT[(size_t)c * 32768 + e]; const f32x2 d = *(const f32x2*)(DC + (c * 4 + hh) * 128 + k0);
            C0 = d.x * C0 + bflo(u); C1 = d.y * C1 + bfhi(u); }
    }
}
__device__ __forceinline__ void phase_rec_c2(const Frame& F) {
    PH_TID();
    unsigned char* ws = F.ws; const int w = ph_wave;
    LAS float* tot = (LAS float*)F.lds;
    for (int unit = F.blk; unit < 256; unit += F.G) {
        const int hh = unit >> 6; const unsigned eo = (unsigned)(unit * 128 + lane), ko = (unsigned)(hh * 128 + 2 * lane);
        const unsigned* ut = (const unsigned*)(ws + WS_UT) + (size_t)(32 * w) * 32768; unsigned* st = (unsigned*)(ws + WS_ST) + (size_t)(32 * w) * 32768;
        const float* dc = (const float*)(ws + MS_DC) + (32 * w) * 512; const float* mmp = (const float*)(ws + MS_MM) + (32 * w) * 512;
        asm volatile("" : "+s"(ut), "+s"(st), "+s"(dc), "+s"(mmp));
        unsigned ua[32], ub[32]; f32x2 d[32], m0[16], m1[16];
#pragma unroll
        for (int cc = 0; cc < 32; ++cc) { ua[cc] = (ut + cc * 32768)[eo]; ub[cc] = (ut + cc * 32768 + 64)[eo]; d[cc] = *(const f32x2*)((dc + cc * 512) + ko); }
        __builtin_amdgcn_sched_barrier(0);
        float a0 = 0.f, a1 = 0.f, b0 = 0.f, b1 = 0.f, p0 = 1.f, p1 = 1.f;
#pragma unroll
        for (int cc = 0; cc < 32; ++cc) { a0 = d[cc].x * a0 + bflo(ua[cc]); a1 = d[cc].y * a1 + bfhi(ua[cc]); b0 = d[cc].x * b0 + bflo(ub[cc]); b1 = d[cc].y * b1 + bfhi(ub[cc]); p0 *= d[cc].x; p1 *= d[cc].y; }
        { LAS float* tw = tot + w * 384 + lane; tw[0] = a0; tw[64] = a1; tw[128] = b0; tw[192] = b1; tw[256] = p0; tw[320] = p1; }
        __builtin_amdgcn_sched_barrier(0);
#pragma unroll
        for (int cc = 0; cc < 16; ++cc) m0[cc] = *(const f32x2*)((mmp + cc * 512) + ko);
        __builtin_amdgcn_sched_barrier(0);
        __syncthreads();
        float A0 = 0.f, A1 = 0.f, B0 = 0.f, B1 = 0.f;
        for (int g2 = 0; g2 < w; ++g2) { const LAS float* tw = tot + g2 * 384 + lane; const float q0 = tw[256], q1 = tw[320]; A0 = q0 * A0 + tw[0]; A1 = q1 * A1 + tw[64]; B0 = q0 * B0 + tw[128]; B1 = q1 * B1 + tw[192]; }
        __builtin_amdgcn_sched_barrier(0);
#pragma unroll
        for (int cc = 0; cc < 16; ++cc) m1[cc] = *(const f32x2*)((mmp + (16 + cc) * 512) + ko);
        __builtin_amdgcn_sched_barrier(0);
#pragma unroll
        for (int cc = 0; cc < 32; ++cc) { const f32x2 mm = cc < 16 ? m0[cc & 15] : m1[cc & 15];
            (st + cc * 32768)[eo] = pk2(A0 * mm.x, A1 * mm.y); (st + cc * 32768 + 64)[eo] = pk2(B0 * mm.x, B1 * mm.y);
            unsigned xa = ua[cc], xb = ub[cc]; asm volatile("" : "+v"(xa), "+v"(xb));
            A0 = d[cc].x * A0 + bflo(xa); A1 = d[cc].y * A1 + bfhi(xa); B0 = d[cc].x * B0 + bflo(xb); B1 = d[cc].y * B1 + bfhi(xb);
            asm volatile("" : "+v"(A0), "+v"(A1), "+v"(B0), "+v"(B1) :: "memory"); }
        __syncthreads();
    }
}
template <int PV = 0> __device__ __forceinline__ void phase_rec_c3(const Frame& F, int l) {
    PH_TID();
    unsigned char* ws = F.ws; const bf16* Z = (const bf16*)(ws + WS_Z); const bf16* ST = (const bf16*)(ws + WS_ST); bf16* O = (bf16*)(ws + WS_O);
    const float* lb = (const float*)(ws + MS_LB) + l * DREC; const float* ogain = F.in[5] + l * 128;
    LAS unsigned char* QT = F.lds; LAS unsigned char* KT = F.lds + 128 * RP; LAS unsigned char* IM = F.lds + 256 * RP;
    const int wave = ph_wave, ch = tid & 255, half = tid >> 8, hl = ch >> 7, k = ch & 127, g = lane >> 4, li = lane & 15, q = li >> 2, p = li & 3;
    u32x4 pq[4], pf[4];
    const unsigned tvo = (unsigned)((tid >> 4) * DIN + (tid & 15) * 8), tlo = (unsigned)((tid >> 4) * RP + (tid & 15) * 16);
    auto fetch = [&](int unit) { const bf16* zc = Z + (size_t)(unit >> 1) * 64 * DIN + (unit & 1) * 256;
#pragma unroll
        for (int j = 0; j < 4; ++j) { const bf16* src = zc + (32 * (j & 1)) * DIN + (j >> 1) * 128; pq[j] = *(const u32x4*)(src + tvo); pf[j] = *(const u32x4*)(src + 512 + tvo); } };
    if (F.blk < 512) fetch(F.blk);
    for (int unit = F.blk; unit < 512; unit += F.G) {
        const int c = unit >> 1, hp = unit & 1, hh = 2 * hp + hl;
#pragma unroll
        for (int j = 0; j < 4; ++j) { const int dst = ((j >> 1) * 64 + 32 * (j & 1)) * RP;
            *(LAS u32x4*)(QT + dst + tlo) = pq[j]; *(LAS u32x4*)(KT + dst + tlo) = pf[j]; }
        u32x4 vi[4];
        { const bf16* zc = Z + (size_t)c * 64 * DIN + hp * 256 + 1024;
#pragma unroll
          for (int j = 0; j < 4; ++j) vi[j] = *(const u32x4*)(zc + (32 * (j & 1)) * DIN + (j >> 1) * 128 + tvo); }
        __syncthreads();
        { const float lbk = lb[hh * 128 + k]; const int col = (hl * 64 + 32 * half) * RP + 2 * k;
          float cs[32], kk[32], qs[32]; float run = 1.f;
#pragma unroll
          for (int t = 0; t < 32; ++t) { const float fz = bf2f(*(const LAS bf16*)(KT + col + t * RP)); const float sg = sigmoid_(fz); run *= lbk + (1.f - lbk) * sg; cs[t] = run; kk[t] = (1.f - lbk) * (1.f - sg);
              qs[t] = silu_(bf2f(*(const LAS bf16*)(QT + col + t * RP))); }
          const float inv = half == 0 ? frcp(fmaxf(run, 1e-30f)) : 1.f;
#pragma unroll
          for (int t = 0; t < 32; ++t) { const float ex = cs[t] * inv; const int off = col + t * RP;
              *(LAS bf16*)(QT + off) = (bf16)f2bf(qs[t] * ex); *(LAS bf16*)(KT + off) = (bf16)f2bf(kk[t] * frcp(fmaxf(ex, 1e-30f))); } }
#pragma unroll
        for (int j = 0; j < 4; ++j) *(LAS u32x4*)(IM + ((j >> 1) * 64 + 32 * (j & 1)) * RP + tlo) = vi[j];
        const int whl = wave >> 2, tt = wave & 3, whh = 2 * hp + whl;
        bf16x8 Sf[8][4];
#pragma unroll
        for (int vt = 0; vt < 8; ++vt)
#pragma unroll
            for (int a = 0; a < 4; ++a) Sf[vt][a] = *(const bf16x8*)(ST + ((size_t)(c * 4 + whh) * 128 + 16 * vt + li) * 128 + 32 * a + 8 * g);
        __syncthreads();
        if (PV != 1) {
          bf16 gz[8][4];
#pragma unroll
          for (int vt = 0; vt < 8; ++vt)
#pragma unroll
              for (int r = 0; r < 4; ++r) gz[vt][r] = Z[((size_t)c * 64 + 16 * tt + 4 * g + r) * DIN + 1536 + whh * 128 + 16 * vt + li];
          bf16x8 Qf[4];
#pragma unroll
          for (int a = 0; a < 4; ++a) Qf[a] = *(const LAS bf16x8*)(QT + (whl * 64 + 16 * tt + li) * RP + (32 * a + 8 * g) * 2);
          unsigned pw[4][2];
#pragma unroll
          for (int st = 0; st < 4; ++st) { pw[st][0] = 0u; pw[st][1] = 0u;
              { f32x4 s = (f32x4){0.f, 0.f, 0.f, 0.f};
#pragma unroll
                  for (int a = 0; a < 4; ++a) { const bf16x8 Kf = *(const LAS bf16x8*)(KT + (whl * 64 + 16 * st + li) * RP + (32 * a + 8 * g) * 2); s = MFMA16(Kf, Qf[a], s); }
                  if (st == tt) {
#pragma unroll
                      for (int r = 0; r < 4; ++r) if (4 * g + r > li) s[r] = 0.f; }
                  pw[st][0] = st <= tt ? pg8::cvt_pk_bf16(s[0], s[1]) : 0u; pw[st][1] = st <= tt ? pg8::cvt_pk_bf16(s[2], s[3]) : 0u; } }
          f32x4 acc[8];
#pragma unroll
          for (int vt = 0; vt < 8; ++vt) { acc[vt] = (f32x4){0.f, 0.f, 0.f, 0.f};
#pragma unroll
              for (int a = 0; a < 4; ++a) acc[vt] = MFMA16(Qf[a], Sf[vt][a], acc[vt]); }
          __builtin_amdgcn_sched_barrier(0);
          if (unit + F.G < 512) fetch(unit + F.G);
          __builtin_amdgcn_sched_barrier(0);
          LAS unsigned char* imb = IM + whl * 64 * RP;
#pragma unroll
          for (int a = 0; a < 2; ++a) { const u32x4 pv = (u32x4){pw[2 * a][0], pw[2 * a][1], pw[2 * a + 1][0], pw[2 * a + 1][1]}; const bf16x8 Pf = __builtin_bit_cast(bf16x8, pv);
              const unsigned ro = (unsigned)((32 * a + 4 * g + q) * RP);
#pragma unroll
              for (int vt = 0; vt < 8; ++vt) { const unsigned co = (unsigned)((16 * vt + 4 * p) * 2); const bf16x8 If = tr_frag(imb + ro + co, imb + ro + 16 * RP + co); acc[vt] = MFMA16(Pf, If, acc[vt]); } }
          float rs[4];
#pragma unroll
          for (int r = 0; r < 4; ++r) { float ss = 0.f;
#pragma unroll
              for (int vt = 0; vt < 8; ++vt) ss += acc[vt][r] * acc[vt][r];
              ss += shx<1>(ss); ss += shx<2>(ss); ss += shx<4>(ss); ss += shx<8>(ss); rs[r] = frsq(ss * (1.f / 128.f) + EPS); }
#pragma unroll
          for (int vt = 0; vt < 8; ++vt) { const float og = ogain[16 * vt + li];
#pragma unroll
              for (int r = 0; r < 4; ++r) { const size_t t = (size_t)c * 64 + 16 * tt + 4 * g + r; const float gv = bf2f(gz[vt][r]);
                  O[t * D + whh * 128 + 16 * vt + li] = (bf16)f2bf(acc[vt][r] * rs[r] * og * silu_(gv)); } } }
        __syncthreads();
    }
}
__device__ __forceinline__ void phase_sgu(const Frame& F, int l) {
    PH_TID();
    unsigned char* ws = F.ws; const bf16* Z = (const bf16*)(ws + WS_Z); bf16* O = (bf16*)(ws + WS_O);
    const bf16* Wb = (const bf16*)(ws + MS_SGUW) + (size_t)l * 4 * 128 * 128; const float* sb = F.in[9] + l * 4 * 128;
    LAS unsigned char* VN = F.lds;
    const int wave = ph_wave, g = lane >> 4, li = lane & 15, q = li >> 2, p = li & 3;
    for (int unit = (F.blk + F.G / 2) % F.G; unit < 128; unit += F.G) {
        float lg[8], lbv[8];
#pragma unroll
        for (int j = 0; j < 8; ++j) { lg[j] = F.in[6][l * DSGU + 8 * lane + j]; lbv[j] = F.in[7][l * DSGU + 8 * lane + j]; }
        u32x4 raw[16];
#pragma unroll
        for (int i = 0; i < 16; ++i) raw[i] = *(const u32x4*)(Z + ((size_t)unit * 128 + 16 * wave + i) * DIN + 2560 + 8 * lane);
#pragma unroll
        for (int i = 0; i < 16; ++i) { const int s = 16 * wave + i; const u32x4 r = raw[i];
            float x[8] = {gelu_(bflo(r.x)), gelu_(bfhi(r.x)), gelu_(bflo(r.y)), gelu_(bfhi(r.y)), gelu_(bflo(r.z)), gelu_(bfhi(r.z)), gelu_(bflo(r.w)), gelu_(bfhi(r.w))};
            float sm = 0.f, qq = 0.f;
#pragma unroll
            for (int j = 0; j < 8; ++j) { sm += x[j]; qq += x[j] * x[j]; }
            sm += shx<1>(sm); qq += shx<1>(qq); sm += shx<2>(sm); qq += shx<2>(qq); sm += shx<4>(sm); qq += shx<4>(qq); sm += shx<8>(sm); qq += shx<8>(qq); sm += shx<16>(sm); qq += shx<16>(qq);
            const float mu = halves_sum(sm) * (1.f / 512.f); const float var = fmaxf(halves_sum(qq) * (1.f / 512.f) - mu * mu, 0.f);
            const float rstd = frsq(var + EPS);
#pragma unroll
            for (int j = 0; j < 8; ++j) x[j] = (x[j] - mu) * rstd * lg[j] + lbv[j];
            u32x4 o; o.x = pk2(x[0], x[1]); o.y = pk2(x[2], x[3]); o.z = pk2(x[4], x[5]); o.w = pk2(x[6], x[7]);
            *(LAS u32x4*)(VN + s * VP + lane * 16) = o; }
        __syncthreads();
        { const int hh = wave >> 1, dh = wave & 1; const bf16* W = Wb + (size_t)hh * 128 * 128;
          LAS unsigned char* vnb = VN;
#pragma unroll 1
          for (int dp = 0; dp < 2; ++dp) {
          bf16x8 Wf[2][8];
#pragma unroll
          for (int a = 0; a < 2; ++a)
#pragma unroll
              for (int ti = 0; ti < 8; ++ti) if (ti >= 2 * a) Wf[a][ti] = *(const bf16x8*)(W + (size_t)(16 * ti + li) * 128 + 32 * a + 8 * g);
          u32x2 uu[8][2]; float bs[8];
#pragma unroll
          for (int ti = 0; ti < 8; ++ti) { bs[ti] = sb[hh * 128 + 16 * ti + li];
#pragma unroll
              for (int dt = 0; dt < 2; ++dt) uu[ti][dt] = *(const u32x2*)(Z + ((size_t)unit * 128 + 16 * ti + li) * DIN + 2048 + hh * 128 + 64 * dh + 16 * (2 * dp + dt) + 4 * g); }
          f32x4 acc[2][8];
#pragma unroll
          for (int dt = 0; dt < 2; ++dt)
#pragma unroll
              for (int ti = 0; ti < 8; ++ti) acc[dt][ti] = (f32x4){0.f, 0.f, 0.f, 0.f};
#pragma unroll
          for (int a = 0; a < 4; ++a) { const unsigned ro = (unsigned)((32 * a + 8 * g + q) * VP);
              bf16x8 Af[2];
#pragma unroll
              for (int dt = 0; dt < 2; ++dt) { const unsigned co = (unsigned)((hh * 128 + 64 * dh + 16 * (2 * dp + dt) + 4 * p) * 2); Af[dt] = tr_frag(vnb + ro + co, vnb + ro + 4 * VP + co); }
#pragma unroll
              for (int ti = 0; ti < 8; ++ti) if (ti >= 2 * a) {
                  const bf16x8 Bf = a < 2 ? Wf[a < 2 ? a : 0][ti] : *(const bf16x8*)(W + (size_t)(16 * ti + li) * 128 + 32 * a + 8 * g);
#pragma unroll
                  for (int dt = 0; dt < 2; ++dt) acc[dt][ti] = MFMA16(Af[dt], Bf, acc[dt][ti]); } }
#pragma unroll
          for (int ti = 0; ti < 8; ++ti) { const size_t t = (size_t)unit * 128 + 16 * ti + li; const float bias = bs[ti];
#pragma unroll
              for (int dt = 0; dt < 2; ++dt) { const int col = hh * 128 + 64 * dh + 16 * (2 * dp + dt) + 4 * g; const u32x2 u = uu[ti][dt];
                  u32x2 w; w.x = pk2((acc[dt][ti][0] + bias) * gelu_(bflo(u.x)), (acc[dt][ti][1] + bias) * gelu_(bfhi(u.x))); w.y = pk2((acc[dt][ti][2] + bias) * gelu_(bflo(u.y)), (acc[dt][ti][3] + bias) * gelu_(bfhi(u.y)));
                  *(u32x2*)(O + t * D + 512 + col) = w; } } } }
        __syncthreads();
    }
}

#define XB_TMO      128
#define XB_XCNT(j)  (256  + 64 * (j))
#define XB_XSUB(j)  (1280 + 64 * (j))
#define XB_XGEN(j)  (2304 + 64 * (j))
#define XB_TOP      3328
#define XB_TOPGEN   3392
#define XCD_BAR_WORDS 3456
#define XB_SPIN_CAP (1u << 18)
__device__ __forceinline__ unsigned xb_ld(unsigned* p)              { return __hip_atomic_load(p, __ATOMIC_RELAXED, __HIP_MEMORY_SCOPE_AGENT); }
__device__ __forceinline__ unsigned xb_add(unsigned* p, unsigned v) { return __hip_atomic_fetch_add(p, v, __ATOMIC_RELAXED, __HIP_MEMORY_SCOPE_AGENT); }
__device__ __forceinline__ unsigned xb_xcc_id() { return (unsigned)__builtin_amdgcn_s_getreg((3 << 11) | 20) & 0xFu; }
#define XB_SPIN(cond, bar) do { unsigned _sp = 0; while (cond) { __builtin_amdgcn_s_sleep(1); \
    if ((++_sp & 255u) == 0u) { if (xb_ld(&(bar)[XB_TMO])) break; if (_sp > XB_SPIN_CAP) { atomicAdd(&(bar)[XB_TMO], 1u); break; } } } } while (0)
struct XcdBarrier { unsigned* bar; unsigned x; volatile LAS unsigned* st; int wave; };
__device__ __forceinline__ XcdBarrier xcd_barrier_post(unsigned* bar, volatile LAS unsigned* st, int wave) {
    XcdBarrier b; b.bar = bar; b.x = xb_xcc_id(); b.st = st; b.wave = wave;
    if (wave == 0 && lane_now() == 0) (void)xb_add(&bar[XB_XCNT(b.x)], 1u);
    return b;
}
__device__ __forceinline__ void xcd_barrier_complete(unsigned* bar, unsigned x, unsigned& nloc, unsigned& nx) {
    const unsigned G = gridDim.x * gridDim.y * gridDim.z;
    unsigned sum, cnt, mine, sp = 0u;
    for (;;) {
        sum = 0u; cnt = 0u; mine = 0u;
#pragma unroll
        for (unsigned j = 0; j < 16; ++j) { const unsigned c = xb_ld(&bar[XB_XCNT(j)]); sum += c; cnt += (c > 0u) ? 1u : 0u; mine = (j == x) ? c : mine; }
        if (sum == G) break;
        __builtin_amdgcn_s_sleep(1);
        if ((++sp & 255u) == 0u) { if (xb_ld(&bar[XB_TMO])) break; if (sp > XB_SPIN_CAP) { atomicAdd(&bar[XB_TMO], 1u); break; } }
    }
    nloc = mine > 0u ? mine : 1u; nx = cnt > 0u ? cnt : 1u;
}
__device__ __forceinline__ void xcd_barrier(const XcdBarrier& b) {
    asm volatile("s_waitcnt vmcnt(0)" ::: "memory");
    __syncthreads();
    if (b.wave == 0 && lane_now() == 0) {
        unsigned* bar = b.bar;
        __builtin_amdgcn_s_waitcnt(0);
        unsigned nloc = b.st[0], nx = b.st[1];
        if (nloc == 0u) { xcd_barrier_complete(bar, b.x, nloc, nx); b.st[0] = nloc; b.st[1] = nx; }
        const unsigned old = xb_add(&bar[XB_XSUB(b.x)], 1u);
        const unsigned gen = old / nloc;
        if (old + 1u == (gen + 1u) * nloc) {
            __builtin_amdgcn_fence(__ATOMIC_RELEASE, "agent");
            asm volatile("s_waitcnt vmcnt(0)" ::: "memory");
            const unsigned og = xb_add(&bar[XB_TOP], 1u);
            const unsigned tg = og / nx;
            if (og + 1u == (tg + 1u) * nx) xb_add(&bar[XB_TOPGEN], 1u);
            else XB_SPIN(xb_ld(&bar[XB_TOPGEN]) == tg, bar);
            __builtin_amdgcn_fence(__ATOMIC_ACQUIRE, "agent");
            xb_add(&bar[XB_XGEN(b.x)], 1u);
            asm volatile("s_waitcnt vmcnt(0)" ::: "memory");
        } else {
            XB_SPIN(xb_ld(&bar[XB_XGEN(b.x)]) == gen, bar);
            __builtin_amdgcn_fence(__ATOMIC_ACQUIRE, "agent");
            asm volatile("s_waitcnt vmcnt(0)" ::: "memory");
        }
    }
    __syncthreads();
}


__device__ __forceinline__ void xcd_barrier_bg(const XcdBarrier& b, const Frame& F, int lnext, bool drain) {
    asm volatile("s_waitcnt vmcnt(0)" ::: "memory");
    __syncthreads();
    volatile LAS unsigned* sx = b.st + 4;
    unsigned* q = (unsigned*)(F.ws + WS_CTL) + CW_BGQ + lnext * 64;
    if (b.wave == 0 && lane_now() == 0) {
        unsigned* bar = b.bar;
        __builtin_amdgcn_s_waitcnt(0);
        unsigned nloc = b.st[0], nx = b.st[1];
        if (nloc == 0u) { xcd_barrier_complete(bar, b.x, nloc, nx); b.st[0] = nloc; b.st[1] = nx; }
        const unsigned old = xb_add(&bar[XB_XSUB(b.x)], 1u);
        const unsigned gen = old / nloc;
        const bool leader = (old + 1u == (gen + 1u) * nloc);
        unsigned ti = 0u; if (!leader) { const unsigned k = xb_add(q, 1u); if (k < (unsigned)NBG) ti = k + 1u; }
        sx[0] = leader ? 1u : 0u; sx[1] = gen; sx[2] = ti;
    }
    __syncthreads();
    if (__builtin_amdgcn_readfirstlane(sx[0]) == 0u) {
        unsigned ti = (unsigned)__builtin_amdgcn_readfirstlane(sx[2]);
        while (ti != 0u) {
            const int it = lnext * TL_LAYER + NDEF + (int)ti - 1;
            conv_run(F, 0, 1, 1, [=](int) { return it; });
            if (b.wave == 0 && lane_now() == 0) {
                unsigned nt = 0u;
                if (drain || xb_ld(&b.bar[XB_XGEN(b.x)]) == sx[1]) { const unsigned k = xb_add(q, 1u); if (k < (unsigned)NBG) nt = k + 1u; }
                sx[2] = nt; }
            __syncthreads();
            ti = (unsigned)__builtin_amdgcn_readfirstlane(sx[2]);
            __syncthreads();
        }
    }
    if (b.wave == 0 && lane_now() == 0) {
        unsigned* bar = b.bar; const unsigned gen = sx[1], nx = b.st[1];
        asm volatile("s_waitcnt vmcnt(0)" ::: "memory");
        if (sx[0] != 0u) {
            __builtin_amdgcn_fence(__ATOMIC_RELEASE, "agent");
            asm volatile("s_waitcnt vmcnt(0)" ::: "memory");
            const unsigned og = xb_add(&bar[XB_TOP], 1u);
            const unsigned tg = og / nx;
            if (og + 1u == (tg + 1u) * nx) xb_add(&bar[XB_TOPGEN], 1u);
            else XB_SPIN(xb_ld(&bar[XB_TOPGEN]) == tg, bar);
            __builtin_amdgcn_fence(__ATOMIC_ACQUIRE, "agent");
            xb_add(&bar[XB_XGEN(b.x)], 1u);
            asm volatile("s_waitcnt vmcnt(0)" ::: "memory");
        } else {
            XB_SPIN(xb_ld(&bar[XB_XGEN(b.x)]) == gen, bar);
            __builtin_amdgcn_fence(__ATOMIC_ACQUIRE, "agent");
            asm volatile("s_waitcnt vmcnt(0)" ::: "memory");
        }
    }
    __syncthreads();
}

__device__ __forceinline__ bool opq(Frame& F) { asm volatile("" : "+s"(F.ws), "+s"(F.blk), "+s"(F.out), "+s"(F.G)); return true; }
__device__ __forceinline__ int lq_(int l) { asm volatile("" : "+s"(l)); return l; }
__global__ void __launch_bounds__(NTHR, 2) k_mega(Params p) {
    extern __shared__ __attribute__((aligned(16))) unsigned char lds[];
    Frame F; F.lds = (LAS unsigned char*)lds; F.ws = p.ws; F.in = p.in; F.out = p.out; F.wave = __builtin_amdgcn_readfirstlane(threadIdx.x >> 6); F.blk = blockIdx.x; F.G = gridDim.x;
    volatile LAS unsigned* st = (volatile LAS unsigned*)(F.lds + LDS_BYTES - 32);
    if (threadIdx.x < 8) st[threadIdx.x] = 0u;
    __syncthreads();
#if USE_CG_SYNC
#define GRID_BAR() cooperative_groups::this_grid().sync()
#else
    const XcdBarrier bar = xcd_barrier_post((unsigned*)(p.ws + WS_CTL) + CW_BAR + p.li * XCD_BAR_WORDS, st, F.wave);
#define GRID_BAR() xcd_barrier(bar)
#endif
    const int lo = p.ph_lo, hi = p.ph_hi;
#define RUN(k) (lo <= (k) && (k) < hi && opq(F))
#define SEAM(k) do { if (RUN(k) && RUN((k) + 1)) GRID_BAR(); } while (0)
#define SEAM_BG(k, drain) do { if (RUN(k) && RUN((k) + 1)) { if (!USE_CG_SYNC && l + 1 < DEPTH) xcd_barrier_bg(bar, F, l + 1, drain); else GRID_BAR(); } } while (0)
    if (RUN(0)) { phase_prologue(F); if (PROBE_DUP & 16) { __syncthreads(); phase_prologue(F); } }
    SEAM(0);
    { const int l = 0, b = 2; if (RUN(b + 0)) phase_norm1(F, lq_(l));
      SEAM_BG(b + 0, false); }
    for (int l = 0; l < DEPTH; ++l) {
        const int b = 2 + 13 * l;
        if (RUN(b + 1)) phase_gemm_in(F, lq_(l));
        SEAM_BG(b + 1, false);
        if (RUN(b + 2)) { phase_rec_c1(F, lq_(l)); phase_sgu(F, lq_(l)); if (PROBE_DUP & 1) { __syncthreads(); phase_rec_c1(F, lq_(l)); phase_sgu(F, lq_(l)); } if (PROBE_DUP & 64) { __syncthreads(); phase_sgu(F, lq_(l)); } }
        SEAM_BG(b + 2, false);
        if (RUN(b + 3)) { phase_rec_c2(F); if (PROBE_DUP & 4) phase_rec_c2(F); }
        SEAM_BG(b + 3, false);
        if (RUN(b + 5)) { phase_rec_c3(F, lq_(l)); if (PROBE_DUP & 2) { __syncthreads(); phase_rec_c3(F, lq_(l)); } if (PROBE_DUP & 128) { __syncthreads(); phase_rec_c3<1>(F, lq_(l)); } }
        SEAM_BG(b + 5, false);
        if (RUN(b + 6)) phase_gemm_out(F, lq_(l));
        SEAM_BG(b + 6, false);
        if (RUN(b + 7)) phase_norm2(F, lq_(l));
        SEAM_BG(b + 7, false);
        if (RUN(b + 8)) { phase_gather(F, lq_(l)); if (PROBE_DUP & 8) { __syncthreads(); phase_gather(F, lq_(l)); } }
        SEAM_BG(b + 8, false);
#if MOE_FUSED == 1
        if (RUN(b + 9)) phase_moe_fused(F, lq_(l));
        SEAM_BG(b + 9, false);
#elif MOE_FUSED == 2
        if (RUN(b + 9)) phase_moe_fused<1>(F, lq_(l));
        SEAM_BG(b + 9, false);
        if (RUN(b + 10)) phase_moe_fused<2>(F, lq_(l));
        SEAM_BG(b + 10, false);
#else
        if (RUN(b + 9)) phase_gemm_moe1(F, lq_(l));
        SEAM_BG(b + 9, false);
        if (RUN(b + 10)) phase_gemm_moe2(F, lq_(l));
        SEAM_BG(b + 10, false);
#endif
        if (RUN(b + 11)) phase_combine(F, lq_(l));
        SEAM_BG(b + 11, true);
        if (RUN(b + 12)) phase_gemm_pg(F, lq_(l));
        SEAM(b + 12);
    }
    if (RUN(54)) phase_final(F);
#undef RUN
#undef SEAM
}

#ifndef ONE_LAUNCH
#define ONE_LAUNCH 1
#endif
#ifndef CUTS
#define CUTS {0, 55}
#endif
#ifndef MFMA_MASK
#define MFMA_MASK 255
#endif
extern "C" void kernel_launch(void* const* d_in, const int* in_sizes, int n_in, void* d_out, int out_size, void* d_ws, size_t ws_size, hipStream_t stream) {
    if (n_in != 24 || out_size != T * D || ws_size < WS_END) { fprintf(stderr, "kernel_launch: unexpected shapes (n_in %d out %d ws %zu)\n", n_in, out_size, ws_size); return; }
    static_assert(CW_BAR + 60 * XCD_BAR_WORDS <= (int)(CTL_BYTES / 4), "barrier regions inside the zeroed control words");
    Params p{}; for (int i = 0; i < 24; ++i) p.in[i] = (const float*)d_in[i]; p.out = (float*)d_out; p.ws = (unsigned char*)d_ws;
    unsigned char* ws = p.ws;
    (void)hipMemsetAsync(ws + WS_CTL, 0, CTL_BYTES, stream);
    { static bool attr = false; if (!attr) { (void)hipFuncSetAttribute((const void*)k_mega, hipFuncAttributeMaxDynamicSharedMemorySize, LDS_BYTES); attr = true; }
      const int cuts[] = CUTS; const int ncut = (int)(sizeof(cuts) / sizeof(cuts[0]));
      for (int i = 0; i + 1 < ncut; ++i) { p.ph_lo = cuts[i]; p.ph_hi = cuts[i + 1]; p.li = i; p.pad = 0;
#if USE_CG_SYNC
          void* args[] = {&p}; hipError_t e = hipLaunchCooperativeKernel((const void*)k_mega, dim3(256), dim3(NTHR), args, LDS_BYTES, stream);
          if (e != hipSuccess) fprintf(stderr, "cooperative launch failed: %s\n", hipGetErrorName(e));
#else
          hipLaunchKernelGGL(k_mega, dim3(256), dim3(NTHR), LDS_BYTES, stream, p);
#endif
      }
    }
}
```
